# Optimizing an MI355X kernel written in HIP

```python
import jax, jax.numpy as jnp
from jax import lax
import numpy as np

D_MODEL = 2048
BATCH = 8
SEQ = 2048
DEPTH = 1

GRID_W = 64
CTX_LEN = 256
D_MIX = D_MODEL
GLA_WIDTH = D_MIX // 2
GLA_HEADS = 4
GLA_DK = GLA_WIDTH // 2 // GLA_HEADS
GLA_DV = GLA_WIDTH // GLA_HEADS
GLA_KEY_WIDTH = GLA_HEADS * GLA_DK
GLA_RANK = 16
GLA_TAU = 16.0
GLA_CHUNK = 64
POOL_WIDTH = D_MIX - GLA_WIDTH
POOL_WINDOWS = (2, 4, 8, 16)
POOL_GROUP = POOL_WIDTH // len(POOL_WINDOWS)
D_IN = 2 * GLA_KEY_WIDTH + 2 * GLA_WIDTH + 2 * GLA_RANK + POOL_WIDTH
SPLITS = (
    GLA_KEY_WIDTH,
    2 * GLA_KEY_WIDTH,
    2 * GLA_KEY_WIDTH + GLA_WIDTH,
    2 * GLA_KEY_WIDTH + 2 * GLA_WIDTH,
    2 * GLA_KEY_WIDTH + 2 * GLA_WIDTH + GLA_RANK,
    2 * GLA_KEY_WIDTH + 2 * GLA_WIDTH + 2 * GLA_RANK,
)
N_EXPERTS = 64
TOP_K = 8
N_GROUPS = 8
TOPK_GROUPS = 4
D_EXPERT = D_MODEL // 4
D_SHARED = D_MODEL // 4
ROUTED_SCALE = 2.5
MOE_BLOCK = 256
EPS = 1e-6

kernel_name = "hybrid_gla_pool_moe_dit_prefix"


def _rmsnorm(x, g):
    xf = x.astype(jnp.float32)
    y = xf * lax.rsqrt(jnp.mean(xf * xf, axis=-1, keepdims=True) + EPS)
    return (y * g.astype(jnp.float32)).astype(x.dtype)


def _log_decay(a_lr, w_a2, b_a):
    B, L, _ = a_lr.shape
    z = (a_lr @ w_a2 + b_a).astype(jnp.float32)
    return (jax.nn.log_sigmoid(z) / GLA_TAU).reshape(B, L, GLA_HEADS, GLA_DK)


def _gla_scan(q, k, v, g, s0, with_output):
    B, L, H, DK = q.shape
    DV = v.shape[-1]
    C = GLA_CHUNK
    n = L // C
    qc = q.reshape(B, n, C, H, DK)
    kc = k.reshape(B, n, C, H, DK)
    vc = v.reshape(B, n, C, H, DV)
    G = jnp.cumsum(g.reshape(B, n, C, H, DK), axis=2)
    G_end = G[:, :, -1:]
    u = jnp.einsum("bnchk,bnchv->nbhkv", kc * jnp.exp(G_end - G), vc)
    decay = jnp.moveaxis(jnp.exp(G_end[:, :, 0]), 1, 0)

    def step(s, inp):
        d, du = inp
        return d[..., None] * s + du, s

    s_final, s_prev = lax.scan(step, s0, (decay, u))
    if not with_output:
        return None, s_final
    o_inter = jnp.einsum("bnchk,nbhkv->bnchv", qc * jnp.exp(G), s_prev)
    G_mid = G[:, :, C // 2 : C // 2 + 1]
    a = jnp.einsum("bnihk,bnjhk->bnhij", qc * jnp.exp(G - G_mid), kc * jnp.exp(G_mid - G))
    lower = jnp.tril(jnp.ones((C, C), dtype=bool))
    a = jnp.where(lower, a, 0.0)
    o_intra = jnp.einsum("bnhij,bnjhv->bnihv", a, vc)
    return (o_inter + o_intra).reshape(B, L, H, DV), s_final


def _window_mean(x, w, axis):
    n = x.shape[axis]
    xf = jnp.moveaxis(x.astype(jnp.float32), axis, 0)
    cs = jnp.concatenate([jnp.zeros_like(xf[:1]), jnp.cumsum(xf, axis=0)], axis=0)
    pos = jnp.arange(n)
    lo = jnp.maximum(pos - w // 2, 0)
    hi = jnp.minimum(pos + w // 2, n)
    cnt = (hi - lo).astype(jnp.float32).reshape((n,) + (1,) * (xf.ndim - 1))
    return jnp.moveaxis((cs[hi] - cs[lo]) / cnt, 0, axis)


def _pool_mixer(p, w_pool, pool_scale, grid):
    B, L, _ = p.shape
    pg = p.reshape(B, L, len(POOL_WINDOWS), POOL_GROUP)
    outs = []
    for gi, w in enumerate(POOL_WINDOWS):
        xg = pg[:, :, gi]
        if grid:
            rows = L // GRID_W
            x2 = xg.reshape(B, rows, GRID_W, POOL_GROUP)
            m = _window_mean(_window_mean(x2, w, 1), w, 2).reshape(B, L, POOL_GROUP)
        else:
            m = _window_mean(xg, w, 1)
        outs.append(m.astype(p.dtype) - xg)
    d = jnp.stack(outs, axis=2)
    y = jnp.einsum("blgc,gcd->blgd", d, w_pool).reshape(B, L, POOL_WIDTH)
    return y * pool_scale


def _token_mixer(u, s_f0, s_b0, w_a2_f, b_a_f, w_a2_b, b_a_b, gla_norm, w_pool, pool_scale,
                 w_out, grid, with_output):
    B, L, _ = u.shape
    f32 = jnp.float32
    q, k, v, r, a_f, a_b, p = jnp.split(u, SPLITS, axis=-1)
    q = q.astype(f32).reshape(B, L, GLA_HEADS, GLA_DK) * (GLA_DK ** -0.5)
    k = k.astype(f32).reshape(B, L, GLA_HEADS, GLA_DK)
    v = v.astype(f32).reshape(B, L, GLA_HEADS, GLA_DV)
    g_f = _log_decay(a_f, w_a2_f, b_a_f)
    g_b = _log_decay(a_b, w_a2_b, b_a_b)
    o_f, s_f = _gla_scan(q, k, v, g_f, s_f0, with_output)
    o_b, s_b = _gla_scan(q[:, ::-1], k[:, ::-1], v[:, ::-1], g_b[:, ::-1], s_b0, with_output)
    if not with_output:
        return None, s_f, s_b
    o = o_f + o_b[:, ::-1]
    o = o * lax.rsqrt(jnp.mean(o * o, axis=-1, keepdims=True) + EPS)
    o = o * gla_norm.astype(f32).reshape(GLA_HEADS, GLA_DV)
    y_gla = o.reshape(B, L, GLA_WIDTH).astype(u.dtype) * jax.nn.silu(r)
    y_pool = _pool_mixer(p, w_pool, pool_scale, grid)
    y = jnp.concatenate([y_gla, y_pool], axis=-1) @ w_out
    return y, s_f, s_b


def _route(h, w_router, router_bias):
    scores = jax.nn.sigmoid((h @ w_router).astype(jnp.float32))
    sel = scores + router_bias.astype(jnp.float32)
    grp = sel.reshape(-1, N_GROUPS, N_EXPERTS // N_GROUPS)
    grp_score = lax.top_k(grp, 2)[0].sum(-1)
    _, gidx = lax.top_k(grp_score, TOPK_GROUPS)
    gmask = jax.nn.one_hot(gidx, N_GROUPS, dtype=jnp.float32).sum(1) > 0
    emask = jnp.repeat(gmask, N_EXPERTS // N_GROUPS, axis=1)
    _, eidx = lax.top_k(jnp.where(emask, sel, -jnp.inf), TOP_K)
    wts = jnp.take_along_axis(scores, eidx, axis=1)
    wts = wts / jnp.sum(wts, axis=-1, keepdims=True) * ROUTED_SCALE
    return eidx, wts


def _moe(h, w_router, router_bias, w_eg, w_eu, w_ed, w_sg, w_su, w_sd):
    T, D = h.shape
    eidx, wts = _route(h, w_router, router_bias)
    tk = T * TOP_K
    e_flat = eidx.reshape(tk)
    tok_flat = jnp.repeat(jnp.arange(T, dtype=jnp.int32), TOP_K)
    w_flat = wts.reshape(tk)
    order = jnp.argsort(e_flat)
    e_sorted = e_flat[order]
    counts = jnp.zeros((N_EXPERTS,), jnp.int32).at[e_flat].add(1)
    starts = jnp.cumsum(counts) - counts
    padded = (counts + MOE_BLOCK - 1) // MOE_BLOCK * MOE_BLOCK
    pends = jnp.cumsum(padded)
    pstarts = pends - padded
    dest = pstarts[e_sorted] + jnp.arange(tk, dtype=jnp.int32) - starts[e_sorted]
    n_blocks = -(-tk // MOE_BLOCK) + N_EXPERTS
    n_rows = n_blocks * MOE_BLOCK
    tok_buf = jnp.full((n_rows,), T, jnp.int32).at[dest].set(tok_flat[order])
    gate_buf = jnp.zeros((n_rows,), h.dtype).at[dest].set(w_flat[order].astype(h.dtype))
    block_start = jnp.arange(n_blocks, dtype=jnp.int32) * MOE_BLOCK
    block_e = jnp.minimum(jnp.searchsorted(pends, block_start, side="right"), N_EXPERTS - 1)
    h_pad = jnp.concatenate([h, jnp.zeros((1, D), h.dtype)], axis=0)

    def body(acc, blk):
        tok, gate, e = blk
        rows = h_pad[tok]
        a = jax.nn.silu(rows @ w_eg[e]) * (rows @ w_eu[e])
        y = (a @ w_ed[e]) * gate[:, None]
        return acc.at[tok].add(y), None

    acc, _ = lax.scan(body, jnp.zeros((T + 1, D), h.dtype),
                      (tok_buf.reshape(n_blocks, MOE_BLOCK), gate_buf.reshape(n_blocks, MOE_BLOCK), block_e))
    shared = (jax.nn.silu(h @ w_sg) * (h @ w_su)) @ w_sd
    return acc[:T] + shared


def setup_inputs(seed: int = 0) -> dict:
    key = jax.random.key(seed)
    ks = jax.random.split(key, 27)
    f32 = jnp.float32
    L = DEPTH
    D = D_MODEL

    def nrm(k, shape, scale):
        return jax.random.normal(k, shape, f32) * scale

    def gain(k, n):
        return 1.0 + 0.05 * jax.random.normal(k, (L, n), f32)

    return {
        "x": nrm(ks[0], (BATCH, SEQ, D), 1.0),
        "c": nrm(ks[1], (BATCH, D), 1.0),
        "ctx": nrm(ks[2], (BATCH, CTX_LEN, D), 1.0),
        "c_ctx": nrm(ks[3], (D,), 1.0),
        "w_mod": nrm(ks[4], (L, D, 6 * D), 0.5 * D ** -0.5),
        "b_mod": nrm(ks[5], (L, 6 * D), 0.02),
        "norm_mix_pre": gain(ks[6], D),
        "norm_mix_post": gain(ks[7], D),
        "norm_ffn_pre": gain(ks[8], D),
        "norm_ffn_post": gain(ks[9], D),
        "w_in": nrm(ks[10], (L, D, D_IN), D ** -0.5),
        "w_a2_fwd": nrm(ks[11], (L, GLA_RANK, GLA_KEY_WIDTH), GLA_RANK ** -0.5),
        "b_a_fwd": nrm(ks[12], (L, GLA_KEY_WIDTH), 0.5),
        "w_a2_bwd": nrm(ks[13], (L, GLA_RANK, GLA_KEY_WIDTH), GLA_RANK ** -0.5),
        "b_a_bwd": nrm(ks[14], (L, GLA_KEY_WIDTH), 0.5),
        "gla_norm": gain(ks[15], GLA_WIDTH),
        "w_pool": nrm(ks[16], (L, len(POOL_WINDOWS), POOL_GROUP, POOL_GROUP), POOL_GROUP ** -0.5),
        "pool_scale": gain(ks[17], POOL_WIDTH),
        "w_out": nrm(ks[18], (L, D_MIX, D), D_MIX ** -0.5),
        "w_router": nrm(ks[19], (L, D, N_EXPERTS), D ** -0.5),
        "router_bias": nrm(ks[20], (L, N_EXPERTS), 0.01),
        "w_exp_gate": nrm(ks[21], (L, N_EXPERTS, D, D_EXPERT), D ** -0.5),
        "w_exp_up": nrm(ks[22], (L, N_EXPERTS, D, D_EXPERT), D ** -0.5),
        "w_exp_down": nrm(ks[23], (L, N_EXPERTS, D_EXPERT, D), D_EXPERT ** -0.5),
        "w_sh_gate": nrm(ks[24], (L, D, D_SHARED), D ** -0.5),
        "w_sh_up": nrm(ks[25], (L, D, D_SHARED), D ** -0.5),
        "w_sh_down": nrm(ks[26], (L, D_SHARED, D), D_SHARED ** -0.5),
    }


def reference(x, c, ctx, c_ctx, w_mod, b_mod, norm_mix_pre, norm_mix_post, norm_ffn_pre,
              norm_ffn_post, w_in, w_a2_fwd, b_a_fwd, w_a2_bwd, b_a_bwd, gla_norm, w_pool,
              pool_scale, w_out, w_router, router_bias, w_exp_gate, w_exp_up, w_exp_down,
              w_sh_gate, w_sh_up, w_sh_down):
    B = x.shape[0]
    zero_state = jnp.zeros((B, GLA_HEADS, GLA_DK, GLA_DV), jnp.float32)
    for i in range(DEPTH):
        last = i == DEPTH - 1
        mod = jax.nn.silu(c) @ w_mod[i] + b_mod[i]
        mod_c = jax.nn.silu(c_ctx) @ w_mod[i] + b_mod[i]
        sh1, sc1, gt1, sh2, sc2, gt2 = jnp.split(mod[:, None, :], 6, axis=-1)
        csh1, csc1, cgt1, csh2, csc2, cgt2 = jnp.split(mod_c, 6, axis=-1)
        mix_w = (w_a2_fwd[i], b_a_fwd[i], w_a2_bwd[i], b_a_bwd[i], gla_norm[i], w_pool[i],
                 pool_scale[i], w_out[i])
        ffn_w = (w_router[i], router_bias[i], w_exp_gate[i], w_exp_up[i], w_exp_down[i],
                 w_sh_gate[i], w_sh_up[i], w_sh_down[i])
        hc = _rmsnorm(ctx, norm_mix_pre[i]) * (1 + csc1) + csh1
        y_c, s_f, s_b = _token_mixer(hc @ w_in[i], zero_state, zero_state, *mix_w,
                                     grid=False, with_output=not last)
        h = _rmsnorm(x, norm_mix_pre[i]) * (1 + sc1) + sh1
        y, _, _ = _token_mixer(h @ w_in[i], s_f, s_b, *mix_w, grid=True, with_output=True)
        x = x + gt1 * _rmsnorm(y, norm_mix_post[i])
        h = _rmsnorm(x, norm_ffn_pre[i]) * (1 + sc2) + sh2
        y = _moe(h.reshape(-1, D_MODEL), *ffn_w).reshape(x.shape)
        x = x + gt2 * _rmsnorm(y, norm_ffn_post[i])
        if not last:
            ctx = ctx + cgt1 * _rmsnorm(y_c, norm_mix_post[i])
            hc = _rmsnorm(ctx, norm_ffn_pre[i]) * (1 + csc2) + csh2
            y_c = _moe(hc.reshape(-1, D_MODEL), *ffn_w).reshape(ctx.shape)
            ctx = ctx + cgt2 * _rmsnorm(y_c, norm_ffn_post[i])
    return x
```

```cpp
#include <hip/hip_runtime.h>
#include <cstdio>
#include <cstdint>

#ifndef N_LAUNCHES
#define N_LAUNCHES 11
#endif

#define GAS __attribute__((address_space(1)))
#define LAS __attribute__((address_space(3)))
typedef unsigned short bf16;
typedef unsigned v4u __attribute__((ext_vector_type(4)));
typedef unsigned v2u __attribute__((ext_vector_type(2)));
typedef float f32x4 __attribute__((ext_vector_type(4)));
typedef short bf16x8 __attribute__((ext_vector_type(8)));
typedef unsigned long long u64;

constexpr int NB = 8, SEQ = 2048, DM = 2048, CTXL = 256;
constexpr int NT = NB * SEQ;
constexpr int NTC = NB * CTXL;
constexpr int MROWS = NT + NTC;
constexpr int DIN = 4128, DINP = 4352;
constexpr int NE = 64, TOPK = 8, DE = 512;
constexpr int NSLOT_E = NT * TOPK;
constexpr int SH_ROW0 = NSLOT_E + 256;
constexpr int NSLOT = SH_ROW0 + NT;
constexpr int NTILE_MAX = 704;
constexpr float EPS = 1e-6f;
constexpr int NPH = 11;

constexpr size_t MiB = 1u << 20;
constexpr size_t WS_CTL = 0, CTL_ZERO_BYTES = 64 * 1024;
constexpr size_t WS_MOD = 1 * MiB;
constexpr size_t WS_TAB = 1 * MiB + 512 * 1024;
constexpr size_t WS_WIN = 2 * MiB;
constexpr size_t WS_WOUT = WS_WIN + 17 * MiB;
constexpr size_t WS_WPOOL = WS_WOUT + 8 * MiB;
constexpr size_t WS_WD = WS_WPOOL + 1 * MiB;
constexpr size_t WS_WGU = WS_WD + 130 * MiB;
constexpr size_t WS_RA = WS_WGU + 260 * MiB;
constexpr size_t RA_H = WS_RA;
constexpr size_t RA_OF = WS_RA;
constexpr size_t RA_H2 = WS_RA;
constexpr size_t RA_Q = WS_RA + 128 * MiB;
constexpr size_t RA_K = RA_Q + 16 * MiB;
constexpr size_t RA_V = RA_K + 18 * MiB;
constexpr size_t RA_R = RA_V + 36 * MiB;
constexpr size_t RA_P = RA_R + 32 * MiB;
constexpr size_t RA_ALR = RA_P + 32 * MiB;
constexpr size_t RA_DPOOL = RA_ALR + 3 * MiB;
constexpr size_t RA_YMIX = RA_DPOOL + 32 * MiB;
constexpr size_t RA_Y1 = WS_RA + 128 * MiB;
constexpr size_t RA_END = RA_YMIX + 64 * MiB;
constexpr size_t WS_SLOTOUT = WS_WGU;
constexpr size_t WS_ACT = RA_END > WS_SLOTOUT + 578 * MiB ? RA_END : WS_SLOTOUT + 578 * MiB;
constexpr size_t WS_END = WS_ACT + 145 * MiB;
constexpr size_t WS_T0 = WS_END;
constexpr size_t T_CNT = WS_T0;
constexpr size_t T_MASK = T_CNT + 65536;
constexpr size_t T_TOKW = T_MASK + 131072;
constexpr size_t T_TOKSLOT = T_TOKW + 524288;
constexpr size_t T_SLOTTOK = T_TOKSLOT + 524288;
constexpr size_t T_SLOTW = T_SLOTTOK + 655360;
constexpr size_t T_TILE = T_SLOTW + 655360;
constexpr size_t WS_NEED = T_TILE + 16384;

constexpr int RING_BYTES = 131072;
constexpr int LDS_MISC = RING_BYTES;
constexpr int LDS_LOGIT = RING_BYTES + 256;
constexpr int LDS_MASKS = LDS_LOGIT + 4096;
constexpr int LDS_BYTES = 147456;

#define LDS_WAIT() asm volatile("s_waitcnt lgkmcnt(0)" ::: "memory")
#define VM_WAIT() asm volatile("s_waitcnt vmcnt(0)" ::: "memory")

__device__ __forceinline__ unsigned f2bf(float f) { unsigned u = __builtin_bit_cast(unsigned, f); return (u + 0x7fffu + ((u >> 16) & 1u)) >> 16; }
__device__ __forceinline__ unsigned pk2(float lo, float hi) { return f2bf(lo) | (f2bf(hi) << 16); }
__device__ __forceinline__ float bflo(unsigned u) { return __builtin_bit_cast(float, u << 16); }
__device__ __forceinline__ float bfhi(unsigned u) { return __builtin_bit_cast(float, u & 0xffff0000u); }
__device__ __forceinline__ float bf1(bf16 b) { return __builtin_bit_cast(float, ((unsigned)b) << 16); }
__device__ __forceinline__ float wave_sum(float v) {
#pragma unroll
    for (int o = 1; o < 64; o <<= 1) v += __shfl_xor(v, o);
    return v;
}
__device__ __forceinline__ float silu_f(float x) { return x / (1.f + __expf(-x)); }

#define XB_TMO      128
#define XB_XCNT(j)  (256  + 64 * (j))
#define XB_XSUB(j)  (1280 + 64 * (j))
#define XB_XGEN(j)  (2304 + 64 * (j))
#define XB_TOP      3328
#define XB_TOPGEN   3392
#define XCD_BAR_WORDS 3456
#define XB_SPIN_CAP (1u << 18)

__device__ __forceinline__ unsigned xb_ld(unsigned* p)              { return __hip_atomic_load(p, __ATOMIC_RELAXED, __HIP_MEMORY_SCOPE_AGENT); }
__device__ __forceinline__ unsigned xb_add(unsigned* p, unsigned v) { return __hip_atomic_fetch_add(p, v, __ATOMIC_RELAXED, __HIP_MEMORY_SCOPE_AGENT); }
__device__ __forceinline__ unsigned xb_xcc_id() { return (unsigned)__builtin_amdgcn_s_getreg((3 << 11) | 20) & 0xFu; }
#define XB_SPIN(cond, bar) do { unsigned _sp = 0; while (cond) { __builtin_amdgcn_s_sleep(1); \
    if ((++_sp & 255u) == 0u) { if (xb_ld(&(bar)[XB_TMO])) break; if (_sp > XB_SPIN_CAP) { atomicAdd(&(bar)[XB_TMO], 1u); break; } } } } while (0)

struct XcdBarrier { unsigned* bar; unsigned x; volatile LAS unsigned* st; };

__device__ __forceinline__ XcdBarrier xcd_barrier_post(unsigned* bar, volatile LAS unsigned* st) {
    XcdBarrier b; b.bar = bar; b.x = xb_xcc_id(); b.st = st;
    if (threadIdx.x == 0) (void)xb_add(&bar[XB_XCNT(b.x)], 1u);
    return b;
}
__device__ __forceinline__ void xcd_barrier_complete(unsigned* bar, unsigned x, unsigned& nloc, unsigned& nx) {
    const unsigned G = gridDim.x * gridDim.y * gridDim.z;
    unsigned sum, cnt, mine, sp = 0u;
    for (;;) {
        sum = 0u; cnt = 0u; mine = 0u;
#pragma unroll
        for (unsigned j = 0; j < 16; ++j) { const unsigned c = xb_ld(&bar[XB_XCNT(j)]); sum += c; cnt += (c > 0u) ? 1u : 0u; mine = (j == x) ? c : mine; }
        if (sum == G) break;
        __builtin_amdgcn_s_sleep(1);
        if ((++sp & 255u) == 0u) { if (xb_ld(&bar[XB_TMO])) break; if (sp > XB_SPIN_CAP) { atomicAdd(&bar[XB_TMO], 1u); break; } }
    }
    nloc = mine > 0u ? mine : 1u; nx = cnt > 0u ? cnt : 1u;
}
__device__ __forceinline__ void xcd_barrier(const XcdBarrier& b) {
    asm volatile("s_waitcnt vmcnt(0)" ::: "memory");
    __syncthreads();
    if (threadIdx.x == 0) {
        unsigned* bar = b.bar;
        __builtin_amdgcn_s_waitcnt(0);
        unsigned nloc = b.st[0], nx = b.st[1];
        if (nloc == 0u) { xcd_barrier_complete(bar, b.x, nloc, nx); b.st[0] = nloc; b.st[1] = nx; }
        const unsigned old = xb_add(&bar[XB_XSUB(b.x)], 1u);
        const unsigned gen = old / nloc;
        if (old + 1u == (gen + 1u) * nloc) {
            __builtin_amdgcn_fence(__ATOMIC_RELEASE, "agent");
            asm volatile("s_waitcnt vmcnt(0)" ::: "memory");
            const unsigned og = xb_add(&bar[XB_TOP], 1u);
            const unsigned tg = og / nx;
            if (og + 1u == (tg + 1u) * nx) xb_add(&bar[XB_TOPGEN], 1u);
            else XB_SPIN(xb_ld(&bar[XB_TOPGEN]) == tg, bar);
            __builtin_amdgcn_fence(__ATOMIC_ACQUIRE, "agent");
            xb_add(&bar[XB_XGEN(b.x)], 1u);
            asm volatile("s_waitcnt vmcnt(0)" ::: "memory");
        } else {
            XB_SPIN(xb_ld(&bar[XB_XGEN(b.x)]) == gen, bar);
            __builtin_amdgcn_fence(__ATOMIC_ACQUIRE, "agent");
            asm volatile("s_waitcnt vmcnt(0)" ::: "memory");
        }
    }
    __syncthreads();
}

namespace pg8 {
constexpr int BM = 256, BK = 64, HALF = 128, HTB = HALF * BK * 2, STAGE_BYTES = 8 * HTB, NXCD = 8, WGM = 8;
__device__ __forceinline__ int lds_byte(int r, int c) { const int st = (r >> 4) * 2 + (c >> 5), rr = r & 15, cc = c & 31, ob = rr * 64 + cc * 2; return st * 1024 + (ob ^ (((ob >> 9) & 1) << 5)); }
__device__ __forceinline__ void stage_rc(int b, int& R, int& C) { const int st = b / 1024, sb = b % 1024, swz = sb ^ (((sb >> 9) & 1) << 5); R = (st >> 1) * 16 + swz / 64; C = (st & 1) * 32 + (swz % 64) / 2; }
__device__ __forceinline__ int perm32(int rho) { const int n = rho >> 4, i = rho & 15; return 8 * (i >> 2) + 4 * n + (i & 3); }
__device__ __forceinline__ unsigned cvt_pk_bf16(float lo, float hi) { unsigned r; asm volatile("v_cvt_pk_bf16_f32 %0, %1, %2" : "=v"(r) : "v"(lo), "v"(hi)); return r; }

template <class Epi, class Sched>
__device__ __forceinline__ void gemm_phase(LAS unsigned char* lds, const int K, const Sched& S, const Epi& E) {
    typedef typename Sched::U Unit;
    const int tid = threadIdx.x, wid = __builtin_amdgcn_readfirstlane(tid >> 6), lane = tid & 63, wr = wid >> 2, wc = wid & 3, fr = lane & 15, fq = lane >> 4;
    const int nt = K / BK;
    int R[2], C[2]; unsigned voffB[2];
#pragma unroll
    for (int i = 0; i < 2; ++i) { stage_rc(tid * 16 + i * 8192, R[i], C[i]); const int Rb = Epi::PERM ? ((R[i] & ~31) + perm32(R[i] & 31)) : R[i];
        voffB[i] = (unsigned)(Rb * K + C[i]) * 2u; }
    const size_t kstep = (size_t)(BK * 2);
    const size_t hstepB = (size_t)HALF * K * 2;
    const unsigned ldsw = (unsigned)wid * 1024u;
    const int aoff = lds_byte(wr * 64 + fr, fq * 8), boff = lds_byte(wc * 32 + fr, fq * 8);
#define PG8_SA(b, h) (((b) * 2 + (h)) * HTB)
#define PG8_SB(b, h) ((4 + (b) * 2 + (h)) * HTB)
#define PG8_STAGE(bufoff, gbase, v0, v1) do { \
        __builtin_amdgcn_global_load_lds((const unsigned*)((const char*)(gbase) + (v0)), (LAS unsigned*)(lds + (bufoff) + ldsw), 16, 0, 0); \
        __builtin_amdgcn_global_load_lds((const unsigned*)((const char*)(gbase) + (v1)), (LAS unsigned*)(lds + (bufoff) + ldsw + 8192), 16, 0, 0); } while (0)
#define PG8_LDA(dst, b, h) do { _Pragma("unroll") for (int m = 0; m < 4; ++m) _Pragma("unroll") for (int k = 0; k < 2; ++k) dst[m][k] = *(const LAS bf16x8*)(lds + PG8_SA(b, h) + aoff + m * 2048 + k * 1024); } while (0)
#define PG8_LDB(dst, b, h) do { _Pragma("unroll") for (int n = 0; n < 2; ++n) _Pragma("unroll") for (int k = 0; k < 2; ++k) dst[n][k] = *(const LAS bf16x8*)(lds + PG8_SB(b, h) + boff + n * 2048 + k * 1024); } while (0)
#define PG8_MMA(ai, bj, At, Bt) do { __builtin_amdgcn_s_setprio(1); _Pragma("unroll") for (int m = 0; m < 4; ++m) _Pragma("unroll") for (int n = 0; n < 2; ++n) _Pragma("unroll") for (int k = 0; k < 2; ++k) \
        acc[ai][bj][m][n] = __builtin_amdgcn_mfma_f32_16x16x32_bf16(Bt[n][k], At[m][k], acc[ai][bj][m][n], 0, 0, 0); __builtin_amdgcn_s_setprio(0); } while (0)
#define PG8_WAIT_V(n) asm volatile("s_waitcnt vmcnt(" #n ")" ::: "memory")
#define PG8_WAIT_L(n) asm volatile("s_waitcnt lgkmcnt(" #n ")" ::: "memory")
#define PG8_BAR __builtin_amdgcn_s_barrier()
#define PG8_SCHED __builtin_amdgcn_sched_barrier(0)
    Unit cur, nxt; int ui = 0;
    if (!S.next(0, cur)) return;
    f32x4 acc[2][2][4][2];
#pragma unroll
    for (int a = 0; a < 2; ++a)
#pragma unroll
        for (int b = 0; b < 2; ++b)
#pragma unroll
            for (int m = 0; m < 4; ++m)
#pragma unroll
                for (int n = 0; n < 2; ++n) acc[a][b][m][n] = (f32x4){0.f, 0.f, 0.f, 0.f};
    bf16x8 At[4][2], B0[2][2], B1[2][2];
    unsigned vA[4], vN[4];
    S.aoffs(cur, R, C, vA);
    const char* cA = cur.A; const char* cB = cur.B;
    PG8_STAGE(PG8_SB(0, 0), cB, voffB[0], voffB[1]); PG8_STAGE(PG8_SB(0, 1), cB + hstepB, voffB[0], voffB[1]); PG8_STAGE(PG8_SA(0, 0), cA, vA[0], vA[1]); PG8_STAGE(PG8_SA(0, 1), cA, vA[2], vA[3]);
    if (wr == 1) PG8_BAR;
    PG8_WAIT_V(2); PG8_BAR;
    PG8_STAGE(PG8_SB(1, 0), cB + kstep, voffB[0], voffB[1]); PG8_STAGE(PG8_SA(1, 0), cA + kstep, vA[0], vA[1]); PG8_STAGE(PG8_SB(1, 1), cB + hstepB + kstep, voffB[0], voffB[1]);
    PG8_WAIT_V(6); PG8_BAR;
    for (;;) {
        const bool has_next = S.next(ui + 1, nxt);
        const char* nA = has_next ? nxt.A : cA; const char* nB = has_next ? nxt.B : cB;
        if (has_next) S.aoffs(nxt, R, C, vN); else { vN[0] = vA[0]; vN[1] = vA[1]; vN[2] = vA[2]; vN[3] = vA[3]; }
        for (int t = 0; t < nt; t += 2) {
            const bool last = (t == nt - 2);
            const char* a1 = cA + (size_t)(t + 1) * kstep;
            const char* a2 = last ? nA : cA + (size_t)(t + 2) * kstep; const char* b2 = last ? nB : cB + (size_t)(t + 2) * kstep;
            const char* a3 = a2 + kstep; const char* b3 = b2 + kstep;
            const unsigned x0 = last ? vN[0] : vA[0], x1 = last ? vN[1] : vA[1], x2 = last ? vN[2] : vA[2], x3 = last ? vN[3] : vA[3];
            PG8_LDB(B0, 0, 0); PG8_LDB(B1, 0, 1); PG8_SCHED; PG8_LDA(At, 0, 0); PG8_STAGE(PG8_SA(1, 1), a1, vA[2], vA[3]);
            PG8_WAIT_V(8); PG8_WAIT_L(0); PG8_BAR; PG8_MMA(0, 0, At, B0); PG8_MMA(0, 1, At, B1); PG8_BAR; PG8_SCHED;
            PG8_LDA(At, 0, 1); PG8_STAGE(PG8_SB(0, 0), b2, voffB[0], voffB[1]); PG8_STAGE(PG8_SB(0, 1), b2 + hstepB, voffB[0], voffB[1]); PG8_STAGE(PG8_SA(0, 0), a2, x0, x1);
            PG8_WAIT_V(8); PG8_WAIT_L(0); PG8_BAR; PG8_MMA(1, 0, At, B0); PG8_MMA(1, 1, At, B1); PG8_BAR; PG8_SCHED;
            PG8_LDB(B0, 1, 0); PG8_LDB(B1, 1, 1); PG8_SCHED; PG8_LDA(At, 1, 0); PG8_STAGE(PG8_SA(0, 1), a2, x2, x3);
            PG8_WAIT_V(8); PG8_WAIT_L(0); PG8_BAR; PG8_MMA(0, 0, At, B0); PG8_MMA(0, 1, At, B1); PG8_BAR; PG8_SCHED;
            PG8_LDA(At, 1, 1); PG8_STAGE(PG8_SB(1, 0), b3, voffB[0], voffB[1]); PG8_STAGE(PG8_SB(1, 1), b3 + hstepB, voffB[0], voffB[1]); PG8_STAGE(PG8_SA(1, 0), a3, x0, x1);
            PG8_WAIT_V(8); PG8_WAIT_L(0); PG8_BAR; PG8_MMA(1, 0, At, B0); PG8_MMA(1, 1, At, B1); PG8_BAR; PG8_SCHED;
        }
        if (wr == 0) PG8_BAR;
        E(acc, cur, wr, wc, fr, fq);
        if (!has_next) break;
#pragma unroll
        for (int a = 0; a < 2; ++a)
#pragma unroll
            for (int b = 0; b < 2; ++b)
#pragma unroll
                for (int m = 0; m < 4; ++m)
#pragma unroll
                    for (int n = 0; n < 2; ++n) acc[a][b][m][n] = (f32x4){0.f, 0.f, 0.f, 0.f};
        cur = nxt; cA = nA; cB = nB; ++ui;
        vA[0] = vN[0]; vA[1] = vN[1]; vA[2] = vN[2]; vA[3] = vN[3];
        if (wr == 1) PG8_BAR;
    }
    PG8_WAIT_V(0);
    PG8_BAR;
#undef PG8_SA
#undef PG8_SB
#undef PG8_STAGE
#undef PG8_LDA
#undef PG8_LDB
#undef PG8_MMA
#undef PG8_WAIT_V
#undef PG8_WAIT_L
#undef PG8_BAR
#undef PG8_SCHED
}
}

struct Args { const float* in[27]; float* out; unsigned char* ws; int ph_lo, ph_hi; };
static_assert(sizeof(Args) == 27 * 8 + 8 + 8 + 8, "Args has no padding");

struct DenseU { const char* A; const char* B; int pm, pn; };
struct DenseSched {
    typedef DenseU U;
    const char* A; const char* B; int lda, K, nM, nN, nwg, G, c;
    __device__ __forceinline__ void init(const void* A_, const void* B_, int lda_, int K_, int M, int N, int G_, int c_) { A = (const char*)A_; B = (const char*)B_; lda = lda_; K = K_; nM = M / 256; nN = N / 256; nwg = nM * nN; G = G_; c = c_; }
    __device__ __forceinline__ bool next(int i, U& u) const {
        const long L = (long)i * G + c; if (L >= nwg) return false;
        int wgid = (int)L; { const int q = nwg / 8, r = nwg % 8, xcd = wgid % 8, off = wgid / 8; wgid = (xcd < r ? xcd * (q + 1) : r * (q + 1) + (xcd - r) * q) + off; }
        const int nig = 8 * nN, gid = wgid / nig, fm = gid * 8, gsz = (nM - fm) < 8 ? (nM - fm) : 8;
        u.pm = fm + ((wgid % nig) % gsz); u.pn = (wgid % nig) / gsz;
        u.A = A + (size_t)u.pm * 256 * lda * 2; u.B = B + (size_t)u.pn * 256 * K * 2; return true;
    }
    __device__ __forceinline__ void aoffs(const U&, const int (&R)[2], const int (&C)[2], unsigned (&v)[4]) const {
#pragma unroll
        for (int h = 0; h < 2; ++h)
#pragma unroll
            for (int i = 0; i < 2; ++i) v[h * 2 + i] = (unsigned)((h * 128 + R[i]) * lda + C[i]) * 2u;
    }
};
struct PoolU { const char* A; const char* B; int pm, g; };
struct PoolSched {
    typedef PoolU U;
    const char* A; const char* B; int G, c;
    __device__ __forceinline__ bool next(int i, U& u) const {
        const int L = i * G + c; if (L >= 256) return false;
        u.g = L & 3; u.pm = L >> 2;
        u.A = A + ((size_t)u.pm * 256 * 1024 + u.g * 256) * 2; u.B = B + (size_t)u.g * 256 * 256 * 2; return true;
    }
    __device__ __forceinline__ void aoffs(const U&, const int (&R)[2], const int (&C)[2], unsigned (&v)[4]) const {
#pragma unroll
        for (int h = 0; h < 2; ++h)
#pragma unroll
            for (int i = 0; i < 2; ++i) v[h * 2 + i] = (unsigned)((h * 128 + R[i]) * 1024 + C[i]) * 2u;
    }
};
struct MoeU { const char* A; const char* B; int row0, nrows, pn; };
struct MoeGUSched {
    typedef MoeU U;
    const char* H2; const char* W; const int* tile; const int* slot_tok; int G, c;
    __device__ __forceinline__ bool next(int i, U& u) const {
        const int nt = tile[3 * NTILE_MAX]; const int L = i * G + c; if (L >= nt * 4) return false;
        const int t = L >> 2; u.pn = L & 3; const int e = tile[t]; u.row0 = tile[NTILE_MAX + t]; u.nrows = tile[2 * NTILE_MAX + t];
        u.A = H2; u.B = W + ((size_t)e * 1024 + u.pn * 256) * 2048 * 2; return true;
    }
    __device__ __forceinline__ void aoffs(const U& u, const int (&R)[2], const int (&C)[2], unsigned (&v)[4]) const {
#pragma unroll
        for (int h = 0; h < 2; ++h)
#pragma unroll
            for (int i = 0; i < 2; ++i) { int r = h * 128 + R[i]; r = r < u.nrows ? r : u.nrows - 1; const int tok = slot_tok[u.row0 + r]; v[h * 2 + i] = (unsigned)(tok * 2048 + C[i]) * 2u; }
    }
};
struct MoeDownSched {
    typedef MoeU U;
    const char* ACT; const char* W; const int* tile; int G, c;
    __device__ __forceinline__ bool next(int i, U& u) const {
        const int nt = tile[3 * NTILE_MAX]; const int L = i * G + c; if (L >= nt * 8) return false;
        const int t = L >> 3; u.pn = L & 7; const int e = tile[t]; u.row0 = tile[NTILE_MAX + t]; u.nrows = tile[2 * NTILE_MAX + t];
        u.A = ACT + (size_t)u.row0 * 512 * 2; u.B = W + ((size_t)e * 2048 + u.pn * 256) * 512 * 2; return true;
    }
    __device__ __forceinline__ void aoffs(const U&, const int (&R)[2], const int (&C)[2], unsigned (&v)[4]) const {
#pragma unroll
        for (int h = 0; h < 2; ++h)
#pragma unroll
            for (int i = 0; i < 2; ++i) v[h * 2 + i] = (unsigned)((h * 128 + R[i]) * 512 + C[i]) * 2u;
    }
};

struct EpiIn {
    static constexpr bool PERM = true;
    unsigned char* ws;
    __device__ __forceinline__ void operator()(const f32x4 (&acc)[2][2][4][2], const DenseU& u, int wr, int wc, int fr, int fq) const {
        const int pn = u.pn; const int row0 = u.pm * 256 + wr * 64 + fr;
        if (pn == 16) {
            if (wc != 0) return;
            float* alr = (float*)(ws + RA_ALR);
#pragma unroll
            for (int ai = 0; ai < 2; ++ai)
#pragma unroll
                for (int m = 0; m < 4; ++m) { float* rp = alr + (size_t)(row0 + ai * 128 + m * 16) * 32 + 8 * fq;
                    *(f32x4*)(rp) = acc[ai][0][m][0]; *(f32x4*)(rp + 4) = acc[ai][0][m][1]; }
            return;
        }
        bf16* base; int ld, colt; bool lat_only;
        if (pn < 2) { base = (bf16*)(ws + RA_Q); ld = 512; colt = pn * 256; lat_only = true; }
        else if (pn < 4) { base = (bf16*)(ws + RA_K); ld = 512; colt = (pn - 2) * 256; lat_only = false; }
        else if (pn < 8) { base = (bf16*)(ws + RA_V); ld = 1024; colt = (pn - 4) * 256; lat_only = false; }
        else if (pn < 12) { base = (bf16*)(ws + RA_R); ld = 1024; colt = (pn - 8) * 256; lat_only = true; }
        else { base = (bf16*)(ws + RA_P); ld = 1024; colt = (pn - 12) * 256; lat_only = true; }
        if (lat_only && u.pm >= 64) return;
        const int col0 = colt + wc * 32 + 8 * fq;
#pragma unroll
        for (int ai = 0; ai < 2; ++ai)
#pragma unroll
            for (int m = 0; m < 4; ++m) { bf16* rp = base + (size_t)(row0 + ai * 128 + m * 16) * ld + col0;
#pragma unroll
                for (int bj = 0; bj < 2; ++bj) { const f32x4 v0 = acc[ai][bj][m][0], v1 = acc[ai][bj][m][1];
                    v4u o; o.x = pg8::cvt_pk_bf16(v0[0], v0[1]); o.y = pg8::cvt_pk_bf16(v0[2], v0[3]); o.z = pg8::cvt_pk_bf16(v1[0], v1[1]); o.w = pg8::cvt_pk_bf16(v1[2], v1[3]);
                    *(v4u*)(rp + bj * 128) = o; } }
    }
};
struct EpiPool {
    static constexpr bool PERM = true;
    bf16* ymix; const float* scale;
    __device__ __forceinline__ void operator()(const f32x4 (&acc)[2][2][4][2], const PoolU& u, int wr, int wc, int fr, int fq) const {
        const int row0 = u.pm * 256 + wr * 64 + fr; const int c0 = u.g * 256 + wc * 32 + 8 * fq;
#pragma unroll
        for (int ai = 0; ai < 2; ++ai)
#pragma unroll
            for (int m = 0; m < 4; ++m) { bf16* rp = ymix + (size_t)(row0 + ai * 128 + m * 16) * 2048 + 1024 + c0;
#pragma unroll
                for (int bj = 0; bj < 2; ++bj) { const f32x4 s0 = *(const f32x4*)(scale + c0 + bj * 128), s1 = *(const f32x4*)(scale + c0 + bj * 128 + 4);
                    const f32x4 v0 = acc[ai][bj][m][0] * s0, v1 = acc[ai][bj][m][1] * s1;
                    v4u o; o.x = pg8::cvt_pk_bf16(v0[0], v0[1]); o.y = pg8::cvt_pk_bf16(v0[2], v0[3]); o.z = pg8::cvt_pk_bf16(v1[0], v1[1]); o.w = pg8::cvt_pk_bf16(v1[2], v1[3]);
                    *(v4u*)(rp + bj * 128) = o; } }
    }
};
struct EpiOut {
    static constexpr bool PERM = false;
    float* y;
    __device__ __forceinline__ void operator()(const f32x4 (&acc)[2][2][4][2], const DenseU& u, int wr, int wc, int fr, int fq) const {
        const int row0 = u.pm * 256 + wr * 64 + fr, col0 = u.pn * 256 + wc * 32 + 4 * fq;
#pragma unroll
        for (int ai = 0; ai < 2; ++ai)
#pragma unroll
            for (int m = 0; m < 4; ++m) { float* rp = y + (size_t)(row0 + ai * 128 + m * 16) * 2048 + col0;
#pragma unroll
                for (int bj = 0; bj < 2; ++bj)
#pragma unroll
                    for (int n = 0; n < 2; ++n) *(f32x4*)(rp + bj * 128 + n * 16) = acc[ai][bj][m][n]; }
    }
};
struct EpiGU {
    static constexpr bool PERM = true;
    bf16* act; const float* slot_w;
    __device__ __forceinline__ void operator()(const f32x4 (&acc)[2][2][4][2], const MoeU& u, int wr, int wc, int fr, int fq) const {
        const int c0 = u.pn * 128 + wc * 32 + 8 * fq;
#pragma unroll
        for (int ai = 0; ai < 2; ++ai)
#pragma unroll
            for (int m = 0; m < 4; ++m) { const int r = ai * 128 + wr * 64 + m * 16 + fr;
                if (r < u.nrows) { const float w = slot_w[u.row0 + r]; float o[8];
#pragma unroll
                    for (int n = 0; n < 2; ++n)
#pragma unroll
                        for (int j = 0; j < 4; ++j) { const float g = acc[ai][0][m][n][j], up = acc[ai][1][m][n][j]; o[n * 4 + j] = silu_f(g) * up * w; }
                    v4u q; q.x = pg8::cvt_pk_bf16(o[0], o[1]); q.y = pg8::cvt_pk_bf16(o[2], o[3]); q.z = pg8::cvt_pk_bf16(o[4], o[5]); q.w = pg8::cvt_pk_bf16(o[6], o[7]);
                    *(v4u*)(act + (size_t)(u.row0 + r) * 512 + c0) = q; } }
    }
};
struct EpiDown {
    static constexpr bool PERM = true;
    bf16* so;
    __device__ __forceinline__ void operator()(const f32x4 (&acc)[2][2][4][2], const MoeU& u, int wr, int wc, int fr, int fq) const {
        const int c0 = u.pn * 256 + wc * 32 + 8 * fq;
#pragma unroll
        for (int ai = 0; ai < 2; ++ai)
#pragma unroll
            for (int m = 0; m < 4; ++m) { const int r = ai * 128 + wr * 64 + m * 16 + fr;
                if (r < u.nrows) { bf16* rp = so + (size_t)(u.row0 + r) * 2048 + c0;
#pragma unroll
                    for (int bj = 0; bj < 2; ++bj) { const f32x4 v0 = acc[ai][bj][m][0], v1 = acc[ai][bj][m][1];
                        v4u o; o.x = pg8::cvt_pk_bf16(v0[0], v0[1]); o.y = pg8::cvt_pk_bf16(v0[2], v0[3]); o.z = pg8::cvt_pk_bf16(v1[0], v1[1]); o.w = pg8::cvt_pk_bf16(v1[2], v1[3]);
                        *(v4u*)(rp + bj * 128) = o; } } }
    }
};

__device__ __forceinline__ void tr_item(const float* W, int ldn, bf16* WT, int Kd, int drow0, int k0, int n0, LAS float* scr, int lane) {
#pragma unroll 8
    for (int i = 0; i < 32; ++i) { const int kk = 2 * i + (lane >> 5); scr[kk * 33 + (lane & 31)] = W[(size_t)(k0 + kk) * ldn + n0 + (lane & 31)]; }
    LDS_WAIT(); asm volatile("" ::: "memory");
    const int c = lane & 7;
#pragma unroll
    for (int j = 0; j < 4; ++j) { const int n = (lane >> 3) + 8 * j; const LAS float* s = scr + (8 * c) * 33 + n;
        v4u o; o.x = pk2(s[0 * 33], s[1 * 33]); o.y = pk2(s[2 * 33], s[3 * 33]); o.z = pk2(s[4 * 33], s[5 * 33]); o.w = pk2(s[6 * 33], s[7 * 33]);
        *(v4u*)(WT + (size_t)(drow0 + n) * Kd + k0 + 8 * c) = o; }
    LDS_WAIT(); asm volatile("" ::: "memory");
}

__device__ __forceinline__ void phase0(const Args& a, LAS unsigned char* lds, int tid, int lane, int wave, int vcu, int G) {
    unsigned char* ws = a.ws;
    if (vcu < 192) {
        LAS float* sc = (LAS float*)lds;
        LAS float* red = (LAS float*)(lds + 73728);
        for (int i = tid; i < 9 * 2048; i += 512) { const int r = i >> 11, k = i & 2047; const float v = r < 8 ? a.in[1][r * 2048 + k] : a.in[3][k]; sc[i] = silu_f(v); }
        __syncthreads();
        const float* wm = a.in[4]; const float* bm = a.in[5]; float* mod = (float*)(ws + WS_MOD);
        for (int chunk = vcu; chunk < 192; chunk += G) {
            const int n0 = chunk * 64, ks = lane >> 4, n4 = (lane & 15) * 4;
            f32x4 acc[9];
#pragma unroll
            for (int r = 0; r < 9; ++r) acc[r] = (f32x4){0.f, 0.f, 0.f, 0.f};
#pragma unroll 4
            for (int kk = 0; kk < 256; kk += 4) { const int k = wave * 256 + kk + ks; const f32x4 wv = *(const f32x4*)(wm + (size_t)k * 12288 + n0 + n4);
#pragma unroll
                for (int r = 0; r < 9; ++r) { const float s = sc[r * 2048 + k]; acc[r] += wv * s; } }
#pragma unroll
            for (int r = 0; r < 9; ++r)
#pragma unroll
                for (int j = 0; j < 4; ++j) { float v = acc[r][j]; v += __shfl_xor(v, 16); v += __shfl_xor(v, 32); acc[r][j] = v; }
            if (lane < 16) {
#pragma unroll
                for (int r = 0; r < 9; ++r) *(LAS f32x4*)(red + (wave * 9 + r) * 64 + n4) = acc[r]; }
            __syncthreads();
            for (int i = tid; i < 9 * 64; i += 512) { const int r = i >> 6, n = i & 63; float s = 0.f;
#pragma unroll
                for (int w = 0; w < 8; ++w) s += red[(w * 9 + r) * 64 + n];
                mod[r * 12288 + n0 + n] = s + bm[n0 + n]; }
            __syncthreads();
        }
    }
    __syncthreads();
    LAS float* scr = (LAS float*)(lds + wave * 16384);
    const int gw = vcu * 8 + wave, NGW = G * 8;
    bf16* Win_t = (bf16*)(ws + WS_WIN); bf16* Wout_t = (bf16*)(ws + WS_WOUT); bf16* Wpool_t = (bf16*)(ws + WS_WPOOL); bf16* Wd_t = (bf16*)(ws + WS_WD); bf16* Wgu_t = (bf16*)(ws + WS_WGU);
    constexpr int I_IN = 32 * 129, I_OUT = 32 * 64, I_POOL = 4 * 4 * 8, I_E = 65 * 512;
    constexpr int NITEMS = I_IN + I_OUT + I_POOL + 3 * I_E;
    for (int it = gw; it < NITEMS; it += NGW) {
        int r = it;
        if (r < I_IN) { const int kb = r / 129, nb = r % 129, n0 = 32 * nb; const int drow = n0 < 3072 ? n0 : (n0 == 3072 ? 4096 : n0 - 32);
            tr_item(a.in[10], DIN, Win_t, 2048, drow, 64 * kb, n0, scr, lane); continue; } r -= I_IN;
        if (r < I_OUT) { const int kb = r / 64, nb = r % 64; tr_item(a.in[18], 2048, Wout_t, 2048, 32 * nb, 64 * kb, 32 * nb, scr, lane); continue; } r -= I_OUT;
        if (r < I_POOL) { const int g = r / 32, rr = r % 32, kb = rr / 8, nb = rr % 8; tr_item(a.in[16] + g * 65536, 256, Wpool_t + g * 65536, 256, 32 * nb, 64 * kb, 32 * nb, scr, lane); continue; } r -= I_POOL;
        if (r < I_E) { const int e = r / 512, rr = r % 512, kb = rr / 16, nb = rr % 16, n0 = 32 * nb; const float* src = e < 64 ? a.in[21] + (size_t)e * 2048 * 512 : a.in[24];
            tr_item(src, 512, Wgu_t + (size_t)e * 1024 * 2048, 2048, (n0 / 128) * 256 + (n0 % 128), 64 * kb, n0, scr, lane); continue; } r -= I_E;
        if (r < I_E) { const int e = r / 512, rr = r % 512, kb = rr / 16, nb = rr % 16, n0 = 32 * nb; const float* src = e < 64 ? a.in[22] + (size_t)e * 2048 * 512 : a.in[25];
            tr_item(src, 512, Wgu_t + (size_t)e * 1024 * 2048, 2048, (n0 / 128) * 256 + 128 + (n0 % 128), 64 * kb, n0, scr, lane); continue; } r -= I_E;
        { const int e = r / 512, rr = r % 512, kb = rr / 64, nb = rr % 64; const float* src = e < 64 ? a.in[23] + (size_t)e * 512 * 2048 : a.in[26];
            tr_item(src, 2048, Wd_t + (size_t)e * 2048 * 512, 512, 32 * nb, 64 * kb, 32 * nb, scr, lane); }
    }
    { v4u* z = (v4u*)(Win_t + (size_t)DIN * 2048); const int nz = (DINP - DIN) * 2048 / 8;
      for (int i = vcu * 512 + tid; i < nz; i += G * 512) z[i] = (v4u){0u, 0u, 0u, 0u}; }
}

__device__ __forceinline__ void phase1(const Args& a, int lane, int wave, int vcu, int G) {
    const float* mod = (const float*)(a.ws + WS_MOD); bf16* H = (bf16*)(a.ws + RA_H); const float* g = a.in[6];
    for (int m = vcu * 8 + wave; m < MROWS; m += G * 8) {
        const float* xr = m < NT ? a.in[0] + (size_t)m * 2048 : a.in[2] + (size_t)(m - NT) * 2048;
        const float* mr = mod + (size_t)(m < NT ? (m >> 11) : 8) * 12288;
        f32x4 v[8]; float ss = 0.f;
#pragma unroll
        for (int j = 0; j < 8; ++j) { v[j] = *(const f32x4*)(xr + 4 * (lane + 64 * j)); ss += v[j][0] * v[j][0] + v[j][1] * v[j][1] + v[j][2] * v[j][2] + v[j][3] * v[j][3]; }
        const float rstd = rsqrtf(wave_sum(ss) * (1.f / 2048.f) + EPS);
#pragma unroll
        for (int j = 0; j < 8; ++j) { const int c = 4 * (lane + 64 * j); const f32x4 gg = *(const f32x4*)(g + c), sh = *(const f32x4*)(mr + c), sc = *(const f32x4*)(mr + 2048 + c);
            const f32x4 o = v[j] * rstd * gg * (sc + 1.f) + sh;
            v2u q; q.x = pk2(o[0], o[1]); q.y = pk2(o[2], o[3]); *(v2u*)(H + (size_t)m * 2048 + c) = q; }
    }
}

__device__ __forceinline__ void phase3_gla(const Args& a, LAS unsigned char* lds, int tid, int vcu, int G) {
    unsigned char* ws = a.ws;
    const bf16* Q = (const bf16*)(ws + RA_Q); const bf16* Kb = (const bf16*)(ws + RA_K); const bf16* V = (const bf16*)(ws + RA_V); const float* ALR = (const float*)(ws + RA_ALR);
    float* OF = (float*)(ws + RA_OF);
    LAS float* al = (LAS float*)lds;
    LAS float* kk = (LAS float*)(lds + 32768);
    LAS float* qq = (LAS float*)(lds + 65536);
    LAS float* vv = (LAS float*)(lds + 98304);
    LAS float* red = (LAS float*)(lds + 114688);
    for (int item = vcu; item < 256; item += G) {
        const int vs = item & 3, dir = (item >> 2) & 1, h = (item >> 3) & 3, b = item >> 5;
        const float* wa2 = dir ? a.in[13] : a.in[11]; const float* ba = dir ? a.in[14] : a.in[12];
        const int v = tid & 63, kg = tid >> 6;
        float S[16];
#pragma unroll
        for (int j = 0; j < 16; ++j) S[j] = 0.f;
        for (int ch = 0; ch < 36; ++ch) {
            const bool lat = ch >= 4;
            { const int tl = tid >> 3, part = tid & 7; const int s = ch * 64 + tl;
              int row; if (s < 256) { const int tc = dir ? 255 - s : s; row = NT + b * 256 + tc; } else { const int t0 = s - 256; const int t = dir ? 2047 - t0 : t0; row = b * 2048 + t; }
              float ar[16];
#pragma unroll
              for (int r = 0; r < 16; ++r) ar[r] = ALR[(size_t)row * 32 + dir * 16 + r];
#pragma unroll 1
              for (int j = 0; j < 16; ++j) { const int col = h * 128 + part * 16 + j; float z = ba[col];
#pragma unroll
                  for (int r = 0; r < 16; ++r) z += ar[r] * wa2[r * 512 + col];
                  const float ls = fminf(z, 0.f) - log1pf(__expf(-fabsf(z)));
                  al[tl * 128 + part * 16 + j] = __expf(ls * (1.f / 16.f));
                  kk[tl * 128 + part * 16 + j] = bf1(Kb[(size_t)row * 512 + col]);
                  qq[tl * 128 + part * 16 + j] = lat ? bf1(Q[(size_t)row * 512 + col]) * 0.08838834764831845f : 0.f; }
#pragma unroll
              for (int j = 0; j < 8; ++j) vv[tl * 64 + part * 8 + j] = bf1(V[(size_t)row * 1024 + h * 256 + vs * 64 + part * 8 + j]); }
            __syncthreads();
            for (int sub = 0; sub < 8; ++sub) {
#pragma unroll
                for (int tt = 0; tt < 8; ++tt) { const int t = sub * 8 + tt; const float vt = vv[t * 64 + v]; float po = 0.f;
#pragma unroll
                    for (int j = 0; j < 16; ++j) { S[j] = al[t * 128 + kg * 16 + j] * S[j] + kk[t * 128 + kg * 16 + j] * vt; po += qq[t * 128 + kg * 16 + j] * S[j]; }
                    red[(tt * 8 + kg) * 64 + v] = po; }
                if (lat) {
                    __syncthreads();
                    { const int tt = tid >> 6; float o = 0.f;
#pragma unroll
                      for (int g2 = 0; g2 < 8; ++g2) o += red[(tt * 8 + g2) * 64 + v];
                      const int s = ch * 64 + sub * 8 + tt, t0 = s - 256, t = dir ? 2047 - t0 : t0;
                      OF[((size_t)dir * NT + b * 2048 + t) * 1024 + h * 256 + vs * 64 + v] = o; }
                    __syncthreads();
                }
            }
            __syncthreads();
        }
    }
}

__device__ __forceinline__ void phase3_pool(const Args& a, LAS unsigned char* lds, int tid, int vcu, int G) {
    const bf16* P = (const bf16*)(a.ws + RA_P); bf16* DP = (bf16*)(a.ws + RA_DPOOL);
    LAS float* tmp = (LAS float*)lds;
    for (int item = vcu; item < 1024; item += G) {
        const int g = item & 3, r = (item >> 2) & 31, b = item >> 7;
        const int half = 1 << g;
        const int rlo = r - half < 0 ? 0 : r - half, rhi = r + half > 32 ? 32 : r + half;
        const float rinv = 1.f / (float)(rhi - rlo);
#pragma unroll
        for (int q = 0; q < 4; ++q) { const int p = tid + 512 * q, c = p >> 5, ch0 = (p & 31) * 8; float acc[8];
#pragma unroll
            for (int j = 0; j < 8; ++j) acc[j] = 0.f;
            for (int rr = rlo; rr < rhi; ++rr) { const v4u x = *(const v4u*)(P + ((size_t)(b * 2048 + rr * 64 + c)) * 1024 + g * 256 + ch0);
                acc[0] += bflo(x.x); acc[1] += bfhi(x.x); acc[2] += bflo(x.y); acc[3] += bfhi(x.y); acc[4] += bflo(x.z); acc[5] += bfhi(x.z); acc[6] += bflo(x.w); acc[7] += bfhi(x.w); }
#pragma unroll
            for (int j = 0; j < 8; ++j) tmp[c * 256 + ch0 + j] = acc[j] * rinv; }
        __syncthreads();
#pragma unroll
        for (int q = 0; q < 4; ++q) { const int p = tid + 512 * q, c = p >> 5, ch0 = (p & 31) * 8;
            const int clo = c - half < 0 ? 0 : c - half, chi = c + half > 64 ? 64 : c + half; const float cinv = 1.f / (float)(chi - clo);
            float acc[8];
#pragma unroll
            for (int j = 0; j < 8; ++j) acc[j] = 0.f;
            for (int cc = clo; cc < chi; ++cc) {
#pragma unroll
                for (int j = 0; j < 8; ++j) acc[j] += tmp[cc * 256 + ch0 + j]; }
            const size_t o = ((size_t)(b * 2048 + r * 64 + c)) * 1024 + g * 256 + ch0;
            const v4u x = *(const v4u*)(P + o);
            v4u d; d.x = pk2(acc[0] * cinv - bflo(x.x), acc[1] * cinv - bfhi(x.x)); d.y = pk2(acc[2] * cinv - bflo(x.y), acc[3] * cinv - bfhi(x.y));
            d.z = pk2(acc[4] * cinv - bflo(x.z), acc[5] * cinv - bfhi(x.z)); d.w = pk2(acc[6] * cinv - bflo(x.w), acc[7] * cinv - bfhi(x.w));
            *(v4u*)(DP + o) = d; }
        __syncthreads();
    }
}

__device__ __forceinline__ void phase4_post(const Args& a, int lane, int wave, int vcu, int G) {
    const float* OF = (const float*)(a.ws + RA_OF); const float* OB = OF + (size_t)NT * 1024; const bf16* Rr = (const bf16*)(a.ws + RA_R); bf16* Y = (bf16*)(a.ws + RA_YMIX);
    const float* gn = a.in[15];
    for (int idx = vcu * 8 + wave; idx < NT * 4; idx += G * 8) {
        const int t = idx >> 2, h = idx & 3; const size_t o = (size_t)t * 1024 + h * 256 + 4 * lane;
        const f32x4 x = *(const f32x4*)(OF + o) + *(const f32x4*)(OB + o);
        const float ms = wave_sum(x[0] * x[0] + x[1] * x[1] + x[2] * x[2] + x[3] * x[3]) * (1.f / 256.f);
        const float sc = rsqrtf(ms + EPS);
        const f32x4 g4 = *(const f32x4*)(gn + h * 256 + 4 * lane);
        const v2u rr = *(const v2u*)(Rr + o);
        const float r0 = bflo(rr.x), r1 = bfhi(rr.x), r2 = bflo(rr.y), r3 = bfhi(rr.y);
        v2u q; q.x = pk2(x[0] * sc * g4[0] * silu_f(r0), x[1] * sc * g4[1] * silu_f(r1)); q.y = pk2(x[2] * sc * g4[2] * silu_f(r2), x[3] * sc * g4[3] * silu_f(r3));
        *(v2u*)(Y + (size_t)t * 2048 + h * 256 + 4 * lane) = q;
    }
}

__device__ __forceinline__ void phase6(const Args& a, LAS unsigned char* lds, int tid, int lane, int wave, int vcu, int G) {
    unsigned char* ws = a.ws;
    const float* mod = (const float*)(ws + WS_MOD); const float* Y1 = (const float*)(ws + RA_Y1); bf16* H2 = (bf16*)(ws + RA_H2);
    const float* gpost = a.in[7]; const float* gpre2 = a.in[8]; const float* wr = a.in[19]; const float* rbias = a.in[20];
    LAS float* hrow = (LAS float*)lds;
    LAS float* logit = (LAS float*)(lds + LDS_LOGIT);
    LAS u64* masks = (LAS u64*)(lds + LDS_MASKS);
    int* cnt = (int*)(ws + T_CNT); u64* tmask = (u64*)(ws + T_MASK); float* tokw = (float*)(ws + T_TOKW);
    for (int blk = vcu; blk < NT / 64; blk += G) {
        for (int it = 0; it < 4; ++it) {
#pragma unroll 1
            for (int rr = 0; rr < 2; ++rr) {
                const int lr = wave * 2 + rr, t = blk * 64 + it * 16 + lr; const float* mr = mod + (size_t)(t >> 11) * 12288;
                const float* yr = Y1 + (size_t)t * 2048; const float* xr = a.in[0] + (size_t)t * 2048; float* outr = a.out + (size_t)t * 2048;
                f32x4 y[8]; float ss = 0.f;
#pragma unroll
                for (int j = 0; j < 8; ++j) { y[j] = *(const f32x4*)(yr + 4 * (lane + 64 * j)); ss += y[j][0] * y[j][0] + y[j][1] * y[j][1] + y[j][2] * y[j][2] + y[j][3] * y[j][3]; }
                const float rstd1 = rsqrtf(wave_sum(ss) * (1.f / 2048.f) + EPS);
                float s2 = 0.f;
#pragma unroll
                for (int j = 0; j < 8; ++j) { const int c = 4 * (lane + 64 * j); const f32x4 x = *(const f32x4*)(xr + c), gp = *(const f32x4*)(gpost + c), gt = *(const f32x4*)(mr + 4096 + c);
                    const f32x4 x1 = x + gt * (y[j] * rstd1 * gp); y[j] = x1; *(f32x4*)(outr + c) = x1;
                    s2 += x1[0] * x1[0] + x1[1] * x1[1] + x1[2] * x1[2] + x1[3] * x1[3]; }
                const float rstd2 = rsqrtf(wave_sum(s2) * (1.f / 2048.f) + EPS);
#pragma unroll
                for (int j = 0; j < 8; ++j) { const int c = 4 * (lane + 64 * j); const f32x4 g2 = *(const f32x4*)(gpre2 + c), sh = *(const f32x4*)(mr + 6144 + c), sc = *(const f32x4*)(mr + 8192 + c);
                    const f32x4 hh = y[j] * rstd2 * g2 * (sc + 1.f) + sh;
                    *(LAS f32x4*)(hrow + lr * 2048 + c) = hh;
                    v2u q; q.x = pk2(hh[0], hh[1]); q.y = pk2(hh[2], hh[3]); *(v2u*)(H2 + (size_t)t * 2048 + c) = q; }
            }
            __syncthreads();
            { float a0 = 0.f, a1 = 0.f; const LAS float* h0 = hrow + (wave * 2) * 2048; const LAS float* h1 = h0 + 2048;
#pragma unroll 8
              for (int k = 0; k < 2048; ++k) { const float w = wr[k * 64 + lane]; a0 += h0[k] * w; a1 += h1[k] * w; }
              logit[(wave * 2) * 64 + lane] = a0; logit[(wave * 2 + 1) * 64 + lane] = a1; }
            LDS_WAIT();
#pragma unroll 1
            for (int rr = 0; rr < 2; ++rr) {
                const int lr = wave * 2 + rr, t = blk * 64 + it * 16 + lr;
                const float lg = logit[lr * 64 + lane]; const float s = 1.f / (1.f + __expf(-lg)); const float sel = s + rbias[lane];
                float m1 = sel; m1 = fmaxf(m1, __shfl_xor(m1, 1)); m1 = fmaxf(m1, __shfl_xor(m1, 2)); m1 = fmaxf(m1, __shfl_xor(m1, 4));
                const u64 eq = __ballot(sel == m1); const unsigned gb = (unsigned)(eq >> (lane & ~7)) & 0xffu; const int first = __builtin_ctz(gb);
                float v2 = ((lane & 7) == first) ? -INFINITY : sel; v2 = fmaxf(v2, __shfl_xor(v2, 1)); v2 = fmaxf(v2, __shfl_xor(v2, 2)); v2 = fmaxf(v2, __shfl_xor(v2, 4));
                const float gs = m1 + v2; const int g = lane >> 3; int grank = 0;
#pragma unroll
                for (int g2 = 0; g2 < 8; ++g2) { const float o = __shfl(gs, g2 * 8); grank += (o > gs || (o == gs && g2 < g)) ? 1 : 0; }
                const bool gsel = grank < 4; const float mk = gsel ? sel : -INFINITY; int rank = 0;
                for (int e2 = 0; e2 < 64; ++e2) { const float o = __shfl(mk, e2); rank += (o > mk || (o == mk && e2 < lane)) ? 1 : 0; }
                const bool chosen = gsel && rank < 8;
                const u64 mask = __ballot(chosen); const float ssum = wave_sum(chosen ? s : 0.f);
                const int kidx = __popcll(mask & ((1ull << lane) - 1ull));
                if (chosen) tokw[(size_t)t * 8 + kidx] = s / ssum * 2.5f;
                if (lane == 0) { tmask[t] = mask; masks[it * 16 + lr] = mask; }
            }
            __syncthreads();
        }
        if (wave == 0) { const u64 m = masks[lane]; int mine = 0;
            for (int e = 0; e < 64; ++e) { const int c = __popcll(__ballot((m >> e) & 1ull)); mine = (lane == e) ? c : mine; }
            cnt[blk * 64 + lane] = mine; }
        __syncthreads();
    }
}

__device__ __forceinline__ void phase7(const Args& a, LAS unsigned char* lds, int tid, int lane, int wave, int vcu, int G) {
    unsigned char* ws = a.ws;
    const int* cnt = (const int*)(ws + T_CNT); const u64* tmask = (const u64*)(ws + T_MASK); const float* tokw = (const float*)(ws + T_TOKW);
    int* tokslot = (int*)(ws + T_TOKSLOT); int* slottok = (int*)(ws + T_SLOTTOK); float* slotw = (float*)(ws + T_SLOTW); int* tile = (int*)(ws + T_TILE);
    LAS int* part = (LAS int*)lds;
    LAS int* tot = (LAS int*)(lds + 4096);
    for (int blk = vcu; blk < NT / 64; blk += G) {
        int pre = 0, all = 0;
        for (int b2 = wave; b2 < 256; b2 += 8) { const int c = cnt[b2 * 64 + lane]; all += c; pre += (b2 < blk) ? c : 0; }
        part[(wave * 2) * 64 + lane] = pre; part[(wave * 2 + 1) * 64 + lane] = all;
        __syncthreads();
        if (wave == 0) {
            int p = 0, t = 0;
#pragma unroll
            for (int w = 0; w < 8; ++w) { p += part[(w * 2) * 64 + lane]; t += part[(w * 2 + 1) * 64 + lane]; }
            int incl = t;
#pragma unroll
            for (int o = 1; o < 64; o <<= 1) { const int v = __shfl_up(incl, o); if (lane >= o) incl += v; }
            const int start = incl - t; const int base = start + p;
            tot[lane] = t; tot[64 + lane] = start;
            const int tokn = blk * 64 + lane; const u64 m = tmask[tokn];
            for (int e = 0; e < 64; ++e) { const bool bit = (m >> e) & 1ull; const u64 bal = __ballot(bit); const int be = __shfl(base, e);
                if (bit) { const int rank = __popcll(bal & ((1ull << lane) - 1ull)); const int slot = be + rank; const int k = __popcll(m & ((1ull << e) - 1ull));
                    slottok[slot] = tokn; slotw[slot] = tokw[(size_t)tokn * 8 + k]; tokslot[(size_t)tokn * 8 + k] = slot; } }
            slottok[SH_ROW0 + tokn] = tokn; slotw[SH_ROW0 + tokn] = 1.f;
        }
        __syncthreads();
        if (blk == 0 && tid == 0) {
            int n = 0;
            for (int e = 0; e < 64; ++e) { const int te = tot[e], st = tot[64 + e];
                for (int j = 0; j * 256 < te; ++j) { tile[n] = e; tile[NTILE_MAX + n] = st + j * 256; tile[2 * NTILE_MAX + n] = (te - j * 256) < 256 ? (te - j * 256) : 256; ++n; } }
            for (int j = 0; j < 64; ++j) { tile[n] = 64; tile[NTILE_MAX + n] = SH_ROW0 + j * 256; tile[2 * NTILE_MAX + n] = 256; ++n; }
            tile[3 * NTILE_MAX] = n;
        }
        __syncthreads();
    }
}

__device__ __forceinline__ void phase10(const Args& a, int lane, int wave, int vcu, int G) {
    unsigned char* ws = a.ws;
    const float* mod = (const float*)(ws + WS_MOD); const bf16* SO = (const bf16*)(ws + WS_SLOTOUT); const int* tokslot = (const int*)(ws + T_TOKSLOT); const float* gp = a.in[9];
    for (int t = vcu * 8 + wave; t < NT; t += G * 8) {
        const float* mr = mod + (size_t)(t >> 11) * 12288;
        float y[4][8];
#pragma unroll
        for (int j = 0; j < 4; ++j)
#pragma unroll
            for (int q = 0; q < 8; ++q) y[j][q] = 0.f;
#pragma unroll 1
        for (int k = 0; k < 9; ++k) { const int slot = k < 8 ? tokslot[(size_t)t * 8 + k] : SH_ROW0 + t; const bf16* sr = SO + (size_t)slot * 2048;
#pragma unroll
            for (int j = 0; j < 4; ++j) { const v4u x = *(const v4u*)(sr + 8 * (lane + 64 * j));
                y[j][0] += bflo(x.x); y[j][1] += bfhi(x.x); y[j][2] += bflo(x.y); y[j][3] += bfhi(x.y); y[j][4] += bflo(x.z); y[j][5] += bfhi(x.z); y[j][6] += bflo(x.w); y[j][7] += bfhi(x.w); } }
        float ss = 0.f;
#pragma unroll
        for (int j = 0; j < 4; ++j)
#pragma unroll
            for (int q = 0; q < 8; ++q) ss += y[j][q] * y[j][q];
        const float rstd = rsqrtf(wave_sum(ss) * (1.f / 2048.f) + EPS);
        float* outr = a.out + (size_t)t * 2048;
#pragma unroll
        for (int j = 0; j < 4; ++j)
#pragma unroll
            for (int hh = 0; hh < 2; ++hh) { const int c = 8 * (lane + 64 * j) + 4 * hh; const f32x4 x1 = *(const f32x4*)(outr + c), g = *(const f32x4*)(gp + c), gt = *(const f32x4*)(mr + 10240 + c);
                f32x4 yy; yy[0] = y[j][4 * hh]; yy[1] = y[j][4 * hh + 1]; yy[2] = y[j][4 * hh + 2]; yy[3] = y[j][4 * hh + 3];
                *(f32x4*)(outr + c) = x1 + gt * (yy * rstd * g); }
    }
}

__global__ void __launch_bounds__(512, 2) fwd(Args args) {
    extern __shared__ __attribute__((aligned(16))) unsigned char lds_raw[];
    LAS unsigned char* lds = (LAS unsigned char*)lds_raw;
    const int tid = threadIdx.x, lane = tid & 63, wave = __builtin_amdgcn_readfirstlane(tid >> 6);
    const int G = gridDim.x, bx = blockIdx.x;
    const int vcu = (G % 8 == 0) ? (bx % 8) * (G / 8) + bx / 8 : bx;
    unsigned char* ws = args.ws;
    volatile LAS unsigned* MISC = (volatile LAS unsigned*)(lds + LDS_MISC);
    if (tid < 64) MISC[tid] = 0u;
    __syncthreads();
    const int lo = args.ph_lo, hi = args.ph_hi;
    XcdBarrier bar; bar.bar = (unsigned*)(ws + WS_CTL) + 4096; bar.x = 0; bar.st = nullptr;
    if (hi - lo > 1) bar = xcd_barrier_post((unsigned*)(ws + WS_CTL) + 4096, MISC + 8);
#ifndef PH_MASK
#define PH_MASK 0x7ff
#endif
#define IN(k) (((PH_MASK >> (k)) & 1) && lo <= (k) && (k) < hi)
#define SEAM(k) do { if (IN(k) && IN((k) + 1)) xcd_barrier(bar); } while (0)

    if (IN(0)) { phase0(args, lds, tid, lane, wave, vcu, G); SEAM(0); }
    if (IN(1)) { phase1(args, lane, wave, vcu, G); SEAM(1); }
    if (IN(2)) {
        DenseSched S; S.init(ws + RA_H, ws + WS_WIN, 2048, 2048, MROWS, DINP, G, bx);
        EpiIn E{ws};
        pg8::gemm_phase<EpiIn, DenseSched>(lds, 2048, S, E);
        SEAM(2);
    }
    if (IN(3)) { phase3_gla(args, lds, tid, vcu, G); __syncthreads(); phase3_pool(args, lds, tid, vcu, G); SEAM(3); }
    if (IN(4)) {
        phase4_post(args, lane, wave, vcu, G);
        PoolSched S{(const char*)(ws + RA_DPOOL), (const char*)(ws + WS_WPOOL), G, vcu};
        EpiPool E{(bf16*)(ws + RA_YMIX), args.in[17]};
        int kpool = 256; asm volatile("" : "+s"(kpool));
        pg8::gemm_phase<EpiPool, PoolSched>(lds, kpool, S, E);
        SEAM(4);
    }
    if (IN(5)) {
        DenseSched S; S.init(ws + RA_YMIX, ws + WS_WOUT, 2048, 2048, NT, 2048, G, bx);
        EpiOut E{(float*)(ws + RA_Y1)};
        pg8::gemm_phase<EpiOut, DenseSched>(lds, 2048, S, E);
        SEAM(5);
    }
    if (IN(6)) { phase6(args, lds, tid, lane, wave, vcu, G); SEAM(6); }
    if (IN(7)) { phase7(args, lds, tid, lane, wave, vcu, G); SEAM(7); }
    if (IN(8)) {
        MoeGUSched S{(const char*)(ws + RA_H2), (const char*)(ws + WS_WGU), (const int*)(ws + T_TILE), (const int*)(ws + T_SLOTTOK), G, vcu};
        EpiGU E{(bf16*)(ws + WS_ACT), (const float*)(ws + T_SLOTW)};
        pg8::gemm_phase<EpiGU, MoeGUSched>(lds, 2048, S, E);
        SEAM(8);
    }
    if (IN(9)) {
        MoeDownSched S{(const char*)(ws + WS_ACT), (const char*)(ws + WS_WD), (const int*)(ws + T_TILE), G, vcu};
        EpiDown E{(bf16*)(ws + WS_SLOTOUT)};
        pg8::gemm_phase<EpiDown, MoeDownSched>(lds, 512, S, E);
        SEAM(9);
    }
    if (IN(10)) { phase10(args, lane, wave, vcu, G); }
#undef IN
#undef SEAM
}

extern "C" void kernel_launch(void* const* d_in, const int* in_sizes, int n_in, void* d_out, int out_size, void* d_ws, size_t ws_size, hipStream_t stream) {
    static int grid = 0;
    if (grid == 0) {
        if (n_in != 27 || out_size != NT * DM || ws_size < WS_NEED) { fprintf(stderr, "kernel_launch: unexpected problem: n_in %d out %d ws %zu (need %zu)\n", n_in, out_size, ws_size, (size_t)WS_NEED); grid = -1; return; }
        int dev = 0, cus = 0, per_cu = 0;
        if (hipGetDevice(&dev) != hipSuccess || hipDeviceGetAttribute(&cus, hipDeviceAttributeMultiprocessorCount, dev) != hipSuccess) { grid = -1; return; }
        if (hipFuncSetAttribute((const void*)fwd, hipFuncAttributeMaxDynamicSharedMemorySize, LDS_BYTES) != hipSuccess) { fprintf(stderr, "kernel_launch: hipFuncSetAttribute failed\n"); grid = -1; return; }
        if (hipOccupancyMaxActiveBlocksPerMultiprocessor(&per_cu, (const void*)fwd, 512, LDS_BYTES) != hipSuccess || per_cu < 1) { fprintf(stderr, "kernel_launch: occupancy query says %d\n", per_cu); }
        (void)hipGetLastError();
        grid = cus;
    }
    if (grid < 0) return;
    (void)hipMemsetAsync((char*)d_ws + WS_CTL, 0, CTL_ZERO_BYTES, stream);
    Args a{};
    for (int i = 0; i < 27; ++i) a.in[i] = (const float*)d_in[i];
    a.out = (float*)d_out; a.ws = (unsigned char*)d_ws;
    if (N_LAUNCHES == 1) {
        a.ph_lo = 0; a.ph_hi = NPH;
        hipLaunchKernelGGL(fwd, dim3(grid), dim3(512), LDS_BYTES, stream, a);
    } else {
        for (int p = 0; p < NPH; ++p) { a.ph_lo = p; a.ph_hi = p + 1; hipLaunchKernelGGL(fwd, dim3(grid), dim3(512), LDS_BYTES, stream, a); }
    }
}
```

```cpp
#include <hip/hip_runtime.h>
#include <cstdio>
#include <cstdint>

#ifndef N_LAUNCHES
#define N_LAUNCHES 1
#endif

#define GAS __attribute__((address_space(1)))
#define LAS __attribute__((address_space(3)))
typedef unsigned short bf16;
typedef unsigned v4u __attribute__((ext_vector_type(4)));
typedef unsigned v2u __attribute__((ext_vector_type(2)));
typedef float f32x4 __attribute__((ext_vector_type(4)));
typedef short bf16x8 __attribute__((ext_vector_type(8)));
typedef unsigned long long u64;

constexpr int NB = 8, SEQ = 2048, DM = 2048, CTXL = 256;
constexpr int NT = NB * SEQ;
constexpr int NTC = NB * CTXL;
constexpr int MROWS = NT + NTC;
constexpr int DIN = 4128, DINP = 4352;
constexpr int NE = 64, TOPK = 8, DE = 512;
constexpr int NSLOT_E = NT * TOPK;
constexpr int SH_ROW0 = NSLOT_E + 256;
constexpr int NSLOT = SH_ROW0 + NT;
constexpr int NTILE_MAX = 704;
constexpr float EPS = 1e-6f;
constexpr int NPH = 12;

constexpr size_t MiB = 1u << 20;
constexpr size_t WS_CTL = 0, CTL_ZERO_BYTES = 64 * 1024;
constexpr size_t WS_MOD = 1 * MiB;
constexpr size_t WS_TAB = 1 * MiB + 512 * 1024;
constexpr size_t WS_WIN = 2 * MiB;
constexpr size_t WS_WOUT = WS_WIN + 17 * MiB;
constexpr size_t WS_WPOOL = WS_WOUT + 8 * MiB;
constexpr size_t WS_WD = WS_WPOOL + 1 * MiB;
constexpr size_t WS_WGU = WS_WD + 130 * MiB;
constexpr size_t WS_RA = WS_WGU + 260 * MiB;
constexpr size_t RA_H = WS_RA;
constexpr size_t RA_OF = WS_RA;
constexpr size_t RA_H2 = WS_RA;
constexpr size_t RA_Q = WS_RA + 128 * MiB;
constexpr size_t RA_K = RA_Q + 16 * MiB;
constexpr size_t RA_V = RA_K + 18 * MiB;
constexpr size_t RA_R = RA_V + 36 * MiB;
constexpr size_t RA_P = RA_R + 32 * MiB;
constexpr size_t RA_ALR = RA_P + 32 * MiB;
constexpr size_t RA_DPOOL = RA_ALR + 3 * MiB;
constexpr size_t RA_YMIX = RA_DPOOL + 32 * MiB;
constexpr size_t RA_Y1 = WS_RA + 128 * MiB;
constexpr size_t RA_END = RA_YMIX + 64 * MiB;
constexpr size_t WS_SLOTOUT = WS_WGU;
constexpr size_t WS_ACT = RA_END > WS_SLOTOUT + 578 * MiB ? RA_END : WS_SLOTOUT + 578 * MiB;
constexpr size_t WS_END = WS_ACT + 145 * MiB;
constexpr size_t PQG = WS_ACT;
constexpr size_t PQM = WS_ACT + 32 * MiB;
constexpr size_t PKM = WS_ACT + 64 * MiB;
constexpr size_t PKD = WS_ACT + 96 * MiB;
constexpr size_t PDEC = WS_ACT + 132 * MiB;
constexpr size_t WS_T0 = WS_END;
constexpr size_t T_CNT = WS_T0;
constexpr size_t T_MASK = T_CNT + 65536;
constexpr size_t T_TOKW = T_MASK + 131072;
constexpr size_t T_TOKSLOT = T_TOKW + 524288;
constexpr size_t T_SLOTTOK = T_TOKSLOT + 524288;
constexpr size_t T_SLOTW = T_SLOTTOK + 655360;
constexpr size_t T_TILE = T_SLOTW + 655360;
constexpr size_t WS_NEED = T_TILE + 16384;

constexpr int RING_BYTES = 131072;
constexpr int LDS_MISC = RING_BYTES;
constexpr int LDS_LOGIT = RING_BYTES + 256;
constexpr int LDS_MASKS = LDS_LOGIT + 4096;
constexpr int LDS_BYTES = 147456;

#define LDS_WAIT() asm volatile("s_waitcnt lgkmcnt(0)" ::: "memory")
#define VM_WAIT() asm volatile("s_waitcnt vmcnt(0)" ::: "memory")

__device__ __forceinline__ unsigned f2bf(float f) { unsigned u = __builtin_bit_cast(unsigned, f); return (u + 0x7fffu + ((u >> 16) & 1u)) >> 16; }
__device__ __forceinline__ unsigned pk2(float lo, float hi) { return f2bf(lo) | (f2bf(hi) << 16); }
__device__ __forceinline__ float bflo(unsigned u) { return __builtin_bit_cast(float, u << 16); }
__device__ __forceinline__ float bfhi(unsigned u) { return __builtin_bit_cast(float, u & 0xffff0000u); }
__device__ __forceinline__ float bf1(bf16 b) { return __builtin_bit_cast(float, ((unsigned)b) << 16); }
__device__ __forceinline__ float wave_sum(float v) {
#pragma unroll
    for (int o = 1; o < 64; o <<= 1) v += __shfl_xor(v, o);
    return v;
}
__device__ __forceinline__ float silu_f(float x) { return x / (1.f + __expf(-x)); }

#define XB_TMO      128
#define XB_XCNT(j)  (256  + 64 * (j))
#define XB_XSUB(j)  (1280 + 64 * (j))
#define XB_XGEN(j)  (2304 + 64 * (j))
#define XB_TOP      3328
#define XB_TOPGEN   3392
#define XCD_BAR_WORDS 3456
#define XB_SPIN_CAP (1u << 18)

__device__ __forceinline__ unsigned xb_ld(unsigned* p)              { return __hip_atomic_load(p, __ATOMIC_RELAXED, __HIP_MEMORY_SCOPE_AGENT); }
__device__ __forceinline__ unsigned xb_add(unsigned* p, unsigned v) { return __hip_atomic_fetch_add(p, v, __ATOMIC_RELAXED, __HIP_MEMORY_SCOPE_AGENT); }
__device__ __forceinline__ unsigned xb_xcc_id() { return (unsigned)__builtin_amdgcn_s_getreg((3 << 11) | 20) & 0xFu; }
#define XB_SPIN(cond, bar) do { unsigned _sp = 0; while (cond) { __builtin_amdgcn_s_sleep(1); \
    if ((++_sp & 255u) == 0u) { if (xb_ld(&(bar)[XB_TMO])) break; if (_sp > XB_SPIN_CAP) { atomicAdd(&(bar)[XB_TMO], 1u); break; } } } } while (0)

struct XcdBarrier { unsigned* bar; unsigned x; volatile LAS unsigned* st; };

__device__ __forceinline__ XcdBarrier xcd_barrier_post(unsigned* bar, volatile LAS unsigned* st) {
    XcdBarrier b; b.bar = bar; b.x = xb_xcc_id(); b.st = st;
    if (threadIdx.x == 0) (void)xb_add(&bar[XB_XCNT(b.x)], 1u);
    return b;
}
__device__ __forceinline__ void xcd_barrier_complete(unsigned* bar, unsigned x, unsigned& nloc, unsigned& nx) {
    const unsigned G = gridDim.x * gridDim.y * gridDim.z;
    unsigned sum, cnt, mine, sp = 0u;
    for (;;) {
        sum = 0u; cnt = 0u; mine = 0u;
#pragma unroll
        for (unsigned j = 0; j < 16; ++j) { const unsigned c = xb_ld(&bar[XB_XCNT(j)]); sum += c; cnt += (c > 0u) ? 1u : 0u; mine = (j == x) ? c : mine; }
        if (sum == G) break;
        __builtin_amdgcn_s_sleep(1);
        if ((++sp & 255u) == 0u) { if (xb_ld(&bar[XB_TMO])) break; if (sp > XB_SPIN_CAP) { atomicAdd(&bar[XB_TMO], 1u); break; } }
    }
    nloc = mine > 0u ? mine : 1u; nx = cnt > 0u ? cnt : 1u;
}
__device__ __forceinline__ void xcd_barrier(const XcdBarrier& b) {
    asm volatile("s_waitcnt vmcnt(0)" ::: "memory");
    __syncthreads();
    if (threadIdx.x == 0) {
        unsigned* bar = b.bar;
        __builtin_amdgcn_s_waitcnt(0);
        unsigned nloc = b.st[0], nx = b.st[1];
        if (nloc == 0u) { xcd_barrier_complete(bar, b.x, nloc, nx); b.st[0] = nloc; b.st[1] = nx; }
        const unsigned old = xb_add(&bar[XB_XSUB(b.x)], 1u);
        const unsigned gen = old / nloc;
        if (old + 1u == (gen + 1u) * nloc) {
            __builtin_amdgcn_fence(__ATOMIC_RELEASE, "agent");
            asm volatile("s_waitcnt vmcnt(0)" ::: "memory");
            const unsigned og = xb_add(&bar[XB_TOP], 1u);
            const unsigned tg = og / nx;
            if (og + 1u == (tg + 1u) * nx) xb_add(&bar[XB_TOPGEN], 1u);
            else XB_SPIN(xb_ld(&bar[XB_TOPGEN]) == tg, bar);
            __builtin_amdgcn_fence(__ATOMIC_ACQUIRE, "agent");
            xb_add(&bar[XB_XGEN(b.x)], 1u);
            asm volatile("s_waitcnt vmcnt(0)" ::: "memory");
        } else {
            XB_SPIN(xb_ld(&bar[XB_XGEN(b.x)]) == gen, bar);
            __builtin_amdgcn_fence(__ATOMIC_ACQUIRE, "agent");
            asm volatile("s_waitcnt vmcnt(0)" ::: "memory");
        }
    }
    __syncthreads();
}

namespace pg8 {
constexpr int BM = 256, BK = 64, HALF = 128, HTB = HALF * BK * 2, STAGE_BYTES = 8 * HTB, NXCD = 8, WGM = 8;
__device__ __forceinline__ int lds_byte(int r, int c) { const int st = (r >> 4) * 2 + (c >> 5), rr = r & 15, cc = c & 31, ob = rr * 64 + cc * 2; return st * 1024 + (ob ^ (((ob >> 9) & 1) << 5)); }
__device__ __forceinline__ void stage_rc(int b, int& R, int& C) { const int st = b / 1024, sb = b % 1024, swz = sb ^ (((sb >> 9) & 1) << 5); R = (st >> 1) * 16 + swz / 64; C = (st & 1) * 32 + (swz % 64) / 2; }
__device__ __forceinline__ int perm32(int rho) { const int n = rho >> 4, i = rho & 15; return 8 * (i >> 2) + 4 * n + (i & 3); }
__device__ __forceinline__ unsigned cvt_pk_bf16(float lo, float hi) { unsigned r; asm volatile("v_cvt_pk_bf16_f32 %0, %1, %2" : "=v"(r) : "v"(lo), "v"(hi)); return r; }

template <class Epi, class Sched>
__device__ __forceinline__ void gemm_phase(LAS unsigned char* lds, const int K, const Sched& S, const Epi& E) {
    typedef typename Sched::U Unit;
    const int tid = threadIdx.x, wid = __builtin_amdgcn_readfirstlane(tid >> 6), lane = tid & 63, wr = wid >> 2, wc = wid & 3, fr = lane & 15, fq = lane >> 4;
    const int nt = K / BK;
    int R[2], C[2]; unsigned voffB[2];
#pragma unroll
    for (int i = 0; i < 2; ++i) { stage_rc(tid * 16 + i * 8192, R[i], C[i]); const int Rb = Epi::PERM ? ((R[i] & ~31) + perm32(R[i] & 31)) : R[i];
        voffB[i] = (unsigned)(Rb * K + C[i]) * 2u; }
    const size_t kstep = (size_t)(BK * 2);
    const size_t hstepB = (size_t)HALF * K * 2;
    const unsigned ldsw = (unsigned)wid * 1024u;
    const int aoff = lds_byte(wr * 64 + fr, fq * 8), boff = lds_byte(wc * 32 + fr, fq * 8);
#define PG8_SA(b, h) (((b) * 2 + (h)) * HTB)
#define PG8_SB(b, h) ((4 + (b) * 2 + (h)) * HTB)
#define PG8_STAGE(bufoff, gbase, v0, v1) do { \
        __builtin_amdgcn_global_load_lds((const unsigned*)((const char*)(gbase) + (v0)), (LAS unsigned*)(lds + (bufoff) + ldsw), 16, 0, 0); \
        __builtin_amdgcn_global_load_lds((const unsigned*)((const char*)(gbase) + (v1)), (LAS unsigned*)(lds + (bufoff) + ldsw + 8192), 16, 0, 0); } while (0)
#define PG8_LDA(dst, b, h) do { _Pragma("unroll") for (int m = 0; m < 4; ++m) _Pragma("unroll") for (int k = 0; k < 2; ++k) dst[m][k] = *(const LAS bf16x8*)(lds + PG8_SA(b, h) + aoff + m * 2048 + k * 1024); } while (0)
#define PG8_LDB(dst, b, h) do { _Pragma("unroll") for (int n = 0; n < 2; ++n) _Pragma("unroll") for (int k = 0; k < 2; ++k) dst[n][k] = *(const LAS bf16x8*)(lds + PG8_SB(b, h) + boff + n * 2048 + k * 1024); } while (0)
#define PG8_MMA(ai, bj, At, Bt) do { __builtin_amdgcn_s_setprio(1); _Pragma("unroll") for (int m = 0; m < 4; ++m) _Pragma("unroll") for (int n = 0; n < 2; ++n) _Pragma("unroll") for (int k = 0; k < 2; ++k) \
        acc[ai][bj][m][n] = __builtin_amdgcn_mfma_f32_16x16x32_bf16(Bt[n][k], At[m][k], acc[ai][bj][m][n], 0, 0, 0); __builtin_amdgcn_s_setprio(0); } while (0)
#define PG8_WAIT_V(n) asm volatile("s_waitcnt vmcnt(" #n ")" ::: "memory")
#define PG8_WAIT_L(n) asm volatile("s_waitcnt lgkmcnt(" #n ")" ::: "memory")
#define PG8_BAR __builtin_amdgcn_s_barrier()
#define PG8_SCHED __builtin_amdgcn_sched_barrier(0)
    Unit cur, nxt; int ui = 0;
    if (!S.next(0, cur)) return;
    f32x4 acc[2][2][4][2];
#pragma unroll
    for (int a = 0; a < 2; ++a)
#pragma unroll
        for (int b = 0; b < 2; ++b)
#pragma unroll
            for (int m = 0; m < 4; ++m)
#pragma unroll
                for (int n = 0; n < 2; ++n) acc[a][b][m][n] = (f32x4){0.f, 0.f, 0.f, 0.f};
    bf16x8 At[4][2], B0[2][2], B1[2][2];
    unsigned vA[4], vN[4];
    S.aoffs(cur, R, C, vA);
    const char* cA = cur.A; const char* cB = cur.B;
    PG8_STAGE(PG8_SB(0, 0), cB, voffB[0], voffB[1]); PG8_STAGE(PG8_SB(0, 1), cB + hstepB, voffB[0], voffB[1]); PG8_STAGE(PG8_SA(0, 0), cA, vA[0], vA[1]); PG8_STAGE(PG8_SA(0, 1), cA, vA[2], vA[3]);
    if (wr == 1) PG8_BAR;
    PG8_WAIT_V(2); PG8_BAR;
    PG8_STAGE(PG8_SB(1, 0), cB + kstep, voffB[0], voffB[1]); PG8_STAGE(PG8_SA(1, 0), cA + kstep, vA[0], vA[1]); PG8_STAGE(PG8_SB(1, 1), cB + hstepB + kstep, voffB[0], voffB[1]);
    PG8_WAIT_V(6); PG8_BAR;
    for (;;) {
        const bool has_next = S.next(ui + 1, nxt);
        const char* nA = has_next ? nxt.A : cA; const char* nB = has_next ? nxt.B : cB;
        if (has_next) S.aoffs(nxt, R, C, vN); else { vN[0] = vA[0]; vN[1] = vA[1]; vN[2] = vA[2]; vN[3] = vA[3]; }
        for (int t = 0; t < nt; t += 2) {
            const bool last = (t == nt - 2);
            const char* a1 = cA + (size_t)(t + 1) * kstep;
            const char* a2 = last ? nA : cA + (size_t)(t + 2) * kstep; const char* b2 = last ? nB : cB + (size_t)(t + 2) * kstep;
            const char* a3 = a2 + kstep; const char* b3 = b2 + kstep;
            const unsigned x0 = last ? vN[0] : vA[0], x1 = last ? vN[1] : vA[1], x2 = last ? vN[2] : vA[2], x3 = last ? vN[3] : vA[3];
            PG8_LDB(B0, 0, 0); PG8_LDB(B1, 0, 1); PG8_SCHED; PG8_LDA(At, 0, 0); PG8_STAGE(PG8_SA(1, 1), a1, vA[2], vA[3]);
            PG8_WAIT_V(8); PG8_WAIT_L(0); PG8_BAR; PG8_MMA(0, 0, At, B0); PG8_MMA(0, 1, At, B1); PG8_BAR; PG8_SCHED;
            PG8_LDA(At, 0, 1); PG8_STAGE(PG8_SB(0, 0), b2, voffB[0], voffB[1]); PG8_STAGE(PG8_SB(0, 1), b2 + hstepB, voffB[0], voffB[1]); PG8_STAGE(PG8_SA(0, 0), a2, x0, x1);
            PG8_WAIT_V(8); PG8_WAIT_L(0); PG8_BAR; PG8_MMA(1, 0, At, B0); PG8_MMA(1, 1, At, B1); PG8_BAR; PG8_SCHED;
            PG8_LDB(B0, 1, 0); PG8_LDB(B1, 1, 1); PG8_SCHED; PG8_LDA(At, 1, 0); PG8_STAGE(PG8_SA(0, 1), a2, x2, x3);
            PG8_WAIT_V(8); PG8_WAIT_L(0); PG8_BAR; PG8_MMA(0, 0, At, B0); PG8_MMA(0, 1, At, B1); PG8_BAR; PG8_SCHED;
            PG8_LDA(At, 1, 1); PG8_STAGE(PG8_SB(1, 0), b3, voffB[0], voffB[1]); PG8_STAGE(PG8_SB(1, 1), b3 + hstepB, voffB[0], voffB[1]); PG8_STAGE(PG8_SA(1, 0), a3, x0, x1);
            PG8_WAIT_V(8); PG8_WAIT_L(0); PG8_BAR; PG8_MMA(1, 0, At, B0); PG8_MMA(1, 1, At, B1); PG8_BAR; PG8_SCHED;
        }
        if (wr == 0) PG8_BAR;
        E(acc, cur, wr, wc, fr, fq);
        if (!has_next) break;
#pragma unroll
        for (int a = 0; a < 2; ++a)
#pragma unroll
            for (int b = 0; b < 2; ++b)
#pragma unroll
                for (int m = 0; m < 4; ++m)
#pragma unroll
                    for (int n = 0; n < 2; ++n) acc[a][b][m][n] = (f32x4){0.f, 0.f, 0.f, 0.f};
        cur = nxt; cA = nA; cB = nB; ++ui;
        vA[0] = vN[0]; vA[1] = vN[1]; vA[2] = vN[2]; vA[3] = vN[3];
        if (wr == 1) PG8_BAR;
    }
    PG8_WAIT_V(0);
    PG8_BAR;
#undef PG8_SA
#undef PG8_SB
#undef PG8_STAGE
#undef PG8_LDA
#undef PG8_LDB
#undef PG8_MMA
#undef PG8_WAIT_V
#undef PG8_WAIT_L
#undef PG8_BAR
#undef PG8_SCHED
}
}

struct Args { const float* in[27]; float* out; unsigned char* ws; int ph_lo, ph_hi; };
static_assert(sizeof(Args) == 27 * 8 + 8 + 8 + 8, "Args has no padding");

struct DenseU { const char* A; const char* B; int pm, pn; };
struct DenseSched {
    typedef DenseU U;
    const char* A; const char* B; int lda, K, nM, nN, nwg, G, c;
    __device__ __forceinline__ void init(const void* A_, const void* B_, int lda_, int K_, int M, int N, int G_, int c_) { A = (const char*)A_; B = (const char*)B_; lda = lda_; K = K_; nM = M / 256; nN = N / 256; nwg = nM * nN; G = G_; c = c_; }
    __device__ __forceinline__ bool next(int i, U& u) const {
        const long L = (long)i * G + c; if (L >= nwg) return false;
        int wgid = (int)L; { const int q = nwg / 8, r = nwg % 8, xcd = wgid % 8, off = wgid / 8; wgid = (xcd < r ? xcd * (q + 1) : r * (q + 1) + (xcd - r) * q) + off; }
        const int nig = 8 * nN, gid = wgid / nig, fm = gid * 8, gsz = (nM - fm) < 8 ? (nM - fm) : 8;
        u.pm = fm + ((wgid % nig) % gsz); u.pn = (wgid % nig) / gsz;
        u.A = A + (size_t)u.pm * 256 * lda * 2; u.B = B + (size_t)u.pn * 256 * K * 2; return true;
    }
    __device__ __forceinline__ void aoffs(const U&, const int (&R)[2], const int (&C)[2], unsigned (&v)[4]) const {
#pragma unroll
        for (int h = 0; h < 2; ++h)
#pragma unroll
            for (int i = 0; i < 2; ++i) v[h * 2 + i] = (unsigned)((h * 128 + R[i]) * lda + C[i]) * 2u;
    }
};
struct PoolU { const char* A; const char* B; int pm, g; };
struct PoolSched {
    typedef PoolU U;
    const char* A; const char* B; int G, c;
    __device__ __forceinline__ bool next(int i, U& u) const {
        const int L = i * G + c; if (L >= 256) return false;
        u.g = L & 3; u.pm = L >> 2;
        u.A = A + ((size_t)u.pm * 256 * 1024 + u.g * 256) * 2; u.B = B + (size_t)u.g * 256 * 256 * 2; return true;
    }
    __device__ __forceinline__ void aoffs(const U&, const int (&R)[2], const int (&C)[2], unsigned (&v)[4]) const {
#pragma unroll
        for (int h = 0; h < 2; ++h)
#pragma unroll
            for (int i = 0; i < 2; ++i) v[h * 2 + i] = (unsigned)((h * 128 + R[i]) * 1024 + C[i]) * 2u;
    }
};
struct MoeU { const char* A; const char* B; int row0, nrows, pn; };
struct MoeGUSched {
    typedef MoeU U;
    const char* H2; const char* W; const int* tile; const int* slot_tok; int G, c;
    __device__ __forceinline__ bool next(int i, U& u) const {
        const int nt = tile[3 * NTILE_MAX]; const int L = i * G + c; if (L >= nt * 4) return false;
        const int t = L >> 2; u.pn = L & 3; const int e = tile[t]; u.row0 = tile[NTILE_MAX + t]; u.nrows = tile[2 * NTILE_MAX + t];
        u.A = H2; u.B = W + ((size_t)e * 1024 + u.pn * 256) * 2048 * 2; return true;
    }
    __device__ __forceinline__ void aoffs(const U& u, const int (&R)[2], const int (&C)[2], unsigned (&v)[4]) const {
#pragma unroll
        for (int h = 0; h < 2; ++h)
#pragma unroll
            for (int i = 0; i < 2; ++i) { int r = h * 128 + R[i]; r = r < u.nrows ? r : u.nrows - 1; const int tok = slot_tok[u.row0 + r]; v[h * 2 + i] = (unsigned)(tok * 2048 + C[i]) * 2u; }
    }
};
struct MoeDownSched {
    typedef MoeU U;
    const char* ACT; const char* W; const int* tile; int G, c;
    __device__ __forceinline__ bool next(int i, U& u) const {
        const int nt = tile[3 * NTILE_MAX]; const int L = i * G + c; if (L >= nt * 8) return false;
        const int t = L >> 3; u.pn = L & 7; const int e = tile[t]; u.row0 = tile[NTILE_MAX + t]; u.nrows = tile[2 * NTILE_MAX + t];
        u.A = ACT + (size_t)u.row0 * 512 * 2; u.B = W + ((size_t)e * 2048 + u.pn * 256) * 512 * 2; return true;
    }
    __device__ __forceinline__ void aoffs(const U&, const int (&R)[2], const int (&C)[2], unsigned (&v)[4]) const {
#pragma unroll
        for (int h = 0; h < 2; ++h)
#pragma unroll
            for (int i = 0; i < 2; ++i) v[h * 2 + i] = (unsigned)((h * 128 + R[i]) * 512 + C[i]) * 2u;
    }
};

struct EpiIn {
    static constexpr bool PERM = true;
    unsigned char* ws;
    __device__ __forceinline__ void operator()(const f32x4 (&acc)[2][2][4][2], const DenseU& u, int wr, int wc, int fr, int fq) const {
        const int pn = u.pn; const int row0 = u.pm * 256 + wr * 64 + fr;
        if (pn == 16) {
            if (wc != 0) return;
            float* alr = (float*)(ws + RA_ALR);
#pragma unroll
            for (int ai = 0; ai < 2; ++ai)
#pragma unroll
                for (int m = 0; m < 4; ++m) { float* rp = alr + (size_t)(row0 + ai * 128 + m * 16) * 32 + 8 * fq;
                    *(f32x4*)(rp) = acc[ai][0][m][0]; *(f32x4*)(rp + 4) = acc[ai][0][m][1]; }
            return;
        }
        bf16* base; int ld, colt; bool lat_only;
        if (pn < 2) { base = (bf16*)(ws + RA_Q); ld = 512; colt = pn * 256; lat_only = true; }
        else if (pn < 4) { base = (bf16*)(ws + RA_K); ld = 512; colt = (pn - 2) * 256; lat_only = false; }
        else if (pn < 8) { base = (bf16*)(ws + RA_V); ld = 1024; colt = (pn - 4) * 256; lat_only = false; }
        else if (pn < 12) { base = (bf16*)(ws + RA_R); ld = 1024; colt = (pn - 8) * 256; lat_only = true; }
        else { base = (bf16*)(ws + RA_P); ld = 1024; colt = (pn - 12) * 256; lat_only = true; }
        if (lat_only && u.pm >= 64) return;
        const int col0 = colt + wc * 32 + 8 * fq;
#pragma unroll
        for (int ai = 0; ai < 2; ++ai)
#pragma unroll
            for (int m = 0; m < 4; ++m) { bf16* rp = base + (size_t)(row0 + ai * 128 + m * 16) * ld + col0;
#pragma unroll
                for (int bj = 0; bj < 2; ++bj) { const f32x4 v0 = acc[ai][bj][m][0], v1 = acc[ai][bj][m][1];
                    v4u o; o.x = pg8::cvt_pk_bf16(v0[0], v0[1]); o.y = pg8::cvt_pk_bf16(v0[2], v0[3]); o.z = pg8::cvt_pk_bf16(v1[0], v1[1]); o.w = pg8::cvt_pk_bf16(v1[2], v1[3]);
                    *(v4u*)(rp + bj * 128) = o; } }
    }
};
struct EpiPool {
    static constexpr bool PERM = true;
    bf16* ymix; const float* scale;
    __device__ __forceinline__ void operator()(const f32x4 (&acc)[2][2][4][2], const PoolU& u, int wr, int wc, int fr, int fq) const {
        const int row0 = u.pm * 256 + wr * 64 + fr; const int c0 = u.g * 256 + wc * 32 + 8 * fq;
#pragma unroll
        for (int ai = 0; ai < 2; ++ai)
#pragma unroll
            for (int m = 0; m < 4; ++m) { bf16* rp = ymix + (size_t)(row0 + ai * 128 + m * 16) * 2048 + 1024 + c0;
#pragma unroll
                for (int bj = 0; bj < 2; ++bj) { const f32x4 s0 = *(const f32x4*)(scale + c0 + bj * 128), s1 = *(const f32x4*)(scale + c0 + bj * 128 + 4);
                    const f32x4 v0 = acc[ai][bj][m][0] * s0, v1 = acc[ai][bj][m][1] * s1;
                    v4u o; o.x = pg8::cvt_pk_bf16(v0[0], v0[1]); o.y = pg8::cvt_pk_bf16(v0[2], v0[3]); o.z = pg8::cvt_pk_bf16(v1[0], v1[1]); o.w = pg8::cvt_pk_bf16(v1[2], v1[3]);
                    *(v4u*)(rp + bj * 128) = o; } }
    }
};
struct EpiOut {
    static constexpr bool PERM = false;
    float* y;
    __device__ __forceinline__ void operator()(const f32x4 (&acc)[2][2][4][2], const DenseU& u, int wr, int wc, int fr, int fq) const {
        const int row0 = u.pm * 256 + wr * 64 + fr, col0 = u.pn * 256 + wc * 32 + 4 * fq;
#pragma unroll
        for (int ai = 0; ai < 2; ++ai)
#pragma unroll
            for (int m = 0; m < 4; ++m) { float* rp = y + (size_t)(row0 + ai * 128 + m * 16) * 2048 + col0;
#pragma unroll
                for (int bj = 0; bj < 2; ++bj)
#pragma unroll
                    for (int n = 0; n < 2; ++n) *(f32x4*)(rp + bj * 128 + n * 16) = acc[ai][bj][m][n]; }
    }
};
struct EpiGU {
    static constexpr bool PERM = true;
    bf16* act; const float* slot_w;
    __device__ __forceinline__ void operator()(const f32x4 (&acc)[2][2][4][2], const MoeU& u, int wr, int wc, int fr, int fq) const {
        const int c0 = u.pn * 128 + wc * 32 + 8 * fq;
#pragma unroll
        for (int ai = 0; ai < 2; ++ai)
#pragma unroll
            for (int m = 0; m < 4; ++m) { const int r = ai * 128 + wr * 64 + m * 16 + fr;
                if (r < u.nrows) { const float w = slot_w[u.row0 + r]; float o[8];
#pragma unroll
                    for (int n = 0; n < 2; ++n)
#pragma unroll
                        for (int j = 0; j < 4; ++j) { const float g = acc[ai][0][m][n][j], up = acc[ai][1][m][n][j]; o[n * 4 + j] = silu_f(g) * up * w; }
                    v4u q; q.x = pg8::cvt_pk_bf16(o[0], o[1]); q.y = pg8::cvt_pk_bf16(o[2], o[3]); q.z = pg8::cvt_pk_bf16(o[4], o[5]); q.w = pg8::cvt_pk_bf16(o[6], o[7]);
                    *(v4u*)(act + (size_t)(u.row0 + r) * 512 + c0) = q; } }
    }
};
struct EpiDown {
    static constexpr bool PERM = true;
    bf16* so;
    __device__ __forceinline__ void operator()(const f32x4 (&acc)[2][2][4][2], const MoeU& u, int wr, int wc, int fr, int fq) const {
        const int c0 = u.pn * 256 + wc * 32 + 8 * fq;
#pragma unroll
        for (int ai = 0; ai < 2; ++ai)
#pragma unroll
            for (int m = 0; m < 4; ++m) { const int r = ai * 128 + wr * 64 + m * 16 + fr;
                if (r < u.nrows) { bf16* rp = so + (size_t)(u.row0 + r) * 2048 + c0;
#pragma unroll
                    for (int bj = 0; bj < 2; ++bj) { const f32x4 v0 = acc[ai][bj][m][0], v1 = acc[ai][bj][m][1];
                        v4u o; o.x = pg8::cvt_pk_bf16(v0[0], v0[1]); o.y = pg8::cvt_pk_bf16(v0[2], v0[3]); o.z = pg8::cvt_pk_bf16(v1[0], v1[1]); o.w = pg8::cvt_pk_bf16(v1[2], v1[3]);
                        *(v4u*)(rp + bj * 128) = o; } } }
    }
};

__device__ __forceinline__ void tr_item(const float* W, int ldn, bf16* WT, int Kd, int drow0, int k0, int n0, LAS float* scr, int lane) {
#pragma unroll 8
    for (int i = 0; i < 32; ++i) { const int kk = 2 * i + (lane >> 5); scr[kk * 33 + (lane & 31)] = W[(size_t)(k0 + kk) * ldn + n0 + (lane & 31)]; }
    LDS_WAIT(); asm volatile("" ::: "memory");
    const int c = lane & 7;
#pragma unroll
    for (int j = 0; j < 4; ++j) { const int n = (lane >> 3) + 8 * j; const LAS float* s = scr + (8 * c) * 33 + n;
        v4u o; o.x = pk2(s[0 * 33], s[1 * 33]); o.y = pk2(s[2 * 33], s[3 * 33]); o.z = pk2(s[4 * 33], s[5 * 33]); o.w = pk2(s[6 * 33], s[7 * 33]);
        *(v4u*)(WT + (size_t)(drow0 + n) * Kd + k0 + 8 * c) = o; }
    LDS_WAIT(); asm volatile("" ::: "memory");
}

__device__ __forceinline__ void phase0(const Args& a, LAS unsigned char* lds, int tid, int lane, int wave, int vcu, int G) {
    unsigned char* ws = a.ws;
    if (vcu < 192) {
        LAS float* sc = (LAS float*)lds;
        LAS float* red = (LAS float*)(lds + 73728);
        for (int i = tid; i < 9 * 2048; i += 512) { const int r = i >> 11, k = i & 2047; const float v = r < 8 ? a.in[1][r * 2048 + k] : a.in[3][k]; sc[i] = silu_f(v); }
        __syncthreads();
        const float* wm = a.in[4]; const float* bm = a.in[5]; float* mod = (float*)(ws + WS_MOD);
        for (int chunk = vcu; chunk < 192; chunk += G) {
            const int n0 = chunk * 64, ks = lane >> 4, n4 = (lane & 15) * 4;
            f32x4 acc[9];
#pragma unroll
            for (int r = 0; r < 9; ++r) acc[r] = (f32x4){0.f, 0.f, 0.f, 0.f};
#pragma unroll 4
            for (int kk = 0; kk < 256; kk += 4) { const int k = wave * 256 + kk + ks; const f32x4 wv = *(const f32x4*)(wm + (size_t)k * 12288 + n0 + n4);
#pragma unroll
                for (int r = 0; r < 9; ++r) { const float s = sc[r * 2048 + k]; acc[r] += wv * s; } }
#pragma unroll
            for (int r = 0; r < 9; ++r)
#pragma unroll
                for (int j = 0; j < 4; ++j) { float v = acc[r][j]; v += __shfl_xor(v, 16); v += __shfl_xor(v, 32); acc[r][j] = v; }
            if (lane < 16) {
#pragma unroll
                for (int r = 0; r < 9; ++r) *(LAS f32x4*)(red + (wave * 9 + r) * 64 + n4) = acc[r]; }
            __syncthreads();
            for (int i = tid; i < 9 * 64; i += 512) { const int r = i >> 6, n = i & 63; float s = 0.f;
#pragma unroll
                for (int w = 0; w < 8; ++w) s += red[(w * 9 + r) * 64 + n];
                mod[r * 12288 + n0 + n] = s + bm[n0 + n]; }
            __syncthreads();
        }
    }
    __syncthreads();
    LAS float* scr = (LAS float*)(lds + wave * 16384);
    const int gw = vcu * 8 + wave, NGW = G * 8;
    bf16* Win_t = (bf16*)(ws + WS_WIN); bf16* Wout_t = (bf16*)(ws + WS_WOUT); bf16* Wpool_t = (bf16*)(ws + WS_WPOOL); bf16* Wd_t = (bf16*)(ws + WS_WD); bf16* Wgu_t = (bf16*)(ws + WS_WGU);
    constexpr int I_IN = 32 * 129, I_OUT = 32 * 64, I_POOL = 4 * 4 * 8, I_E = 65 * 512;
    constexpr int NITEMS = I_IN + I_OUT + I_POOL + 3 * I_E;
    for (int it = gw; it < NITEMS; it += NGW) {
        int r = it;
        if (r < I_IN) { const int kb = r / 129, nb = r % 129, n0 = 32 * nb; const int drow = n0 < 3072 ? n0 : (n0 == 3072 ? 4096 : n0 - 32);
            tr_item(a.in[10], DIN, Win_t, 2048, drow, 64 * kb, n0, scr, lane); continue; } r -= I_IN;
        if (r < I_OUT) { const int kb = r / 64, nb = r % 64; tr_item(a.in[18], 2048, Wout_t, 2048, 32 * nb, 64 * kb, 32 * nb, scr, lane); continue; } r -= I_OUT;
        if (r < I_POOL) { const int g = r / 32, rr = r % 32, kb = rr / 8, nb = rr % 8; tr_item(a.in[16] + g * 65536, 256, Wpool_t + g * 65536, 256, 32 * nb, 64 * kb, 32 * nb, scr, lane); continue; } r -= I_POOL;
        if (r < I_E) { const int e = r / 512, rr = r % 512, kb = rr / 16, nb = rr % 16, n0 = 32 * nb; const float* src = e < 64 ? a.in[21] + (size_t)e * 2048 * 512 : a.in[24];
            tr_item(src, 512, Wgu_t + (size_t)e * 1024 * 2048, 2048, (n0 / 128) * 256 + (n0 % 128), 64 * kb, n0, scr, lane); continue; } r -= I_E;
        if (r < I_E) { const int e = r / 512, rr = r % 512, kb = rr / 16, nb = rr % 16, n0 = 32 * nb; const float* src = e < 64 ? a.in[22] + (size_t)e * 2048 * 512 : a.in[25];
            tr_item(src, 512, Wgu_t + (size_t)e * 1024 * 2048, 2048, (n0 / 128) * 256 + 128 + (n0 % 128), 64 * kb, n0, scr, lane); continue; } r -= I_E;
        { const int e = r / 512, rr = r % 512, kb = rr / 64, nb = rr % 64; const float* src = e < 64 ? a.in[23] + (size_t)e * 512 * 2048 : a.in[26];
            tr_item(src, 2048, Wd_t + (size_t)e * 2048 * 512, 512, 32 * nb, 64 * kb, 32 * nb, scr, lane); }
    }
    { v4u* z = (v4u*)(Win_t + (size_t)DIN * 2048); const int nz = (DINP - DIN) * 2048 / 8;
      for (int i = vcu * 512 + tid; i < nz; i += G * 512) z[i] = (v4u){0u, 0u, 0u, 0u}; }
}

__device__ __forceinline__ void phase1(const Args& a, int lane, int wave, int vcu, int G) {
    const float* mod = (const float*)(a.ws + WS_MOD); bf16* H = (bf16*)(a.ws + RA_H); const float* g = a.in[6];
    for (int m = vcu * 8 + wave; m < MROWS; m += G * 8) {
        const float* xr = m < NT ? a.in[0] + (size_t)m * 2048 : a.in[2] + (size_t)(m - NT) * 2048;
        const float* mr = mod + (size_t)(m < NT ? (m >> 11) : 8) * 12288;
        f32x4 v[8]; float ss = 0.f;
#pragma unroll
        for (int j = 0; j < 8; ++j) { v[j] = *(const f32x4*)(xr + 4 * (lane + 64 * j)); ss += v[j][0] * v[j][0] + v[j][1] * v[j][1] + v[j][2] * v[j][2] + v[j][3] * v[j][3]; }
        const float rstd = rsqrtf(wave_sum(ss) * (1.f / 2048.f) + EPS);
#pragma unroll
        for (int j = 0; j < 8; ++j) { const int c = 4 * (lane + 64 * j); const f32x4 gg = *(const f32x4*)(g + c), sh = *(const f32x4*)(mr + c), sc = *(const f32x4*)(mr + 2048 + c);
            const f32x4 o = v[j] * rstd * gg * (sc + 1.f) + sh;
            v2u q; q.x = pk2(o[0], o[1]); q.y = pk2(o[2], o[3]); *(v2u*)(H + (size_t)m * 2048 + c) = q; }
    }
}

__device__ __forceinline__ int scan_row(int b, int dir, int s) {
    if (s < 256) { const int tc = dir ? 255 - s : s; return NT + b * 256 + tc; }
    const int t0 = s - 256; return b * 2048 + (dir ? 2047 - t0 : t0);
}
__device__ __forceinline__ void phase3_prep(const Args& a, int tid, int vcu, int G) {
    unsigned char* ws = a.ws;
    const bf16* Q = (const bf16*)(ws + RA_Q); const bf16* Kb = (const bf16*)(ws + RA_K); const float* ALR = (const float*)(ws + RA_ALR);
    bf16* QG = (bf16*)(ws + PQG); bf16* QM = (bf16*)(ws + PQM); bf16* KM = (bf16*)(ws + PKM); bf16* KD = (bf16*)(ws + PKD); float* DEC = (float*)(ws + PDEC);
    const int col = tid, h = col >> 7, dk = col & 127;
    for (int item = vcu; item < 2 * 8 * 36; item += G) {
        const int ch = item % 36, b = (item / 36) & 7, dir = item / 288;
        const float* wa2 = dir ? a.in[13] : a.in[11]; const float bia = (dir ? a.in[14] : a.in[12])[col];
        float w[16];
#pragma unroll
        for (int r = 0; r < 16; ++r) w[r] = wa2[r * 512 + col];
        float Gc = 0.f, Gmid = 0.f;
#pragma unroll 4
        for (int i = 0; i < 64; ++i) { const int row = scan_row(b, dir, ch * 64 + i); const float* ar = ALR + (size_t)row * 32 + dir * 16; float z = bia;
#pragma unroll
            for (int r = 0; r < 16; ++r) z += ar[r] * w[r];
            Gc += (fminf(z, 0.f) - log1pf(__expf(-fabsf(z)))) * (1.f / 16.f);
            if (i == 32) Gmid = Gc; }
        const float Gend = Gc;
        const bool lat = ch >= 4;
        DEC[((size_t)(dir * 8 + b) * 36 + ch) * 512 + col] = __expf(Gend);
        bf16* kdrow = KD + ((((size_t)(dir * 8 + b) * 36 + ch) * 4 + h) * 128 + dk) * 64;
        const size_t lt = lat ? ((((size_t)(dir * 8 + b) * 32 + (ch - 4)) * 4 + h) * 64) * 128 + dk : 0;
        Gc = 0.f;
#pragma unroll 1
        for (int i0 = 0; i0 < 64; i0 += 8) { unsigned kd[8];
#pragma unroll
            for (int ii = 0; ii < 8; ++ii) { const int i = i0 + ii; const int row = scan_row(b, dir, ch * 64 + i); const float* ar = ALR + (size_t)row * 32 + dir * 16; float z = bia;
#pragma unroll
                for (int r = 0; r < 16; ++r) z += ar[r] * w[r];
                Gc += (fminf(z, 0.f) - log1pf(__expf(-fabsf(z)))) * (1.f / 16.f);
                const float kv = bf1(Kb[(size_t)row * 512 + col]);
                kd[ii] = f2bf(kv * __expf(Gend - Gc));
                if (lat) { const float qv = bf1(Q[(size_t)row * 512 + col]) * 0.08838834764831845f;
                    QG[lt + (size_t)i * 128] = (bf16)f2bf(qv * __expf(Gc)); QM[lt + (size_t)i * 128] = (bf16)f2bf(qv * __expf(Gc - Gmid)); KM[lt + (size_t)i * 128] = (bf16)f2bf(kv * __expf(Gmid - Gc)); } }
            v4u o; o.x = kd[0] | (kd[1] << 16); o.y = kd[2] | (kd[3] << 16); o.z = kd[4] | (kd[5] << 16); o.w = kd[6] | (kd[7] << 16);
            *(v4u*)(kdrow + i0) = o; }
    }
}

constexpr int GL_QG = 0, GL_QM = 17408, GL_KM = 34816, GL_ST = 52224, GL_KDT = 69632, GL_VT = 88064, GL_AM = 97280, GL_DEC = 106496;
__device__ __forceinline__ void phase_chain(const Args& a, LAS unsigned char* lds, int tid, int lane, int wave, int vcu, int G) {
    unsigned char* ws = a.ws;
    const v4u* QG = (const v4u*)(ws + PQG); const v4u* QM = (const v4u*)(ws + PQM); const v4u* KM = (const v4u*)(ws + PKM); const v4u* KD = (const v4u*)(ws + PKD); const float* DEC = (const float*)(ws + PDEC);
    const bf16* V = (const bf16*)(ws + RA_V); float* OF = (float*)(ws + RA_OF);
    const int l15 = lane & 15, l4 = lane >> 4;
    for (int item = vcu; item < 256; item += G) {
        const int vs = item & 3, dir = (item >> 2) & 1, h = (item >> 3) & 3, b = item >> 5;
        f32x4 S[4];
#pragma unroll
        for (int tv = 0; tv < 4; ++tv) S[tv] = (f32x4){0.f, 0.f, 0.f, 0.f};
        v4u rq[6], rk[2], rv; float rdec = 0.f;
#define GL_LOAD(ch_) do { const int ch__ = (ch_); \
            if (ch__ >= 4) { const size_t t_ = ((((size_t)(dir * 8 + b) * 32 + (ch__ - 4)) * 4 + h) * 1024); \
                rq[0] = QG[t_ + tid]; rq[1] = QG[t_ + tid + 512]; rq[2] = QM[t_ + tid]; rq[3] = QM[t_ + tid + 512]; rq[4] = KM[t_ + tid]; rq[5] = KM[t_ + tid + 512]; } \
            { const size_t t_ = ((((size_t)(dir * 8 + b) * 36 + ch__) * 4 + h) * 1024); rk[0] = KD[t_ + tid]; rk[1] = KD[t_ + tid + 512]; } \
            { const int row_ = scan_row(b, dir, ch__ * 64 + (tid >> 3)); rv = *(const v4u*)(V + (size_t)row_ * 1024 + h * 256 + vs * 64 + 8 * (tid & 7)); } \
            if (tid < 128) rdec = DEC[((size_t)(dir * 8 + b) * 36 + ch__) * 512 + h * 128 + tid]; } while (0)
        GL_LOAD(0);
        for (int ch = 0; ch < 36; ++ch) {
            const bool lat = ch >= 4;
#pragma unroll
            for (int tv = 0; tv < 4; ++tv) { v2u p; p.x = pk2(S[tv][0], S[tv][1]); p.y = pk2(S[tv][2], S[tv][3]);
                *(LAS v2u*)(lds + GL_ST + (16 * tv + l15) * 272 + (16 * wave + 4 * l4) * 2) = p; }
            if (lat) {
#pragma unroll
                for (int q = 0; q < 2; ++q) { const int p = tid + 512 * q; const int off = (p >> 4) * 272 + (p & 15) * 16;
                    *(LAS v4u*)(lds + GL_QG + off) = rq[q]; *(LAS v4u*)(lds + GL_QM + off) = rq[2 + q]; *(LAS v4u*)(lds + GL_KM + off) = rq[4 + q]; } }
#pragma unroll
            for (int q = 0; q < 2; ++q) { const int p = tid + 512 * q; *(LAS v4u*)(lds + GL_KDT + (p >> 3) * 144 + (p & 7) * 16) = rk[q]; }
            { const int i = tid >> 3, c = tid & 7; LAS bf16* vt = (LAS bf16*)(lds + GL_VT) + i;
              vt[(8 * c + 0) * 72] = (bf16)(rv.x & 0xffffu); vt[(8 * c + 1) * 72] = (bf16)(rv.x >> 16); vt[(8 * c + 2) * 72] = (bf16)(rv.y & 0xffffu); vt[(8 * c + 3) * 72] = (bf16)(rv.y >> 16);
              vt[(8 * c + 4) * 72] = (bf16)(rv.z & 0xffffu); vt[(8 * c + 5) * 72] = (bf16)(rv.z >> 16); vt[(8 * c + 6) * 72] = (bf16)(rv.w & 0xffffu); vt[(8 * c + 7) * 72] = (bf16)(rv.w >> 16); }
            if (tid < 128) *(LAS float*)(lds + GL_DEC + tid * 4) = rdec;
            __syncthreads();
            if (ch + 1 < 36) GL_LOAD(ch + 1);
            if (lat) {
                { const int ti = wave >> 1; f32x4 c0 = (f32x4){0.f, 0.f, 0.f, 0.f}, c1 = c0; const int tj0 = (wave & 1) * 2;
#pragma unroll
                  for (int ks = 0; ks < 4; ++ks) { const int ko = (32 * ks + 8 * l4) * 2;
                      const bf16x8 bq = *(const LAS bf16x8*)(lds + GL_QM + (16 * ti + l15) * 272 + ko);
                      const bf16x8 a0 = *(const LAS bf16x8*)(lds + GL_KM + (16 * tj0 + l15) * 272 + ko), a1 = *(const LAS bf16x8*)(lds + GL_KM + (16 * tj0 + 16 + l15) * 272 + ko);
                      c0 = __builtin_amdgcn_mfma_f32_16x16x32_bf16(a0, bq, c0, 0, 0, 0); c1 = __builtin_amdgcn_mfma_f32_16x16x32_bf16(a1, bq, c1, 0, 0, 0); }
                  const int i = 16 * ti + l15;
                  { const int j0 = 16 * tj0 + 4 * l4; v2u p; p.x = pk2(j0 <= i ? c0[0] : 0.f, j0 + 1 <= i ? c0[1] : 0.f); p.y = pk2(j0 + 2 <= i ? c0[2] : 0.f, j0 + 3 <= i ? c0[3] : 0.f);
                    *(LAS v2u*)(lds + GL_AM + i * 144 + j0 * 2) = p; }
                  { const int j0 = 16 * tj0 + 16 + 4 * l4; v2u p; p.x = pk2(j0 <= i ? c1[0] : 0.f, j0 + 1 <= i ? c1[1] : 0.f); p.y = pk2(j0 + 2 <= i ? c1[2] : 0.f, j0 + 3 <= i ? c1[3] : 0.f);
                    *(LAS v2u*)(lds + GL_AM + i * 144 + j0 * 2) = p; } }
                __syncthreads();
                { const int ti = wave >> 1, tv0 = (wave & 1) * 2; f32x4 c0 = (f32x4){0.f, 0.f, 0.f, 0.f}, c1 = c0;
#pragma unroll
                  for (int ks = 0; ks < 4; ++ks) { const int ko = (32 * ks + 8 * l4) * 2;
                      const bf16x8 bq = *(const LAS bf16x8*)(lds + GL_QG + (16 * ti + l15) * 272 + ko);
                      const bf16x8 a0 = *(const LAS bf16x8*)(lds + GL_ST + (16 * tv0 + l15) * 272 + ko), a1 = *(const LAS bf16x8*)(lds + GL_ST + (16 * tv0 + 16 + l15) * 272 + ko);
                      c0 = __builtin_amdgcn_mfma_f32_16x16x32_bf16(a0, bq, c0, 0, 0, 0); c1 = __builtin_amdgcn_mfma_f32_16x16x32_bf16(a1, bq, c1, 0, 0, 0); }
#pragma unroll
                  for (int ks = 0; ks < 2; ++ks) { const int ko = (32 * ks + 8 * l4) * 2;
                      const bf16x8 bq = *(const LAS bf16x8*)(lds + GL_AM + (16 * ti + l15) * 144 + ko);
                      const bf16x8 a0 = *(const LAS bf16x8*)(lds + GL_VT + (16 * tv0 + l15) * 144 + ko), a1 = *(const LAS bf16x8*)(lds + GL_VT + (16 * tv0 + 16 + l15) * 144 + ko);
                      c0 = __builtin_amdgcn_mfma_f32_16x16x32_bf16(a0, bq, c0, 0, 0, 0); c1 = __builtin_amdgcn_mfma_f32_16x16x32_bf16(a1, bq, c1, 0, 0, 0); }
                  const int s = ch * 64 + 16 * ti + l15; const int t0 = s - 256; const int t = dir ? 2047 - t0 : t0;
                  float* orow = OF + ((size_t)dir * NT + b * 2048 + t) * 1024 + h * 256 + vs * 64 + 16 * tv0 + 4 * l4;
                  *(f32x4*)(orow) = c0; *(f32x4*)(orow + 16) = c1; }
            }
            { const f32x4 d4 = *(const LAS f32x4*)(lds + GL_DEC + (16 * wave + 4 * l4) * 4);
#pragma unroll
              for (int tv = 0; tv < 4; ++tv) S[tv] = S[tv] * d4;
#pragma unroll
              for (int ks = 0; ks < 2; ++ks) { const int ko = (32 * ks + 8 * l4) * 2;
                  const bf16x8 ak = *(const LAS bf16x8*)(lds + GL_KDT + (16 * wave + l15) * 144 + ko);
#pragma unroll
                  for (int tv = 0; tv < 4; ++tv) { const bf16x8 bv = *(const LAS bf16x8*)(lds + GL_VT + (16 * tv + l15) * 144 + ko);
                      S[tv] = __builtin_amdgcn_mfma_f32_16x16x32_bf16(ak, bv, S[tv], 0, 0, 0); } } }
            __syncthreads();
        }
#undef GL_LOAD
    }
}

__device__ __forceinline__ void phase3_pool(const Args& a, LAS unsigned char* lds, int tid, int vcu, int G) {
    const bf16* P = (const bf16*)(a.ws + RA_P); bf16* DP = (bf16*)(a.ws + RA_DPOOL);
    LAS float* tmp = (LAS float*)lds;
    for (int item = vcu; item < 1024; item += G) {
        const int g = item & 3, r = (item >> 2) & 31, b = item >> 7;
        const int half = 1 << g;
        const int rlo = r - half < 0 ? 0 : r - half, rhi = r + half > 32 ? 32 : r + half;
        const float rinv = 1.f / (float)(rhi - rlo);
#pragma unroll
        for (int q = 0; q < 4; ++q) { const int p = tid + 512 * q, c = p >> 5, ch0 = (p & 31) * 8; float acc[8];
#pragma unroll
            for (int j = 0; j < 8; ++j) acc[j] = 0.f;
            for (int rr = rlo; rr < rhi; ++rr) { const v4u x = *(const v4u*)(P + ((size_t)(b * 2048 + rr * 64 + c)) * 1024 + g * 256 + ch0);
                acc[0] += bflo(x.x); acc[1] += bfhi(x.x); acc[2] += bflo(x.y); acc[3] += bfhi(x.y); acc[4] += bflo(x.z); acc[5] += bfhi(x.z); acc[6] += bflo(x.w); acc[7] += bfhi(x.w); }
#pragma unroll
            for (int j = 0; j < 8; ++j) tmp[c * 256 + ch0 + j] = acc[j] * rinv; }
        __syncthreads();
#pragma unroll
        for (int q = 0; q < 4; ++q) { const int p = tid + 512 * q, c = p >> 5, ch0 = (p & 31) * 8;
            const int clo = c - half < 0 ? 0 : c - half, chi = c + half > 64 ? 64 : c + half; const float cinv = 1.f / (float)(chi - clo);
            float acc[8];
#pragma unroll
            for (int j = 0; j < 8; ++j) acc[j] = 0.f;
            for (int cc = clo; cc < chi; ++cc) {
#pragma unroll
                for (int j = 0; j < 8; ++j) acc[j] += tmp[cc * 256 + ch0 + j]; }
            const size_t o = ((size_t)(b * 2048 + r * 64 + c)) * 1024 + g * 256 + ch0;
            const v4u x = *(const v4u*)(P + o);
            v4u d; d.x = pk2(acc[0] * cinv - bflo(x.x), acc[1] * cinv - bfhi(x.x)); d.y = pk2(acc[2] * cinv - bflo(x.y), acc[3] * cinv - bfhi(x.y));
            d.z = pk2(acc[4] * cinv - bflo(x.z), acc[5] * cinv - bfhi(x.z)); d.w = pk2(acc[6] * cinv - bflo(x.w), acc[7] * cinv - bfhi(x.w));
            *(v4u*)(DP + o) = d; }
        __syncthreads();
    }
}

__device__ __forceinline__ void phase4_post(const Args& a, int lane, int wave, int vcu, int G) {
    const float* OF = (const float*)(a.ws + RA_OF); const float* OB = OF + (size_t)NT * 1024; const bf16* Rr = (const bf16*)(a.ws + RA_R); bf16* Y = (bf16*)(a.ws + RA_YMIX);
    const float* gn = a.in[15];
    for (int idx = vcu * 8 + wave; idx < NT * 4; idx += G * 8) {
        const int t = idx >> 2, h = idx & 3; const size_t o = (size_t)t * 1024 + h * 256 + 4 * lane;
        const f32x4 x = *(const f32x4*)(OF + o) + *(const f32x4*)(OB + o);
        const float ms = wave_sum(x[0] * x[0] + x[1] * x[1] + x[2] * x[2] + x[3] * x[3]) * (1.f / 256.f);
        const float sc = rsqrtf(ms + EPS);
        const f32x4 g4 = *(const f32x4*)(gn + h * 256 + 4 * lane);
        const v2u rr = *(const v2u*)(Rr + o);
        const float r0 = bflo(rr.x), r1 = bfhi(rr.x), r2 = bflo(rr.y), r3 = bfhi(rr.y);
        v2u q; q.x = pk2(x[0] * sc * g4[0] * silu_f(r0), x[1] * sc * g4[1] * silu_f(r1)); q.y = pk2(x[2] * sc * g4[2] * silu_f(r2), x[3] * sc * g4[3] * silu_f(r3));
        *(v2u*)(Y + (size_t)t * 2048 + h * 256 + 4 * lane) = q;
    }
}

__device__ __forceinline__ void phase6(const Args& a, LAS unsigned char* lds, int tid, int lane, int wave, int vcu, int G) {
    unsigned char* ws = a.ws;
    const float* mod = (const float*)(ws + WS_MOD); const float* Y1 = (const float*)(ws + RA_Y1); bf16* H2 = (bf16*)(ws + RA_H2);
    const float* gpost = a.in[7]; const float* gpre2 = a.in[8]; const float* wr = a.in[19]; const float* rbias = a.in[20];
    LAS float* hrow = (LAS float*)lds;
    LAS float* logit = (LAS float*)(lds + LDS_LOGIT);
    LAS u64* masks = (LAS u64*)(lds + LDS_MASKS);
    int* cnt = (int*)(ws + T_CNT); u64* tmask = (u64*)(ws + T_MASK); float* tokw = (float*)(ws + T_TOKW);
    for (int blk = vcu; blk < NT / 64; blk += G) {
        for (int it = 0; it < 4; ++it) {
#pragma unroll 1
            for (int rr = 0; rr < 2; ++rr) {
                const int lr = wave * 2 + rr, t = blk * 64 + it * 16 + lr; const float* mr = mod + (size_t)(t >> 11) * 12288;
                const float* yr = Y1 + (size_t)t * 2048; const float* xr = a.in[0] + (size_t)t * 2048; float* outr = a.out + (size_t)t * 2048;
                f32x4 y[8]; float ss = 0.f;
#pragma unroll
                for (int j = 0; j < 8; ++j) { y[j] = *(const f32x4*)(yr + 4 * (lane + 64 * j)); ss += y[j][0] * y[j][0] + y[j][1] * y[j][1] + y[j][2] * y[j][2] + y[j][3] * y[j][3]; }
                const float rstd1 = rsqrtf(wave_sum(ss) * (1.f / 2048.f) + EPS);
                float s2 = 0.f;
#pragma unroll
                for (int j = 0; j < 8; ++j) { const int c = 4 * (lane + 64 * j); const f32x4 x = *(const f32x4*)(xr + c), gp = *(const f32x4*)(gpost + c), gt = *(const f32x4*)(mr + 4096 + c);
                    const f32x4 x1 = x + gt * (y[j] * rstd1 * gp); y[j] = x1; *(f32x4*)(outr + c) = x1;
                    s2 += x1[0] * x1[0] + x1[1] * x1[1] + x1[2] * x1[2] + x1[3] * x1[3]; }
                const float rstd2 = rsqrtf(wave_sum(s2) * (1.f / 2048.f) + EPS);
#pragma unroll
                for (int j = 0; j < 8; ++j) { const int c = 4 * (lane + 64 * j); const f32x4 g2 = *(const f32x4*)(gpre2 + c), sh = *(const f32x4*)(mr + 6144 + c), sc = *(const f32x4*)(mr + 8192 + c);
                    const f32x4 hh = y[j] * rstd2 * g2 * (sc + 1.f) + sh;
                    *(LAS f32x4*)(hrow + lr * 2048 + c) = hh;
                    v2u q; q.x = pk2(hh[0], hh[1]); q.y = pk2(hh[2], hh[3]); *(v2u*)(H2 + (size_t)t * 2048 + c) = q; }
            }
            __syncthreads();
            { float a0 = 0.f, a1 = 0.f; const LAS float* h0 = hrow + (wave * 2) * 2048; const LAS float* h1 = h0 + 2048;
#pragma unroll 8
              for (int k = 0; k < 2048; ++k) { const float w = wr[k * 64 + lane]; a0 += h0[k] * w; a1 += h1[k] * w; }
              logit[(wave * 2) * 64 + lane] = a0; logit[(wave * 2 + 1) * 64 + lane] = a1; }
            LDS_WAIT();
#pragma unroll 1
            for (int rr = 0; rr < 2; ++rr) {
                const int lr = wave * 2 + rr, t = blk * 64 + it * 16 + lr;
                const float lg = logit[lr * 64 + lane]; const float s = 1.f / (1.f + __expf(-lg)); const float sel = s + rbias[lane];
                float m1 = sel; m1 = fmaxf(m1, __shfl_xor(m1, 1)); m1 = fmaxf(m1, __shfl_xor(m1, 2)); m1 = fmaxf(m1, __shfl_xor(m1, 4));
                const u64 eq = __ballot(sel == m1); const unsigned gb = (unsigned)(eq >> (lane & ~7)) & 0xffu; const int first = __builtin_ctz(gb);
                float v2 = ((lane & 7) == first) ? -INFINITY : sel; v2 = fmaxf(v2, __shfl_xor(v2, 1)); v2 = fmaxf(v2, __shfl_xor(v2, 2)); v2 = fmaxf(v2, __shfl_xor(v2, 4));
                const float gs = m1 + v2; const int g = lane >> 3; int grank = 0;
#pragma unroll
                for (int g2 = 0; g2 < 8; ++g2) { const float o = __shfl(gs, g2 * 8); grank += (o > gs || (o == gs && g2 < g)) ? 1 : 0; }
                const bool gsel = grank < 4; const float mk = gsel ? sel : -INFINITY; int rank = 0;
                for (int e2 = 0; e2 < 64; ++e2) { const float o = __shfl(mk, e2); rank += (o > mk || (o == mk && e2 < lane)) ? 1 : 0; }
                const bool chosen = gsel && rank < 8;
                const u64 mask = __ballot(chosen); const float ssum = wave_sum(chosen ? s : 0.f);
                const int kidx = __popcll(mask & ((1ull << lane) - 1ull));
                if (chosen) tokw[(size_t)t * 8 + kidx] = s / ssum * 2.5f;
                if (lane == 0) { tmask[t] = mask; masks[it * 16 + lr] = mask; }
            }
            __syncthreads();
        }
        if (wave == 0) { const u64 m = masks[lane]; int mine = 0;
            for (int e = 0; e < 64; ++e) { const int c = __popcll(__ballot((m >> e) & 1ull)); mine = (lane == e) ? c : mine; }
            cnt[blk * 64 + lane] = mine; }
        __syncthreads();
    }
}

__device__ __forceinline__ void phase7(const Args& a, LAS unsigned char* lds, int tid, int lane, int wave, int vcu, int G) {
    unsigned char* ws = a.ws;
    const int* cnt = (const int*)(ws + T_CNT); const u64* tmask = (const u64*)(ws + T_MASK); const float* tokw = (const float*)(ws + T_TOKW);
    int* tokslot = (int*)(ws + T_TOKSLOT); int* slottok = (int*)(ws + T_SLOTTOK); float* slotw = (float*)(ws + T_SLOTW); int* tile = (int*)(ws + T_TILE);
    LAS int* part = (LAS int*)lds;
    LAS int* tot = (LAS int*)(lds + 4096);
    for (int blk = vcu; blk < NT / 64; blk += G) {
        int pre = 0, all = 0;
        for (int b2 = wave; b2 < 256; b2 += 8) { const int c = cnt[b2 * 64 + lane]; all += c; pre += (b2 < blk) ? c : 0; }
        part[(wave * 2) * 64 + lane] = pre; part[(wave * 2 + 1) * 64 + lane] = all;
        __syncthreads();
        if (wave == 0) {
            int p = 0, t = 0;
#pragma unroll
            for (int w = 0; w < 8; ++w) { p += part[(w * 2) * 64 + lane]; t += part[(w * 2 + 1) * 64 + lane]; }
            int incl = t;
#pragma unroll
            for (int o = 1; o < 64; o <<= 1) { const int v = __shfl_up(incl, o); if (lane >= o) incl += v; }
            const int start = incl - t; const int base = start + p;
            tot[lane] = t; tot[64 + lane] = start;
            const int tokn = blk * 64 + lane; const u64 m = tmask[tokn];
            for (int e = 0; e < 64; ++e) { const bool bit = (m >> e) & 1ull; const u64 bal = __ballot(bit); const int be = __shfl(base, e);
                if (bit) { const int rank = __popcll(bal & ((1ull << lane) - 1ull)); const int slot = be + rank; const int k = __popcll(m & ((1ull << e) - 1ull));
                    slottok[slot] = tokn; slotw[slot] = tokw[(size_t)tokn * 8 + k]; tokslot[(size_t)tokn * 8 + k] = slot; } }
            slottok[SH_ROW0 + tokn] = tokn; slotw[SH_ROW0 + tokn] = 1.f;
        }
        __syncthreads();
        if (blk == 0 && tid == 0) {
            int n = 0;
            for (int e = 0; e < 64; ++e) { const int te = tot[e], st = tot[64 + e];
                for (int j = 0; j * 256 < te; ++j) { tile[n] = e; tile[NTILE_MAX + n] = st + j * 256; tile[2 * NTILE_MAX + n] = (te - j * 256) < 256 ? (te - j * 256) : 256; ++n; } }
            for (int j = 0; j < 64; ++j) { tile[n] = 64; tile[NTILE_MAX + n] = SH_ROW0 + j * 256; tile[2 * NTILE_MAX + n] = 256; ++n; }
            tile[3 * NTILE_MAX] = n;
        }
        __syncthreads();
    }
}

__device__ __forceinline__ void phase10(const Args& a, int lane, int wave, int vcu, int G) {
    unsigned char* ws = a.ws;
    const float* mod = (const float*)(ws + WS_MOD); const bf16* SO = (const bf16*)(ws + WS_SLOTOUT); const int* tokslot = (const int*)(ws + T_TOKSLOT); const float* gp = a.in[9];
    for (int t = vcu * 8 + wave; t < NT; t += G * 8) {
        const float* mr = mod + (size_t)(t >> 11) * 12288;
        float y[4][8];
#pragma unroll
        for (int j = 0; j < 4; ++j)
#pragma unroll
            for (int q = 0; q < 8; ++q) y[j][q] = 0.f;
#pragma unroll 1
        for (int k = 0; k < 9; ++k) { const int slot = k < 8 ? tokslot[(size_t)t * 8 + k] : SH_ROW0 + t; const bf16* sr = SO + (size_t)slot * 2048;
#pragma unroll
            for (int j = 0; j < 4; ++j) { const v4u x = *(const v4u*)(sr + 8 * (lane + 64 * j));
                y[j][0] += bflo(x.x); y[j][1] += bfhi(x.x); y[j][2] += bflo(x.y); y[j][3] += bfhi(x.y); y[j][4] += bflo(x.z); y[j][5] += bfhi(x.z); y[j][6] += bflo(x.w); y[j][7] += bfhi(x.w); } }
        float ss = 0.f;
#pragma unroll
        for (int j = 0; j < 4; ++j)
#pragma unroll
            for (int q = 0; q < 8; ++q) ss += y[j][q] * y[j][q];
        const float rstd = rsqrtf(wave_sum(ss) * (1.f / 2048.f) + EPS);
        float* outr = a.out + (size_t)t * 2048;
#pragma unroll
        for (int j = 0; j < 4; ++j)
#pragma unroll
            for (int hh = 0; hh < 2; ++hh) { const int c = 8 * (lane + 64 * j) + 4 * hh; const f32x4 x1 = *(const f32x4*)(outr + c), g = *(const f32x4*)(gp + c), gt = *(const f32x4*)(mr + 10240 + c);
                f32x4 yy; yy[0] = y[j][4 * hh]; yy[1] = y[j][4 * hh + 1]; yy[2] = y[j][4 * hh + 2]; yy[3] = y[j][4 * hh + 3];
                *(f32x4*)(outr + c) = x1 + gt * (yy * rstd * g); }
    }
}

__global__ void __launch_bounds__(512, 2) fwd(Args args) {
    extern __shared__ __attribute__((aligned(16))) unsigned char lds_raw[];
    LAS unsigned char* lds = (LAS unsigned char*)lds_raw;
    const int tid = threadIdx.x, lane = tid & 63, wave = __builtin_amdgcn_readfirstlane(tid >> 6);
    const int G = gridDim.x, bx = blockIdx.x;
    const int vcu = (G % 8 == 0) ? (bx % 8) * (G / 8) + bx / 8 : bx;
    unsigned char* ws = args.ws;
    volatile LAS unsigned* MISC = (volatile LAS unsigned*)(lds + LDS_MISC);
    if (tid < 64) MISC[tid] = 0u;
    __syncthreads();
    const int lo = args.ph_lo, hi = args.ph_hi;
    XcdBarrier bar; bar.bar = (unsigned*)(ws + WS_CTL) + 4096; bar.x = 0; bar.st = nullptr;
    if (hi - lo > 1) bar = xcd_barrier_post((unsigned*)(ws + WS_CTL) + 4096, MISC + 8);
#ifndef PH_MASK
#define PH_MASK 0xfff
#endif
#define IN(k) (((PH_MASK >> (k)) & 1) && lo <= (k) && (k) < hi)
#define SEAM(k) do { if (IN(k) && IN((k) + 1)) xcd_barrier(bar); } while (0)

    if (IN(0)) { phase0(args, lds, tid, lane, wave, vcu, G); SEAM(0); }
    if (IN(1)) { phase1(args, lane, wave, vcu, G); SEAM(1); }
    if (IN(2)) {
        DenseSched S; S.init(ws + RA_H, ws + WS_WIN, 2048, 2048, MROWS, DINP, G, bx);
        EpiIn E{ws};
        pg8::gemm_phase<EpiIn, DenseSched>(lds, 2048, S, E);
        SEAM(2);
    }
    if (IN(3)) { phase3_prep(args, tid, vcu, G); phase3_pool(args, lds, tid, vcu, G); SEAM(3); }
    if (IN(4)) { phase_chain(args, lds, tid, lane, wave, vcu, G); SEAM(4); }
    if (IN(5)) {
        phase4_post(args, lane, wave, vcu, G);
        PoolSched S{(const char*)(ws + RA_DPOOL), (const char*)(ws + WS_WPOOL), G, vcu};
        EpiPool E{(bf16*)(ws + RA_YMIX), args.in[17]};
        int kpool = 256; asm volatile("" : "+s"(kpool));
        pg8::gemm_phase<EpiPool, PoolSched>(lds, kpool, S, E);
        SEAM(5);
    }
    if (IN(6)) {
        DenseSched S; S.init(ws + RA_YMIX, ws + WS_WOUT, 2048, 2048, NT, 2048, G, bx);
        EpiOut E{(float*)(ws + RA_Y1)};
        pg8::gemm_phase<EpiOut, DenseSched>(lds, 2048, S, E);
        SEAM(6);
    }
    if (IN(7)) { phase6(args, lds, tid, lane, wave, vcu, G); SEAM(7); }
    if (IN(8)) { phase7(args, lds, tid, lane, wave, vcu, G); SEAM(8); }
    if (IN(9)) {
        MoeGUSched S{(const char*)(ws + RA_H2), (const char*)(ws + WS_WGU), (const int*)(ws + T_TILE), (const int*)(ws + T_SLOTTOK), G, vcu};
        EpiGU E{(bf16*)(ws + WS_ACT), (const float*)(ws + T_SLOTW)};
        pg8::gemm_phase<EpiGU, MoeGUSched>(lds, 2048, S, E);
        SEAM(9);
    }
    if (IN(10)) {
        MoeDownSched S{(const char*)(ws + WS_ACT), (const char*)(ws + WS_WD), (const int*)(ws + T_TILE), G, vcu};
        EpiDown E{(bf16*)(ws + WS_SLOTOUT)};
        pg8::gemm_phase<EpiDown, MoeDownSched>(lds, 512, S, E);
        SEAM(10);
    }
    if (IN(11)) { phase10(args, lane, wave, vcu, G); }
#undef IN
#undef SEAM
}

extern "C" void kernel_launch(void* const* d_in, const int* in_sizes, int n_in, void* d_out, int out_size, void* d_ws, size_t ws_size, hipStream_t stream) {
    static int grid = 0;
    if (grid == 0) {
        if (n_in != 27 || out_size != NT * DM || ws_size < WS_NEED) { fprintf(stderr, "kernel_launch: unexpected problem: n_in %d out %d ws %zu (need %zu)\n", n_in, out_size, ws_size, (size_t)WS_NEED); grid = -1; return; }
        int dev = 0, cus = 0, per_cu = 0;
        if (hipGetDevice(&dev) != hipSuccess || hipDeviceGetAttribute(&cus, hipDeviceAttributeMultiprocessorCount, dev) != hipSuccess) { grid = -1; return; }
        if (hipFuncSetAttribute((const void*)fwd, hipFuncAttributeMaxDynamicSharedMemorySize, LDS_BYTES) != hipSuccess) { fprintf(stderr, "kernel_launch: hipFuncSetAttribute failed\n"); grid = -1; return; }
        if (hipOccupancyMaxActiveBlocksPerMultiprocessor(&per_cu, (const void*)fwd, 512, LDS_BYTES) != hipSuccess || per_cu < 1) { fprintf(stderr, "kernel_launch: occupancy query says %d\n", per_cu); }
        (void)hipGetLastError();
        grid = cus;
    }
    if (grid < 0) return;
    (void)hipMemsetAsync((char*)d_ws + WS_CTL, 0, CTL_ZERO_BYTES, stream);
    Args a{};
    for (int i = 0; i < 27; ++i) a.in[i] = (const float*)d_in[i];
    a.out = (float*)d_out; a.ws = (unsigned char*)d_ws;
    if (N_LAUNCHES == 1) {
        a.ph_lo = 0; a.ph_hi = NPH;
        hipLaunchKernelGGL(fwd, dim3(grid), dim3(512), LDS_BYTES, stream, a);
    } else {
        for (int p = 0; p < NPH; ++p) { a.ph_lo = p; a.ph_hi = p + 1; hipLaunchKernelGGL(fwd, dim3(grid), dim3(512), LDS_BYTES, stream, a); }
    }
}
```

```cpp
#include <hip/hip_runtime.h>
#include <cstdio>
#include <cstdint>

#ifndef N_LAUNCHES
#define N_LAUNCHES 1
#endif

#define GAS __attribute__((address_space(1)))
#define LAS __attribute__((address_space(3)))
typedef unsigned short bf16;
typedef unsigned v4u __attribute__((ext_vector_type(4)));
typedef unsigned v2u __attribute__((ext_vector_type(2)));
typedef float f32x4 __attribute__((ext_vector_type(4)));
typedef short bf16x8 __attribute__((ext_vector_type(8)));
typedef unsigned long long u64;

constexpr int NB = 8, SEQ = 2048, DM = 2048, CTXL = 256;
constexpr int NT = NB * SEQ;
constexpr int NTC = NB * CTXL;
constexpr int MROWS = NT + NTC;
constexpr int DIN = 4128, DINP = 4352;
constexpr int NE = 64, TOPK = 8, DE = 512;
constexpr int NSLOT_E = NT * TOPK;
constexpr int SH_ROW0 = NSLOT_E + 256;
constexpr int NSLOT = SH_ROW0 + NT;
constexpr int NTILE_MAX = 704;
constexpr float EPS = 1e-6f;
constexpr int NPH = 12;

constexpr size_t MiB = 1u << 20;
constexpr size_t WS_CTL = 0, CTL_ZERO_BYTES = 64 * 1024;
constexpr size_t WS_MOD = 1 * MiB;
constexpr size_t WS_WRT = 1 * MiB + 512 * 1024;
constexpr size_t WS_WIN = 2 * MiB;
constexpr size_t WS_WOUT = WS_WIN + 17 * MiB;
constexpr size_t WS_WPOOL = WS_WOUT + 8 * MiB;
constexpr size_t WS_WD = WS_WPOOL + 1 * MiB;
constexpr size_t WS_WGU = WS_WD + 130 * MiB;
constexpr size_t WS_RA = WS_WGU + 260 * MiB;
constexpr size_t RA_H = WS_RA;
constexpr size_t RA_OF = WS_RA;
constexpr size_t RA_H2 = WS_RA;
constexpr size_t RA_Q = WS_RA + 128 * MiB;
constexpr size_t RA_K = RA_Q + 16 * MiB;
constexpr size_t RA_V = RA_K + 18 * MiB;
constexpr size_t RA_R = RA_V + 36 * MiB;
constexpr size_t RA_P = RA_R + 32 * MiB;
constexpr size_t RA_ALR = RA_P + 32 * MiB;
constexpr size_t RA_DPOOL = RA_ALR + 3 * MiB;
constexpr size_t RA_YMIX = RA_DPOOL + 32 * MiB;
constexpr size_t RA_Y1 = WS_RA + 128 * MiB;
constexpr size_t RA_END = RA_YMIX + 64 * MiB;
constexpr size_t WS_SLOTOUT = WS_WGU;
constexpr size_t WS_ACT = RA_END > WS_SLOTOUT + 578 * MiB ? RA_END : WS_SLOTOUT + 578 * MiB;
constexpr size_t WS_END = WS_ACT + 145 * MiB;
constexpr size_t PQG = WS_ACT;
constexpr size_t PQM = WS_ACT + 32 * MiB;
constexpr size_t PKM = WS_ACT + 64 * MiB;
constexpr size_t PKD = WS_ACT + 96 * MiB;
constexpr size_t PDEC = WS_ACT + 132 * MiB;
constexpr size_t WS_T0 = WS_END;
constexpr size_t T_CNT = WS_T0;
constexpr size_t T_MASK = T_CNT + 65536;
constexpr size_t T_TOKW = T_MASK + 131072;
constexpr size_t T_TOKSLOT = T_TOKW + 524288;
constexpr size_t T_SLOTTOK = T_TOKSLOT + 524288;
constexpr size_t T_SLOTW = T_SLOTTOK + 655360;
constexpr size_t T_TILE = T_SLOTW + 655360;
constexpr size_t WS_NEED = T_TILE + 16384;

constexpr int RING_BYTES = 131072;
constexpr int LDS_BYTES = 147456;
constexpr int LDS_MISC = LDS_BYTES - 256;
constexpr int RT_ROWB = 4112;
constexpr int RT_HI = 0, RT_LO = 16 * RT_ROWB;
constexpr int LDS_LOGIT = 2 * 16 * RT_ROWB;
constexpr int LDS_MASKS = LDS_LOGIT + 4096;
static_assert(LDS_MASKS + 512 <= LDS_MISC, "LDS map");

#define LDS_WAIT() asm volatile("s_waitcnt lgkmcnt(0)" ::: "memory")
#define VM_WAIT() asm volatile("s_waitcnt vmcnt(0)" ::: "memory")

__device__ __forceinline__ unsigned f2bf(float f) { unsigned u = __builtin_bit_cast(unsigned, f); return (u + 0x7fffu + ((u >> 16) & 1u)) >> 16; }
__device__ __forceinline__ unsigned pk2(float lo, float hi) { return f2bf(lo) | (f2bf(hi) << 16); }
__device__ __forceinline__ float bflo(unsigned u) { return __builtin_bit_cast(float, u << 16); }
__device__ __forceinline__ float bfhi(unsigned u) { return __builtin_bit_cast(float, u & 0xffff0000u); }
__device__ __forceinline__ float bf1(bf16 b) { return __builtin_bit_cast(float, ((unsigned)b) << 16); }
__device__ __forceinline__ float wave_sum(float v) {
#pragma unroll
    for (int o = 1; o < 64; o <<= 1) v += __shfl_xor(v, o);
    return v;
}
__device__ __forceinline__ float silu_f(float x) { return x / (1.f + __expf(-x)); }

#define XB_TMO      128
#define XB_XCNT(j)  (256  + 64 * (j))
#define XB_XSUB(j)  (1280 + 64 * (j))
#define XB_XGEN(j)  (2304 + 64 * (j))
#define XB_TOP      3328
#define XB_TOPGEN   3392
#define XCD_BAR_WORDS 3456
#define XB_SPIN_CAP (1u << 18)

__device__ __forceinline__ unsigned xb_ld(unsigned* p)              { return __hip_atomic_load(p, __ATOMIC_RELAXED, __HIP_MEMORY_SCOPE_AGENT); }
__device__ __forceinline__ unsigned xb_add(unsigned* p, unsigned v) { return __hip_atomic_fetch_add(p, v, __ATOMIC_RELAXED, __HIP_MEMORY_SCOPE_AGENT); }
__device__ __forceinline__ unsigned xb_xcc_id() { return (unsigned)__builtin_amdgcn_s_getreg((3 << 11) | 20) & 0xFu; }
#define XB_SPIN(cond, bar) do { unsigned _sp = 0; while (cond) { __builtin_amdgcn_s_sleep(1); \
    if ((++_sp & 255u) == 0u) { if (xb_ld(&(bar)[XB_TMO])) break; if (_sp > XB_SPIN_CAP) { atomicAdd(&(bar)[XB_TMO], 1u); break; } } } } while (0)

struct XcdBarrier { unsigned* bar; unsigned x; volatile LAS unsigned* st; };

__device__ __forceinline__ XcdBarrier xcd_barrier_post(unsigned* bar, volatile LAS unsigned* st) {
    XcdBarrier b; b.bar = bar; b.x = xb_xcc_id(); b.st = st;
    if (threadIdx.x == 0) (void)xb_add(&bar[XB_XCNT(b.x)], 1u);
    return b;
}
__device__ __forceinline__ void xcd_barrier_complete(unsigned* bar, unsigned x, unsigned& nloc, unsigned& nx) {
    const unsigned G = gridDim.x * gridDim.y * gridDim.z;
    unsigned sum, cnt, mine, sp = 0u;
    for (;;) {
        sum = 0u; cnt = 0u; mine = 0u;
#pragma unroll
        for (unsigned j = 0; j < 16; ++j) { const unsigned c = xb_ld(&bar[XB_XCNT(j)]); sum += c; cnt += (c > 0u) ? 1u : 0u; mine = (j == x) ? c : mine; }
        if (sum == G) break;
        __builtin_amdgcn_s_sleep(1);
        if ((++sp & 255u) == 0u) { if (xb_ld(&bar[XB_TMO])) break; if (sp > XB_SPIN_CAP) { atomicAdd(&bar[XB_TMO], 1u); break; } }
    }
    nloc = mine > 0u ? mine : 1u; nx = cnt > 0u ? cnt : 1u;
}
__device__ __forceinline__ void xcd_barrier(const XcdBarrier& b) {
    asm volatile("s_waitcnt vmcnt(0)" ::: "memory");
    __syncthreads();
    if (threadIdx.x == 0) {
        unsigned* bar = b.bar;
        __builtin_amdgcn_s_waitcnt(0);
        unsigned nloc = b.st[0], nx = b.st[1];
        if (nloc == 0u) { xcd_barrier_complete(bar, b.x, nloc, nx); b.st[0] = nloc; b.st[1] = nx; }
        const unsigned old = xb_add(&bar[XB_XSUB(b.x)], 1u);
        const unsigned gen = old / nloc;
        if (old + 1u == (gen + 1u) * nloc) {
            __builtin_amdgcn_fence(__ATOMIC_RELEASE, "agent");
            asm volatile("s_waitcnt vmcnt(0)" ::: "memory");
            const unsigned og = xb_add(&bar[XB_TOP], 1u);
            const unsigned tg = og / nx;
            if (og + 1u == (tg + 1u) * nx) xb_add(&bar[XB_TOPGEN], 1u);
            else XB_SPIN(xb_ld(&bar[XB_TOPGEN]) == tg, bar);
            __builtin_amdgcn_fence(__ATOMIC_ACQUIRE, "agent");
            xb_add(&bar[XB_XGEN(b.x)], 1u);
            asm volatile("s_waitcnt vmcnt(0)" ::: "memory");
        } else {
            XB_SPIN(xb_ld(&bar[XB_XGEN(b.x)]) == gen, bar);
            __builtin_amdgcn_fence(__ATOMIC_ACQUIRE, "agent");
            asm volatile("s_waitcnt vmcnt(0)" ::: "memory");
        }
    }
    __syncthreads();
}

namespace pg8 {
constexpr int BM = 256, BK = 64, HALF = 128, HTB = HALF * BK * 2, STAGE_BYTES = 8 * HTB, NXCD = 8, WGM = 8;
__device__ __forceinline__ int lds_byte(int r, int c) { const int st = (r >> 4) * 2 + (c >> 5), rr = r & 15, cc = c & 31, ob = rr * 64 + cc * 2; return st * 1024 + (ob ^ (((ob >> 9) & 1) << 5)); }
__device__ __forceinline__ void stage_rc(int b, int& R, int& C) { const int st = b / 1024, sb = b % 1024, swz = sb ^ (((sb >> 9) & 1) << 5); R = (st >> 1) * 16 + swz / 64; C = (st & 1) * 32 + (swz % 64) / 2; }
__device__ __forceinline__ int perm32(int rho) { const int n = rho >> 4, i = rho & 15; return 8 * (i >> 2) + 4 * n + (i & 3); }
__device__ __forceinline__ unsigned cvt_pk_bf16(float lo, float hi) { unsigned r; asm volatile("v_cvt_pk_bf16_f32 %0, %1, %2" : "=v"(r) : "v"(lo), "v"(hi)); return r; }

template <class Epi, class Sched>
__device__ __forceinline__ void gemm_phase(LAS unsigned char* lds, const int K, const Sched& S, const Epi& E) {
    typedef typename Sched::U Unit;
    const int tid = threadIdx.x, wid = __builtin_amdgcn_readfirstlane(tid >> 6), lane = tid & 63, wr = wid >> 2, wc = wid & 3, fr = lane & 15, fq = lane >> 4;
    const int nt = K / BK;
    int R[2], C[2]; unsigned voffB[2];
#pragma unroll
    for (int i = 0; i < 2; ++i) { stage_rc(tid * 16 + i * 8192, R[i], C[i]); const int Rb = Epi::PERM ? ((R[i] & ~31) + perm32(R[i] & 31)) : R[i];
        voffB[i] = (unsigned)(Rb * K + C[i]) * 2u; }
    const size_t kstep = (size_t)(BK * 2);
    const size_t hstepB = (size_t)HALF * K * 2;
    const unsigned ldsw = (unsigned)wid * 1024u;
    const int aoff = lds_byte(wr * 64 + fr, fq * 8), boff = lds_byte(wc * 32 + fr, fq * 8);
#define PG8_SA(b, h) (((b) * 2 + (h)) * HTB)
#define PG8_SB(b, h) ((4 + (b) * 2 + (h)) * HTB)
#define PG8_STAGE(bufoff, gbase, v0, v1) do { \
        __builtin_amdgcn_global_load_lds((const unsigned*)((const char*)(gbase) + (v0)), (LAS unsigned*)(lds + (bufoff) + ldsw), 16, 0, 0); \
        __builtin_amdgcn_global_load_lds((const unsigned*)((const char*)(gbase) + (v1)), (LAS unsigned*)(lds + (bufoff) + ldsw + 8192), 16, 0, 0); } while (0)
#define PG8_LDA(dst, b, h) do { _Pragma("unroll") for (int m = 0; m < 4; ++m) _Pragma("unroll") for (int k = 0; k < 2; ++k) dst[m][k] = *(const LAS bf16x8*)(lds + PG8_SA(b, h) + aoff + m * 2048 + k * 1024); } while (0)
#define PG8_LDB(dst, b, h) do { _Pragma("unroll") for (int n = 0; n < 2; ++n) _Pragma("unroll") for (int k = 0; k < 2; ++k) dst[n][k] = *(const LAS bf16x8*)(lds + PG8_SB(b, h) + boff + n * 2048 + k * 1024); } while (0)
#define PG8_MMA(ai, bj, At, Bt) do { __builtin_amdgcn_s_setprio(1); _Pragma("unroll") for (int m = 0; m < 4; ++m) _Pragma("unroll") for (int n = 0; n < 2; ++n) _Pragma("unroll") for (int k = 0; k < 2; ++k) \
        acc[ai][bj][m][n] = __builtin_amdgcn_mfma_f32_16x16x32_bf16(Bt[n][k], At[m][k], acc[ai][bj][m][n], 0, 0, 0); __builtin_amdgcn_s_setprio(0); } while (0)
#define PG8_WAIT_V(n) asm volatile("s_waitcnt vmcnt(" #n ")" ::: "memory")
#define PG8_WAIT_L(n) asm volatile("s_waitcnt lgkmcnt(" #n ")" ::: "memory")
#define PG8_BAR __builtin_amdgcn_s_barrier()
#define PG8_SCHED __builtin_amdgcn_sched_barrier(0)
    Unit cur, nxt; int ui = 0;
    if (!S.next(0, cur)) return;
    f32x4 acc[2][2][4][2];
#pragma unroll
    for (int a = 0; a < 2; ++a)
#pragma unroll
        for (int b = 0; b < 2; ++b)
#pragma unroll
            for (int m = 0; m < 4; ++m)
#pragma unroll
                for (int n = 0; n < 2; ++n) acc[a][b][m][n] = (f32x4){0.f, 0.f, 0.f, 0.f};
    bf16x8 At[4][2], B0[2][2], B1[2][2];
    unsigned vA[4], vN[4];
    S.aoffs(cur, R, C, vA);
    const char* cA = cur.A; const char* cB = cur.B;
    PG8_STAGE(PG8_SB(0, 0), cB, voffB[0], voffB[1]); PG8_STAGE(PG8_SB(0, 1), cB + hstepB, voffB[0], voffB[1]); PG8_STAGE(PG8_SA(0, 0), cA, vA[0], vA[1]); PG8_STAGE(PG8_SA(0, 1), cA, vA[2], vA[3]);
    if (wr == 1) PG8_BAR;
    PG8_WAIT_V(2); PG8_BAR;
    PG8_STAGE(PG8_SB(1, 0), cB + kstep, voffB[0], voffB[1]); PG8_STAGE(PG8_SA(1, 0), cA + kstep, vA[0], vA[1]); PG8_STAGE(PG8_SB(1, 1), cB + hstepB + kstep, voffB[0], voffB[1]);
    PG8_WAIT_V(6); PG8_BAR;
    for (;;) {
        const bool has_next = S.next(ui + 1, nxt);
        const char* nA = has_next ? nxt.A : cA; const char* nB = has_next ? nxt.B : cB;
        if (has_next) S.aoffs(nxt, R, C, vN); else { vN[0] = vA[0]; vN[1] = vA[1]; vN[2] = vA[2]; vN[3] = vA[3]; }
        for (int t = 0; t < nt; t += 2) {
            const bool last = (t == nt - 2);
            const char* a1 = cA + (size_t)(t + 1) * kstep;
            const char* a2 = last ? nA : cA + (size_t)(t + 2) * kstep; const char* b2 = last ? nB : cB + (size_t)(t + 2) * kstep;
            const char* a3 = a2 + kstep; const char* b3 = b2 + kstep;
            const unsigned x0 = last ? vN[0] : vA[0], x1 = last ? vN[1] : vA[1], x2 = last ? vN[2] : vA[2], x3 = last ? vN[3] : vA[3];
            PG8_LDB(B0, 0, 0); PG8_LDB(B1, 0, 1); PG8_SCHED; PG8_LDA(At, 0, 0); PG8_STAGE(PG8_SA(1, 1), a1, vA[2], vA[3]);
            PG8_WAIT_V(8); PG8_WAIT_L(0); PG8_BAR; PG8_MMA(0, 0, At, B0); PG8_MMA(0, 1, At, B1); PG8_BAR; PG8_SCHED;
            PG8_LDA(At, 0, 1); PG8_STAGE(PG8_SB(0, 0), b2, voffB[0], voffB[1]); PG8_STAGE(PG8_SB(0, 1), b2 + hstepB, voffB[0], voffB[1]); PG8_STAGE(PG8_SA(0, 0), a2, x0, x1);
            PG8_WAIT_V(8); PG8_WAIT_L(0); PG8_BAR; PG8_MMA(1, 0, At, B0); PG8_MMA(1, 1, At, B1); PG8_BAR; PG8_SCHED;
            PG8_LDB(B0, 1, 0); PG8_LDB(B1, 1, 1); PG8_SCHED; PG8_LDA(At, 1, 0); PG8_STAGE(PG8_SA(0, 1), a2, x2, x3);
            PG8_WAIT_V(8); PG8_WAIT_L(0); PG8_BAR; PG8_MMA(0, 0, At, B0); PG8_MMA(0, 1, At, B1); PG8_BAR; PG8_SCHED;
            PG8_LDA(At, 1, 1); PG8_STAGE(PG8_SB(1, 0), b3, voffB[0], voffB[1]); PG8_STAGE(PG8_SB(1, 1), b3 + hstepB, voffB[0], voffB[1]); PG8_STAGE(PG8_SA(1, 0), a3, x0, x1);
            PG8_WAIT_V(8); PG8_WAIT_L(0); PG8_BAR; PG8_MMA(1, 0, At, B0); PG8_MMA(1, 1, At, B1); PG8_BAR; PG8_SCHED;
        }
        if (wr == 0) PG8_BAR;
        E(acc, cur, wr, wc, fr, fq);
        if (!has_next) break;
#pragma unroll
        for (int a = 0; a < 2; ++a)
#pragma unroll
            for (int b = 0; b < 2; ++b)
#pragma unroll
                for (int m = 0; m < 4; ++m)
#pragma unroll
                    for (int n = 0; n < 2; ++n) acc[a][b][m][n] = (f32x4){0.f, 0.f, 0.f, 0.f};
        cur = nxt; cA = nA; cB = nB; ++ui;
        vA[0] = vN[0]; vA[1] = vN[1]; vA[2] = vN[2]; vA[3] = vN[3];
        if (wr == 1) PG8_BAR;
    }
    PG8_WAIT_V(0);
    PG8_BAR;
#undef PG8_SA
#undef PG8_SB
#undef PG8_STAGE
#undef PG8_LDA
#undef PG8_LDB
#undef PG8_MMA
#undef PG8_WAIT_V
#undef PG8_WAIT_L
#undef PG8_BAR
#undef PG8_SCHED
}
}

struct Args { const float* in[27]; float* out; unsigned char* ws; int ph_lo, ph_hi; };
static_assert(sizeof(Args) == 27 * 8 + 8 + 8 + 8, "Args has no padding");

struct DenseU { const char* A; const char* B; int pm, pn; };
struct DenseSched {
    typedef DenseU U;
    const char* A; const char* B; int lda, K, nM, nN, nwg, G, c;
    __device__ __forceinline__ void init(const void* A_, const void* B_, int lda_, int K_, int M, int N, int G_, int c_) { A = (const char*)A_; B = (const char*)B_; lda = lda_; K = K_; nM = M / 256; nN = N / 256; nwg = nM * nN; G = G_; c = c_; }
    __device__ __forceinline__ bool next(int i, U& u) const {
        const long L = (long)i * G + c; if (L >= nwg) return false;
        int wgid = (int)L; { const int q = nwg / 8, r = nwg % 8, xcd = wgid % 8, off = wgid / 8; wgid = (xcd < r ? xcd * (q + 1) : r * (q + 1) + (xcd - r) * q) + off; }
        const int nig = 8 * nN, gid = wgid / nig, fm = gid * 8, gsz = (nM - fm) < 8 ? (nM - fm) : 8;
        u.pm = fm + ((wgid % nig) % gsz); u.pn = (wgid % nig) / gsz;
        u.A = A + (size_t)u.pm * 256 * lda * 2; u.B = B + (size_t)u.pn * 256 * K * 2; return true;
    }
    __device__ __forceinline__ void aoffs(const U&, const int (&R)[2], const int (&C)[2], unsigned (&v)[4]) const {
#pragma unroll
        for (int h = 0; h < 2; ++h)
#pragma unroll
            for (int i = 0; i < 2; ++i) v[h * 2 + i] = (unsigned)((h * 128 + R[i]) * lda + C[i]) * 2u;
    }
};
struct PoolU { const char* A; const char* B; int pm, g; };
struct PoolSched {
    typedef PoolU U;
    const char* A; const char* B; int G, c;
    __device__ __forceinline__ bool next(int i, U& u) const {
        const int L = i * G + c; if (L >= 256) return false;
        u.g = L & 3; u.pm = L >> 2;
        u.A = A + ((size_t)u.pm * 256 * 1024 + u.g * 256) * 2; u.B = B + (size_t)u.g * 256 * 256 * 2; return true;
    }
    __device__ __forceinline__ void aoffs(const U&, const int (&R)[2], const int (&C)[2], unsigned (&v)[4]) const {
#pragma unroll
        for (int h = 0; h < 2; ++h)
#pragma unroll
            for (int i = 0; i < 2; ++i) v[h * 2 + i] = (unsigned)((h * 128 + R[i]) * 1024 + C[i]) * 2u;
    }
};
struct MoeU { const char* A; const char* B; int row0, nrows, pn; };
struct MoeGUSched {
    typedef MoeU U;
    const char* H2; const char* W; const int* tile; const int* slot_tok; int G, c;
    __device__ __forceinline__ bool next(int i, U& u) const {
        const int nt = tile[3 * NTILE_MAX]; const int L = i * G + c; if (L >= nt * 4) return false;
        const int t = L >> 2; u.pn = L & 3; const int e = tile[t]; u.row0 = tile[NTILE_MAX + t]; u.nrows = tile[2 * NTILE_MAX + t];
        u.A = H2; u.B = W + ((size_t)e * 1024 + u.pn * 256) * 2048 * 2; return true;
    }
    __device__ __forceinline__ void aoffs(const U& u, const int (&R)[2], const int (&C)[2], unsigned (&v)[4]) const {
#pragma unroll
        for (int h = 0; h < 2; ++h)
#pragma unroll
            for (int i = 0; i < 2; ++i) { int r = h * 128 + R[i]; r = r < u.nrows ? r : u.nrows - 1; const int tok = slot_tok[u.row0 + r]; v[h * 2 + i] = (unsigned)(tok * 2048 + C[i]) * 2u; }
    }
};
struct MoeDownSched {
    typedef MoeU U;
    const char* ACT; const char* W; const int* tile; int G, c;
    __device__ __forceinline__ bool next(int i, U& u) const {
        const int nt = tile[3 * NTILE_MAX]; const int L = i * G + c; if (L >= nt * 8) return false;
        const int t = L >> 3; u.pn = L & 7; const int e = tile[t]; u.row0 = tile[NTILE_MAX + t]; u.nrows = tile[2 * NTILE_MAX + t];
        u.A = ACT + (size_t)u.row0 * 512 * 2; u.B = W + ((size_t)e * 2048 + u.pn * 256) * 512 * 2; return true;
    }
    __device__ __forceinline__ void aoffs(const U&, const int (&R)[2], const int (&C)[2], unsigned (&v)[4]) const {
#pragma unroll
        for (int h = 0; h < 2; ++h)
#pragma unroll
            for (int i = 0; i < 2; ++i) v[h * 2 + i] = (unsigned)((h * 128 + R[i]) * 512 + C[i]) * 2u;
    }
};

struct EpiIn {
    static constexpr bool PERM = true;
    unsigned char* ws;
    __device__ __forceinline__ void operator()(const f32x4 (&acc)[2][2][4][2], const DenseU& u, int wr, int wc, int fr, int fq) const {
        const int pn = u.pn; const int row0 = u.pm * 256 + wr * 64 + fr;
        if (pn == 16) {
            if (wc != 0) return;
            float* alr = (float*)(ws + RA_ALR);
#pragma unroll
            for (int ai = 0; ai < 2; ++ai)
#pragma unroll
                for (int m = 0; m < 4; ++m) { float* rp = alr + (size_t)(row0 + ai * 128 + m * 16) * 32 + 8 * fq;
                    *(f32x4*)(rp) = acc[ai][0][m][0]; *(f32x4*)(rp + 4) = acc[ai][0][m][1]; }
            return;
        }
        bf16* base; int ld, colt; bool lat_only;
        if (pn < 2) { base = (bf16*)(ws + RA_Q); ld = 512; colt = pn * 256; lat_only = true; }
        else if (pn < 4) { base = (bf16*)(ws + RA_K); ld = 512; colt = (pn - 2) * 256; lat_only = false; }
        else if (pn < 8) { base = (bf16*)(ws + RA_V); ld = 1024; colt = (pn - 4) * 256; lat_only = false; }
        else if (pn < 12) { base = (bf16*)(ws + RA_R); ld = 1024; colt = (pn - 8) * 256; lat_only = true; }
        else { base = (bf16*)(ws + RA_P); ld = 1024; colt = (pn - 12) * 256; lat_only = true; }
        if (lat_only && u.pm >= 64) return;
        const int col0 = colt + wc * 32 + 8 * fq;
#pragma unroll
        for (int ai = 0; ai < 2; ++ai)
#pragma unroll
            for (int m = 0; m < 4; ++m) { bf16* rp = base + (size_t)(row0 + ai * 128 + m * 16) * ld + col0;
#pragma unroll
                for (int bj = 0; bj < 2; ++bj) { const f32x4 v0 = acc[ai][bj][m][0], v1 = acc[ai][bj][m][1];
                    v4u o; o.x = pg8::cvt_pk_bf16(v0[0], v0[1]); o.y = pg8::cvt_pk_bf16(v0[2], v0[3]); o.z = pg8::cvt_pk_bf16(v1[0], v1[1]); o.w = pg8::cvt_pk_bf16(v1[2], v1[3]);
                    *(v4u*)(rp + bj * 128) = o; } }
    }
};
struct EpiPool {
    static constexpr bool PERM = true;
    bf16* ymix; const float* scale;
    __device__ __forceinline__ void operator()(const f32x4 (&acc)[2][2][4][2], const PoolU& u, int wr, int wc, int fr, int fq) const {
        const int row0 = u.pm * 256 + wr * 64 + fr; const int c0 = u.g * 256 + wc * 32 + 8 * fq;
#pragma unroll
        for (int ai = 0; ai < 2; ++ai)
#pragma unroll
            for (int m = 0; m < 4; ++m) { bf16* rp = ymix + (size_t)(row0 + ai * 128 + m * 16) * 2048 + 1024 + c0;
#pragma unroll
                for (int bj = 0; bj < 2; ++bj) { const f32x4 s0 = *(const f32x4*)(scale + c0 + bj * 128), s1 = *(const f32x4*)(scale + c0 + bj * 128 + 4);
                    const f32x4 v0 = acc[ai][bj][m][0] * s0, v1 = acc[ai][bj][m][1] * s1;
                    v4u o; o.x = pg8::cvt_pk_bf16(v0[0], v0[1]); o.y = pg8::cvt_pk_bf16(v0[2], v0[3]); o.z = pg8::cvt_pk_bf16(v1[0], v1[1]); o.w = pg8::cvt_pk_bf16(v1[2], v1[3]);
                    *(v4u*)(rp + bj * 128) = o; } }
    }
};
struct EpiOut {
    static constexpr bool PERM = false;
    float* y;
    __device__ __forceinline__ void operator()(const f32x4 (&acc)[2][2][4][2], const DenseU& u, int wr, int wc, int fr, int fq) const {
        const int row0 = u.pm * 256 + wr * 64 + fr, col0 = u.pn * 256 + wc * 32 + 4 * fq;
#pragma unroll
        for (int ai = 0; ai < 2; ++ai)
#pragma unroll
            for (int m = 0; m < 4; ++m) { float* rp = y + (size_t)(row0 + ai * 128 + m * 16) * 2048 + col0;
#pragma unroll
                for (int bj = 0; bj < 2; ++bj)
#pragma unroll
                    for (int n = 0; n < 2; ++n) *(f32x4*)(rp + bj * 128 + n * 16) = acc[ai][bj][m][n]; }
    }
};
struct EpiGU {
    static constexpr bool PERM = true;
    bf16* act; const float* slot_w;
    __device__ __forceinline__ void operator()(const f32x4 (&acc)[2][2][4][2], const MoeU& u, int wr, int wc, int fr, int fq) const {
        const int c0 = u.pn * 128 + wc * 32 + 8 * fq;
#pragma unroll
        for (int ai = 0; ai < 2; ++ai)
#pragma unroll
            for (int m = 0; m < 4; ++m) { const int r = ai * 128 + wr * 64 + m * 16 + fr;
                if (r < u.nrows) { const float w = slot_w[u.row0 + r]; float o[8];
#pragma unroll
                    for (int n = 0; n < 2; ++n)
#pragma unroll
                        for (int j = 0; j < 4; ++j) { const float g = acc[ai][0][m][n][j], up = acc[ai][1][m][n][j]; o[n * 4 + j] = silu_f(g) * up * w; }
                    v4u q; q.x = pg8::cvt_pk_bf16(o[0], o[1]); q.y = pg8::cvt_pk_bf16(o[2], o[3]); q.z = pg8::cvt_pk_bf16(o[4], o[5]); q.w = pg8::cvt_pk_bf16(o[6], o[7]);
                    *(v4u*)(act + (size_t)(u.row0 + r) * 512 + c0) = q; } }
    }
};
struct EpiDown {
    static constexpr bool PERM = true;
    bf16* so;
    __device__ __forceinline__ void operator()(const f32x4 (&acc)[2][2][4][2], const MoeU& u, int wr, int wc, int fr, int fq) const {
        const int c0 = u.pn * 256 + wc * 32 + 8 * fq;
#pragma unroll
        for (int ai = 0; ai < 2; ++ai)
#pragma unroll
            for (int m = 0; m < 4; ++m) { const int r = ai * 128 + wr * 64 + m * 16 + fr;
                if (r < u.nrows) { bf16* rp = so + (size_t)(u.row0 + r) * 2048 + c0;
#pragma unroll
                    for (int bj = 0; bj < 2; ++bj) { const f32x4 v0 = acc[ai][bj][m][0], v1 = acc[ai][bj][m][1];
                        v4u o; o.x = pg8::cvt_pk_bf16(v0[0], v0[1]); o.y = pg8::cvt_pk_bf16(v0[2], v0[3]); o.z = pg8::cvt_pk_bf16(v1[0], v1[1]); o.w = pg8::cvt_pk_bf16(v1[2], v1[3]);
                        *(v4u*)(rp + bj * 128) = o; } } }
    }
};

__device__ __forceinline__ void tr_item(const float* W, int ldn, bf16* WT, int Kd, int drow0, int k0, int n0, LAS float* scr, int lane) {
#pragma unroll 8
    for (int i = 0; i < 32; ++i) { const int kk = 2 * i + (lane >> 5); scr[kk * 33 + (lane & 31)] = W[(size_t)(k0 + kk) * ldn + n0 + (lane & 31)]; }
    LDS_WAIT(); asm volatile("" ::: "memory");
    const int c = lane & 7;
#pragma unroll
    for (int j = 0; j < 4; ++j) { const int n = (lane >> 3) + 8 * j; const LAS float* s = scr + (8 * c) * 33 + n;
        v4u o; o.x = pk2(s[0 * 33], s[1 * 33]); o.y = pk2(s[2 * 33], s[3 * 33]); o.z = pk2(s[4 * 33], s[5 * 33]); o.w = pk2(s[6 * 33], s[7 * 33]);
        *(v4u*)(WT + (size_t)(drow0 + n) * Kd + k0 + 8 * c) = o; }
    LDS_WAIT(); asm volatile("" ::: "memory");
}

__device__ __forceinline__ void phase0(const Args& a, LAS unsigned char* lds, int tid, int lane, int wave, int vcu, int G) {
    unsigned char* ws = a.ws;
    if (vcu < 192) {
        LAS float* sc = (LAS float*)lds;
        LAS float* red = (LAS float*)(lds + 73728);
        for (int i = tid; i < 9 * 2048; i += 512) { const int r = i >> 11, k = i & 2047; const float v = r < 8 ? a.in[1][r * 2048 + k] : a.in[3][k]; sc[i] = silu_f(v); }
        __syncthreads();
        const float* wm = a.in[4]; const float* bm = a.in[5]; float* mod = (float*)(ws + WS_MOD);
        for (int chunk = vcu; chunk < 192; chunk += G) {
            const int n0 = chunk * 64, ks = lane >> 4, n4 = (lane & 15) * 4;
            f32x4 acc[9];
#pragma unroll
            for (int r = 0; r < 9; ++r) acc[r] = (f32x4){0.f, 0.f, 0.f, 0.f};
#pragma unroll 4
            for (int kk = 0; kk < 256; kk += 4) { const int k = wave * 256 + kk + ks; const f32x4 wv = *(const f32x4*)(wm + (size_t)k * 12288 + n0 + n4);
#pragma unroll
                for (int r = 0; r < 9; ++r) { const float s = sc[r * 2048 + k]; acc[r] += wv * s; } }
#pragma unroll
            for (int r = 0; r < 9; ++r)
#pragma unroll
                for (int j = 0; j < 4; ++j) { float v = acc[r][j]; v += __shfl_xor(v, 16); v += __shfl_xor(v, 32); acc[r][j] = v; }
            if (lane < 16) {
#pragma unroll
                for (int r = 0; r < 9; ++r) *(LAS f32x4*)(red + (wave * 9 + r) * 64 + n4) = acc[r]; }
            __syncthreads();
            for (int i = tid; i < 9 * 64; i += 512) { const int r = i >> 6, n = i & 63; float s = 0.f;
#pragma unroll
                for (int w = 0; w < 8; ++w) s += red[(w * 9 + r) * 64 + n];
                mod[r * 12288 + n0 + n] = s + bm[n0 + n]; }
            __syncthreads();
        }
    }
    __syncthreads();
    LAS float* scr = (LAS float*)(lds + wave * 16384);
    const int gw = vcu * 8 + wave, NGW = G * 8;
    bf16* Win_t = (bf16*)(ws + WS_WIN); bf16* Wout_t = (bf16*)(ws + WS_WOUT); bf16* Wpool_t = (bf16*)(ws + WS_WPOOL); bf16* Wd_t = (bf16*)(ws + WS_WD); bf16* Wgu_t = (bf16*)(ws + WS_WGU);
    constexpr int I_IN = 32 * 129, I_OUT = 32 * 64, I_POOL = 4 * 4 * 8, I_E = 65 * 512;
    constexpr int NITEMS = I_IN + I_OUT + I_POOL + 3 * I_E;
    for (int it = gw; it < NITEMS; it += NGW) {
        int r = it;
        if (r < I_IN) { const int kb = r / 129, nb = r % 129, n0 = 32 * nb; const int drow = n0 < 3072 ? n0 : (n0 == 3072 ? 4096 : n0 - 32);
            tr_item(a.in[10], DIN, Win_t, 2048, drow, 64 * kb, n0, scr, lane); continue; } r -= I_IN;
        if (r < I_OUT) { const int kb = r / 64, nb = r % 64; tr_item(a.in[18], 2048, Wout_t, 2048, 32 * nb, 64 * kb, 32 * nb, scr, lane); continue; } r -= I_OUT;
        if (r < I_POOL) { const int g = r / 32, rr = r % 32, kb = rr / 8, nb = rr % 8; tr_item(a.in[16] + g * 65536, 256, Wpool_t + g * 65536, 256, 32 * nb, 64 * kb, 32 * nb, scr, lane); continue; } r -= I_POOL;
        if (r < I_E) { const int e = r / 512, rr = r % 512, kb = rr / 16, nb = rr % 16, n0 = 32 * nb; const float* src = e < 64 ? a.in[21] + (size_t)e * 2048 * 512 : a.in[24];
            tr_item(src, 512, Wgu_t + (size_t)e * 1024 * 2048, 2048, (n0 / 128) * 256 + (n0 % 128), 64 * kb, n0, scr, lane); continue; } r -= I_E;
        if (r < I_E) { const int e = r / 512, rr = r % 512, kb = rr / 16, nb = rr % 16, n0 = 32 * nb; const float* src = e < 64 ? a.in[22] + (size_t)e * 2048 * 512 : a.in[25];
            tr_item(src, 512, Wgu_t + (size_t)e * 1024 * 2048, 2048, (n0 / 128) * 256 + 128 + (n0 % 128), 64 * kb, n0, scr, lane); continue; } r -= I_E;
        { const int e = r / 512, rr = r % 512, kb = rr / 64, nb = rr % 64; const float* src = e < 64 ? a.in[23] + (size_t)e * 512 * 2048 : a.in[26];
            tr_item(src, 2048, Wd_t + (size_t)e * 2048 * 512, 512, 32 * nb, 64 * kb, 32 * nb, scr, lane); }
    }
    { const float* wr = a.in[19]; bf16* whi = (bf16*)(ws + WS_WRT); bf16* wlo = whi + 64 * 2048;
      for (int idx = vcu * 512 + tid; idx < 64 * 256; idx += G * 512) { const int e = idx >> 8, k8 = idx & 255; unsigned hi[8], lo[8];
#pragma unroll
          for (int j = 0; j < 8; ++j) { const float v = wr[(size_t)(8 * k8 + j) * 64 + e]; hi[j] = f2bf(v); lo[j] = f2bf(v - __builtin_bit_cast(float, hi[j] << 16)); }
          v4u oh, ol; oh.x = hi[0] | (hi[1] << 16); oh.y = hi[2] | (hi[3] << 16); oh.z = hi[4] | (hi[5] << 16); oh.w = hi[6] | (hi[7] << 16);
          ol.x = lo[0] | (lo[1] << 16); ol.y = lo[2] | (lo[3] << 16); ol.z = lo[4] | (lo[5] << 16); ol.w = lo[6] | (lo[7] << 16);
          *(v4u*)(whi + (size_t)e * 2048 + 8 * k8) = oh; *(v4u*)(wlo + (size_t)e * 2048 + 8 * k8) = ol; } }
    { v4u* z = (v4u*)(Win_t + (size_t)DIN * 2048); const int nz = (DINP - DIN) * 2048 / 8;
      for (int i = vcu * 512 + tid; i < nz; i += G * 512) z[i] = (v4u){0u, 0u, 0u, 0u}; }
}

__device__ __forceinline__ void phase1(const Args& a, int lane, int wave, int vcu, int G) {
    const float* mod = (const float*)(a.ws + WS_MOD); bf16* H = (bf16*)(a.ws + RA_H); const float* g = a.in[6];
    for (int m = vcu * 8 + wave; m < MROWS; m += G * 8) {
        const float* xr = m < NT ? a.in[0] + (size_t)m * 2048 : a.in[2] + (size_t)(m - NT) * 2048;
        const float* mr = mod + (size_t)(m < NT ? (m >> 11) : 8) * 12288;
        f32x4 v[8]; float ss = 0.f;
#pragma unroll
        for (int j = 0; j < 8; ++j) { v[j] = *(const f32x4*)(xr + 4 * (lane + 64 * j)); ss += v[j][0] * v[j][0] + v[j][1] * v[j][1] + v[j][2] * v[j][2] + v[j][3] * v[j][3]; }
        const float rstd = rsqrtf(wave_sum(ss) * (1.f / 2048.f) + EPS);
#pragma unroll
        for (int j = 0; j < 8; ++j) { const int c = 4 * (lane + 64 * j); const f32x4 gg = *(const f32x4*)(g + c), sh = *(const f32x4*)(mr + c), sc = *(const f32x4*)(mr + 2048 + c);
            const f32x4 o = v[j] * rstd * gg * (sc + 1.f) + sh;
            v2u q; q.x = pk2(o[0], o[1]); q.y = pk2(o[2], o[3]); *(v2u*)(H + (size_t)m * 2048 + c) = q; }
    }
}

__device__ __forceinline__ int scan_row(int b, int dir, int s) {
    if (s < 256) { const int tc = dir ? 255 - s : s; return NT + b * 256 + tc; }
    const int t0 = s - 256; return b * 2048 + (dir ? 2047 - t0 : t0);
}
__device__ __forceinline__ void phase3_prep(const Args& a, LAS unsigned char* lds, int tid, int vcu, int G) {
    unsigned char* ws = a.ws;
    const bf16* Q = (const bf16*)(ws + RA_Q); const bf16* Kb = (const bf16*)(ws + RA_K); const float* ALR = (const float*)(ws + RA_ALR);
    bf16* QG = (bf16*)(ws + PQG); bf16* QM = (bf16*)(ws + PQM); bf16* KM = (bf16*)(ws + PKM); bf16* KD = (bf16*)(ws + PKD); float* DEC = (float*)(ws + PDEC);
    LAS float* alr = (LAS float*)lds;
    const int col = tid, h = col >> 7, dk = col & 127;
    for (int item = vcu; item < 2 * 8 * 36; item += G) {
        const int ch = item % 36, b = (item / 36) & 7, dir = item / 288;
        if (tid < 256) { const int i = tid >> 2, r4 = (tid & 3) * 4; const int row = scan_row(b, dir, ch * 64 + i);
            *(LAS f32x4*)(alr + i * 16 + r4) = *(const f32x4*)(ALR + (size_t)row * 32 + dir * 16 + r4); }
        const float* wa2 = dir ? a.in[13] : a.in[11]; const float bia = (dir ? a.in[14] : a.in[12])[col];
        float w[16];
#pragma unroll
        for (int r = 0; r < 16; ++r) w[r] = wa2[r * 512 + col];
        __syncthreads();
        float Gc = 0.f, Gmid = 0.f;
#pragma unroll 4
        for (int i = 0; i < 64; ++i) { float z = bia;
#pragma unroll
            for (int r4 = 0; r4 < 4; ++r4) { const f32x4 x = *(const LAS f32x4*)(alr + i * 16 + 4 * r4); z += x[0] * w[4 * r4] + x[1] * w[4 * r4 + 1] + x[2] * w[4 * r4 + 2] + x[3] * w[4 * r4 + 3]; }
            Gc += (fminf(z, 0.f) - __logf(1.f + __expf(-fabsf(z)))) * (1.f / 16.f);
            if (i == 32) Gmid = Gc; }
        const float Gend = Gc;
        const bool lat = ch >= 4;
        DEC[((size_t)(dir * 8 + b) * 36 + ch) * 512 + col] = __expf(Gend);
        bf16* kdrow = KD + ((((size_t)(dir * 8 + b) * 36 + ch) * 4 + h) * 128 + dk) * 64;
        const size_t lt = lat ? ((((size_t)(dir * 8 + b) * 32 + (ch - 4)) * 4 + h) * 64) * 128 + dk : 0;
        Gc = 0.f;
#pragma unroll 1
        for (int i0 = 0; i0 < 64; i0 += 8) { unsigned kd[8]; float kv[8], qv[8];
#pragma unroll
            for (int ii = 0; ii < 8; ++ii) { const int row = scan_row(b, dir, ch * 64 + i0 + ii); kv[ii] = bf1(Kb[(size_t)row * 512 + col]); qv[ii] = lat ? bf1(Q[(size_t)row * 512 + col]) * 0.08838834764831845f : 0.f; }
#pragma unroll
            for (int ii = 0; ii < 8; ++ii) { const int i = i0 + ii; float z = bia;
#pragma unroll
                for (int r4 = 0; r4 < 4; ++r4) { const f32x4 x = *(const LAS f32x4*)(alr + i * 16 + 4 * r4); z += x[0] * w[4 * r4] + x[1] * w[4 * r4 + 1] + x[2] * w[4 * r4 + 2] + x[3] * w[4 * r4 + 3]; }
                Gc += (fminf(z, 0.f) - __logf(1.f + __expf(-fabsf(z)))) * (1.f / 16.f);
                kd[ii] = f2bf(kv[ii] * __expf(Gend - Gc));
                if (lat) { QG[lt + (size_t)i * 128] = (bf16)f2bf(qv[ii] * __expf(Gc)); QM[lt + (size_t)i * 128] = (bf16)f2bf(qv[ii] * __expf(Gc - Gmid)); KM[lt + (size_t)i * 128] = (bf16)f2bf(kv[ii] * __expf(Gmid - Gc)); } }
            v4u o; o.x = kd[0] | (kd[1] << 16); o.y = kd[2] | (kd[3] << 16); o.z = kd[4] | (kd[5] << 16); o.w = kd[6] | (kd[7] << 16);
            *(v4u*)(kdrow + i0) = o; }
        __syncthreads();
    }
}

constexpr int GL_QG = 0, GL_QM = 17408, GL_KM = 34816, GL_ST = 52224, GL_KDT = 69632, GL_VT = 88064, GL_AM = 97280, GL_DEC = 106496;
__device__ __forceinline__ void phase_chain(const Args& a, LAS unsigned char* lds, int tid, int lane, int wave, int vcu, int G) {
    unsigned char* ws = a.ws;
    const v4u* QG = (const v4u*)(ws + PQG); const v4u* QM = (const v4u*)(ws + PQM); const v4u* KM = (const v4u*)(ws + PKM); const v4u* KD = (const v4u*)(ws + PKD); const float* DEC = (const float*)(ws + PDEC);
    const bf16* V = (const bf16*)(ws + RA_V); float* OF = (float*)(ws + RA_OF);
    const int l15 = lane & 15, l4 = lane >> 4;
    for (int item = vcu; item < 256; item += G) {
        const int vs = item & 3, dir = (item >> 2) & 1, h = (item >> 3) & 3, b = item >> 5;
        f32x4 S[4];
#pragma unroll
        for (int tv = 0; tv < 4; ++tv) S[tv] = (f32x4){0.f, 0.f, 0.f, 0.f};
        v4u rq[6], rk[2], rv; float rdec = 0.f;
#define GL_LOAD(ch_) do { const int ch__ = (ch_); \
            if (ch__ >= 4) { const size_t t_ = ((((size_t)(dir * 8 + b) * 32 + (ch__ - 4)) * 4 + h) * 1024); \
                rq[0] = QG[t_ + tid]; rq[1] = QG[t_ + tid + 512]; rq[2] = QM[t_ + tid]; rq[3] = QM[t_ + tid + 512]; rq[4] = KM[t_ + tid]; rq[5] = KM[t_ + tid + 512]; } \
            { const size_t t_ = ((((size_t)(dir * 8 + b) * 36 + ch__) * 4 + h) * 1024); rk[0] = KD[t_ + tid]; rk[1] = KD[t_ + tid + 512]; } \
            { const int row_ = scan_row(b, dir, ch__ * 64 + (tid >> 3)); rv = *(const v4u*)(V + (size_t)row_ * 1024 + h * 256 + vs * 64 + 8 * (tid & 7)); } \
            if (tid < 128) rdec = DEC[((size_t)(dir * 8 + b) * 36 + ch__) * 512 + h * 128 + tid]; } while (0)
        GL_LOAD(0);
        for (int ch = 0; ch < 36; ++ch) {
            const bool lat = ch >= 4;
#pragma unroll
            for (int tv = 0; tv < 4; ++tv) { v2u p; p.x = pk2(S[tv][0], S[tv][1]); p.y = pk2(S[tv][2], S[tv][3]);
                *(LAS v2u*)(lds + GL_ST + (16 * tv + l15) * 272 + (16 * wave + 4 * l4) * 2) = p; }
            if (lat) {
#pragma unroll
                for (int q = 0; q < 2; ++q) { const int p = tid + 512 * q; const int off = (p >> 4) * 272 + (p & 15) * 16;
                    *(LAS v4u*)(lds + GL_QG + off) = rq[q]; *(LAS v4u*)(lds + GL_QM + off) = rq[2 + q]; *(LAS v4u*)(lds + GL_KM + off) = rq[4 + q]; } }
#pragma unroll
            for (int q = 0; q < 2; ++q) { const int p = tid + 512 * q; *(LAS v4u*)(lds + GL_KDT + (p >> 3) * 144 + (p & 7) * 16) = rk[q]; }
            { const int i = tid >> 3, c = tid & 7; LAS bf16* vt = (LAS bf16*)(lds + GL_VT) + i;
              vt[(8 * c + 0) * 72] = (bf16)(rv.x & 0xffffu); vt[(8 * c + 1) * 72] = (bf16)(rv.x >> 16); vt[(8 * c + 2) * 72] = (bf16)(rv.y & 0xffffu); vt[(8 * c + 3) * 72] = (bf16)(rv.y >> 16);
              vt[(8 * c + 4) * 72] = (bf16)(rv.z & 0xffffu); vt[(8 * c + 5) * 72] = (bf16)(rv.z >> 16); vt[(8 * c + 6) * 72] = (bf16)(rv.w & 0xffffu); vt[(8 * c + 7) * 72] = (bf16)(rv.w >> 16); }
            if (tid < 128) *(LAS float*)(lds + GL_DEC + tid * 4) = rdec;
            __syncthreads();
            if (ch + 1 < 36) GL_LOAD(ch + 1);
            if (lat) {
                { const int ti = wave >> 1; f32x4 c0 = (f32x4){0.f, 0.f, 0.f, 0.f}, c1 = c0; const int tj0 = (wave & 1) * 2;
#pragma unroll
                  for (int ks = 0; ks < 4; ++ks) { const int ko = (32 * ks + 8 * l4) * 2;
                      const bf16x8 bq = *(const LAS bf16x8*)(lds + GL_QM + (16 * ti + l15) * 272 + ko);
                      const bf16x8 a0 = *(const LAS bf16x8*)(lds + GL_KM + (16 * tj0 + l15) * 272 + ko), a1 = *(const LAS bf16x8*)(lds + GL_KM + (16 * tj0 + 16 + l15) * 272 + ko);
                      c0 = __builtin_amdgcn_mfma_f32_16x16x32_bf16(a0, bq, c0, 0, 0, 0); c1 = __builtin_amdgcn_mfma_f32_16x16x32_bf16(a1, bq, c1, 0, 0, 0); }
                  const int i = 16 * ti + l15;
                  { const int j0 = 16 * tj0 + 4 * l4; v2u p; p.x = pk2(j0 <= i ? c0[0] : 0.f, j0 + 1 <= i ? c0[1] : 0.f); p.y = pk2(j0 + 2 <= i ? c0[2] : 0.f, j0 + 3 <= i ? c0[3] : 0.f);
                    *(LAS v2u*)(lds + GL_AM + i * 144 + j0 * 2) = p; }
                  { const int j0 = 16 * tj0 + 16 + 4 * l4; v2u p; p.x = pk2(j0 <= i ? c1[0] : 0.f, j0 + 1 <= i ? c1[1] : 0.f); p.y = pk2(j0 + 2 <= i ? c1[2] : 0.f, j0 + 3 <= i ? c1[3] : 0.f);
                    *(LAS v2u*)(lds + GL_AM + i * 144 + j0 * 2) = p; } }
                __syncthreads();
                { const int ti = wave >> 1, tv0 = (wave & 1) * 2; f32x4 c0 = (f32x4){0.f, 0.f, 0.f, 0.f}, c1 = c0;
#pragma unroll
                  for (int ks = 0; ks < 4; ++ks) { const int ko = (32 * ks + 8 * l4) * 2;
                      const bf16x8 bq = *(const LAS bf16x8*)(lds + GL_QG + (16 * ti + l15) * 272 + ko);
                      const bf16x8 a0 = *(const LAS bf16x8*)(lds + GL_ST + (16 * tv0 + l15) * 272 + ko), a1 = *(const LAS bf16x8*)(lds + GL_ST + (16 * tv0 + 16 + l15) * 272 + ko);
                      c0 = __builtin_amdgcn_mfma_f32_16x16x32_bf16(a0, bq, c0, 0, 0, 0); c1 = __builtin_amdgcn_mfma_f32_16x16x32_bf16(a1, bq, c1, 0, 0, 0); }
#pragma unroll
                  for (int ks = 0; ks < 2; ++ks) { const int ko = (32 * ks + 8 * l4) * 2;
                      const bf16x8 bq = *(const LAS bf16x8*)(lds + GL_AM + (16 * ti + l15) * 144 + ko);
                      const bf16x8 a0 = *(const LAS bf16x8*)(lds + GL_VT + (16 * tv0 + l15) * 144 + ko), a1 = *(const LAS bf16x8*)(lds + GL_VT + (16 * tv0 + 16 + l15) * 144 + ko);
                      c0 = __builtin_amdgcn_mfma_f32_16x16x32_bf16(a0, bq, c0, 0, 0, 0); c1 = __builtin_amdgcn_mfma_f32_16x16x32_bf16(a1, bq, c1, 0, 0, 0); }
                  const int s = ch * 64 + 16 * ti + l15; const int t0 = s - 256; const int t = dir ? 2047 - t0 : t0;
                  float* orow = OF + ((size_t)dir * NT + b * 2048 + t) * 1024 + h * 256 + vs * 64 + 16 * tv0 + 4 * l4;
                  *(f32x4*)(orow) = c0; *(f32x4*)(orow + 16) = c1; }
            }
            { const f32x4 d4 = *(const LAS f32x4*)(lds + GL_DEC + (16 * wave + 4 * l4) * 4);
#pragma unroll
              for (int tv = 0; tv < 4; ++tv) S[tv] = S[tv] * d4;
#pragma unroll
              for (int ks = 0; ks < 2; ++ks) { const int ko = (32 * ks + 8 * l4) * 2;
                  const bf16x8 ak = *(const LAS bf16x8*)(lds + GL_KDT + (16 * wave + l15) * 144 + ko);
#pragma unroll
                  for (int tv = 0; tv < 4; ++tv) { const bf16x8 bv = *(const LAS bf16x8*)(lds + GL_VT + (16 * tv + l15) * 144 + ko);
                      S[tv] = __builtin_amdgcn_mfma_f32_16x16x32_bf16(ak, bv, S[tv], 0, 0, 0); } } }
            __syncthreads();
        }
#undef GL_LOAD
    }
}

template <int HALFW>
__device__ __forceinline__ void pool_item(const bf16* P, bf16* DP, LAS float* tmp, int tid, int b, int r, int g) {
    const int rlo = r - HALFW < 0 ? 0 : r - HALFW, rhi = r + HALFW > 32 ? 32 : r + HALFW;
    const float rinv = 1.f / (float)(rhi - rlo);
#pragma unroll 1
    for (int q = 0; q < 4; ++q) { const int p = tid + 512 * q, c = p >> 5, ch0 = (p & 31) * 8; float acc[8]; v4u x[2 * HALFW];
#pragma unroll
        for (int u = 0; u < 2 * HALFW; ++u) { const int rr = (rlo + u < rhi) ? rlo + u : rlo; x[u] = *(const v4u*)(P + ((size_t)(b * 2048 + rr * 64 + c)) * 1024 + g * 256 + ch0); }
#pragma unroll
        for (int j = 0; j < 8; ++j) acc[j] = 0.f;
#pragma unroll
        for (int u = 0; u < 2 * HALFW; ++u) { const float m = (rlo + u < rhi) ? 1.f : 0.f;
            acc[0] += m * bflo(x[u].x); acc[1] += m * bfhi(x[u].x); acc[2] += m * bflo(x[u].y); acc[3] += m * bfhi(x[u].y); acc[4] += m * bflo(x[u].z); acc[5] += m * bfhi(x[u].z); acc[6] += m * bflo(x[u].w); acc[7] += m * bfhi(x[u].w); }
        *(LAS f32x4*)(tmp + c * 256 + ch0) = (f32x4){acc[0] * rinv, acc[1] * rinv, acc[2] * rinv, acc[3] * rinv};
        *(LAS f32x4*)(tmp + c * 256 + ch0 + 4) = (f32x4){acc[4] * rinv, acc[5] * rinv, acc[6] * rinv, acc[7] * rinv}; }
    __syncthreads();
#pragma unroll 1
    for (int q = 0; q < 4; ++q) { const int p = tid + 512 * q, c = p >> 5, ch0 = (p & 31) * 8;
        const int clo = c - HALFW < 0 ? 0 : c - HALFW, chi = c + HALFW > 64 ? 64 : c + HALFW; const float cinv = 1.f / (float)(chi - clo);
        const size_t o = ((size_t)(b * 2048 + r * 64 + c)) * 1024 + g * 256 + ch0;
        const v4u x = *(const v4u*)(P + o);
        f32x4 a0 = (f32x4){0.f, 0.f, 0.f, 0.f}, a1 = a0;
#pragma unroll
        for (int u = 0; u < 2 * HALFW; ++u) { const int cc = (clo + u < chi) ? clo + u : clo; const float m = (clo + u < chi) ? 1.f : 0.f;
            a0 += *(const LAS f32x4*)(tmp + cc * 256 + ch0) * m; a1 += *(const LAS f32x4*)(tmp + cc * 256 + ch0 + 4) * m; }
        v4u d; d.x = pk2(a0[0] * cinv - bflo(x.x), a0[1] * cinv - bfhi(x.x)); d.y = pk2(a0[2] * cinv - bflo(x.y), a0[3] * cinv - bfhi(x.y));
        d.z = pk2(a1[0] * cinv - bflo(x.z), a1[1] * cinv - bfhi(x.z)); d.w = pk2(a1[2] * cinv - bflo(x.w), a1[3] * cinv - bfhi(x.w));
        *(v4u*)(DP + o) = d; }
    __syncthreads();
}
__device__ __forceinline__ void phase3_pool(const Args& a, LAS unsigned char* lds, int tid, int vcu, int G) {
    const bf16* P = (const bf16*)(a.ws + RA_P); bf16* DP = (bf16*)(a.ws + RA_DPOOL);
    LAS float* tmp = (LAS float*)lds;
    for (int item = vcu; item < 1024; item += G) {
        const int g = item >> 8, r = (item >> 3) & 31, b = item & 7;
        const int gg = 3 - g;
        if (gg == 0) pool_item<1>(P, DP, tmp, tid, b, r, gg); else if (gg == 1) pool_item<2>(P, DP, tmp, tid, b, r, gg); else if (gg == 2) pool_item<4>(P, DP, tmp, tid, b, r, gg); else pool_item<8>(P, DP, tmp, tid, b, r, gg);
    }
}

__device__ __forceinline__ void phase4_post(const Args& a, int lane, int wave, int vcu, int G) {
    const float* OF = (const float*)(a.ws + RA_OF); const float* OB = OF + (size_t)NT * 1024; const bf16* Rr = (const bf16*)(a.ws + RA_R); bf16* Y = (bf16*)(a.ws + RA_YMIX);
    const float* gn = a.in[15];
    for (int idx = vcu * 8 + wave; idx < NT * 4; idx += G * 8) {
        const int t = idx >> 2, h = idx & 3; const size_t o = (size_t)t * 1024 + h * 256 + 4 * lane;
        const f32x4 x = *(const f32x4*)(OF + o) + *(const f32x4*)(OB + o);
        const float ms = wave_sum(x[0] * x[0] + x[1] * x[1] + x[2] * x[2] + x[3] * x[3]) * (1.f / 256.f);
        const float sc = rsqrtf(ms + EPS);
        const f32x4 g4 = *(const f32x4*)(gn + h * 256 + 4 * lane);
        const v2u rr = *(const v2u*)(Rr + o);
        const float r0 = bflo(rr.x), r1 = bfhi(rr.x), r2 = bflo(rr.y), r3 = bfhi(rr.y);
        v2u q; q.x = pk2(x[0] * sc * g4[0] * silu_f(r0), x[1] * sc * g4[1] * silu_f(r1)); q.y = pk2(x[2] * sc * g4[2] * silu_f(r2), x[3] * sc * g4[3] * silu_f(r3));
        *(v2u*)(Y + (size_t)t * 2048 + h * 256 + 4 * lane) = q;
    }
}

__device__ __forceinline__ void phase6(const Args& a, LAS unsigned char* lds, int tid, int lane, int wave, int vcu, int G) {
    unsigned char* ws = a.ws;
    const float* mod = (const float*)(ws + WS_MOD); const float* Y1 = (const float*)(ws + RA_Y1); bf16* H2 = (bf16*)(ws + RA_H2);
    const float* gpost = a.in[7]; const float* gpre2 = a.in[8]; const float* rbias = a.in[20];
    const bf16* whi = (const bf16*)(ws + WS_WRT); const bf16* wlo = whi + 64 * 2048;
    LAS float* part = (LAS float*)lds;
    LAS float* logit = (LAS float*)(lds + LDS_LOGIT);
    LAS u64* masks = (LAS u64*)(lds + LDS_MASKS);
    int* cnt = (int*)(ws + T_CNT); u64* tmask = (u64*)(ws + T_MASK); float* tokw = (float*)(ws + T_TOKW);
    const int l15 = lane & 15, l4 = lane >> 4;
    for (int blk = vcu; blk < NT / 64; blk += G) {
        for (int it = 0; it < 4; ++it) {
#pragma unroll 1
            for (int rr = 0; rr < 2; ++rr) {
                const int lr = wave * 2 + rr, t = blk * 64 + it * 16 + lr; const float* mr = mod + (size_t)(t >> 11) * 12288;
                const float* yr = Y1 + (size_t)t * 2048; const float* xr = a.in[0] + (size_t)t * 2048; float* outr = a.out + (size_t)t * 2048;
                f32x4 y[8]; float ss = 0.f;
#pragma unroll
                for (int j = 0; j < 8; ++j) { y[j] = *(const f32x4*)(yr + 4 * (lane + 64 * j)); ss += y[j][0] * y[j][0] + y[j][1] * y[j][1] + y[j][2] * y[j][2] + y[j][3] * y[j][3]; }
                const float rstd1 = rsqrtf(wave_sum(ss) * (1.f / 2048.f) + EPS);
                float s2 = 0.f;
#pragma unroll
                for (int j = 0; j < 8; ++j) { const int c = 4 * (lane + 64 * j); const f32x4 x = *(const f32x4*)(xr + c), gp = *(const f32x4*)(gpost + c), gt = *(const f32x4*)(mr + 4096 + c);
                    const f32x4 x1 = x + gt * (y[j] * rstd1 * gp); y[j] = x1; *(f32x4*)(outr + c) = x1;
                    s2 += x1[0] * x1[0] + x1[1] * x1[1] + x1[2] * x1[2] + x1[3] * x1[3]; }
                const float rstd2 = rsqrtf(wave_sum(s2) * (1.f / 2048.f) + EPS);
#pragma unroll
                for (int j = 0; j < 8; ++j) { const int c = 4 * (lane + 64 * j); const f32x4 g2 = *(const f32x4*)(gpre2 + c), sh = *(const f32x4*)(mr + 6144 + c), sc = *(const f32x4*)(mr + 8192 + c);
                    const f32x4 hh = y[j] * rstd2 * g2 * (sc + 1.f) + sh;
                    unsigned hi[4], lo[4];
#pragma unroll
                    for (int q = 0; q < 4; ++q) { hi[q] = f2bf(hh[q]); lo[q] = f2bf(hh[q] - __builtin_bit_cast(float, hi[q] << 16)); }
                    v2u qh, ql; qh.x = hi[0] | (hi[1] << 16); qh.y = hi[2] | (hi[3] << 16); ql.x = lo[0] | (lo[1] << 16); ql.y = lo[2] | (lo[3] << 16);
                    *(LAS v2u*)(lds + RT_HI + lr * RT_ROWB + c * 2) = qh; *(LAS v2u*)(lds + RT_LO + lr * RT_ROWB + c * 2) = ql;
                    *(v2u*)(H2 + (size_t)t * 2048 + c) = qh; }
            }
            __syncthreads();
            { f32x4 acc[4];
#pragma unroll
              for (int et = 0; et < 4; ++et) acc[et] = (f32x4){0.f, 0.f, 0.f, 0.f};
#pragma unroll 2
              for (int ks = 0; ks < 8; ++ks) { const int k0 = 256 * wave + 32 * ks + 8 * l4;
                  const bf16x8 ah = *(const LAS bf16x8*)(lds + RT_HI + l15 * RT_ROWB + k0 * 2), al = *(const LAS bf16x8*)(lds + RT_LO + l15 * RT_ROWB + k0 * 2);
#pragma unroll
                  for (int et = 0; et < 4; ++et) { const bf16x8 bh = *(const bf16x8*)(whi + (size_t)(16 * et + l15) * 2048 + k0), bl = *(const bf16x8*)(wlo + (size_t)(16 * et + l15) * 2048 + k0);
                      acc[et] = __builtin_amdgcn_mfma_f32_16x16x32_bf16(ah, bh, acc[et], 0, 0, 0);
                      acc[et] = __builtin_amdgcn_mfma_f32_16x16x32_bf16(ah, bl, acc[et], 0, 0, 0);
                      acc[et] = __builtin_amdgcn_mfma_f32_16x16x32_bf16(al, bh, acc[et], 0, 0, 0); } }
              __syncthreads();
#pragma unroll
              for (int et = 0; et < 4; ++et)
#pragma unroll
                  for (int q = 0; q < 4; ++q) part[(wave * 16 + 4 * l4 + q) * 64 + 16 * et + l15] = acc[et][q]; }
            __syncthreads();
#pragma unroll
            for (int q = 0; q < 2; ++q) { const int idx = tid + 512 * q; float sacc = 0.f;
#pragma unroll
                for (int w = 0; w < 8; ++w) sacc += part[w * 1024 + idx];
                logit[idx] = sacc; }
            __syncthreads();
#pragma unroll 1
            for (int rr = 0; rr < 2; ++rr) {
                const int lr = wave * 2 + rr, t = blk * 64 + it * 16 + lr;
                const float lg = logit[lr * 64 + lane]; const float s = 1.f / (1.f + __expf(-lg)); const float sel = s + rbias[lane];
                float m1 = sel; m1 = fmaxf(m1, __shfl_xor(m1, 1)); m1 = fmaxf(m1, __shfl_xor(m1, 2)); m1 = fmaxf(m1, __shfl_xor(m1, 4));
                const u64 eq = __ballot(sel == m1); const unsigned gb = (unsigned)(eq >> (lane & ~7)) & 0xffu; const int first = __builtin_ctz(gb);
                float v2 = ((lane & 7) == first) ? -INFINITY : sel; v2 = fmaxf(v2, __shfl_xor(v2, 1)); v2 = fmaxf(v2, __shfl_xor(v2, 2)); v2 = fmaxf(v2, __shfl_xor(v2, 4));
                const float gs = m1 + v2; const int g = lane >> 3; int grank = 0;
#pragma unroll
                for (int g2 = 0; g2 < 8; ++g2) { const float o = __shfl(gs, g2 * 8); grank += (o > gs || (o == gs && g2 < g)) ? 1 : 0; }
                const bool gsel = grank < 4; const float mk = gsel ? sel : -INFINITY; int rank = 0;
                for (int e2 = 0; e2 < 64; ++e2) { const float o = __shfl(mk, e2); rank += (o > mk || (o == mk && e2 < lane)) ? 1 : 0; }
                const bool chosen = gsel && rank < 8;
                const u64 mask = __ballot(chosen); const float ssum = wave_sum(chosen ? s : 0.f);
                const int kidx = __popcll(mask & ((1ull << lane) - 1ull));
                if (chosen) tokw[(size_t)t * 8 + kidx] = s / ssum * 2.5f;
                if (lane == 0) { tmask[t] = mask; masks[it * 16 + lr] = mask; }
            }
            __syncthreads();
        }
        if (wave == 0) { const u64 m = masks[lane]; int mine = 0;
            for (int e = 0; e < 64; ++e) { const int c = __popcll(__ballot((m >> e) & 1ull)); mine = (lane == e) ? c : mine; }
            cnt[blk * 64 + lane] = mine; }
        __syncthreads();
    }
}

__device__ __forceinline__ void phase7(const Args& a, LAS unsigned char* lds, int tid, int lane, int wave, int vcu, int G) {
    unsigned char* ws = a.ws;
    const int* cnt = (const int*)(ws + T_CNT); const u64* tmask = (const u64*)(ws + T_MASK); const float* tokw = (const float*)(ws + T_TOKW);
    int* tokslot = (int*)(ws + T_TOKSLOT); int* slottok = (int*)(ws + T_SLOTTOK); float* slotw = (float*)(ws + T_SLOTW); int* tile = (int*)(ws + T_TILE);
    LAS int* part = (LAS int*)lds;
    LAS int* tot = (LAS int*)(lds + 4096);
    for (int blk = vcu; blk < NT / 64; blk += G) {
        int pre = 0, all = 0;
        for (int b2 = wave; b2 < 256; b2 += 8) { const int c = cnt[b2 * 64 + lane]; all += c; pre += (b2 < blk) ? c : 0; }
        part[(wave * 2) * 64 + lane] = pre; part[(wave * 2 + 1) * 64 + lane] = all;
        __syncthreads();
        if (wave == 0) {
            int p = 0, t = 0;
#pragma unroll
            for (int w = 0; w < 8; ++w) { p += part[(w * 2) * 64 + lane]; t += part[(w * 2 + 1) * 64 + lane]; }
            int incl = t;
#pragma unroll
            for (int o = 1; o < 64; o <<= 1) { const int v = __shfl_up(incl, o); if (lane >= o) incl += v; }
            const int start = incl - t; const int base = start + p;
            tot[lane] = t; tot[64 + lane] = start;
            const int tokn = blk * 64 + lane; const u64 m = tmask[tokn];
            for (int e = 0; e < 64; ++e) { const bool bit = (m >> e) & 1ull; const u64 bal = __ballot(bit); const int be = __shfl(base, e);
                if (bit) { const int rank = __popcll(bal & ((1ull << lane) - 1ull)); const int slot = be + rank; const int k = __popcll(m & ((1ull << e) - 1ull));
                    slottok[slot] = tokn; slotw[slot] = tokw[(size_t)tokn * 8 + k]; tokslot[(size_t)tokn * 8 + k] = slot; } }
            slottok[SH_ROW0 + tokn] = tokn; slotw[SH_ROW0 + tokn] = 1.f;
        }
        __syncthreads();
        if (blk == 0 && tid == 0) {
            int n = 0;
            for (int e = 0; e < 64; ++e) { const int te = tot[e], st = tot[64 + e];
                for (int j = 0; j * 256 < te; ++j) { tile[n] = e; tile[NTILE_MAX + n] = st + j * 256; tile[2 * NTILE_MAX + n] = (te - j * 256) < 256 ? (te - j * 256) : 256; ++n; } }
            for (int j = 0; j < 64; ++j) { tile[n] = 64; tile[NTILE_MAX + n] = SH_ROW0 + j * 256; tile[2 * NTILE_MAX + n] = 256; ++n; }
            tile[3 * NTILE_MAX] = n;
        }
        __syncthreads();
    }
}

__device__ __forceinline__ void phase10(const Args& a, int lane, int wave, int vcu, int G) {
    unsigned char* ws = a.ws;
    const float* mod = (const float*)(ws + WS_MOD); const bf16* SO = (const bf16*)(ws + WS_SLOTOUT); const int* tokslot = (const int*)(ws + T_TOKSLOT); const float* gp = a.in[9];
    for (int t = vcu * 8 + wave; t < NT; t += G * 8) {
        const float* mr = mod + (size_t)(t >> 11) * 12288;
        const int myslot = lane < 8 ? tokslot[(size_t)t * 8 + lane] : SH_ROW0 + t;
        v4u x[9][4];
#pragma unroll
        for (int k = 0; k < 9; ++k) { const int slot = __shfl(myslot, k); const bf16* sr = SO + (size_t)slot * 2048;
#pragma unroll
            for (int j = 0; j < 4; ++j) x[k][j] = *(const v4u*)(sr + 8 * (lane + 64 * j)); }
        float y[4][8];
#pragma unroll
        for (int j = 0; j < 4; ++j)
#pragma unroll
            for (int q = 0; q < 8; ++q) y[j][q] = 0.f;
#pragma unroll
        for (int k = 0; k < 9; ++k)
#pragma unroll
            for (int j = 0; j < 4; ++j) { const v4u v = x[k][j];
                y[j][0] += bflo(v.x); y[j][1] += bfhi(v.x); y[j][2] += bflo(v.y); y[j][3] += bfhi(v.y); y[j][4] += bflo(v.z); y[j][5] += bfhi(v.z); y[j][6] += bflo(v.w); y[j][7] += bfhi(v.w); }
        float ss = 0.f;
#pragma unroll
        for (int j = 0; j < 4; ++j)
#pragma unroll
            for (int q = 0; q < 8; ++q) ss += y[j][q] * y[j][q];
        const float rstd = rsqrtf(wave_sum(ss) * (1.f / 2048.f) + EPS);
        float* outr = a.out + (size_t)t * 2048;
#pragma unroll
        for (int j = 0; j < 4; ++j)
#pragma unroll
            for (int hh = 0; hh < 2; ++hh) { const int c = 8 * (lane + 64 * j) + 4 * hh; const f32x4 x1 = *(const f32x4*)(outr + c), g = *(const f32x4*)(gp + c), gt = *(const f32x4*)(mr + 10240 + c);
                f32x4 yy; yy[0] = y[j][4 * hh]; yy[1] = y[j][4 * hh + 1]; yy[2] = y[j][4 * hh + 2]; yy[3] = y[j][4 * hh + 3];
                *(f32x4*)(outr + c) = x1 + gt * (yy * rstd * g); }
    }
}

__global__ void __launch_bounds__(512, 2) fwd(Args args) {
    extern __shared__ __attribute__((aligned(16))) unsigned char lds_raw[];
    LAS unsigned char* lds = (LAS unsigned char*)lds_raw;
    const int tid = threadIdx.x, lane = tid & 63, wave = __builtin_amdgcn_readfirstlane(tid >> 6);
    const int G = gridDim.x, bx = blockIdx.x;
    const int vcu = (G % 8 == 0) ? (bx % 8) * (G / 8) + bx / 8 : bx;
    unsigned char* ws = args.ws;
    volatile LAS unsigned* MISC = (volatile LAS unsigned*)(lds + LDS_MISC);
    if (tid < 64) MISC[tid] = 0u;
    __syncthreads();
    const int lo = args.ph_lo, hi = args.ph_hi;
    XcdBarrier bar; bar.bar = (unsigned*)(ws + WS_CTL) + 4096; bar.x = 0; bar.st = nullptr;
    if (hi - lo > 1) bar = xcd_barrier_post((unsigned*)(ws + WS_CTL) + 4096, MISC + 8);
#ifndef PH_MASK
#define PH_MASK 0xfff
#endif
#define IN(k) (((PH_MASK >> (k)) & 1) && lo <= (k) && (k) < hi)
#define SEAM(k) do { if (IN(k) && IN((k) + 1)) xcd_barrier(bar); } while (0)

#ifndef REP_PHASE
#define REP_PHASE -1
#endif
#define RUNPH(k, ...) do { if (IN(k)) { __VA_ARGS__ if (REP_PHASE == (k)) { xcd_barrier(bar); __VA_ARGS__ } SEAM(k); } } while (0)
    RUNPH(0, phase0(args, lds, tid, lane, wave, vcu, G););
    RUNPH(1, phase1(args, lane, wave, vcu, G););
    RUNPH(2, {
        DenseSched S; S.init(ws + RA_H, ws + WS_WIN, 2048, 2048, MROWS, DINP, G, bx);
        EpiIn E{ws};
        pg8::gemm_phase<EpiIn, DenseSched>(lds, 2048, S, E); });
    RUNPH(3, phase3_prep(args, lds, tid, vcu, G); phase3_pool(args, lds, tid, vcu, G););
    RUNPH(4, phase_chain(args, lds, tid, lane, wave, vcu, G););
    RUNPH(5, {
        phase4_post(args, lane, wave, vcu, G);
        PoolSched S{(const char*)(ws + RA_DPOOL), (const char*)(ws + WS_WPOOL), G, vcu};
        EpiPool E{(bf16*)(ws + RA_YMIX), args.in[17]};
        int kpool = 256; asm volatile("" : "+s"(kpool));
        pg8::gemm_phase<EpiPool, PoolSched>(lds, kpool, S, E); });
    RUNPH(6, {
        DenseSched S; S.init(ws + RA_YMIX, ws + WS_WOUT, 2048, 2048, NT, 2048, G, bx);
        EpiOut E{(float*)(ws + RA_Y1)};
        pg8::gemm_phase<EpiOut, DenseSched>(lds, 2048, S, E); });
    RUNPH(7, phase6(args, lds, tid, lane, wave, vcu, G););
    RUNPH(8, phase7(args, lds, tid, lane, wave, vcu, G););
    RUNPH(9, {
        MoeGUSched S{(const char*)(ws + RA_H2), (const char*)(ws + WS_WGU), (const int*)(ws + T_TILE), (const int*)(ws + T_SLOTTOK), G, vcu};
        EpiGU E{(bf16*)(ws + WS_ACT), (const float*)(ws + T_SLOTW)};
        pg8::gemm_phase<EpiGU, MoeGUSched>(lds, 2048, S, E); });
    RUNPH(10, {
        MoeDownSched S{(const char*)(ws + WS_ACT), (const char*)(ws + WS_WD), (const int*)(ws + T_TILE), G, vcu};
        EpiDown E{(bf16*)(ws + WS_SLOTOUT)};
        pg8::gemm_phase<EpiDown, MoeDownSched>(lds, 512, S, E); });
    if (IN(11)) { phase10(args, lane, wave, vcu, G); }
#undef IN
#undef SEAM
}

extern "C" void kernel_launch(void* const* d_in, const int* in_sizes, int n_in, void* d_out, int out_size, void* d_ws, size_t ws_size, hipStream_t stream) {
    static int grid = 0;
    if (grid == 0) {
        if (n_in != 27 || out_size != NT * DM || ws_size < WS_NEED) { fprintf(stderr, "kernel_launch: unexpected problem: n_in %d out %d ws %zu (need %zu)\n", n_in, out_size, ws_size, (size_t)WS_NEED); grid = -1; return; }
        int dev = 0, cus = 0, per_cu = 0;
        if (hipGetDevice(&dev) != hipSuccess || hipDeviceGetAttribute(&cus, hipDeviceAttributeMultiprocessorCount, dev) != hipSuccess) { grid = -1; return; }
        if (hipFuncSetAttribute((const void*)fwd, hipFuncAttributeMaxDynamicSharedMemorySize, LDS_BYTES) != hipSuccess) { fprintf(stderr, "kernel_launch: hipFuncSetAttribute failed\n"); grid = -1; return; }
        if (hipOccupancyMaxActiveBlocksPerMultiprocessor(&per_cu, (const void*)fwd, 512, LDS_BYTES) != hipSuccess || per_cu < 1) { fprintf(stderr, "kernel_launch: occupancy query says %d\n", per_cu); }
        (void)hipGetLastError();
        grid = cus;
    }
    if (grid < 0) return;
    (void)hipMemsetAsync((char*)d_ws + WS_CTL, 0, CTL_ZERO_BYTES, stream);
    Args a{};
    for (int i = 0; i < 27; ++i) a.in[i] = (const float*)d_in[i];
    a.out = (float*)d_out; a.ws = (unsigned char*)d_ws;
    if (N_LAUNCHES == 1) {
        a.ph_lo = 0; a.ph_hi = NPH;
        hipLaunchKernelGGL(fwd, dim3(grid), dim3(512), LDS_BYTES, stream, a);
    } else {
        for (int p = 0; p < NPH; ++p) { a.ph_lo = p; a.ph_hi = p + 1; hipLaunchKernelGGL(fwd, dim3(grid), dim3(512), LDS_BYTES, stream, a); }
    }
}
```

```cpp
#include <hip/hip_runtime.h>
#include <cstdio>
#include <cstdint>

#ifndef N_LAUNCHES
#define N_LAUNCHES 1
#endif

#define GAS __attribute__((address_space(1)))
#define LAS __attribute__((address_space(3)))
typedef unsigned short bf16;
typedef unsigned v4u __attribute__((ext_vector_type(4)));
typedef unsigned v2u __attribute__((ext_vector_type(2)));
typedef float f32x4 __attribute__((ext_vector_type(4)));
typedef short bf16x8 __attribute__((ext_vector_type(8)));
typedef unsigned long long u64;

constexpr int NB = 8, SEQ = 2048, DM = 2048, CTXL = 256;
constexpr int NT = NB * SEQ;
constexpr int NTC = NB * CTXL;
constexpr int MROWS = NT + NTC;
constexpr int DIN = 4128, DINP = 4352;
constexpr int NE = 64, TOPK = 8, DE = 512;
constexpr int NSLOT_E = NT * TOPK;
constexpr int SH_ROW0 = NSLOT_E + 256;
constexpr int NSLOT = SH_ROW0 + NT;
constexpr int NTILE_MAX = 704;
constexpr float EPS = 1e-6f;
constexpr int NPH = 12;

constexpr size_t MiB = 1u << 20;
constexpr size_t WS_CTL = 0, CTL_ZERO_BYTES = 64 * 1024;
constexpr size_t WS_MOD = 1 * MiB;
constexpr size_t WS_WRT = 1 * MiB + 512 * 1024;
constexpr size_t WS_WIN = 2 * MiB;
constexpr size_t WS_WOUT = WS_WIN + 17 * MiB;
constexpr size_t WS_WPOOL = WS_WOUT + 8 * MiB;
constexpr size_t WS_WD = WS_WPOOL + 1 * MiB;
constexpr size_t WS_WGU = WS_WD + 130 * MiB;
constexpr size_t WS_RA = WS_WGU + 260 * MiB;
constexpr size_t RA_H = WS_RA;
constexpr size_t RA_OF = WS_RA;
constexpr size_t RA_H2 = WS_RA;
constexpr size_t RA_Q = WS_RA + 128 * MiB;
constexpr size_t RA_K = RA_Q + 16 * MiB;
constexpr size_t RA_V = RA_K + 18 * MiB;
constexpr size_t RA_R = RA_V + 36 * MiB;
constexpr size_t RA_P = RA_R + 32 * MiB;
constexpr size_t RA_ALR = RA_P + 32 * MiB;
constexpr size_t RA_DPOOL = RA_ALR + 3 * MiB;
constexpr size_t RA_YMIX = RA_DPOOL + 32 * MiB;
constexpr size_t RA_Y1 = WS_RA + 128 * MiB;
constexpr size_t RA_END = RA_YMIX + 64 * MiB;
constexpr size_t WS_SLOTOUT = WS_WGU;
constexpr size_t WS_ACT = RA_END > WS_SLOTOUT + 578 * MiB ? RA_END : WS_SLOTOUT + 578 * MiB;
constexpr size_t WS_END = WS_ACT + 145 * MiB;
constexpr size_t PQG = WS_ACT;
constexpr size_t PQM = WS_ACT + 32 * MiB;
constexpr size_t PKM = WS_ACT + 64 * MiB;
constexpr size_t PKD = WS_ACT + 96 * MiB;
constexpr size_t PDEC = WS_ACT + 132 * MiB;
constexpr size_t WS_T0 = WS_END;
constexpr size_t T_CNT = WS_T0;
constexpr size_t T_MASK = T_CNT + 65536;
constexpr size_t T_TOKW = T_MASK + 131072;
constexpr size_t T_TOKSLOT = T_TOKW + 524288;
constexpr size_t T_SLOTTOK = T_TOKSLOT + 524288;
constexpr size_t T_SLOTW = T_SLOTTOK + 655360;
constexpr size_t T_TILE = T_SLOTW + 655360;
constexpr size_t WS_X1 = (T_TILE + 16384 + 4095) / 4096 * 4096;
constexpr size_t WS_NEED = WS_X1 + (size_t)NT * DM * 4;

constexpr int RING_BYTES = 131072;
constexpr int LDS_BYTES = 147456;
constexpr int LDS_MISC = LDS_BYTES - 256;
constexpr int RT_ROWB = 4112;
constexpr int RT_HI = 0, RT_LO = 16 * RT_ROWB;
constexpr int LDS_LOGIT = 2 * 16 * RT_ROWB;
constexpr int LDS_MASKS = LDS_LOGIT + 4096;
static_assert(LDS_MASKS + 512 <= LDS_MISC, "LDS map");

#define LDS_WAIT() asm volatile("s_waitcnt lgkmcnt(0)" ::: "memory")
#define VM_WAIT() asm volatile("s_waitcnt vmcnt(0)" ::: "memory")

__device__ __forceinline__ unsigned f2bf(float f) { unsigned u = __builtin_bit_cast(unsigned, f); return (u + 0x7fffu + ((u >> 16) & 1u)) >> 16; }
__device__ __forceinline__ unsigned pk2(float lo, float hi) { return f2bf(lo) | (f2bf(hi) << 16); }
__device__ __forceinline__ float bflo(unsigned u) { return __builtin_bit_cast(float, u << 16); }
__device__ __forceinline__ float bfhi(unsigned u) { return __builtin_bit_cast(float, u & 0xffff0000u); }
__device__ __forceinline__ float bf1(bf16 b) { return __builtin_bit_cast(float, ((unsigned)b) << 16); }
__device__ __forceinline__ float wave_sum(float v) {
#pragma unroll
    for (int o = 1; o < 64; o <<= 1) v += __shfl_xor(v, o);
    return v;
}
__device__ __forceinline__ float silu_f(float x) { return x / (1.f + __expf(-x)); }

#define XB_TMO      128
#define XB_XCNT(j)  (256  + 64 * (j))
#define XB_XSUB(j)  (1280 + 64 * (j))
#define XB_XGEN(j)  (2304 + 64 * (j))
#define XB_TOP      3328
#define XB_TOPGEN   3392
#define XCD_BAR_WORDS 3456
#define XB_SPIN_CAP (1u << 18)

__device__ __forceinline__ unsigned xb_ld(unsigned* p)              { return __hip_atomic_load(p, __ATOMIC_RELAXED, __HIP_MEMORY_SCOPE_AGENT); }
__device__ __forceinline__ unsigned xb_add(unsigned* p, unsigned v) { return __hip_atomic_fetch_add(p, v, __ATOMIC_RELAXED, __HIP_MEMORY_SCOPE_AGENT); }
__device__ __forceinline__ unsigned xb_xcc_id() { return (unsigned)__builtin_amdgcn_s_getreg((3 << 11) | 20) & 0xFu; }
#define XB_SPIN(cond, bar) do { unsigned _sp = 0; while (cond) { __builtin_amdgcn_s_sleep(1); \
    if ((++_sp & 255u) == 0u) { if (xb_ld(&(bar)[XB_TMO])) break; if (_sp > XB_SPIN_CAP) { atomicAdd(&(bar)[XB_TMO], 1u); break; } } } } while (0)

struct XcdBarrier { unsigned* bar; unsigned x; volatile LAS unsigned* st; };

__device__ __forceinline__ XcdBarrier xcd_barrier_post(unsigned* bar, volatile LAS unsigned* st) {
    XcdBarrier b; b.bar = bar; b.x = xb_xcc_id(); b.st = st;
    if (threadIdx.x == 0) (void)xb_add(&bar[XB_XCNT(b.x)], 1u);
    return b;
}
__device__ __forceinline__ void xcd_barrier_complete(unsigned* bar, unsigned x, unsigned& nloc, unsigned& nx) {
    const unsigned G = gridDim.x * gridDim.y * gridDim.z;
    unsigned sum, cnt, mine, sp = 0u;
    for (;;) {
        sum = 0u; cnt = 0u; mine = 0u;
#pragma unroll
        for (unsigned j = 0; j < 16; ++j) { const unsigned c = xb_ld(&bar[XB_XCNT(j)]); sum += c; cnt += (c > 0u) ? 1u : 0u; mine = (j == x) ? c : mine; }
        if (sum == G) break;
        __builtin_amdgcn_s_sleep(1);
        if ((++sp & 255u) == 0u) { if (xb_ld(&bar[XB_TMO])) break; if (sp > XB_SPIN_CAP) { atomicAdd(&bar[XB_TMO], 1u); break; } }
    }
    nloc = mine > 0u ? mine : 1u; nx = cnt > 0u ? cnt : 1u;
}
__device__ __forceinline__ void xcd_barrier(const XcdBarrier& b) {
    asm volatile("s_waitcnt vmcnt(0)" ::: "memory");
    __syncthreads();
    if (threadIdx.x == 0) {
        unsigned* bar = b.bar;
        __builtin_amdgcn_s_waitcnt(0);
        unsigned nloc = b.st[0], nx = b.st[1];
        if (nloc == 0u) { xcd_barrier_complete(bar, b.x, nloc, nx); b.st[0] = nloc; b.st[1] = nx; }
        const unsigned old = xb_add(&bar[XB_XSUB(b.x)], 1u);
        const unsigned gen = old / nloc;
        if (old + 1u == (gen + 1u) * nloc) {
            __builtin_amdgcn_fence(__ATOMIC_RELEASE, "agent");
            asm volatile("s_waitcnt vmcnt(0)" ::: "memory");
            const unsigned og = xb_add(&bar[XB_TOP], 1u);
            const unsigned tg = og / nx;
            if (og + 1u == (tg + 1u) * nx) xb_add(&bar[XB_TOPGEN], 1u);
            else XB_SPIN(xb_ld(&bar[XB_TOPGEN]) == tg, bar);
            __builtin_amdgcn_fence(__ATOMIC_ACQUIRE, "agent");
            xb_add(&bar[XB_XGEN(b.x)], 1u);
            asm volatile("s_waitcnt vmcnt(0)" ::: "memory");
        } else {
            XB_SPIN(xb_ld(&bar[XB_XGEN(b.x)]) == gen, bar);
            __builtin_amdgcn_fence(__ATOMIC_ACQUIRE, "agent");
            asm volatile("s_waitcnt vmcnt(0)" ::: "memory");
        }
    }
    __syncthreads();
}

namespace pg8 {
constexpr int BM = 256, BK = 64, HALF = 128, HTB = HALF * BK * 2, STAGE_BYTES = 8 * HTB, NXCD = 8, WGM = 8;
__device__ __forceinline__ int lds_byte(int r, int c) { const int st = (r >> 4) * 2 + (c >> 5), rr = r & 15, cc = c & 31, ob = rr * 64 + cc * 2; return st * 1024 + (ob ^ (((ob >> 9) & 1) << 5)); }
__device__ __forceinline__ void stage_rc(int b, int& R, int& C) { const int st = b / 1024, sb = b % 1024, swz = sb ^ (((sb >> 9) & 1) << 5); R = (st >> 1) * 16 + swz / 64; C = (st & 1) * 32 + (swz % 64) / 2; }
__device__ __forceinline__ int perm32(int rho) { const int n = rho >> 4, i = rho & 15; return 8 * (i >> 2) + 4 * n + (i & 3); }
__device__ __forceinline__ unsigned cvt_pk_bf16(float lo, float hi) { unsigned r; asm volatile("v_cvt_pk_bf16_f32 %0, %1, %2" : "=v"(r) : "v"(lo), "v"(hi)); return r; }

template <class Epi, class Sched>
__device__ __forceinline__ void gemm_phase(LAS unsigned char* lds, const int K, const Sched& S, const Epi& E) {
    typedef typename Sched::U Unit;
    const int tid = threadIdx.x, wid = __builtin_amdgcn_readfirstlane(tid >> 6), lane = tid & 63, wr = wid >> 2, wc = wid & 3, fr = lane & 15, fq = lane >> 4;
    const int nt = K / BK;
    int R[2], C[2]; unsigned voffB[2];
#pragma unroll
    for (int i = 0; i < 2; ++i) { stage_rc(tid * 16 + i * 8192, R[i], C[i]); const int Rb = Epi::PERM ? ((R[i] & ~31) + perm32(R[i] & 31)) : R[i];
        voffB[i] = (unsigned)(Rb * K + C[i]) * 2u; }
    const size_t kstep = (size_t)(BK * 2);
    const size_t hstepB = (size_t)HALF * K * 2;
    const unsigned ldsw = (unsigned)wid * 1024u;
    const int aoff = lds_byte(wr * 64 + fr, fq * 8), boff = lds_byte(wc * 32 + fr, fq * 8);
#define PG8_SA(b, h) (((b) * 2 + (h)) * HTB)
#define PG8_SB(b, h) ((4 + (b) * 2 + (h)) * HTB)
#define PG8_STAGE(bufoff, gbase, v0, v1) do { \
        __builtin_amdgcn_global_load_lds((const unsigned*)((const char*)(gbase) + (v0)), (LAS unsigned*)(lds + (bufoff) + ldsw), 16, 0, 0); \
        __builtin_amdgcn_global_load_lds((const unsigned*)((const char*)(gbase) + (v1)), (LAS unsigned*)(lds + (bufoff) + ldsw + 8192), 16, 0, 0); } while (0)
#define PG8_LDA(dst, b, h) do { _Pragma("unroll") for (int m = 0; m < 4; ++m) _Pragma("unroll") for (int k = 0; k < 2; ++k) dst[m][k] = *(const LAS bf16x8*)(lds + PG8_SA(b, h) + aoff + m * 2048 + k * 1024); } while (0)
#define PG8_LDB(dst, b, h) do { _Pragma("unroll") for (int n = 0; n < 2; ++n) _Pragma("unroll") for (int k = 0; k < 2; ++k) dst[n][k] = *(const LAS bf16x8*)(lds + PG8_SB(b, h) + boff + n * 2048 + k * 1024); } while (0)
#define PG8_MMA(ai, bj, At, Bt) do { __builtin_amdgcn_s_setprio(1); _Pragma("unroll") for (int m = 0; m < 4; ++m) _Pragma("unroll") for (int n = 0; n < 2; ++n) _Pragma("unroll") for (int k = 0; k < 2; ++k) \
        acc[ai][bj][m][n] = __builtin_amdgcn_mfma_f32_16x16x32_bf16(Bt[n][k], At[m][k], acc[ai][bj][m][n], 0, 0, 0); __builtin_amdgcn_s_setprio(0); } while (0)
#define PG8_WAIT_V(n) asm volatile("s_waitcnt vmcnt(" #n ")" ::: "memory")
#define PG8_WAIT_L(n) asm volatile("s_waitcnt lgkmcnt(" #n ")" ::: "memory")
#define PG8_BAR __builtin_amdgcn_s_barrier()
#define PG8_SCHED __builtin_amdgcn_sched_barrier(0)
    Unit cur, nxt; int ui = 0;
    if (!S.next(0, cur)) return;
    f32x4 acc[2][2][4][2];
#pragma unroll
    for (int a = 0; a < 2; ++a)
#pragma unroll
        for (int b = 0; b < 2; ++b)
#pragma unroll
            for (int m = 0; m < 4; ++m)
#pragma unroll
                for (int n = 0; n < 2; ++n) acc[a][b][m][n] = (f32x4){0.f, 0.f, 0.f, 0.f};
    bf16x8 At[4][2], B0[2][2], B1[2][2];
    unsigned vA[4], vN[4];
    S.aoffs(cur, R, C, vA);
    const char* cA = cur.A; const char* cB = cur.B;
    PG8_STAGE(PG8_SB(0, 0), cB, voffB[0], voffB[1]); PG8_STAGE(PG8_SB(0, 1), cB + hstepB, voffB[0], voffB[1]); PG8_STAGE(PG8_SA(0, 0), cA, vA[0], vA[1]); PG8_STAGE(PG8_SA(0, 1), cA, vA[2], vA[3]);
    if (wr == 1) PG8_BAR;
    PG8_WAIT_V(2); PG8_BAR;
    PG8_STAGE(PG8_SB(1, 0), cB + kstep, voffB[0], voffB[1]); PG8_STAGE(PG8_SA(1, 0), cA + kstep, vA[0], vA[1]); PG8_STAGE(PG8_SB(1, 1), cB + hstepB + kstep, voffB[0], voffB[1]);
    PG8_WAIT_V(6); PG8_BAR;
    for (;;) {
        const bool has_next = S.next(ui + 1, nxt);
        const char* nA = has_next ? nxt.A : cA; const char* nB = has_next ? nxt.B : cB;
        if (has_next) S.aoffs(nxt, R, C, vN); else { vN[0] = vA[0]; vN[1] = vA[1]; vN[2] = vA[2]; vN[3] = vA[3]; }
        for (int t = 0; t < nt; t += 2) {
            const bool last = (t == nt - 2);
            const char* a1 = cA + (size_t)(t + 1) * kstep;
            const char* a2 = last ? nA : cA + (size_t)(t + 2) * kstep; const char* b2 = last ? nB : cB + (size_t)(t + 2) * kstep;
            const char* a3 = a2 + kstep; const char* b3 = b2 + kstep;
            const unsigned x0 = last ? vN[0] : vA[0], x1 = last ? vN[1] : vA[1], x2 = last ? vN[2] : vA[2], x3 = last ? vN[3] : vA[3];
            PG8_LDB(B0, 0, 0); PG8_LDB(B1, 0, 1); PG8_SCHED; PG8_LDA(At, 0, 0); PG8_STAGE(PG8_SA(1, 1), a1, vA[2], vA[3]);
            PG8_WAIT_V(8); PG8_WAIT_L(0); PG8_BAR; PG8_MMA(0, 0, At, B0); PG8_MMA(0, 1, At, B1); PG8_BAR; PG8_SCHED;
            PG8_LDA(At, 0, 1); PG8_STAGE(PG8_SB(0, 0), b2, voffB[0], voffB[1]); PG8_STAGE(PG8_SB(0, 1), b2 + hstepB, voffB[0], voffB[1]); PG8_STAGE(PG8_SA(0, 0), a2, x0, x1);
            PG8_WAIT_V(8); PG8_WAIT_L(0); PG8_BAR; PG8_MMA(1, 0, At, B0); PG8_MMA(1, 1, At, B1); PG8_BAR; PG8_SCHED;
            PG8_LDB(B0, 1, 0); PG8_LDB(B1, 1, 1); PG8_SCHED; PG8_LDA(At, 1, 0); PG8_STAGE(PG8_SA(0, 1), a2, x2, x3);
            PG8_WAIT_V(8); PG8_WAIT_L(0); PG8_BAR; PG8_MMA(0, 0, At, B0); PG8_MMA(0, 1, At, B1); PG8_BAR; PG8_SCHED;
            PG8_LDA(At, 1, 1); PG8_STAGE(PG8_SB(1, 0), b3, voffB[0], voffB[1]); PG8_STAGE(PG8_SB(1, 1), b3 + hstepB, voffB[0], voffB[1]); PG8_STAGE(PG8_SA(1, 0), a3, x0, x1);
            PG8_WAIT_V(8); PG8_WAIT_L(0); PG8_BAR; PG8_MMA(1, 0, At, B0); PG8_MMA(1, 1, At, B1); PG8_BAR; PG8_SCHED;
        }
        if (wr == 0) PG8_BAR;
        E(acc, cur, wr, wc, fr, fq);
        if (!has_next) break;
#pragma unroll
        for (int a = 0; a < 2; ++a)
#pragma unroll
            for (int b = 0; b < 2; ++b)
#pragma unroll
                for (int m = 0; m < 4; ++m)
#pragma unroll
                    for (int n = 0; n < 2; ++n) acc[a][b][m][n] = (f32x4){0.f, 0.f, 0.f, 0.f};
        cur = nxt; cA = nA; cB = nB; ++ui;
        vA[0] = vN[0]; vA[1] = vN[1]; vA[2] = vN[2]; vA[3] = vN[3];
        if (wr == 1) PG8_BAR;
    }
    PG8_WAIT_V(0);
    PG8_BAR;
#undef PG8_SA
#undef PG8_SB
#undef PG8_STAGE
#undef PG8_LDA
#undef PG8_LDB
#undef PG8_MMA
#undef PG8_WAIT_V
#undef PG8_WAIT_L
#undef PG8_BAR
#undef PG8_SCHED
}
}

struct Args { const float* in[27]; float* out; unsigned char* ws; int ph_lo, ph_hi; };
static_assert(sizeof(Args) == 27 * 8 + 8 + 8 + 8, "Args has no padding");

struct DenseU { const char* A; const char* B; int pm, pn; };
struct DenseSched {
    typedef DenseU U;
    const char* A; const char* B; int lda, K, nM, nN, nwg, G, c;
    __device__ __forceinline__ void init(const void* A_, const void* B_, int lda_, int K_, int M, int N, int G_, int c_) { A = (const char*)A_; B = (const char*)B_; lda = lda_; K = K_; nM = M / 256; nN = N / 256; nwg = nM * nN; G = G_; c = c_; }
    __device__ __forceinline__ bool next(int i, U& u) const {
        const long L = (long)i * G + c; if (L >= nwg) return false;
        int wgid = (int)L; { const int q = nwg / 8, r = nwg % 8, xcd = wgid % 8, off = wgid / 8; wgid = (xcd < r ? xcd * (q + 1) : r * (q + 1) + (xcd - r) * q) + off; }
        const int nig = 8 * nN, gid = wgid / nig, fm = gid * 8, gsz = (nM - fm) < 8 ? (nM - fm) : 8;
        u.pm = fm + ((wgid % nig) % gsz); u.pn = (wgid % nig) / gsz;
        u.A = A + (size_t)u.pm * 256 * lda * 2; u.B = B + (size_t)u.pn * 256 * K * 2; return true;
    }
    __device__ __forceinline__ void aoffs(const U&, const int (&R)[2], const int (&C)[2], unsigned (&v)[4]) const {
#pragma unroll
        for (int h = 0; h < 2; ++h)
#pragma unroll
            for (int i = 0; i < 2; ++i) v[h * 2 + i] = (unsigned)((h * 128 + R[i]) * lda + C[i]) * 2u;
    }
};
struct PoolU { const char* A; const char* B; int pm, g; };
struct PoolSched {
    typedef PoolU U;
    const char* A; const char* B; int G, c;
    __device__ __forceinline__ bool next(int i, U& u) const {
        const int L = i * G + c; if (L >= 256) return false;
        u.g = L & 3; u.pm = L >> 2;
        u.A = A + ((size_t)u.pm * 256 * 1024 + u.g * 256) * 2; u.B = B + (size_t)u.g * 256 * 256 * 2; return true;
    }
    __device__ __forceinline__ void aoffs(const U&, const int (&R)[2], const int (&C)[2], unsigned (&v)[4]) const {
#pragma unroll
        for (int h = 0; h < 2; ++h)
#pragma unroll
            for (int i = 0; i < 2; ++i) v[h * 2 + i] = (unsigned)((h * 128 + R[i]) * 1024 + C[i]) * 2u;
    }
};
struct MoeU { const char* A; const char* B; int row0, nrows, pn; };
struct MoeGUSched {
    typedef MoeU U;
    const char* H2; const char* W; const int* tile; const int* slot_tok; int G, c;
    __device__ __forceinline__ bool next(int i, U& u) const {
        const int nt = tile[3 * NTILE_MAX]; const int L = i * G + c; if (L >= nt * 4) return false;
        const int t = L >> 2; u.pn = L & 3; const int e = tile[t]; u.row0 = tile[NTILE_MAX + t]; u.nrows = tile[2 * NTILE_MAX + t];
        u.A = H2; u.B = W + ((size_t)e * 1024 + u.pn * 256) * 2048 * 2; return true;
    }
    __device__ __forceinline__ void aoffs(const U& u, const int (&R)[2], const int (&C)[2], unsigned (&v)[4]) const {
#pragma unroll
        for (int h = 0; h < 2; ++h)
#pragma unroll
            for (int i = 0; i < 2; ++i) { int r = h * 128 + R[i]; r = r < u.nrows ? r : u.nrows - 1; const int tok = slot_tok[u.row0 + r]; v[h * 2 + i] = (unsigned)(tok * 2048 + C[i]) * 2u; }
    }
};
struct MoeDownSched {
    typedef MoeU U;
    const char* ACT; const char* W; const int* tile; int G, c;
    __device__ __forceinline__ bool next(int i, U& u) const {
        const int nt = tile[3 * NTILE_MAX]; const int L = i * G + c; if (L >= nt * 8) return false;
        const int t = L >> 3; u.pn = L & 7; const int e = tile[t]; u.row0 = tile[NTILE_MAX + t]; u.nrows = tile[2 * NTILE_MAX + t];
        u.A = ACT + (size_t)u.row0 * 512 * 2; u.B = W + ((size_t)e * 2048 + u.pn * 256) * 512 * 2; return true;
    }
    __device__ __forceinline__ void aoffs(const U&, const int (&R)[2], const int (&C)[2], unsigned (&v)[4]) const {
#pragma unroll
        for (int h = 0; h < 2; ++h)
#pragma unroll
            for (int i = 0; i < 2; ++i) v[h * 2 + i] = (unsigned)((h * 128 + R[i]) * 512 + C[i]) * 2u;
    }
};

struct EpiIn {
    static constexpr bool PERM = true;
    unsigned char* ws;
    __device__ __forceinline__ void operator()(const f32x4 (&acc)[2][2][4][2], const DenseU& u, int wr, int wc, int fr, int fq) const {
        const int pn = u.pn; const int row0 = u.pm * 256 + wr * 64 + fr;
        if (pn == 16) {
            if (wc != 0) return;
            float* alr = (float*)(ws + RA_ALR);
#pragma unroll
            for (int ai = 0; ai < 2; ++ai)
#pragma unroll
                for (int m = 0; m < 4; ++m) { float* rp = alr + (size_t)(row0 + ai * 128 + m * 16) * 32 + 8 * fq;
                    *(f32x4*)(rp) = acc[ai][0][m][0]; *(f32x4*)(rp + 4) = acc[ai][0][m][1]; }
            return;
        }
        bf16* base; int ld, colt; bool lat_only;
        if (pn < 2) { base = (bf16*)(ws + RA_Q); ld = 512; colt = pn * 256; lat_only = true; }
        else if (pn < 4) { base = (bf16*)(ws + RA_K); ld = 512; colt = (pn - 2) * 256; lat_only = false; }
        else if (pn < 8) { base = (bf16*)(ws + RA_V); ld = 1024; colt = (pn - 4) * 256; lat_only = false; }
        else if (pn < 12) { base = (bf16*)(ws + RA_R); ld = 1024; colt = (pn - 8) * 256; lat_only = true; }
        else { base = (bf16*)(ws + RA_P); ld = 1024; colt = (pn - 12) * 256; lat_only = true; }
        if (lat_only && u.pm >= 64) return;
        const int col0 = colt + wc * 32 + 8 * fq;
#pragma unroll
        for (int ai = 0; ai < 2; ++ai)
#pragma unroll
            for (int m = 0; m < 4; ++m) { bf16* rp = base + (size_t)(row0 + ai * 128 + m * 16) * ld + col0;
#pragma unroll
                for (int bj = 0; bj < 2; ++bj) { const f32x4 v0 = acc[ai][bj][m][0], v1 = acc[ai][bj][m][1];
                    v4u o; o.x = pg8::cvt_pk_bf16(v0[0], v0[1]); o.y = pg8::cvt_pk_bf16(v0[2], v0[3]); o.z = pg8::cvt_pk_bf16(v1[0], v1[1]); o.w = pg8::cvt_pk_bf16(v1[2], v1[3]);
                    *(v4u*)(rp + bj * 128) = o; } }
    }
};
struct EpiPool {
    static constexpr bool PERM = true;
    bf16* ymix; const float* scale;
    __device__ __forceinline__ void operator()(const f32x4 (&acc)[2][2][4][2], const PoolU& u, int wr, int wc, int fr, int fq) const {
        const int row0 = u.pm * 256 + wr * 64 + fr; const int c0 = u.g * 256 + wc * 32 + 8 * fq;
#pragma unroll
        for (int ai = 0; ai < 2; ++ai)
#pragma unroll
            for (int m = 0; m < 4; ++m) { bf16* rp = ymix + (size_t)(row0 + ai * 128 + m * 16) * 2048 + 1024 + c0;
#pragma unroll
                for (int bj = 0; bj < 2; ++bj) { const f32x4 s0 = *(const f32x4*)(scale + c0 + bj * 128), s1 = *(const f32x4*)(scale + c0 + bj * 128 + 4);
                    const f32x4 v0 = acc[ai][bj][m][0] * s0, v1 = acc[ai][bj][m][1] * s1;
                    v4u o; o.x = pg8::cvt_pk_bf16(v0[0], v0[1]); o.y = pg8::cvt_pk_bf16(v0[2], v0[3]); o.z = pg8::cvt_pk_bf16(v1[0], v1[1]); o.w = pg8::cvt_pk_bf16(v1[2], v1[3]);
                    *(v4u*)(rp + bj * 128) = o; } }
    }
};
struct EpiOut {
    static constexpr bool PERM = false;
    float* y;
    __device__ __forceinline__ void operator()(const f32x4 (&acc)[2][2][4][2], const DenseU& u, int wr, int wc, int fr, int fq) const {
        const int row0 = u.pm * 256 + wr * 64 + fr, col0 = u.pn * 256 + wc * 32 + 4 * fq;
#pragma unroll
        for (int ai = 0; ai < 2; ++ai)
#pragma unroll
            for (int m = 0; m < 4; ++m) { float* rp = y + (size_t)(row0 + ai * 128 + m * 16) * 2048 + col0;
#pragma unroll
                for (int bj = 0; bj < 2; ++bj)
#pragma unroll
                    for (int n = 0; n < 2; ++n) *(f32x4*)(rp + bj * 128 + n * 16) = acc[ai][bj][m][n]; }
    }
};
struct EpiGU {
    static constexpr bool PERM = true;
    bf16* act; const float* slot_w;
    __device__ __forceinline__ void operator()(const f32x4 (&acc)[2][2][4][2], const MoeU& u, int wr, int wc, int fr, int fq) const {
        const int c0 = u.pn * 128 + wc * 32 + 8 * fq;
#pragma unroll
        for (int ai = 0; ai < 2; ++ai)
#pragma unroll
            for (int m = 0; m < 4; ++m) { const int r = ai * 128 + wr * 64 + m * 16 + fr;
                if (r < u.nrows) { const float w = slot_w[u.row0 + r]; float o[8];
#pragma unroll
                    for (int n = 0; n < 2; ++n)
#pragma unroll
                        for (int j = 0; j < 4; ++j) { const float g = acc[ai][0][m][n][j], up = acc[ai][1][m][n][j]; o[n * 4 + j] = silu_f(g) * up * w; }
                    v4u q; q.x = pg8::cvt_pk_bf16(o[0], o[1]); q.y = pg8::cvt_pk_bf16(o[2], o[3]); q.z = pg8::cvt_pk_bf16(o[4], o[5]); q.w = pg8::cvt_pk_bf16(o[6], o[7]);
                    *(v4u*)(act + (size_t)(u.row0 + r) * 512 + c0) = q; } }
    }
};
struct EpiDown {
    static constexpr bool PERM = true;
    bf16* so;
    __device__ __forceinline__ void operator()(const f32x4 (&acc)[2][2][4][2], const MoeU& u, int wr, int wc, int fr, int fq) const {
        const int c0 = u.pn * 256 + wc * 32 + 8 * fq;
#pragma unroll
        for (int ai = 0; ai < 2; ++ai)
#pragma unroll
            for (int m = 0; m < 4; ++m) { const int r = ai * 128 + wr * 64 + m * 16 + fr;
                if (r < u.nrows) { bf16* rp = so + (size_t)(u.row0 + r) * 2048 + c0;
#pragma unroll
                    for (int bj = 0; bj < 2; ++bj) { const f32x4 v0 = acc[ai][bj][m][0], v1 = acc[ai][bj][m][1];
                        v4u o; o.x = pg8::cvt_pk_bf16(v0[0], v0[1]); o.y = pg8::cvt_pk_bf16(v0[2], v0[3]); o.z = pg8::cvt_pk_bf16(v1[0], v1[1]); o.w = pg8::cvt_pk_bf16(v1[2], v1[3]);
                        *(v4u*)(rp + bj * 128) = o; } } }
    }
};

__device__ __forceinline__ void tr_item(const float* W, int ldn, bf16* WT, int Kd, int drow0, int k0, int n0, LAS float* scr, int lane) {
    f32x4 t[8];
#pragma unroll
    for (int i = 0; i < 8; ++i) t[i] = *(const f32x4*)(W + (size_t)(k0 + 8 * i + (lane >> 3)) * ldn + n0 + 4 * (lane & 7));
#pragma unroll
    for (int i = 0; i < 8; ++i) { LAS float* d = scr + (8 * i + (lane >> 3)) * 33 + 4 * (lane & 7); d[0] = t[i][0]; d[1] = t[i][1]; d[2] = t[i][2]; d[3] = t[i][3]; }
    LDS_WAIT(); asm volatile("" ::: "memory");
    const int c = lane & 7;
#pragma unroll
    for (int j = 0; j < 4; ++j) { const int n = (lane >> 3) + 8 * j; const LAS float* s = scr + (8 * c) * 33 + n;
        v4u o; o.x = pk2(s[0 * 33], s[1 * 33]); o.y = pk2(s[2 * 33], s[3 * 33]); o.z = pk2(s[4 * 33], s[5 * 33]); o.w = pk2(s[6 * 33], s[7 * 33]);
        *(v4u*)(WT + (size_t)(drow0 + n) * Kd + k0 + 8 * c) = o; }
    LDS_WAIT(); asm volatile("" ::: "memory");
}

__device__ __forceinline__ void phase0(const Args& a, LAS unsigned char* lds, int tid, int lane, int wave, int vcu, int G) {
    unsigned char* ws = a.ws;
    if (vcu < 192) {
        LAS float* sc = (LAS float*)lds;
        LAS float* red = (LAS float*)(lds + 73728);
        for (int i = tid; i < 9 * 2048; i += 512) { const int r = i >> 11, k = i & 2047; const float v = r < 8 ? a.in[1][r * 2048 + k] : a.in[3][k]; sc[i] = silu_f(v); }
        __syncthreads();
        const float* wm = a.in[4]; const float* bm = a.in[5]; float* mod = (float*)(ws + WS_MOD);
        for (int chunk = vcu; chunk < 192; chunk += G) {
            const int n0 = chunk * 64, ks = lane >> 4, n4 = (lane & 15) * 4;
            f32x4 acc[9];
#pragma unroll
            for (int r = 0; r < 9; ++r) acc[r] = (f32x4){0.f, 0.f, 0.f, 0.f};
#pragma unroll 4
            for (int kk = 0; kk < 256; kk += 4) { const int k = wave * 256 + kk + ks; const f32x4 wv = *(const f32x4*)(wm + (size_t)k * 12288 + n0 + n4);
#pragma unroll
                for (int r = 0; r < 9; ++r) { const float s = sc[r * 2048 + k]; acc[r] += wv * s; } }
#pragma unroll
            for (int r = 0; r < 9; ++r)
#pragma unroll
                for (int j = 0; j < 4; ++j) { float v = acc[r][j]; v += __shfl_xor(v, 16); v += __shfl_xor(v, 32); acc[r][j] = v; }
            if (lane < 16) {
#pragma unroll
                for (int r = 0; r < 9; ++r) *(LAS f32x4*)(red + (wave * 9 + r) * 64 + n4) = acc[r]; }
            __syncthreads();
            for (int i = tid; i < 9 * 64; i += 512) { const int r = i >> 6, n = i & 63; float s = 0.f;
#pragma unroll
                for (int w = 0; w < 8; ++w) s += red[(w * 9 + r) * 64 + n];
                mod[r * 12288 + n0 + n] = s + bm[n0 + n]; }
            __syncthreads();
        }
    }
    __syncthreads();
    LAS float* scr = (LAS float*)(lds + wave * 16384);
    const int gw = vcu * 8 + wave, NGW = G * 8;
    bf16* Win_t = (bf16*)(ws + WS_WIN); bf16* Wout_t = (bf16*)(ws + WS_WOUT); bf16* Wpool_t = (bf16*)(ws + WS_WPOOL); bf16* Wd_t = (bf16*)(ws + WS_WD); bf16* Wgu_t = (bf16*)(ws + WS_WGU);
    constexpr int I_IN = 32 * 129, I_OUT = 32 * 64, I_POOL = 4 * 4 * 8, I_E = 65 * 512;
    constexpr int NITEMS = I_IN + I_OUT + I_POOL + 3 * I_E;
    for (int it = gw; it < NITEMS; it += NGW) {
        int r = it;
        if (r < I_IN) { const int kb = r / 129, nb = r % 129, n0 = 32 * nb; const int drow = n0 < 3072 ? n0 : (n0 == 3072 ? 4096 : n0 - 32);
            tr_item(a.in[10], DIN, Win_t, 2048, drow, 64 * kb, n0, scr, lane); continue; } r -= I_IN;
        if (r < I_OUT) { const int kb = r / 64, nb = r % 64; tr_item(a.in[18], 2048, Wout_t, 2048, 32 * nb, 64 * kb, 32 * nb, scr, lane); continue; } r -= I_OUT;
        if (r < I_POOL) { const int g = r / 32, rr = r % 32, kb = rr / 8, nb = rr % 8; tr_item(a.in[16] + g * 65536, 256, Wpool_t + g * 65536, 256, 32 * nb, 64 * kb, 32 * nb, scr, lane); continue; } r -= I_POOL;
        if (r < I_E) { const int e = r / 512, rr = r % 512, kb = rr / 16, nb = rr % 16, n0 = 32 * nb; const float* src = e < 64 ? a.in[21] + (size_t)e * 2048 * 512 : a.in[24];
            tr_item(src, 512, Wgu_t + (size_t)e * 1024 * 2048, 2048, (n0 / 128) * 256 + (n0 % 128), 64 * kb, n0, scr, lane); continue; } r -= I_E;
        if (r < I_E) { const int e = r / 512, rr = r % 512, kb = rr / 16, nb = rr % 16, n0 = 32 * nb; const float* src = e < 64 ? a.in[22] + (size_t)e * 2048 * 512 : a.in[25];
            tr_item(src, 512, Wgu_t + (size_t)e * 1024 * 2048, 2048, (n0 / 128) * 256 + 128 + (n0 % 128), 64 * kb, n0, scr, lane); continue; } r -= I_E;
        { const int e = r / 512, rr = r % 512, kb = rr / 64, nb = rr % 64; const float* src = e < 64 ? a.in[23] + (size_t)e * 512 * 2048 : a.in[26];
            tr_item(src, 2048, Wd_t + (size_t)e * 2048 * 512, 512, 32 * nb, 64 * kb, 32 * nb, scr, lane); }
    }
    { const float* wr = a.in[19]; bf16* whi = (bf16*)(ws + WS_WRT); bf16* wlo = whi + 64 * 2048;
      for (int idx = vcu * 512 + tid; idx < 64 * 256; idx += G * 512) { const int e = idx >> 8, k8 = idx & 255; unsigned hi[8], lo[8];
#pragma unroll
          for (int j = 0; j < 8; ++j) { const float v = wr[(size_t)(8 * k8 + j) * 64 + e]; hi[j] = f2bf(v); lo[j] = f2bf(v - __builtin_bit_cast(float, hi[j] << 16)); }
          v4u oh, ol; oh.x = hi[0] | (hi[1] << 16); oh.y = hi[2] | (hi[3] << 16); oh.z = hi[4] | (hi[5] << 16); oh.w = hi[6] | (hi[7] << 16);
          ol.x = lo[0] | (lo[1] << 16); ol.y = lo[2] | (lo[3] << 16); ol.z = lo[4] | (lo[5] << 16); ol.w = lo[6] | (lo[7] << 16);
          *(v4u*)(whi + (size_t)e * 2048 + 8 * k8) = oh; *(v4u*)(wlo + (size_t)e * 2048 + 8 * k8) = ol; } }
    { v4u* z = (v4u*)(Win_t + (size_t)DIN * 2048); const int nz = (DINP - DIN) * 2048 / 8;
      for (int i = vcu * 512 + tid; i < nz; i += G * 512) z[i] = (v4u){0u, 0u, 0u, 0u}; }
}

__device__ __forceinline__ void phase1(const Args& a, int lane, int wave, int vcu, int G) {
    const float* mod = (const float*)(a.ws + WS_MOD); bf16* H = (bf16*)(a.ws + RA_H); const float* g = a.in[6];
    for (int m = vcu * 8 + wave; m < MROWS; m += G * 8) {
        const float* xr = m < NT ? a.in[0] + (size_t)m * 2048 : a.in[2] + (size_t)(m - NT) * 2048;
        const float* mr = mod + (size_t)(m < NT ? (m >> 11) : 8) * 12288;
        f32x4 v[8]; float ss = 0.f;
#pragma unroll
        for (int j = 0; j < 8; ++j) { v[j] = *(const f32x4*)(xr + 4 * (lane + 64 * j)); ss += v[j][0] * v[j][0] + v[j][1] * v[j][1] + v[j][2] * v[j][2] + v[j][3] * v[j][3]; }
        const float rstd = rsqrtf(wave_sum(ss) * (1.f / 2048.f) + EPS);
#pragma unroll
        for (int j = 0; j < 8; ++j) { const int c = 4 * (lane + 64 * j); const f32x4 gg = *(const f32x4*)(g + c), sh = *(const f32x4*)(mr + c), sc = *(const f32x4*)(mr + 2048 + c);
            const f32x4 o = v[j] * rstd * gg * (sc + 1.f) + sh;
            v2u q; q.x = pk2(o[0], o[1]); q.y = pk2(o[2], o[3]); *(v2u*)(H + (size_t)m * 2048 + c) = q; }
    }
}

__device__ __forceinline__ int scan_row(int b, int dir, int s) {
    if (s < 256) { const int tc = dir ? 255 - s : s; return NT + b * 256 + tc; }
    const int t0 = s - 256; return b * 2048 + (dir ? 2047 - t0 : t0);
}
__device__ __forceinline__ void phase3_prep(const Args& a, LAS unsigned char* lds, int tid, int vcu, int G) {
    unsigned char* ws = a.ws;
    const bf16* Q = (const bf16*)(ws + RA_Q); const bf16* Kb = (const bf16*)(ws + RA_K); const float* ALR = (const float*)(ws + RA_ALR);
    bf16* QG = (bf16*)(ws + PQG); bf16* QM = (bf16*)(ws + PQM); bf16* KM = (bf16*)(ws + PKM); bf16* KD = (bf16*)(ws + PKD); float* DEC = (float*)(ws + PDEC);
    LAS float* alr = (LAS float*)lds;
    LAS bf16* Kt = (LAS bf16*)(lds + 4096);
    LAS bf16* Qt = (LAS bf16*)(lds + 4096 + 65536);
    const int col = tid, h = col >> 7, dk = col & 127;
    for (int item = vcu; item < 2 * 8 * 36; item += G) {
        const int ch = item % 36, b = (item / 36) & 7, dir = item / 288;
        const bool lat = ch >= 4;
        if (tid < 256) { const int i = tid >> 2, r4 = (tid & 3) * 4; const int row = scan_row(b, dir, ch * 64 + i);
            *(LAS f32x4*)(alr + i * 16 + r4) = *(const f32x4*)(ALR + (size_t)row * 32 + dir * 16 + r4); }
        { v4u kr[8], qr[8];
#pragma unroll
          for (int q = 0; q < 8; ++q) { const int p = tid + 512 * q, i = p >> 6, c8 = (p & 63) * 8; const int row = scan_row(b, dir, ch * 64 + i);
              kr[q] = *(const v4u*)(Kb + (size_t)row * 512 + c8); if (lat) qr[q] = *(const v4u*)(Q + (size_t)row * 512 + c8); }
#pragma unroll
          for (int q = 0; q < 8; ++q) { const int p = tid + 512 * q; *(LAS v4u*)(Kt + p * 8) = kr[q]; if (lat) *(LAS v4u*)(Qt + p * 8) = qr[q]; } }
        const float* wa2 = dir ? a.in[13] : a.in[11]; const float bia = (dir ? a.in[14] : a.in[12])[col];
        float w[16];
#pragma unroll
        for (int r = 0; r < 16; ++r) w[r] = wa2[r * 512 + col];
        __syncthreads();
        float Gc = 0.f, Gmid = 0.f;
#pragma unroll 4
        for (int i = 0; i < 64; ++i) { float z = bia;
#pragma unroll
            for (int r4 = 0; r4 < 4; ++r4) { const f32x4 x = *(const LAS f32x4*)(alr + i * 16 + 4 * r4); z += x[0] * w[4 * r4] + x[1] * w[4 * r4 + 1] + x[2] * w[4 * r4 + 2] + x[3] * w[4 * r4 + 3]; }
            Gc += (fminf(z, 0.f) - __logf(1.f + __expf(-fabsf(z)))) * (1.f / 16.f);
            if (i == 32) Gmid = Gc; }
        const float Gend = Gc;
        DEC[((size_t)(dir * 8 + b) * 36 + ch) * 512 + col] = __expf(Gend);
        bf16* kdrow = KD + ((((size_t)(dir * 8 + b) * 36 + ch) * 4 + h) * 128 + dk) * 64;
        const size_t lt = lat ? ((((size_t)(dir * 8 + b) * 32 + (ch - 4)) * 4 + h) * 64) * 128 + dk : 0;
        Gc = 0.f;
#pragma unroll 1
        for (int i0 = 0; i0 < 64; i0 += 8) { unsigned kd[8];
#pragma unroll
            for (int ii = 0; ii < 8; ++ii) { const int i = i0 + ii; float z = bia;
#pragma unroll
                for (int r4 = 0; r4 < 4; ++r4) { const f32x4 x = *(const LAS f32x4*)(alr + i * 16 + 4 * r4); z += x[0] * w[4 * r4] + x[1] * w[4 * r4 + 1] + x[2] * w[4 * r4 + 2] + x[3] * w[4 * r4 + 3]; }
                Gc += (fminf(z, 0.f) - __logf(1.f + __expf(-fabsf(z)))) * (1.f / 16.f);
                const float kv = bf1(Kt[i * 512 + col]);
                kd[ii] = f2bf(kv * __expf(Gend - Gc));
                if (lat) { const float qv = bf1(Qt[i * 512 + col]) * 0.08838834764831845f;
                    QG[lt + (size_t)i * 128] = (bf16)f2bf(qv * __expf(Gc)); QM[lt + (size_t)i * 128] = (bf16)f2bf(qv * __expf(Gc - Gmid)); KM[lt + (size_t)i * 128] = (bf16)f2bf(kv * __expf(Gmid - Gc)); } }
            v4u o; o.x = kd[0] | (kd[1] << 16); o.y = kd[2] | (kd[3] << 16); o.z = kd[4] | (kd[5] << 16); o.w = kd[6] | (kd[7] << 16);
            *(v4u*)(kdrow + i0) = o; }
        __syncthreads();
    }
}

constexpr int GL_QG = 0, GL_QM = 17408, GL_KM = 34816, GL_ST = 52224, GL_KDT = 69632, GL_VT = 88064, GL_AM = 97280, GL_DEC = 106496;
__device__ __forceinline__ void phase_chain(const Args& a, LAS unsigned char* lds, int tid, int lane, int wave, int vcu, int G) {
    unsigned char* ws = a.ws;
    const v4u* QG = (const v4u*)(ws + PQG); const v4u* QM = (const v4u*)(ws + PQM); const v4u* KM = (const v4u*)(ws + PKM); const v4u* KD = (const v4u*)(ws + PKD); const float* DEC = (const float*)(ws + PDEC);
    const bf16* V = (const bf16*)(ws + RA_V); float* OF = (float*)(ws + RA_OF);
    const int l15 = lane & 15, l4 = lane >> 4;
    for (int item = vcu; item < 256; item += G) {
        const int vs = item & 3, dir = (item >> 2) & 1, h = (item >> 3) & 3, b = item >> 5;
        f32x4 S[4];
#pragma unroll
        for (int tv = 0; tv < 4; ++tv) S[tv] = (f32x4){0.f, 0.f, 0.f, 0.f};
        v4u rq[6], rk[2], rv; float rdec = 0.f;
#define GL_LOAD(ch_) do { const int ch__ = (ch_); \
            if (ch__ >= 4) { const size_t t_ = ((((size_t)(dir * 8 + b) * 32 + (ch__ - 4)) * 4 + h) * 1024); \
                rq[0] = QG[t_ + tid]; rq[1] = QG[t_ + tid + 512]; rq[2] = QM[t_ + tid]; rq[3] = QM[t_ + tid + 512]; rq[4] = KM[t_ + tid]; rq[5] = KM[t_ + tid + 512]; } \
            { const size_t t_ = ((((size_t)(dir * 8 + b) * 36 + ch__) * 4 + h) * 1024); rk[0] = KD[t_ + tid]; rk[1] = KD[t_ + tid + 512]; } \
            { const int row_ = scan_row(b, dir, ch__ * 64 + (tid >> 3)); rv = *(const v4u*)(V + (size_t)row_ * 1024 + h * 256 + vs * 64 + 8 * (tid & 7)); } \
            if (tid < 128) rdec = DEC[((size_t)(dir * 8 + b) * 36 + ch__) * 512 + h * 128 + tid]; } while (0)
        GL_LOAD(0);
        for (int ch = 0; ch < 36; ++ch) {
            const bool lat = ch >= 4;
#pragma unroll
            for (int tv = 0; tv < 4; ++tv) { v2u p; p.x = pk2(S[tv][0], S[tv][1]); p.y = pk2(S[tv][2], S[tv][3]);
                *(LAS v2u*)(lds + GL_ST + (16 * tv + l15) * 272 + (16 * wave + 4 * l4) * 2) = p; }
            if (lat) {
#pragma unroll
                for (int q = 0; q < 2; ++q) { const int p = tid + 512 * q; const int off = (p >> 4) * 272 + (p & 15) * 16;
                    *(LAS v4u*)(lds + GL_QG + off) = rq[q]; *(LAS v4u*)(lds + GL_QM + off) = rq[2 + q]; *(LAS v4u*)(lds + GL_KM + off) = rq[4 + q]; } }
#pragma unroll
            for (int q = 0; q < 2; ++q) { const int p = tid + 512 * q; *(LAS v4u*)(lds + GL_KDT + (p >> 3) * 144 + (p & 7) * 16) = rk[q]; }
            { const int i = tid >> 3, c = tid & 7; LAS bf16* vt = (LAS bf16*)(lds + GL_VT) + i;
              vt[(8 * c + 0) * 72] = (bf16)(rv.x & 0xffffu); vt[(8 * c + 1) * 72] = (bf16)(rv.x >> 16); vt[(8 * c + 2) * 72] = (bf16)(rv.y & 0xffffu); vt[(8 * c + 3) * 72] = (bf16)(rv.y >> 16);
              vt[(8 * c + 4) * 72] = (bf16)(rv.z & 0xffffu); vt[(8 * c + 5) * 72] = (bf16)(rv.z >> 16); vt[(8 * c + 6) * 72] = (bf16)(rv.w & 0xffffu); vt[(8 * c + 7) * 72] = (bf16)(rv.w >> 16); }
            if (tid < 128) *(LAS float*)(lds + GL_DEC + tid * 4) = rdec;
            __syncthreads();
            if (ch + 1 < 36) GL_LOAD(ch + 1);
            if (lat) {
                { const int ti = wave >> 1; f32x4 c0 = (f32x4){0.f, 0.f, 0.f, 0.f}, c1 = c0; const int tj0 = (wave & 1) * 2;
#pragma unroll
                  for (int ks = 0; ks < 4; ++ks) { const int ko = (32 * ks + 8 * l4) * 2;
                      const bf16x8 bq = *(const LAS bf16x8*)(lds + GL_QM + (16 * ti + l15) * 272 + ko);
                      const bf16x8 a0 = *(const LAS bf16x8*)(lds + GL_KM + (16 * tj0 + l15) * 272 + ko), a1 = *(const LAS bf16x8*)(lds + GL_KM + (16 * tj0 + 16 + l15) * 272 + ko);
                      c0 = __builtin_amdgcn_mfma_f32_16x16x32_bf16(a0, bq, c0, 0, 0, 0); c1 = __builtin_amdgcn_mfma_f32_16x16x32_bf16(a1, bq, c1, 0, 0, 0); }
                  const int i = 16 * ti + l15;
                  { const int j0 = 16 * tj0 + 4 * l4; v2u p; p.x = pk2(j0 <= i ? c0[0] : 0.f, j0 + 1 <= i ? c0[1] : 0.f); p.y = pk2(j0 + 2 <= i ? c0[2] : 0.f, j0 + 3 <= i ? c0[3] : 0.f);
                    *(LAS v2u*)(lds + GL_AM + i * 144 + j0 * 2) = p; }
                  { const int j0 = 16 * tj0 + 16 + 4 * l4; v2u p; p.x = pk2(j0 <= i ? c1[0] : 0.f, j0 + 1 <= i ? c1[1] : 0.f); p.y = pk2(j0 + 2 <= i ? c1[2] : 0.f, j0 + 3 <= i ? c1[3] : 0.f);
                    *(LAS v2u*)(lds + GL_AM + i * 144 + j0 * 2) = p; } }
                __syncthreads();
                { const int ti = wave >> 1, tv0 = (wave & 1) * 2; f32x4 c0 = (f32x4){0.f, 0.f, 0.f, 0.f}, c1 = c0;
#pragma unroll
                  for (int ks = 0; ks < 4; ++ks) { const int ko = (32 * ks + 8 * l4) * 2;
                      const bf16x8 bq = *(const LAS bf16x8*)(lds + GL_QG + (16 * ti + l15) * 272 + ko);
                      const bf16x8 a0 = *(const LAS bf16x8*)(lds + GL_ST + (16 * tv0 + l15) * 272 + ko), a1 = *(const LAS bf16x8*)(lds + GL_ST + (16 * tv0 + 16 + l15) * 272 + ko);
                      c0 = __builtin_amdgcn_mfma_f32_16x16x32_bf16(a0, bq, c0, 0, 0, 0); c1 = __builtin_amdgcn_mfma_f32_16x16x32_bf16(a1, bq, c1, 0, 0, 0); }
#pragma unroll
                  for (int ks = 0; ks < 2; ++ks) { const int ko = (32 * ks + 8 * l4) * 2;
                      const bf16x8 bq = *(const LAS bf16x8*)(lds + GL_AM + (16 * ti + l15) * 144 + ko);
                      const bf16x8 a0 = *(const LAS bf16x8*)(lds + GL_VT + (16 * tv0 + l15) * 144 + ko), a1 = *(const LAS bf16x8*)(lds + GL_VT + (16 * tv0 + 16 + l15) * 144 + ko);
                      c0 = __builtin_amdgcn_mfma_f32_16x16x32_bf16(a0, bq, c0, 0, 0, 0); c1 = __builtin_amdgcn_mfma_f32_16x16x32_bf16(a1, bq, c1, 0, 0, 0); }
                  const int s = ch * 64 + 16 * ti + l15; const int t0 = s - 256; const int t = dir ? 2047 - t0 : t0;
                  float* orow = OF + ((size_t)dir * NT + b * 2048 + t) * 1024 + h * 256 + vs * 64 + 16 * tv0 + 4 * l4;
                  *(f32x4*)(orow) = c0; *(f32x4*)(orow + 16) = c1; }
            }
            { const f32x4 d4 = *(const LAS f32x4*)(lds + GL_DEC + (16 * wave + 4 * l4) * 4);
#pragma unroll
              for (int tv = 0; tv < 4; ++tv) S[tv] = S[tv] * d4;
#pragma unroll
              for (int ks = 0; ks < 2; ++ks) { const int ko = (32 * ks + 8 * l4) * 2;
                  const bf16x8 ak = *(const LAS bf16x8*)(lds + GL_KDT + (16 * wave + l15) * 144 + ko);
#pragma unroll
                  for (int tv = 0; tv < 4; ++tv) { const bf16x8 bv = *(const LAS bf16x8*)(lds + GL_VT + (16 * tv + l15) * 144 + ko);
                      S[tv] = __builtin_amdgcn_mfma_f32_16x16x32_bf16(ak, bv, S[tv], 0, 0, 0); } } }
            __syncthreads();
        }
#undef GL_LOAD
    }
}

template <int HALFW>
__device__ __forceinline__ void pool_item(const bf16* P, bf16* DP, LAS float* tmp, int tid, int b, int r, int g) {
    const int rlo = r - HALFW < 0 ? 0 : r - HALFW, rhi = r + HALFW > 32 ? 32 : r + HALFW;
    const float rinv = 1.f / (float)(rhi - rlo);
#pragma unroll 1
    for (int q = 0; q < 4; ++q) { const int p = tid + 512 * q, c = p >> 5, ch0 = (p & 31) * 8; float acc[8]; v4u x[2 * HALFW];
#pragma unroll
        for (int u = 0; u < 2 * HALFW; ++u) { const int rr = (rlo + u < rhi) ? rlo + u : rlo; x[u] = *(const v4u*)(P + ((size_t)(b * 2048 + rr * 64 + c)) * 1024 + g * 256 + ch0); }
#pragma unroll
        for (int j = 0; j < 8; ++j) acc[j] = 0.f;
#pragma unroll
        for (int u = 0; u < 2 * HALFW; ++u) { const float m = (rlo + u < rhi) ? 1.f : 0.f;
            acc[0] += m * bflo(x[u].x); acc[1] += m * bfhi(x[u].x); acc[2] += m * bflo(x[u].y); acc[3] += m * bfhi(x[u].y); acc[4] += m * bflo(x[u].z); acc[5] += m * bfhi(x[u].z); acc[6] += m * bflo(x[u].w); acc[7] += m * bfhi(x[u].w); }
        *(LAS f32x4*)(tmp + c * 256 + ch0) = (f32x4){acc[0] * rinv, acc[1] * rinv, acc[2] * rinv, acc[3] * rinv};
        *(LAS f32x4*)(tmp + c * 256 + ch0 + 4) = (f32x4){acc[4] * rinv, acc[5] * rinv, acc[6] * rinv, acc[7] * rinv}; }
    __syncthreads();
#pragma unroll 1
    for (int q = 0; q < 4; ++q) { const int p = tid + 512 * q, c = p >> 5, ch0 = (p & 31) * 8;
        const int clo = c - HALFW < 0 ? 0 : c - HALFW, chi = c + HALFW > 64 ? 64 : c + HALFW; const float cinv = 1.f / (float)(chi - clo);
        const size_t o = ((size_t)(b * 2048 + r * 64 + c)) * 1024 + g * 256 + ch0;
        const v4u x = *(const v4u*)(P + o);
        f32x4 a0 = (f32x4){0.f, 0.f, 0.f, 0.f}, a1 = a0;
#pragma unroll
        for (int u = 0; u < 2 * HALFW; ++u) { const int cc = (clo + u < chi) ? clo + u : clo; const float m = (clo + u < chi) ? 1.f : 0.f;
            a0 += *(const LAS f32x4*)(tmp + cc * 256 + ch0) * m; a1 += *(const LAS f32x4*)(tmp + cc * 256 + ch0 + 4) * m; }
        v4u d; d.x = pk2(a0[0] * cinv - bflo(x.x), a0[1] * cinv - bfhi(x.x)); d.y = pk2(a0[2] * cinv - bflo(x.y), a0[3] * cinv - bfhi(x.y));
        d.z = pk2(a1[0] * cinv - bflo(x.z), a1[1] * cinv - bfhi(x.z)); d.w = pk2(a1[2] * cinv - bflo(x.w), a1[3] * cinv - bfhi(x.w));
        *(v4u*)(DP + o) = d; }
    __syncthreads();
}
__device__ __forceinline__ void phase3_pool(const Args& a, LAS unsigned char* lds, int tid, int vcu, int G) {
    const bf16* P = (const bf16*)(a.ws + RA_P); bf16* DP = (bf16*)(a.ws + RA_DPOOL);
    LAS float* tmp = (LAS float*)lds;
    for (int item = vcu; item < 1024; item += G) {
        const int g = item >> 8, r = (item >> 3) & 31, b = item & 7;
        const int gg = 3 - g;
        if (gg == 0) pool_item<1>(P, DP, tmp, tid, b, r, gg); else if (gg == 1) pool_item<2>(P, DP, tmp, tid, b, r, gg); else if (gg == 2) pool_item<4>(P, DP, tmp, tid, b, r, gg); else pool_item<8>(P, DP, tmp, tid, b, r, gg);
    }
}

__device__ __forceinline__ void phase4_post(const Args& a, int lane, int wave, int vcu, int G) {
    const float* OF = (const float*)(a.ws + RA_OF); const float* OB = OF + (size_t)NT * 1024; const bf16* Rr = (const bf16*)(a.ws + RA_R); bf16* Y = (bf16*)(a.ws + RA_YMIX);
    const float* gn = a.in[15];
    for (int idx = vcu * 8 + wave; idx < NT * 4; idx += G * 8) {
        const int t = idx >> 2, h = idx & 3; const size_t o = (size_t)t * 1024 + h * 256 + 4 * lane;
        const f32x4 x = *(const f32x4*)(OF + o) + *(const f32x4*)(OB + o);
        const float ms = wave_sum(x[0] * x[0] + x[1] * x[1] + x[2] * x[2] + x[3] * x[3]) * (1.f / 256.f);
        const float sc = rsqrtf(ms + EPS);
        const f32x4 g4 = *(const f32x4*)(gn + h * 256 + 4 * lane);
        const v2u rr = *(const v2u*)(Rr + o);
        const float r0 = bflo(rr.x), r1 = bfhi(rr.x), r2 = bflo(rr.y), r3 = bfhi(rr.y);
        v2u q; q.x = pk2(x[0] * sc * g4[0] * silu_f(r0), x[1] * sc * g4[1] * silu_f(r1)); q.y = pk2(x[2] * sc * g4[2] * silu_f(r2), x[3] * sc * g4[3] * silu_f(r3));
        *(v2u*)(Y + (size_t)t * 2048 + h * 256 + 4 * lane) = q;
    }
}

__device__ __forceinline__ void phase6(const Args& a, LAS unsigned char* lds, int tid, int lane, int wave, int vcu, int G) {
    unsigned char* ws = a.ws;
    const float* mod = (const float*)(ws + WS_MOD); const float* Y1 = (const float*)(ws + RA_Y1); bf16* H2 = (bf16*)(ws + RA_H2);
    const float* gpost = a.in[7]; const float* gpre2 = a.in[8]; const float* rbias = a.in[20];
    const bf16* whi = (const bf16*)(ws + WS_WRT); const bf16* wlo = whi + 64 * 2048;
    LAS float* part = (LAS float*)lds;
    LAS float* logit = (LAS float*)(lds + LDS_LOGIT);
    LAS u64* masks = (LAS u64*)(lds + LDS_MASKS);
    int* cnt = (int*)(ws + T_CNT); u64* tmask = (u64*)(ws + T_MASK); float* tokw = (float*)(ws + T_TOKW);
    const int l15 = lane & 15, l4 = lane >> 4;
    for (int blk = vcu; blk < NT / 64; blk += G) {
        for (int it = 0; it < 4; ++it) {
            { const int lr0 = wave * 2, t0 = blk * 64 + it * 16 + lr0; const float* mr = mod + (size_t)(t0 >> 11) * 12288;
              f32x4 y[2][8], xx[2][8]; float ss[2] = {0.f, 0.f};
#pragma unroll
              for (int rr = 0; rr < 2; ++rr)
#pragma unroll
                  for (int j = 0; j < 8; ++j) { y[rr][j] = *(const f32x4*)(Y1 + (size_t)(t0 + rr) * 2048 + 4 * (lane + 64 * j)); xx[rr][j] = *(const f32x4*)(a.in[0] + (size_t)(t0 + rr) * 2048 + 4 * (lane + 64 * j)); }
#pragma unroll
              for (int rr = 0; rr < 2; ++rr)
#pragma unroll
                  for (int j = 0; j < 8; ++j) ss[rr] += y[rr][j][0] * y[rr][j][0] + y[rr][j][1] * y[rr][j][1] + y[rr][j][2] * y[rr][j][2] + y[rr][j][3] * y[rr][j][3];
              const float rstd1[2] = {rsqrtf(wave_sum(ss[0]) * (1.f / 2048.f) + EPS), rsqrtf(wave_sum(ss[1]) * (1.f / 2048.f) + EPS)};
              float s2[2] = {0.f, 0.f};
              asm volatile("" ::: "memory");
#pragma unroll
              for (int j = 0; j < 8; ++j) { const int c = 4 * (lane + 64 * j); const f32x4 gp = *(const f32x4*)(gpost + c), gt = *(const f32x4*)(mr + 4096 + c);
#pragma unroll
                  for (int rr = 0; rr < 2; ++rr) { const f32x4 x1 = xx[rr][j] + gt * (y[rr][j] * rstd1[rr] * gp); y[rr][j] = x1; *(f32x4*)((float*)(ws + WS_X1) + (size_t)(t0 + rr) * 2048 + c) = x1;
                      s2[rr] += x1[0] * x1[0] + x1[1] * x1[1] + x1[2] * x1[2] + x1[3] * x1[3]; }
                  if (j & 1) asm volatile("" ::: "memory"); }
              const float rstd2[2] = {rsqrtf(wave_sum(s2[0]) * (1.f / 2048.f) + EPS), rsqrtf(wave_sum(s2[1]) * (1.f / 2048.f) + EPS)};
              asm volatile("" ::: "memory");
#pragma unroll
              for (int j = 0; j < 8; ++j) { const int c = 4 * (lane + 64 * j); const f32x4 g2 = *(const f32x4*)(gpre2 + c), sh = *(const f32x4*)(mr + 6144 + c), sc = *(const f32x4*)(mr + 8192 + c);
#pragma unroll
                  for (int rr = 0; rr < 2; ++rr) { const f32x4 hh = y[rr][j] * rstd2[rr] * g2 * (sc + 1.f) + sh;
                      unsigned hi[4], lo[4];
#pragma unroll
                      for (int q = 0; q < 4; ++q) { hi[q] = f2bf(hh[q]); lo[q] = f2bf(hh[q] - __builtin_bit_cast(float, hi[q] << 16)); }
                      v2u qh, ql; qh.x = hi[0] | (hi[1] << 16); qh.y = hi[2] | (hi[3] << 16); ql.x = lo[0] | (lo[1] << 16); ql.y = lo[2] | (lo[3] << 16);
                      *(LAS v2u*)(lds + RT_HI + (lr0 + rr) * RT_ROWB + c * 2) = qh; *(LAS v2u*)(lds + RT_LO + (lr0 + rr) * RT_ROWB + c * 2) = ql;
                      *(v2u*)(H2 + (size_t)(t0 + rr) * 2048 + c) = qh; }
                  if (j & 1) asm volatile("" ::: "memory"); }
            }
            __syncthreads();
            { f32x4 acc[4];
#pragma unroll
              for (int et = 0; et < 4; ++et) acc[et] = (f32x4){0.f, 0.f, 0.f, 0.f};
#pragma unroll 1
              for (int ks = 0; ks < 8; ++ks) { const int k0 = 256 * wave + 32 * ks + 8 * l4;
                  const bf16x8 ah = *(const LAS bf16x8*)(lds + RT_HI + l15 * RT_ROWB + k0 * 2), al = *(const LAS bf16x8*)(lds + RT_LO + l15 * RT_ROWB + k0 * 2);
#pragma unroll
                  for (int et = 0; et < 4; ++et) { const bf16x8 bh = *(const bf16x8*)(whi + (size_t)(16 * et + l15) * 2048 + k0), bl = *(const bf16x8*)(wlo + (size_t)(16 * et + l15) * 2048 + k0);
                      acc[et] = __builtin_amdgcn_mfma_f32_16x16x32_bf16(ah, bh, acc[et], 0, 0, 0);
                      acc[et] = __builtin_amdgcn_mfma_f32_16x16x32_bf16(ah, bl, acc[et], 0, 0, 0);
                      acc[et] = __builtin_amdgcn_mfma_f32_16x16x32_bf16(al, bh, acc[et], 0, 0, 0); } }
              __syncthreads();
#pragma unroll
              for (int et = 0; et < 4; ++et)
#pragma unroll
                  for (int q = 0; q < 4; ++q) part[(wave * 16 + 4 * l4 + q) * 64 + 16 * et + l15] = acc[et][q]; }
            __syncthreads();
#pragma unroll
            for (int q = 0; q < 2; ++q) { const int idx = tid + 512 * q; float sacc = 0.f;
#pragma unroll
                for (int w = 0; w < 8; ++w) sacc += part[w * 1024 + idx];
                logit[idx] = sacc; }
            __syncthreads();
#pragma unroll 1
            for (int rr = 0; rr < 2; ++rr) {
                const int lr = wave * 2 + rr, t = blk * 64 + it * 16 + lr;
                const float lg = logit[lr * 64 + lane]; const float s = 1.f / (1.f + __expf(-lg)); const float sel = s + rbias[lane];
                float m1 = sel; m1 = fmaxf(m1, __shfl_xor(m1, 1)); m1 = fmaxf(m1, __shfl_xor(m1, 2)); m1 = fmaxf(m1, __shfl_xor(m1, 4));
                const u64 eq = __ballot(sel == m1); const unsigned gb = (unsigned)(eq >> (lane & ~7)) & 0xffu; const int first = __builtin_ctz(gb);
                float v2 = ((lane & 7) == first) ? -INFINITY : sel; v2 = fmaxf(v2, __shfl_xor(v2, 1)); v2 = fmaxf(v2, __shfl_xor(v2, 2)); v2 = fmaxf(v2, __shfl_xor(v2, 4));
                const float gs = m1 + v2; const int g = lane >> 3; int grank = 0;
#pragma unroll
                for (int g2 = 0; g2 < 8; ++g2) { const float o = __shfl(gs, g2 * 8); grank += (o > gs || (o == gs && g2 < g)) ? 1 : 0; }
                const bool gsel = grank < 4; const float mk = gsel ? sel : -INFINITY; int rank = 0;
                for (int e2 = 0; e2 < 64; ++e2) { const float o = __shfl(mk, e2); rank += (o > mk || (o == mk && e2 < lane)) ? 1 : 0; }
                const bool chosen = gsel && rank < 8;
                const u64 mask = __ballot(chosen); const float ssum = wave_sum(chosen ? s : 0.f);
                const int kidx = __popcll(mask & ((1ull << lane) - 1ull));
                if (chosen) tokw[(size_t)t * 8 + kidx] = s / ssum * 2.5f;
                if (lane == 0) { tmask[t] = mask; masks[it * 16 + lr] = mask; }
            }
            __syncthreads();
        }
        if (wave == 0) { const u64 m = masks[lane]; int mine = 0;
            for (int e = 0; e < 64; ++e) { const int c = __popcll(__ballot((m >> e) & 1ull)); mine = (lane == e) ? c : mine; }
            cnt[blk * 64 + lane] = mine; }
        __syncthreads();
    }
}

__device__ __forceinline__ void phase7(const Args& a, LAS unsigned char* lds, int tid, int lane, int wave, int vcu, int G) {
    unsigned char* ws = a.ws;
    const int* cnt = (const int*)(ws + T_CNT); const u64* tmask = (const u64*)(ws + T_MASK); const float* tokw = (const float*)(ws + T_TOKW);
    int* tokslot = (int*)(ws + T_TOKSLOT); int* slottok = (int*)(ws + T_SLOTTOK); float* slotw = (float*)(ws + T_SLOTW); int* tile = (int*)(ws + T_TILE);
    LAS int* part = (LAS int*)lds;
    LAS int* tot = (LAS int*)(lds + 4096);
    for (int blk = vcu; blk < NT / 64; blk += G) {
        int pre = 0, all = 0;
        for (int b2 = wave; b2 < 256; b2 += 8) { const int c = cnt[b2 * 64 + lane]; all += c; pre += (b2 < blk) ? c : 0; }
        part[(wave * 2) * 64 + lane] = pre; part[(wave * 2 + 1) * 64 + lane] = all;
        __syncthreads();
        if (wave == 0) {
            int p = 0, t = 0;
#pragma unroll
            for (int w = 0; w < 8; ++w) { p += part[(w * 2) * 64 + lane]; t += part[(w * 2 + 1) * 64 + lane]; }
            int incl = t;
#pragma unroll
            for (int o = 1; o < 64; o <<= 1) { const int v = __shfl_up(incl, o); if (lane >= o) incl += v; }
            const int start = incl - t; const int base = start + p;
            tot[lane] = t; tot[64 + lane] = start;
            const int tokn = blk * 64 + lane; const u64 m = tmask[tokn];
            for (int e = 0; e < 64; ++e) { const bool bit = (m >> e) & 1ull; const u64 bal = __ballot(bit); const int be = __shfl(base, e);
                if (bit) { const int rank = __popcll(bal & ((1ull << lane) - 1ull)); const int slot = be + rank; const int k = __popcll(m & ((1ull << e) - 1ull));
                    slottok[slot] = tokn; slotw[slot] = tokw[(size_t)tokn * 8 + k]; tokslot[(size_t)tokn * 8 + k] = slot; } }
            slottok[SH_ROW0 + tokn] = tokn; slotw[SH_ROW0 + tokn] = 1.f;
        }
        __syncthreads();
        if (blk == 0 && tid == 0) {
            int n = 0;
            for (int e = 0; e < 64; ++e) { const int te = tot[e], st = tot[64 + e];
                for (int j = 0; j * 256 < te; ++j) { tile[n] = e; tile[NTILE_MAX + n] = st + j * 256; tile[2 * NTILE_MAX + n] = (te - j * 256) < 256 ? (te - j * 256) : 256; ++n; } }
            for (int j = 0; j < 64; ++j) { tile[n] = 64; tile[NTILE_MAX + n] = SH_ROW0 + j * 256; tile[2 * NTILE_MAX + n] = 256; ++n; }
            tile[3 * NTILE_MAX] = n;
        }
        __syncthreads();
    }
}

__device__ __forceinline__ void phase10(const Args& a, int lane, int wave, int vcu, int G) {
    unsigned char* ws = a.ws;
    const float* mod = (const float*)(ws + WS_MOD); const bf16* SO = (const bf16*)(ws + WS_SLOTOUT); const int* tokslot = (const int*)(ws + T_TOKSLOT); const float* gp = a.in[9];
    for (int t = vcu * 8 + wave; t < NT; t += G * 8) {
        const float* mr = mod + (size_t)(t >> 11) * 12288;
        const int myslot = lane < 8 ? tokslot[(size_t)t * 8 + lane] : SH_ROW0 + t;
        v4u x[9][4]; f32x4 xo[4][2]; const float* x1r = (const float*)(ws + WS_X1) + (size_t)t * 2048;
#pragma unroll
        for (int k = 0; k < 9; ++k) { const int slot = __shfl(myslot, k); const bf16* sr = SO + (size_t)slot * 2048;
#pragma unroll
            for (int j = 0; j < 4; ++j) x[k][j] = *(const v4u*)(sr + 8 * (lane + 64 * j)); }
#pragma unroll
        for (int j = 0; j < 4; ++j) { xo[j][0] = *(const f32x4*)(x1r + 8 * (lane + 64 * j)); xo[j][1] = *(const f32x4*)(x1r + 8 * (lane + 64 * j) + 4); }
        float y[4][8];
#pragma unroll
        for (int j = 0; j < 4; ++j)
#pragma unroll
            for (int q = 0; q < 8; ++q) y[j][q] = 0.f;
#pragma unroll
        for (int k = 0; k < 9; ++k)
#pragma unroll
            for (int j = 0; j < 4; ++j) { const v4u v = x[k][j];
                y[j][0] += bflo(v.x); y[j][1] += bfhi(v.x); y[j][2] += bflo(v.y); y[j][3] += bfhi(v.y); y[j][4] += bflo(v.z); y[j][5] += bfhi(v.z); y[j][6] += bflo(v.w); y[j][7] += bfhi(v.w); }
        float ss = 0.f;
#pragma unroll
        for (int j = 0; j < 4; ++j)
#pragma unroll
            for (int q = 0; q < 8; ++q) ss += y[j][q] * y[j][q];
        const float rstd = rsqrtf(wave_sum(ss) * (1.f / 2048.f) + EPS);
        float* outr = a.out + (size_t)t * 2048;
#pragma unroll
        for (int j = 0; j < 4; ++j)
#pragma unroll
            for (int hh = 0; hh < 2; ++hh) { const int c = 8 * (lane + 64 * j) + 4 * hh; const f32x4 x1 = xo[j][hh], g = *(const f32x4*)(gp + c), gt = *(const f32x4*)(mr + 10240 + c);
                f32x4 yy; yy[0] = y[j][4 * hh]; yy[1] = y[j][4 * hh + 1]; yy[2] = y[j][4 * hh + 2]; yy[3] = y[j][4 * hh + 3];
                *(f32x4*)(outr + c) = x1 + gt * (yy * rstd * g); }
    }
}

__global__ void __launch_bounds__(512, 2) fwd(Args args) {
    extern __shared__ __attribute__((aligned(16))) unsigned char lds_raw[];
    LAS unsigned char* lds = (LAS unsigned char*)lds_raw;
    const int tid = threadIdx.x, lane = tid & 63, wave = __builtin_amdgcn_readfirstlane(tid >> 6);
    const int G = gridDim.x, bx = blockIdx.x;
    const int vcu = (G % 8 == 0) ? (bx % 8) * (G / 8) + bx / 8 : bx;
    unsigned char* ws = args.ws;
    volatile LAS unsigned* MISC = (volatile LAS unsigned*)(lds + LDS_MISC);
    if (tid < 64) MISC[tid] = 0u;
    __syncthreads();
    const int lo = args.ph_lo, hi = args.ph_hi;
    XcdBarrier bar; bar.bar = (unsigned*)(ws + WS_CTL) + 4096; bar.x = 0; bar.st = nullptr;
    if (hi - lo > 1) bar = xcd_barrier_post((unsigned*)(ws + WS_CTL) + 4096, MISC + 8);
#ifndef PH_MASK
#define PH_MASK 0xfff
#endif
#define IN(k) (((PH_MASK >> (k)) & 1) && lo <= (k) && (k) < hi)
#define SEAM(k) do { if (IN(k) && IN((k) + 1)) xcd_barrier(bar); } while (0)

#ifndef REP_PHASE
#define REP_PHASE -1
#endif
#define RUNPH(k, ...) do { if (IN(k)) { __VA_ARGS__ if (REP_PHASE == (k)) { xcd_barrier(bar); __VA_ARGS__ } SEAM(k); } } while (0)
    RUNPH(0, phase0(args, lds, tid, lane, wave, vcu, G););
    RUNPH(1, phase1(args, lane, wave, vcu, G););
    RUNPH(2, {
        DenseSched S; S.init(ws + RA_H, ws + WS_WIN, 2048, 2048, MROWS, DINP, G, bx);
        EpiIn E{ws};
        pg8::gemm_phase<EpiIn, DenseSched>(lds, 2048, S, E); });
    RUNPH(3, phase3_prep(args, lds, tid, vcu, G); phase3_pool(args, lds, tid, vcu, G););
    RUNPH(4, phase_chain(args, lds, tid, lane, wave, vcu, G););
    RUNPH(5, {
        phase4_post(args, lane, wave, vcu, G);
        PoolSched S{(const char*)(ws + RA_DPOOL), (const char*)(ws + WS_WPOOL), G, vcu};
        EpiPool E{(bf16*)(ws + RA_YMIX), args.in[17]};
        int kpool = 256; asm volatile("" : "+s"(kpool));
        pg8::gemm_phase<EpiPool, PoolSched>(lds, kpool, S, E); });
    RUNPH(6, {
        DenseSched S; S.init(ws + RA_YMIX, ws + WS_WOUT, 2048, 2048, NT, 2048, G, bx);
        EpiOut E{(float*)(ws + RA_Y1)};
        pg8::gemm_phase<EpiOut, DenseSched>(lds, 2048, S, E); });
    RUNPH(7, phase6(args, lds, tid, lane, wave, vcu, G););
    RUNPH(8, phase7(args, lds, tid, lane, wave, vcu, G););
    RUNPH(9, {
        MoeGUSched S{(const char*)(ws + RA_H2), (const char*)(ws + WS_WGU), (const int*)(ws + T_TILE), (const int*)(ws + T_SLOTTOK), G, vcu};
        EpiGU E{(bf16*)(ws + WS_ACT), (const float*)(ws + T_SLOTW)};
        pg8::gemm_phase<EpiGU, MoeGUSched>(lds, 2048, S, E); });
    RUNPH(10, {
        MoeDownSched S{(const char*)(ws + WS_ACT), (const char*)(ws + WS_WD), (const int*)(ws + T_TILE), G, vcu};
        EpiDown E{(bf16*)(ws + WS_SLOTOUT)};
        pg8::gemm_phase<EpiDown, MoeDownSched>(lds, 512, S, E); });
    if (IN(11)) { phase10(args, lane, wave, vcu, G); if (REP_PHASE == 11) { xcd_barrier(bar); phase10(args, lane, wave, vcu, G); } }
#undef IN
#undef SEAM
}

extern "C" void kernel_launch(void* const* d_in, const int* in_sizes, int n_in, void* d_out, int out_size, void* d_ws, size_t ws_size, hipStream_t stream) {
    static int grid = 0;
    if (grid == 0) {
        if (n_in != 27 || out_size != NT * DM || ws_size < WS_NEED) { fprintf(stderr, "kernel_launch: unexpected problem: n_in %d out %d ws %zu (need %zu)\n", n_in, out_size, ws_size, (size_t)WS_NEED); grid = -1; return; }
        int dev = 0, cus = 0, per_cu = 0;
        if (hipGetDevice(&dev) != hipSuccess || hipDeviceGetAttribute(&cus, hipDeviceAttributeMultiprocessorCount, dev) != hipSuccess) { grid = -1; return; }
        if (hipFuncSetAttribute((const void*)fwd, hipFuncAttributeMaxDynamicSharedMemorySize, LDS_BYTES) != hipSuccess) { fprintf(stderr, "kernel_launch: hipFuncSetAttribute failed\n"); grid = -1; return; }
        if (hipOccupancyMaxActiveBlocksPerMultiprocessor(&per_cu, (const void*)fwd, 512, LDS_BYTES) != hipSuccess || per_cu < 1) { fprintf(stderr, "kernel_launch: occupancy query says %d\n", per_cu); }
        (void)hipGetLastError();
        grid = cus;
    }
    if (grid < 0) return;
    (void)hipMemsetAsync((char*)d_ws + WS_CTL, 0, CTL_ZERO_BYTES, stream);
    Args a{};
    for (int i = 0; i < 27; ++i) a.in[i] = (const float*)d_in[i];
    a.out = (float*)d_out; a.ws = (unsigned char*)d_ws;
    if (N_LAUNCHES == 1) {
        a.ph_lo = 0; a.ph_hi = NPH;
        hipLaunchKernelGGL(fwd, dim3(grid), dim3(512), LDS_BYTES, stream, a);
    } else {
        for (int p = 0; p < NPH; ++p) { a.ph_lo = p; a.ph_hi = p + 1; hipLaunchKernelGGL(fwd, dim3(grid), dim3(512), LDS_BYTES, stream, a); }
    }
}
```

```cpp
#include <hip/hip_runtime.h>
#include <cstdio>
#include <cstdint>

#ifndef N_LAUNCHES
#define N_LAUNCHES 1
#endif

#define GAS __attribute__((address_space(1)))
#define LAS __attribute__((address_space(3)))
typedef unsigned short bf16;
typedef unsigned v4u __attribute__((ext_vector_type(4)));
typedef unsigned v2u __attribute__((ext_vector_type(2)));
typedef float f32x4 __attribute__((ext_vector_type(4)));
typedef short bf16x8 __attribute__((ext_vector_type(8)));
typedef unsigned long long u64;

constexpr int NB = 8, SEQ = 2048, DM = 2048, CTXL = 256;
constexpr int NT = NB * SEQ;
constexpr int NTC = NB * CTXL;
constexpr int MROWS = NT + NTC;
constexpr int DIN = 4128, DINP = 4352;
constexpr int NE = 64, TOPK = 8, DE = 512;
constexpr int NSLOT_E = NT * TOPK;
constexpr int SH_ROW0 = NSLOT_E + 256;
constexpr int NSLOT = SH_ROW0 + NT;
constexpr int NTILE_MAX = 704;
constexpr float EPS = 1e-6f;
constexpr int NPH = 12;

constexpr size_t MiB = 1u << 20;
constexpr size_t WS_CTL = 0, CTL_ZERO_BYTES = 64 * 1024;
constexpr size_t WS_MOD = 1 * MiB;
constexpr size_t WS_WRT = 1 * MiB + 512 * 1024;
constexpr size_t WS_WIN = 2 * MiB;
constexpr size_t WS_WOUT = WS_WIN + 17 * MiB;
constexpr size_t WS_WPOOL = WS_WOUT + 8 * MiB;
constexpr size_t WS_WD = WS_WPOOL + 1 * MiB;
constexpr size_t WS_WGU = WS_WD + 130 * MiB;
constexpr size_t WS_RA = WS_WGU + 260 * MiB;
constexpr size_t RA_H = WS_RA;
constexpr size_t RA_OF = WS_RA;
constexpr size_t RA_H2 = WS_RA;
constexpr size_t RA_Q = WS_RA + 128 * MiB;
constexpr size_t RA_K = RA_Q + 16 * MiB;
constexpr size_t RA_V = RA_K + 18 * MiB;
constexpr size_t RA_R = RA_V + 36 * MiB;
constexpr size_t RA_P = RA_R + 32 * MiB;
constexpr size_t RA_ALR = RA_P + 32 * MiB;
constexpr size_t RA_DPOOL = RA_ALR + 3 * MiB;
constexpr size_t RA_YMIX = RA_DPOOL + 32 * MiB;
constexpr size_t RA_Y1 = WS_RA + 128 * MiB;
constexpr size_t RA_END = RA_YMIX + 64 * MiB;
constexpr size_t WS_SLOTOUT = WS_WGU;
constexpr size_t WS_ACT = RA_END > WS_SLOTOUT + 578 * MiB ? RA_END : WS_SLOTOUT + 578 * MiB;
constexpr size_t WS_END = WS_ACT + 145 * MiB;
constexpr size_t PQG = WS_ACT;
constexpr size_t PQM = WS_ACT + 32 * MiB;
constexpr size_t PKM = WS_ACT + 64 * MiB;
constexpr size_t PKD = WS_ACT + 96 * MiB;
constexpr size_t PDEC = WS_ACT + 132 * MiB;
constexpr size_t WS_T0 = WS_END;
constexpr size_t T_CNT = WS_T0;
constexpr size_t T_MASK = T_CNT + 65536;
constexpr size_t T_TOKW = T_MASK + 131072;
constexpr size_t T_TOKSLOT = T_TOKW + 524288;
constexpr size_t T_SLOTTOK = T_TOKSLOT + 524288;
constexpr size_t T_SLOTW = T_SLOTTOK + 655360;
constexpr size_t T_TILE = T_SLOTW + 655360;
constexpr size_t WS_X1 = (T_TILE + 16384 + 4095) / 4096 * 4096;
constexpr size_t WS_NEED = WS_X1 + (size_t)NT * DM * 4;

constexpr int RING_BYTES = 131072;
constexpr int LDS_BYTES = 147456;
constexpr int LDS_MISC = LDS_BYTES - 256;
constexpr int RT_ROWB = 4112;
constexpr int RT_HI = 0, RT_LO = 16 * RT_ROWB;
constexpr int LDS_LOGIT = 2 * 16 * RT_ROWB;
constexpr int LDS_MASKS = LDS_LOGIT + 4096;
static_assert(LDS_MASKS + 512 <= LDS_MISC, "LDS map");

#define LDS_WAIT() asm volatile("s_waitcnt lgkmcnt(0)" ::: "memory")
#define VM_WAIT() asm volatile("s_waitcnt vmcnt(0)" ::: "memory")

__device__ __forceinline__ unsigned f2bf(float f) { unsigned u = __builtin_bit_cast(unsigned, f); return (u + 0x7fffu + ((u >> 16) & 1u)) >> 16; }
__device__ __forceinline__ unsigned pk2(float lo, float hi) { return f2bf(lo) | (f2bf(hi) << 16); }
__device__ __forceinline__ float bflo(unsigned u) { return __builtin_bit_cast(float, u << 16); }
__device__ __forceinline__ float bfhi(unsigned u) { return __builtin_bit_cast(float, u & 0xffff0000u); }
__device__ __forceinline__ float bf1(bf16 b) { return __builtin_bit_cast(float, ((unsigned)b) << 16); }
__device__ __forceinline__ float wave_sum(float v) {
#pragma unroll
    for (int o = 1; o < 64; o <<= 1) v += __shfl_xor(v, o);
    return v;
}
__device__ __forceinline__ float silu_f(float x) { return x / (1.f + __expf(-x)); }

#define XB_TMO      128
#define XB_XCNT(j)  (256  + 64 * (j))
#define XB_XSUB(j)  (1280 + 64 * (j))
#define XB_XGEN(j)  (2304 + 64 * (j))
#define XB_TOP      3328
#define XB_TOPGEN   3392
#define XCD_BAR_WORDS 3456
#define XB_SPIN_CAP (1u << 18)

__device__ __forceinline__ unsigned xb_ld(unsigned* p)              { return __hip_atomic_load(p, __ATOMIC_RELAXED, __HIP_MEMORY_SCOPE_AGENT); }
__device__ __forceinline__ unsigned xb_add(unsigned* p, unsigned v) { return __hip_atomic_fetch_add(p, v, __ATOMIC_RELAXED, __HIP_MEMORY_SCOPE_AGENT); }
__device__ __forceinline__ unsigned xb_xcc_id() { return (unsigned)__builtin_amdgcn_s_getreg((3 << 11) | 20) & 0xFu; }
#define XB_SPIN(cond, bar) do { unsigned _sp = 0; while (cond) { __builtin_amdgcn_s_sleep(1); \
    if ((++_sp & 255u) == 0u) { if (xb_ld(&(bar)[XB_TMO])) break; if (_sp > XB_SPIN_CAP) { atomicAdd(&(bar)[XB_TMO], 1u); break; } } } } while (0)

struct XcdBarrier { unsigned* bar; unsigned x; volatile LAS unsigned* st; };

__device__ __forceinline__ XcdBarrier xcd_barrier_post(unsigned* bar, volatile LAS unsigned* st) {
    XcdBarrier b; b.bar = bar; b.x = xb_xcc_id(); b.st = st;
    if (threadIdx.x == 0) (void)xb_add(&bar[XB_XCNT(b.x)], 1u);
    return b;
}
__device__ __forceinline__ void xcd_barrier_complete(unsigned* bar, unsigned x, unsigned& nloc, unsigned& nx) {
    const unsigned G = gridDim.x * gridDim.y * gridDim.z;
    unsigned sum, cnt, mine, sp = 0u;
    for (;;) {
        sum = 0u; cnt = 0u; mine = 0u;
#pragma unroll
        for (unsigned j = 0; j < 16; ++j) { const unsigned c = xb_ld(&bar[XB_XCNT(j)]); sum += c; cnt += (c > 0u) ? 1u : 0u; mine = (j == x) ? c : mine; }
        if (sum == G) break;
        __builtin_amdgcn_s_sleep(1);
        if ((++sp & 255u) == 0u) { if (xb_ld(&bar[XB_TMO])) break; if (sp > XB_SPIN_CAP) { atomicAdd(&bar[XB_TMO], 1u); break; } }
    }
    nloc = mine > 0u ? mine : 1u; nx = cnt > 0u ? cnt : 1u;
}
__device__ __forceinline__ void xcd_barrier(const XcdBarrier& b) {
    asm volatile("s_waitcnt vmcnt(0)" ::: "memory");
    __syncthreads();
    if (threadIdx.x == 0) {
        unsigned* bar = b.bar;
        __builtin_amdgcn_s_waitcnt(0);
        unsigned nloc = b.st[0], nx = b.st[1];
        if (nloc == 0u) { xcd_barrier_complete(bar, b.x, nloc, nx); b.st[0] = nloc; b.st[1] = nx; }
        const unsigned old = xb_add(&bar[XB_XSUB(b.x)], 1u);
        const unsigned gen = old / nloc;
        if (old + 1u == (gen + 1u) * nloc) {
            __builtin_amdgcn_fence(__ATOMIC_RELEASE, "agent");
            asm volatile("s_waitcnt vmcnt(0)" ::: "memory");
            const unsigned og = xb_add(&bar[XB_TOP], 1u);
            const unsigned tg = og / nx;
            if (og + 1u == (tg + 1u) * nx) xb_add(&bar[XB_TOPGEN], 1u);
            else XB_SPIN(xb_ld(&bar[XB_TOPGEN]) == tg, bar);
            __builtin_amdgcn_fence(__ATOMIC_ACQUIRE, "agent");
            xb_add(&bar[XB_XGEN(b.x)], 1u);
            asm volatile("s_waitcnt vmcnt(0)" ::: "memory");
        } else {
            XB_SPIN(xb_ld(&bar[XB_XGEN(b.x)]) == gen, bar);
            __builtin_amdgcn_fence(__ATOMIC_ACQUIRE, "agent");
            asm volatile("s_waitcnt vmcnt(0)" ::: "memory");
        }
    }
    __syncthreads();
}

namespace pg8 {
constexpr int BM = 256, BK = 64, HALF = 128, HTB = HALF * BK * 2, STAGE_BYTES = 8 * HTB, NXCD = 8, WGM = 8;
__device__ __forceinline__ int lds_byte(int r, int c) { const int st = (r >> 4) * 2 + (c >> 5), rr = r & 15, cc = c & 31, ob = rr * 64 + cc * 2; return st * 1024 + (ob ^ (((ob >> 9) & 1) << 5)); }
__device__ __forceinline__ void stage_rc(int b, int& R, int& C) { const int st = b / 1024, sb = b % 1024, swz = sb ^ (((sb >> 9) & 1) << 5); R = (st >> 1) * 16 + swz / 64; C = (st & 1) * 32 + (swz % 64) / 2; }
__device__ __forceinline__ int perm32(int rho) { const int n = rho >> 4, i = rho & 15; return 8 * (i >> 2) + 4 * n + (i & 3); }
__device__ __forceinline__ unsigned cvt_pk_bf16(float lo, float hi) { unsigned r; asm volatile("v_cvt_pk_bf16_f32 %0, %1, %2" : "=v"(r) : "v"(lo), "v"(hi)); return r; }

typedef int v8i __attribute__((ext_vector_type(8)));
typedef int v4i __attribute__((ext_vector_type(4)));
template <class Epi, class Sched, bool FP8 = false>
__device__ __forceinline__ void gemm_phase(LAS unsigned char* lds, const int K, const Sched& S, const Epi& E) {
    typedef typename Sched::U Unit;
    const int tid = threadIdx.x, wid = __builtin_amdgcn_readfirstlane(tid >> 6), lane = tid & 63, wr = wid >> 2, wc = wid & 3, fr = lane & 15, fq = lane >> 4;
    const int nt = K / BK;
    int R[2], C[2]; unsigned voffB[2];
#pragma unroll
    for (int i = 0; i < 2; ++i) { stage_rc(tid * 16 + i * 8192, R[i], C[i]); const int Rb = Epi::PERM ? ((R[i] & ~31) + perm32(R[i] & 31)) : R[i];
        voffB[i] = (unsigned)(Rb * K + C[i]) * 2u; }
    const size_t kstep = (size_t)(BK * 2);
    const size_t hstepB = (size_t)HALF * K * 2;
    const unsigned ldsw = (unsigned)wid * 1024u;
    const int aoff = lds_byte(wr * 64 + fr, fq * 8), boff = lds_byte(wc * 32 + fr, fq * 8);
#define PG8_SA(b, h) (((b) * 2 + (h)) * HTB)
#define PG8_SB(b, h) ((4 + (b) * 2 + (h)) * HTB)
#define PG8_STAGE(bufoff, gbase, v0, v1) do { \
        __builtin_amdgcn_global_load_lds((const unsigned*)((const char*)(gbase) + (v0)), (LAS unsigned*)(lds + (bufoff) + ldsw), 16, 0, 0); \
        __builtin_amdgcn_global_load_lds((const unsigned*)((const char*)(gbase) + (v1)), (LAS unsigned*)(lds + (bufoff) + ldsw + 8192), 16, 0, 0); } while (0)
#define PG8_LDA(dst, b, h) do { _Pragma("unroll") for (int m = 0; m < 4; ++m) { const v4i lo_ = *(const LAS v4i*)(lds + PG8_SA(b, h) + aoff + m * 2048), hi_ = *(const LAS v4i*)(lds + PG8_SA(b, h) + aoff + m * 2048 + 1024); \
        dst[m] = __builtin_shufflevector(lo_, hi_, 0, 1, 2, 3, 4, 5, 6, 7); } } while (0)
#define PG8_LDB(dst, b, h) do { _Pragma("unroll") for (int n = 0; n < 2; ++n) { const v4i lo_ = *(const LAS v4i*)(lds + PG8_SB(b, h) + boff + n * 2048), hi_ = *(const LAS v4i*)(lds + PG8_SB(b, h) + boff + n * 2048 + 1024); \
        dst[n] = __builtin_shufflevector(lo_, hi_, 0, 1, 2, 3, 4, 5, 6, 7); } } while (0)
#define PG8_H0(x) ((bf16x8)__builtin_shufflevector(x, x, 0, 1, 2, 3))
#define PG8_H1(x) ((bf16x8)__builtin_shufflevector(x, x, 4, 5, 6, 7))
#define PG8_MMA(ai, bj, At, Bt) do { __builtin_amdgcn_s_setprio(1); if constexpr (FP8) asm volatile("s_nop 4"); _Pragma("unroll") for (int m = 0; m < 4; ++m) _Pragma("unroll") for (int n = 0; n < 2; ++n) { \
        if constexpr (FP8) asm volatile("v_mfma_f32_16x16x128_f8f6f4 %0, %1, %2, %0" : "+v"(acc[ai][bj][m][n]) : "v"(Bt[n]), "v"(At[m])); \
        else { acc[ai][bj][m][n] = __builtin_amdgcn_mfma_f32_16x16x32_bf16(PG8_H0(Bt[n]), PG8_H0(At[m]), acc[ai][bj][m][n], 0, 0, 0); \
               acc[ai][bj][m][n] = __builtin_amdgcn_mfma_f32_16x16x32_bf16(PG8_H1(Bt[n]), PG8_H1(At[m]), acc[ai][bj][m][n], 0, 0, 0); } } \
        __builtin_amdgcn_s_setprio(0); } while (0)
#define PG8_WAIT_V(n) asm volatile("s_waitcnt vmcnt(" #n ")" ::: "memory")
#define PG8_WAIT_L(n) asm volatile("s_waitcnt lgkmcnt(" #n ")" ::: "memory")
#define PG8_BAR __builtin_amdgcn_s_barrier()
#define PG8_SCHED __builtin_amdgcn_sched_barrier(0)
    Unit cur, nxt; int ui = 0;
    if (!S.next(0, cur)) return;
    f32x4 acc[2][2][4][2];
#pragma unroll
    for (int a = 0; a < 2; ++a)
#pragma unroll
        for (int b = 0; b < 2; ++b)
#pragma unroll
            for (int m = 0; m < 4; ++m)
#pragma unroll
                for (int n = 0; n < 2; ++n) acc[a][b][m][n] = (f32x4){0.f, 0.f, 0.f, 0.f};
    v8i At[4], B0[2], B1[2];
    unsigned vA[4], vN[4];
    S.aoffs(cur, R, C, vA);
    const char* cA = cur.A; const char* cB = cur.B;
    PG8_STAGE(PG8_SB(0, 0), cB, voffB[0], voffB[1]); PG8_STAGE(PG8_SB(0, 1), cB + hstepB, voffB[0], voffB[1]); PG8_STAGE(PG8_SA(0, 0), cA, vA[0], vA[1]); PG8_STAGE(PG8_SA(0, 1), cA, vA[2], vA[3]);
    if (wr == 1) PG8_BAR;
    PG8_WAIT_V(2); PG8_BAR;
    PG8_STAGE(PG8_SB(1, 0), cB + kstep, voffB[0], voffB[1]); PG8_STAGE(PG8_SA(1, 0), cA + kstep, vA[0], vA[1]); PG8_STAGE(PG8_SB(1, 1), cB + hstepB + kstep, voffB[0], voffB[1]);
    PG8_WAIT_V(6); PG8_BAR;
    for (;;) {
        const bool has_next = S.next(ui + 1, nxt);
        const char* nA = has_next ? nxt.A : cA; const char* nB = has_next ? nxt.B : cB;
        if (has_next) S.aoffs(nxt, R, C, vN); else { vN[0] = vA[0]; vN[1] = vA[1]; vN[2] = vA[2]; vN[3] = vA[3]; }
        for (int t = 0; t < nt; t += 2) {
            const bool last = (t == nt - 2);
            const char* a1 = cA + (size_t)(t + 1) * kstep;
            const char* a2 = last ? nA : cA + (size_t)(t + 2) * kstep; const char* b2 = last ? nB : cB + (size_t)(t + 2) * kstep;
            const char* a3 = a2 + kstep; const char* b3 = b2 + kstep;
            const unsigned x0 = last ? vN[0] : vA[0], x1 = last ? vN[1] : vA[1], x2 = last ? vN[2] : vA[2], x3 = last ? vN[3] : vA[3];
            PG8_LDB(B0, 0, 0); PG8_LDB(B1, 0, 1); PG8_SCHED; PG8_LDA(At, 0, 0); PG8_STAGE(PG8_SA(1, 1), a1, vA[2], vA[3]);
            PG8_WAIT_V(8); PG8_WAIT_L(0); PG8_BAR; PG8_MMA(0, 0, At, B0); PG8_MMA(0, 1, At, B1); PG8_BAR; PG8_SCHED;
            PG8_LDA(At, 0, 1); PG8_STAGE(PG8_SB(0, 0), b2, voffB[0], voffB[1]); PG8_STAGE(PG8_SB(0, 1), b2 + hstepB, voffB[0], voffB[1]); PG8_STAGE(PG8_SA(0, 0), a2, x0, x1);
            PG8_WAIT_V(8); PG8_WAIT_L(0); PG8_BAR; PG8_MMA(1, 0, At, B0); PG8_MMA(1, 1, At, B1); PG8_BAR; PG8_SCHED;
            PG8_LDB(B0, 1, 0); PG8_LDB(B1, 1, 1); PG8_SCHED; PG8_LDA(At, 1, 0); PG8_STAGE(PG8_SA(0, 1), a2, x2, x3);
            PG8_WAIT_V(8); PG8_WAIT_L(0); PG8_BAR; PG8_MMA(0, 0, At, B0); PG8_MMA(0, 1, At, B1); PG8_BAR; PG8_SCHED;
            PG8_LDA(At, 1, 1); PG8_STAGE(PG8_SB(1, 0), b3, voffB[0], voffB[1]); PG8_STAGE(PG8_SB(1, 1), b3 + hstepB, voffB[0], voffB[1]); PG8_STAGE(PG8_SA(1, 0), a3, x0, x1);
            PG8_WAIT_V(8); PG8_WAIT_L(0); PG8_BAR; PG8_MMA(1, 0, At, B0); PG8_MMA(1, 1, At, B1); PG8_BAR; PG8_SCHED;
        }
        if (wr == 0) PG8_BAR;
        if constexpr (FP8) asm volatile("s_nop 15\n\ts_nop 15");
        { int tz = threadIdx.x; asm volatile("" : "+v"(tz));
          const int wid_ = tz >> 6, lane_ = tz & 63; E(acc, cur, wid_ >> 2, wid_ & 3, lane_ & 15, lane_ >> 4); }
        if (!has_next) break;
#pragma unroll
        for (int a = 0; a < 2; ++a)
#pragma unroll
            for (int b = 0; b < 2; ++b)
#pragma unroll
                for (int m = 0; m < 4; ++m)
#pragma unroll
                    for (int n = 0; n < 2; ++n) acc[a][b][m][n] = (f32x4){0.f, 0.f, 0.f, 0.f};
        cur = nxt; cA = nA; cB = nB; ++ui;
        vA[0] = vN[0]; vA[1] = vN[1]; vA[2] = vN[2]; vA[3] = vN[3];
        if (wr == 1) PG8_BAR;
    }
    PG8_WAIT_V(0);
    PG8_BAR;
#undef PG8_SA
#undef PG8_SB
#undef PG8_STAGE
#undef PG8_LDA
#undef PG8_LDB
#undef PG8_H0
#undef PG8_H1
#undef PG8_MMA
#undef PG8_WAIT_V
#undef PG8_WAIT_L
#undef PG8_BAR
#undef PG8_SCHED
}
}

struct Args { const float* in[27]; float* out; unsigned char* ws; int ph_lo, ph_hi; };
static_assert(sizeof(Args) == 27 * 8 + 8 + 8 + 8, "Args has no padding");

struct DenseU { const char* A; const char* B; int pm, pn; };
struct DenseSched {
    typedef DenseU U;
    const char* A; const char* B; int lda, K, nM, nN, nwg, G, c;
    __device__ __forceinline__ void init(const void* A_, const void* B_, int lda_, int K_, int M, int N, int G_, int c_) { A = (const char*)A_; B = (const char*)B_; lda = lda_; K = K_; nM = M / 256; nN = N / 256; nwg = nM * nN; G = G_; c = c_; }
    __device__ __forceinline__ bool next(int i, U& u) const {
        const long L = (long)i * G + c; if (L >= nwg) return false;
        int wgid = (int)L; { const int q = nwg / 8, r = nwg % 8, xcd = wgid % 8, off = wgid / 8; wgid = (xcd < r ? xcd * (q + 1) : r * (q + 1) + (xcd - r) * q) + off; }
        const int nig = 8 * nN, gid = wgid / nig, fm = gid * 8, gsz = (nM - fm) < 8 ? (nM - fm) : 8;
        u.pm = fm + ((wgid % nig) % gsz); u.pn = (wgid % nig) / gsz;
        u.A = A + (size_t)u.pm * 256 * lda * 2; u.B = B + (size_t)u.pn * 256 * K * 2; return true;
    }
    __device__ __forceinline__ void aoffs(const U&, const int (&R)[2], const int (&C)[2], unsigned (&v)[4]) const {
#pragma unroll
        for (int h = 0; h < 2; ++h)
#pragma unroll
            for (int i = 0; i < 2; ++i) v[h * 2 + i] = (unsigned)((h * 128 + R[i]) * lda + C[i]) * 2u;
    }
};
struct PoolU { const char* A; const char* B; int pm, g; };
struct PoolSched {
    typedef PoolU U;
    const char* A; const char* B; int G, c;
    __device__ __forceinline__ bool next(int i, U& u) const {
        const int L = i * G + c; if (L >= 256) return false;
        u.g = L & 3; u.pm = L >> 2;
        u.A = A + ((size_t)u.pm * 256 * 1024 + u.g * 256) * 2; u.B = B + (size_t)u.g * 256 * 256 * 2; return true;
    }
    __device__ __forceinline__ void aoffs(const U&, const int (&R)[2], const int (&C)[2], unsigned (&v)[4]) const {
#pragma unroll
        for (int h = 0; h < 2; ++h)
#pragma unroll
            for (int i = 0; i < 2; ++i) v[h * 2 + i] = (unsigned)((h * 128 + R[i]) * 1024 + C[i]) * 2u;
    }
};
struct MoeU { const char* A; const char* B; int row0, nrows, pn; };
struct MoeGUSched {
    typedef MoeU U;
    const char* H2; const char* W; const int* tile; const int* slot_tok; int G, c;
    __device__ __forceinline__ bool next(int i, U& u) const {
        const int nt = tile[3 * NTILE_MAX]; const int L = i * G + c; if (L >= nt * 4) return false;
        const int t = L >> 2; u.pn = L & 3; const int e = tile[t]; u.row0 = tile[NTILE_MAX + t]; u.nrows = tile[2 * NTILE_MAX + t];
        u.A = H2; u.B = W + ((size_t)e * 1024 + u.pn * 256) * 2048; return true;
    }
    __device__ __forceinline__ void aoffs(const U& u, const int (&R)[2], const int (&C)[2], unsigned (&v)[4]) const {
#pragma unroll
        for (int h = 0; h < 2; ++h)
#pragma unroll
            for (int i = 0; i < 2; ++i) { int r = h * 128 + R[i]; r = r < u.nrows ? r : u.nrows - 1; const int tok = slot_tok[u.row0 + r]; v[h * 2 + i] = (unsigned)(tok * 1024 + C[i]) * 2u; }
    }
};
struct MoeDownSched {
    typedef MoeU U;
    const char* ACT; const char* W; const int* tile; int G, c;
    __device__ __forceinline__ bool next(int i, U& u) const {
        const int nt = tile[3 * NTILE_MAX]; const int L = i * G + c; if (L >= nt * 8) return false;
        const int t = L >> 3; u.pn = L & 7; const int e = tile[t]; u.row0 = tile[NTILE_MAX + t]; u.nrows = tile[2 * NTILE_MAX + t];
        u.A = ACT + (size_t)u.row0 * 512; u.B = W + ((size_t)e * 2048 + u.pn * 256) * 512; return true;
    }
    __device__ __forceinline__ void aoffs(const U&, const int (&R)[2], const int (&C)[2], unsigned (&v)[4]) const {
#pragma unroll
        for (int h = 0; h < 2; ++h)
#pragma unroll
            for (int i = 0; i < 2; ++i) v[h * 2 + i] = (unsigned)((h * 128 + R[i]) * 256 + C[i]) * 2u;
    }
};

struct EpiIn {
    static constexpr bool PERM = true;
    unsigned char* ws;
    __device__ __forceinline__ void operator()(const f32x4 (&acc)[2][2][4][2], const DenseU& u, int wr, int wc, int fr, int fq) const {
        const int pn = u.pn; const int row0 = u.pm * 256 + wr * 64 + fr;
        if (pn == 16) {
            if (wc != 0) return;
            float* alr = (float*)(ws + RA_ALR);
#pragma unroll
            for (int ai = 0; ai < 2; ++ai)
#pragma unroll
                for (int m = 0; m < 4; ++m) { float* rp = alr + (size_t)(row0 + ai * 128 + m * 16) * 32 + 8 * fq;
                    *(f32x4*)(rp) = acc[ai][0][m][0]; *(f32x4*)(rp + 4) = acc[ai][0][m][1]; }
            return;
        }
        bf16* base; int ld, colt; bool lat_only;
        if (pn < 2) { base = (bf16*)(ws + RA_Q); ld = 512; colt = pn * 256; lat_only = true; }
        else if (pn < 4) { base = (bf16*)(ws + RA_K); ld = 512; colt = (pn - 2) * 256; lat_only = false; }
        else if (pn < 8) { base = (bf16*)(ws + RA_V); ld = 1024; colt = (pn - 4) * 256; lat_only = false; }
        else if (pn < 12) { base = (bf16*)(ws + RA_R); ld = 1024; colt = (pn - 8) * 256; lat_only = true; }
        else { base = (bf16*)(ws + RA_P); ld = 1024; colt = (pn - 12) * 256; lat_only = true; }
        if (lat_only && u.pm >= 64) return;
        const int col0 = colt + wc * 32 + 8 * fq;
#pragma unroll
        for (int ai = 0; ai < 2; ++ai)
#pragma unroll
            for (int m = 0; m < 4; ++m) { bf16* rp = base + (size_t)(row0 + ai * 128 + m * 16) * ld + col0;
#pragma unroll
                for (int bj = 0; bj < 2; ++bj) { const f32x4 v0 = acc[ai][bj][m][0], v1 = acc[ai][bj][m][1];
                    v4u o; o.x = pg8::cvt_pk_bf16(v0[0], v0[1]); o.y = pg8::cvt_pk_bf16(v0[2], v0[3]); o.z = pg8::cvt_pk_bf16(v1[0], v1[1]); o.w = pg8::cvt_pk_bf16(v1[2], v1[3]);
                    *(v4u*)(rp + bj * 128) = o; } }
    }
};
struct EpiPool {
    static constexpr bool PERM = true;
    bf16* ymix; const float* scale;
    __device__ __forceinline__ void operator()(const f32x4 (&acc)[2][2][4][2], const PoolU& u, int wr, int wc, int fr, int fq) const {
        const int row0 = u.pm * 256 + wr * 64 + fr; const int c0 = u.g * 256 + wc * 32 + 8 * fq;
#pragma unroll
        for (int ai = 0; ai < 2; ++ai)
#pragma unroll
            for (int m = 0; m < 4; ++m) { bf16* rp = ymix + (size_t)(row0 + ai * 128 + m * 16) * 2048 + 1024 + c0;
#pragma unroll
                for (int bj = 0; bj < 2; ++bj) { const f32x4 s0 = *(const f32x4*)(scale + c0 + bj * 128), s1 = *(const f32x4*)(scale + c0 + bj * 128 + 4);
                    const f32x4 v0 = acc[ai][bj][m][0] * s0, v1 = acc[ai][bj][m][1] * s1;
                    v4u o; o.x = pg8::cvt_pk_bf16(v0[0], v0[1]); o.y = pg8::cvt_pk_bf16(v0[2], v0[3]); o.z = pg8::cvt_pk_bf16(v1[0], v1[1]); o.w = pg8::cvt_pk_bf16(v1[2], v1[3]);
                    *(v4u*)(rp + bj * 128) = o; } }
    }
};
struct EpiOut {
    static constexpr bool PERM = false;
    float* y;
    __device__ __forceinline__ void operator()(const f32x4 (&acc)[2][2][4][2], const DenseU& u, int wr, int wc, int fr, int fq) const {
        const int row0 = u.pm * 256 + wr * 64 + fr, col0 = u.pn * 256 + wc * 32 + 4 * fq;
#pragma unroll
        for (int ai = 0; ai < 2; ++ai)
#pragma unroll
            for (int m = 0; m < 4; ++m) { float* rp = y + (size_t)(row0 + ai * 128 + m * 16) * 2048 + col0;
#pragma unroll
                for (int bj = 0; bj < 2; ++bj)
#pragma unroll
                    for (int n = 0; n < 2; ++n) *(f32x4*)(rp + bj * 128 + n * 16) = acc[ai][bj][m][n]; }
    }
};
constexpr float SC_W = 256.f, SC_H = 16.f, SC_A = 16.f;
__device__ __forceinline__ unsigned pk4_fp8(float a, float b, float c, float d) {
    a = fminf(fmaxf(a, -448.f), 448.f); b = fminf(fmaxf(b, -448.f), 448.f); c = fminf(fmaxf(c, -448.f), 448.f); d = fminf(fmaxf(d, -448.f), 448.f);
    unsigned w = 0; w = __builtin_amdgcn_cvt_pk_fp8_f32(a, b, w, false); w = __builtin_amdgcn_cvt_pk_fp8_f32(c, d, w, true); return w;
}
struct EpiGU {
    static constexpr bool PERM = true;
    unsigned char* act; const float* slot_w;
    __device__ __forceinline__ void operator()(const f32x4 (&acc)[2][2][4][2], const MoeU& u, int wr, int wc, int fr, int fq) const {
        const int c0 = u.pn * 128 + wc * 32 + 8 * fq; constexpr float inv = 1.f / (SC_W * SC_H);
#pragma unroll
        for (int ai = 0; ai < 2; ++ai)
#pragma unroll
            for (int m = 0; m < 4; ++m) { const int r = ai * 128 + wr * 64 + m * 16 + fr;
                if (r < u.nrows) { const float w = slot_w[u.row0 + r] * SC_A; float o[8];
#pragma unroll
                    for (int n = 0; n < 2; ++n)
#pragma unroll
                        for (int j = 0; j < 4; ++j) { const float g = acc[ai][0][m][n][j] * inv, up = acc[ai][1][m][n][j] * inv; o[n * 4 + j] = silu_f(g) * up * w; }
                    v2u q; q.x = pk4_fp8(o[0], o[1], o[2], o[3]); q.y = pk4_fp8(o[4], o[5], o[6], o[7]);
                    *(v2u*)(act + (size_t)(u.row0 + r) * 512 + c0) = q; } }
    }
};
struct EpiDown {
    static constexpr bool PERM = true;
    bf16* so;
    __device__ __forceinline__ void operator()(const f32x4 (&acc)[2][2][4][2], const MoeU& u, int wr, int wc, int fr, int fq) const {
        const int c0 = u.pn * 256 + wc * 32 + 8 * fq; constexpr float inv = 1.f / (SC_W * SC_A);
#pragma unroll
        for (int ai = 0; ai < 2; ++ai)
#pragma unroll
            for (int m = 0; m < 4; ++m) { const int r = ai * 128 + wr * 64 + m * 16 + fr;
                if (r < u.nrows) { bf16* rp = so + (size_t)(u.row0 + r) * 2048 + c0;
#pragma unroll
                    for (int bj = 0; bj < 2; ++bj) { const f32x4 v0 = acc[ai][bj][m][0] * inv, v1 = acc[ai][bj][m][1] * inv;
                        v4u o; o.x = pg8::cvt_pk_bf16(v0[0], v0[1]); o.y = pg8::cvt_pk_bf16(v0[2], v0[3]); o.z = pg8::cvt_pk_bf16(v1[0], v1[1]); o.w = pg8::cvt_pk_bf16(v1[2], v1[3]);
                        *(v4u*)(rp + bj * 128) = o; } } }
    }
};

__device__ __forceinline__ void tr_item(const float* W, int ldn, bf16* WT, int Kd, int drow0, int k0, int n0, LAS float* scr, int lane) {
    f32x4 t[8];
#pragma unroll
    for (int i = 0; i < 8; ++i) t[i] = *(const f32x4*)(W + (size_t)(k0 + 8 * i + (lane >> 3)) * ldn + n0 + 4 * (lane & 7));
#pragma unroll
    for (int i = 0; i < 8; ++i) { LAS float* d = scr + (8 * i + (lane >> 3)) * 33 + 4 * (lane & 7); d[0] = t[i][0]; d[1] = t[i][1]; d[2] = t[i][2]; d[3] = t[i][3]; }
    LDS_WAIT(); asm volatile("" ::: "memory");
    const int c = lane & 7;
#pragma unroll
    for (int j = 0; j < 4; ++j) { const int n = (lane >> 3) + 8 * j; const LAS float* s = scr + (8 * c) * 33 + n;
        v4u o; o.x = pk2(s[0 * 33], s[1 * 33]); o.y = pk2(s[2 * 33], s[3 * 33]); o.z = pk2(s[4 * 33], s[5 * 33]); o.w = pk2(s[6 * 33], s[7 * 33]);
        *(v4u*)(WT + (size_t)(drow0 + n) * Kd + k0 + 8 * c) = o; }
    LDS_WAIT(); asm volatile("" ::: "memory");
}

__device__ __forceinline__ void tr_item8(const float* W, int ldn, unsigned char* WT, int Kd, int drow0, int k0, int n0, LAS float* scr, int lane) {
    f32x4 t[8];
#pragma unroll
    for (int i = 0; i < 8; ++i) t[i] = *(const f32x4*)(W + (size_t)(k0 + 8 * i + (lane >> 3)) * ldn + n0 + 4 * (lane & 7));
#pragma unroll
    for (int i = 0; i < 8; ++i) { LAS float* d = scr + (8 * i + (lane >> 3)) * 33 + 4 * (lane & 7); d[0] = t[i][0]; d[1] = t[i][1]; d[2] = t[i][2]; d[3] = t[i][3]; }
    LDS_WAIT(); asm volatile("" ::: "memory");
    const int c = lane & 7;
#pragma unroll
    for (int j = 0; j < 4; ++j) { const int n = (lane >> 3) + 8 * j; const LAS float* s = scr + (8 * c) * 33 + n;
        v2u o; o.x = pk4_fp8(s[0 * 33] * SC_W, s[1 * 33] * SC_W, s[2 * 33] * SC_W, s[3 * 33] * SC_W); o.y = pk4_fp8(s[4 * 33] * SC_W, s[5 * 33] * SC_W, s[6 * 33] * SC_W, s[7 * 33] * SC_W);
        *(v2u*)(WT + (size_t)(drow0 + n) * Kd + k0 + 8 * c) = o; }
    LDS_WAIT(); asm volatile("" ::: "memory");
}

__device__ __forceinline__ void phase0(const Args& a, LAS unsigned char* lds, int tid, int lane, int wave, int vcu, int G) {
    unsigned char* ws = a.ws;
    if (vcu < 192) {
        LAS float* sc = (LAS float*)lds;
        LAS float* red = (LAS float*)(lds + 73728);
        for (int i = tid; i < 9 * 2048; i += 512) { const int r = i >> 11, k = i & 2047; const float v = r < 8 ? a.in[1][r * 2048 + k] : a.in[3][k]; sc[i] = silu_f(v); }
        __syncthreads();
        const float* wm = a.in[4]; const float* bm = a.in[5]; float* mod = (float*)(ws + WS_MOD);
        for (int chunk = vcu; chunk < 192; chunk += G) {
            const int n0 = chunk * 64, ks = lane >> 4, n4 = (lane & 15) * 4;
            f32x4 acc[9];
#pragma unroll
            for (int r = 0; r < 9; ++r) acc[r] = (f32x4){0.f, 0.f, 0.f, 0.f};
#pragma unroll 4
            for (int kk = 0; kk < 256; kk += 4) { const int k = wave * 256 + kk + ks; const f32x4 wv = *(const f32x4*)(wm + (size_t)k * 12288 + n0 + n4);
#pragma unroll
                for (int r = 0; r < 9; ++r) { const float s = sc[r * 2048 + k]; acc[r] += wv * s; } }
#pragma unroll
            for (int r = 0; r < 9; ++r)
#pragma unroll
                for (int j = 0; j < 4; ++j) { float v = acc[r][j]; v += __shfl_xor(v, 16); v += __shfl_xor(v, 32); acc[r][j] = v; }
            if (lane < 16) {
#pragma unroll
                for (int r = 0; r < 9; ++r) *(LAS f32x4*)(red + (wave * 9 + r) * 64 + n4) = acc[r]; }
            __syncthreads();
            for (int i = tid; i < 9 * 64; i += 512) { const int r = i >> 6, n = i & 63; float s = 0.f;
#pragma unroll
                for (int w = 0; w < 8; ++w) s += red[(w * 9 + r) * 64 + n];
                mod[r * 12288 + n0 + n] = s + bm[n0 + n]; }
            __syncthreads();
        }
    }
    __syncthreads();
    LAS float* scr = (LAS float*)(lds + wave * 16384);
    const int gw = vcu * 8 + wave, NGW = G * 8;
    bf16* Win_t = (bf16*)(ws + WS_WIN); bf16* Wout_t = (bf16*)(ws + WS_WOUT); bf16* Wpool_t = (bf16*)(ws + WS_WPOOL); unsigned char* Wd_t = ws + WS_WD; unsigned char* Wgu_t = ws + WS_WGU;
    constexpr int I_IN = 32 * 129, I_OUT = 32 * 64, I_POOL = 4 * 4 * 8, I_E = 65 * 512;
    constexpr int NITEMS = I_IN + I_OUT + I_POOL + 3 * I_E;
    for (int it = gw; it < NITEMS; it += NGW) {
        int r = it;
        if (r < I_IN) { const int kb = r / 129, nb = r % 129, n0 = 32 * nb; const int drow = n0 < 3072 ? n0 : (n0 == 3072 ? 4096 : n0 - 32);
            tr_item(a.in[10], DIN, Win_t, 2048, drow, 64 * kb, n0, scr, lane); continue; } r -= I_IN;
        if (r < I_OUT) { const int kb = r / 64, nb = r % 64; tr_item(a.in[18], 2048, Wout_t, 2048, 32 * nb, 64 * kb, 32 * nb, scr, lane); continue; } r -= I_OUT;
        if (r < I_POOL) { const int g = r / 32, rr = r % 32, kb = rr / 8, nb = rr % 8; tr_item(a.in[16] + g * 65536, 256, Wpool_t + g * 65536, 256, 32 * nb, 64 * kb, 32 * nb, scr, lane); continue; } r -= I_POOL;
        if (r < I_E) { const int e = r / 512, rr = r % 512, kb = rr / 16, nb = rr % 16, n0 = 32 * nb; const float* src = e < 64 ? a.in[21] + (size_t)e * 2048 * 512 : a.in[24];
            tr_item8(src, 512, Wgu_t + (size_t)e * 1024 * 2048, 2048, (n0 / 128) * 256 + (n0 % 128), 64 * kb, n0, scr, lane); continue; } r -= I_E;
        if (r < I_E) { const int e = r / 512, rr = r % 512, kb = rr / 16, nb = rr % 16, n0 = 32 * nb; const float* src = e < 64 ? a.in[22] + (size_t)e * 2048 * 512 : a.in[25];
            tr_item8(src, 512, Wgu_t + (size_t)e * 1024 * 2048, 2048, (n0 / 128) * 256 + 128 + (n0 % 128), 64 * kb, n0, scr, lane); continue; } r -= I_E;
        { const int e = r / 512, rr = r % 512, kb = rr / 64, nb = rr % 64; const float* src = e < 64 ? a.in[23] + (size_t)e * 512 * 2048 : a.in[26];
            tr_item8(src, 2048, Wd_t + (size_t)e * 2048 * 512, 512, 32 * nb, 64 * kb, 32 * nb, scr, lane); }
    }
    { const float* wr = a.in[19]; bf16* whi = (bf16*)(ws + WS_WRT); bf16* wlo = whi + 64 * 2048;
      for (int idx = vcu * 512 + tid; idx < 64 * 256; idx += G * 512) { const int e = idx >> 8, k8 = idx & 255; unsigned hi[8], lo[8];
#pragma unroll
          for (int j = 0; j < 8; ++j) { const float v = wr[(size_t)(8 * k8 + j) * 64 + e]; hi[j] = f2bf(v); lo[j] = f2bf(v - __builtin_bit_cast(float, hi[j] << 16)); }
          v4u oh, ol; oh.x = hi[0] | (hi[1] << 16); oh.y = hi[2] | (hi[3] << 16); oh.z = hi[4] | (hi[5] << 16); oh.w = hi[6] | (hi[7] << 16);
          ol.x = lo[0] | (lo[1] << 16); ol.y = lo[2] | (lo[3] << 16); ol.z = lo[4] | (lo[5] << 16); ol.w = lo[6] | (lo[7] << 16);
          *(v4u*)(whi + (size_t)e * 2048 + 8 * k8) = oh; *(v4u*)(wlo + (size_t)e * 2048 + 8 * k8) = ol; } }
    { v4u* z = (v4u*)(Win_t + (size_t)DIN * 2048); const int nz = (DINP - DIN) * 2048 / 8;
      for (int i = vcu * 512 + tid; i < nz; i += G * 512) z[i] = (v4u){0u, 0u, 0u, 0u}; }
}

__device__ __forceinline__ void phase1(const Args& a, int lane, int wave, int vcu, int G) {
    const float* mod = (const float*)(a.ws + WS_MOD); bf16* H = (bf16*)(a.ws + RA_H); const float* g = a.in[6];
    for (int m = vcu * 8 + wave; m < MROWS; m += G * 8) {
        const float* xr = m < NT ? a.in[0] + (size_t)m * 2048 : a.in[2] + (size_t)(m - NT) * 2048;
        const float* mr = mod + (size_t)(m < NT ? (m >> 11) : 8) * 12288;
        f32x4 v[8]; float ss = 0.f;
#pragma unroll
        for (int j = 0; j < 8; ++j) { v[j] = *(const f32x4*)(xr + 4 * (lane + 64 * j)); ss += v[j][0] * v[j][0] + v[j][1] * v[j][1] + v[j][2] * v[j][2] + v[j][3] * v[j][3]; }
        const float rstd = rsqrtf(wave_sum(ss) * (1.f / 2048.f) + EPS);
#pragma unroll
        for (int j = 0; j < 8; ++j) { const int c = 4 * (lane + 64 * j); const f32x4 gg = *(const f32x4*)(g + c), sh = *(const f32x4*)(mr + c), sc = *(const f32x4*)(mr + 2048 + c);
            const f32x4 o = v[j] * rstd * gg * (sc + 1.f) + sh;
            v2u q; q.x = pk2(o[0], o[1]); q.y = pk2(o[2], o[3]); *(v2u*)(H + (size_t)m * 2048 + c) = q; }
    }
}

__device__ __forceinline__ int scan_row(int b, int dir, int s) {
    if (s < 256) { const int tc = dir ? 255 - s : s; return NT + b * 256 + tc; }
    const int t0 = s - 256; return b * 2048 + (dir ? 2047 - t0 : t0);
}
__device__ __forceinline__ void phase3_prep(const Args& a, LAS unsigned char* lds, int tid, int vcu, int G) {
    unsigned char* ws = a.ws;
    const bf16* Q = (const bf16*)(ws + RA_Q); const bf16* Kb = (const bf16*)(ws + RA_K); const float* ALR = (const float*)(ws + RA_ALR);
    bf16* QG = (bf16*)(ws + PQG); bf16* QM = (bf16*)(ws + PQM); bf16* KM = (bf16*)(ws + PKM); bf16* KD = (bf16*)(ws + PKD); float* DEC = (float*)(ws + PDEC);
    LAS float* alr = (LAS float*)lds;
    LAS bf16* Kt = (LAS bf16*)(lds + 4096);
    LAS bf16* Qt = (LAS bf16*)(lds + 4096 + 65536);
    const int col = tid, h = col >> 7, dk = col & 127;
    for (int item = vcu; item < 2 * 8 * 36; item += G) {
        const int ch = item % 36, b = (item / 36) & 7, dir = item / 288;
        const bool lat = ch >= 4;
        if (tid < 256) { const int i = tid >> 2, r4 = (tid & 3) * 4; const int row = scan_row(b, dir, ch * 64 + i);
            *(LAS f32x4*)(alr + i * 16 + r4) = *(const f32x4*)(ALR + (size_t)row * 32 + dir * 16 + r4); }
        { v4u kr[8], qr[8];
#pragma unroll
          for (int q = 0; q < 8; ++q) { const int p = tid + 512 * q, i = p >> 6, c8 = (p & 63) * 8; const int row = scan_row(b, dir, ch * 64 + i);
              kr[q] = *(const v4u*)(Kb + (size_t)row * 512 + c8); if (lat) qr[q] = *(const v4u*)(Q + (size_t)row * 512 + c8); }
#pragma unroll
          for (int q = 0; q < 8; ++q) { const int p = tid + 512 * q; *(LAS v4u*)(Kt + p * 8) = kr[q]; if (lat) *(LAS v4u*)(Qt + p * 8) = qr[q]; } }
        const float* wa2 = dir ? a.in[13] : a.in[11]; const float bia = (dir ? a.in[14] : a.in[12])[col];
        float w[16];
#pragma unroll
        for (int r = 0; r < 16; ++r) w[r] = wa2[r * 512 + col];
        __syncthreads();
        float Gc = 0.f, Gmid = 0.f;
#pragma unroll 4
        for (int i = 0; i < 64; ++i) { float z = bia;
#pragma unroll
            for (int r4 = 0; r4 < 4; ++r4) { const f32x4 x = *(const LAS f32x4*)(alr + i * 16 + 4 * r4); z += x[0] * w[4 * r4] + x[1] * w[4 * r4 + 1] + x[2] * w[4 * r4 + 2] + x[3] * w[4 * r4 + 3]; }
            Gc += (fminf(z, 0.f) - __logf(1.f + __expf(-fabsf(z)))) * (1.f / 16.f);
            if (i == 32) Gmid = Gc; }
        const float Gend = Gc;
        DEC[((size_t)(dir * 8 + b) * 36 + ch) * 512 + col] = __expf(Gend);
        bf16* kdrow = KD + ((((size_t)(dir * 8 + b) * 36 + ch) * 4 + h) * 128 + dk) * 64;
        const size_t lt = lat ? ((((size_t)(dir * 8 + b) * 32 + (ch - 4)) * 4 + h) * 64) * 128 + dk : 0;
        Gc = 0.f;
#pragma unroll 1
        for (int i0 = 0; i0 < 64; i0 += 8) { unsigned kd[8];
#pragma unroll
            for (int ii = 0; ii < 8; ++ii) { const int i = i0 + ii; float z = bia;
#pragma unroll
                for (int r4 = 0; r4 < 4; ++r4) { const f32x4 x = *(const LAS f32x4*)(alr + i * 16 + 4 * r4); z += x[0] * w[4 * r4] + x[1] * w[4 * r4 + 1] + x[2] * w[4 * r4 + 2] + x[3] * w[4 * r4 + 3]; }
                Gc += (fminf(z, 0.f) - __logf(1.f + __expf(-fabsf(z)))) * (1.f / 16.f);
                const float kv = bf1(Kt[i * 512 + col]);
                kd[ii] = f2bf(kv * __expf(Gend - Gc));
                if (lat) { const float qv = bf1(Qt[i * 512 + col]) * 0.08838834764831845f;
                    QG[lt + (size_t)i * 128] = (bf16)f2bf(qv * __expf(Gc)); QM[lt + (size_t)i * 128] = (bf16)f2bf(qv * __expf(Gc - Gmid)); KM[lt + (size_t)i * 128] = (bf16)f2bf(kv * __expf(Gmid - Gc)); } }
            v4u o; o.x = kd[0] | (kd[1] << 16); o.y = kd[2] | (kd[3] << 16); o.z = kd[4] | (kd[5] << 16); o.w = kd[6] | (kd[7] << 16);
            *(v4u*)(kdrow + i0) = o; }
        __syncthreads();
    }
}

constexpr int GL_QG = 0, GL_QM = 17408, GL_KM = 34816, GL_ST = 52224, GL_KDT = 69632, GL_VT = 88064, GL_AM = 97280, GL_DEC = 106496;
__device__ __forceinline__ void phase_chain(const Args& a, LAS unsigned char* lds, int tid, int lane, int wave, int vcu, int G) {
    unsigned char* ws = a.ws;
    const v4u* QG = (const v4u*)(ws + PQG); const v4u* QM = (const v4u*)(ws + PQM); const v4u* KM = (const v4u*)(ws + PKM); const v4u* KD = (const v4u*)(ws + PKD); const float* DEC = (const float*)(ws + PDEC);
    const bf16* V = (const bf16*)(ws + RA_V); float* OF = (float*)(ws + RA_OF);
    const int l15 = lane & 15, l4 = lane >> 4;
    for (int item = vcu; item < 256; item += G) {
        const int vs = item & 3, dir = (item >> 2) & 1, h = (item >> 3) & 3, b = item >> 5;
        f32x4 S[4];
#pragma unroll
        for (int tv = 0; tv < 4; ++tv) S[tv] = (f32x4){0.f, 0.f, 0.f, 0.f};
        v4u rq[6], rk[2], rv; float rdec = 0.f;
#define GL_LOAD(ch_) do { const int ch__ = (ch_); \
            if (ch__ >= 4) { const size_t t_ = ((((size_t)(dir * 8 + b) * 32 + (ch__ - 4)) * 4 + h) * 1024); \
                rq[0] = QG[t_ + tid]; rq[1] = QG[t_ + tid + 512]; rq[2] = QM[t_ + tid]; rq[3] = QM[t_ + tid + 512]; rq[4] = KM[t_ + tid]; rq[5] = KM[t_ + tid + 512]; } \
            { const size_t t_ = ((((size_t)(dir * 8 + b) * 36 + ch__) * 4 + h) * 1024); rk[0] = KD[t_ + tid]; rk[1] = KD[t_ + tid + 512]; } \
            { const int row_ = scan_row(b, dir, ch__ * 64 + (tid >> 3)); rv = *(const v4u*)(V + (size_t)row_ * 1024 + h * 256 + vs * 64 + 8 * (tid & 7)); } \
            if (tid < 128) rdec = DEC[((size_t)(dir * 8 + b) * 36 + ch__) * 512 + h * 128 + tid]; } while (0)
        GL_LOAD(0);
        for (int ch = 0; ch < 36; ++ch) {
            const bool lat = ch >= 4;
#pragma unroll
            for (int tv = 0; tv < 4; ++tv) { v2u p; p.x = pk2(S[tv][0], S[tv][1]); p.y = pk2(S[tv][2], S[tv][3]);
                *(LAS v2u*)(lds + GL_ST + (16 * tv + l15) * 272 + (16 * wave + 4 * l4) * 2) = p; }
            if (lat) {
#pragma unroll
                for (int q = 0; q < 2; ++q) { const int p = tid + 512 * q; const int off = (p >> 4) * 272 + (p & 15) * 16;
                    *(LAS v4u*)(lds + GL_QG + off) = rq[q]; *(LAS v4u*)(lds + GL_QM + off) = rq[2 + q]; *(LAS v4u*)(lds + GL_KM + off) = rq[4 + q]; } }
#pragma unroll
            for (int q = 0; q < 2; ++q) { const int p = tid + 512 * q; *(LAS v4u*)(lds + GL_KDT + (p >> 3) * 144 + (p & 7) * 16) = rk[q]; }
            { const int i = tid >> 3, c = tid & 7; LAS bf16* vt = (LAS bf16*)(lds + GL_VT) + i;
              vt[(8 * c + 0) * 72] = (bf16)(rv.x & 0xffffu); vt[(8 * c + 1) * 72] = (bf16)(rv.x >> 16); vt[(8 * c + 2) * 72] = (bf16)(rv.y & 0xffffu); vt[(8 * c + 3) * 72] = (bf16)(rv.y >> 16);
              vt[(8 * c + 4) * 72] = (bf16)(rv.z & 0xffffu); vt[(8 * c + 5) * 72] = (bf16)(rv.z >> 16); vt[(8 * c + 6) * 72] = (bf16)(rv.w & 0xffffu); vt[(8 * c + 7) * 72] = (bf16)(rv.w >> 16); }
            if (tid < 128) *(LAS float*)(lds + GL_DEC + tid * 4) = rdec;
            __syncthreads();
            if (ch + 1 < 36) GL_LOAD(ch + 1);
            if (lat) {
                { const int ti = wave >> 1; f32x4 c0 = (f32x4){0.f, 0.f, 0.f, 0.f}, c1 = c0; const int tj0 = (wave & 1) * 2;
#pragma unroll
                  for (int ks = 0; ks < 4; ++ks) { const int ko = (32 * ks + 8 * l4) * 2;
                      const bf16x8 bq = *(const LAS bf16x8*)(lds + GL_QM + (16 * ti + l15) * 272 + ko);
                      const bf16x8 a0 = *(const LAS bf16x8*)(lds + GL_KM + (16 * tj0 + l15) * 272 + ko), a1 = *(const LAS bf16x8*)(lds + GL_KM + (16 * tj0 + 16 + l15) * 272 + ko);
                      c0 = __builtin_amdgcn_mfma_f32_16x16x32_bf16(a0, bq, c0, 0, 0, 0); c1 = __builtin_amdgcn_mfma_f32_16x16x32_bf16(a1, bq, c1, 0, 0, 0); }
                  const int i = 16 * ti + l15;
                  { const int j0 = 16 * tj0 + 4 * l4; v2u p; p.x = pk2(j0 <= i ? c0[0] : 0.f, j0 + 1 <= i ? c0[1] : 0.f); p.y = pk2(j0 + 2 <= i ? c0[2] : 0.f, j0 + 3 <= i ? c0[3] : 0.f);
                    *(LAS v2u*)(lds + GL_AM + i * 144 + j0 * 2) = p; }
                  { const int j0 = 16 * tj0 + 16 + 4 * l4; v2u p; p.x = pk2(j0 <= i ? c1[0] : 0.f, j0 + 1 <= i ? c1[1] : 0.f); p.y = pk2(j0 + 2 <= i ? c1[2] : 0.f, j0 + 3 <= i ? c1[3] : 0.f);
                    *(LAS v2u*)(lds + GL_AM + i * 144 + j0 * 2) = p; } }
                __syncthreads();
                { const int ti = wave >> 1, tv0 = (wave & 1) * 2; f32x4 c0 = (f32x4){0.f, 0.f, 0.f, 0.f}, c1 = c0;
#pragma unroll
                  for (int ks = 0; ks < 4; ++ks) { const int ko = (32 * ks + 8 * l4) * 2;
                      const bf16x8 bq = *(const LAS bf16x8*)(lds + GL_QG + (16 * ti + l15) * 272 + ko);
                      const bf16x8 a0 = *(const LAS bf16x8*)(lds + GL_ST + (16 * tv0 + l15) * 272 + ko), a1 = *(const LAS bf16x8*)(lds + GL_ST + (16 * tv0 + 16 + l15) * 272 + ko);
                      c0 = __builtin_amdgcn_mfma_f32_16x16x32_bf16(a0, bq, c0, 0, 0, 0); c1 = __builtin_amdgcn_mfma_f32_16x16x32_bf16(a1, bq, c1, 0, 0, 0); }
#pragma unroll
                  for (int ks = 0; ks < 2; ++ks) { const int ko = (32 * ks + 8 * l4) * 2;
                      const bf16x8 bq = *(const LAS bf16x8*)(lds + GL_AM + (16 * ti + l15) * 144 + ko);
                      const bf16x8 a0 = *(const LAS bf16x8*)(lds + GL_VT + (16 * tv0 + l15) * 144 + ko), a1 = *(const LAS bf16x8*)(lds + GL_VT + (16 * tv0 + 16 + l15) * 144 + ko);
                      c0 = __builtin_amdgcn_mfma_f32_16x16x32_bf16(a0, bq, c0, 0, 0, 0); c1 = __builtin_amdgcn_mfma_f32_16x16x32_bf16(a1, bq, c1, 0, 0, 0); }
                  const int s = ch * 64 + 16 * ti + l15; const int t0 = s - 256; const int t = dir ? 2047 - t0 : t0;
                  float* orow = OF + ((size_t)dir * NT + b * 2048 + t) * 1024 + h * 256 + vs * 64 + 16 * tv0 + 4 * l4;
                  *(f32x4*)(orow) = c0; *(f32x4*)(orow + 16) = c1; }
            }
            { const f32x4 d4 = *(const LAS f32x4*)(lds + GL_DEC + (16 * wave + 4 * l4) * 4);
#pragma unroll
              for (int tv = 0; tv < 4; ++tv) S[tv] = S[tv] * d4;
#pragma unroll
              for (int ks = 0; ks < 2; ++ks) { const int ko = (32 * ks + 8 * l4) * 2;
                  const bf16x8 ak = *(const LAS bf16x8*)(lds + GL_KDT + (16 * wave + l15) * 144 + ko);
#pragma unroll
                  for (int tv = 0; tv < 4; ++tv) { const bf16x8 bv = *(const LAS bf16x8*)(lds + GL_VT + (16 * tv + l15) * 144 + ko);
                      S[tv] = __builtin_amdgcn_mfma_f32_16x16x32_bf16(ak, bv, S[tv], 0, 0, 0); } } }
            __syncthreads();
        }
#undef GL_LOAD
    }
}

template <int HALFW>
__device__ __forceinline__ void pool_item(const bf16* P, bf16* DP, LAS float* tmp, int tid, int b, int r, int g) {
    const int rlo = r - HALFW < 0 ? 0 : r - HALFW, rhi = r + HALFW > 32 ? 32 : r + HALFW;
    const float rinv = 1.f / (float)(rhi - rlo);
#pragma unroll 1
    for (int q = 0; q < 4; ++q) { const int p = tid + 512 * q, c = p >> 5, ch0 = (p & 31) * 8; float acc[8]; v4u x[2 * HALFW];
#pragma unroll
        for (int u = 0; u < 2 * HALFW; ++u) { const int rr = (rlo + u < rhi) ? rlo + u : rlo; x[u] = *(const v4u*)(P + ((size_t)(b * 2048 + rr * 64 + c)) * 1024 + g * 256 + ch0); }
#pragma unroll
        for (int j = 0; j < 8; ++j) acc[j] = 0.f;
#pragma unroll
        for (int u = 0; u < 2 * HALFW; ++u) { const float m = (rlo + u < rhi) ? 1.f : 0.f;
            acc[0] += m * bflo(x[u].x); acc[1] += m * bfhi(x[u].x); acc[2] += m * bflo(x[u].y); acc[3] += m * bfhi(x[u].y); acc[4] += m * bflo(x[u].z); acc[5] += m * bfhi(x[u].z); acc[6] += m * bflo(x[u].w); acc[7] += m * bfhi(x[u].w); }
        *(LAS f32x4*)(tmp + c * 256 + ch0) = (f32x4){acc[0] * rinv, acc[1] * rinv, acc[2] * rinv, acc[3] * rinv};
        *(LAS f32x4*)(tmp + c * 256 + ch0 + 4) = (f32x4){acc[4] * rinv, acc[5] * rinv, acc[6] * rinv, acc[7] * rinv}; }
    __syncthreads();
#pragma unroll 1
    for (int q = 0; q < 4; ++q) { const int p = tid + 512 * q, c = p >> 5, ch0 = (p & 31) * 8;
        const int clo = c - HALFW < 0 ? 0 : c - HALFW, chi = c + HALFW > 64 ? 64 : c + HALFW; const float cinv = 1.f / (float)(chi - clo);
        const size_t o = ((size_t)(b * 2048 + r * 64 + c)) * 1024 + g * 256 + ch0;
        const v4u x = *(const v4u*)(P + o);
        f32x4 a0 = (f32x4){0.f, 0.f, 0.f, 0.f}, a1 = a0;
#pragma unroll
        for (int u = 0; u < 2 * HALFW; ++u) { const int cc = (clo + u < chi) ? clo + u : clo; const float m = (clo + u < chi) ? 1.f : 0.f;
            a0 += *(const LAS f32x4*)(tmp + cc * 256 + ch0) * m; a1 += *(const LAS f32x4*)(tmp + cc * 256 + ch0 + 4) * m; }
        v4u d; d.x = pk2(a0[0] * cinv - bflo(x.x), a0[1] * cinv - bfhi(x.x)); d.y = pk2(a0[2] * cinv - bflo(x.y), a0[3] * cinv - bfhi(x.y));
        d.z = pk2(a1[0] * cinv - bflo(x.z), a1[1] * cinv - bfhi(x.z)); d.w = pk2(a1[2] * cinv - bflo(x.w), a1[3] * cinv - bfhi(x.w));
        *(v4u*)(DP + o) = d; }
    __syncthreads();
}
__device__ __forceinline__ void phase3_pool(const Args& a, LAS unsigned char* lds, int tid, int vcu, int G) {
    const bf16* P = (const bf16*)(a.ws + RA_P); bf16* DP = (bf16*)(a.ws + RA_DPOOL);
    LAS float* tmp = (LAS float*)lds;
    for (int item = vcu; item < 1024; item += G) {
        const int g = item >> 8, r = (item >> 3) & 31, b = item & 7;
        const int gg = 3 - g;
        if (gg == 0) pool_item<1>(P, DP, tmp, tid, b, r, gg); else if (gg == 1) pool_item<2>(P, DP, tmp, tid, b, r, gg); else if (gg == 2) pool_item<4>(P, DP, tmp, tid, b, r, gg); else pool_item<8>(P, DP, tmp, tid, b, r, gg);
    }
}

__device__ __forceinline__ void phase4_post(const Args& a, int lane, int wave, int vcu, int G) {
    const float* OF = (const float*)(a.ws + RA_OF); const float* OB = OF + (size_t)NT * 1024; const bf16* Rr = (const bf16*)(a.ws + RA_R); bf16* Y = (bf16*)(a.ws + RA_YMIX);
    const float* gn = a.in[15];
    for (int idx = vcu * 8 + wave; idx < NT * 4; idx += G * 8) {
        const int t = idx >> 2, h = idx & 3; const size_t o = (size_t)t * 1024 + h * 256 + 4 * lane;
        const f32x4 x = *(const f32x4*)(OF + o) + *(const f32x4*)(OB + o);
        const float ms = wave_sum(x[0] * x[0] + x[1] * x[1] + x[2] * x[2] + x[3] * x[3]) * (1.f / 256.f);
        const float sc = rsqrtf(ms + EPS);
        const f32x4 g4 = *(const f32x4*)(gn + h * 256 + 4 * lane);
        const v2u rr = *(const v2u*)(Rr + o);
        const float r0 = bflo(rr.x), r1 = bfhi(rr.x), r2 = bflo(rr.y), r3 = bfhi(rr.y);
        v2u q; q.x = pk2(x[0] * sc * g4[0] * silu_f(r0), x[1] * sc * g4[1] * silu_f(r1)); q.y = pk2(x[2] * sc * g4[2] * silu_f(r2), x[3] * sc * g4[3] * silu_f(r3));
        *(v2u*)(Y + (size_t)t * 2048 + h * 256 + 4 * lane) = q;
    }
}

__device__ __forceinline__ void phase6(const Args& a, LAS unsigned char* lds, int tid, int lane, int wave, int vcu, int G) {
    unsigned char* ws = a.ws;
    const float* mod = (const float*)(ws + WS_MOD); const float* Y1 = (const float*)(ws + RA_Y1); unsigned char* H2 = ws + RA_H2;
    const float* gpost = a.in[7]; const float* gpre2 = a.in[8]; const float* rbias = a.in[20];
    const bf16* whi = (const bf16*)(ws + WS_WRT); const bf16* wlo = whi + 64 * 2048;
    LAS float* part = (LAS float*)lds;
    LAS float* logit = (LAS float*)(lds + LDS_LOGIT);
    LAS u64* masks = (LAS u64*)(lds + LDS_MASKS);
    int* cnt = (int*)(ws + T_CNT); u64* tmask = (u64*)(ws + T_MASK); float* tokw = (float*)(ws + T_TOKW);
    const int l15 = lane & 15, l4 = lane >> 4;
    for (int blk = vcu; blk < NT / 64; blk += G) {
        for (int it = 0; it < 4; ++it) {
#pragma unroll 1
            for (int rr = 0; rr < 2; ++rr) {
                const int lr = wave * 2 + rr, t = blk * 64 + it * 16 + lr; const float* mr = mod + (size_t)(t >> 11) * 12288;
                const float* yr = Y1 + (size_t)t * 2048; const float* xr = a.in[0] + (size_t)t * 2048; float* outr = (float*)(ws + WS_X1) + (size_t)t * 2048;
                f32x4 y[8]; float ss = 0.f;
#pragma unroll
                for (int j = 0; j < 8; ++j) { y[j] = *(const f32x4*)(yr + 4 * (lane + 64 * j)); ss += y[j][0] * y[j][0] + y[j][1] * y[j][1] + y[j][2] * y[j][2] + y[j][3] * y[j][3]; }
                const float rstd1 = rsqrtf(wave_sum(ss) * (1.f / 2048.f) + EPS);
                float s2 = 0.f;
#pragma unroll
                for (int j = 0; j < 8; ++j) { const int c = 4 * (lane + 64 * j); const f32x4 x = *(const f32x4*)(xr + c), gp = *(const f32x4*)(gpost + c), gt = *(const f32x4*)(mr + 4096 + c);
                    const f32x4 x1 = x + gt * (y[j] * rstd1 * gp); y[j] = x1; *(f32x4*)(outr + c) = x1;
                    s2 += x1[0] * x1[0] + x1[1] * x1[1] + x1[2] * x1[2] + x1[3] * x1[3]; }
                const float rstd2 = rsqrtf(wave_sum(s2) * (1.f / 2048.f) + EPS);
#pragma unroll
                for (int j = 0; j < 8; ++j) { const int c = 4 * (lane + 64 * j); const f32x4 g2 = *(const f32x4*)(gpre2 + c), sh = *(const f32x4*)(mr + 6144 + c), sc = *(const f32x4*)(mr + 8192 + c);
                    const f32x4 hh = y[j] * rstd2 * g2 * (sc + 1.f) + sh;
                    unsigned hi[4], lo[4];
#pragma unroll
                    for (int q = 0; q < 4; ++q) { hi[q] = f2bf(hh[q]); lo[q] = f2bf(hh[q] - __builtin_bit_cast(float, hi[q] << 16)); }
                    v2u qh, ql; qh.x = hi[0] | (hi[1] << 16); qh.y = hi[2] | (hi[3] << 16); ql.x = lo[0] | (lo[1] << 16); ql.y = lo[2] | (lo[3] << 16);
                    *(LAS v2u*)(lds + RT_HI + lr * RT_ROWB + c * 2) = qh; *(LAS v2u*)(lds + RT_LO + lr * RT_ROWB + c * 2) = ql;
                    *(unsigned*)(H2 + (size_t)t * 2048 + c) = pk4_fp8(hh[0] * SC_H, hh[1] * SC_H, hh[2] * SC_H, hh[3] * SC_H); }
            }
            __syncthreads();
            { f32x4 acc[4];
#pragma unroll
              for (int et = 0; et < 4; ++et) acc[et] = (f32x4){0.f, 0.f, 0.f, 0.f};
#pragma unroll 1
              for (int ks = 0; ks < 8; ++ks) { const int k0 = 256 * wave + 32 * ks + 8 * l4;
                  const bf16x8 ah = *(const LAS bf16x8*)(lds + RT_HI + l15 * RT_ROWB + k0 * 2), al = *(const LAS bf16x8*)(lds + RT_LO + l15 * RT_ROWB + k0 * 2);
#pragma unroll
                  for (int et = 0; et < 4; ++et) { const bf16x8 bh = *(const bf16x8*)(whi + (size_t)(16 * et + l15) * 2048 + k0), bl = *(const bf16x8*)(wlo + (size_t)(16 * et + l15) * 2048 + k0);
                      acc[et] = __builtin_amdgcn_mfma_f32_16x16x32_bf16(ah, bh, acc[et], 0, 0, 0);
                      acc[et] = __builtin_amdgcn_mfma_f32_16x16x32_bf16(ah, bl, acc[et], 0, 0, 0);
                      acc[et] = __builtin_amdgcn_mfma_f32_16x16x32_bf16(al, bh, acc[et], 0, 0, 0); } }
              __syncthreads();
#pragma unroll
              for (int et = 0; et < 4; ++et)
#pragma unroll
                  for (int q = 0; q < 4; ++q) part[(wave * 16 + 4 * l4 + q) * 64 + 16 * et + l15] = acc[et][q]; }
            __syncthreads();
#pragma unroll
            for (int q = 0; q < 2; ++q) { const int idx = tid + 512 * q; float sacc = 0.f;
#pragma unroll
                for (int w = 0; w < 8; ++w) sacc += part[w * 1024 + idx];
                logit[idx] = sacc; }
            __syncthreads();
#pragma unroll 1
            for (int rr = 0; rr < 2; ++rr) {
                const int lr = wave * 2 + rr, t = blk * 64 + it * 16 + lr;
                const float lg = logit[lr * 64 + lane]; const float s = 1.f / (1.f + __expf(-lg)); const float sel = s + rbias[lane];
                float m1 = sel; m1 = fmaxf(m1, __shfl_xor(m1, 1)); m1 = fmaxf(m1, __shfl_xor(m1, 2)); m1 = fmaxf(m1, __shfl_xor(m1, 4));
                const u64 eq = __ballot(sel == m1); const unsigned gb = (unsigned)(eq >> (lane & ~7)) & 0xffu; const int first = __builtin_ctz(gb);
                float v2 = ((lane & 7) == first) ? -INFINITY : sel; v2 = fmaxf(v2, __shfl_xor(v2, 1)); v2 = fmaxf(v2, __shfl_xor(v2, 2)); v2 = fmaxf(v2, __shfl_xor(v2, 4));
                const float gs = m1 + v2; const int g = lane >> 3; int grank = 0;
#pragma unroll
                for (int g2 = 0; g2 < 8; ++g2) { const float o = __shfl(gs, g2 * 8); grank += (o > gs || (o == gs && g2 < g)) ? 1 : 0; }
                const bool gsel = grank < 4; const float mk = gsel ? sel : -INFINITY; int rank = 0;
                for (int e2 = 0; e2 < 64; ++e2) { const float o = __shfl(mk, e2); rank += (o > mk || (o == mk && e2 < lane)) ? 1 : 0; }
                const bool chosen = gsel && rank < 8;
                const u64 mask = __ballot(chosen); const float ssum = wave_sum(chosen ? s : 0.f);
                const int kidx = __popcll(mask & ((1ull << lane) - 1ull));
                if (chosen) tokw[(size_t)t * 8 + kidx] = s / ssum * 2.5f;
                if (lane == 0) { tmask[t] = mask; masks[it * 16 + lr] = mask; }
            }
            __syncthreads();
        }
        if (wave == 0) { const u64 m = masks[lane]; int mine = 0;
            for (int e = 0; e < 64; ++e) { const int c = __popcll(__ballot((m >> e) & 1ull)); mine = (lane == e) ? c : mine; }
            cnt[blk * 64 + lane] = mine; }
        __syncthreads();
    }
}

__device__ __forceinline__ void phase7(const Args& a, LAS unsigned char* lds, int tid, int lane, int wave, int vcu, int G) {
    unsigned char* ws = a.ws;
    const int* cnt = (const int*)(ws + T_CNT); const u64* tmask = (const u64*)(ws + T_MASK); const float* tokw = (const float*)(ws + T_TOKW);
    int* tokslot = (int*)(ws + T_TOKSLOT); int* slottok = (int*)(ws + T_SLOTTOK); float* slotw = (float*)(ws + T_SLOTW); int* tile = (int*)(ws + T_TILE);
    LAS int* part = (LAS int*)lds;
    LAS int* tot = (LAS int*)(lds + 4096);
    for (int blk = vcu; blk < NT / 64; blk += G) {
        int pre = 0, all = 0;
        for (int b2 = wave; b2 < 256; b2 += 8) { const int c = cnt[b2 * 64 + lane]; all += c; pre += (b2 < blk) ? c : 0; }
        part[(wave * 2) * 64 + lane] = pre; part[(wave * 2 + 1) * 64 + lane] = all;
        __syncthreads();
        if (wave == 0) {
            int p = 0, t = 0;
#pragma unroll
            for (int w = 0; w < 8; ++w) { p += part[(w * 2) * 64 + lane]; t += part[(w * 2 + 1) * 64 + lane]; }
            int incl = t;
#pragma unroll
            for (int o = 1; o < 64; o <<= 1) { const int v = __shfl_up(incl, o); if (lane >= o) incl += v; }
            const int start = incl - t; const int base = start + p;
            tot[lane] = t; tot[64 + lane] = start;
            const int tokn = blk * 64 + lane; const u64 m = tmask[tokn];
            for (int e = 0; e < 64; ++e) { const bool bit = (m >> e) & 1ull; const u64 bal = __ballot(bit); const int be = __shfl(base, e);
                if (bit) { const int rank = __popcll(bal & ((1ull << lane) - 1ull)); const int slot = be + rank; const int k = __popcll(m & ((1ull << e) - 1ull));
                    slottok[slot] = tokn; slotw[slot] = tokw[(size_t)tokn * 8 + k]; tokslot[(size_t)tokn * 8 + k] = slot; } }
            slottok[SH_ROW0 + tokn] = tokn; slotw[SH_ROW0 + tokn] = 1.f;
        }
        __syncthreads();
        if (blk == 0 && tid == 0) {
            int n = 0;
            for (int e = 0; e < 64; ++e) { const int te = tot[e], st = tot[64 + e];
                for (int j = 0; j * 256 < te; ++j) { tile[n] = e; tile[NTILE_MAX + n] = st + j * 256; tile[2 * NTILE_MAX + n] = (te - j * 256) < 256 ? (te - j * 256) : 256; ++n; } }
            for (int j = 0; j < 64; ++j) { tile[n] = 64; tile[NTILE_MAX + n] = SH_ROW0 + j * 256; tile[2 * NTILE_MAX + n] = 256; ++n; }
            tile[3 * NTILE_MAX] = n;
        }
        __syncthreads();
    }
}

__device__ __forceinline__ void phase10(const Args& a, int lane, int wave, int vcu, int G) {
    unsigned char* ws = a.ws;
    const float* mod = (const float*)(ws + WS_MOD); const bf16* SO = (const bf16*)(ws + WS_SLOTOUT); const int* tokslot = (const int*)(ws + T_TOKSLOT); const float* gp = a.in[9];
    for (int t = vcu * 8 + wave; t < NT; t += G * 8) {
        const float* mr = mod + (size_t)(t >> 11) * 12288;
        const int myslot = lane < 8 ? tokslot[(size_t)t * 8 + lane] : SH_ROW0 + t;
        v4u x[9][4]; f32x4 xo[4][2]; const float* x1r = (const float*)(ws + WS_X1) + (size_t)t * 2048;
#pragma unroll
        for (int k = 0; k < 9; ++k) { const int slot = __shfl(myslot, k); const bf16* sr = SO + (size_t)slot * 2048;
#pragma unroll
            for (int j = 0; j < 4; ++j) x[k][j] = *(const v4u*)(sr + 8 * (lane + 64 * j)); }
#pragma unroll
        for (int j = 0; j < 4; ++j) { xo[j][0] = *(const f32x4*)(x1r + 8 * (lane + 64 * j)); xo[j][1] = *(const f32x4*)(x1r + 8 * (lane + 64 * j) + 4); }
        float y[4][8];
#pragma unroll
        for (int j = 0; j < 4; ++j)
#pragma unroll
            for (int q = 0; q < 8; ++q) y[j][q] = 0.f;
#pragma unroll
        for (int k = 0; k < 9; ++k)
#pragma unroll
            for (int j = 0; j < 4; ++j) { const v4u v = x[k][j];
                y[j][0] += bflo(v.x); y[j][1] += bfhi(v.x); y[j][2] += bflo(v.y); y[j][3] += bfhi(v.y); y[j][4] += bflo(v.z); y[j][5] += bfhi(v.z); y[j][6] += bflo(v.w); y[j][7] += bfhi(v.w); }
        float ss = 0.f;
#pragma unroll
        for (int j = 0; j < 4; ++j)
#pragma unroll
            for (int q = 0; q < 8; ++q) ss += y[j][q] * y[j][q];
        const float rstd = rsqrtf(wave_sum(ss) * (1.f / 2048.f) + EPS);
        float* outr = a.out + (size_t)t * 2048;
#pragma unroll
        for (int j = 0; j < 4; ++j)
#pragma unroll
            for (int hh = 0; hh < 2; ++hh) { const int c = 8 * (lane + 64 * j) + 4 * hh; const f32x4 x1 = xo[j][hh], g = *(const f32x4*)(gp + c), gt = *(const f32x4*)(mr + 10240 + c);
                f32x4 yy; yy[0] = y[j][4 * hh]; yy[1] = y[j][4 * hh + 1]; yy[2] = y[j][4 * hh + 2]; yy[3] = y[j][4 * hh + 3];
                *(f32x4*)(outr + c) = x1 + gt * (yy * rstd * g); }
    }
}

__global__ void __launch_bounds__(512, 2) fwd(Args args) {
    extern __shared__ __attribute__((aligned(16))) unsigned char lds_raw[];
    LAS unsigned char* lds = (LAS unsigned char*)lds_raw;
    const int tid = threadIdx.x, lane = tid & 63, wave = __builtin_amdgcn_readfirstlane(tid >> 6);
    const int G = gridDim.x, bx = blockIdx.x;
    const int vcu = (G % 8 == 0) ? (bx % 8) * (G / 8) + bx / 8 : bx;
    unsigned char* ws = args.ws;
    volatile LAS unsigned* MISC = (volatile LAS unsigned*)(lds + LDS_MISC);
    if (tid < 64) MISC[tid] = 0u;
    __syncthreads();
    const int lo = args.ph_lo, hi = args.ph_hi;
    XcdBarrier bar; bar.bar = (unsigned*)(ws + WS_CTL) + 4096; bar.x = 0; bar.st = nullptr;
    if (hi - lo > 1) bar = xcd_barrier_post((unsigned*)(ws + WS_CTL) + 4096, MISC + 8);
#ifndef PH_MASK
#define PH_MASK 0xfff
#endif
#define IN(k) (((PH_MASK >> (k)) & 1) && lo <= (k) && (k) < hi)
#define SEAM(k) do { if (IN(k) && IN((k) + 1)) xcd_barrier(bar); } while (0)

#ifndef REP_PHASE
#define REP_PHASE -1
#endif
#define RUNPH(k, ...) do { if (IN(k)) { __VA_ARGS__ if (REP_PHASE == (k)) { xcd_barrier(bar); __VA_ARGS__ } SEAM(k); } } while (0)
    RUNPH(0, phase0(args, lds, tid, lane, wave, vcu, G););
    RUNPH(1, phase1(args, lane, wave, vcu, G););
    RUNPH(2, {
        DenseSched S; S.init(ws + RA_H, ws + WS_WIN, 2048, 2048, MROWS, DINP, G, bx);
        EpiIn E{ws};
        pg8::gemm_phase<EpiIn, DenseSched>(lds, 2048, S, E); });
    RUNPH(3, phase3_prep(args, lds, tid, vcu, G); phase3_pool(args, lds, tid, vcu, G););
    RUNPH(4, phase_chain(args, lds, tid, lane, wave, vcu, G););
    RUNPH(5, {
        phase4_post(args, lane, wave, vcu, G);
        PoolSched S{(const char*)(ws + RA_DPOOL), (const char*)(ws + WS_WPOOL), G, vcu};
        EpiPool E{(bf16*)(ws + RA_YMIX), args.in[17]};
        int kpool = 256; asm volatile("" : "+s"(kpool));
        pg8::gemm_phase<EpiPool, PoolSched>(lds, kpool, S, E); });
    RUNPH(6, {
        DenseSched S; S.init(ws + RA_YMIX, ws + WS_WOUT, 2048, 2048, NT, 2048, G, bx);
        EpiOut E{(float*)(ws + RA_Y1)};
        pg8::gemm_phase<EpiOut, DenseSched>(lds, 2048, S, E); });
    RUNPH(7, phase6(args, lds, tid, lane, wave, vcu, G););
    RUNPH(8, phase7(args, lds, tid, lane, wave, vcu, G););
    RUNPH(9, {
        MoeGUSched S{(const char*)(ws + RA_H2), (const char*)(ws + WS_WGU), (const int*)(ws + T_TILE), (const int*)(ws + T_SLOTTOK), G, vcu};
        EpiGU E{ws + WS_ACT, (const float*)(ws + T_SLOTW)};
        int kgu = 1024; asm volatile("" : "+s"(kgu));
        pg8::gemm_phase<EpiGU, MoeGUSched, true>(lds, kgu, S, E); });
    RUNPH(10, {
        MoeDownSched S{(const char*)(ws + WS_ACT), (const char*)(ws + WS_WD), (const int*)(ws + T_TILE), G, vcu};
        EpiDown E{(bf16*)(ws + WS_SLOTOUT)};
        int kdn = 256; asm volatile("" : "+s"(kdn));
        pg8::gemm_phase<EpiDown, MoeDownSched, true>(lds, kdn, S, E); });
    if (IN(11)) { phase10(args, lane, wave, vcu, G); if (REP_PHASE == 11) { xcd_barrier(bar); phase10(args, lane, wave, vcu, G); } }
#undef IN
#undef SEAM
}

extern "C" void kernel_launch(void* const* d_in, const int* in_sizes, int n_in, void* d_out, int out_size, void* d_ws, size_t ws_size, hipStream_t stream) {
    static int grid = 0;
    if (grid == 0) {
        if (n_in != 27 || out_size != NT * DM || ws_size < WS_NEED) { fprintf(stderr, "kernel_launch: unexpected problem: n_in %d out %d ws %zu (need %zu)\n", n_in, out_size, ws_size, (size_t)WS_NEED); grid = -1; return; }
        int dev = 0, cus = 0, per_cu = 0;
        if (hipGetDevice(&dev) != hipSuccess || hipDeviceGetAttribute(&cus, hipDeviceAttributeMultiprocessorCount, dev) != hipSuccess) { grid = -1; return; }
        if (hipFuncSetAttribute((const void*)fwd, hipFuncAttributeMaxDynamicSharedMemorySize, LDS_BYTES) != hipSuccess) { fprintf(stderr, "kernel_launch: hipFuncSetAttribute failed\n"); grid = -1; return; }
        if (hipOccupancyMaxActiveBlocksPerMultiprocessor(&per_cu, (const void*)fwd, 512, LDS_BYTES) != hipSuccess || per_cu < 1) { fprintf(stderr, "kernel_launch: occupancy query says %d\n", per_cu); }
        (void)hipGetLastError();
        grid = cus;
    }
    if (grid < 0) return;
    (void)hipMemsetAsync((char*)d_ws + WS_CTL, 0, CTL_ZERO_BYTES, stream);
    Args a{};
    for (int i = 0; i < 27; ++i) a.in[i] = (const float*)d_in[i];
    a.out = (float*)d_out; a.ws = (unsigned char*)d_ws;
    if (N_LAUNCHES == 1) {
        a.ph_lo = 0; a.ph_hi = NPH;
        hipLaunchKernelGGL(fwd, dim3(grid), dim3(512), LDS_BYTES, stream, a);
    } else {
        for (int p = 0; p < NPH; ++p) { a.ph_lo = p; a.ph_hi = p + 1; hipLaunchKernelGGL(fwd, dim3(grid), dim3(512), LDS_BYTES, stream, a); }
    }
}
```

```cpp
#include <hip/hip_runtime.h>
#include <cstdio>
#include <cstdint>

#ifndef N_LAUNCHES
#define N_LAUNCHES 1
#endif

#define GAS __attribute__((address_space(1)))
#define LAS __attribute__((address_space(3)))
typedef unsigned short bf16;
typedef unsigned v4u __attribute__((ext_vector_type(4)));
typedef unsigned v2u __attribute__((ext_vector_type(2)));
typedef float f32x4 __attribute__((ext_vector_type(4)));
typedef short bf16x8 __attribute__((ext_vector_type(8)));
typedef unsigned long long u64;

constexpr int NB = 8, SEQ = 2048, DM = 2048, CTXL = 256;
constexpr int NT = NB * SEQ;
constexpr int NTC = NB * CTXL;
constexpr int MROWS = NT + NTC;
constexpr int DIN = 4128, DINP = 4352;
constexpr int NE = 64, TOPK = 8, DE = 512;
constexpr int NSLOT_E = NT * TOPK;
constexpr int SH_ROW0 = NSLOT_E + 256;
constexpr int NSLOT = SH_ROW0 + NT;
constexpr int NTILE_MAX = 704;
constexpr float EPS = 1e-6f;
constexpr int NPH = 12;

constexpr size_t MiB = 1u << 20;
constexpr size_t WS_CTL = 0, CTL_ZERO_BYTES = 64 * 1024;
constexpr size_t WS_MOD = 1 * MiB;
constexpr size_t WS_WRT = 1 * MiB + 512 * 1024;
constexpr size_t WS_WIN = 2 * MiB;
constexpr size_t WS_WOUT = WS_WIN + 17 * MiB;
constexpr size_t WS_WPOOL = WS_WOUT + 8 * MiB;
constexpr size_t WS_WD = WS_WPOOL + 1 * MiB;
constexpr size_t WS_WGU = WS_WD + 130 * MiB;
constexpr size_t WS_RA = WS_WGU + 260 * MiB;
constexpr size_t RA_H = WS_RA;
constexpr size_t RA_OF = WS_RA;
constexpr size_t RA_H2 = WS_RA;
constexpr size_t RA_Q = WS_RA + 128 * MiB;
constexpr size_t RA_K = RA_Q + 16 * MiB;
constexpr size_t RA_V = RA_K + 18 * MiB;
constexpr size_t RA_R = RA_V + 36 * MiB;
constexpr size_t RA_P = RA_R + 32 * MiB;
constexpr size_t RA_ALR = RA_P + 32 * MiB;
constexpr size_t RA_DPOOL = RA_ALR + 3 * MiB;
constexpr size_t RA_YMIX = RA_DPOOL + 32 * MiB;
constexpr size_t RA_Y1 = WS_RA + 128 * MiB;
constexpr size_t RA_END = RA_YMIX + 64 * MiB;
constexpr size_t WS_SLOTOUT = WS_WGU;
constexpr size_t WS_ACT = RA_END > WS_SLOTOUT + 578 * MiB ? RA_END : WS_SLOTOUT + 578 * MiB;
constexpr size_t WS_END = WS_ACT + 145 * MiB;
constexpr size_t PQG = WS_ACT;
constexpr size_t PQM = WS_ACT + 32 * MiB;
constexpr size_t PKM = WS_ACT + 64 * MiB;
constexpr size_t PKD = WS_ACT + 96 * MiB;
constexpr size_t PDEC = WS_ACT + 132 * MiB;
constexpr size_t WS_T0 = WS_END;
constexpr size_t T_CNT = WS_T0;
constexpr size_t T_MASK = T_CNT + 65536;
constexpr size_t T_TOKW = T_MASK + 131072;
constexpr size_t T_TOKSLOT = T_TOKW + 524288;
constexpr size_t T_SLOTTOK = T_TOKSLOT + 524288;
constexpr size_t T_SLOTW = T_SLOTTOK + 655360;
constexpr size_t T_TILE = T_SLOTW + 655360;
constexpr size_t WS_X1 = (T_TILE + 16384 + 4095) / 4096 * 4096;
constexpr size_t WS_NEED = WS_X1 + (size_t)NT * DM * 4;

constexpr int RING_BYTES = 131072;
constexpr int LDS_BYTES = 147456;
constexpr int LDS_MISC = LDS_BYTES - 256;
constexpr int RT_ROWB = 4112;
constexpr int RT_HI = 0, RT_LO = 16 * RT_ROWB;
constexpr int LDS_LOGIT = 2 * 16 * RT_ROWB;
constexpr int LDS_MASKS = LDS_LOGIT + 4096;
static_assert(LDS_MASKS + 512 <= LDS_MISC, "LDS map");

#define LDS_WAIT() asm volatile("s_waitcnt lgkmcnt(0)" ::: "memory")
#define VM_WAIT() asm volatile("s_waitcnt vmcnt(0)" ::: "memory")

__device__ __forceinline__ unsigned f2bf(float f) { unsigned u = __builtin_bit_cast(unsigned, f); return (u + 0x7fffu + ((u >> 16) & 1u)) >> 16; }
__device__ __forceinline__ unsigned pk2(float lo, float hi) { return f2bf(lo) | (f2bf(hi) << 16); }
__device__ __forceinline__ float bflo(unsigned u) { return __builtin_bit_cast(float, u << 16); }
__device__ __forceinline__ float bfhi(unsigned u) { return __builtin_bit_cast(float, u & 0xffff0000u); }
__device__ __forceinline__ float bf1(bf16 b) { return __builtin_bit_cast(float, ((unsigned)b) << 16); }
__device__ __forceinline__ float wave_sum(float v) {
#pragma unroll
    for (int o = 1; o < 64; o <<= 1) v += __shfl_xor(v, o);
    return v;
}
__device__ __forceinline__ float silu_f(float x) { return x / (1.f + __expf(-x)); }

#define XB_TMO      128
#define XB_XCNT(j)  (256  + 64 * (j))
#define XB_XSUB(j)  (1280 + 64 * (j))
#define XB_XGEN(j)  (2304 + 64 * (j))
#define XB_TOP      3328
#define XB_TOPGEN   3392
#define XCD_BAR_WORDS 3456
#define XB_SPIN_CAP (1u << 18)

__device__ __forceinline__ unsigned xb_ld(unsigned* p)              { return __hip_atomic_load(p, __ATOMIC_RELAXED, __HIP_MEMORY_SCOPE_AGENT); }
__device__ __forceinline__ unsigned xb_add(unsigned* p, unsigned v) { return __hip_atomic_fetch_add(p, v, __ATOMIC_RELAXED, __HIP_MEMORY_SCOPE_AGENT); }
__device__ __forceinline__ unsigned xb_xcc_id() { return (unsigned)__builtin_amdgcn_s_getreg((3 << 11) | 20) & 0xFu; }
#define XB_SPIN(cond, bar) do { unsigned _sp = 0; while (cond) { __builtin_amdgcn_s_sleep(1); \
    if ((++_sp & 255u) == 0u) { if (xb_ld(&(bar)[XB_TMO])) break; if (_sp > XB_SPIN_CAP) { atomicAdd(&(bar)[XB_TMO], 1u); break; } } } } while (0)

struct XcdBarrier { unsigned* bar; unsigned x; volatile LAS unsigned* st; };

__device__ __forceinline__ XcdBarrier xcd_barrier_post(unsigned* bar, volatile LAS unsigned* st) {
    XcdBarrier b; b.bar = bar; b.x = xb_xcc_id(); b.st = st;
    if (threadIdx.x == 0) (void)xb_add(&bar[XB_XCNT(b.x)], 1u);
    return b;
}
__device__ __forceinline__ void xcd_barrier_complete(unsigned* bar, unsigned x, unsigned& nloc, unsigned& nx) {
    const unsigned G = gridDim.x * gridDim.y * gridDim.z;
    unsigned sum, cnt, mine, sp = 0u;
    for (;;) {
        sum = 0u; cnt = 0u; mine = 0u;
#pragma unroll
        for (unsigned j = 0; j < 16; ++j) { const unsigned c = xb_ld(&bar[XB_XCNT(j)]); sum += c; cnt += (c > 0u) ? 1u : 0u; mine = (j == x) ? c : mine; }
        if (sum == G) break;
        __builtin_amdgcn_s_sleep(1);
        if ((++sp & 255u) == 0u) { if (xb_ld(&bar[XB_TMO])) break; if (sp > XB_SPIN_CAP) { atomicAdd(&bar[XB_TMO], 1u); break; } }
    }
    nloc = mine > 0u ? mine : 1u; nx = cnt > 0u ? cnt : 1u;
}
__device__ __forceinline__ void xcd_barrier(const XcdBarrier& b) {
    asm volatile("s_waitcnt vmcnt(0)" ::: "memory");
    __syncthreads();
    if (threadIdx.x == 0) {
        unsigned* bar = b.bar;
        __builtin_amdgcn_s_waitcnt(0);
        unsigned nloc = b.st[0], nx = b.st[1];
        if (nloc == 0u) { xcd_barrier_complete(bar, b.x, nloc, nx); b.st[0] = nloc; b.st[1] = nx; }
        const unsigned old = xb_add(&bar[XB_XSUB(b.x)], 1u);
        const unsigned gen = old / nloc;
        if (old + 1u == (gen + 1u) * nloc) {
            __builtin_amdgcn_fence(__ATOMIC_RELEASE, "agent");
            asm volatile("s_waitcnt vmcnt(0)" ::: "memory");
            const unsigned og = xb_add(&bar[XB_TOP], 1u);
            const unsigned tg = og / nx;
            if (og + 1u == (tg + 1u) * nx) xb_add(&bar[XB_TOPGEN], 1u);
            else XB_SPIN(xb_ld(&bar[XB_TOPGEN]) == tg, bar);
            __builtin_amdgcn_fence(__ATOMIC_ACQUIRE, "agent");
            xb_add(&bar[XB_XGEN(b.x)], 1u);
            asm volatile("s_waitcnt vmcnt(0)" ::: "memory");
        } else {
            XB_SPIN(xb_ld(&bar[XB_XGEN(b.x)]) == gen, bar);
            __builtin_amdgcn_fence(__ATOMIC_ACQUIRE, "agent");
            asm volatile("s_waitcnt vmcnt(0)" ::: "memory");
        }
    }
    __syncthreads();
}

namespace pg8 {
constexpr int BM = 256, BK = 64, HALF = 128, HTB = HALF * BK * 2, STAGE_BYTES = 8 * HTB, NXCD = 8, WGM = 8;
__device__ __forceinline__ int lds_byte(int r, int c) { const int st = (r >> 4) * 2 + (c >> 5), rr = r & 15, cc = c & 31, ob = rr * 64 + cc * 2; return st * 1024 + (ob ^ (((ob >> 9) & 1) << 5)); }
__device__ __forceinline__ void stage_rc(int b, int& R, int& C) { const int st = b / 1024, sb = b % 1024, swz = sb ^ (((sb >> 9) & 1) << 5); R = (st >> 1) * 16 + swz / 64; C = (st & 1) * 32 + (swz % 64) / 2; }
__device__ __forceinline__ int perm32(int rho) { const int n = rho >> 4, i = rho & 15; return 8 * (i >> 2) + 4 * n + (i & 3); }
__device__ __forceinline__ unsigned cvt_pk_bf16(float lo, float hi) { unsigned r; asm volatile("v_cvt_pk_bf16_f32 %0, %1, %2" : "=v"(r) : "v"(lo), "v"(hi)); return r; }

typedef int v8i __attribute__((ext_vector_type(8)));
typedef int v4i __attribute__((ext_vector_type(4)));
template <class Epi, class Sched, bool FP8 = false>
__device__ __forceinline__ void gemm_phase(LAS unsigned char* lds, const int K, const Sched& S, const Epi& E) {
    typedef typename Sched::U Unit;
    const int tid = threadIdx.x, wid = __builtin_amdgcn_readfirstlane(tid >> 6), lane = tid & 63, wr = wid >> 2, wc = wid & 3, fr = lane & 15, fq = lane >> 4;
    const int nt = K / BK;
    int R[2], C[2]; unsigned voffB[2];
#pragma unroll
    for (int i = 0; i < 2; ++i) { stage_rc(tid * 16 + i * 8192, R[i], C[i]); const int Rb = Epi::PERM ? ((R[i] & ~31) + perm32(R[i] & 31)) : R[i];
        voffB[i] = (unsigned)(Rb * K + C[i]) * 2u; }
    const size_t kstep = (size_t)(BK * 2);
    const size_t hstepB = (size_t)HALF * K * 2;
    const unsigned ldsw = (unsigned)wid * 1024u;
    const int aoff = lds_byte(wr * 64 + fr, fq * 8), boff = lds_byte(wc * 32 + fr, fq * 8);
#define PG8_SA(b, h) (((b) * 2 + (h)) * HTB)
#define PG8_SB(b, h) ((4 + (b) * 2 + (h)) * HTB)
#define PG8_STAGE(bufoff, gbase, v0, v1) do { \
        __builtin_amdgcn_global_load_lds((const unsigned*)((const char*)(gbase) + (v0)), (LAS unsigned*)(lds + (bufoff) + ldsw), 16, 0, 0); \
        __builtin_amdgcn_global_load_lds((const unsigned*)((const char*)(gbase) + (v1)), (LAS unsigned*)(lds + (bufoff) + ldsw + 8192), 16, 0, 0); } while (0)
#define PG8_LDA(dst, b, h) do { _Pragma("unroll") for (int m = 0; m < 4; ++m) { const v4i lo_ = *(const LAS v4i*)(lds + PG8_SA(b, h) + aoff + m * 2048), hi_ = *(const LAS v4i*)(lds + PG8_SA(b, h) + aoff + m * 2048 + 1024); \
        dst[m] = __builtin_shufflevector(lo_, hi_, 0, 1, 2, 3, 4, 5, 6, 7); } } while (0)
#define PG8_LDB(dst, b, h) do { _Pragma("unroll") for (int n = 0; n < 2; ++n) { const v4i lo_ = *(const LAS v4i*)(lds + PG8_SB(b, h) + boff + n * 2048), hi_ = *(const LAS v4i*)(lds + PG8_SB(b, h) + boff + n * 2048 + 1024); \
        dst[n] = __builtin_shufflevector(lo_, hi_, 0, 1, 2, 3, 4, 5, 6, 7); } } while (0)
#define PG8_H0(x) ((bf16x8)__builtin_shufflevector(x, x, 0, 1, 2, 3))
#define PG8_H1(x) ((bf16x8)__builtin_shufflevector(x, x, 4, 5, 6, 7))
#define PG8_MMA(ai, bj, At, Bt) do { __builtin_amdgcn_s_setprio(1); if constexpr (FP8) asm volatile("s_nop 4"); _Pragma("unroll") for (int m = 0; m < 4; ++m) _Pragma("unroll") for (int n = 0; n < 2; ++n) { \
        if constexpr (FP8) asm volatile("v_mfma_f32_16x16x128_f8f6f4 %0, %1, %2, %0" : "+v"(acc[ai][bj][m][n]) : "v"(Bt[n]), "v"(At[m])); \
        else { acc[ai][bj][m][n] = __builtin_amdgcn_mfma_f32_16x16x32_bf16(PG8_H0(Bt[n]), PG8_H0(At[m]), acc[ai][bj][m][n], 0, 0, 0); \
               acc[ai][bj][m][n] = __builtin_amdgcn_mfma_f32_16x16x32_bf16(PG8_H1(Bt[n]), PG8_H1(At[m]), acc[ai][bj][m][n], 0, 0, 0); } } \
        __builtin_amdgcn_s_setprio(0); } while (0)
#define PG8_WAIT_V(n) asm volatile("s_waitcnt vmcnt(" #n ")" ::: "memory")
#define PG8_WAIT_L(n) asm volatile("s_waitcnt lgkmcnt(" #n ")" ::: "memory")
#define PG8_BAR __builtin_amdgcn_s_barrier()
#define PG8_SCHED __builtin_amdgcn_sched_barrier(0)
    Unit cur, nxt; int ui = 0;
    if (!S.next(0, cur)) return;
    f32x4 acc[2][2][4][2];
#pragma unroll
    for (int a = 0; a < 2; ++a)
#pragma unroll
        for (int b = 0; b < 2; ++b)
#pragma unroll
            for (int m = 0; m < 4; ++m)
#pragma unroll
                for (int n = 0; n < 2; ++n) acc[a][b][m][n] = (f32x4){0.f, 0.f, 0.f, 0.f};
    v8i At[4], B0[2], B1[2];
    unsigned vA[4], vN[4];
    S.aoffs(cur, R, C, vA);
    const char* cA = cur.A; const char* cB = cur.B;
    PG8_STAGE(PG8_SB(0, 0), cB, voffB[0], voffB[1]); PG8_STAGE(PG8_SB(0, 1), cB + hstepB, voffB[0], voffB[1]); PG8_STAGE(PG8_SA(0, 0), cA, vA[0], vA[1]); PG8_STAGE(PG8_SA(0, 1), cA, vA[2], vA[3]);
    if (wr == 1) PG8_BAR;
    PG8_WAIT_V(2); PG8_BAR;
    PG8_STAGE(PG8_SB(1, 0), cB + kstep, voffB[0], voffB[1]); PG8_STAGE(PG8_SA(1, 0), cA + kstep, vA[0], vA[1]); PG8_STAGE(PG8_SB(1, 1), cB + hstepB + kstep, voffB[0], voffB[1]);
    PG8_WAIT_V(6); PG8_BAR;
    for (;;) {
        const bool has_next = S.next(ui + 1, nxt);
        const char* nA = has_next ? nxt.A : cA; const char* nB = has_next ? nxt.B : cB;
        if (has_next) S.aoffs(nxt, R, C, vN); else { vN[0] = vA[0]; vN[1] = vA[1]; vN[2] = vA[2]; vN[3] = vA[3]; }
        for (int t = 0; t < nt; t += 2) {
            const bool last = (t == nt - 2);
            const char* a1 = cA + (size_t)(t + 1) * kstep;
            const char* a2 = last ? nA : cA + (size_t)(t + 2) * kstep; const char* b2 = last ? nB : cB + (size_t)(t + 2) * kstep;
            const char* a3 = a2 + kstep; const char* b3 = b2 + kstep;
            const unsigned x0 = last ? vN[0] : vA[0], x1 = last ? vN[1] : vA[1], x2 = last ? vN[2] : vA[2], x3 = last ? vN[3] : vA[3];
            PG8_LDB(B0, 0, 0); PG8_LDB(B1, 0, 1); PG8_SCHED; PG8_LDA(At, 0, 0); PG8_STAGE(PG8_SA(1, 1), a1, vA[2], vA[3]);
            PG8_WAIT_V(8); PG8_WAIT_L(0); PG8_BAR; PG8_MMA(0, 0, At, B0); PG8_MMA(0, 1, At, B1); PG8_BAR; PG8_SCHED;
            PG8_LDA(At, 0, 1); PG8_STAGE(PG8_SB(0, 0), b2, voffB[0], voffB[1]); PG8_STAGE(PG8_SB(0, 1), b2 + hstepB, voffB[0], voffB[1]); PG8_STAGE(PG8_SA(0, 0), a2, x0, x1);
            PG8_WAIT_V(8); PG8_WAIT_L(0); PG8_BAR; PG8_MMA(1, 0, At, B0); PG8_MMA(1, 1, At, B1); PG8_BAR; PG8_SCHED;
            PG8_LDB(B0, 1, 0); PG8_LDB(B1, 1, 1); PG8_SCHED; PG8_LDA(At, 1, 0); PG8_STAGE(PG8_SA(0, 1), a2, x2, x3);
            PG8_WAIT_V(8); PG8_WAIT_L(0); PG8_BAR; PG8_MMA(0, 0, At, B0); PG8_MMA(0, 1, At, B1); PG8_BAR; PG8_SCHED;
            PG8_LDA(At, 1, 1); PG8_STAGE(PG8_SB(1, 0), b3, voffB[0], voffB[1]); PG8_STAGE(PG8_SB(1, 1), b3 + hstepB, voffB[0], voffB[1]); PG8_STAGE(PG8_SA(1, 0), a3, x0, x1);
            PG8_WAIT_V(8); PG8_WAIT_L(0); PG8_BAR; PG8_MMA(1, 0, At, B0); PG8_MMA(1, 1, At, B1); PG8_BAR; PG8_SCHED;
        }
        if (wr == 0) PG8_BAR;
        if constexpr (FP8) asm volatile("s_nop 15\n\ts_nop 15");
        { int tz = threadIdx.x; asm volatile("" : "+v"(tz));
          const int wid_ = tz >> 6, lane_ = tz & 63; E(acc, cur, wid_ >> 2, wid_ & 3, lane_ & 15, lane_ >> 4);
#ifdef PROBE_EPI2
          if constexpr (Epi::PROBE2) { asm volatile("" : "+v"(tz)); const int w2 = tz >> 6, l2 = tz & 63; E(acc, cur, w2 >> 2, w2 & 3, l2 & 15, l2 >> 4); }
#endif
#ifdef PROBE_DRAIN
          if constexpr (Epi::PROBE2) { asm volatile("s_waitcnt vmcnt(0)" ::: "memory"); }
#endif
        }
        if (!has_next) break;
#pragma unroll
        for (int a = 0; a < 2; ++a)
#pragma unroll
            for (int b = 0; b < 2; ++b)
#pragma unroll
                for (int m = 0; m < 4; ++m)
#pragma unroll
                    for (int n = 0; n < 2; ++n) acc[a][b][m][n] = (f32x4){0.f, 0.f, 0.f, 0.f};
        cur = nxt; cA = nA; cB = nB; ++ui;
        vA[0] = vN[0]; vA[1] = vN[1]; vA[2] = vN[2]; vA[3] = vN[3];
        if (wr == 1) PG8_BAR;
    }
    PG8_WAIT_V(0);
    PG8_BAR;
#undef PG8_SA
#undef PG8_SB
#undef PG8_STAGE
#undef PG8_LDA
#undef PG8_LDB
#undef PG8_H0
#undef PG8_H1
#undef PG8_MMA
#undef PG8_WAIT_V
#undef PG8_WAIT_L
#undef PG8_BAR
#undef PG8_SCHED
}
}

struct Args { const float* in[27]; float* out; unsigned char* ws; int ph_lo, ph_hi; };
static_assert(sizeof(Args) == 27 * 8 + 8 + 8 + 8, "Args has no padding");

struct DenseU { const char* A; const char* B; int pm, pn; };
struct DenseSched {
    typedef DenseU U;
    const char* A; const char* B; int lda, K, nM, nN, nwg, G, c;
    __device__ __forceinline__ void init(const void* A_, const void* B_, int lda_, int K_, int M, int N, int G_, int c_) { A = (const char*)A_; B = (const char*)B_; lda = lda_; K = K_; nM = M / 256; nN = N / 256; nwg = nM * nN; G = G_; c = c_; }
    __device__ __forceinline__ bool next(int i, U& u) const {
        const long L = (long)i * G + c; if (L >= nwg) return false;
        int wgid = (int)L; { const int q = nwg / 8, r = nwg % 8, xcd = wgid % 8, off = wgid / 8; wgid = (xcd < r ? xcd * (q + 1) : r * (q + 1) + (xcd - r) * q) + off; }
        const int nig = 8 * nN, gid = wgid / nig, fm = gid * 8, gsz = (nM - fm) < 8 ? (nM - fm) : 8;
        u.pm = fm + ((wgid % nig) % gsz); u.pn = (wgid % nig) / gsz;
        u.A = A + (size_t)u.pm * 256 * lda * 2; u.B = B + (size_t)u.pn * 256 * K * 2; return true;
    }
    __device__ __forceinline__ void aoffs(const U&, const int (&R)[2], const int (&C)[2], unsigned (&v)[4]) const {
#pragma unroll
        for (int h = 0; h < 2; ++h)
#pragma unroll
            for (int i = 0; i < 2; ++i) v[h * 2 + i] = (unsigned)((h * 128 + R[i]) * lda + C[i]) * 2u;
    }
};
struct PoolU { const char* A; const char* B; int pm, g; };
struct PoolSched {
    typedef PoolU U;
    const char* A; const char* B; int G, c;
    __device__ __forceinline__ bool next(int i, U& u) const {
        const int L = i * G + c; if (L >= 256) return false;
        u.g = L & 3; u.pm = L >> 2;
        u.A = A + ((size_t)u.pm * 256 * 1024 + u.g * 256) * 2; u.B = B + (size_t)u.g * 256 * 256 * 2; return true;
    }
    __device__ __forceinline__ void aoffs(const U&, const int (&R)[2], const int (&C)[2], unsigned (&v)[4]) const {
#pragma unroll
        for (int h = 0; h < 2; ++h)
#pragma unroll
            for (int i = 0; i < 2; ++i) v[h * 2 + i] = (unsigned)((h * 128 + R[i]) * 1024 + C[i]) * 2u;
    }
};
struct MoeU { const char* A; const char* B; int row0, nrows, pn; };
struct MoeGUSched {
    typedef MoeU U;
    const char* H2; const char* W; const int* tile; const int* slot_tok; int G, c;
    __device__ __forceinline__ bool next(int i, U& u) const {
        const int nt = tile[3 * NTILE_MAX]; const int L = i * G + c; if (L >= nt * 4) return false;
        const int t = L >> 2; u.pn = L & 3; const int e = tile[t]; u.row0 = tile[NTILE_MAX + t]; u.nrows = tile[2 * NTILE_MAX + t];
        u.A = H2; u.B = W + ((size_t)e * 1024 + u.pn * 256) * 2048; return true;
    }
    __device__ __forceinline__ void aoffs(const U& u, const int (&R)[2], const int (&C)[2], unsigned (&v)[4]) const {
#pragma unroll
        for (int h = 0; h < 2; ++h)
#pragma unroll
            for (int i = 0; i < 2; ++i) { int r = h * 128 + R[i]; r = r < u.nrows ? r : u.nrows - 1; const int tok = slot_tok[u.row0 + r]; v[h * 2 + i] = (unsigned)(tok * 1024 + C[i]) * 2u; }
    }
};
struct MoeDownSched {
    typedef MoeU U;
    const char* ACT; const char* W; const int* tile; int G, c;
    __device__ __forceinline__ bool next(int i, U& u) const {
        const int nt = tile[3 * NTILE_MAX]; const int L = i * G + c; if (L >= nt * 8) return false;
        const int t = L >> 3; u.pn = L & 7; const int e = tile[t]; u.row0 = tile[NTILE_MAX + t]; u.nrows = tile[2 * NTILE_MAX + t];
        u.A = ACT + (size_t)u.row0 * 512; u.B = W + ((size_t)e * 2048 + u.pn * 256) * 512; return true;
    }
    __device__ __forceinline__ void aoffs(const U&, const int (&R)[2], const int (&C)[2], unsigned (&v)[4]) const {
#pragma unroll
        for (int h = 0; h < 2; ++h)
#pragma unroll
            for (int i = 0; i < 2; ++i) v[h * 2 + i] = (unsigned)((h * 128 + R[i]) * 256 + C[i]) * 2u;
    }
};

struct EpiIn {
    static constexpr bool PERM = true; static constexpr bool PROBE2 = false;
    unsigned char* ws;
    __device__ __forceinline__ void operator()(const f32x4 (&acc)[2][2][4][2], const DenseU& u, int wr, int wc, int fr, int fq) const {
        const int pn = u.pn; const int row0 = u.pm * 256 + wr * 64 + fr;
        if (pn == 16) {
            if (wc != 0) return;
            float* alr = (float*)(ws + RA_ALR);
#pragma unroll
            for (int ai = 0; ai < 2; ++ai)
#pragma unroll
                for (int m = 0; m < 4; ++m) { float* rp = alr + (size_t)(row0 + ai * 128 + m * 16) * 32 + 8 * fq;
                    *(f32x4*)(rp) = acc[ai][0][m][0]; *(f32x4*)(rp + 4) = acc[ai][0][m][1]; }
            return;
        }
        bf16* base; int ld, colt; bool lat_only;
        if (pn < 2) { base = (bf16*)(ws + RA_Q); ld = 512; colt = pn * 256; lat_only = true; }
        else if (pn < 4) { base = (bf16*)(ws + RA_K); ld = 512; colt = (pn - 2) * 256; lat_only = false; }
        else if (pn < 8) { base = (bf16*)(ws + RA_V); ld = 1024; colt = (pn - 4) * 256; lat_only = false; }
        else if (pn < 12) { base = (bf16*)(ws + RA_R); ld = 1024; colt = (pn - 8) * 256; lat_only = true; }
        else { base = (bf16*)(ws + RA_P); ld = 1024; colt = (pn - 12) * 256; lat_only = true; }
        if (lat_only && u.pm >= 64) return;
        const int col0 = colt + wc * 32 + 8 * fq;
#pragma unroll
        for (int ai = 0; ai < 2; ++ai)
#pragma unroll
            for (int m = 0; m < 4; ++m) { bf16* rp = base + (size_t)(row0 + ai * 128 + m * 16) * ld + col0;
#pragma unroll
                for (int bj = 0; bj < 2; ++bj) { const f32x4 v0 = acc[ai][bj][m][0], v1 = acc[ai][bj][m][1];
                    v4u o; o.x = pg8::cvt_pk_bf16(v0[0], v0[1]); o.y = pg8::cvt_pk_bf16(v0[2], v0[3]); o.z = pg8::cvt_pk_bf16(v1[0], v1[1]); o.w = pg8::cvt_pk_bf16(v1[2], v1[3]);
                    *(v4u*)(rp + bj * 128) = o; } }
    }
};
struct EpiPool {
    static constexpr bool PERM = true; static constexpr bool PROBE2 = false;
    bf16* ymix; const float* scale;
    __device__ __forceinline__ void operator()(const f32x4 (&acc)[2][2][4][2], const PoolU& u, int wr, int wc, int fr, int fq) const {
        const int row0 = u.pm * 256 + wr * 64 + fr; const int c0 = u.g * 256 + wc * 32 + 8 * fq;
#pragma unroll
        for (int ai = 0; ai < 2; ++ai)
#pragma unroll
            for (int m = 0; m < 4; ++m) { bf16* rp = ymix + (size_t)(row0 + ai * 128 + m * 16) * 2048 + 1024 + c0;
#pragma unroll
                for (int bj = 0; bj < 2; ++bj) { const f32x4 s0 = *(const f32x4*)(scale + c0 + bj * 128), s1 = *(const f32x4*)(scale + c0 + bj * 128 + 4);
                    const f32x4 v0 = acc[ai][bj][m][0] * s0, v1 = acc[ai][bj][m][1] * s1;
                    v4u o; o.x = pg8::cvt_pk_bf16(v0[0], v0[1]); o.y = pg8::cvt_pk_bf16(v0[2], v0[3]); o.z = pg8::cvt_pk_bf16(v1[0], v1[1]); o.w = pg8::cvt_pk_bf16(v1[2], v1[3]);
                    *(v4u*)(rp + bj * 128) = o; } }
    }
};
struct EpiOut {
    static constexpr bool PERM = true; static constexpr bool PROBE2 = false;
    bf16* y;
    __device__ __forceinline__ void operator()(const f32x4 (&acc)[2][2][4][2], const DenseU& u, int wr, int wc, int fr, int fq) const {
        const int row0 = u.pm * 256 + wr * 64 + fr, col0 = u.pn * 256 + wc * 32 + 8 * fq;
#pragma unroll
        for (int ai = 0; ai < 2; ++ai)
#pragma unroll
            for (int m = 0; m < 4; ++m) { bf16* rp = y + (size_t)(row0 + ai * 128 + m * 16) * 2048 + col0;
#pragma unroll
                for (int bj = 0; bj < 2; ++bj) { const f32x4 v0 = acc[ai][bj][m][0], v1 = acc[ai][bj][m][1];
                    v4u o; o.x = pg8::cvt_pk_bf16(v0[0], v0[1]); o.y = pg8::cvt_pk_bf16(v0[2], v0[3]); o.z = pg8::cvt_pk_bf16(v1[0], v1[1]); o.w = pg8::cvt_pk_bf16(v1[2], v1[3]);
                    *(v4u*)(rp + bj * 128) = o; } }
    }
};
constexpr float SC_W = 256.f, SC_H = 16.f, SC_A = 16.f;
__device__ __forceinline__ unsigned pk4_fp8(float a, float b, float c, float d) {
    a = fminf(fmaxf(a, -448.f), 448.f); b = fminf(fmaxf(b, -448.f), 448.f); c = fminf(fmaxf(c, -448.f), 448.f); d = fminf(fmaxf(d, -448.f), 448.f);
    unsigned w = 0; w = __builtin_amdgcn_cvt_pk_fp8_f32(a, b, w, false); w = __builtin_amdgcn_cvt_pk_fp8_f32(c, d, w, true); return w;
}
struct EpiGU {
    static constexpr bool PERM = true; static constexpr bool PROBE2 = false;
    unsigned char* act; const float* slot_w;
    __device__ __forceinline__ void operator()(const f32x4 (&acc)[2][2][4][2], const MoeU& u, int wr, int wc, int fr, int fq) const {
        const int c0 = u.pn * 128 + wc * 32 + 8 * fq; constexpr float inv = 1.f / (SC_W * SC_H);
#pragma unroll
        for (int ai = 0; ai < 2; ++ai)
#pragma unroll
            for (int m = 0; m < 4; ++m) { const int r = ai * 128 + wr * 64 + m * 16 + fr;
                if (r < u.nrows) { const float w = slot_w[u.row0 + r] * SC_A; float o[8];
#pragma unroll
                    for (int n = 0; n < 2; ++n)
#pragma unroll
                        for (int j = 0; j < 4; ++j) { const float g = acc[ai][0][m][n][j] * inv, up = acc[ai][1][m][n][j] * inv; o[n * 4 + j] = silu_f(g) * up * w; }
                    v2u q; q.x = pk4_fp8(o[0], o[1], o[2], o[3]); q.y = pk4_fp8(o[4], o[5], o[6], o[7]);
                    *(v2u*)(act + (size_t)(u.row0 + r) * 512 + c0) = q; } }
    }
};
struct EpiDown {
    static constexpr bool PERM = true; static constexpr bool PROBE2 = true;
    bf16* so;
    __device__ __forceinline__ void operator()(const f32x4 (&acc)[2][2][4][2], const MoeU& u, int wr, int wc, int fr, int fq) const {
        const int c0 = u.pn * 256 + wc * 32 + 8 * fq; constexpr float inv = 1.f / (SC_W * SC_A);
#pragma unroll
        for (int ai = 0; ai < 2; ++ai)
#pragma unroll
            for (int m = 0; m < 4; ++m) { const int r = ai * 128 + wr * 64 + m * 16 + fr;
                if (r < u.nrows) { bf16* rp = so + (size_t)(u.row0 + r) * 2048 + c0;
#pragma unroll
                    for (int bj = 0; bj < 2; ++bj) { const f32x4 v0 = acc[ai][bj][m][0] * inv, v1 = acc[ai][bj][m][1] * inv;
                        v4u o; o.x = pg8::cvt_pk_bf16(v0[0], v0[1]); o.y = pg8::cvt_pk_bf16(v0[2], v0[3]); o.z = pg8::cvt_pk_bf16(v1[0], v1[1]); o.w = pg8::cvt_pk_bf16(v1[2], v1[3]);
                        __builtin_nontemporal_store(o, (v4u*)(rp + bj * 128)); } } }
    }
};

__device__ __forceinline__ void tr_item(const float* W, int ldn, bf16* WT, int Kd, int drow0, int k0, int n0, LAS float* scr, int lane) {
    f32x4 t[8];
#pragma unroll
    for (int i = 0; i < 8; ++i) t[i] = *(const f32x4*)(W + (size_t)(k0 + 8 * i + (lane >> 3)) * ldn + n0 + 4 * (lane & 7));
#pragma unroll
    for (int i = 0; i < 8; ++i) { LAS float* d = scr + (8 * i + (lane >> 3)) * 33 + 4 * (lane & 7); d[0] = t[i][0]; d[1] = t[i][1]; d[2] = t[i][2]; d[3] = t[i][3]; }
    LDS_WAIT(); asm volatile("" ::: "memory");
    const int c = lane & 7;
#pragma unroll
    for (int j = 0; j < 4; ++j) { const int n = (lane >> 3) + 8 * j; const LAS float* s = scr + (8 * c) * 33 + n;
        v4u o; o.x = pk2(s[0 * 33], s[1 * 33]); o.y = pk2(s[2 * 33], s[3 * 33]); o.z = pk2(s[4 * 33], s[5 * 33]); o.w = pk2(s[6 * 33], s[7 * 33]);
        *(v4u*)(WT + (size_t)(drow0 + n) * Kd + k0 + 8 * c) = o; }
    LDS_WAIT(); asm volatile("" ::: "memory");
}

__device__ __forceinline__ void tr_item8(const float* W, int ldn, unsigned char* WT, int Kd, int drow0, int k0, int n0, LAS float* scr, int lane) {
    f32x4 t[8];
#pragma unroll
    for (int i = 0; i < 8; ++i) t[i] = *(const f32x4*)(W + (size_t)(k0 + 8 * i + (lane >> 3)) * ldn + n0 + 4 * (lane & 7));
#pragma unroll
    for (int i = 0; i < 8; ++i) { LAS float* d = scr + (8 * i + (lane >> 3)) * 33 + 4 * (lane & 7); d[0] = t[i][0]; d[1] = t[i][1]; d[2] = t[i][2]; d[3] = t[i][3]; }
    LDS_WAIT(); asm volatile("" ::: "memory");
    const int c = lane & 7;
#pragma unroll
    for (int j = 0; j < 4; ++j) { const int n = (lane >> 3) + 8 * j; const LAS float* s = scr + (8 * c) * 33 + n;
        v2u o; o.x = pk4_fp8(s[0 * 33] * SC_W, s[1 * 33] * SC_W, s[2 * 33] * SC_W, s[3 * 33] * SC_W); o.y = pk4_fp8(s[4 * 33] * SC_W, s[5 * 33] * SC_W, s[6 * 33] * SC_W, s[7 * 33] * SC_W);
        *(v2u*)(WT + (size_t)(drow0 + n) * Kd + k0 + 8 * c) = o; }
    LDS_WAIT(); asm volatile("" ::: "memory");
}

__device__ __forceinline__ void phase0(const Args& a, LAS unsigned char* lds, int tid, int lane, int wave, int vcu, int G) {
    unsigned char* ws = a.ws;
    if (vcu < 192) {
        LAS float* sc = (LAS float*)lds;
        LAS float* red = (LAS float*)(lds + 73728);
        for (int i = tid; i < 9 * 2048; i += 512) { const int r = i >> 11, k = i & 2047; const float v = r < 8 ? a.in[1][r * 2048 + k] : a.in[3][k]; sc[i] = silu_f(v); }
        __syncthreads();
        const float* wm = a.in[4]; const float* bm = a.in[5]; float* mod = (float*)(ws + WS_MOD);
        for (int chunk = vcu; chunk < 192; chunk += G) {
            const int n0 = chunk * 64, ks = lane >> 4, n4 = (lane & 15) * 4;
            f32x4 acc[9];
#pragma unroll
            for (int r = 0; r < 9; ++r) acc[r] = (f32x4){0.f, 0.f, 0.f, 0.f};
#pragma unroll 4
            for (int kk = 0; kk < 256; kk += 4) { const int k = wave * 256 + kk + ks; const f32x4 wv = *(const f32x4*)(wm + (size_t)k * 12288 + n0 + n4);
#pragma unroll
                for (int r = 0; r < 9; ++r) { const float s = sc[r * 2048 + k]; acc[r] += wv * s; } }
#pragma unroll
            for (int r = 0; r < 9; ++r)
#pragma unroll
                for (int j = 0; j < 4; ++j) { float v = acc[r][j]; v += __shfl_xor(v, 16); v += __shfl_xor(v, 32); acc[r][j] = v; }
            if (lane < 16) {
#pragma unroll
                for (int r = 0; r < 9; ++r) *(LAS f32x4*)(red + (wave * 9 + r) * 64 + n4) = acc[r]; }
            __syncthreads();
            for (int i = tid; i < 9 * 64; i += 512) { const int r = i >> 6, n = i & 63; float s = 0.f;
#pragma unroll
                for (int w = 0; w < 8; ++w) s += red[(w * 9 + r) * 64 + n];
                mod[r * 12288 + n0 + n] = s + bm[n0 + n]; }
            __syncthreads();
        }
    }
    __syncthreads();
    LAS float* scr = (LAS float*)(lds + wave * 16384);
    const int gw = vcu * 8 + wave, NGW = G * 8;
    bf16* Win_t = (bf16*)(ws + WS_WIN); bf16* Wout_t = (bf16*)(ws + WS_WOUT); bf16* Wpool_t = (bf16*)(ws + WS_WPOOL); unsigned char* Wd_t = ws + WS_WD; unsigned char* Wgu_t = ws + WS_WGU;
    constexpr int I_IN = 32 * 129, I_OUT = 32 * 64, I_POOL = 4 * 4 * 8, I_E = 65 * 512;
    constexpr int NITEMS = I_IN + I_OUT + I_POOL + 3 * I_E;
    for (int it = gw; it < NITEMS; it += NGW) {
        int r = it;
        if (r < I_IN) { const int kb = r / 129, nb = r % 129, n0 = 32 * nb; const int drow = n0 < 3072 ? n0 : (n0 == 3072 ? 4096 : n0 - 32);
            tr_item(a.in[10], DIN, Win_t, 2048, drow, 64 * kb, n0, scr, lane); continue; } r -= I_IN;
        if (r < I_OUT) { const int kb = r / 64, nb = r % 64; tr_item(a.in[18], 2048, Wout_t, 2048, 32 * nb, 64 * kb, 32 * nb, scr, lane); continue; } r -= I_OUT;
        if (r < I_POOL) { const int g = r / 32, rr = r % 32, kb = rr / 8, nb = rr % 8; tr_item(a.in[16] + g * 65536, 256, Wpool_t + g * 65536, 256, 32 * nb, 64 * kb, 32 * nb, scr, lane); continue; } r -= I_POOL;
        if (r < I_E) { const int e = r / 512, rr = r % 512, kb = rr / 16, nb = rr % 16, n0 = 32 * nb; const float* src = e < 64 ? a.in[21] + (size_t)e * 2048 * 512 : a.in[24];
            tr_item8(src, 512, Wgu_t + (size_t)e * 1024 * 2048, 2048, (n0 / 128) * 256 + (n0 % 128), 64 * kb, n0, scr, lane); continue; } r -= I_E;
        if (r < I_E) { const int e = r / 512, rr = r % 512, kb = rr / 16, nb = rr % 16, n0 = 32 * nb; const float* src = e < 64 ? a.in[22] + (size_t)e * 2048 * 512 : a.in[25];
            tr_item8(src, 512, Wgu_t + (size_t)e * 1024 * 2048, 2048, (n0 / 128) * 256 + 128 + (n0 % 128), 64 * kb, n0, scr, lane); continue; } r -= I_E;
        { const int e = r / 512, rr = r % 512, kb = rr / 64, nb = rr % 64; const float* src = e < 64 ? a.in[23] + (size_t)e * 512 * 2048 : a.in[26];
            tr_item8(src, 2048, Wd_t + (size_t)e * 2048 * 512, 512, 32 * nb, 64 * kb, 32 * nb, scr, lane); }
    }
    { const float* wr = a.in[19]; bf16* whi = (bf16*)(ws + WS_WRT); bf16* wlo = whi + 64 * 2048;
      for (int idx = vcu * 512 + tid; idx < 64 * 256; idx += G * 512) { const int e = idx >> 8, k8 = idx & 255; unsigned hi[8], lo[8];
#pragma unroll
          for (int j = 0; j < 8; ++j) { const float v = wr[(size_t)(8 * k8 + j) * 64 + e]; hi[j] = f2bf(v); lo[j] = f2bf(v - __builtin_bit_cast(float, hi[j] << 16)); }
          v4u oh, ol; oh.x = hi[0] | (hi[1] << 16); oh.y = hi[2] | (hi[3] << 16); oh.z = hi[4] | (hi[5] << 16); oh.w = hi[6] | (hi[7] << 16);
          ol.x = lo[0] | (lo[1] << 16); ol.y = lo[2] | (lo[3] << 16); ol.z = lo[4] | (lo[5] << 16); ol.w = lo[6] | (lo[7] << 16);
          *(v4u*)(whi + (size_t)e * 2048 + 8 * k8) = oh; *(v4u*)(wlo + (size_t)e * 2048 + 8 * k8) = ol; } }
    { v4u* z = (v4u*)(Win_t + (size_t)DIN * 2048); const int nz = (DINP - DIN) * 2048 / 8;
      for (int i = vcu * 512 + tid; i < nz; i += G * 512) z[i] = (v4u){0u, 0u, 0u, 0u}; }
}

__device__ __forceinline__ void phase1(const Args& a, int lane, int wave, int vcu, int G) {
    const float* mod = (const float*)(a.ws + WS_MOD); bf16* H = (bf16*)(a.ws + RA_H); const float* g = a.in[6];
    for (int m = vcu * 8 + wave; m < MROWS; m += G * 8) {
        const float* xr = m < NT ? a.in[0] + (size_t)m * 2048 : a.in[2] + (size_t)(m - NT) * 2048;
        const float* mr = mod + (size_t)(m < NT ? (m >> 11) : 8) * 12288;
        f32x4 v[8]; float ss = 0.f;
#pragma unroll
        for (int j = 0; j < 8; ++j) { v[j] = *(const f32x4*)(xr + 4 * (lane + 64 * j)); ss += v[j][0] * v[j][0] + v[j][1] * v[j][1] + v[j][2] * v[j][2] + v[j][3] * v[j][3]; }
        const float rstd = rsqrtf(wave_sum(ss) * (1.f / 2048.f) + EPS);
#pragma unroll
        for (int j = 0; j < 8; ++j) { const int c = 4 * (lane + 64 * j); const f32x4 gg = *(const f32x4*)(g + c), sh = *(const f32x4*)(mr + c), sc = *(const f32x4*)(mr + 2048 + c);
            const f32x4 o = v[j] * rstd * gg * (sc + 1.f) + sh;
            v2u q; q.x = pk2(o[0], o[1]); q.y = pk2(o[2], o[3]); *(v2u*)(H + (size_t)m * 2048 + c) = q; }
    }
}

__device__ __forceinline__ int scan_row(int b, int dir, int s) {
    if (s < 256) { const int tc = dir ? 255 - s : s; return NT + b * 256 + tc; }
    const int t0 = s - 256; return b * 2048 + (dir ? 2047 - t0 : t0);
}
__device__ __forceinline__ void phase3_prep(const Args& a, LAS unsigned char* lds, int tid, int vcu, int G) {
    unsigned char* ws = a.ws;
    const bf16* Q = (const bf16*)(ws + RA_Q); const bf16* Kb = (const bf16*)(ws + RA_K); const float* ALR = (const float*)(ws + RA_ALR);
    bf16* QG = (bf16*)(ws + PQG); bf16* QM = (bf16*)(ws + PQM); bf16* KM = (bf16*)(ws + PKM); bf16* KD = (bf16*)(ws + PKD); float* DEC = (float*)(ws + PDEC);
    LAS float* alr = (LAS float*)lds;
    LAS bf16* Kt = (LAS bf16*)(lds + 4096);
    LAS bf16* Qt = (LAS bf16*)(lds + 4096 + 65536);
    const int col = tid, h = col >> 7, dk = col & 127;
    for (int item = vcu; item < 2 * 8 * 36; item += G) {
        const int ch = item % 36, b = (item / 36) & 7, dir = item / 288;
        const bool lat = ch >= 4;
        if (tid < 256) { const int i = tid >> 2, r4 = (tid & 3) * 4; const int row = scan_row(b, dir, ch * 64 + i);
            *(LAS f32x4*)(alr + i * 16 + r4) = *(const f32x4*)(ALR + (size_t)row * 32 + dir * 16 + r4); }
        { v4u kr[8], qr[8];
#pragma unroll
          for (int q = 0; q < 8; ++q) { const int p = tid + 512 * q, i = p >> 6, c8 = (p & 63) * 8; const int row = scan_row(b, dir, ch * 64 + i);
              kr[q] = *(const v4u*)(Kb + (size_t)row * 512 + c8); if (lat) qr[q] = *(const v4u*)(Q + (size_t)row * 512 + c8); }
#pragma unroll
          for (int q = 0; q < 8; ++q) { const int p = tid + 512 * q; *(LAS v4u*)(Kt + p * 8) = kr[q]; if (lat) *(LAS v4u*)(Qt + p * 8) = qr[q]; } }
        const float* wa2 = dir ? a.in[13] : a.in[11]; const float bia = (dir ? a.in[14] : a.in[12])[col];
        float w[16];
#pragma unroll
        for (int r = 0; r < 16; ++r) w[r] = wa2[r * 512 + col];
        __syncthreads();
        float Gc = 0.f, Gmid = 0.f;
#pragma unroll 4
        for (int i = 0; i < 64; ++i) { float z = bia;
#pragma unroll
            for (int r4 = 0; r4 < 4; ++r4) { const f32x4 x = *(const LAS f32x4*)(alr + i * 16 + 4 * r4); z += x[0] * w[4 * r4] + x[1] * w[4 * r4 + 1] + x[2] * w[4 * r4 + 2] + x[3] * w[4 * r4 + 3]; }
            Gc += (fminf(z, 0.f) - __logf(1.f + __expf(-fabsf(z)))) * (1.f / 16.f);
            if (i == 32) Gmid = Gc; }
        const float Gend = Gc;
        DEC[((size_t)(dir * 8 + b) * 36 + ch) * 512 + col] = __expf(Gend);
        bf16* kdrow = KD + ((((size_t)(dir * 8 + b) * 36 + ch) * 4 + h) * 128 + dk) * 64;
        const size_t lt = lat ? ((((size_t)(dir * 8 + b) * 32 + (ch - 4)) * 4 + h) * 64) * 128 + dk : 0;
        Gc = 0.f;
#pragma unroll 1
        for (int i0 = 0; i0 < 64; i0 += 8) { unsigned kd[8];
#pragma unroll
            for (int ii = 0; ii < 8; ++ii) { const int i = i0 + ii; float z = bia;
#pragma unroll
                for (int r4 = 0; r4 < 4; ++r4) { const f32x4 x = *(const LAS f32x4*)(alr + i * 16 + 4 * r4); z += x[0] * w[4 * r4] + x[1] * w[4 * r4 + 1] + x[2] * w[4 * r4 + 2] + x[3] * w[4 * r4 + 3]; }
                Gc += (fminf(z, 0.f) - __logf(1.f + __expf(-fabsf(z)))) * (1.f / 16.f);
                const float kv = bf1(Kt[i * 512 + col]);
                kd[ii] = f2bf(kv * __expf(Gend - Gc));
                if (lat) { const float qv = bf1(Qt[i * 512 + col]) * 0.08838834764831845f;
                    QG[lt + (size_t)i * 128] = (bf16)f2bf(qv * __expf(Gc)); QM[lt + (size_t)i * 128] = (bf16)f2bf(qv * __expf(Gc - Gmid)); KM[lt + (size_t)i * 128] = (bf16)f2bf(kv * __expf(Gmid - Gc)); } }
            v4u o; o.x = kd[0] | (kd[1] << 16); o.y = kd[2] | (kd[3] << 16); o.z = kd[4] | (kd[5] << 16); o.w = kd[6] | (kd[7] << 16);
            *(v4u*)(kdrow + i0) = o; }
        __syncthreads();
    }
}

constexpr int GL_QG = 0, GL_QM = 17408, GL_KM = 34816, GL_ST = 52224, GL_KDT = 69632, GL_VT = 88064, GL_AM = 97280, GL_DEC = 106496;
__device__ __forceinline__ void phase_chain(const Args& a, LAS unsigned char* lds, int tid, int lane, int wave, int vcu, int G) {
    unsigned char* ws = a.ws;
    const v4u* QG = (const v4u*)(ws + PQG); const v4u* QM = (const v4u*)(ws + PQM); const v4u* KM = (const v4u*)(ws + PKM); const v4u* KD = (const v4u*)(ws + PKD); const float* DEC = (const float*)(ws + PDEC);
    const bf16* V = (const bf16*)(ws + RA_V); float* OF = (float*)(ws + RA_OF);
    const int l15 = lane & 15, l4 = lane >> 4;
    for (int item = vcu; item < 256; item += G) {
        const int vs = item & 3, dir = (item >> 2) & 1, h = (item >> 3) & 3, b = item >> 5;
        f32x4 S[4];
#pragma unroll
        for (int tv = 0; tv < 4; ++tv) S[tv] = (f32x4){0.f, 0.f, 0.f, 0.f};
        v4u rq[6], rk[2], rv; float rdec = 0.f;
#define GL_LOAD(ch_) do { const int ch__ = (ch_); \
            if (ch__ >= 4) { const size_t t_ = ((((size_t)(dir * 8 + b) * 32 + (ch__ - 4)) * 4 + h) * 1024); \
                rq[0] = QG[t_ + tid]; rq[1] = QG[t_ + tid + 512]; rq[2] = QM[t_ + tid]; rq[3] = QM[t_ + tid + 512]; rq[4] = KM[t_ + tid]; rq[5] = KM[t_ + tid + 512]; } \
            { const size_t t_ = ((((size_t)(dir * 8 + b) * 36 + ch__) * 4 + h) * 1024); rk[0] = KD[t_ + tid]; rk[1] = KD[t_ + tid + 512]; } \
            { const int row_ = scan_row(b, dir, ch__ * 64 + (tid >> 3)); rv = *(const v4u*)(V + (size_t)row_ * 1024 + h * 256 + vs * 64 + 8 * (tid & 7)); } \
            if (tid < 128) rdec = DEC[((size_t)(dir * 8 + b) * 36 + ch__) * 512 + h * 128 + tid]; } while (0)
        GL_LOAD(0);
        for (int ch = 0; ch < 36; ++ch) {
            const bool lat = ch >= 4;
#pragma unroll
            for (int tv = 0; tv < 4; ++tv) { v2u p; p.x = pk2(S[tv][0], S[tv][1]); p.y = pk2(S[tv][2], S[tv][3]);
                *(LAS v2u*)(lds + GL_ST + (16 * tv + l15) * 272 + (16 * wave + 4 * l4) * 2) = p; }
            if (lat) {
#pragma unroll
                for (int q = 0; q < 2; ++q) { const int p = tid + 512 * q; const int off = (p >> 4) * 272 + (p & 15) * 16;
                    *(LAS v4u*)(lds + GL_QG + off) = rq[q]; *(LAS v4u*)(lds + GL_QM + off) = rq[2 + q]; *(LAS v4u*)(lds + GL_KM + off) = rq[4 + q]; } }
#pragma unroll
            for (int q = 0; q < 2; ++q) { const int p = tid + 512 * q; *(LAS v4u*)(lds + GL_KDT + (p >> 3) * 144 + (p & 7) * 16) = rk[q]; }
            { const int i = tid >> 3, c = tid & 7; LAS bf16* vt = (LAS bf16*)(lds + GL_VT) + i;
              vt[(8 * c + 0) * 72] = (bf16)(rv.x & 0xffffu); vt[(8 * c + 1) * 72] = (bf16)(rv.x >> 16); vt[(8 * c + 2) * 72] = (bf16)(rv.y & 0xffffu); vt[(8 * c + 3) * 72] = (bf16)(rv.y >> 16);
              vt[(8 * c + 4) * 72] = (bf16)(rv.z & 0xffffu); vt[(8 * c + 5) * 72] = (bf16)(rv.z >> 16); vt[(8 * c + 6) * 72] = (bf16)(rv.w & 0xffffu); vt[(8 * c + 7) * 72] = (bf16)(rv.w >> 16); }
            if (tid < 128) *(LAS float*)(lds + GL_DEC + tid * 4) = rdec;
            __syncthreads();
            if (ch + 1 < 36) GL_LOAD(ch + 1);
            if (lat) {
                { const int ti = wave >> 1; f32x4 c0 = (f32x4){0.f, 0.f, 0.f, 0.f}, c1 = c0; const int tj0 = (wave & 1) * 2;
#pragma unroll
                  for (int ks = 0; ks < 4; ++ks) { const int ko = (32 * ks + 8 * l4) * 2;
                      const bf16x8 bq = *(const LAS bf16x8*)(lds + GL_QM + (16 * ti + l15) * 272 + ko);
                      const bf16x8 a0 = *(const LAS bf16x8*)(lds + GL_KM + (16 * tj0 + l15) * 272 + ko), a1 = *(const LAS bf16x8*)(lds + GL_KM + (16 * tj0 + 16 + l15) * 272 + ko);
                      c0 = __builtin_amdgcn_mfma_f32_16x16x32_bf16(a0, bq, c0, 0, 0, 0); c1 = __builtin_amdgcn_mfma_f32_16x16x32_bf16(a1, bq, c1, 0, 0, 0); }
                  const int i = 16 * ti + l15;
                  { const int j0 = 16 * tj0 + 4 * l4; v2u p; p.x = pk2(j0 <= i ? c0[0] : 0.f, j0 + 1 <= i ? c0[1] : 0.f); p.y = pk2(j0 + 2 <= i ? c0[2] : 0.f, j0 + 3 <= i ? c0[3] : 0.f);
                    *(LAS v2u*)(lds + GL_AM + i * 144 + j0 * 2) = p; }
                  { const int j0 = 16 * tj0 + 16 + 4 * l4; v2u p; p.x = pk2(j0 <= i ? c1[0] : 0.f, j0 + 1 <= i ? c1[1] : 0.f); p.y = pk2(j0 + 2 <= i ? c1[2] : 0.f, j0 + 3 <= i ? c1[3] : 0.f);
                    *(LAS v2u*)(lds + GL_AM + i * 144 + j0 * 2) = p; } }
                __syncthreads();
                { const int ti = wave >> 1, tv0 = (wave & 1) * 2; f32x4 c0 = (f32x4){0.f, 0.f, 0.f, 0.f}, c1 = c0;
#pragma unroll
                  for (int ks = 0; ks < 4; ++ks) { const int ko = (32 * ks + 8 * l4) * 2;
                      const bf16x8 bq = *(const LAS bf16x8*)(lds + GL_QG + (16 * ti + l15) * 272 + ko);
                      const bf16x8 a0 = *(const LAS bf16x8*)(lds + GL_ST + (16 * tv0 + l15) * 272 + ko), a1 = *(const LAS bf16x8*)(lds + GL_ST + (16 * tv0 + 16 + l15) * 272 + ko);
                      c0 = __builtin_amdgcn_mfma_f32_16x16x32_bf16(a0, bq, c0, 0, 0, 0); c1 = __builtin_amdgcn_mfma_f32_16x16x32_bf16(a1, bq, c1, 0, 0, 0); }
#pragma unroll
                  for (int ks = 0; ks < 2; ++ks) { const int ko = (32 * ks + 8 * l4) * 2;
                      const bf16x8 bq = *(const LAS bf16x8*)(lds + GL_AM + (16 * ti + l15) * 144 + ko);
                      const bf16x8 a0 = *(const LAS bf16x8*)(lds + GL_VT + (16 * tv0 + l15) * 144 + ko), a1 = *(const LAS bf16x8*)(lds + GL_VT + (16 * tv0 + 16 + l15) * 144 + ko);
                      c0 = __builtin_amdgcn_mfma_f32_16x16x32_bf16(a0, bq, c0, 0, 0, 0); c1 = __builtin_amdgcn_mfma_f32_16x16x32_bf16(a1, bq, c1, 0, 0, 0); }
                  const int s = ch * 64 + 16 * ti + l15; const int t0 = s - 256; const int t = dir ? 2047 - t0 : t0;
                  float* orow = OF + ((size_t)dir * NT + b * 2048 + t) * 1024 + h * 256 + vs * 64 + 16 * tv0 + 4 * l4;
                  *(f32x4*)(orow) = c0; *(f32x4*)(orow + 16) = c1; }
            }
            { const f32x4 d4 = *(const LAS f32x4*)(lds + GL_DEC + (16 * wave + 4 * l4) * 4);
#pragma unroll
              for (int tv = 0; tv < 4; ++tv) S[tv] = S[tv] * d4;
#pragma unroll
              for (int ks = 0; ks < 2; ++ks) { const int ko = (32 * ks + 8 * l4) * 2;
                  const bf16x8 ak = *(const LAS bf16x8*)(lds + GL_KDT + (16 * wave + l15) * 144 + ko);
#pragma unroll
                  for (int tv = 0; tv < 4; ++tv) { const bf16x8 bv = *(const LAS bf16x8*)(lds + GL_VT + (16 * tv + l15) * 144 + ko);
                      S[tv] = __builtin_amdgcn_mfma_f32_16x16x32_bf16(ak, bv, S[tv], 0, 0, 0); } } }
            __syncthreads();
        }
#undef GL_LOAD
    }
}

template <int HALFW>
__device__ __forceinline__ void pool_item(const bf16* P, bf16* DP, LAS float* tmp, int tid, int b, int r, int g) {
    const int rlo = r - HALFW < 0 ? 0 : r - HALFW, rhi = r + HALFW > 32 ? 32 : r + HALFW;
    const float rinv = 1.f / (float)(rhi - rlo);
#pragma unroll 1
    for (int q = 0; q < 4; ++q) { const int p = tid + 512 * q, c = p >> 5, ch0 = (p & 31) * 8; float acc[8]; v4u x[2 * HALFW];
#pragma unroll
        for (int u = 0; u < 2 * HALFW; ++u) { const int rr = (rlo + u < rhi) ? rlo + u : rlo; x[u] = *(const v4u*)(P + ((size_t)(b * 2048 + rr * 64 + c)) * 1024 + g * 256 + ch0); }
#pragma unroll
        for (int j = 0; j < 8; ++j) acc[j] = 0.f;
#pragma unroll
        for (int u = 0; u < 2 * HALFW; ++u) { const float m = (rlo + u < rhi) ? 1.f : 0.f;
            acc[0] += m * bflo(x[u].x); acc[1] += m * bfhi(x[u].x); acc[2] += m * bflo(x[u].y); acc[3] += m * bfhi(x[u].y); acc[4] += m * bflo(x[u].z); acc[5] += m * bfhi(x[u].z); acc[6] += m * bflo(x[u].w); acc[7] += m * bfhi(x[u].w); }
        *(LAS f32x4*)(tmp + c * 256 + ch0) = (f32x4){acc[0] * rinv, acc[1] * rinv, acc[2] * rinv, acc[3] * rinv};
        *(LAS f32x4*)(tmp + c * 256 + ch0 + 4) = (f32x4){acc[4] * rinv, acc[5] * rinv, acc[6] * rinv, acc[7] * rinv}; }
    __syncthreads();
#pragma unroll 1
    for (int q = 0; q < 4; ++q) { const int p = tid + 512 * q, c = p >> 5, ch0 = (p & 31) * 8;
        const int clo = c - HALFW < 0 ? 0 : c - HALFW, chi = c + HALFW > 64 ? 64 : c + HALFW; const float cinv = 1.f / (float)(chi - clo);
        const size_t o = ((size_t)(b * 2048 + r * 64 + c)) * 1024 + g * 256 + ch0;
        const v4u x = *(const v4u*)(P + o);
        f32x4 a0 = (f32x4){0.f, 0.f, 0.f, 0.f}, a1 = a0;
#pragma unroll
        for (int u = 0; u < 2 * HALFW; ++u) { const int cc = (clo + u < chi) ? clo + u : clo; const float m = (clo + u < chi) ? 1.f : 0.f;
            a0 += *(const LAS f32x4*)(tmp + cc * 256 + ch0) * m; a1 += *(const LAS f32x4*)(tmp + cc * 256 + ch0 + 4) * m; }
        v4u d; d.x = pk2(a0[0] * cinv - bflo(x.x), a0[1] * cinv - bfhi(x.x)); d.y = pk2(a0[2] * cinv - bflo(x.y), a0[3] * cinv - bfhi(x.y));
        d.z = pk2(a1[0] * cinv - bflo(x.z), a1[1] * cinv - bfhi(x.z)); d.w = pk2(a1[2] * cinv - bflo(x.w), a1[3] * cinv - bfhi(x.w));
        *(v4u*)(DP + o) = d; }
    __syncthreads();
}
__device__ __forceinline__ void phase3_pool(const Args& a, LAS unsigned char* lds, int tid, int vcu, int G) {
    const bf16* P = (const bf16*)(a.ws + RA_P); bf16* DP = (bf16*)(a.ws + RA_DPOOL);
    LAS float* tmp = (LAS float*)lds;
    for (int item = vcu; item < 1024; item += G) {
        const int g = item >> 8, r = (item >> 3) & 31, b = item & 7;
        const int gg = 3 - g;
        if (gg == 0) pool_item<1>(P, DP, tmp, tid, b, r, gg); else if (gg == 1) pool_item<2>(P, DP, tmp, tid, b, r, gg); else if (gg == 2) pool_item<4>(P, DP, tmp, tid, b, r, gg); else pool_item<8>(P, DP, tmp, tid, b, r, gg);
    }
}

__device__ __forceinline__ void phase4_post(const Args& a, int lane, int wave, int vcu, int G) {
    const float* OF = (const float*)(a.ws + RA_OF); const float* OB = OF + (size_t)NT * 1024; const bf16* Rr = (const bf16*)(a.ws + RA_R); bf16* Y = (bf16*)(a.ws + RA_YMIX);
    const float* gn = a.in[15];
    for (int idx = vcu * 8 + wave; idx < NT * 4; idx += G * 8) {
        const int t = idx >> 2, h = idx & 3; const size_t o = (size_t)t * 1024 + h * 256 + 4 * lane;
        const f32x4 x = *(const f32x4*)(OF + o) + *(const f32x4*)(OB + o);
        const float ms = wave_sum(x[0] * x[0] + x[1] * x[1] + x[2] * x[2] + x[3] * x[3]) * (1.f / 256.f);
        const float sc = rsqrtf(ms + EPS);
        const f32x4 g4 = *(const f32x4*)(gn + h * 256 + 4 * lane);
        const v2u rr = *(const v2u*)(Rr + o);
        const float r0 = bflo(rr.x), r1 = bfhi(rr.x), r2 = bflo(rr.y), r3 = bfhi(rr.y);
        v2u q; q.x = pk2(x[0] * sc * g4[0] * silu_f(r0), x[1] * sc * g4[1] * silu_f(r1)); q.y = pk2(x[2] * sc * g4[2] * silu_f(r2), x[3] * sc * g4[3] * silu_f(r3));
        *(v2u*)(Y + (size_t)t * 2048 + h * 256 + 4 * lane) = q;
    }
}

__device__ __forceinline__ void phase6(const Args& a, LAS unsigned char* lds, int tid, int lane, int wave, int vcu, int G) {
    unsigned char* ws = a.ws;
    const float* mod = (const float*)(ws + WS_MOD); const bf16* Y1 = (const bf16*)(ws + RA_Y1); unsigned char* H2 = ws + RA_H2;
    const float* gpost = a.in[7]; const float* gpre2 = a.in[8]; const float* rbias = a.in[20];
    const bf16* whi = (const bf16*)(ws + WS_WRT); const bf16* wlo = whi + 64 * 2048;
    LAS float* part = (LAS float*)lds;
    LAS float* logit = (LAS float*)(lds + LDS_LOGIT);
    LAS u64* masks = (LAS u64*)(lds + LDS_MASKS);
    int* cnt = (int*)(ws + T_CNT); u64* tmask = (u64*)(ws + T_MASK); float* tokw = (float*)(ws + T_TOKW);
    const int l15 = lane & 15, l4 = lane >> 4;
    for (int blk = vcu; blk < NT / 64; blk += G) {
        for (int it = 0; it < 4; ++it) {
#pragma unroll 1
            for (int rr = 0; rr < 2; ++rr) {
                const int lr = wave * 2 + rr, t = blk * 64 + it * 16 + lr; const float* mr = mod + (size_t)(t >> 11) * 12288;
                const bf16* yr = Y1 + (size_t)t * 2048; const float* xr = a.in[0] + (size_t)t * 2048; float* outr = (float*)(ws + WS_X1) + (size_t)t * 2048;
                f32x4 y[8]; float ss = 0.f;
#pragma unroll
                for (int j = 0; j < 8; ++j) { const v2u yb = *(const v2u*)(yr + 4 * (lane + 64 * j)); y[j] = (f32x4){bflo(yb.x), bfhi(yb.x), bflo(yb.y), bfhi(yb.y)}; ss += y[j][0] * y[j][0] + y[j][1] * y[j][1] + y[j][2] * y[j][2] + y[j][3] * y[j][3]; }
                const float rstd1 = rsqrtf(wave_sum(ss) * (1.f / 2048.f) + EPS);
                float s2 = 0.f;
#pragma unroll
                for (int j = 0; j < 8; ++j) { const int c = 4 * (lane + 64 * j); const f32x4 x = *(const f32x4*)(xr + c), gp = *(const f32x4*)(gpost + c), gt = *(const f32x4*)(mr + 4096 + c);
                    const f32x4 x1 = x + gt * (y[j] * rstd1 * gp); y[j] = x1; *(f32x4*)(outr + c) = x1;
                    s2 += x1[0] * x1[0] + x1[1] * x1[1] + x1[2] * x1[2] + x1[3] * x1[3]; }
                const float rstd2 = rsqrtf(wave_sum(s2) * (1.f / 2048.f) + EPS);
#pragma unroll
                for (int j = 0; j < 8; ++j) { const int c = 4 * (lane + 64 * j); const f32x4 g2 = *(const f32x4*)(gpre2 + c), sh = *(const f32x4*)(mr + 6144 + c), sc = *(const f32x4*)(mr + 8192 + c);
                    const f32x4 hh = y[j] * rstd2 * g2 * (sc + 1.f) + sh;
                    unsigned hi[4], lo[4];
#pragma unroll
                    for (int q = 0; q < 4; ++q) { hi[q] = f2bf(hh[q]); lo[q] = f2bf(hh[q] - __builtin_bit_cast(float, hi[q] << 16)); }
                    v2u qh, ql; qh.x = hi[0] | (hi[1] << 16); qh.y = hi[2] | (hi[3] << 16); ql.x = lo[0] | (lo[1] << 16); ql.y = lo[2] | (lo[3] << 16);
                    *(LAS v2u*)(lds + RT_HI + lr * RT_ROWB + c * 2) = qh; *(LAS v2u*)(lds + RT_LO + lr * RT_ROWB + c * 2) = ql;
                    *(unsigned*)(H2 + (size_t)t * 2048 + c) = pk4_fp8(hh[0] * SC_H, hh[1] * SC_H, hh[2] * SC_H, hh[3] * SC_H); }
            }
            __syncthreads();
            { f32x4 acc[4];
#pragma unroll
              for (int et = 0; et < 4; ++et) acc[et] = (f32x4){0.f, 0.f, 0.f, 0.f};
#pragma unroll 1
              for (int ks = 0; ks < 8; ++ks) { const int k0 = 256 * wave + 32 * ks + 8 * l4;
                  const bf16x8 ah = *(const LAS bf16x8*)(lds + RT_HI + l15 * RT_ROWB + k0 * 2), al = *(const LAS bf16x8*)(lds + RT_LO + l15 * RT_ROWB + k0 * 2);
#pragma unroll
                  for (int et = 0; et < 4; ++et) { const bf16x8 bh = *(const bf16x8*)(whi + (size_t)(16 * et + l15) * 2048 + k0), bl = *(const bf16x8*)(wlo + (size_t)(16 * et + l15) * 2048 + k0);
                      acc[et] = __builtin_amdgcn_mfma_f32_16x16x32_bf16(ah, bh, acc[et], 0, 0, 0);
                      acc[et] = __builtin_amdgcn_mfma_f32_16x16x32_bf16(ah, bl, acc[et], 0, 0, 0);
                      acc[et] = __builtin_amdgcn_mfma_f32_16x16x32_bf16(al, bh, acc[et], 0, 0, 0); } }
              __syncthreads();
#pragma unroll
              for (int et = 0; et < 4; ++et)
#pragma unroll
                  for (int q = 0; q < 4; ++q) part[(wave * 16 + 4 * l4 + q) * 64 + 16 * et + l15] = acc[et][q]; }
            __syncthreads();
#pragma unroll
            for (int q = 0; q < 2; ++q) { const int idx = tid + 512 * q; float sacc = 0.f;
#pragma unroll
                for (int w = 0; w < 8; ++w) sacc += part[w * 1024 + idx];
                logit[idx] = sacc; }
            __syncthreads();
#pragma unroll 1
            for (int rr = 0; rr < 2; ++rr) {
                const int lr = wave * 2 + rr, t = blk * 64 + it * 16 + lr;
                const float lg = logit[lr * 64 + lane]; const float s = 1.f / (1.f + __expf(-lg)); const float sel = s + rbias[lane];
                float m1 = sel; m1 = fmaxf(m1, __shfl_xor(m1, 1)); m1 = fmaxf(m1, __shfl_xor(m1, 2)); m1 = fmaxf(m1, __shfl_xor(m1, 4));
                const u64 eq = __ballot(sel == m1); const unsigned gb = (unsigned)(eq >> (lane & ~7)) & 0xffu; const int first = __builtin_ctz(gb);
                float v2 = ((lane & 7) == first) ? -INFINITY : sel; v2 = fmaxf(v2, __shfl_xor(v2, 1)); v2 = fmaxf(v2, __shfl_xor(v2, 2)); v2 = fmaxf(v2, __shfl_xor(v2, 4));
                const float gs = m1 + v2; const int g = lane >> 3; int grank = 0;
#pragma unroll
                for (int g2 = 0; g2 < 8; ++g2) { const float o = __shfl(gs, g2 * 8); grank += (o > gs || (o == gs && g2 < g)) ? 1 : 0; }
                const bool gsel = grank < 4; const float mk = gsel ? sel : -INFINITY; int rank = 0;
                for (int e2 = 0; e2 < 64; ++e2) { const float o = __shfl(mk, e2); rank += (o > mk || (o == mk && e2 < lane)) ? 1 : 0; }
                const bool chosen = gsel && rank < 8;
                const u64 mask = __ballot(chosen); const float ssum = wave_sum(chosen ? s : 0.f);
                const int kidx = __popcll(mask & ((1ull << lane) - 1ull));
                if (chosen) tokw[(size_t)t * 8 + kidx] = s / ssum * 2.5f;
                if (lane == 0) { tmask[t] = mask; masks[it * 16 + lr] = mask; }
            }
            __syncthreads();
        }
        if (wave == 0) { const u64 m = masks[lane]; int mine = 0;
            for (int e = 0; e < 64; ++e) { const int c = __popcll(__ballot((m >> e) & 1ull)); mine = (lane == e) ? c : mine; }
            cnt[blk * 64 + lane] = mine; }
        __syncthreads();
    }
}

__device__ __forceinline__ void phase7(const Args& a, LAS unsigned char* lds, int tid, int lane, int wave, int vcu, int G) {
    unsigned char* ws = a.ws;
    const int* cnt = (const int*)(ws + T_CNT); const u64* tmask = (const u64*)(ws + T_MASK); const float* tokw = (const float*)(ws + T_TOKW);
    int* tokslot = (int*)(ws + T_TOKSLOT); int* slottok = (int*)(ws + T_SLOTTOK); float* slotw = (float*)(ws + T_SLOTW); int* tile = (int*)(ws + T_TILE);
    LAS int* part = (LAS int*)lds;
    LAS int* tot = (LAS int*)(lds + 4096);
    for (int blk = vcu; blk < NT / 64; blk += G) {
        int pre = 0, all = 0;
        for (int b2 = wave; b2 < 256; b2 += 8) { const int c = cnt[b2 * 64 + lane]; all += c; pre += (b2 < blk) ? c : 0; }
        part[(wave * 2) * 64 + lane] = pre; part[(wave * 2 + 1) * 64 + lane] = all;
        __syncthreads();
        if (wave == 0) {
            int p = 0, t = 0;
#pragma unroll
            for (int w = 0; w < 8; ++w) { p += part[(w * 2) * 64 + lane]; t += part[(w * 2 + 1) * 64 + lane]; }
            int incl = t;
#pragma unroll
            for (int o = 1; o < 64; o <<= 1) { const int v = __shfl_up(incl, o); if (lane >= o) incl += v; }
            const int start = incl - t; const int base = start + p;
            tot[lane] = t; tot[64 + lane] = start;
            const int tokn = blk * 64 + lane; const u64 m = tmask[tokn];
            for (int e = 0; e < 64; ++e) { const bool bit = (m >> e) & 1ull; const u64 bal = __ballot(bit); const int be = __shfl(base, e);
                if (bit) { const int rank = __popcll(bal & ((1ull << lane) - 1ull)); const int slot = be + rank; const int k = __popcll(m & ((1ull << e) - 1ull));
                    slottok[slot] = tokn; slotw[slot] = tokw[(size_t)tokn * 8 + k]; tokslot[(size_t)tokn * 8 + k] = slot; } }
            slottok[SH_ROW0 + tokn] = tokn; slotw[SH_ROW0 + tokn] = 1.f;
        }
        __syncthreads();
        if (blk == 0 && tid == 0) {
            int n = 0;
            for (int e = 0; e < 64; ++e) { const int te = tot[e], st = tot[64 + e];
                for (int j = 0; j * 256 < te; ++j) { tile[n] = e; tile[NTILE_MAX + n] = st + j * 256; tile[2 * NTILE_MAX + n] = (te - j * 256) < 256 ? (te - j * 256) : 256; ++n; } }
            for (int j = 0; j < 64; ++j) { tile[n] = 64; tile[NTILE_MAX + n] = SH_ROW0 + j * 256; tile[2 * NTILE_MAX + n] = 256; ++n; }
            tile[3 * NTILE_MAX] = n;
        }
        __syncthreads();
    }
}

__device__ __forceinline__ void phase10(const Args& a, int lane, int wave, int vcu, int G) {
    unsigned char* ws = a.ws;
    const float* mod = (const float*)(ws + WS_MOD); const bf16* SO = (const bf16*)(ws + WS_SLOTOUT); const int* tokslot = (const int*)(ws + T_TOKSLOT); const float* gp = a.in[9];
    for (int t = vcu * 8 + wave; t < NT; t += G * 8) {
        const float* mr = mod + (size_t)(t >> 11) * 12288;
        const int myslot = lane < 8 ? tokslot[(size_t)t * 8 + lane] : SH_ROW0 + t;
        v4u x[9][4]; f32x4 xo[4][2]; const float* x1r = (const float*)(ws + WS_X1) + (size_t)t * 2048;
#pragma unroll
        for (int k = 0; k < 9; ++k) { const int slot = __shfl(myslot, k); const bf16* sr = SO + (size_t)slot * 2048;
#pragma unroll
            for (int j = 0; j < 4; ++j) x[k][j] = *(const v4u*)(sr + 8 * (lane + 64 * j)); }
#pragma unroll
        for (int j = 0; j < 4; ++j) { xo[j][0] = *(const f32x4*)(x1r + 8 * (lane + 64 * j)); xo[j][1] = *(const f32x4*)(x1r + 8 * (lane + 64 * j) + 4); }
        float y[4][8];
#pragma unroll
        for (int j = 0; j < 4; ++j)
#pragma unroll
            for (int q = 0; q < 8; ++q) y[j][q] = 0.f;
#pragma unroll
        for (int k = 0; k < 9; ++k)
#pragma unroll
            for (int j = 0; j < 4; ++j) { const v4u v = x[k][j];
                y[j][0] += bflo(v.x); y[j][1] += bfhi(v.x); y[j][2] += bflo(v.y); y[j][3] += bfhi(v.y); y[j][4] += bflo(v.z); y[j][5] += bfhi(v.z); y[j][6] += bflo(v.w); y[j][7] += bfhi(v.w); }
        float ss = 0.f;
#pragma unroll
        for (int j = 0; j < 4; ++j)
#pragma unroll
            for (int q = 0; q < 8; ++q) ss += y[j][q] * y[j][q];
        const float rstd = rsqrtf(wave_sum(ss) * (1.f / 2048.f) + EPS);
        float* outr = a.out + (size_t)t * 2048;
#pragma unroll
        for (int j = 0; j < 4; ++j)
#pragma unroll
            for (int hh = 0; hh < 2; ++hh) { const int c = 8 * (lane + 64 * j) + 4 * hh; const f32x4 x1 = xo[j][hh], g = *(const f32x4*)(gp + c), gt = *(const f32x4*)(mr + 10240 + c);
                f32x4 yy; yy[0] = y[j][4 * hh]; yy[1] = y[j][4 * hh + 1]; yy[2] = y[j][4 * hh + 2]; yy[3] = y[j][4 * hh + 3];
                *(f32x4*)(outr + c) = x1 + gt * (yy * rstd * g); }
    }
}

__global__ void __launch_bounds__(512, 2) fwd(Args args) {
    extern __shared__ __attribute__((aligned(16))) unsigned char lds_raw[];
    LAS unsigned char* lds = (LAS unsigned char*)lds_raw;
    const int tid = threadIdx.x, lane = tid & 63, wave = __builtin_amdgcn_readfirstlane(tid >> 6);
    const int G = gridDim.x, bx = blockIdx.x;
    const int vcu = (G % 8 == 0) ? (bx % 8) * (G / 8) + bx / 8 : bx;
    unsigned char* ws = args.ws;
    volatile LAS unsigned* MISC = (volatile LAS unsigned*)(lds + LDS_MISC);
    if (tid < 64) MISC[tid] = 0u;
    __syncthreads();
    const int lo = args.ph_lo, hi = args.ph_hi;
    XcdBarrier bar; bar.bar = (unsigned*)(ws + WS_CTL) + 4096; bar.x = 0; bar.st = nullptr;
    if (hi - lo > 1) bar = xcd_barrier_post((unsigned*)(ws + WS_CTL) + 4096, MISC + 8);
#ifndef PH_MASK
#define PH_MASK 0xfff
#endif
#define IN(k) (((PH_MASK >> (k)) & 1) && lo <= (k) && (k) < hi)
#define SEAM(k) do { if (IN(k) && IN((k) + 1)) xcd_barrier(bar); } while (0)

#ifndef REP_PHASE
#define REP_PHASE -1
#endif
#define RUNPH(k, ...) do { if (IN(k)) { __VA_ARGS__ if (REP_PHASE == (k)) { xcd_barrier(bar); __VA_ARGS__ } SEAM(k); } } while (0)
    RUNPH(0, phase0(args, lds, tid, lane, wave, vcu, G););
    RUNPH(1, phase1(args, lane, wave, vcu, G););
    RUNPH(2, {
        DenseSched S; S.init(ws + RA_H, ws + WS_WIN, 2048, 2048, MROWS, DINP, G, bx);
        EpiIn E{ws};
        pg8::gemm_phase<EpiIn, DenseSched>(lds, 2048, S, E); });
    RUNPH(3, phase3_prep(args, lds, tid, vcu, G); phase3_pool(args, lds, tid, vcu, G););
    RUNPH(4, phase_chain(args, lds, tid, lane, wave, vcu, G););
    RUNPH(5, {
        phase4_post(args, lane, wave, vcu, G);
        PoolSched S{(const char*)(ws + RA_DPOOL), (const char*)(ws + WS_WPOOL), G, vcu};
        EpiPool E{(bf16*)(ws + RA_YMIX), args.in[17]};
        int kpool = 256; asm volatile("" : "+s"(kpool));
        pg8::gemm_phase<EpiPool, PoolSched>(lds, kpool, S, E); });
    RUNPH(6, {
        DenseSched S; S.init(ws + RA_YMIX, ws + WS_WOUT, 2048, 2048, NT, 2048, G, bx);
        EpiOut E{(bf16*)(ws + RA_Y1)};
        pg8::gemm_phase<EpiOut, DenseSched>(lds, 2048, S, E); });
    RUNPH(7, phase6(args, lds, tid, lane, wave, vcu, G););
    RUNPH(8, phase7(args, lds, tid, lane, wave, vcu, G););
    RUNPH(9, {
        MoeGUSched S{(const char*)(ws + RA_H2), (const char*)(ws + WS_WGU), (const int*)(ws + T_TILE), (const int*)(ws + T_SLOTTOK), G, vcu};
        EpiGU E{ws + WS_ACT, (const float*)(ws + T_SLOTW)};
        int kgu = 1024; asm volatile("" : "+s"(kgu));
        pg8::gemm_phase<EpiGU, MoeGUSched, true>(lds, kgu, S, E); });
    RUNPH(10, {
        MoeDownSched S{(const char*)(ws + WS_ACT), (const char*)(ws + WS_WD), (const int*)(ws + T_TILE), G, vcu};
        EpiDown E{(bf16*)(ws + WS_SLOTOUT)};
        int kdn = 256; asm volatile("" : "+s"(kdn));
        pg8::gemm_phase<EpiDown, MoeDownSched, true>(lds, kdn, S, E); });
    if (IN(11)) { phase10(args, lane, wave, vcu, G); if (REP_PHASE == 11) { xcd_barrier(bar); phase10(args, lane, wave, vcu, G); } }
#undef IN
#undef SEAM
}

extern "C" void kernel_launch(void* const* d_in, const int* in_sizes, int n_in, void* d_out, int out_size, void* d_ws, size_t ws_size, hipStream_t stream) {
    static int grid = 0;
    if (grid == 0) {
        if (n_in != 27 || out_size != NT * DM || ws_size < WS_NEED) { fprintf(stderr, "kernel_launch: unexpected problem: n_in %d out %d ws %zu (need %zu)\n", n_in, out_size, ws_size, (size_t)WS_NEED); grid = -1; return; }
        int dev = 0, cus = 0, per_cu = 0;
        if (hipGetDevice(&dev) != hipSuccess || hipDeviceGetAttribute(&cus, hipDeviceAttributeMultiprocessorCount, dev) != hipSuccess) { grid = -1; return; }
        if (hipFuncSetAttribute((const void*)fwd, hipFuncAttributeMaxDynamicSharedMemorySize, LDS_BYTES) != hipSuccess) { fprintf(stderr, "kernel_launch: hipFuncSetAttribute failed\n"); grid = -1; return; }
        if (hipOccupancyMaxActiveBlocksPerMultiprocessor(&per_cu, (const void*)fwd, 512, LDS_BYTES) != hipSuccess || per_cu < 1) { fprintf(stderr, "kernel_launch: occupancy query says %d\n", per_cu); }
        (void)hipGetLastError();
        grid = cus;
    }
    if (grid < 0) return;
    (void)hipMemsetAsync((char*)d_ws + WS_CTL, 0, CTL_ZERO_BYTES, stream);
    Args a{};
    for (int i = 0; i < 27; ++i) a.in[i] = (const float*)d_in[i];
    a.out = (float*)d_out; a.ws = (unsigned char*)d_ws;
    if (N_LAUNCHES == 1) {
        a.ph_lo = 0; a.ph_hi = NPH;
        hipLaunchKernelGGL(fwd, dim3(grid), dim3(512), LDS_BYTES, stream, a);
    } else {
        for (int p = 0; p < NPH; ++p) { a.ph_lo = p; a.ph_hi = p + 1; hipLaunchKernelGGL(fwd, dim3(grid), dim3(512), LDS_BYTES, stream, a); }
    }
}
```

```cpp
#include <hip/hip_runtime.h>
#include <cstdio>
#include <cstdint>

#ifndef N_LAUNCHES
#define N_LAUNCHES 1
#endif

#define GAS __attribute__((address_space(1)))
#define LAS __attribute__((address_space(3)))
typedef unsigned short bf16;
typedef unsigned v4u __attribute__((ext_vector_type(4)));
typedef unsigned v2u __attribute__((ext_vector_type(2)));
typedef float f32x4 __attribute__((ext_vector_type(4)));
typedef short bf16x8 __attribute__((ext_vector_type(8)));
typedef unsigned long long u64;

constexpr int NB = 8, SEQ = 2048, DM = 2048, CTXL = 256;
constexpr int NT = NB * SEQ;
constexpr int NTC = NB * CTXL;
constexpr int MROWS = NT + NTC;
constexpr int DIN = 4128, DINP = 4352;
constexpr int NE = 64, TOPK = 8, DE = 512;
constexpr int NSLOT_E = NT * TOPK;
constexpr int SH_ROW0 = NSLOT_E + 256;
constexpr int NSLOT = SH_ROW0 + NT;
constexpr int NTILE_MAX = 704;
constexpr float EPS = 1e-6f;
constexpr int NPH = 12;

constexpr size_t MiB = 1u << 20;
constexpr size_t WS_CTL = 0, CTL_ZERO_BYTES = 64 * 1024;
constexpr size_t WS_MOD = 1 * MiB;
constexpr size_t WS_WRT = 1 * MiB + 512 * 1024;
constexpr size_t WS_WIN = 2 * MiB;
constexpr size_t WS_WOUT = WS_WIN + 17 * MiB;
constexpr size_t WS_WPOOL = WS_WOUT + 8 * MiB;
constexpr size_t WS_WD = WS_WPOOL + 1 * MiB;
constexpr size_t WS_WGU = WS_WD + 130 * MiB;
constexpr size_t WS_RA = WS_WGU + 260 * MiB;
constexpr size_t RA_H = WS_RA;
constexpr size_t RA_OF = WS_RA;
constexpr size_t RA_H2 = WS_RA;
constexpr size_t RA_Q = WS_RA + 128 * MiB;
constexpr size_t RA_K = RA_Q + 16 * MiB;
constexpr size_t RA_V = RA_K + 18 * MiB;
constexpr size_t RA_R = RA_V + 36 * MiB;
constexpr size_t RA_P = RA_R + 32 * MiB;
constexpr size_t RA_ALR = RA_P + 32 * MiB;
constexpr size_t RA_DPOOL = RA_ALR + 3 * MiB;
constexpr size_t RA_YMIX = RA_DPOOL + 32 * MiB;
constexpr size_t RA_Y1 = WS_RA + 128 * MiB;
constexpr size_t RA_END = RA_YMIX + 64 * MiB;
constexpr size_t WS_SLOTOUT = WS_WGU;
constexpr size_t WS_ACT = RA_END > WS_SLOTOUT + 578 * MiB ? RA_END : WS_SLOTOUT + 578 * MiB;
constexpr size_t WS_END = WS_ACT + 145 * MiB;
constexpr size_t PQG = WS_ACT;
constexpr size_t PQM = WS_ACT + 32 * MiB;
constexpr size_t PKM = WS_ACT + 64 * MiB;
constexpr size_t PKD = WS_ACT + 96 * MiB;
constexpr size_t PDEC = WS_ACT + 132 * MiB;
constexpr size_t WS_T0 = WS_END;
constexpr size_t T_CNT = WS_T0;
constexpr size_t T_MASK = T_CNT + 65536;
constexpr size_t T_TOKW = T_MASK + 131072;
constexpr size_t T_TOKSLOT = T_TOKW + 524288;
constexpr size_t T_SLOTTOK = T_TOKSLOT + 524288;
constexpr size_t T_SLOTW = T_SLOTTOK + 655360;
constexpr size_t T_TILE = T_SLOTW + 655360;
constexpr size_t WS_X1 = (T_TILE + 16384 + 4095) / 4096 * 4096;
constexpr size_t WS_NEED = WS_X1 + (size_t)NT * DM * 4;

constexpr int RING_BYTES = 131072;
constexpr int LDS_BYTES = 147456;
constexpr int LDS_MISC = LDS_BYTES - 256;
constexpr int RT_ROWB = 4112;
constexpr int RT_HI = 0, RT_LO = 16 * RT_ROWB;
constexpr int LDS_LOGIT = 2 * 16 * RT_ROWB;
constexpr int LDS_MASKS = LDS_LOGIT + 4096;
static_assert(LDS_MASKS + 512 <= LDS_MISC, "LDS map");

#define LDS_WAIT() asm volatile("s_waitcnt lgkmcnt(0)" ::: "memory")
#define VM_WAIT() asm volatile("s_waitcnt vmcnt(0)" ::: "memory")

__device__ __forceinline__ unsigned f2bf(float f) { unsigned u = __builtin_bit_cast(unsigned, f); return (u + 0x7fffu + ((u >> 16) & 1u)) >> 16; }
__device__ __forceinline__ unsigned pk2(float lo, float hi) { return f2bf(lo) | (f2bf(hi) << 16); }
__device__ __forceinline__ float bflo(unsigned u) { return __builtin_bit_cast(float, u << 16); }
__device__ __forceinline__ float bfhi(unsigned u) { return __builtin_bit_cast(float, u & 0xffff0000u); }
__device__ __forceinline__ float bf1(bf16 b) { return __builtin_bit_cast(float, ((unsigned)b) << 16); }
__device__ __forceinline__ float wave_sum(float v) {
#pragma unroll
    for (int o = 1; o < 64; o <<= 1) v += __shfl_xor(v, o);
    return v;
}
__device__ __forceinline__ float silu_f(float x) { return x / (1.f + __expf(-x)); }

#define XB_TMO      128
#define XB_XCNT(j)  (256  + 64 * (j))
#define XB_XSUB(j)  (1280 + 64 * (j))
#define XB_XGEN(j)  (2304 + 64 * (j))
#define XB_TOP      3328
#define XB_TOPGEN   3392
#define XCD_BAR_WORDS 3456
#define XB_SPIN_CAP (1u << 18)

__device__ __forceinline__ unsigned xb_ld(unsigned* p)              { return __hip_atomic_load(p, __ATOMIC_RELAXED, __HIP_MEMORY_SCOPE_AGENT); }
__device__ __forceinline__ unsigned xb_add(unsigned* p, unsigned v) { return __hip_atomic_fetch_add(p, v, __ATOMIC_RELAXED, __HIP_MEMORY_SCOPE_AGENT); }
__device__ __forceinline__ unsigned xb_xcc_id() { return (unsigned)__builtin_amdgcn_s_getreg((3 << 11) | 20) & 0xFu; }
#define XB_SPIN(cond, bar) do { unsigned _sp = 0; while (cond) { __builtin_amdgcn_s_sleep(1); \
    if ((++_sp & 255u) == 0u) { if (xb_ld(&(bar)[XB_TMO])) break; if (_sp > XB_SPIN_CAP) { atomicAdd(&(bar)[XB_TMO], 1u); break; } } } } while (0)

struct XcdBarrier { unsigned* bar; unsigned x; volatile LAS unsigned* st; };

__device__ __forceinline__ XcdBarrier xcd_barrier_post(unsigned* bar, volatile LAS unsigned* st) {
    XcdBarrier b; b.bar = bar; b.x = xb_xcc_id(); b.st = st;
    if (threadIdx.x == 0) (void)xb_add(&bar[XB_XCNT(b.x)], 1u);
    return b;
}
__device__ __forceinline__ void xcd_barrier_complete(unsigned* bar, unsigned x, unsigned& nloc, unsigned& nx) {
    const unsigned G = gridDim.x * gridDim.y * gridDim.z;
    unsigned sum, cnt, mine, sp = 0u;
    for (;;) {
        sum = 0u; cnt = 0u; mine = 0u;
#pragma unroll
        for (unsigned j = 0; j < 16; ++j) { const unsigned c = xb_ld(&bar[XB_XCNT(j)]); sum += c; cnt += (c > 0u) ? 1u : 0u; mine = (j == x) ? c : mine; }
        if (sum == G) break;
        __builtin_amdgcn_s_sleep(1);
        if ((++sp & 255u) == 0u) { if (xb_ld(&bar[XB_TMO])) break; if (sp > XB_SPIN_CAP) { atomicAdd(&bar[XB_TMO], 1u); break; } }
    }
    nloc = mine > 0u ? mine : 1u; nx = cnt > 0u ? cnt : 1u;
}
__device__ __forceinline__ void xcd_barrier(const XcdBarrier& b) {
    asm volatile("s_waitcnt vmcnt(0)" ::: "memory");
    __syncthreads();
    if (threadIdx.x == 0) {
        unsigned* bar = b.bar;
        __builtin_amdgcn_s_waitcnt(0);
        unsigned nloc = b.st[0], nx = b.st[1];
        if (nloc == 0u) { xcd_barrier_complete(bar, b.x, nloc, nx); b.st[0] = nloc; b.st[1] = nx; }
        const unsigned old = xb_add(&bar[XB_XSUB(b.x)], 1u);
        const unsigned gen = old / nloc;
        if (old + 1u == (gen + 1u) * nloc) {
            __builtin_amdgcn_fence(__ATOMIC_RELEASE, "agent");
            asm volatile("s_waitcnt vmcnt(0)" ::: "memory");
            const unsigned og = xb_add(&bar[XB_TOP], 1u);
            const unsigned tg = og / nx;
            if (og + 1u == (tg + 1u) * nx) xb_add(&bar[XB_TOPGEN], 1u);
            else XB_SPIN(xb_ld(&bar[XB_TOPGEN]) == tg, bar);
            __builtin_amdgcn_fence(__ATOMIC_ACQUIRE, "agent");
            xb_add(&bar[XB_XGEN(b.x)], 1u);
            asm volatile("s_waitcnt vmcnt(0)" ::: "memory");
        } else {
            XB_SPIN(xb_ld(&bar[XB_XGEN(b.x)]) == gen, bar);
            __builtin_amdgcn_fence(__ATOMIC_ACQUIRE, "agent");
            asm volatile("s_waitcnt vmcnt(0)" ::: "memory");
        }
    }
    __syncthreads();
}

namespace pg8 {
constexpr int BM = 256, BK = 64, HALF = 128, HTB = HALF * BK * 2, STAGE_BYTES = 8 * HTB, NXCD = 8, WGM = 8;
__device__ __forceinline__ int lds_byte(int r, int c) { const int st = (r >> 4) * 2 + (c >> 5), rr = r & 15, cc = c & 31, ob = rr * 64 + cc * 2; return st * 1024 + (ob ^ (((ob >> 9) & 1) << 5)); }
__device__ __forceinline__ void stage_rc(int b, int& R, int& C) { const int st = b / 1024, sb = b % 1024, swz = sb ^ (((sb >> 9) & 1) << 5); R = (st >> 1) * 16 + swz / 64; C = (st & 1) * 32 + (swz % 64) / 2; }
__device__ __forceinline__ int perm32(int rho) { const int n = rho >> 4, i = rho & 15; return 8 * (i >> 2) + 4 * n + (i & 3); }
__device__ __forceinline__ unsigned cvt_pk_bf16(float lo, float hi) { unsigned r; asm volatile("v_cvt_pk_bf16_f32 %0, %1, %2" : "=v"(r) : "v"(lo), "v"(hi)); return r; }

typedef int v8i __attribute__((ext_vector_type(8)));
typedef int v4i __attribute__((ext_vector_type(4)));
template <class Epi, class Sched, bool FP8 = false>
__device__ __forceinline__ void gemm_phase(LAS unsigned char* lds, const int K, const Sched& S, const Epi& E) {
    typedef typename Sched::U Unit;
    const int tid = threadIdx.x, wid = __builtin_amdgcn_readfirstlane(tid >> 6), lane = tid & 63, wr = wid >> 2, wc = wid & 3, fr = lane & 15, fq = lane >> 4;
    const int nt = K / BK;
    int R[2], C[2]; unsigned voffB[2];
#pragma unroll
    for (int i = 0; i < 2; ++i) { stage_rc(tid * 16 + i * 8192, R[i], C[i]);
        const int Rb = Epi::PERMK == 2 ? (64 * (R[i] >> 5) + 16 * ((R[i] & 15) >> 2) + 4 * ((R[i] >> 4) & 1) + (R[i] & 3)) : (Epi::PERMK == 1 ? ((R[i] & ~31) + perm32(R[i] & 31)) : R[i]);
        voffB[i] = (unsigned)(Rb * K + C[i]) * 2u; }
    const size_t kstep = (size_t)(BK * 2);
    const size_t hstepB = (size_t)(Epi::PERMK == 2 ? 8 : HALF) * K * 2;
    const unsigned ldsw = (unsigned)wid * 1024u;
    const int aoff = lds_byte(wr * 64 + fr, fq * 8), boff = lds_byte(wc * 32 + fr, fq * 8);
#define PG8_SA(b, h) (((b) * 2 + (h)) * HTB)
#define PG8_SB(b, h) ((4 + (b) * 2 + (h)) * HTB)
#define PG8_STAGE(bufoff, gbase, v0, v1) do { \
        __builtin_amdgcn_global_load_lds((const unsigned*)((const char*)(gbase) + (v0)), (LAS unsigned*)(lds + (bufoff) + ldsw), 16, 0, 0); \
        __builtin_amdgcn_global_load_lds((const unsigned*)((const char*)(gbase) + (v1)), (LAS unsigned*)(lds + (bufoff) + ldsw + 8192), 16, 0, 0); } while (0)
#define PG8_LDA(dst, b, h) do { _Pragma("unroll") for (int m = 0; m < 4; ++m) { const v4i lo_ = *(const LAS v4i*)(lds + PG8_SA(b, h) + aoff + m * 2048), hi_ = *(const LAS v4i*)(lds + PG8_SA(b, h) + aoff + m * 2048 + 1024); \
        dst[m] = __builtin_shufflevector(lo_, hi_, 0, 1, 2, 3, 4, 5, 6, 7); } } while (0)
#define PG8_LDB(dst, b, h) do { _Pragma("unroll") for (int n = 0; n < 2; ++n) { const v4i lo_ = *(const LAS v4i*)(lds + PG8_SB(b, h) + boff + n * 2048), hi_ = *(const LAS v4i*)(lds + PG8_SB(b, h) + boff + n * 2048 + 1024); \
        dst[n] = __builtin_shufflevector(lo_, hi_, 0, 1, 2, 3, 4, 5, 6, 7); } } while (0)
#define PG8_H0(x) ((bf16x8)__builtin_shufflevector(x, x, 0, 1, 2, 3))
#define PG8_H1(x) ((bf16x8)__builtin_shufflevector(x, x, 4, 5, 6, 7))
#define PG8_MMA(ai, bj, At, Bt) do { __builtin_amdgcn_s_setprio(1); if constexpr (FP8) asm volatile("s_nop 4"); _Pragma("unroll") for (int m = 0; m < 4; ++m) _Pragma("unroll") for (int n = 0; n < 2; ++n) { \
        if constexpr (FP8) asm volatile("v_mfma_f32_16x16x128_f8f6f4 %0, %1, %2, %0" : "+v"(acc[ai][bj][m][n]) : "v"(Bt[n]), "v"(At[m])); \
        else { acc[ai][bj][m][n] = __builtin_amdgcn_mfma_f32_16x16x32_bf16(PG8_H0(Bt[n]), PG8_H0(At[m]), acc[ai][bj][m][n], 0, 0, 0); \
               acc[ai][bj][m][n] = __builtin_amdgcn_mfma_f32_16x16x32_bf16(PG8_H1(Bt[n]), PG8_H1(At[m]), acc[ai][bj][m][n], 0, 0, 0); } } \
        __builtin_amdgcn_s_setprio(0); } while (0)
#define PG8_WAIT_V(n) asm volatile("s_waitcnt vmcnt(" #n ")" ::: "memory")
#define PG8_WAIT_L(n) asm volatile("s_waitcnt lgkmcnt(" #n ")" ::: "memory")
#define PG8_BAR __builtin_amdgcn_s_barrier()
#define PG8_SCHED __builtin_amdgcn_sched_barrier(0)
    Unit cur, nxt; int ui = 0;
    if (!S.next(0, cur)) return;
    f32x4 acc[2][2][4][2];
#pragma unroll
    for (int a = 0; a < 2; ++a)
#pragma unroll
        for (int b = 0; b < 2; ++b)
#pragma unroll
            for (int m = 0; m < 4; ++m)
#pragma unroll
                for (int n = 0; n < 2; ++n) acc[a][b][m][n] = (f32x4){0.f, 0.f, 0.f, 0.f};
    v8i At[4], B0[2], B1[2];
    unsigned vA[4], vN[4];
    S.aoffs(cur, R, C, vA);
    const char* cA = cur.A; const char* cB = cur.B;
    PG8_STAGE(PG8_SB(0, 0), cB, voffB[0], voffB[1]); PG8_STAGE(PG8_SB(0, 1), cB + hstepB, voffB[0], voffB[1]); PG8_STAGE(PG8_SA(0, 0), cA, vA[0], vA[1]); PG8_STAGE(PG8_SA(0, 1), cA, vA[2], vA[3]);
    if (wr == 1) PG8_BAR;
    PG8_WAIT_V(2); PG8_BAR;
    PG8_STAGE(PG8_SB(1, 0), cB + kstep, voffB[0], voffB[1]); PG8_STAGE(PG8_SA(1, 0), cA + kstep, vA[0], vA[1]); PG8_STAGE(PG8_SB(1, 1), cB + hstepB + kstep, voffB[0], voffB[1]);
    PG8_WAIT_V(6); PG8_BAR;
    for (;;) {
        const bool has_next = S.next(ui + 1, nxt);
        const char* nA = has_next ? nxt.A : cA; const char* nB = has_next ? nxt.B : cB;
        if (has_next) S.aoffs(nxt, R, C, vN); else { vN[0] = vA[0]; vN[1] = vA[1]; vN[2] = vA[2]; vN[3] = vA[3]; }
        for (int t = 0; t < nt; t += 2) {
            const bool last = (t == nt - 2);
            const char* a1 = cA + (size_t)(t + 1) * kstep;
            const char* a2 = last ? nA : cA + (size_t)(t + 2) * kstep; const char* b2 = last ? nB : cB + (size_t)(t + 2) * kstep;
            const char* a3 = a2 + kstep; const char* b3 = b2 + kstep;
            const unsigned x0 = last ? vN[0] : vA[0], x1 = last ? vN[1] : vA[1], x2 = last ? vN[2] : vA[2], x3 = last ? vN[3] : vA[3];
            PG8_LDB(B0, 0, 0); PG8_LDB(B1, 0, 1); PG8_SCHED; PG8_LDA(At, 0, 0); PG8_STAGE(PG8_SA(1, 1), a1, vA[2], vA[3]);
            PG8_WAIT_V(8); PG8_WAIT_L(0); PG8_BAR; PG8_MMA(0, 0, At, B0); PG8_MMA(0, 1, At, B1); PG8_BAR; PG8_SCHED;
            PG8_LDA(At, 0, 1); PG8_STAGE(PG8_SB(0, 0), b2, voffB[0], voffB[1]); PG8_STAGE(PG8_SB(0, 1), b2 + hstepB, voffB[0], voffB[1]); PG8_STAGE(PG8_SA(0, 0), a2, x0, x1);
            PG8_WAIT_V(8); PG8_WAIT_L(0); PG8_BAR; PG8_MMA(1, 0, At, B0); PG8_MMA(1, 1, At, B1); PG8_BAR; PG8_SCHED;
            PG8_LDB(B0, 1, 0); PG8_LDB(B1, 1, 1); PG8_SCHED; PG8_LDA(At, 1, 0); PG8_STAGE(PG8_SA(0, 1), a2, x2, x3);
            PG8_WAIT_V(8); PG8_WAIT_L(0); PG8_BAR; PG8_MMA(0, 0, At, B0); PG8_MMA(0, 1, At, B1); PG8_BAR; PG8_SCHED;
            PG8_LDA(At, 1, 1); PG8_STAGE(PG8_SB(1, 0), b3, voffB[0], voffB[1]); PG8_STAGE(PG8_SB(1, 1), b3 + hstepB, voffB[0], voffB[1]); PG8_STAGE(PG8_SA(1, 0), a3, x0, x1);
            PG8_WAIT_V(8); PG8_WAIT_L(0); PG8_BAR; PG8_MMA(1, 0, At, B0); PG8_MMA(1, 1, At, B1); PG8_BAR; PG8_SCHED;
        }
        if (wr == 0) PG8_BAR;
        if constexpr (FP8) asm volatile("s_nop 15\n\ts_nop 15");
        { int tz = threadIdx.x; asm volatile("" : "+v"(tz));
          const int wid_ = tz >> 6, lane_ = tz & 63; E(acc, cur, wid_ >> 2, wid_ & 3, lane_ & 15, lane_ >> 4);
#ifdef PROBE_EPI2
          if constexpr (Epi::PROBE2) { asm volatile("" : "+v"(tz)); const int w2 = tz >> 6, l2 = tz & 63; E(acc, cur, w2 >> 2, w2 & 3, l2 & 15, l2 >> 4); }
#endif
#ifdef PROBE_DRAIN
          if constexpr (Epi::PROBE2) { asm volatile("s_waitcnt vmcnt(0)" ::: "memory"); }
#endif
        }
        if (!has_next) break;
#pragma unroll
        for (int a = 0; a < 2; ++a)
#pragma unroll
            for (int b = 0; b < 2; ++b)
#pragma unroll
                for (int m = 0; m < 4; ++m)
#pragma unroll
                    for (int n = 0; n < 2; ++n) acc[a][b][m][n] = (f32x4){0.f, 0.f, 0.f, 0.f};
        cur = nxt; cA = nA; cB = nB; ++ui;
        vA[0] = vN[0]; vA[1] = vN[1]; vA[2] = vN[2]; vA[3] = vN[3];
        if (wr == 1) PG8_BAR;
    }
    PG8_WAIT_V(0);
    PG8_BAR;
#undef PG8_SA
#undef PG8_SB
#undef PG8_STAGE
#undef PG8_LDA
#undef PG8_LDB
#undef PG8_H0
#undef PG8_H1
#undef PG8_MMA
#undef PG8_WAIT_V
#undef PG8_WAIT_L
#undef PG8_BAR
#undef PG8_SCHED
}
}

struct Args { const float* in[27]; float* out; unsigned char* ws; int ph_lo, ph_hi; };
static_assert(sizeof(Args) == 27 * 8 + 8 + 8 + 8, "Args has no padding");

struct DenseU { const char* A; const char* B; int pm, pn; };
struct DenseSched {
    typedef DenseU U;
    const char* A; const char* B; int lda, K, nM, nN, nwg, G, c;
    __device__ __forceinline__ void init(const void* A_, const void* B_, int lda_, int K_, int M, int N, int G_, int c_) { A = (const char*)A_; B = (const char*)B_; lda = lda_; K = K_; nM = M / 256; nN = N / 256; nwg = nM * nN; G = G_; c = c_; }
    __device__ __forceinline__ bool next(int i, U& u) const {
        const long L = (long)i * G + c; if (L >= nwg) return false;
        int wgid = (int)L; { const int q = nwg / 8, r = nwg % 8, xcd = wgid % 8, off = wgid / 8; wgid = (xcd < r ? xcd * (q + 1) : r * (q + 1) + (xcd - r) * q) + off; }
        const int nig = 8 * nN, gid = wgid / nig, fm = gid * 8, gsz = (nM - fm) < 8 ? (nM - fm) : 8;
        u.pm = fm + ((wgid % nig) % gsz); u.pn = (wgid % nig) / gsz;
        u.A = A + (size_t)u.pm * 256 * lda * 2; u.B = B + (size_t)u.pn * 256 * K * 2; return true;
    }
    __device__ __forceinline__ void aoffs(const U&, const int (&R)[2], const int (&C)[2], unsigned (&v)[4]) const {
#pragma unroll
        for (int h = 0; h < 2; ++h)
#pragma unroll
            for (int i = 0; i < 2; ++i) v[h * 2 + i] = (unsigned)((h * 128 + R[i]) * lda + C[i]) * 2u;
    }
};
struct PoolU { const char* A; const char* B; int pm, g; };
struct PoolSched {
    typedef PoolU U;
    const char* A; const char* B; int G, c;
    __device__ __forceinline__ bool next(int i, U& u) const {
        const int L = i * G + c; if (L >= 256) return false;
        u.g = L & 3; u.pm = L >> 2;
        u.A = A + ((size_t)u.pm * 256 * 1024 + u.g * 256) * 2; u.B = B + (size_t)u.g * 256 * 256 * 2; return true;
    }
    __device__ __forceinline__ void aoffs(const U&, const int (&R)[2], const int (&C)[2], unsigned (&v)[4]) const {
#pragma unroll
        for (int h = 0; h < 2; ++h)
#pragma unroll
            for (int i = 0; i < 2; ++i) v[h * 2 + i] = (unsigned)((h * 128 + R[i]) * 1024 + C[i]) * 2u;
    }
};
struct MoeU { const char* A; const char* B; int row0, nrows, pn; };
struct MoeGUSched {
    typedef MoeU U;
    const char* H2; const char* W; const int* tile; const int* slot_tok; int G, c;
    __device__ __forceinline__ bool next(int i, U& u) const {
        const int nt = tile[3 * NTILE_MAX]; const int L = i * G + c; if (L >= nt * 4) return false;
        const int t = L >> 2; u.pn = L & 3; const int e = tile[t]; u.row0 = tile[NTILE_MAX + t]; u.nrows = tile[2 * NTILE_MAX + t];
        u.A = H2; u.B = W + ((size_t)e * 1024 + u.pn * 256) * 2048; return true;
    }
    __device__ __forceinline__ void aoffs(const U& u, const int (&R)[2], const int (&C)[2], unsigned (&v)[4]) const {
#pragma unroll
        for (int h = 0; h < 2; ++h)
#pragma unroll
            for (int i = 0; i < 2; ++i) { int r = h * 128 + R[i]; r = r < u.nrows ? r : u.nrows - 1; const int tok = slot_tok[u.row0 + r]; v[h * 2 + i] = (unsigned)(tok * 1024 + C[i]) * 2u; }
    }
};
struct MoeDownSched {
    typedef MoeU U;
    const char* ACT; const char* W; const int* tile; int G, c;
    __device__ __forceinline__ bool next(int i, U& u) const {
        const int nt = tile[3 * NTILE_MAX]; const int L = i * G + c; if (L >= nt * 8) return false;
        const int t = L >> 3; u.pn = L & 7; const int e = tile[t]; u.row0 = tile[NTILE_MAX + t]; u.nrows = tile[2 * NTILE_MAX + t];
        u.A = ACT + (size_t)u.row0 * 512; u.B = W + ((size_t)e * 2048 + u.pn * 256) * 512; return true;
    }
    __device__ __forceinline__ void aoffs(const U&, const int (&R)[2], const int (&C)[2], unsigned (&v)[4]) const {
#pragma unroll
        for (int h = 0; h < 2; ++h)
#pragma unroll
            for (int i = 0; i < 2; ++i) v[h * 2 + i] = (unsigned)((h * 128 + R[i]) * 256 + C[i]) * 2u;
    }
};

struct EpiIn {
    static constexpr int PERMK = 1; static constexpr bool PROBE2 = false;
    unsigned char* ws;
    __device__ __forceinline__ void operator()(const f32x4 (&acc)[2][2][4][2], const DenseU& u, int wr, int wc, int fr, int fq) const {
        const int pn = u.pn; const int row0 = u.pm * 256 + wr * 64 + fr;
        if (pn == 16) {
            if (wc != 0) return;
            float* alr = (float*)(ws + RA_ALR);
#pragma unroll
            for (int ai = 0; ai < 2; ++ai)
#pragma unroll
                for (int m = 0; m < 4; ++m) { float* rp = alr + (size_t)(row0 + ai * 128 + m * 16) * 32 + 8 * fq;
                    *(f32x4*)(rp) = acc[ai][0][m][0]; *(f32x4*)(rp + 4) = acc[ai][0][m][1]; }
            return;
        }
        bf16* base; int ld, colt; bool lat_only;
        if (pn < 2) { base = (bf16*)(ws + RA_Q); ld = 512; colt = pn * 256; lat_only = true; }
        else if (pn < 4) { base = (bf16*)(ws + RA_K); ld = 512; colt = (pn - 2) * 256; lat_only = false; }
        else if (pn < 8) { base = (bf16*)(ws + RA_V); ld = 1024; colt = (pn - 4) * 256; lat_only = false; }
        else if (pn < 12) { base = (bf16*)(ws + RA_R); ld = 1024; colt = (pn - 8) * 256; lat_only = true; }
        else { base = (bf16*)(ws + RA_P); ld = 1024; colt = (pn - 12) * 256; lat_only = true; }
        if (lat_only && u.pm >= 64) return;
        const int col0 = colt + wc * 32 + 8 * fq;
#pragma unroll
        for (int ai = 0; ai < 2; ++ai)
#pragma unroll
            for (int m = 0; m < 4; ++m) { bf16* rp = base + (size_t)(row0 + ai * 128 + m * 16) * ld + col0;
#pragma unroll
                for (int bj = 0; bj < 2; ++bj) { const f32x4 v0 = acc[ai][bj][m][0], v1 = acc[ai][bj][m][1];
                    v4u o; o.x = pg8::cvt_pk_bf16(v0[0], v0[1]); o.y = pg8::cvt_pk_bf16(v0[2], v0[3]); o.z = pg8::cvt_pk_bf16(v1[0], v1[1]); o.w = pg8::cvt_pk_bf16(v1[2], v1[3]);
                    *(v4u*)(rp + bj * 128) = o; } }
    }
};
struct EpiPool {
    static constexpr int PERMK = 1; static constexpr bool PROBE2 = false;
    bf16* ymix; const float* scale;
    __device__ __forceinline__ void operator()(const f32x4 (&acc)[2][2][4][2], const PoolU& u, int wr, int wc, int fr, int fq) const {
        const int row0 = u.pm * 256 + wr * 64 + fr; const int c0 = u.g * 256 + wc * 32 + 8 * fq;
#pragma unroll
        for (int ai = 0; ai < 2; ++ai)
#pragma unroll
            for (int m = 0; m < 4; ++m) { bf16* rp = ymix + (size_t)(row0 + ai * 128 + m * 16) * 2048 + 1024 + c0;
#pragma unroll
                for (int bj = 0; bj < 2; ++bj) { const f32x4 s0 = *(const f32x4*)(scale + c0 + bj * 128), s1 = *(const f32x4*)(scale + c0 + bj * 128 + 4);
                    const f32x4 v0 = acc[ai][bj][m][0] * s0, v1 = acc[ai][bj][m][1] * s1;
                    v4u o; o.x = pg8::cvt_pk_bf16(v0[0], v0[1]); o.y = pg8::cvt_pk_bf16(v0[2], v0[3]); o.z = pg8::cvt_pk_bf16(v1[0], v1[1]); o.w = pg8::cvt_pk_bf16(v1[2], v1[3]);
                    *(v4u*)(rp + bj * 128) = o; } }
    }
};
struct EpiOut {
    static constexpr int PERMK = 1; static constexpr bool PROBE2 = false;
    bf16* y;
    __device__ __forceinline__ void operator()(const f32x4 (&acc)[2][2][4][2], const DenseU& u, int wr, int wc, int fr, int fq) const {
        const int row0 = u.pm * 256 + wr * 64 + fr, col0 = u.pn * 256 + wc * 32 + 8 * fq;
#pragma unroll
        for (int ai = 0; ai < 2; ++ai)
#pragma unroll
            for (int m = 0; m < 4; ++m) { bf16* rp = y + (size_t)(row0 + ai * 128 + m * 16) * 2048 + col0;
#pragma unroll
                for (int bj = 0; bj < 2; ++bj) { const f32x4 v0 = acc[ai][bj][m][0], v1 = acc[ai][bj][m][1];
                    v4u o; o.x = pg8::cvt_pk_bf16(v0[0], v0[1]); o.y = pg8::cvt_pk_bf16(v0[2], v0[3]); o.z = pg8::cvt_pk_bf16(v1[0], v1[1]); o.w = pg8::cvt_pk_bf16(v1[2], v1[3]);
                    *(v4u*)(rp + bj * 128) = o; } }
    }
};
constexpr float SC_W = 256.f, SC_H = 16.f, SC_A = 16.f;
__device__ __forceinline__ unsigned pk4_fp8(float a, float b, float c, float d) {
    a = fminf(fmaxf(a, -448.f), 448.f); b = fminf(fmaxf(b, -448.f), 448.f); c = fminf(fmaxf(c, -448.f), 448.f); d = fminf(fmaxf(d, -448.f), 448.f);
    unsigned w = 0; w = __builtin_amdgcn_cvt_pk_fp8_f32(a, b, w, false); w = __builtin_amdgcn_cvt_pk_fp8_f32(c, d, w, true); return w;
}
struct EpiGU {
    static constexpr int PERMK = 1; static constexpr bool PROBE2 = false;
    unsigned char* act; const float* slot_w;
    __device__ __forceinline__ void operator()(const f32x4 (&acc)[2][2][4][2], const MoeU& u, int wr, int wc, int fr, int fq) const {
        const int c0 = u.pn * 128 + wc * 32 + 8 * fq; constexpr float inv = 1.f / (SC_W * SC_H);
#pragma unroll
        for (int ai = 0; ai < 2; ++ai)
#pragma unroll
            for (int m = 0; m < 4; ++m) { const int r = ai * 128 + wr * 64 + m * 16 + fr;
                if (r < u.nrows) { const float w = slot_w[u.row0 + r] * SC_A; float o[8];
#pragma unroll
                    for (int n = 0; n < 2; ++n)
#pragma unroll
                        for (int j = 0; j < 4; ++j) { const float g = acc[ai][0][m][n][j] * inv, up = acc[ai][1][m][n][j] * inv; o[n * 4 + j] = silu_f(g) * up * w; }
                    v2u q; q.x = pk4_fp8(o[0], o[1], o[2], o[3]); q.y = pk4_fp8(o[4], o[5], o[6], o[7]);
                    *(v2u*)(act + (size_t)(u.row0 + r) * 512 + c0) = q; } }
    }
};
constexpr float SC_O = 32.f;
struct EpiDown {
    static constexpr int PERMK = 2; static constexpr bool PROBE2 = true;
    unsigned char* so;
    __device__ __forceinline__ void operator()(const f32x4 (&acc)[2][2][4][2], const MoeU& u, int wr, int wc, int fr, int fq) const {
        const int c0 = u.pn * 256 + wc * 64 + 16 * fq; constexpr float sc = SC_O / (SC_W * SC_A);
#pragma unroll
        for (int ai = 0; ai < 2; ++ai)
#pragma unroll
            for (int m = 0; m < 4; ++m) { const int r = ai * 128 + wr * 64 + m * 16 + fr;
                if (r < u.nrows) { const f32x4 a0 = acc[ai][0][m][0] * sc, a1 = acc[ai][0][m][1] * sc, b0 = acc[ai][1][m][0] * sc, b1 = acc[ai][1][m][1] * sc;
                    v4u o; o.x = pk4_fp8(a0[0], a0[1], a0[2], a0[3]); o.y = pk4_fp8(a1[0], a1[1], a1[2], a1[3]); o.z = pk4_fp8(b0[0], b0[1], b0[2], b0[3]); o.w = pk4_fp8(b1[0], b1[1], b1[2], b1[3]);
                    __builtin_nontemporal_store(o, (v4u*)(so + (size_t)(u.row0 + r) * 2048 + c0)); } }
    }
};

__device__ __forceinline__ void tr_item(const float* W, int ldn, bf16* WT, int Kd, int drow0, int k0, int n0, LAS float* scr, int lane) {
    f32x4 t[8];
#pragma unroll
    for (int i = 0; i < 8; ++i) t[i] = *(const f32x4*)(W + (size_t)(k0 + 8 * i + (lane >> 3)) * ldn + n0 + 4 * (lane & 7));
#pragma unroll
    for (int i = 0; i < 8; ++i) { LAS float* d = scr + (8 * i + (lane >> 3)) * 33 + 4 * (lane & 7); d[0] = t[i][0]; d[1] = t[i][1]; d[2] = t[i][2]; d[3] = t[i][3]; }
    LDS_WAIT(); asm volatile("" ::: "memory");
    const int c = lane & 7;
#pragma unroll
    for (int j = 0; j < 4; ++j) { const int n = (lane >> 3) + 8 * j; const LAS float* s = scr + (8 * c) * 33 + n;
        v4u o; o.x = pk2(s[0 * 33], s[1 * 33]); o.y = pk2(s[2 * 33], s[3 * 33]); o.z = pk2(s[4 * 33], s[5 * 33]); o.w = pk2(s[6 * 33], s[7 * 33]);
        *(v4u*)(WT + (size_t)(drow0 + n) * Kd + k0 + 8 * c) = o; }
    LDS_WAIT(); asm volatile("" ::: "memory");
}

__device__ __forceinline__ void tr_item8(const float* W, int ldn, unsigned char* WT, int Kd, int drow0, int k0, int n0, LAS float* scr, int lane) {
    f32x4 t[8];
#pragma unroll
    for (int i = 0; i < 8; ++i) t[i] = *(const f32x4*)(W + (size_t)(k0 + 8 * i + (lane >> 3)) * ldn + n0 + 4 * (lane & 7));
#pragma unroll
    for (int i = 0; i < 8; ++i) { LAS float* d = scr + (8 * i + (lane >> 3)) * 33 + 4 * (lane & 7); d[0] = t[i][0]; d[1] = t[i][1]; d[2] = t[i][2]; d[3] = t[i][3]; }
    LDS_WAIT(); asm volatile("" ::: "memory");
    const int c = lane & 7;
#pragma unroll
    for (int j = 0; j < 4; ++j) { const int n = (lane >> 3) + 8 * j; const LAS float* s = scr + (8 * c) * 33 + n;
        v2u o; o.x = pk4_fp8(s[0 * 33] * SC_W, s[1 * 33] * SC_W, s[2 * 33] * SC_W, s[3 * 33] * SC_W); o.y = pk4_fp8(s[4 * 33] * SC_W, s[5 * 33] * SC_W, s[6 * 33] * SC_W, s[7 * 33] * SC_W);
        *(v2u*)(WT + (size_t)(drow0 + n) * Kd + k0 + 8 * c) = o; }
    LDS_WAIT(); asm volatile("" ::: "memory");
}

__device__ __forceinline__ void phase0(const Args& a, LAS unsigned char* lds, int tid, int lane, int wave, int vcu, int G) {
    unsigned char* ws = a.ws;
    if (vcu < 192) {
        LAS float* sc = (LAS float*)lds;
        LAS float* red = (LAS float*)(lds + 73728);
        for (int i = tid; i < 9 * 2048; i += 512) { const int r = i >> 11, k = i & 2047; const float v = r < 8 ? a.in[1][r * 2048 + k] : a.in[3][k]; sc[i] = silu_f(v); }
        __syncthreads();
        const float* wm = a.in[4]; const float* bm = a.in[5]; float* mod = (float*)(ws + WS_MOD);
        for (int chunk = vcu; chunk < 192; chunk += G) {
            const int n0 = chunk * 64, ks = lane >> 4, n4 = (lane & 15) * 4;
            f32x4 acc[9];
#pragma unroll
            for (int r = 0; r < 9; ++r) acc[r] = (f32x4){0.f, 0.f, 0.f, 0.f};
#pragma unroll 4
            for (int kk = 0; kk < 256; kk += 4) { const int k = wave * 256 + kk + ks; const f32x4 wv = *(const f32x4*)(wm + (size_t)k * 12288 + n0 + n4);
#pragma unroll
                for (int r = 0; r < 9; ++r) { const float s = sc[r * 2048 + k]; acc[r] += wv * s; } }
#pragma unroll
            for (int r = 0; r < 9; ++r)
#pragma unroll
                for (int j = 0; j < 4; ++j) { float v = acc[r][j]; v += __shfl_xor(v, 16); v += __shfl_xor(v, 32); acc[r][j] = v; }
            if (lane < 16) {
#pragma unroll
                for (int r = 0; r < 9; ++r) *(LAS f32x4*)(red + (wave * 9 + r) * 64 + n4) = acc[r]; }
            __syncthreads();
            for (int i = tid; i < 9 * 64; i += 512) { const int r = i >> 6, n = i & 63; float s = 0.f;
#pragma unroll
                for (int w = 0; w < 8; ++w) s += red[(w * 9 + r) * 64 + n];
                mod[r * 12288 + n0 + n] = s + bm[n0 + n]; }
            __syncthreads();
        }
    }
    __syncthreads();
    LAS float* scr = (LAS float*)(lds + wave * 16384);
    const int gw = vcu * 8 + wave, NGW = G * 8;
    bf16* Win_t = (bf16*)(ws + WS_WIN); bf16* Wout_t = (bf16*)(ws + WS_WOUT); bf16* Wpool_t = (bf16*)(ws + WS_WPOOL); unsigned char* Wd_t = ws + WS_WD; unsigned char* Wgu_t = ws + WS_WGU;
    constexpr int I_IN = 32 * 129, I_OUT = 32 * 64, I_POOL = 4 * 4 * 8, I_E = 65 * 512;
    constexpr int NITEMS = I_IN + I_OUT + I_POOL + 3 * I_E;
    for (int it = gw; it < NITEMS; it += NGW) {
        int r = it;
        if (r < I_IN) { const int kb = r / 129, nb = r % 129, n0 = 32 * nb; const int drow = n0 < 3072 ? n0 : (n0 == 3072 ? 4096 : n0 - 32);
            tr_item(a.in[10], DIN, Win_t, 2048, drow, 64 * kb, n0, scr, lane); continue; } r -= I_IN;
        if (r < I_OUT) { const int kb = r / 64, nb = r % 64; tr_item(a.in[18], 2048, Wout_t, 2048, 32 * nb, 64 * kb, 32 * nb, scr, lane); continue; } r -= I_OUT;
        if (r < I_POOL) { const int g = r / 32, rr = r % 32, kb = rr / 8, nb = rr % 8; tr_item(a.in[16] + g * 65536, 256, Wpool_t + g * 65536, 256, 32 * nb, 64 * kb, 32 * nb, scr, lane); continue; } r -= I_POOL;
        if (r < I_E) { const int e = r / 512, rr = r % 512, kb = rr / 16, nb = rr % 16, n0 = 32 * nb; const float* src = e < 64 ? a.in[21] + (size_t)e * 2048 * 512 : a.in[24];
            tr_item8(src, 512, Wgu_t + (size_t)e * 1024 * 2048, 2048, (n0 / 128) * 256 + (n0 % 128), 64 * kb, n0, scr, lane); continue; } r -= I_E;
        if (r < I_E) { const int e = r / 512, rr = r % 512, kb = rr / 16, nb = rr % 16, n0 = 32 * nb; const float* src = e < 64 ? a.in[22] + (size_t)e * 2048 * 512 : a.in[25];
            tr_item8(src, 512, Wgu_t + (size_t)e * 1024 * 2048, 2048, (n0 / 128) * 256 + 128 + (n0 % 128), 64 * kb, n0, scr, lane); continue; } r -= I_E;
        { const int e = r / 512, rr = r % 512, kb = rr / 64, nb = rr % 64; const float* src = e < 64 ? a.in[23] + (size_t)e * 512 * 2048 : a.in[26];
            tr_item8(src, 2048, Wd_t + (size_t)e * 2048 * 512, 512, 32 * nb, 64 * kb, 32 * nb, scr, lane); }
    }
    { const float* wr = a.in[19]; bf16* whi = (bf16*)(ws + WS_WRT); bf16* wlo = whi + 64 * 2048;
      for (int idx = vcu * 512 + tid; idx < 64 * 256; idx += G * 512) { const int e = idx >> 8, k8 = idx & 255; unsigned hi[8], lo[8];
#pragma unroll
          for (int j = 0; j < 8; ++j) { const float v = wr[(size_t)(8 * k8 + j) * 64 + e]; hi[j] = f2bf(v); lo[j] = f2bf(v - __builtin_bit_cast(float, hi[j] << 16)); }
          v4u oh, ol; oh.x = hi[0] | (hi[1] << 16); oh.y = hi[2] | (hi[3] << 16); oh.z = hi[4] | (hi[5] << 16); oh.w = hi[6] | (hi[7] << 16);
          ol.x = lo[0] | (lo[1] << 16); ol.y = lo[2] | (lo[3] << 16); ol.z = lo[4] | (lo[5] << 16); ol.w = lo[6] | (lo[7] << 16);
          *(v4u*)(whi + (size_t)e * 2048 + 8 * k8) = oh; *(v4u*)(wlo + (size_t)e * 2048 + 8 * k8) = ol; } }
    { v4u* z = (v4u*)(Win_t + (size_t)DIN * 2048); const int nz = (DINP - DIN) * 2048 / 8;
      for (int i = vcu * 512 + tid; i < nz; i += G * 512) z[i] = (v4u){0u, 0u, 0u, 0u}; }
}

__device__ __forceinline__ void phase1(const Args& a, int lane, int wave, int vcu, int G) {
    const float* mod = (const float*)(a.ws + WS_MOD); bf16* H = (bf16*)(a.ws + RA_H); const float* g = a.in[6];
    for (int m = vcu * 8 + wave; m < MROWS; m += G * 8) {
        const float* xr = m < NT ? a.in[0] + (size_t)m * 2048 : a.in[2] + (size_t)(m - NT) * 2048;
        const float* mr = mod + (size_t)(m < NT ? (m >> 11) : 8) * 12288;
        f32x4 v[8]; float ss = 0.f;
#pragma unroll
        for (int j = 0; j < 8; ++j) { v[j] = *(const f32x4*)(xr + 4 * (lane + 64 * j)); ss += v[j][0] * v[j][0] + v[j][1] * v[j][1] + v[j][2] * v[j][2] + v[j][3] * v[j][3]; }
        const float rstd = rsqrtf(wave_sum(ss) * (1.f / 2048.f) + EPS);
#pragma unroll
        for (int j = 0; j < 8; ++j) { const int c = 4 * (lane + 64 * j); const f32x4 gg = *(const f32x4*)(g + c), sh = *(const f32x4*)(mr + c), sc = *(const f32x4*)(mr + 2048 + c);
            const f32x4 o = v[j] * rstd * gg * (sc + 1.f) + sh;
            v2u q; q.x = pk2(o[0], o[1]); q.y = pk2(o[2], o[3]); *(v2u*)(H + (size_t)m * 2048 + c) = q; }
    }
}

__device__ __forceinline__ int scan_row(int b, int dir, int s) {
    if (s < 256) { const int tc = dir ? 255 - s : s; return NT + b * 256 + tc; }
    const int t0 = s - 256; return b * 2048 + (dir ? 2047 - t0 : t0);
}
__device__ __forceinline__ void phase3_prep(const Args& a, LAS unsigned char* lds, int tid, int vcu, int G) {
    unsigned char* ws = a.ws;
    const bf16* Q = (const bf16*)(ws + RA_Q); const bf16* Kb = (const bf16*)(ws + RA_K); const float* ALR = (const float*)(ws + RA_ALR);
    bf16* QG = (bf16*)(ws + PQG); bf16* QM = (bf16*)(ws + PQM); bf16* KM = (bf16*)(ws + PKM); bf16* KD = (bf16*)(ws + PKD); float* DEC = (float*)(ws + PDEC);
    LAS float* alr = (LAS float*)lds;
    LAS bf16* Kt = (LAS bf16*)(lds + 4096);
    LAS bf16* Qt = (LAS bf16*)(lds + 4096 + 65536);
    const int col = tid, h = col >> 7, dk = col & 127;
    for (int item = vcu; item < 2 * 8 * 36; item += G) {
        const int ch = item % 36, b = (item / 36) & 7, dir = item / 288;
        const bool lat = ch >= 4;
        if (tid < 256) { const int i = tid >> 2, r4 = (tid & 3) * 4; const int row = scan_row(b, dir, ch * 64 + i);
            *(LAS f32x4*)(alr + i * 16 + r4) = *(const f32x4*)(ALR + (size_t)row * 32 + dir * 16 + r4); }
        { v4u kr[8], qr[8];
#pragma unroll
          for (int q = 0; q < 8; ++q) { const int p = tid + 512 * q, i = p >> 6, c8 = (p & 63) * 8; const int row = scan_row(b, dir, ch * 64 + i);
              kr[q] = *(const v4u*)(Kb + (size_t)row * 512 + c8); if (lat) qr[q] = *(const v4u*)(Q + (size_t)row * 512 + c8); }
#pragma unroll
          for (int q = 0; q < 8; ++q) { const int p = tid + 512 * q; *(LAS v4u*)(Kt + p * 8) = kr[q]; if (lat) *(LAS v4u*)(Qt + p * 8) = qr[q]; } }
        const float* wa2 = dir ? a.in[13] : a.in[11]; const float bia = (dir ? a.in[14] : a.in[12])[col];
        float w[16];
#pragma unroll
        for (int r = 0; r < 16; ++r) w[r] = wa2[r * 512 + col];
        __syncthreads();
        float Gc = 0.f, Gmid = 0.f;
#pragma unroll 4
        for (int i = 0; i < 64; ++i) { float z = bia;
#pragma unroll
            for (int r4 = 0; r4 < 4; ++r4) { const f32x4 x = *(const LAS f32x4*)(alr + i * 16 + 4 * r4); z += x[0] * w[4 * r4] + x[1] * w[4 * r4 + 1] + x[2] * w[4 * r4 + 2] + x[3] * w[4 * r4 + 3]; }
            Gc += (fminf(z, 0.f) - __logf(1.f + __expf(-fabsf(z)))) * (1.f / 16.f);
            if (i == 32) Gmid = Gc; }
        const float Gend = Gc;
        DEC[((size_t)(dir * 8 + b) * 36 + ch) * 512 + col] = __expf(Gend);
        bf16* kdrow = KD + ((((size_t)(dir * 8 + b) * 36 + ch) * 4 + h) * 128 + dk) * 64;
        const size_t lt = lat ? ((((size_t)(dir * 8 + b) * 32 + (ch - 4)) * 4 + h) * 64) * 128 + dk : 0;
        Gc = 0.f;
#pragma unroll 1
        for (int i0 = 0; i0 < 64; i0 += 8) { unsigned kd[8];
#pragma unroll
            for (int ii = 0; ii < 8; ++ii) { const int i = i0 + ii; float z = bia;
#pragma unroll
                for (int r4 = 0; r4 < 4; ++r4) { const f32x4 x = *(const LAS f32x4*)(alr + i * 16 + 4 * r4); z += x[0] * w[4 * r4] + x[1] * w[4 * r4 + 1] + x[2] * w[4 * r4 + 2] + x[3] * w[4 * r4 + 3]; }
                Gc += (fminf(z, 0.f) - __logf(1.f + __expf(-fabsf(z)))) * (1.f / 16.f);
                const float kv = bf1(Kt[i * 512 + col]);
                kd[ii] = f2bf(kv * __expf(Gend - Gc));
                if (lat) { const float qv = bf1(Qt[i * 512 + col]) * 0.08838834764831845f;
                    QG[lt + (size_t)i * 128] = (bf16)f2bf(qv * __expf(Gc)); QM[lt + (size_t)i * 128] = (bf16)f2bf(qv * __expf(Gc - Gmid)); KM[lt + (size_t)i * 128] = (bf16)f2bf(kv * __expf(Gmid - Gc)); } }
            v4u o; o.x = kd[0] | (kd[1] << 16); o.y = kd[2] | (kd[3] << 16); o.z = kd[4] | (kd[5] << 16); o.w = kd[6] | (kd[7] << 16);
            *(v4u*)(kdrow + i0) = o; }
        __syncthreads();
    }
}

constexpr int GL_QG = 0, GL_QM = 17408, GL_KM = 34816, GL_ST = 52224, GL_KDT = 69632, GL_VT = 88064, GL_AM = 97280, GL_DEC = 106496;
__device__ __forceinline__ void phase_chain(const Args& a, LAS unsigned char* lds, int tid, int lane, int wave, int vcu, int G) {
    unsigned char* ws = a.ws;
    const v4u* QG = (const v4u*)(ws + PQG); const v4u* QM = (const v4u*)(ws + PQM); const v4u* KM = (const v4u*)(ws + PKM); const v4u* KD = (const v4u*)(ws + PKD); const float* DEC = (const float*)(ws + PDEC);
    const bf16* V = (const bf16*)(ws + RA_V); float* OF = (float*)(ws + RA_OF);
    const int l15 = lane & 15, l4 = lane >> 4;
    for (int item = vcu; item < 256; item += G) {
        const int vs = item & 3, dir = (item >> 2) & 1, h = (item >> 3) & 3, b = item >> 5;
        f32x4 S[4];
#pragma unroll
        for (int tv = 0; tv < 4; ++tv) S[tv] = (f32x4){0.f, 0.f, 0.f, 0.f};
        v4u rq[6], rk[2], rv; float rdec = 0.f;
#define GL_LOAD(ch_) do { const int ch__ = (ch_); \
            if (ch__ >= 4) { const size_t t_ = ((((size_t)(dir * 8 + b) * 32 + (ch__ - 4)) * 4 + h) * 1024); \
                rq[0] = QG[t_ + tid]; rq[1] = QG[t_ + tid + 512]; rq[2] = QM[t_ + tid]; rq[3] = QM[t_ + tid + 512]; rq[4] = KM[t_ + tid]; rq[5] = KM[t_ + tid + 512]; } \
            { const size_t t_ = ((((size_t)(dir * 8 + b) * 36 + ch__) * 4 + h) * 1024); rk[0] = KD[t_ + tid]; rk[1] = KD[t_ + tid + 512]; } \
            { const int row_ = scan_row(b, dir, ch__ * 64 + (tid >> 3)); rv = *(const v4u*)(V + (size_t)row_ * 1024 + h * 256 + vs * 64 + 8 * (tid & 7)); } \
            if (tid < 128) rdec = DEC[((size_t)(dir * 8 + b) * 36 + ch__) * 512 + h * 128 + tid]; } while (0)
        GL_LOAD(0);
        for (int ch = 0; ch < 36; ++ch) {
            const bool lat = ch >= 4;
#pragma unroll
            for (int tv = 0; tv < 4; ++tv) { v2u p; p.x = pk2(S[tv][0], S[tv][1]); p.y = pk2(S[tv][2], S[tv][3]);
                *(LAS v2u*)(lds + GL_ST + (16 * tv + l15) * 272 + (16 * wave + 4 * l4) * 2) = p; }
            if (lat) {
#pragma unroll
                for (int q = 0; q < 2; ++q) { const int p = tid + 512 * q; const int off = (p >> 4) * 272 + (p & 15) * 16;
                    *(LAS v4u*)(lds + GL_QG + off) = rq[q]; *(LAS v4u*)(lds + GL_QM + off) = rq[2 + q]; *(LAS v4u*)(lds + GL_KM + off) = rq[4 + q]; } }
#pragma unroll
            for (int q = 0; q < 2; ++q) { const int p = tid + 512 * q; *(LAS v4u*)(lds + GL_KDT + (p >> 3) * 144 + (p & 7) * 16) = rk[q]; }
            { const int i = tid >> 3, c = tid & 7; LAS bf16* vt = (LAS bf16*)(lds + GL_VT) + i;
              vt[(8 * c + 0) * 72] = (bf16)(rv.x & 0xffffu); vt[(8 * c + 1) * 72] = (bf16)(rv.x >> 16); vt[(8 * c + 2) * 72] = (bf16)(rv.y & 0xffffu); vt[(8 * c + 3) * 72] = (bf16)(rv.y >> 16);
              vt[(8 * c + 4) * 72] = (bf16)(rv.z & 0xffffu); vt[(8 * c + 5) * 72] = (bf16)(rv.z >> 16); vt[(8 * c + 6) * 72] = (bf16)(rv.w & 0xffffu); vt[(8 * c + 7) * 72] = (bf16)(rv.w >> 16); }
            if (tid < 128) *(LAS float*)(lds + GL_DEC + tid * 4) = rdec;
            __syncthreads();
            if (ch + 1 < 36) GL_LOAD(ch + 1);
            if (lat) {
                { const int ti = wave >> 1; f32x4 c0 = (f32x4){0.f, 0.f, 0.f, 0.f}, c1 = c0; const int tj0 = (wave & 1) * 2;
#pragma unroll
                  for (int ks = 0; ks < 4; ++ks) { const int ko = (32 * ks + 8 * l4) * 2;
                      const bf16x8 bq = *(const LAS bf16x8*)(lds + GL_QM + (16 * ti + l15) * 272 + ko);
                      const bf16x8 a0 = *(const LAS bf16x8*)(lds + GL_KM + (16 * tj0 + l15) * 272 + ko), a1 = *(const LAS bf16x8*)(lds + GL_KM + (16 * tj0 + 16 + l15) * 272 + ko);
                      c0 = __builtin_amdgcn_mfma_f32_16x16x32_bf16(a0, bq, c0, 0, 0, 0); c1 = __builtin_amdgcn_mfma_f32_16x16x32_bf16(a1, bq, c1, 0, 0, 0); }
                  const int i = 16 * ti + l15;
                  { const int j0 = 16 * tj0 + 4 * l4; v2u p; p.x = pk2(j0 <= i ? c0[0] : 0.f, j0 + 1 <= i ? c0[1] : 0.f); p.y = pk2(j0 + 2 <= i ? c0[2] : 0.f, j0 + 3 <= i ? c0[3] : 0.f);
                    *(LAS v2u*)(lds + GL_AM + i * 144 + j0 * 2) = p; }
                  { const int j0 = 16 * tj0 + 16 + 4 * l4; v2u p; p.x = pk2(j0 <= i ? c1[0] : 0.f, j0 + 1 <= i ? c1[1] : 0.f); p.y = pk2(j0 + 2 <= i ? c1[2] : 0.f, j0 + 3 <= i ? c1[3] : 0.f);
                    *(LAS v2u*)(lds + GL_AM + i * 144 + j0 * 2) = p; } }
                __syncthreads();
                { const int ti = wave >> 1, tv0 = (wave & 1) * 2; f32x4 c0 = (f32x4){0.f, 0.f, 0.f, 0.f}, c1 = c0;
#pragma unroll
                  for (int ks = 0; ks < 4; ++ks) { const int ko = (32 * ks + 8 * l4) * 2;
                      const bf16x8 bq = *(const LAS bf16x8*)(lds + GL_QG + (16 * ti + l15) * 272 + ko);
                      const bf16x8 a0 = *(const LAS bf16x8*)(lds + GL_ST + (16 * tv0 + l15) * 272 + ko), a1 = *(const LAS bf16x8*)(lds + GL_ST + (16 * tv0 + 16 + l15) * 272 + ko);
                      c0 = __builtin_amdgcn_mfma_f32_16x16x32_bf16(a0, bq, c0, 0, 0, 0); c1 = __builtin_amdgcn_mfma_f32_16x16x32_bf16(a1, bq, c1, 0, 0, 0); }
#pragma unroll
                  for (int ks = 0; ks < 2; ++ks) { const int ko = (32 * ks + 8 * l4) * 2;
                      const bf16x8 bq = *(const LAS bf16x8*)(lds + GL_AM + (16 * ti + l15) * 144 + ko);
                      const bf16x8 a0 = *(const LAS bf16x8*)(lds + GL_VT + (16 * tv0 + l15) * 144 + ko), a1 = *(const LAS bf16x8*)(lds + GL_VT + (16 * tv0 + 16 + l15) * 144 + ko);
                      c0 = __builtin_amdgcn_mfma_f32_16x16x32_bf16(a0, bq, c0, 0, 0, 0); c1 = __builtin_amdgcn_mfma_f32_16x16x32_bf16(a1, bq, c1, 0, 0, 0); }
                  const int s = ch * 64 + 16 * ti + l15; const int t0 = s - 256; const int t = dir ? 2047 - t0 : t0;
                  float* orow = OF + ((size_t)dir * NT + b * 2048 + t) * 1024 + h * 256 + vs * 64 + 16 * tv0 + 4 * l4;
                  *(f32x4*)(orow) = c0; *(f32x4*)(orow + 16) = c1; }
            }
            { const f32x4 d4 = *(const LAS f32x4*)(lds + GL_DEC + (16 * wave + 4 * l4) * 4);
#pragma unroll
              for (int tv = 0; tv < 4; ++tv) S[tv] = S[tv] * d4;
#pragma unroll
              for (int ks = 0; ks < 2; ++ks) { const int ko = (32 * ks + 8 * l4) * 2;
                  const bf16x8 ak = *(const LAS bf16x8*)(lds + GL_KDT + (16 * wave + l15) * 144 + ko);
#pragma unroll
                  for (int tv = 0; tv < 4; ++tv) { const bf16x8 bv = *(const LAS bf16x8*)(lds + GL_VT + (16 * tv + l15) * 144 + ko);
                      S[tv] = __builtin_amdgcn_mfma_f32_16x16x32_bf16(ak, bv, S[tv], 0, 0, 0); } } }
            __syncthreads();
        }
#undef GL_LOAD
    }
}

template <int HALFW>
__device__ __forceinline__ void pool_item(const bf16* P, bf16* DP, LAS float* tmp, int tid, int b, int r, int g) {
    const int rlo = r - HALFW < 0 ? 0 : r - HALFW, rhi = r + HALFW > 32 ? 32 : r + HALFW;
    const float rinv = 1.f / (float)(rhi - rlo);
#pragma unroll 1
    for (int q = 0; q < 4; ++q) { const int p = tid + 512 * q, c = p >> 5, ch0 = (p & 31) * 8; float acc[8]; v4u x[2 * HALFW];
#pragma unroll
        for (int u = 0; u < 2 * HALFW; ++u) { const int rr = (rlo + u < rhi) ? rlo + u : rlo; x[u] = *(const v4u*)(P + ((size_t)(b * 2048 + rr * 64 + c)) * 1024 + g * 256 + ch0); }
#pragma unroll
        for (int j = 0; j < 8; ++j) acc[j] = 0.f;
#pragma unroll
        for (int u = 0; u < 2 * HALFW; ++u) { const float m = (rlo + u < rhi) ? 1.f : 0.f;
            acc[0] += m * bflo(x[u].x); acc[1] += m * bfhi(x[u].x); acc[2] += m * bflo(x[u].y); acc[3] += m * bfhi(x[u].y); acc[4] += m * bflo(x[u].z); acc[5] += m * bfhi(x[u].z); acc[6] += m * bflo(x[u].w); acc[7] += m * bfhi(x[u].w); }
        *(LAS f32x4*)(tmp + c * 256 + ch0) = (f32x4){acc[0] * rinv, acc[1] * rinv, acc[2] * rinv, acc[3] * rinv};
        *(LAS f32x4*)(tmp + c * 256 + ch0 + 4) = (f32x4){acc[4] * rinv, acc[5] * rinv, acc[6] * rinv, acc[7] * rinv}; }
    __syncthreads();
#pragma unroll 1
    for (int q = 0; q < 4; ++q) { const int p = tid + 512 * q, c = p >> 5, ch0 = (p & 31) * 8;
        const int clo = c - HALFW < 0 ? 0 : c - HALFW, chi = c + HALFW > 64 ? 64 : c + HALFW; const float cinv = 1.f / (float)(chi - clo);
        const size_t o = ((size_t)(b * 2048 + r * 64 + c)) * 1024 + g * 256 + ch0;
        const v4u x = *(const v4u*)(P + o);
        f32x4 a0 = (f32x4){0.f, 0.f, 0.f, 0.f}, a1 = a0;
#pragma unroll
        for (int u = 0; u < 2 * HALFW; ++u) { const int cc = (clo + u < chi) ? clo + u : clo; const float m = (clo + u < chi) ? 1.f : 0.f;
            a0 += *(const LAS f32x4*)(tmp + cc * 256 + ch0) * m; a1 += *(const LAS f32x4*)(tmp + cc * 256 + ch0 + 4) * m; }
        v4u d; d.x = pk2(a0[0] * cinv - bflo(x.x), a0[1] * cinv - bfhi(x.x)); d.y = pk2(a0[2] * cinv - bflo(x.y), a0[3] * cinv - bfhi(x.y));
        d.z = pk2(a1[0] * cinv - bflo(x.z), a1[1] * cinv - bfhi(x.z)); d.w = pk2(a1[2] * cinv - bflo(x.w), a1[3] * cinv - bfhi(x.w));
        *(v4u*)(DP + o) = d; }
    __syncthreads();
}
__device__ __forceinline__ void phase3_pool(const Args& a, LAS unsigned char* lds, int tid, int vcu, int G) {
    const bf16* P = (const bf16*)(a.ws + RA_P); bf16* DP = (bf16*)(a.ws + RA_DPOOL);
    LAS float* tmp = (LAS float*)lds;
    for (int item = vcu; item < 1024; item += G) {
        const int g = item >> 8, r = (item >> 3) & 31, b = item & 7;
        const int gg = 3 - g;
        if (gg == 0) pool_item<1>(P, DP, tmp, tid, b, r, gg); else if (gg == 1) pool_item<2>(P, DP, tmp, tid, b, r, gg); else if (gg == 2) pool_item<4>(P, DP, tmp, tid, b, r, gg); else pool_item<8>(P, DP, tmp, tid, b, r, gg);
    }
}

__device__ __forceinline__ void phase4_post(const Args& a, int lane, int wave, int vcu, int G) {
    const float* OF = (const float*)(a.ws + RA_OF); const float* OB = OF + (size_t)NT * 1024; const bf16* Rr = (const bf16*)(a.ws + RA_R); bf16* Y = (bf16*)(a.ws + RA_YMIX);
    const float* gn = a.in[15];
    for (int idx = vcu * 8 + wave; idx < NT * 4; idx += G * 8) {
        const int t = idx >> 2, h = idx & 3; const size_t o = (size_t)t * 1024 + h * 256 + 4 * lane;
        const f32x4 x = *(const f32x4*)(OF + o) + *(const f32x4*)(OB + o);
        const float ms = wave_sum(x[0] * x[0] + x[1] * x[1] + x[2] * x[2] + x[3] * x[3]) * (1.f / 256.f);
        const float sc = rsqrtf(ms + EPS);
        const f32x4 g4 = *(const f32x4*)(gn + h * 256 + 4 * lane);
        const v2u rr = *(const v2u*)(Rr + o);
        const float r0 = bflo(rr.x), r1 = bfhi(rr.x), r2 = bflo(rr.y), r3 = bfhi(rr.y);
        v2u q; q.x = pk2(x[0] * sc * g4[0] * silu_f(r0), x[1] * sc * g4[1] * silu_f(r1)); q.y = pk2(x[2] * sc * g4[2] * silu_f(r2), x[3] * sc * g4[3] * silu_f(r3));
        *(v2u*)(Y + (size_t)t * 2048 + h * 256 + 4 * lane) = q;
    }
}

__device__ __forceinline__ void phase6(const Args& a, LAS unsigned char* lds, int tid, int lane, int wave, int vcu, int G) {
    unsigned char* ws = a.ws;
    const float* mod = (const float*)(ws + WS_MOD); const bf16* Y1 = (const bf16*)(ws + RA_Y1); unsigned char* H2 = ws + RA_H2;
    const float* gpost = a.in[7]; const float* gpre2 = a.in[8]; const float* rbias = a.in[20];
    const bf16* whi = (const bf16*)(ws + WS_WRT); const bf16* wlo = whi + 64 * 2048;
    LAS float* part = (LAS float*)lds;
    LAS float* logit = (LAS float*)(lds + LDS_LOGIT);
    LAS u64* masks = (LAS u64*)(lds + LDS_MASKS);
    int* cnt = (int*)(ws + T_CNT); u64* tmask = (u64*)(ws + T_MASK); float* tokw = (float*)(ws + T_TOKW);
    const int l15 = lane & 15, l4 = lane >> 4;
    for (int blk = vcu; blk < NT / 64; blk += G) {
        for (int it = 0; it < 4; ++it) {
#pragma unroll 1
            for (int rr = 0; rr < 2; ++rr) {
                const int lr = wave * 2 + rr, t = blk * 64 + it * 16 + lr; const float* mr = mod + (size_t)(t >> 11) * 12288;
                const bf16* yr = Y1 + (size_t)t * 2048; const float* xr = a.in[0] + (size_t)t * 2048; float* outr = (float*)(ws + WS_X1) + (size_t)t * 2048;
                f32x4 y[8]; float ss = 0.f;
#pragma unroll
                for (int j = 0; j < 8; ++j) { const v2u yb = *(const v2u*)(yr + 4 * (lane + 64 * j)); y[j] = (f32x4){bflo(yb.x), bfhi(yb.x), bflo(yb.y), bfhi(yb.y)}; ss += y[j][0] * y[j][0] + y[j][1] * y[j][1] + y[j][2] * y[j][2] + y[j][3] * y[j][3]; }
                const float rstd1 = rsqrtf(wave_sum(ss) * (1.f / 2048.f) + EPS);
                float s2 = 0.f;
#pragma unroll
                for (int j = 0; j < 8; ++j) { const int c = 4 * (lane + 64 * j); const f32x4 x = *(const f32x4*)(xr + c), gp = *(const f32x4*)(gpost + c), gt = *(const f32x4*)(mr + 4096 + c);
                    const f32x4 x1 = x + gt * (y[j] * rstd1 * gp); y[j] = x1; *(f32x4*)(outr + c) = x1;
                    s2 += x1[0] * x1[0] + x1[1] * x1[1] + x1[2] * x1[2] + x1[3] * x1[3]; }
                const float rstd2 = rsqrtf(wave_sum(s2) * (1.f / 2048.f) + EPS);
#pragma unroll
                for (int j = 0; j < 8; ++j) { const int c = 4 * (lane + 64 * j); const f32x4 g2 = *(const f32x4*)(gpre2 + c), sh = *(const f32x4*)(mr + 6144 + c), sc = *(const f32x4*)(mr + 8192 + c);
                    const f32x4 hh = y[j] * rstd2 * g2 * (sc + 1.f) + sh;
                    unsigned hi[4], lo[4];
#pragma unroll
                    for (int q = 0; q < 4; ++q) { hi[q] = f2bf(hh[q]); lo[q] = f2bf(hh[q] - __builtin_bit_cast(float, hi[q] << 16)); }
                    v2u qh, ql; qh.x = hi[0] | (hi[1] << 16); qh.y = hi[2] | (hi[3] << 16); ql.x = lo[0] | (lo[1] << 16); ql.y = lo[2] | (lo[3] << 16);
                    *(LAS v2u*)(lds + RT_HI + lr * RT_ROWB + c * 2) = qh; *(LAS v2u*)(lds + RT_LO + lr * RT_ROWB + c * 2) = ql;
                    *(unsigned*)(H2 + (size_t)t * 2048 + c) = pk4_fp8(hh[0] * SC_H, hh[1] * SC_H, hh[2] * SC_H, hh[3] * SC_H); }
            }
            __syncthreads();
            { f32x4 acc[4];
#pragma unroll
              for (int et = 0; et < 4; ++et) acc[et] = (f32x4){0.f, 0.f, 0.f, 0.f};
#pragma unroll 1
              for (int ks = 0; ks < 8; ++ks) { const int k0 = 256 * wave + 32 * ks + 8 * l4;
                  const bf16x8 ah = *(const LAS bf16x8*)(lds + RT_HI + l15 * RT_ROWB + k0 * 2), al = *(const LAS bf16x8*)(lds + RT_LO + l15 * RT_ROWB + k0 * 2);
#pragma unroll
                  for (int et = 0; et < 4; ++et) { const bf16x8 bh = *(const bf16x8*)(whi + (size_t)(16 * et + l15) * 2048 + k0), bl = *(const bf16x8*)(wlo + (size_t)(16 * et + l15) * 2048 + k0);
                      acc[et] = __builtin_amdgcn_mfma_f32_16x16x32_bf16(ah, bh, acc[et], 0, 0, 0);
                      acc[et] = __builtin_amdgcn_mfma_f32_16x16x32_bf16(ah, bl, acc[et], 0, 0, 0);
                      acc[et] = __builtin_amdgcn_mfma_f32_16x16x32_bf16(al, bh, acc[et], 0, 0, 0); } }
              __syncthreads();
#pragma unroll
              for (int et = 0; et < 4; ++et)
#pragma unroll
                  for (int q = 0; q < 4; ++q) part[(wave * 16 + 4 * l4 + q) * 64 + 16 * et + l15] = acc[et][q]; }
            __syncthreads();
#pragma unroll
            for (int q = 0; q < 2; ++q) { const int idx = tid + 512 * q; float sacc = 0.f;
#pragma unroll
                for (int w = 0; w < 8; ++w) sacc += part[w * 1024 + idx];
                logit[idx] = sacc; }
            __syncthreads();
#pragma unroll 1
            for (int rr = 0; rr < 2; ++rr) {
                const int lr = wave * 2 + rr, t = blk * 64 + it * 16 + lr;
                const float lg = logit[lr * 64 + lane]; const float s = 1.f / (1.f + __expf(-lg)); const float sel = s + rbias[lane];
                float m1 = sel; m1 = fmaxf(m1, __shfl_xor(m1, 1)); m1 = fmaxf(m1, __shfl_xor(m1, 2)); m1 = fmaxf(m1, __shfl_xor(m1, 4));
                const u64 eq = __ballot(sel == m1); const unsigned gb = (unsigned)(eq >> (lane & ~7)) & 0xffu; const int first = __builtin_ctz(gb);
                float v2 = ((lane & 7) == first) ? -INFINITY : sel; v2 = fmaxf(v2, __shfl_xor(v2, 1)); v2 = fmaxf(v2, __shfl_xor(v2, 2)); v2 = fmaxf(v2, __shfl_xor(v2, 4));
                const float gs = m1 + v2; const int g = lane >> 3; int grank = 0;
#pragma unroll
                for (int g2 = 0; g2 < 8; ++g2) { const float o = __shfl(gs, g2 * 8); grank += (o > gs || (o == gs && g2 < g)) ? 1 : 0; }
                const bool gsel = grank < 4; const float mk = gsel ? sel : -INFINITY; int rank = 0;
                for (int e2 = 0; e2 < 64; ++e2) { const float o = __shfl(mk, e2); rank += (o > mk || (o == mk && e2 < lane)) ? 1 : 0; }
                const bool chosen = gsel && rank < 8;
                const u64 mask = __ballot(chosen); const float ssum = wave_sum(chosen ? s : 0.f);
                const int kidx = __popcll(mask & ((1ull << lane) - 1ull));
                if (chosen) tokw[(size_t)t * 8 + kidx] = s / ssum * 2.5f;
                if (lane == 0) { tmask[t] = mask; masks[it * 16 + lr] = mask; }
            }
            __syncthreads();
        }
        if (wave == 0) { const u64 m = masks[lane]; int mine = 0;
            for (int e = 0; e < 64; ++e) { const int c = __popcll(__ballot((m >> e) & 1ull)); mine = (lane == e) ? c : mine; }
            cnt[blk * 64 + lane] = mine; }
        __syncthreads();
    }
}

__device__ __forceinline__ void phase7(const Args& a, LAS unsigned char* lds, int tid, int lane, int wave, int vcu, int G) {
    unsigned char* ws = a.ws;
    const int* cnt = (const int*)(ws + T_CNT); const u64* tmask = (const u64*)(ws + T_MASK); const float* tokw = (const float*)(ws + T_TOKW);
    int* tokslot = (int*)(ws + T_TOKSLOT); int* slottok = (int*)(ws + T_SLOTTOK); float* slotw = (float*)(ws + T_SLOTW); int* tile = (int*)(ws + T_TILE);
    LAS int* part = (LAS int*)lds;
    LAS int* tot = (LAS int*)(lds + 4096);
    for (int blk = vcu; blk < NT / 64; blk += G) {
        int pre = 0, all = 0;
        for (int b2 = wave; b2 < 256; b2 += 8) { const int c = cnt[b2 * 64 + lane]; all += c; pre += (b2 < blk) ? c : 0; }
        part[(wave * 2) * 64 + lane] = pre; part[(wave * 2 + 1) * 64 + lane] = all;
        __syncthreads();
        if (wave == 0) {
            int p = 0, t = 0;
#pragma unroll
            for (int w = 0; w < 8; ++w) { p += part[(w * 2) * 64 + lane]; t += part[(w * 2 + 1) * 64 + lane]; }
            int incl = t;
#pragma unroll
            for (int o = 1; o < 64; o <<= 1) { const int v = __shfl_up(incl, o); if (lane >= o) incl += v; }
            const int start = incl - t; const int base = start + p;
            tot[lane] = t; tot[64 + lane] = start;
            const int tokn = blk * 64 + lane; const u64 m = tmask[tokn];
            for (int e = 0; e < 64; ++e) { const bool bit = (m >> e) & 1ull; const u64 bal = __ballot(bit); const int be = __shfl(base, e);
                if (bit) { const int rank = __popcll(bal & ((1ull << lane) - 1ull)); const int slot = be + rank; const int k = __popcll(m & ((1ull << e) - 1ull));
                    slottok[slot] = tokn; slotw[slot] = tokw[(size_t)tokn * 8 + k]; tokslot[(size_t)tokn * 8 + k] = slot; } }
            slottok[SH_ROW0 + tokn] = tokn; slotw[SH_ROW0 + tokn] = 1.f;
        }
        __syncthreads();
        if (blk == 0 && tid == 0) {
            int n = 0;
            for (int e = 0; e < 64; ++e) { const int te = tot[e], st = tot[64 + e];
                for (int j = 0; j * 256 < te; ++j) { tile[n] = e; tile[NTILE_MAX + n] = st + j * 256; tile[2 * NTILE_MAX + n] = (te - j * 256) < 256 ? (te - j * 256) : 256; ++n; } }
            for (int j = 0; j < 64; ++j) { tile[n] = 64; tile[NTILE_MAX + n] = SH_ROW0 + j * 256; tile[2 * NTILE_MAX + n] = 256; ++n; }
            tile[3 * NTILE_MAX] = n;
        }
        __syncthreads();
    }
}

__device__ __forceinline__ void phase10(const Args& a, LAS unsigned char* lds, int lane, int wave, int vcu, int G) {
    unsigned char* ws = a.ws;
    const float* mod = (const float*)(ws + WS_MOD); const unsigned char* SO = ws + WS_SLOTOUT; const int* tokslot = (const int*)(ws + T_TOKSLOT); const float* gp = a.in[9];
    LAS float* ysc = (LAS float*)(lds + wave * 8192);
    for (int t = vcu * 8 + wave; t < NT; t += G * 8) {
        const float* mr = mod + (size_t)(t >> 11) * 12288;
        const int myslot = lane < 8 ? tokslot[(size_t)t * 8 + lane] : SH_ROW0 + t;
        v4u x[9][2]; f32x4 xo[8]; const float* x1r = (const float*)(ws + WS_X1) + (size_t)t * 2048;
#pragma unroll
        for (int k = 0; k < 9; ++k) { const int slot = __shfl(myslot, k); const unsigned char* sr = SO + (size_t)slot * 2048;
#pragma unroll
            for (int j = 0; j < 2; ++j) x[k][j] = *(const v4u*)(sr + 16 * (lane + 64 * j)); }
#pragma unroll
        for (int j = 0; j < 8; ++j) xo[j] = *(const f32x4*)(x1r + 4 * (lane + 64 * j));
        float y[2][16];
#pragma unroll
        for (int j = 0; j < 2; ++j)
#pragma unroll
            for (int q = 0; q < 16; ++q) y[j][q] = 0.f;
#pragma unroll
        for (int k = 0; k < 9; ++k)
#pragma unroll
            for (int j = 0; j < 2; ++j) { const v4u v = x[k][j];
#pragma unroll
                for (int w = 0; w < 4; ++w) { const unsigned d = v[w]; const auto lo = __builtin_amdgcn_cvt_pk_f32_fp8(d, false), hi = __builtin_amdgcn_cvt_pk_f32_fp8(d, true);
                    y[j][4 * w] += lo[0]; y[j][4 * w + 1] += lo[1]; y[j][4 * w + 2] += hi[0]; y[j][4 * w + 3] += hi[1]; } }
        float ss = 0.f;
#pragma unroll
        for (int j = 0; j < 2; ++j)
#pragma unroll
            for (int q = 0; q < 16; ++q) ss += y[j][q] * y[j][q];
        const float rstd = rsqrtf(wave_sum(ss) * (1.f / 2048.f) + EPS * SC_O * SC_O);
#pragma unroll
        for (int j = 0; j < 2; ++j)
#pragma unroll
            for (int q = 0; q < 4; ++q) *(LAS f32x4*)(ysc + 16 * (lane + 64 * j) + 4 * q) = (f32x4){y[j][4 * q], y[j][4 * q + 1], y[j][4 * q + 2], y[j][4 * q + 3]};
        LDS_WAIT(); asm volatile("" ::: "memory");
        float* outr = a.out + (size_t)t * 2048;
#pragma unroll
        for (int j = 0; j < 8; ++j) { const int c = 4 * (lane + 64 * j); const f32x4 yy = *(const LAS f32x4*)(ysc + c), g = *(const f32x4*)(gp + c), gt = *(const f32x4*)(mr + 10240 + c);
            *(f32x4*)(outr + c) = xo[j] + gt * (yy * rstd * g); }
        LDS_WAIT(); asm volatile("" ::: "memory");
    }
}

__global__ void __launch_bounds__(512, 2) fwd(Args args) {
    extern __shared__ __attribute__((aligned(16))) unsigned char lds_raw[];
    LAS unsigned char* lds = (LAS unsigned char*)lds_raw;
    const int tid = threadIdx.x, lane = tid & 63, wave = __builtin_amdgcn_readfirstlane(tid >> 6);
    const int G = gridDim.x, bx = blockIdx.x;
    const int vcu = (G % 8 == 0) ? (bx % 8) * (G / 8) + bx / 8 : bx;
    unsigned char* ws = args.ws;
    volatile LAS unsigned* MISC = (volatile LAS unsigned*)(lds + LDS_MISC);
    if (tid < 64) MISC[tid] = 0u;
    __syncthreads();
    const int lo = args.ph_lo, hi = args.ph_hi;
    XcdBarrier bar; bar.bar = (unsigned*)(ws + WS_CTL) + 4096; bar.x = 0; bar.st = nullptr;
    if (hi - lo > 1) bar = xcd_barrier_post((unsigned*)(ws + WS_CTL) + 4096, MISC + 8);
#ifndef PH_MASK
#define PH_MASK 0xfff
#endif
#define IN(k) (((PH_MASK >> (k)) & 1) && lo <= (k) && (k) < hi)
#define SEAM(k) do { if (IN(k) && IN((k) + 1)) xcd_barrier(bar); } while (0)

#ifndef REP_PHASE
#define REP_PHASE -1
#endif
#define RUNPH(k, ...) do { if (IN(k)) { __VA_ARGS__ if (REP_PHASE == (k)) { xcd_barrier(bar); __VA_ARGS__ } SEAM(k); } } while (0)
    RUNPH(0, phase0(args, lds, tid, lane, wave, vcu, G););
    RUNPH(1, phase1(args, lane, wave, vcu, G););
    RUNPH(2, {
        DenseSched S; S.init(ws + RA_H, ws + WS_WIN, 2048, 2048, MROWS, DINP, G, bx);
        EpiIn E{ws};
        pg8::gemm_phase<EpiIn, DenseSched>(lds, 2048, S, E); });
    RUNPH(3, phase3_prep(args, lds, tid, vcu, G); phase3_pool(args, lds, tid, vcu, G););
    RUNPH(4, phase_chain(args, lds, tid, lane, wave, vcu, G););
    RUNPH(5, {
        phase4_post(args, lane, wave, vcu, G);
        PoolSched S{(const char*)(ws + RA_DPOOL), (const char*)(ws + WS_WPOOL), G, vcu};
        EpiPool E{(bf16*)(ws + RA_YMIX), args.in[17]};
        int kpool = 256; asm volatile("" : "+s"(kpool));
        pg8::gemm_phase<EpiPool, PoolSched>(lds, kpool, S, E); });
    RUNPH(6, {
        DenseSched S; S.init(ws + RA_YMIX, ws + WS_WOUT, 2048, 2048, NT, 2048, G, bx);
        EpiOut E{(bf16*)(ws + RA_Y1)};
        pg8::gemm_phase<EpiOut, DenseSched>(lds, 2048, S, E); });
    RUNPH(7, phase6(args, lds, tid, lane, wave, vcu, G););
    RUNPH(8, phase7(args, lds, tid, lane, wave, vcu, G););
    RUNPH(9, {
        MoeGUSched S{(const char*)(ws + RA_H2), (const char*)(ws + WS_WGU), (const int*)(ws + T_TILE), (const int*)(ws + T_SLOTTOK), G, vcu};
        EpiGU E{ws + WS_ACT, (const float*)(ws + T_SLOTW)};
        int kgu = 1024; asm volatile("" : "+s"(kgu));
        pg8::gemm_phase<EpiGU, MoeGUSched, true>(lds, kgu, S, E); });
    RUNPH(10, {
        MoeDownSched S{(const char*)(ws + WS_ACT), (const char*)(ws + WS_WD), (const int*)(ws + T_TILE), G, vcu};
        EpiDown E{ws + WS_SLOTOUT};
        int kdn = 256; asm volatile("" : "+s"(kdn));
        pg8::gemm_phase<EpiDown, MoeDownSched, true>(lds, kdn, S, E); });
    if (IN(11)) { phase10(args, lds, lane, wave, vcu, G); if (REP_PHASE == 11) { xcd_barrier(bar); phase10(args, lds, lane, wave, vcu, G); } }
#undef IN
#undef SEAM
}

extern "C" void kernel_launch(void* const* d_in, const int* in_sizes, int n_in, void* d_out, int out_size, void* d_ws, size_t ws_size, hipStream_t stream) {
    static int grid = 0;
    if (grid == 0) {
        if (n_in != 27 || out_size != NT * DM || ws_size < WS_NEED) { fprintf(stderr, "kernel_launch: unexpected problem: n_in %d out %d ws %zu (need %zu)\n", n_in, out_size, ws_size, (size_t)WS_NEED); grid = -1; return; }
        int dev = 0, cus = 0, per_cu = 0;
        if (hipGetDevice(&dev) != hipSuccess || hipDeviceGetAttribute(&cus, hipDeviceAttributeMultiprocessorCount, dev) != hipSuccess) { grid = -1; return; }
        if (hipFuncSetAttribute((const void*)fwd, hipFuncAttributeMaxDynamicSharedMemorySize, LDS_BYTES) != hipSuccess) { fprintf(stderr, "kernel_launch: hipFuncSetAttribute failed\n"); grid = -1; return; }
        if (hipOccupancyMaxActiveBlocksPerMultiprocessor(&per_cu, (const void*)fwd, 512, LDS_BYTES) != hipSuccess || per_cu < 1) { fprintf(stderr, "kernel_launch: occupancy query says %d\n", per_cu); }
        (void)hipGetLastError();
        grid = cus;
    }
    if (grid < 0) return;
    (void)hipMemsetAsync((char*)d_ws + WS_CTL, 0, CTL_ZERO_BYTES, stream);
    Args a{};
    for (int i = 0; i < 27; ++i) a.in[i] = (const float*)d_in[i];
    a.out = (float*)d_out; a.ws = (unsigned char*)d_ws;
    if (N_LAUNCHES == 1) {
        a.ph_lo = 0; a.ph_hi = NPH;
        hipLaunchKernelGGL(fwd, dim3(grid), dim3(512), LDS_BYTES, stream, a);
    } else {
        for (int p = 0; p < NPH; ++p) { a.ph_lo = p; a.ph_hi = p + 1; hipLaunchKernelGGL(fwd, dim3(grid), dim3(512), LDS_BYTES, stream, a); }
    }
}
```

```cpp
#include <hip/hip_runtime.h>
#include <cstdio>
#include <cstdint>

#ifndef N_LAUNCHES
#define N_LAUNCHES 1
#endif

#define GAS __attribute__((address_space(1)))
#define LAS __attribute__((address_space(3)))
typedef unsigned short bf16;
typedef unsigned v4u __attribute__((ext_vector_type(4)));
typedef unsigned v2u __attribute__((ext_vector_type(2)));
typedef float f32x4 __attribute__((ext_vector_type(4)));
typedef short bf16x8 __attribute__((ext_vector_type(8)));
typedef unsigned long long u64;

constexpr int NB = 8, SEQ = 2048, DM = 2048, CTXL = 256;
constexpr int NT = NB * SEQ;
constexpr int NTC = NB * CTXL;
constexpr int MROWS = NT + NTC;
constexpr int DIN = 4128, DINP = 4352;
constexpr int NE = 64, TOPK = 8, DE = 512;
constexpr int NSLOT_E = NT * TOPK;
constexpr int SH_ROW0 = NSLOT_E + 256;
constexpr int NSLOT = SH_ROW0 + NT;
constexpr int NTILE_MAX = 704;
constexpr float EPS = 1e-6f;
constexpr int NPH = 12;

constexpr size_t MiB = 1u << 20;
constexpr size_t WS_CTL = 0, CTL_ZERO_BYTES = 64 * 1024;
constexpr size_t WS_MOD = 1 * MiB;
constexpr size_t WS_WRT = 1 * MiB + 512 * 1024;
constexpr size_t WS_WIN = 2 * MiB;
constexpr size_t WS_WOUT = WS_WIN + 17 * MiB;
constexpr size_t WS_WPOOL = WS_WOUT + 8 * MiB;
constexpr size_t WS_WD = WS_WPOOL + 1 * MiB;
constexpr size_t WS_WGU = WS_WD + 130 * MiB;
constexpr size_t WS_RA = WS_WGU + 260 * MiB;
constexpr size_t RA_H = WS_RA;
constexpr size_t RA_OF = WS_RA;
constexpr size_t RA_H2 = WS_RA;
constexpr size_t RA_Q = WS_RA + 128 * MiB;
constexpr size_t RA_K = RA_Q + 16 * MiB;
constexpr size_t RA_V = RA_K + 18 * MiB;
constexpr size_t RA_R = RA_V + 36 * MiB;
constexpr size_t RA_P = RA_R + 32 * MiB;
constexpr size_t RA_ALR = RA_P + 32 * MiB;
constexpr size_t RA_DPOOL = RA_ALR + 3 * MiB;
constexpr size_t RA_YMIX = RA_DPOOL + 32 * MiB;
constexpr size_t RA_Y1 = WS_RA + 128 * MiB;
constexpr size_t RA_END = RA_YMIX + 64 * MiB;
constexpr size_t WS_SLOTOUT = WS_WGU;
constexpr size_t WS_ACT = RA_END > WS_SLOTOUT + 578 * MiB ? RA_END : WS_SLOTOUT + 578 * MiB;
constexpr size_t WS_END = WS_ACT + 145 * MiB;
constexpr size_t PQG = WS_ACT;
constexpr size_t PQM = WS_ACT + 32 * MiB;
constexpr size_t PKM = WS_ACT + 64 * MiB;
constexpr size_t PKD = WS_ACT + 96 * MiB;
constexpr size_t PDEC = WS_ACT + 132 * MiB;
constexpr size_t WS_T0 = WS_END;
constexpr size_t T_CNT = WS_T0;
constexpr size_t T_MASK = T_CNT + 65536;
constexpr size_t T_TOKW = T_MASK + 131072;
constexpr size_t T_TOKSLOT = T_TOKW + 524288;
constexpr size_t T_SLOTTOK = T_TOKSLOT + 524288;
constexpr size_t T_SLOTW = T_SLOTTOK + 655360;
constexpr size_t T_TILE = T_SLOTW + 655360;
constexpr size_t T_RSTD1 = (T_TILE + 16384 + 4095) / 4096 * 4096;
constexpr size_t WS_NEED = T_RSTD1 + (size_t)NT * 4;

constexpr int RING_BYTES = 131072;
constexpr int LDS_BYTES = 147456;
constexpr int LDS_MISC = LDS_BYTES - 256;
constexpr int RT_ROWB = 4112;
constexpr int RT_HI = 0, RT_LO = 16 * RT_ROWB;
constexpr int LDS_LOGIT = 2 * 16 * RT_ROWB;
constexpr int LDS_MASKS = LDS_LOGIT + 4096;
static_assert(LDS_MASKS + 512 <= LDS_MISC, "LDS map");

#define LDS_WAIT() asm volatile("s_waitcnt lgkmcnt(0)" ::: "memory")
#define VM_WAIT() asm volatile("s_waitcnt vmcnt(0)" ::: "memory")

__device__ __forceinline__ unsigned f2bf(float f) { unsigned u = __builtin_bit_cast(unsigned, f); return (u + 0x7fffu + ((u >> 16) & 1u)) >> 16; }
__device__ __forceinline__ unsigned pk2(float lo, float hi) { return f2bf(lo) | (f2bf(hi) << 16); }
__device__ __forceinline__ float bflo(unsigned u) { return __builtin_bit_cast(float, u << 16); }
__device__ __forceinline__ float bfhi(unsigned u) { return __builtin_bit_cast(float, u & 0xffff0000u); }
__device__ __forceinline__ float bf1(bf16 b) { return __builtin_bit_cast(float, ((unsigned)b) << 16); }
__device__ __forceinline__ float wave_sum(float v) {
#pragma unroll
    for (int o = 1; o < 64; o <<= 1) v += __shfl_xor(v, o);
    return v;
}
__device__ __forceinline__ float silu_f(float x) { return x / (1.f + __expf(-x)); }

#define XB_TMO      128
#define XB_XCNT(j)  (256  + 64 * (j))
#define XB_XSUB(j)  (1280 + 64 * (j))
#define XB_XGEN(j)  (2304 + 64 * (j))
#define XB_TOP      3328
#define XB_TOPGEN   3392
#define XCD_BAR_WORDS 3456
#define XB_SPIN_CAP (1u << 18)

__device__ __forceinline__ unsigned xb_ld(unsigned* p)              { return __hip_atomic_load(p, __ATOMIC_RELAXED, __HIP_MEMORY_SCOPE_AGENT); }
__device__ __forceinline__ unsigned xb_add(unsigned* p, unsigned v) { return __hip_atomic_fetch_add(p, v, __ATOMIC_RELAXED, __HIP_MEMORY_SCOPE_AGENT); }
__device__ __forceinline__ unsigned xb_xcc_id() { return (unsigned)__builtin_amdgcn_s_getreg((3 << 11) | 20) & 0xFu; }
#define XB_SPIN(cond, bar) do { unsigned _sp = 0; while (cond) { __builtin_amdgcn_s_sleep(1); \
    if ((++_sp & 255u) == 0u) { if (xb_ld(&(bar)[XB_TMO])) break; if (_sp > XB_SPIN_CAP) { atomicAdd(&(bar)[XB_TMO], 1u); break; } } } } while (0)

struct XcdBarrier { unsigned* bar; unsigned x; volatile LAS unsigned* st; };

__device__ __forceinline__ XcdBarrier xcd_barrier_post(unsigned* bar, volatile LAS unsigned* st) {
    XcdBarrier b; b.bar = bar; b.x = xb_xcc_id(); b.st = st;
    if (threadIdx.x == 0) (void)xb_add(&bar[XB_XCNT(b.x)], 1u);
    return b;
}
__device__ __forceinline__ void xcd_barrier_complete(unsigned* bar, unsigned x, unsigned& nloc, unsigned& nx) {
    const unsigned G = gridDim.x * gridDim.y * gridDim.z;
    unsigned sum, cnt, mine, sp = 0u;
    for (;;) {
        sum = 0u; cnt = 0u; mine = 0u;
#pragma unroll
        for (unsigned j = 0; j < 16; ++j) { const unsigned c = xb_ld(&bar[XB_XCNT(j)]); sum += c; cnt += (c > 0u) ? 1u : 0u; mine = (j == x) ? c : mine; }
        if (sum == G) break;
        __builtin_amdgcn_s_sleep(1);
        if ((++sp & 255u) == 0u) { if (xb_ld(&bar[XB_TMO])) break; if (sp > XB_SPIN_CAP) { atomicAdd(&bar[XB_TMO], 1u); break; } }
    }
    nloc = mine > 0u ? mine : 1u; nx = cnt > 0u ? cnt : 1u;
}
__device__ __forceinline__ void xcd_barrier(const XcdBarrier& b) {
    asm volatile("s_waitcnt vmcnt(0)" ::: "memory");
    __syncthreads();
    if (threadIdx.x == 0) {
        unsigned* bar = b.bar;
        __builtin_amdgcn_s_waitcnt(0);
        unsigned nloc = b.st[0], nx = b.st[1];
        if (nloc == 0u) { xcd_barrier_complete(bar, b.x, nloc, nx); b.st[0] = nloc; b.st[1] = nx; }
        const unsigned old = xb_add(&bar[XB_XSUB(b.x)], 1u);
        const unsigned gen = old / nloc;
        if (old + 1u == (gen + 1u) * nloc) {
            __builtin_amdgcn_fence(__ATOMIC_RELEASE, "agent");
            asm volatile("s_waitcnt vmcnt(0)" ::: "memory");
            const unsigned og = xb_add(&bar[XB_TOP], 1u);
            const unsigned tg = og / nx;
            if (og + 1u == (tg + 1u) * nx) xb_add(&bar[XB_TOPGEN], 1u);
            else XB_SPIN(xb_ld(&bar[XB_TOPGEN]) == tg, bar);
            __builtin_amdgcn_fence(__ATOMIC_ACQUIRE, "agent");
            xb_add(&bar[XB_XGEN(b.x)], 1u);
            asm volatile("s_waitcnt vmcnt(0)" ::: "memory");
        } else {
            XB_SPIN(xb_ld(&bar[XB_XGEN(b.x)]) == gen, bar);
            __builtin_amdgcn_fence(__ATOMIC_ACQUIRE, "agent");
            asm volatile("s_waitcnt vmcnt(0)" ::: "memory");
        }
    }
    __syncthreads();
}

namespace pg8 {
constexpr int BM = 256, BK = 64, HALF = 128, HTB = HALF * BK * 2, STAGE_BYTES = 8 * HTB, NXCD = 8, WGM = 8;
__device__ __forceinline__ int lds_byte(int r, int c) { const int st = (r >> 4) * 2 + (c >> 5), rr = r & 15, cc = c & 31, ob = rr * 64 + cc * 2; return st * 1024 + (ob ^ (((ob >> 9) & 1) << 5)); }
__device__ __forceinline__ void stage_rc(int b, int& R, int& C) { const int st = b / 1024, sb = b % 1024, swz = sb ^ (((sb >> 9) & 1) << 5); R = (st >> 1) * 16 + swz / 64; C = (st & 1) * 32 + (swz % 64) / 2; }
__device__ __forceinline__ int perm32(int rho) { const int n = rho >> 4, i = rho & 15; return 8 * (i >> 2) + 4 * n + (i & 3); }
__device__ __forceinline__ unsigned cvt_pk_bf16(float lo, float hi) { unsigned r; asm volatile("v_cvt_pk_bf16_f32 %0, %1, %2" : "=v"(r) : "v"(lo), "v"(hi)); return r; }

typedef int v8i __attribute__((ext_vector_type(8)));
typedef int v4i __attribute__((ext_vector_type(4)));
template <class Epi, class Sched, bool FP8 = false>
__device__ __forceinline__ void gemm_phase(LAS unsigned char* lds, const int K, const Sched& S, const Epi& E) {
    typedef typename Sched::U Unit;
    const int tid = threadIdx.x, wid = __builtin_amdgcn_readfirstlane(tid >> 6), lane = tid & 63, wr = wid >> 2, wc = wid & 3, fr = lane & 15, fq = lane >> 4;
    const int nt = K / BK;
    int R[2], C[2]; unsigned voffB[2];
#pragma unroll
    for (int i = 0; i < 2; ++i) { stage_rc(tid * 16 + i * 8192, R[i], C[i]);
        const int Rb = Epi::PERMK == 2 ? (64 * (R[i] >> 5) + 16 * ((R[i] & 15) >> 2) + 4 * ((R[i] >> 4) & 1) + (R[i] & 3)) : (Epi::PERMK == 1 ? ((R[i] & ~31) + perm32(R[i] & 31)) : R[i]);
        voffB[i] = (unsigned)(Rb * K + C[i]) * 2u; }
    const size_t kstep = (size_t)(BK * 2);
    const size_t hstepB = (size_t)(Epi::PERMK == 2 ? 8 : HALF) * K * 2;
    const unsigned ldsw = (unsigned)wid * 1024u;
    const int aoff = lds_byte(wr * 64 + fr, fq * 8), boff = lds_byte(wc * 32 + fr, fq * 8);
#define PG8_SA(b, h) (((b) * 2 + (h)) * HTB)
#define PG8_SB(b, h) ((4 + (b) * 2 + (h)) * HTB)
#define PG8_STAGE(bufoff, gbase, v0, v1) do { \
        __builtin_amdgcn_global_load_lds((const unsigned*)((const char*)(gbase) + (v0)), (LAS unsigned*)(lds + (bufoff) + ldsw), 16, 0, 0); \
        __builtin_amdgcn_global_load_lds((const unsigned*)((const char*)(gbase) + (v1)), (LAS unsigned*)(lds + (bufoff) + ldsw + 8192), 16, 0, 0); } while (0)
#define PG8_LDA(dst, b, h) do { _Pragma("unroll") for (int m = 0; m < 4; ++m) { const v4i lo_ = *(const LAS v4i*)(lds + PG8_SA(b, h) + aoff + m * 2048), hi_ = *(const LAS v4i*)(lds + PG8_SA(b, h) + aoff + m * 2048 + 1024); \
        dst[m] = __builtin_shufflevector(lo_, hi_, 0, 1, 2, 3, 4, 5, 6, 7); } } while (0)
#define PG8_LDB(dst, b, h) do { _Pragma("unroll") for (int n = 0; n < 2; ++n) { const v4i lo_ = *(const LAS v4i*)(lds + PG8_SB(b, h) + boff + n * 2048), hi_ = *(const LAS v4i*)(lds + PG8_SB(b, h) + boff + n * 2048 + 1024); \
        dst[n] = __builtin_shufflevector(lo_, hi_, 0, 1, 2, 3, 4, 5, 6, 7); } } while (0)
#define PG8_H0(x) ((bf16x8)__builtin_shufflevector(x, x, 0, 1, 2, 3))
#define PG8_H1(x) ((bf16x8)__builtin_shufflevector(x, x, 4, 5, 6, 7))
#define PG8_MMA(ai, bj, At, Bt) do { __builtin_amdgcn_s_setprio(1); if constexpr (FP8) asm volatile("s_nop 4"); _Pragma("unroll") for (int m = 0; m < 4; ++m) _Pragma("unroll") for (int n = 0; n < 2; ++n) { \
        if constexpr (FP8) asm volatile("v_mfma_f32_16x16x128_f8f6f4 %0, %1, %2, %0" : "+v"(acc[ai][bj][m][n]) : "v"(Bt[n]), "v"(At[m])); \
        else { acc[ai][bj][m][n] = __builtin_amdgcn_mfma_f32_16x16x32_bf16(PG8_H0(Bt[n]), PG8_H0(At[m]), acc[ai][bj][m][n], 0, 0, 0); \
               acc[ai][bj][m][n] = __builtin_amdgcn_mfma_f32_16x16x32_bf16(PG8_H1(Bt[n]), PG8_H1(At[m]), acc[ai][bj][m][n], 0, 0, 0); } } \
        __builtin_amdgcn_s_setprio(0); } while (0)
#define PG8_WAIT_V(n) asm volatile("s_waitcnt vmcnt(" #n ")" ::: "memory")
#define PG8_WAIT_L(n) asm volatile("s_waitcnt lgkmcnt(" #n ")" ::: "memory")
#define PG8_BAR __builtin_amdgcn_s_barrier()
#define PG8_SCHED __builtin_amdgcn_sched_barrier(0)
    Unit cur, nxt; int ui = 0;
    if (!S.next(0, cur)) return;
    f32x4 acc[2][2][4][2];
#pragma unroll
    for (int a = 0; a < 2; ++a)
#pragma unroll
        for (int b = 0; b < 2; ++b)
#pragma unroll
            for (int m = 0; m < 4; ++m)
#pragma unroll
                for (int n = 0; n < 2; ++n) acc[a][b][m][n] = (f32x4){0.f, 0.f, 0.f, 0.f};
    v8i At[4], B0[2], B1[2];
    unsigned vA[4], vN[4];
    S.aoffs(cur, R, C, vA);
    const char* cA = cur.A; const char* cB = cur.B;
    PG8_STAGE(PG8_SB(0, 0), cB, voffB[0], voffB[1]); PG8_STAGE(PG8_SB(0, 1), cB + hstepB, voffB[0], voffB[1]); PG8_STAGE(PG8_SA(0, 0), cA, vA[0], vA[1]); PG8_STAGE(PG8_SA(0, 1), cA, vA[2], vA[3]);
    if (wr == 1) PG8_BAR;
    PG8_WAIT_V(2); PG8_BAR;
    PG8_STAGE(PG8_SB(1, 0), cB + kstep, voffB[0], voffB[1]); PG8_STAGE(PG8_SA(1, 0), cA + kstep, vA[0], vA[1]); PG8_STAGE(PG8_SB(1, 1), cB + hstepB + kstep, voffB[0], voffB[1]);
    PG8_WAIT_V(6); PG8_BAR;
    for (;;) {
        const bool has_next = S.next(ui + 1, nxt);
        const char* nA = has_next ? nxt.A : cA; const char* nB = has_next ? nxt.B : cB;
        if (has_next) S.aoffs(nxt, R, C, vN); else { vN[0] = vA[0]; vN[1] = vA[1]; vN[2] = vA[2]; vN[3] = vA[3]; }
        for (int t = 0; t < nt; t += 2) {
            const bool last = (t == nt - 2);
            const char* a1 = cA + (size_t)(t + 1) * kstep;
            const char* a2 = last ? nA : cA + (size_t)(t + 2) * kstep; const char* b2 = last ? nB : cB + (size_t)(t + 2) * kstep;
            const char* a3 = a2 + kstep; const char* b3 = b2 + kstep;
            const unsigned x0 = last ? vN[0] : vA[0], x1 = last ? vN[1] : vA[1], x2 = last ? vN[2] : vA[2], x3 = last ? vN[3] : vA[3];
            PG8_LDB(B0, 0, 0); PG8_LDB(B1, 0, 1); PG8_SCHED; PG8_LDA(At, 0, 0); PG8_STAGE(PG8_SA(1, 1), a1, vA[2], vA[3]);
            PG8_WAIT_V(8); PG8_WAIT_L(0); PG8_BAR; PG8_MMA(0, 0, At, B0); PG8_MMA(0, 1, At, B1); PG8_BAR; PG8_SCHED;
            PG8_LDA(At, 0, 1); PG8_STAGE(PG8_SB(0, 0), b2, voffB[0], voffB[1]); PG8_STAGE(PG8_SB(0, 1), b2 + hstepB, voffB[0], voffB[1]); PG8_STAGE(PG8_SA(0, 0), a2, x0, x1);
            PG8_WAIT_V(8); PG8_WAIT_L(0); PG8_BAR; PG8_MMA(1, 0, At, B0); PG8_MMA(1, 1, At, B1); PG8_BAR; PG8_SCHED;
            PG8_LDB(B0, 1, 0); PG8_LDB(B1, 1, 1); PG8_SCHED; PG8_LDA(At, 1, 0); PG8_STAGE(PG8_SA(0, 1), a2, x2, x3);
            PG8_WAIT_V(8); PG8_WAIT_L(0); PG8_BAR; PG8_MMA(0, 0, At, B0); PG8_MMA(0, 1, At, B1); PG8_BAR; PG8_SCHED;
            PG8_LDA(At, 1, 1); PG8_STAGE(PG8_SB(1, 0), b3, voffB[0], voffB[1]); PG8_STAGE(PG8_SB(1, 1), b3 + hstepB, voffB[0], voffB[1]); PG8_STAGE(PG8_SA(1, 0), a3, x0, x1);
            PG8_WAIT_V(8); PG8_WAIT_L(0); PG8_BAR; PG8_MMA(1, 0, At, B0); PG8_MMA(1, 1, At, B1); PG8_BAR; PG8_SCHED;
        }
        if (wr == 0) PG8_BAR;
        if constexpr (FP8) asm volatile("s_nop 15\n\ts_nop 15");
        { int tz = threadIdx.x; asm volatile("" : "+v"(tz));
          const int wid_ = tz >> 6, lane_ = tz & 63; E(acc, cur, wid_ >> 2, wid_ & 3, lane_ & 15, lane_ >> 4);
#ifdef PROBE_EPI2
          if constexpr (Epi::PROBE2) { asm volatile("" : "+v"(tz)); const int w2 = tz >> 6, l2 = tz & 63; E(acc, cur, w2 >> 2, w2 & 3, l2 & 15, l2 >> 4); }
#endif
#ifdef PROBE_DRAIN
          if constexpr (Epi::PROBE2) { asm volatile("s_waitcnt vmcnt(0)" ::: "memory"); }
#endif
        }
        if (!has_next) break;
#pragma unroll
        for (int a = 0; a < 2; ++a)
#pragma unroll
            for (int b = 0; b < 2; ++b)
#pragma unroll
                for (int m = 0; m < 4; ++m)
#pragma unroll
                    for (int n = 0; n < 2; ++n) acc[a][b][m][n] = (f32x4){0.f, 0.f, 0.f, 0.f};
        cur = nxt; cA = nA; cB = nB; ++ui;
        vA[0] = vN[0]; vA[1] = vN[1]; vA[2] = vN[2]; vA[3] = vN[3];
        if (wr == 1) PG8_BAR;
    }
    PG8_WAIT_V(0);
    PG8_BAR;
#undef PG8_SA
#undef PG8_SB
#undef PG8_STAGE
#undef PG8_LDA
#undef PG8_LDB
#undef PG8_H0
#undef PG8_H1
#undef PG8_MMA
#undef PG8_WAIT_V
#undef PG8_WAIT_L
#undef PG8_BAR
#undef PG8_SCHED
}
}

struct Args { const float* in[27]; float* out; unsigned char* ws; int ph_lo, ph_hi; };
static_assert(sizeof(Args) == 27 * 8 + 8 + 8 + 8, "Args has no padding");

struct DenseU { const char* A; const char* B; int pm, pn; };
struct DenseSched {
    typedef DenseU U;
    const char* A; const char* B; int lda, K, nM, nN, nwg, G, c;
    __device__ __forceinline__ void init(const void* A_, const void* B_, int lda_, int K_, int M, int N, int G_, int c_) { A = (const char*)A_; B = (const char*)B_; lda = lda_; K = K_; nM = M / 256; nN = N / 256; nwg = nM * nN; G = G_; c = c_; }
    __device__ __forceinline__ bool next(int i, U& u) const {
        const long L = (long)i * G + c; if (L >= nwg) return false;
        int wgid = (int)L; { const int q = nwg / 8, r = nwg % 8, xcd = wgid % 8, off = wgid / 8; wgid = (xcd < r ? xcd * (q + 1) : r * (q + 1) + (xcd - r) * q) + off; }
        const int nig = 8 * nN, gid = wgid / nig, fm = gid * 8, gsz = (nM - fm) < 8 ? (nM - fm) : 8;
        u.pm = fm + ((wgid % nig) % gsz); u.pn = (wgid % nig) / gsz;
        u.A = A + (size_t)u.pm * 256 * lda * 2; u.B = B + (size_t)u.pn * 256 * K * 2; return true;
    }
    __device__ __forceinline__ void aoffs(const U&, const int (&R)[2], const int (&C)[2], unsigned (&v)[4]) const {
#pragma unroll
        for (int h = 0; h < 2; ++h)
#pragma unroll
            for (int i = 0; i < 2; ++i) v[h * 2 + i] = (unsigned)((h * 128 + R[i]) * lda + C[i]) * 2u;
    }
};
struct PoolU { const char* A; const char* B; int pm, g; };
struct PoolSched {
    typedef PoolU U;
    const char* A; const char* B; int G, c;
    __device__ __forceinline__ bool next(int i, U& u) const {
        const int L = i * G + c; if (L >= 256) return false;
        u.g = L & 3; u.pm = L >> 2;
        u.A = A + ((size_t)u.pm * 256 * 1024 + u.g * 256) * 2; u.B = B + (size_t)u.g * 256 * 256 * 2; return true;
    }
    __device__ __forceinline__ void aoffs(const U&, const int (&R)[2], const int (&C)[2], unsigned (&v)[4]) const {
#pragma unroll
        for (int h = 0; h < 2; ++h)
#pragma unroll
            for (int i = 0; i < 2; ++i) v[h * 2 + i] = (unsigned)((h * 128 + R[i]) * 1024 + C[i]) * 2u;
    }
};
struct MoeU { const char* A; const char* B; int row0, nrows, pn; };
struct MoeGUSched {
    typedef MoeU U;
    const char* H2; const char* W; const int* tile; const int* slot_tok; int G, c;
    __device__ __forceinline__ bool next(int i, U& u) const {
        const int nt = tile[3 * NTILE_MAX]; const int L = i * G + c; if (L >= nt * 4) return false;
        const int t = L >> 2; u.pn = L & 3; const int e = tile[t]; u.row0 = tile[NTILE_MAX + t]; u.nrows = tile[2 * NTILE_MAX + t];
        u.A = H2; u.B = W + ((size_t)e * 1024 + u.pn * 256) * 2048; return true;
    }
    __device__ __forceinline__ void aoffs(const U& u, const int (&R)[2], const int (&C)[2], unsigned (&v)[4]) const {
#pragma unroll
        for (int h = 0; h < 2; ++h)
#pragma unroll
            for (int i = 0; i < 2; ++i) { int r = h * 128 + R[i]; r = r < u.nrows ? r : u.nrows - 1; const int tok = slot_tok[u.row0 + r]; v[h * 2 + i] = (unsigned)(tok * 1024 + C[i]) * 2u; }
    }
};
struct MoeDownSched {
    typedef MoeU U;
    const char* ACT; const char* W; const int* tile; int G, c;
    __device__ __forceinline__ bool next(int i, U& u) const {
        const int nt = tile[3 * NTILE_MAX]; const int L = i * G + c; if (L >= nt * 8) return false;
        const int t = L >> 3; u.pn = L & 7; const int e = tile[t]; u.row0 = tile[NTILE_MAX + t]; u.nrows = tile[2 * NTILE_MAX + t];
        u.A = ACT + (size_t)u.row0 * 512; u.B = W + ((size_t)e * 2048 + u.pn * 256) * 512; return true;
    }
    __device__ __forceinline__ void aoffs(const U&, const int (&R)[2], const int (&C)[2], unsigned (&v)[4]) const {
#pragma unroll
        for (int h = 0; h < 2; ++h)
#pragma unroll
            for (int i = 0; i < 2; ++i) v[h * 2 + i] = (unsigned)((h * 128 + R[i]) * 256 + C[i]) * 2u;
    }
};

struct EpiIn {
    static constexpr int PERMK = 1; static constexpr bool PROBE2 = false;
    unsigned char* ws;
    __device__ __forceinline__ void operator()(const f32x4 (&acc)[2][2][4][2], const DenseU& u, int wr, int wc, int fr, int fq) const {
        const int pn = u.pn; const int row0 = u.pm * 256 + wr * 64 + fr;
        if (pn == 16) {
            if (wc != 0) return;
            float* alr = (float*)(ws + RA_ALR);
#pragma unroll
            for (int ai = 0; ai < 2; ++ai)
#pragma unroll
                for (int m = 0; m < 4; ++m) { float* rp = alr + (size_t)(row0 + ai * 128 + m * 16) * 32 + 8 * fq;
                    *(f32x4*)(rp) = acc[ai][0][m][0]; *(f32x4*)(rp + 4) = acc[ai][0][m][1]; }
            return;
        }
        bf16* base; int ld, colt; bool lat_only;
        if (pn < 2) { base = (bf16*)(ws + RA_Q); ld = 512; colt = pn * 256; lat_only = true; }
        else if (pn < 4) { base = (bf16*)(ws + RA_K); ld = 512; colt = (pn - 2) * 256; lat_only = false; }
        else if (pn < 8) { base = (bf16*)(ws + RA_V); ld = 1024; colt = (pn - 4) * 256; lat_only = false; }
        else if (pn < 12) { base = (bf16*)(ws + RA_R); ld = 1024; colt = (pn - 8) * 256; lat_only = true; }
        else { base = (bf16*)(ws + RA_P); ld = 1024; colt = (pn - 12) * 256; lat_only = true; }
        if (lat_only && u.pm >= 64) return;
        const int col0 = colt + wc * 32 + 8 * fq;
#pragma unroll
        for (int ai = 0; ai < 2; ++ai)
#pragma unroll
            for (int m = 0; m < 4; ++m) { bf16* rp = base + (size_t)(row0 + ai * 128 + m * 16) * ld + col0;
#pragma unroll
                for (int bj = 0; bj < 2; ++bj) { const f32x4 v0 = acc[ai][bj][m][0], v1 = acc[ai][bj][m][1];
                    v4u o; o.x = pg8::cvt_pk_bf16(v0[0], v0[1]); o.y = pg8::cvt_pk_bf16(v0[2], v0[3]); o.z = pg8::cvt_pk_bf16(v1[0], v1[1]); o.w = pg8::cvt_pk_bf16(v1[2], v1[3]);
                    *(v4u*)(rp + bj * 128) = o; } }
    }
};
struct EpiPool {
    static constexpr int PERMK = 1; static constexpr bool PROBE2 = false;
    bf16* ymix; const float* scale;
    __device__ __forceinline__ void operator()(const f32x4 (&acc)[2][2][4][2], const PoolU& u, int wr, int wc, int fr, int fq) const {
        const int row0 = u.pm * 256 + wr * 64 + fr; const int c0 = u.g * 256 + wc * 32 + 8 * fq;
#pragma unroll
        for (int ai = 0; ai < 2; ++ai)
#pragma unroll
            for (int m = 0; m < 4; ++m) { bf16* rp = ymix + (size_t)(row0 + ai * 128 + m * 16) * 2048 + 1024 + c0;
#pragma unroll
                for (int bj = 0; bj < 2; ++bj) { const f32x4 s0 = *(const f32x4*)(scale + c0 + bj * 128), s1 = *(const f32x4*)(scale + c0 + bj * 128 + 4);
                    const f32x4 v0 = acc[ai][bj][m][0] * s0, v1 = acc[ai][bj][m][1] * s1;
                    v4u o; o.x = pg8::cvt_pk_bf16(v0[0], v0[1]); o.y = pg8::cvt_pk_bf16(v0[2], v0[3]); o.z = pg8::cvt_pk_bf16(v1[0], v1[1]); o.w = pg8::cvt_pk_bf16(v1[2], v1[3]);
                    *(v4u*)(rp + bj * 128) = o; } }
    }
};
struct EpiOut {
    static constexpr int PERMK = 1; static constexpr bool PROBE2 = false;
    bf16* y;
    __device__ __forceinline__ void operator()(const f32x4 (&acc)[2][2][4][2], const DenseU& u, int wr, int wc, int fr, int fq) const {
        const int row0 = u.pm * 256 + wr * 64 + fr, col0 = u.pn * 256 + wc * 32 + 8 * fq;
#pragma unroll
        for (int ai = 0; ai < 2; ++ai)
#pragma unroll
            for (int m = 0; m < 4; ++m) { bf16* rp = y + (size_t)(row0 + ai * 128 + m * 16) * 2048 + col0;
#pragma unroll
                for (int bj = 0; bj < 2; ++bj) { const f32x4 v0 = acc[ai][bj][m][0], v1 = acc[ai][bj][m][1];
                    v4u o; o.x = pg8::cvt_pk_bf16(v0[0], v0[1]); o.y = pg8::cvt_pk_bf16(v0[2], v0[3]); o.z = pg8::cvt_pk_bf16(v1[0], v1[1]); o.w = pg8::cvt_pk_bf16(v1[2], v1[3]);
                    *(v4u*)(rp + bj * 128) = o; } }
    }
};
constexpr float SC_W = 256.f, SC_H = 16.f, SC_A = 16.f;
__device__ __forceinline__ unsigned pk4_fp8(float a, float b, float c, float d) {
    a = fminf(fmaxf(a, -448.f), 448.f); b = fminf(fmaxf(b, -448.f), 448.f); c = fminf(fmaxf(c, -448.f), 448.f); d = fminf(fmaxf(d, -448.f), 448.f);
    unsigned w = 0; w = __builtin_amdgcn_cvt_pk_fp8_f32(a, b, w, false); w = __builtin_amdgcn_cvt_pk_fp8_f32(c, d, w, true); return w;
}
struct EpiGU {
    static constexpr int PERMK = 1; static constexpr bool PROBE2 = false;
    unsigned char* act; const float* slot_w;
    __device__ __forceinline__ void operator()(const f32x4 (&acc)[2][2][4][2], const MoeU& u, int wr, int wc, int fr, int fq) const {
        const int c0 = u.pn * 128 + wc * 32 + 8 * fq; constexpr float inv = 1.f / (SC_W * SC_H);
#pragma unroll
        for (int ai = 0; ai < 2; ++ai)
#pragma unroll
            for (int m = 0; m < 4; ++m) { const int r = ai * 128 + wr * 64 + m * 16 + fr;
                if (r < u.nrows) { const float w = slot_w[u.row0 + r] * SC_A; float o[8];
#pragma unroll
                    for (int n = 0; n < 2; ++n)
#pragma unroll
                        for (int j = 0; j < 4; ++j) { const float g = acc[ai][0][m][n][j] * inv, up = acc[ai][1][m][n][j] * inv; o[n * 4 + j] = silu_f(g) * up * w; }
                    v2u q; q.x = pk4_fp8(o[0], o[1], o[2], o[3]); q.y = pk4_fp8(o[4], o[5], o[6], o[7]);
                    *(v2u*)(act + (size_t)(u.row0 + r) * 512 + c0) = q; } }
    }
};
constexpr float SC_O = 32.f;
struct EpiDown {
    static constexpr int PERMK = 2; static constexpr bool PROBE2 = true;
    unsigned char* so;
    __device__ __forceinline__ void operator()(const f32x4 (&acc)[2][2][4][2], const MoeU& u, int wr, int wc, int fr, int fq) const {
        const int c0 = u.pn * 256 + wc * 64 + 16 * fq; constexpr float sc = SC_O / (SC_W * SC_A);
#pragma unroll
        for (int ai = 0; ai < 2; ++ai)
#pragma unroll
            for (int m = 0; m < 4; ++m) { const int r = ai * 128 + wr * 64 + m * 16 + fr;
                if (r < u.nrows) { const f32x4 a0 = acc[ai][0][m][0] * sc, a1 = acc[ai][0][m][1] * sc, b0 = acc[ai][1][m][0] * sc, b1 = acc[ai][1][m][1] * sc;
                    v4u o; o.x = pk4_fp8(a0[0], a0[1], a0[2], a0[3]); o.y = pk4_fp8(a1[0], a1[1], a1[2], a1[3]); o.z = pk4_fp8(b0[0], b0[1], b0[2], b0[3]); o.w = pk4_fp8(b1[0], b1[1], b1[2], b1[3]);
                    __builtin_nontemporal_store(o, (v4u*)(so + (size_t)(u.row0 + r) * 2048 + c0)); } }
    }
};

__device__ __forceinline__ void tr_item(const float* W, int ldn, bf16* WT, int Kd, int drow0, int k0, int n0, LAS float* scr, int lane) {
    f32x4 t[8];
#pragma unroll
    for (int i = 0; i < 8; ++i) t[i] = *(const f32x4*)(W + (size_t)(k0 + 8 * i + (lane >> 3)) * ldn + n0 + 4 * (lane & 7));
#pragma unroll
    for (int i = 0; i < 8; ++i) { LAS float* d = scr + (8 * i + (lane >> 3)) * 33 + 4 * (lane & 7); d[0] = t[i][0]; d[1] = t[i][1]; d[2] = t[i][2]; d[3] = t[i][3]; }
    LDS_WAIT(); asm volatile("" ::: "memory");
    const int c = lane & 7;
#pragma unroll
    for (int j = 0; j < 4; ++j) { const int n = (lane >> 3) + 8 * j; const LAS float* s = scr + (8 * c) * 33 + n;
        v4u o; o.x = pk2(s[0 * 33], s[1 * 33]); o.y = pk2(s[2 * 33], s[3 * 33]); o.z = pk2(s[4 * 33], s[5 * 33]); o.w = pk2(s[6 * 33], s[7 * 33]);
        *(v4u*)(WT + (size_t)(drow0 + n) * Kd + k0 + 8 * c) = o; }
    LDS_WAIT(); asm volatile("" ::: "memory");
}

__device__ __forceinline__ void tr_item8(const float* W, int ldn, unsigned char* WT, int Kd, int drow0, int k0, int n0, LAS float* scr, int lane) {
    f32x4 t[8];
#pragma unroll
    for (int i = 0; i < 8; ++i) t[i] = *(const f32x4*)(W + (size_t)(k0 + 8 * i + (lane >> 3)) * ldn + n0 + 4 * (lane & 7));
#pragma unroll
    for (int i = 0; i < 8; ++i) { LAS float* d = scr + (8 * i + (lane >> 3)) * 33 + 4 * (lane & 7); d[0] = t[i][0]; d[1] = t[i][1]; d[2] = t[i][2]; d[3] = t[i][3]; }
    LDS_WAIT(); asm volatile("" ::: "memory");
    const int c = lane & 7;
#pragma unroll
    for (int j = 0; j < 4; ++j) { const int n = (lane >> 3) + 8 * j; const LAS float* s = scr + (8 * c) * 33 + n;
        v2u o; o.x = pk4_fp8(s[0 * 33] * SC_W, s[1 * 33] * SC_W, s[2 * 33] * SC_W, s[3 * 33] * SC_W); o.y = pk4_fp8(s[4 * 33] * SC_W, s[5 * 33] * SC_W, s[6 * 33] * SC_W, s[7 * 33] * SC_W);
        *(v2u*)(WT + (size_t)(drow0 + n) * Kd + k0 + 8 * c) = o; }
    LDS_WAIT(); asm volatile("" ::: "memory");
}

__device__ __forceinline__ void phase0(const Args& a, LAS unsigned char* lds, int tid, int lane, int wave, int vcu, int G) {
    unsigned char* ws = a.ws;
    if (vcu < 192) {
        LAS float* sc = (LAS float*)lds;
        LAS float* red = (LAS float*)(lds + 73728);
        for (int i = tid; i < 9 * 2048; i += 512) { const int r = i >> 11, k = i & 2047; const float v = r < 8 ? a.in[1][r * 2048 + k] : a.in[3][k]; sc[i] = silu_f(v); }
        __syncthreads();
        const float* wm = a.in[4]; const float* bm = a.in[5]; float* mod = (float*)(ws + WS_MOD);
        for (int chunk = vcu; chunk < 192; chunk += G) {
            const int n0 = chunk * 64, ks = lane >> 4, n4 = (lane & 15) * 4;
            f32x4 acc[9];
#pragma unroll
            for (int r = 0; r < 9; ++r) acc[r] = (f32x4){0.f, 0.f, 0.f, 0.f};
#pragma unroll 4
            for (int kk = 0; kk < 256; kk += 4) { const int k = wave * 256 + kk + ks; const f32x4 wv = *(const f32x4*)(wm + (size_t)k * 12288 + n0 + n4);
#pragma unroll
                for (int r = 0; r < 9; ++r) { const float s = sc[r * 2048 + k]; acc[r] += wv * s; } }
#pragma unroll
            for (int r = 0; r < 9; ++r)
#pragma unroll
                for (int j = 0; j < 4; ++j) { float v = acc[r][j]; v += __shfl_xor(v, 16); v += __shfl_xor(v, 32); acc[r][j] = v; }
            if (lane < 16) {
#pragma unroll
                for (int r = 0; r < 9; ++r) *(LAS f32x4*)(red + (wave * 9 + r) * 64 + n4) = acc[r]; }
            __syncthreads();
            for (int i = tid; i < 9 * 64; i += 512) { const int r = i >> 6, n = i & 63; float s = 0.f;
#pragma unroll
                for (int w = 0; w < 8; ++w) s += red[(w * 9 + r) * 64 + n];
                mod[r * 12288 + n0 + n] = s + bm[n0 + n]; }
            __syncthreads();
        }
    }
    __syncthreads();
    LAS float* scr = (LAS float*)(lds + wave * 16384);
    const int gw = vcu * 8 + wave, NGW = G * 8;
    bf16* Win_t = (bf16*)(ws + WS_WIN); bf16* Wout_t = (bf16*)(ws + WS_WOUT); bf16* Wpool_t = (bf16*)(ws + WS_WPOOL); unsigned char* Wd_t = ws + WS_WD; unsigned char* Wgu_t = ws + WS_WGU;
    constexpr int I_IN = 32 * 129, I_OUT = 32 * 64, I_POOL = 4 * 4 * 8, I_E = 65 * 512;
    constexpr int NITEMS = I_IN + I_OUT + I_POOL + 3 * I_E;
    for (int it = gw; it < NITEMS; it += NGW) {
        int r = it;
        if (r < I_IN) { const int kb = r / 129, nb = r % 129, n0 = 32 * nb; const int drow = n0 < 3072 ? n0 : (n0 == 3072 ? 4096 : n0 - 32);
            tr_item(a.in[10], DIN, Win_t, 2048, drow, 64 * kb, n0, scr, lane); continue; } r -= I_IN;
        if (r < I_OUT) { const int kb = r / 64, nb = r % 64; tr_item(a.in[18], 2048, Wout_t, 2048, 32 * nb, 64 * kb, 32 * nb, scr, lane); continue; } r -= I_OUT;
        if (r < I_POOL) { const int g = r / 32, rr = r % 32, kb = rr / 8, nb = rr % 8; tr_item(a.in[16] + g * 65536, 256, Wpool_t + g * 65536, 256, 32 * nb, 64 * kb, 32 * nb, scr, lane); continue; } r -= I_POOL;
        if (r < I_E) { const int e = r / 512, rr = r % 512, kb = rr / 16, nb = rr % 16, n0 = 32 * nb; const float* src = e < 64 ? a.in[21] + (size_t)e * 2048 * 512 : a.in[24];
            tr_item8(src, 512, Wgu_t + (size_t)e * 1024 * 2048, 2048, (n0 / 128) * 256 + (n0 % 128), 64 * kb, n0, scr, lane); continue; } r -= I_E;
        if (r < I_E) { const int e = r / 512, rr = r % 512, kb = rr / 16, nb = rr % 16, n0 = 32 * nb; const float* src = e < 64 ? a.in[22] + (size_t)e * 2048 * 512 : a.in[25];
            tr_item8(src, 512, Wgu_t + (size_t)e * 1024 * 2048, 2048, (n0 / 128) * 256 + 128 + (n0 % 128), 64 * kb, n0, scr, lane); continue; } r -= I_E;
        { const int e = r / 512, rr = r % 512, kb = rr / 64, nb = rr % 64; const float* src = e < 64 ? a.in[23] + (size_t)e * 512 * 2048 : a.in[26];
            tr_item8(src, 2048, Wd_t + (size_t)e * 2048 * 512, 512, 32 * nb, 64 * kb, 32 * nb, scr, lane); }
    }
    { const float* wr = a.in[19]; bf16* whi = (bf16*)(ws + WS_WRT); bf16* wlo = whi + 64 * 2048;
      for (int idx = vcu * 512 + tid; idx < 64 * 256; idx += G * 512) { const int e = idx >> 8, k8 = idx & 255; unsigned hi[8], lo[8];
#pragma unroll
          for (int j = 0; j < 8; ++j) { const float v = wr[(size_t)(8 * k8 + j) * 64 + e]; hi[j] = f2bf(v); lo[j] = f2bf(v - __builtin_bit_cast(float, hi[j] << 16)); }
          v4u oh, ol; oh.x = hi[0] | (hi[1] << 16); oh.y = hi[2] | (hi[3] << 16); oh.z = hi[4] | (hi[5] << 16); oh.w = hi[6] | (hi[7] << 16);
          ol.x = lo[0] | (lo[1] << 16); ol.y = lo[2] | (lo[3] << 16); ol.z = lo[4] | (lo[5] << 16); ol.w = lo[6] | (lo[7] << 16);
          *(v4u*)(whi + (size_t)e * 2048 + 8 * k8) = oh; *(v4u*)(wlo + (size_t)e * 2048 + 8 * k8) = ol; } }
    { v4u* z = (v4u*)(Win_t + (size_t)DIN * 2048); const int nz = (DINP - DIN) * 2048 / 8;
      for (int i = vcu * 512 + tid; i < nz; i += G * 512) z[i] = (v4u){0u, 0u, 0u, 0u}; }
}

__device__ __forceinline__ void phase1(const Args& a, int lane, int wave, int vcu, int G) {
    const float* mod = (const float*)(a.ws + WS_MOD); bf16* H = (bf16*)(a.ws + RA_H); const float* g = a.in[6];
    for (int m = vcu * 8 + wave; m < MROWS; m += G * 8) {
        const float* xr = m < NT ? a.in[0] + (size_t)m * 2048 : a.in[2] + (size_t)(m - NT) * 2048;
        const float* mr = mod + (size_t)(m < NT ? (m >> 11) : 8) * 12288;
        f32x4 v[8]; float ss = 0.f;
#pragma unroll
        for (int j = 0; j < 8; ++j) { v[j] = *(const f32x4*)(xr + 4 * (lane + 64 * j)); ss += v[j][0] * v[j][0] + v[j][1] * v[j][1] + v[j][2] * v[j][2] + v[j][3] * v[j][3]; }
        const float rstd = rsqrtf(wave_sum(ss) * (1.f / 2048.f) + EPS);
#pragma unroll
        for (int j = 0; j < 8; ++j) { const int c = 4 * (lane + 64 * j); const f32x4 gg = *(const f32x4*)(g + c), sh = *(const f32x4*)(mr + c), sc = *(const f32x4*)(mr + 2048 + c);
            const f32x4 o = v[j] * rstd * gg * (sc + 1.f) + sh;
            v2u q; q.x = pk2(o[0], o[1]); q.y = pk2(o[2], o[3]); *(v2u*)(H + (size_t)m * 2048 + c) = q; }
    }
}

__device__ __forceinline__ int scan_row(int b, int dir, int s) {
    if (s < 256) { const int tc = dir ? 255 - s : s; return NT + b * 256 + tc; }
    const int t0 = s - 256; return b * 2048 + (dir ? 2047 - t0 : t0);
}
__device__ __forceinline__ void phase3_prep(const Args& a, LAS unsigned char* lds, int tid, int vcu, int G) {
    unsigned char* ws = a.ws;
    const bf16* Q = (const bf16*)(ws + RA_Q); const bf16* Kb = (const bf16*)(ws + RA_K); const float* ALR = (const float*)(ws + RA_ALR);
    bf16* QG = (bf16*)(ws + PQG); bf16* QM = (bf16*)(ws + PQM); bf16* KM = (bf16*)(ws + PKM); bf16* KD = (bf16*)(ws + PKD); float* DEC = (float*)(ws + PDEC);
    LAS float* alr = (LAS float*)lds;
    LAS bf16* Kt = (LAS bf16*)(lds + 4096);
    LAS bf16* Qt = (LAS bf16*)(lds + 4096 + 65536);
    const int col = tid, h = col >> 7, dk = col & 127;
    for (int item = vcu; item < 2 * 8 * 36; item += G) {
        const int ch = item % 36, b = (item / 36) & 7, dir = item / 288;
        const bool lat = ch >= 4;
        if (tid < 256) { const int i = tid >> 2, r4 = (tid & 3) * 4; const int row = scan_row(b, dir, ch * 64 + i);
            *(LAS f32x4*)(alr + i * 16 + r4) = *(const f32x4*)(ALR + (size_t)row * 32 + dir * 16 + r4); }
        { v4u kr[8], qr[8];
#pragma unroll
          for (int q = 0; q < 8; ++q) { const int p = tid + 512 * q, i = p >> 6, c8 = (p & 63) * 8; const int row = scan_row(b, dir, ch * 64 + i);
              kr[q] = *(const v4u*)(Kb + (size_t)row * 512 + c8); if (lat) qr[q] = *(const v4u*)(Q + (size_t)row * 512 + c8); }
#pragma unroll
          for (int q = 0; q < 8; ++q) { const int p = tid + 512 * q; *(LAS v4u*)(Kt + p * 8) = kr[q]; if (lat) *(LAS v4u*)(Qt + p * 8) = qr[q]; } }
        const float* wa2 = dir ? a.in[13] : a.in[11]; const float bia = (dir ? a.in[14] : a.in[12])[col];
        float w[16];
#pragma unroll
        for (int r = 0; r < 16; ++r) w[r] = wa2[r * 512 + col];
        __syncthreads();
        float Gc = 0.f, Gmid = 0.f;
#pragma unroll 4
        for (int i = 0; i < 64; ++i) { float z = bia;
#pragma unroll
            for (int r4 = 0; r4 < 4; ++r4) { const f32x4 x = *(const LAS f32x4*)(alr + i * 16 + 4 * r4); z += x[0] * w[4 * r4] + x[1] * w[4 * r4 + 1] + x[2] * w[4 * r4 + 2] + x[3] * w[4 * r4 + 3]; }
            Gc += (fminf(z, 0.f) - __logf(1.f + __expf(-fabsf(z)))) * (1.f / 16.f);
            if (i == 32) Gmid = Gc; }
        const float Gend = Gc;
        DEC[((size_t)(dir * 8 + b) * 36 + ch) * 512 + col] = __expf(Gend);
        bf16* kdrow = KD + ((((size_t)(dir * 8 + b) * 36 + ch) * 4 + h) * 128 + dk) * 64;
        const size_t lt = lat ? ((((size_t)(dir * 8 + b) * 32 + (ch - 4)) * 4 + h) * 64) * 128 + dk : 0;
        Gc = 0.f;
#pragma unroll 1
        for (int i0 = 0; i0 < 64; i0 += 8) { unsigned kd[8];
#pragma unroll
            for (int ii = 0; ii < 8; ++ii) { const int i = i0 + ii; float z = bia;
#pragma unroll
                for (int r4 = 0; r4 < 4; ++r4) { const f32x4 x = *(const LAS f32x4*)(alr + i * 16 + 4 * r4); z += x[0] * w[4 * r4] + x[1] * w[4 * r4 + 1] + x[2] * w[4 * r4 + 2] + x[3] * w[4 * r4 + 3]; }
                Gc += (fminf(z, 0.f) - __logf(1.f + __expf(-fabsf(z)))) * (1.f / 16.f);
                const float kv = bf1(Kt[i * 512 + col]);
                kd[ii] = f2bf(kv * __expf(Gend - Gc));
                if (lat) { const float qv = bf1(Qt[i * 512 + col]) * 0.08838834764831845f;
                    QG[lt + (size_t)i * 128] = (bf16)f2bf(qv * __expf(Gc)); QM[lt + (size_t)i * 128] = (bf16)f2bf(qv * __expf(Gc - Gmid)); KM[lt + (size_t)i * 128] = (bf16)f2bf(kv * __expf(Gmid - Gc)); } }
            v4u o; o.x = kd[0] | (kd[1] << 16); o.y = kd[2] | (kd[3] << 16); o.z = kd[4] | (kd[5] << 16); o.w = kd[6] | (kd[7] << 16);
            *(v4u*)(kdrow + i0) = o; }
        __syncthreads();
    }
}

constexpr int GL_QG = 0, GL_QM = 17408, GL_KM = 34816, GL_ST = 52224, GL_KDT = 69632, GL_VT = 88064, GL_AM = 97280, GL_DEC = 106496;
__device__ __forceinline__ void phase_chain(const Args& a, LAS unsigned char* lds, int tid, int lane, int wave, int vcu, int G) {
    unsigned char* ws = a.ws;
    const v4u* QG = (const v4u*)(ws + PQG); const v4u* QM = (const v4u*)(ws + PQM); const v4u* KM = (const v4u*)(ws + PKM); const v4u* KD = (const v4u*)(ws + PKD); const float* DEC = (const float*)(ws + PDEC);
    const bf16* V = (const bf16*)(ws + RA_V); bf16* OF = (bf16*)(ws + RA_OF);
    const int l15 = lane & 15, l4 = lane >> 4;
    for (int item = vcu; item < 256; item += G) {
        const int vs = item & 3, dir = (item >> 2) & 1, h = (item >> 3) & 3, b = item >> 5;
        f32x4 S[4];
#pragma unroll
        for (int tv = 0; tv < 4; ++tv) S[tv] = (f32x4){0.f, 0.f, 0.f, 0.f};
        v4u rq[6], rk[2], rv; float rdec = 0.f;
#define GL_LOAD(ch_) do { const int ch__ = (ch_); \
            if (ch__ >= 4) { const size_t t_ = ((((size_t)(dir * 8 + b) * 32 + (ch__ - 4)) * 4 + h) * 1024); \
                rq[0] = QG[t_ + tid]; rq[1] = QG[t_ + tid + 512]; rq[2] = QM[t_ + tid]; rq[3] = QM[t_ + tid + 512]; rq[4] = KM[t_ + tid]; rq[5] = KM[t_ + tid + 512]; } \
            { const size_t t_ = ((((size_t)(dir * 8 + b) * 36 + ch__) * 4 + h) * 1024); rk[0] = KD[t_ + tid]; rk[1] = KD[t_ + tid + 512]; } \
            { const int row_ = scan_row(b, dir, ch__ * 64 + (tid >> 3)); rv = *(const v4u*)(V + (size_t)row_ * 1024 + h * 256 + vs * 64 + 8 * (tid & 7)); } \
            if (tid < 128) rdec = DEC[((size_t)(dir * 8 + b) * 36 + ch__) * 512 + h * 128 + tid]; } while (0)
        GL_LOAD(0);
        for (int ch = 0; ch < 36; ++ch) {
            const bool lat = ch >= 4;
#pragma unroll
            for (int tv = 0; tv < 4; ++tv) { v2u p; p.x = pk2(S[tv][0], S[tv][1]); p.y = pk2(S[tv][2], S[tv][3]);
                *(LAS v2u*)(lds + GL_ST + (16 * tv + l15) * 272 + (16 * wave + 4 * l4) * 2) = p; }
            if (lat) {
#pragma unroll
                for (int q = 0; q < 2; ++q) { const int p = tid + 512 * q; const int off = (p >> 4) * 272 + (p & 15) * 16;
                    *(LAS v4u*)(lds + GL_QG + off) = rq[q]; *(LAS v4u*)(lds + GL_QM + off) = rq[2 + q]; *(LAS v4u*)(lds + GL_KM + off) = rq[4 + q]; } }
#pragma unroll
            for (int q = 0; q < 2; ++q) { const int p = tid + 512 * q; *(LAS v4u*)(lds + GL_KDT + (p >> 3) * 144 + (p & 7) * 16) = rk[q]; }
            { const int i = tid >> 3, c = tid & 7; LAS bf16* vt = (LAS bf16*)(lds + GL_VT) + i;
              vt[(8 * c + 0) * 72] = (bf16)(rv.x & 0xffffu); vt[(8 * c + 1) * 72] = (bf16)(rv.x >> 16); vt[(8 * c + 2) * 72] = (bf16)(rv.y & 0xffffu); vt[(8 * c + 3) * 72] = (bf16)(rv.y >> 16);
              vt[(8 * c + 4) * 72] = (bf16)(rv.z & 0xffffu); vt[(8 * c + 5) * 72] = (bf16)(rv.z >> 16); vt[(8 * c + 6) * 72] = (bf16)(rv.w & 0xffffu); vt[(8 * c + 7) * 72] = (bf16)(rv.w >> 16); }
            if (tid < 128) *(LAS float*)(lds + GL_DEC + tid * 4) = rdec;
            __syncthreads();
            if (ch + 1 < 36) GL_LOAD(ch + 1);
            if (lat) {
                { const int ti = wave >> 1; f32x4 c0 = (f32x4){0.f, 0.f, 0.f, 0.f}, c1 = c0; const int tj0 = (wave & 1) * 2;
#pragma unroll
                  for (int ks = 0; ks < 4; ++ks) { const int ko = (32 * ks + 8 * l4) * 2;
                      const bf16x8 bq = *(const LAS bf16x8*)(lds + GL_QM + (16 * ti + l15) * 272 + ko);
                      const bf16x8 a0 = *(const LAS bf16x8*)(lds + GL_KM + (16 * tj0 + l15) * 272 + ko), a1 = *(const LAS bf16x8*)(lds + GL_KM + (16 * tj0 + 16 + l15) * 272 + ko);
                      c0 = __builtin_amdgcn_mfma_f32_16x16x32_bf16(a0, bq, c0, 0, 0, 0); c1 = __builtin_amdgcn_mfma_f32_16x16x32_bf16(a1, bq, c1, 0, 0, 0); }
                  const int i = 16 * ti + l15;
                  { const int j0 = 16 * tj0 + 4 * l4; v2u p; p.x = pk2(j0 <= i ? c0[0] : 0.f, j0 + 1 <= i ? c0[1] : 0.f); p.y = pk2(j0 + 2 <= i ? c0[2] : 0.f, j0 + 3 <= i ? c0[3] : 0.f);
                    *(LAS v2u*)(lds + GL_AM + i * 144 + j0 * 2) = p; }
                  { const int j0 = 16 * tj0 + 16 + 4 * l4; v2u p; p.x = pk2(j0 <= i ? c1[0] : 0.f, j0 + 1 <= i ? c1[1] : 0.f); p.y = pk2(j0 + 2 <= i ? c1[2] : 0.f, j0 + 3 <= i ? c1[3] : 0.f);
                    *(LAS v2u*)(lds + GL_AM + i * 144 + j0 * 2) = p; } }
                __syncthreads();
                { const int ti = wave >> 1, tv0 = (wave & 1) * 2; f32x4 c0 = (f32x4){0.f, 0.f, 0.f, 0.f}, c1 = c0;
#pragma unroll
                  for (int ks = 0; ks < 4; ++ks) { const int ko = (32 * ks + 8 * l4) * 2;
                      const bf16x8 bq = *(const LAS bf16x8*)(lds + GL_QG + (16 * ti + l15) * 272 + ko);
                      const bf16x8 a0 = *(const LAS bf16x8*)(lds + GL_ST + (16 * tv0 + l15) * 272 + ko), a1 = *(const LAS bf16x8*)(lds + GL_ST + (16 * tv0 + 16 + l15) * 272 + ko);
                      c0 = __builtin_amdgcn_mfma_f32_16x16x32_bf16(a0, bq, c0, 0, 0, 0); c1 = __builtin_amdgcn_mfma_f32_16x16x32_bf16(a1, bq, c1, 0, 0, 0); }
#pragma unroll
                  for (int ks = 0; ks < 2; ++ks) { const int ko = (32 * ks + 8 * l4) * 2;
                      const bf16x8 bq = *(const LAS bf16x8*)(lds + GL_AM + (16 * ti + l15) * 144 + ko);
                      const bf16x8 a0 = *(const LAS bf16x8*)(lds + GL_VT + (16 * tv0 + l15) * 144 + ko), a1 = *(const LAS bf16x8*)(lds + GL_VT + (16 * tv0 + 16 + l15) * 144 + ko);
                      c0 = __builtin_amdgcn_mfma_f32_16x16x32_bf16(a0, bq, c0, 0, 0, 0); c1 = __builtin_amdgcn_mfma_f32_16x16x32_bf16(a1, bq, c1, 0, 0, 0); }
                  const int s = ch * 64 + 16 * ti + l15; const int t0 = s - 256; const int t = dir ? 2047 - t0 : t0;
                  bf16* orow = OF + ((size_t)dir * NT + b * 2048 + t) * 1024 + h * 256 + vs * 64 + 16 * tv0 + 4 * l4;
                  v2u p0, p1; p0.x = pk2(c0[0], c0[1]); p0.y = pk2(c0[2], c0[3]); p1.x = pk2(c1[0], c1[1]); p1.y = pk2(c1[2], c1[3]);
                  *(v2u*)(orow) = p0; *(v2u*)(orow + 16) = p1; }
            }
            { const f32x4 d4 = *(const LAS f32x4*)(lds + GL_DEC + (16 * wave + 4 * l4) * 4);
#pragma unroll
              for (int tv = 0; tv < 4; ++tv) S[tv] = S[tv] * d4;
#pragma unroll
              for (int ks = 0; ks < 2; ++ks) { const int ko = (32 * ks + 8 * l4) * 2;
                  const bf16x8 ak = *(const LAS bf16x8*)(lds + GL_KDT + (16 * wave + l15) * 144 + ko);
#pragma unroll
                  for (int tv = 0; tv < 4; ++tv) { const bf16x8 bv = *(const LAS bf16x8*)(lds + GL_VT + (16 * tv + l15) * 144 + ko);
                      S[tv] = __builtin_amdgcn_mfma_f32_16x16x32_bf16(ak, bv, S[tv], 0, 0, 0); } } }
            __syncthreads();
        }
#undef GL_LOAD
    }
}

template <int HALFW>
__device__ __forceinline__ void pool_item(const bf16* P, bf16* DP, LAS float* tmp, int tid, int b, int r, int g) {
    const int rlo = r - HALFW < 0 ? 0 : r - HALFW, rhi = r + HALFW > 32 ? 32 : r + HALFW;
    const float rinv = 1.f / (float)(rhi - rlo);
#pragma unroll 1
    for (int q = 0; q < 4; ++q) { const int p = tid + 512 * q, c = p >> 5, ch0 = (p & 31) * 8; float acc[8]; v4u x[2 * HALFW];
#pragma unroll
        for (int u = 0; u < 2 * HALFW; ++u) { const int rr = (rlo + u < rhi) ? rlo + u : rlo; x[u] = *(const v4u*)(P + ((size_t)(b * 2048 + rr * 64 + c)) * 1024 + g * 256 + ch0); }
#pragma unroll
        for (int j = 0; j < 8; ++j) acc[j] = 0.f;
#pragma unroll
        for (int u = 0; u < 2 * HALFW; ++u) { const float m = (rlo + u < rhi) ? 1.f : 0.f;
            acc[0] += m * bflo(x[u].x); acc[1] += m * bfhi(x[u].x); acc[2] += m * bflo(x[u].y); acc[3] += m * bfhi(x[u].y); acc[4] += m * bflo(x[u].z); acc[5] += m * bfhi(x[u].z); acc[6] += m * bflo(x[u].w); acc[7] += m * bfhi(x[u].w); }
        *(LAS f32x4*)(tmp + c * 256 + ch0) = (f32x4){acc[0] * rinv, acc[1] * rinv, acc[2] * rinv, acc[3] * rinv};
        *(LAS f32x4*)(tmp + c * 256 + ch0 + 4) = (f32x4){acc[4] * rinv, acc[5] * rinv, acc[6] * rinv, acc[7] * rinv}; }
    __syncthreads();
#pragma unroll 1
    for (int q = 0; q < 4; ++q) { const int p = tid + 512 * q, c = p >> 5, ch0 = (p & 31) * 8;
        const int clo = c - HALFW < 0 ? 0 : c - HALFW, chi = c + HALFW > 64 ? 64 : c + HALFW; const float cinv = 1.f / (float)(chi - clo);
        const size_t o = ((size_t)(b * 2048 + r * 64 + c)) * 1024 + g * 256 + ch0;
        const v4u x = *(const v4u*)(P + o);
        f32x4 a0 = (f32x4){0.f, 0.f, 0.f, 0.f}, a1 = a0;
#pragma unroll
        for (int u = 0; u < 2 * HALFW; ++u) { const int cc = (clo + u < chi) ? clo + u : clo; const float m = (clo + u < chi) ? 1.f : 0.f;
            a0 += *(const LAS f32x4*)(tmp + cc * 256 + ch0) * m; a1 += *(const LAS f32x4*)(tmp + cc * 256 + ch0 + 4) * m; }
        v4u d; d.x = pk2(a0[0] * cinv - bflo(x.x), a0[1] * cinv - bfhi(x.x)); d.y = pk2(a0[2] * cinv - bflo(x.y), a0[3] * cinv - bfhi(x.y));
        d.z = pk2(a1[0] * cinv - bflo(x.z), a1[1] * cinv - bfhi(x.z)); d.w = pk2(a1[2] * cinv - bflo(x.w), a1[3] * cinv - bfhi(x.w));
        *(v4u*)(DP + o) = d; }
    __syncthreads();
}
__device__ __forceinline__ void phase3_pool(const Args& a, LAS unsigned char* lds, int tid, int vcu, int G) {
    const bf16* P = (const bf16*)(a.ws + RA_P); bf16* DP = (bf16*)(a.ws + RA_DPOOL);
    LAS float* tmp = (LAS float*)lds;
    for (int item = vcu; item < 1024; item += G) {
        const int g = item >> 8, r = (item >> 3) & 31, b = item & 7;
        const int gg = 3 - g;
        if (gg == 0) pool_item<1>(P, DP, tmp, tid, b, r, gg); else if (gg == 1) pool_item<2>(P, DP, tmp, tid, b, r, gg); else if (gg == 2) pool_item<4>(P, DP, tmp, tid, b, r, gg); else pool_item<8>(P, DP, tmp, tid, b, r, gg);
    }
}

__device__ __forceinline__ void phase4_post(const Args& a, int lane, int wave, int vcu, int G) {
    const bf16* OF = (const bf16*)(a.ws + RA_OF); const bf16* OB = OF + (size_t)NT * 1024; const bf16* Rr = (const bf16*)(a.ws + RA_R); bf16* Y = (bf16*)(a.ws + RA_YMIX);
    const float* gn = a.in[15];
    for (int idx = vcu * 8 + wave; idx < NT * 4; idx += G * 8) {
        const int t = idx >> 2, h = idx & 3; const size_t o = (size_t)t * 1024 + h * 256 + 4 * lane;
        const v2u of = *(const v2u*)(OF + o), ob = *(const v2u*)(OB + o);
        const f32x4 x = (f32x4){bflo(of.x) + bflo(ob.x), bfhi(of.x) + bfhi(ob.x), bflo(of.y) + bflo(ob.y), bfhi(of.y) + bfhi(ob.y)};
        const float ms = wave_sum(x[0] * x[0] + x[1] * x[1] + x[2] * x[2] + x[3] * x[3]) * (1.f / 256.f);
        const float sc = rsqrtf(ms + EPS);
        const f32x4 g4 = *(const f32x4*)(gn + h * 256 + 4 * lane);
        const v2u rr = *(const v2u*)(Rr + o);
        const float r0 = bflo(rr.x), r1 = bfhi(rr.x), r2 = bflo(rr.y), r3 = bfhi(rr.y);
        v2u q; q.x = pk2(x[0] * sc * g4[0] * silu_f(r0), x[1] * sc * g4[1] * silu_f(r1)); q.y = pk2(x[2] * sc * g4[2] * silu_f(r2), x[3] * sc * g4[3] * silu_f(r3));
        *(v2u*)(Y + (size_t)t * 2048 + h * 256 + 4 * lane) = q;
    }
}

__device__ __forceinline__ void phase6(const Args& a, LAS unsigned char* lds, int tid, int lane, int wave, int vcu, int G) {
    unsigned char* ws = a.ws;
    const float* mod = (const float*)(ws + WS_MOD); const bf16* Y1 = (const bf16*)(ws + RA_Y1); unsigned char* H2 = ws + RA_H2;
    const float* gpost = a.in[7]; const float* gpre2 = a.in[8]; const float* rbias = a.in[20];
    const bf16* whi = (const bf16*)(ws + WS_WRT); const bf16* wlo = whi + 64 * 2048;
    LAS float* part = (LAS float*)lds;
    LAS float* logit = (LAS float*)(lds + LDS_LOGIT);
    LAS u64* masks = (LAS u64*)(lds + LDS_MASKS);
    int* cnt = (int*)(ws + T_CNT); u64* tmask = (u64*)(ws + T_MASK); float* tokw = (float*)(ws + T_TOKW);
    const int l15 = lane & 15, l4 = lane >> 4;
    for (int blk = vcu; blk < NT / 64; blk += G) {
        for (int it = 0; it < 4; ++it) {
#pragma unroll 1
            for (int rr = 0; rr < 2; ++rr) {
                const int lr = wave * 2 + rr, t = blk * 64 + it * 16 + lr; const float* mr = mod + (size_t)(t >> 11) * 12288;
                const bf16* yr = Y1 + (size_t)t * 2048; const float* xr = a.in[0] + (size_t)t * 2048;
                f32x4 y[8]; float ss = 0.f;
#pragma unroll
                for (int j = 0; j < 8; ++j) { const v2u yb = *(const v2u*)(yr + 4 * (lane + 64 * j)); y[j] = (f32x4){bflo(yb.x), bfhi(yb.x), bflo(yb.y), bfhi(yb.y)}; ss += y[j][0] * y[j][0] + y[j][1] * y[j][1] + y[j][2] * y[j][2] + y[j][3] * y[j][3]; }
                const float rstd1 = rsqrtf(wave_sum(ss) * (1.f / 2048.f) + EPS);
                if (lane == 0) ((float*)(ws + T_RSTD1))[t] = rstd1;
                float s2 = 0.f;
#pragma unroll
                for (int j = 0; j < 8; ++j) { const int c = 4 * (lane + 64 * j); const f32x4 x = *(const f32x4*)(xr + c), gp = *(const f32x4*)(gpost + c), gt = *(const f32x4*)(mr + 4096 + c);
                    const f32x4 x1 = x + gt * (y[j] * rstd1 * gp); y[j] = x1;
                    s2 += x1[0] * x1[0] + x1[1] * x1[1] + x1[2] * x1[2] + x1[3] * x1[3]; }
                const float rstd2 = rsqrtf(wave_sum(s2) * (1.f / 2048.f) + EPS);
#pragma unroll
                for (int j = 0; j < 8; ++j) { const int c = 4 * (lane + 64 * j); const f32x4 g2 = *(const f32x4*)(gpre2 + c), sh = *(const f32x4*)(mr + 6144 + c), sc = *(const f32x4*)(mr + 8192 + c);
                    const f32x4 hh = y[j] * rstd2 * g2 * (sc + 1.f) + sh;
                    unsigned hi[4], lo[4];
#pragma unroll
                    for (int q = 0; q < 4; ++q) { hi[q] = f2bf(hh[q]); lo[q] = f2bf(hh[q] - __builtin_bit_cast(float, hi[q] << 16)); }
                    v2u qh, ql; qh.x = hi[0] | (hi[1] << 16); qh.y = hi[2] | (hi[3] << 16); ql.x = lo[0] | (lo[1] << 16); ql.y = lo[2] | (lo[3] << 16);
                    *(LAS v2u*)(lds + RT_HI + lr * RT_ROWB + c * 2) = qh; *(LAS v2u*)(lds + RT_LO + lr * RT_ROWB + c * 2) = ql;
                    *(unsigned*)(H2 + (size_t)t * 2048 + c) = pk4_fp8(hh[0] * SC_H, hh[1] * SC_H, hh[2] * SC_H, hh[3] * SC_H); }
            }
            __syncthreads();
            { f32x4 acc[4];
#pragma unroll
              for (int et = 0; et < 4; ++et) acc[et] = (f32x4){0.f, 0.f, 0.f, 0.f};
#pragma unroll 1
              for (int ks = 0; ks < 8; ++ks) { const int k0 = 256 * wave + 32 * ks + 8 * l4;
                  const bf16x8 ah = *(const LAS bf16x8*)(lds + RT_HI + l15 * RT_ROWB + k0 * 2), al = *(const LAS bf16x8*)(lds + RT_LO + l15 * RT_ROWB + k0 * 2);
#pragma unroll
                  for (int et = 0; et < 4; ++et) { const bf16x8 bh = *(const bf16x8*)(whi + (size_t)(16 * et + l15) * 2048 + k0), bl = *(const bf16x8*)(wlo + (size_t)(16 * et + l15) * 2048 + k0);
                      acc[et] = __builtin_amdgcn_mfma_f32_16x16x32_bf16(ah, bh, acc[et], 0, 0, 0);
                      acc[et] = __builtin_amdgcn_mfma_f32_16x16x32_bf16(ah, bl, acc[et], 0, 0, 0);
                      acc[et] = __builtin_amdgcn_mfma_f32_16x16x32_bf16(al, bh, acc[et], 0, 0, 0); } }
              __syncthreads();
#pragma unroll
              for (int et = 0; et < 4; ++et)
#pragma unroll
                  for (int q = 0; q < 4; ++q) part[(wave * 16 + 4 * l4 + q) * 64 + 16 * et + l15] = acc[et][q]; }
            __syncthreads();
#pragma unroll
            for (int q = 0; q < 2; ++q) { const int idx = tid + 512 * q; float sacc = 0.f;
#pragma unroll
                for (int w = 0; w < 8; ++w) sacc += part[w * 1024 + idx];
                logit[idx] = sacc; }
            __syncthreads();
#pragma unroll 1
            for (int rr = 0; rr < 2; ++rr) {
                const int lr = wave * 2 + rr, t = blk * 64 + it * 16 + lr;
                const float lg = logit[lr * 64 + lane]; const float s = 1.f / (1.f + __expf(-lg)); const float sel = s + rbias[lane];
                float m1 = sel; m1 = fmaxf(m1, __shfl_xor(m1, 1)); m1 = fmaxf(m1, __shfl_xor(m1, 2)); m1 = fmaxf(m1, __shfl_xor(m1, 4));
                const u64 eq = __ballot(sel == m1); const unsigned gb = (unsigned)(eq >> (lane & ~7)) & 0xffu; const int first = __builtin_ctz(gb);
                float v2 = ((lane & 7) == first) ? -INFINITY : sel; v2 = fmaxf(v2, __shfl_xor(v2, 1)); v2 = fmaxf(v2, __shfl_xor(v2, 2)); v2 = fmaxf(v2, __shfl_xor(v2, 4));
                const float gs = m1 + v2; const int g = lane >> 3; int grank = 0;
#pragma unroll
                for (int g2 = 0; g2 < 8; ++g2) { const float o = __shfl(gs, g2 * 8); grank += (o > gs || (o == gs && g2 < g)) ? 1 : 0; }
                const bool gsel = grank < 4; const float mk = gsel ? sel : -INFINITY; int rank = 0;
                for (int e2 = 0; e2 < 64; ++e2) { const float o = __shfl(mk, e2); rank += (o > mk || (o == mk && e2 < lane)) ? 1 : 0; }
                const bool chosen = gsel && rank < 8;
                const u64 mask = __ballot(chosen); const float ssum = wave_sum(chosen ? s : 0.f);
                const int kidx = __popcll(mask & ((1ull << lane) - 1ull));
                if (chosen) tokw[(size_t)t * 8 + kidx] = s / ssum * 2.5f;
                if (lane == 0) { tmask[t] = mask; masks[it * 16 + lr] = mask; }
            }
            __syncthreads();
        }
        if (wave == 0) { const u64 m = masks[lane]; int mine = 0;
            for (int e = 0; e < 64; ++e) { const int c = __popcll(__ballot((m >> e) & 1ull)); mine = (lane == e) ? c : mine; }
            cnt[blk * 64 + lane] = mine; }
        __syncthreads();
    }
}

__device__ __forceinline__ void phase7(const Args& a, LAS unsigned char* lds, int tid, int lane, int wave, int vcu, int G) {
    unsigned char* ws = a.ws;
    const int* cnt = (const int*)(ws + T_CNT); const u64* tmask = (const u64*)(ws + T_MASK); const float* tokw = (const float*)(ws + T_TOKW);
    int* tokslot = (int*)(ws + T_TOKSLOT); int* slottok = (int*)(ws + T_SLOTTOK); float* slotw = (float*)(ws + T_SLOTW); int* tile = (int*)(ws + T_TILE);
    LAS int* part = (LAS int*)lds;
    LAS int* tot = (LAS int*)(lds + 4096);
    for (int blk = vcu; blk < NT / 64; blk += G) {
        int pre = 0, all = 0;
        for (int b2 = wave; b2 < 256; b2 += 8) { const int c = cnt[b2 * 64 + lane]; all += c; pre += (b2 < blk) ? c : 0; }
        part[(wave * 2) * 64 + lane] = pre; part[(wave * 2 + 1) * 64 + lane] = all;
        __syncthreads();
        if (wave == 0) {
            int p = 0, t = 0;
#pragma unroll
            for (int w = 0; w < 8; ++w) { p += part[(w * 2) * 64 + lane]; t += part[(w * 2 + 1) * 64 + lane]; }
            int incl = t;
#pragma unroll
            for (int o = 1; o < 64; o <<= 1) { const int v = __shfl_up(incl, o); if (lane >= o) incl += v; }
            const int start = incl - t; const int base = start + p;
            tot[lane] = t; tot[64 + lane] = start;
            const int tokn = blk * 64 + lane; const u64 m = tmask[tokn];
            for (int e = 0; e < 64; ++e) { const bool bit = (m >> e) & 1ull; const u64 bal = __ballot(bit); const int be = __shfl(base, e);
                if (bit) { const int rank = __popcll(bal & ((1ull << lane) - 1ull)); const int slot = be + rank; const int k = __popcll(m & ((1ull << e) - 1ull));
                    slottok[slot] = tokn; slotw[slot] = tokw[(size_t)tokn * 8 + k]; tokslot[(size_t)tokn * 8 + k] = slot; } }
            slottok[SH_ROW0 + tokn] = tokn; slotw[SH_ROW0 + tokn] = 1.f;
        }
        __syncthreads();
        if (blk == 0 && tid == 0) {
            int n = 0;
            for (int e = 0; e < 64; ++e) { const int te = tot[e], st = tot[64 + e];
                for (int j = 0; j * 256 < te; ++j) { tile[n] = e; tile[NTILE_MAX + n] = st + j * 256; tile[2 * NTILE_MAX + n] = (te - j * 256) < 256 ? (te - j * 256) : 256; ++n; } }
            for (int j = 0; j < 64; ++j) { tile[n] = 64; tile[NTILE_MAX + n] = SH_ROW0 + j * 256; tile[2 * NTILE_MAX + n] = 256; ++n; }
            tile[3 * NTILE_MAX] = n;
        }
        __syncthreads();
    }
}

__device__ __forceinline__ void phase10(const Args& a, LAS unsigned char* lds, int lane, int wave, int vcu, int G) {
    unsigned char* ws = a.ws;
    const float* mod = (const float*)(ws + WS_MOD); const unsigned char* SO = ws + WS_SLOTOUT; const int* tokslot = (const int*)(ws + T_TOKSLOT); const float* gp = a.in[9];
    LAS float* ysc = (LAS float*)(lds + wave * 8192);
    const unsigned lo16_ = 16u * (unsigned)lane;
#pragma unroll 1
    for (int t = vcu * 8 + wave; t < NT; t += G * 8) {
        const float* mr = mod + (size_t)(t >> 11) * 12288;
        const int myslot = lane < 8 ? tokslot[(size_t)t * 8 + lane] : SH_ROW0 + t;
        unsigned lo16 = lo16_; asm volatile("" : "+v"(lo16));
        v4u x[9][2]; f32x4 xo[8]; v2u yb[8];
        const unsigned char* x1r = (const unsigned char*)(a.in[0] + (size_t)t * 2048); const unsigned char* y1r = (const unsigned char*)((const bf16*)(ws + RA_Y1) + (size_t)t * 2048);
        const float rstd1 = ((const float*)(ws + T_RSTD1))[t];
#pragma unroll
        for (int k = 0; k < 9; ++k) { const int slot = __builtin_amdgcn_readfirstlane(__shfl(myslot, k)); const unsigned char* sr = SO + (size_t)slot * 2048;
#pragma unroll
            for (int j = 0; j < 2; ++j) x[k][j] = *(const v4u*)(sr + (lo16 + 1024u * j)); }
        float y[2][16];
#pragma unroll
        for (int j = 0; j < 2; ++j)
#pragma unroll
            for (int q = 0; q < 16; ++q) y[j][q] = 0.f;
#pragma unroll
        for (int k = 0; k < 9; ++k)
#pragma unroll
            for (int j = 0; j < 2; ++j) { v4u v = x[k][j]; asm volatile("" : "+v"(v) : "v"(y[j][0]), "v"(y[j][15]));
#pragma unroll
                for (int w = 0; w < 4; ++w) { const unsigned d = v[w]; const auto lo = __builtin_amdgcn_cvt_pk_f32_fp8(d, false), hi = __builtin_amdgcn_cvt_pk_f32_fp8(d, true);
                    y[j][4 * w] += lo[0]; y[j][4 * w + 1] += lo[1]; y[j][4 * w + 2] += hi[0]; y[j][4 * w + 3] += hi[1]; } }
        asm volatile("" ::: "memory");
#pragma unroll
        for (int j = 0; j < 8; ++j) { xo[j] = *(const f32x4*)(x1r + (lo16 + 1024u * j)); yb[j] = *(const v2u*)(y1r + (lo16 / 2u + 512u * j)); }
        float ss = 0.f;
#pragma unroll
        for (int j = 0; j < 2; ++j)
#pragma unroll
            for (int q = 0; q < 16; ++q) ss += y[j][q] * y[j][q];
        const float rstd = rsqrtf(wave_sum(ss) * (1.f / 2048.f) + EPS * SC_O * SC_O);
#pragma unroll
        for (int j = 0; j < 2; ++j)
#pragma unroll
            for (int q = 0; q < 4; ++q) *(LAS f32x4*)(ysc + 16 * (lane + 64 * j) + 4 * q) = (f32x4){y[j][4 * q], y[j][4 * q + 1], y[j][4 * q + 2], y[j][4 * q + 3]};
        LDS_WAIT(); asm volatile("" ::: "memory");
        unsigned char* outr = (unsigned char*)(a.out + (size_t)t * 2048); const unsigned char* gpb = (const unsigned char*)gp; const unsigned char* g1b = (const unsigned char*)a.in[7];
        const unsigned char* gt2b = (const unsigned char*)(mr + 10240); const unsigned char* gt1b = (const unsigned char*)(mr + 4096);
#pragma unroll
        for (int j = 0; j < 8; ++j) { const unsigned cb = lo16 + 1024u * j; const f32x4 yy = *(const LAS f32x4*)(ysc + 4 * (lane + 64 * j)), g = *(const f32x4*)(gpb + cb), gt = *(const f32x4*)(gt2b + cb);
            const f32x4 g1 = *(const f32x4*)(g1b + cb), gt1 = *(const f32x4*)(gt1b + cb); const f32x4 y1 = (f32x4){bflo(yb[j].x), bfhi(yb[j].x), bflo(yb[j].y), bfhi(yb[j].y)};
            const f32x4 x1 = xo[j] + gt1 * (y1 * rstd1 * g1);
            *(f32x4*)(outr + cb) = x1 + gt * (yy * rstd * g); }
        LDS_WAIT(); asm volatile("" ::: "memory");
    }
}

__global__ void __launch_bounds__(512, 2) fwd(Args args) {
    extern __shared__ __attribute__((aligned(16))) unsigned char lds_raw[];
    LAS unsigned char* lds = (LAS unsigned char*)lds_raw;
    const int tid = threadIdx.x, lane = tid & 63, wave = __builtin_amdgcn_readfirstlane(tid >> 6);
    const int G = gridDim.x, bx = blockIdx.x;
    const int vcu = (G % 8 == 0) ? (bx % 8) * (G / 8) + bx / 8 : bx;
    unsigned char* ws = args.ws;
    volatile LAS unsigned* MISC = (volatile LAS unsigned*)(lds + LDS_MISC);
    if (tid < 64) MISC[tid] = 0u;
    __syncthreads();
    const int lo = args.ph_lo, hi = args.ph_hi;
    XcdBarrier bar; bar.bar = (unsigned*)(ws + WS_CTL) + 4096; bar.x = 0; bar.st = nullptr;
    if (hi - lo > 1) bar = xcd_barrier_post((unsigned*)(ws + WS_CTL) + 4096, MISC + 8);
#ifndef PH_MASK
#define PH_MASK 0xfff
#endif
#define IN(k) (((PH_MASK >> (k)) & 1) && lo <= (k) && (k) < hi)
#define SEAM(k) do { if (IN(k) && IN((k) + 1)) xcd_barrier(bar); } while (0)

#ifndef REP_PHASE
#define REP_PHASE -1
#endif
#define PH_IDS int tz_ = threadIdx.x; asm volatile("" : "+v"(tz_)); const int tid = tz_, lane = tz_ & 63, wave = __builtin_amdgcn_readfirstlane(tz_ >> 6); (void)tid; (void)lane; (void)wave;
#define RUNPH(k, ...) do { if (IN(k)) { { PH_IDS __VA_ARGS__ } if (REP_PHASE == (k)) { xcd_barrier(bar); { PH_IDS __VA_ARGS__ } } SEAM(k); } } while (0)
    RUNPH(0, phase0(args, lds, tid, lane, wave, vcu, G););
    RUNPH(1, phase1(args, lane, wave, vcu, G););
    RUNPH(2, {
        DenseSched S; S.init(ws + RA_H, ws + WS_WIN, 2048, 2048, MROWS, DINP, G, bx);
        EpiIn E{ws};
        pg8::gemm_phase<EpiIn, DenseSched>(lds, 2048, S, E); });
    RUNPH(3, phase3_prep(args, lds, tid, vcu, G); phase3_pool(args, lds, tid, vcu, G););
    RUNPH(4, phase_chain(args, lds, tid, lane, wave, vcu, G););
    RUNPH(5, {
        phase4_post(args, lane, wave, vcu, G);
        PoolSched S{(const char*)(ws + RA_DPOOL), (const char*)(ws + WS_WPOOL), G, vcu};
        EpiPool E{(bf16*)(ws + RA_YMIX), args.in[17]};
        int kpool = 256; asm volatile("" : "+s"(kpool));
        pg8::gemm_phase<EpiPool, PoolSched>(lds, kpool, S, E); });
    RUNPH(6, {
        DenseSched S; S.init(ws + RA_YMIX, ws + WS_WOUT, 2048, 2048, NT, 2048, G, bx);
        EpiOut E{(bf16*)(ws + RA_Y1)};
        pg8::gemm_phase<EpiOut, DenseSched>(lds, 2048, S, E); });
    RUNPH(7, phase6(args, lds, tid, lane, wave, vcu, G););
    RUNPH(8, phase7(args, lds, tid, lane, wave, vcu, G););
    RUNPH(9, {
        MoeGUSched S{(const char*)(ws + RA_H2), (const char*)(ws + WS_WGU), (const int*)(ws + T_TILE), (const int*)(ws + T_SLOTTOK), G, vcu};
        EpiGU E{ws + WS_ACT, (const float*)(ws + T_SLOTW)};
        int kgu = 1024; asm volatile("" : "+s"(kgu));
        pg8::gemm_phase<EpiGU, MoeGUSched, true>(lds, kgu, S, E); });
    RUNPH(10, {
        MoeDownSched S{(const char*)(ws + WS_ACT), (const char*)(ws + WS_WD), (const int*)(ws + T_TILE), G, vcu};
        EpiDown E{ws + WS_SLOTOUT};
        int kdn = 256; asm volatile("" : "+s"(kdn));
        pg8::gemm_phase<EpiDown, MoeDownSched, true>(lds, kdn, S, E); });
    if (IN(11)) { { PH_IDS phase10(args, lds, lane, wave, vcu, G); } if (REP_PHASE == 11) { xcd_barrier(bar); { PH_IDS phase10(args, lds, lane, wave, vcu, G); } } }
#undef IN
#undef SEAM
}

extern "C" void kernel_launch(void* const* d_in, const int* in_sizes, int n_in, void* d_out, int out_size, void* d_ws, size_t ws_size, hipStream_t stream) {
    static int grid = 0;
    if (grid == 0) {
        if (n_in != 27 || out_size != NT * DM || ws_size < WS_NEED) { fprintf(stderr, "kernel_launch: unexpected problem: n_in %d out %d ws %zu (need %zu)\n", n_in, out_size, ws_size, (size_t)WS_NEED); grid = -1; return; }
        int dev = 0, cus = 0, per_cu = 0;
        if (hipGetDevice(&dev) != hipSuccess || hipDeviceGetAttribute(&cus, hipDeviceAttributeMultiprocessorCount, dev) != hipSuccess) { grid = -1; return; }
        if (hipFuncSetAttribute((const void*)fwd, hipFuncAttributeMaxDynamicSharedMemorySize, LDS_BYTES) != hipSuccess) { fprintf(stderr, "kernel_launch: hipFuncSetAttribute failed\n"); grid = -1; return; }
        if (hipOccupancyMaxActiveBlocksPerMultiprocessor(&per_cu, (const void*)fwd, 512, LDS_BYTES) != hipSuccess || per_cu < 1) { fprintf(stderr, "kernel_launch: occupancy query says %d\n", per_cu); }
        (void)hipGetLastError();
        grid = cus;
    }
    if (grid < 0) return;
    (void)hipMemsetAsync((char*)d_ws + WS_CTL, 0, CTL_ZERO_BYTES, stream);
    Args a{};
    for (int i = 0; i < 27; ++i) a.in[i] = (const float*)d_in[i];
    a.out = (float*)d_out; a.ws = (unsigned char*)d_ws;
    if (N_LAUNCHES == 1) {
        a.ph_lo = 0; a.ph_hi = NPH;
        hipLaunchKernelGGL(fwd, dim3(grid), dim3(512), LDS_BYTES, stream, a);
    } else {
        for (int p = 0; p < NPH; ++p) { a.ph_lo = p; a.ph_hi = p + 1; hipLaunchKernelGGL(fwd, dim3(grid), dim3(512), LDS_BYTES, stream, a); }
    }
}
```

```cpp
#include <hip/hip_runtime.h>
#include <cstdio>
#include <cstdint>

#ifndef N_LAUNCHES
#define N_LAUNCHES 1
#endif

#define GAS __attribute__((address_space(1)))
#define LAS __attribute__((address_space(3)))
typedef unsigned short bf16;
typedef unsigned v4u __attribute__((ext_vector_type(4)));
typedef unsigned v2u __attribute__((ext_vector_type(2)));
typedef float f32x4 __attribute__((ext_vector_type(4)));
typedef short bf16x8 __attribute__((ext_vector_type(8)));
typedef unsigned long long u64;

constexpr int NB = 8, SEQ = 2048, DM = 2048, CTXL = 256;
constexpr int NT = NB * SEQ;
constexpr int NTC = NB * CTXL;
constexpr int MROWS = NT + NTC;
constexpr int DIN = 4128, DINP = 4352;
constexpr int NE = 64, TOPK = 8, DE = 512;
constexpr int NSLOT_E = NT * TOPK;
constexpr int SH_ROW0 = NSLOT_E + 256;
constexpr int NSLOT = SH_ROW0 + NT;
constexpr int NTILE_MAX = 704;
constexpr float EPS = 1e-6f;
constexpr int NPH = 12;

constexpr size_t MiB = 1u << 20;
constexpr size_t WS_CTL = 0, CTL_ZERO_BYTES = 64 * 1024;
constexpr size_t WS_MOD = 1 * MiB;
constexpr size_t WS_WRT = 1 * MiB + 512 * 1024;
constexpr size_t WS_WIN = 2 * MiB;
constexpr size_t WS_WOUT = WS_WIN + 17 * MiB;
constexpr size_t WS_WPOOL = WS_WOUT + 8 * MiB;
constexpr size_t WS_WD = WS_WPOOL + 1 * MiB;
constexpr size_t WS_WGU = WS_WD + 130 * MiB;
constexpr size_t WS_RA = WS_WGU + 260 * MiB;
constexpr size_t RA_H = WS_RA;
constexpr size_t RA_OF = WS_RA;
constexpr size_t RA_H2 = WS_RA;
constexpr size_t RA_Q = WS_RA + 128 * MiB;
constexpr size_t RA_K = RA_Q + 16 * MiB;
constexpr size_t RA_V = RA_K + 18 * MiB;
constexpr size_t RA_R = RA_V + 36 * MiB;
constexpr size_t RA_P = RA_R + 32 * MiB;
constexpr size_t RA_ALR = RA_P + 32 * MiB;
constexpr size_t RA_DPOOL = RA_ALR + 3 * MiB;
constexpr size_t RA_YMIX = RA_DPOOL + 32 * MiB;
constexpr size_t RA_Y1 = WS_RA + 128 * MiB;
constexpr size_t RA_END = RA_YMIX + 64 * MiB;
constexpr size_t WS_SLOTOUT = WS_WGU;
constexpr size_t WS_ACT = RA_END > WS_SLOTOUT + 578 * MiB ? RA_END : WS_SLOTOUT + 578 * MiB;
constexpr size_t WS_END = WS_ACT + 145 * MiB;
constexpr size_t PQG = WS_ACT;
constexpr size_t PAM = WS_ACT + 32 * MiB;
constexpr size_t PKD = WS_ACT + 96 * MiB;
constexpr size_t PDEC = WS_ACT + 132 * MiB;
constexpr size_t WS_T0 = WS_END;
constexpr size_t T_CNT = WS_T0;
constexpr size_t T_MASK = T_CNT + 65536;
constexpr size_t T_TOKW = T_MASK + 131072;
constexpr size_t T_TOKSLOT = T_TOKW + 524288;
constexpr size_t T_SLOTTOK = T_TOKSLOT + 524288;
constexpr size_t T_SLOTW = T_SLOTTOK + 655360;
constexpr size_t T_TILE = T_SLOTW + 655360;
constexpr size_t T_RSTD1 = (T_TILE + 16384 + 4095) / 4096 * 4096;
constexpr size_t WS_NEED = T_RSTD1 + (size_t)NT * 4;

constexpr int RING_BYTES = 131072;
constexpr int LDS_BYTES = 147456;
constexpr int LDS_MISC = LDS_BYTES - 256;
constexpr int RT_ROWB = 4112;
constexpr int RT_HI = 0, RT_LO = 16 * RT_ROWB;
constexpr int LDS_LOGIT = 2 * 16 * RT_ROWB;
constexpr int LDS_MASKS = LDS_LOGIT + 4096;
static_assert(LDS_MASKS + 512 <= LDS_MISC, "LDS map");

#define LDS_WAIT() asm volatile("s_waitcnt lgkmcnt(0)" ::: "memory")
#define VM_WAIT() asm volatile("s_waitcnt vmcnt(0)" ::: "memory")

__device__ __forceinline__ unsigned f2bf(float f) { unsigned u = __builtin_bit_cast(unsigned, f); return (u + 0x7fffu + ((u >> 16) & 1u)) >> 16; }
__device__ __forceinline__ unsigned pk2(float lo, float hi) { return f2bf(lo) | (f2bf(hi) << 16); }
__device__ __forceinline__ float bflo(unsigned u) { return __builtin_bit_cast(float, u << 16); }
__device__ __forceinline__ float bfhi(unsigned u) { return __builtin_bit_cast(float, u & 0xffff0000u); }
__device__ __forceinline__ float bf1(bf16 b) { return __builtin_bit_cast(float, ((unsigned)b) << 16); }
__device__ __forceinline__ float wave_sum(float v) {
#pragma unroll
    for (int o = 1; o < 64; o <<= 1) v += __shfl_xor(v, o);
    return v;
}
__device__ __forceinline__ float silu_f(float x) { return x / (1.f + __expf(-x)); }

#define XB_TMO      128
#define XB_XCNT(j)  (256  + 64 * (j))
#define XB_XSUB(j)  (1280 + 64 * (j))
#define XB_XGEN(j)  (2304 + 64 * (j))
#define XB_TOP      3328
#define XB_TOPGEN   3392
#define XCD_BAR_WORDS 3456
#define XB_SPIN_CAP (1u << 18)

__device__ __forceinline__ unsigned xb_ld(unsigned* p)              { return __hip_atomic_load(p, __ATOMIC_RELAXED, __HIP_MEMORY_SCOPE_AGENT); }
__device__ __forceinline__ unsigned xb_add(unsigned* p, unsigned v) { return __hip_atomic_fetch_add(p, v, __ATOMIC_RELAXED, __HIP_MEMORY_SCOPE_AGENT); }
__device__ __forceinline__ unsigned xb_xcc_id() { return (unsigned)__builtin_amdgcn_s_getreg((3 << 11) | 20) & 0xFu; }
#define XB_SPIN(cond, bar) do { unsigned _sp = 0; while (cond) { __builtin_amdgcn_s_sleep(1); \
    if ((++_sp & 255u) == 0u) { if (xb_ld(&(bar)[XB_TMO])) break; if (_sp > XB_SPIN_CAP) { atomicAdd(&(bar)[XB_TMO], 1u); break; } } } } while (0)

struct XcdBarrier { unsigned* bar; unsigned x; volatile LAS unsigned* st; };

__device__ __forceinline__ XcdBarrier xcd_barrier_post(unsigned* bar, volatile LAS unsigned* st) {
    XcdBarrier b; b.bar = bar; b.x = xb_xcc_id(); b.st = st;
    if (threadIdx.x == 0) (void)xb_add(&bar[XB_XCNT(b.x)], 1u);
    return b;
}
__device__ __forceinline__ void xcd_barrier_complete(unsigned* bar, unsigned x, unsigned& nloc, unsigned& nx) {
    const unsigned G = gridDim.x * gridDim.y * gridDim.z;
    unsigned sum, cnt, mine, sp = 0u;
    for (;;) {
        sum = 0u; cnt = 0u; mine = 0u;
#pragma unroll
        for (unsigned j = 0; j < 16; ++j) { const unsigned c = xb_ld(&bar[XB_XCNT(j)]); sum += c; cnt += (c > 0u) ? 1u : 0u; mine = (j == x) ? c : mine; }
        if (sum == G) break;
        __builtin_amdgcn_s_sleep(1);
        if ((++sp & 255u) == 0u) { if (xb_ld(&bar[XB_TMO])) break; if (sp > XB_SPIN_CAP) { atomicAdd(&bar[XB_TMO], 1u); break; } }
    }
    nloc = mine > 0u ? mine : 1u; nx = cnt > 0u ? cnt : 1u;
}
__device__ __forceinline__ void xcd_barrier(const XcdBarrier& b) {
    asm volatile("s_waitcnt vmcnt(0)" ::: "memory");
    __syncthreads();
    if (threadIdx.x == 0) {
        unsigned* bar = b.bar;
        __builtin_amdgcn_s_waitcnt(0);
        unsigned nloc = b.st[0], nx = b.st[1];
        if (nloc == 0u) { xcd_barrier_complete(bar, b.x, nloc, nx); b.st[0] = nloc; b.st[1] = nx; }
        const unsigned old = xb_add(&bar[XB_XSUB(b.x)], 1u);
        const unsigned gen = old / nloc;
        if (old + 1u == (gen + 1u) * nloc) {
            __builtin_amdgcn_fence(__ATOMIC_RELEASE, "agent");
            asm volatile("s_waitcnt vmcnt(0)" ::: "memory");
            const unsigned og = xb_add(&bar[XB_TOP], 1u);
            const unsigned tg = og / nx;
            if (og + 1u == (tg + 1u) * nx) xb_add(&bar[XB_TOPGEN], 1u);
            else XB_SPIN(xb_ld(&bar[XB_TOPGEN]) == tg, bar);
            __builtin_amdgcn_fence(__ATOMIC_ACQUIRE, "agent");
            xb_add(&bar[XB_XGEN(b.x)], 1u);
            asm volatile("s_waitcnt vmcnt(0)" ::: "memory");
        } else {
            XB_SPIN(xb_ld(&bar[XB_XGEN(b.x)]) == gen, bar);
            __builtin_amdgcn_fence(__ATOMIC_ACQUIRE, "agent");
            asm volatile("s_waitcnt vmcnt(0)" ::: "memory");
        }
    }
    __syncthreads();
}

namespace pg8 {
constexpr int BM = 256, BK = 64, HALF = 128, HTB = HALF * BK * 2, STAGE_BYTES = 8 * HTB, NXCD = 8, WGM = 8;
__device__ __forceinline__ int lds_byte(int r, int c) { const int st = (r >> 4) * 2 + (c >> 5), rr = r & 15, cc = c & 31, ob = rr * 64 + cc * 2; return st * 1024 + (ob ^ (((ob >> 9) & 1) << 5)); }
__device__ __forceinline__ void stage_rc(int b, int& R, int& C) { const int st = b / 1024, sb = b % 1024, swz = sb ^ (((sb >> 9) & 1) << 5); R = (st >> 1) * 16 + swz / 64; C = (st & 1) * 32 + (swz % 64) / 2; }
__device__ __forceinline__ int perm32(int rho) { const int n = rho >> 4, i = rho & 15; return 8 * (i >> 2) + 4 * n + (i & 3); }
__device__ __forceinline__ unsigned cvt_pk_bf16(float lo, float hi) { unsigned r; asm volatile("v_cvt_pk_bf16_f32 %0, %1, %2" : "=v"(r) : "v"(lo), "v"(hi)); return r; }

typedef int v8i __attribute__((ext_vector_type(8)));
typedef int v4i __attribute__((ext_vector_type(4)));
template <class Epi, class Sched, bool FP8 = false>
__device__ __forceinline__ void gemm_phase(LAS unsigned char* lds, const int K, const Sched& S, const Epi& E) {
    typedef typename Sched::U Unit;
    const int tid = threadIdx.x, wid = __builtin_amdgcn_readfirstlane(tid >> 6), lane = tid & 63, wr = wid >> 2, wc = wid & 3, fr = lane & 15, fq = lane >> 4;
    const int nt = K / BK;
    int R[2], C[2]; unsigned voffB[2];
#pragma unroll
    for (int i = 0; i < 2; ++i) { stage_rc(tid * 16 + i * 8192, R[i], C[i]);
        const int Rb = Epi::PERMK == 2 ? (64 * (R[i] >> 5) + 16 * ((R[i] & 15) >> 2) + 4 * ((R[i] >> 4) & 1) + (R[i] & 3)) : (Epi::PERMK == 1 ? ((R[i] & ~31) + perm32(R[i] & 31)) : R[i]);
        voffB[i] = (unsigned)(Rb * K + C[i]) * 2u; }
    const size_t kstep = (size_t)(BK * 2);
    const size_t hstepB = (size_t)(Epi::PERMK == 2 ? 8 : HALF) * K * 2;
    const unsigned ldsw = (unsigned)wid * 1024u;
    const int aoff = lds_byte(wr * 64 + fr, fq * 8), boff = lds_byte(wc * 32 + fr, fq * 8);
#define PG8_SA(b, h) (((b) * 2 + (h)) * HTB)
#define PG8_SB(b, h) ((4 + (b) * 2 + (h)) * HTB)
#define PG8_STAGE(bufoff, gbase, v0, v1) do { \
        __builtin_amdgcn_global_load_lds((const unsigned*)((const char*)(gbase) + (v0)), (LAS unsigned*)(lds + (bufoff) + ldsw), 16, 0, 0); \
        __builtin_amdgcn_global_load_lds((const unsigned*)((const char*)(gbase) + (v1)), (LAS unsigned*)(lds + (bufoff) + ldsw + 8192), 16, 0, 0); } while (0)
#define PG8_LDA(dst, b, h) do { _Pragma("unroll") for (int m = 0; m < 4; ++m) { const v4i lo_ = *(const LAS v4i*)(lds + PG8_SA(b, h) + aoff + m * 2048), hi_ = *(const LAS v4i*)(lds + PG8_SA(b, h) + aoff + m * 2048 + 1024); \
        dst[m] = __builtin_shufflevector(lo_, hi_, 0, 1, 2, 3, 4, 5, 6, 7); } } while (0)
#define PG8_LDB(dst, b, h) do { _Pragma("unroll") for (int n = 0; n < 2; ++n) { const v4i lo_ = *(const LAS v4i*)(lds + PG8_SB(b, h) + boff + n * 2048), hi_ = *(const LAS v4i*)(lds + PG8_SB(b, h) + boff + n * 2048 + 1024); \
        dst[n] = __builtin_shufflevector(lo_, hi_, 0, 1, 2, 3, 4, 5, 6, 7); } } while (0)
#define PG8_H0(x) ((bf16x8)__builtin_shufflevector(x, x, 0, 1, 2, 3))
#define PG8_H1(x) ((bf16x8)__builtin_shufflevector(x, x, 4, 5, 6, 7))
#define PG8_MMA(ai, bj, At, Bt) do { __builtin_amdgcn_s_setprio(1); if constexpr (FP8) asm volatile("s_nop 4"); _Pragma("unroll") for (int m = 0; m < 4; ++m) _Pragma("unroll") for (int n = 0; n < 2; ++n) { \
        if constexpr (FP8) asm volatile("v_mfma_f32_16x16x128_f8f6f4 %0, %1, %2, %0" : "+v"(acc[ai][bj][m][n]) : "v"(Bt[n]), "v"(At[m])); \
        else { acc[ai][bj][m][n] = __builtin_amdgcn_mfma_f32_16x16x32_bf16(PG8_H0(Bt[n]), PG8_H0(At[m]), acc[ai][bj][m][n], 0, 0, 0); \
               acc[ai][bj][m][n] = __builtin_amdgcn_mfma_f32_16x16x32_bf16(PG8_H1(Bt[n]), PG8_H1(At[m]), acc[ai][bj][m][n], 0, 0, 0); } } \
        __builtin_amdgcn_s_setprio(0); } while (0)
#define PG8_WAIT_V(n) asm volatile("s_waitcnt vmcnt(" #n ")" ::: "memory")
#define PG8_WAIT_L(n) asm volatile("s_waitcnt lgkmcnt(" #n ")" ::: "memory")
#define PG8_BAR __builtin_amdgcn_s_barrier()
#define PG8_SCHED __builtin_amdgcn_sched_barrier(0)
    Unit cur, nxt; int ui = 0;
    if (!S.next(0, cur)) return;
    f32x4 acc[2][2][4][2];
#pragma unroll
    for (int a = 0; a < 2; ++a)
#pragma unroll
        for (int b = 0; b < 2; ++b)
#pragma unroll
            for (int m = 0; m < 4; ++m)
#pragma unroll
                for (int n = 0; n < 2; ++n) acc[a][b][m][n] = (f32x4){0.f, 0.f, 0.f, 0.f};
    v8i At[4], B0[2], B1[2];
    unsigned vA[4], vN[4];
    S.aoffs(cur, R, C, vA);
    const char* cA = cur.A; const char* cB = cur.B;
    PG8_STAGE(PG8_SB(0, 0), cB, voffB[0], voffB[1]); PG8_STAGE(PG8_SB(0, 1), cB + hstepB, voffB[0], voffB[1]); PG8_STAGE(PG8_SA(0, 0), cA, vA[0], vA[1]); PG8_STAGE(PG8_SA(0, 1), cA, vA[2], vA[3]);
    if (wr == 1) PG8_BAR;
    PG8_WAIT_V(2); PG8_BAR;
    PG8_STAGE(PG8_SB(1, 0), cB + kstep, voffB[0], voffB[1]); PG8_STAGE(PG8_SA(1, 0), cA + kstep, vA[0], vA[1]); PG8_STAGE(PG8_SB(1, 1), cB + hstepB + kstep, voffB[0], voffB[1]);
    PG8_WAIT_V(6); PG8_BAR;
    for (;;) {
        const bool has_next = S.next(ui + 1, nxt);
        const char* nA = has_next ? nxt.A : cA; const char* nB = has_next ? nxt.B : cB;
        if (has_next) S.aoffs(nxt, R, C, vN); else { vN[0] = vA[0]; vN[1] = vA[1]; vN[2] = vA[2]; vN[3] = vA[3]; }
        for (int t = 0; t < nt; t += 2) {
            const bool last = (t == nt - 2);
            const char* a1 = cA + (size_t)(t + 1) * kstep;
            const char* a2 = last ? nA : cA + (size_t)(t + 2) * kstep; const char* b2 = last ? nB : cB + (size_t)(t + 2) * kstep;
            const char* a3 = a2 + kstep; const char* b3 = b2 + kstep;
            const unsigned x0 = last ? vN[0] : vA[0], x1 = last ? vN[1] : vA[1], x2 = last ? vN[2] : vA[2], x3 = last ? vN[3] : vA[3];
            PG8_LDB(B0, 0, 0); PG8_LDB(B1, 0, 1); PG8_SCHED; PG8_LDA(At, 0, 0); PG8_STAGE(PG8_SA(1, 1), a1, vA[2], vA[3]);
            PG8_WAIT_V(8); PG8_WAIT_L(0); PG8_BAR; PG8_MMA(0, 0, At, B0); PG8_MMA(0, 1, At, B1); PG8_BAR; PG8_SCHED;
            PG8_LDA(At, 0, 1); PG8_STAGE(PG8_SB(0, 0), b2, voffB[0], voffB[1]); PG8_STAGE(PG8_SB(0, 1), b2 + hstepB, voffB[0], voffB[1]); PG8_STAGE(PG8_SA(0, 0), a2, x0, x1);
            PG8_WAIT_V(8); PG8_WAIT_L(0); PG8_BAR; PG8_MMA(1, 0, At, B0); PG8_MMA(1, 1, At, B1); PG8_BAR; PG8_SCHED;
            PG8_LDB(B0, 1, 0); PG8_LDB(B1, 1, 1); PG8_SCHED; PG8_LDA(At, 1, 0); PG8_STAGE(PG8_SA(0, 1), a2, x2, x3);
            PG8_WAIT_V(8); PG8_WAIT_L(0); PG8_BAR; PG8_MMA(0, 0, At, B0); PG8_MMA(0, 1, At, B1); PG8_BAR; PG8_SCHED;
            PG8_LDA(At, 1, 1); PG8_STAGE(PG8_SB(1, 0), b3, voffB[0], voffB[1]); PG8_STAGE(PG8_SB(1, 1), b3 + hstepB, voffB[0], voffB[1]); PG8_STAGE(PG8_SA(1, 0), a3, x0, x1);
            PG8_WAIT_V(8); PG8_WAIT_L(0); PG8_BAR; PG8_MMA(1, 0, At, B0); PG8_MMA(1, 1, At, B1); PG8_BAR; PG8_SCHED;
        }
        if (wr == 0) PG8_BAR;
        if constexpr (FP8) asm volatile("s_nop 15\n\ts_nop 15");
        { int tz = threadIdx.x; asm volatile("" : "+v"(tz));
          const int wid_ = tz >> 6, lane_ = tz & 63; E(acc, cur, wid_ >> 2, wid_ & 3, lane_ & 15, lane_ >> 4);
#ifdef PROBE_EPI2
          if constexpr (Epi::PROBE2) { asm volatile("" : "+v"(tz)); const int w2 = tz >> 6, l2 = tz & 63; E(acc, cur, w2 >> 2, w2 & 3, l2 & 15, l2 >> 4); }
#endif
#ifdef PROBE_DRAIN
          if constexpr (Epi::PROBE2) { asm volatile("s_waitcnt vmcnt(0)" ::: "memory"); }
#endif
        }
        if (!has_next) break;
#pragma unroll
        for (int a = 0; a < 2; ++a)
#pragma unroll
            for (int b = 0; b < 2; ++b)
#pragma unroll
                for (int m = 0; m < 4; ++m)
#pragma unroll
                    for (int n = 0; n < 2; ++n) acc[a][b][m][n] = (f32x4){0.f, 0.f, 0.f, 0.f};
        cur = nxt; cA = nA; cB = nB; ++ui;
        vA[0] = vN[0]; vA[1] = vN[1]; vA[2] = vN[2]; vA[3] = vN[3];
        if (wr == 1) PG8_BAR;
    }
    PG8_WAIT_V(0);
    PG8_BAR;
#undef PG8_SA
#undef PG8_SB
#undef PG8_STAGE
#undef PG8_LDA
#undef PG8_LDB
#undef PG8_H0
#undef PG8_H1
#undef PG8_MMA
#undef PG8_WAIT_V
#undef PG8_WAIT_L
#undef PG8_BAR
#undef PG8_SCHED
}
}

struct Args { const float* in[27]; float* out; unsigned char* ws; int ph_lo, ph_hi; };
static_assert(sizeof(Args) == 27 * 8 + 8 + 8 + 8, "Args has no padding");

struct DenseU { const char* A; const char* B; int pm, pn; };
struct DenseSched {
    typedef DenseU U;
    const char* A; const char* B; int lda, K, nM, nN, nwg, G, c;
    __device__ __forceinline__ void init(const void* A_, const void* B_, int lda_, int K_, int M, int N, int G_, int c_) { A = (const char*)A_; B = (const char*)B_; lda = lda_; K = K_; nM = M / 256; nN = N / 256; nwg = nM * nN; G = G_; c = c_; }
    __device__ __forceinline__ bool next(int i, U& u) const {
        const long L = (long)i * G + c; if (L >= nwg) return false;
        int wgid = (int)L; { const int q = nwg / 8, r = nwg % 8, xcd = wgid % 8, off = wgid / 8; wgid = (xcd < r ? xcd * (q + 1) : r * (q + 1) + (xcd - r) * q) + off; }
        const int nig = 8 * nN, gid = wgid / nig, fm = gid * 8, gsz = (nM - fm) < 8 ? (nM - fm) : 8;
        u.pm = fm + ((wgid % nig) % gsz); u.pn = (wgid % nig) / gsz;
        u.A = A + (size_t)u.pm * 256 * lda * 2; u.B = B + (size_t)u.pn * 256 * K * 2; return true;
    }
    __device__ __forceinline__ void aoffs(const U&, const int (&R)[2], const int (&C)[2], unsigned (&v)[4]) const {
#pragma unroll
        for (int h = 0; h < 2; ++h)
#pragma unroll
            for (int i = 0; i < 2; ++i) v[h * 2 + i] = (unsigned)((h * 128 + R[i]) * lda + C[i]) * 2u;
    }
};
struct PoolU { const char* A; const char* B; int pm, g; };
struct PoolSched {
    typedef PoolU U;
    const char* A; const char* B; int G, c;
    __device__ __forceinline__ bool next(int i, U& u) const {
        const int L = i * G + c; if (L >= 256) return false;
        u.g = L & 3; u.pm = L >> 2;
        u.A = A + ((size_t)u.pm * 256 * 1024 + u.g * 256) * 2; u.B = B + (size_t)u.g * 256 * 256 * 2; return true;
    }
    __device__ __forceinline__ void aoffs(const U&, const int (&R)[2], const int (&C)[2], unsigned (&v)[4]) const {
#pragma unroll
        for (int h = 0; h < 2; ++h)
#pragma unroll
            for (int i = 0; i < 2; ++i) v[h * 2 + i] = (unsigned)((h * 128 + R[i]) * 1024 + C[i]) * 2u;
    }
};
struct MoeU { const char* A; const char* B; int row0, nrows, pn; };
struct MoeGUSched {
    typedef MoeU U;
    const char* H2; const char* W; const int* tile; const int* slot_tok; int G, c;
    __device__ __forceinline__ bool next(int i, U& u) const {
        const int nt = tile[3 * NTILE_MAX]; const int L = i * G + c; if (L >= nt * 4) return false;
        const int t = L >> 2; u.pn = L & 3; const int e = tile[t]; u.row0 = tile[NTILE_MAX + t]; u.nrows = tile[2 * NTILE_MAX + t];
        u.A = H2; u.B = W + ((size_t)e * 1024 + u.pn * 256) * 2048; return true;
    }
    __device__ __forceinline__ void aoffs(const U& u, const int (&R)[2], const int (&C)[2], unsigned (&v)[4]) const {
#pragma unroll
        for (int h = 0; h < 2; ++h)
#pragma unroll
            for (int i = 0; i < 2; ++i) { int r = h * 128 + R[i]; r = r < u.nrows ? r : u.nrows - 1; const int tok = slot_tok[u.row0 + r]; v[h * 2 + i] = (unsigned)(tok * 1024 + C[i]) * 2u; }
    }
};
struct MoeDownSched {
    typedef MoeU U;
    const char* ACT; const char* W; const int* tile; int G, c;
    __device__ __forceinline__ bool next(int i, U& u) const {
        const int nt = tile[3 * NTILE_MAX]; const int L = i * G + c; if (L >= nt * 8) return false;
        const int t = L >> 3; u.pn = L & 7; const int e = tile[t]; u.row0 = tile[NTILE_MAX + t]; u.nrows = tile[2 * NTILE_MAX + t];
        u.A = ACT + (size_t)u.row0 * 512; u.B = W + ((size_t)e * 2048 + u.pn * 256) * 512; return true;
    }
    __device__ __forceinline__ void aoffs(const U&, const int (&R)[2], const int (&C)[2], unsigned (&v)[4]) const {
#pragma unroll
        for (int h = 0; h < 2; ++h)
#pragma unroll
            for (int i = 0; i < 2; ++i) v[h * 2 + i] = (unsigned)((h * 128 + R[i]) * 256 + C[i]) * 2u;
    }
};

struct EpiIn {
    static constexpr int PERMK = 1; static constexpr bool PROBE2 = false;
    unsigned char* ws;
    __device__ __forceinline__ void operator()(const f32x4 (&acc)[2][2][4][2], const DenseU& u, int wr, int wc, int fr, int fq) const {
        const int pn = u.pn; const int row0 = u.pm * 256 + wr * 64 + fr;
        if (pn == 16) {
            if (wc != 0) return;
            float* alr = (float*)(ws + RA_ALR);
#pragma unroll
            for (int ai = 0; ai < 2; ++ai)
#pragma unroll
                for (int m = 0; m < 4; ++m) { float* rp = alr + (size_t)(row0 + ai * 128 + m * 16) * 32 + 8 * fq;
                    *(f32x4*)(rp) = acc[ai][0][m][0]; *(f32x4*)(rp + 4) = acc[ai][0][m][1]; }
            return;
        }
        bf16* base; int ld, colt; bool lat_only;
        if (pn < 2) { base = (bf16*)(ws + RA_Q); ld = 512; colt = pn * 256; lat_only = true; }
        else if (pn < 4) { base = (bf16*)(ws + RA_K); ld = 512; colt = (pn - 2) * 256; lat_only = false; }
        else if (pn < 8) { base = (bf16*)(ws + RA_V); ld = 1024; colt = (pn - 4) * 256; lat_only = false; }
        else if (pn < 12) { base = (bf16*)(ws + RA_R); ld = 1024; colt = (pn - 8) * 256; lat_only = true; }
        else { base = (bf16*)(ws + RA_P); ld = 1024; colt = (pn - 12) * 256; lat_only = true; }
        if (lat_only && u.pm >= 64) return;
        const int col0 = colt + wc * 32 + 8 * fq;
#pragma unroll
        for (int ai = 0; ai < 2; ++ai)
#pragma unroll
            for (int m = 0; m < 4; ++m) { bf16* rp = base + (size_t)(row0 + ai * 128 + m * 16) * ld + col0;
#pragma unroll
                for (int bj = 0; bj < 2; ++bj) { const f32x4 v0 = acc[ai][bj][m][0], v1 = acc[ai][bj][m][1];
                    v4u o; o.x = pg8::cvt_pk_bf16(v0[0], v0[1]); o.y = pg8::cvt_pk_bf16(v0[2], v0[3]); o.z = pg8::cvt_pk_bf16(v1[0], v1[1]); o.w = pg8::cvt_pk_bf16(v1[2], v1[3]);
                    *(v4u*)(rp + bj * 128) = o; } }
    }
};
struct EpiPool {
    static constexpr int PERMK = 1; static constexpr bool PROBE2 = false;
    bf16* ymix; const float* scale;
    __device__ __forceinline__ void operator()(const f32x4 (&acc)[2][2][4][2], const PoolU& u, int wr, int wc, int fr, int fq) const {
        const int row0 = u.pm * 256 + wr * 64 + fr; const int c0 = u.g * 256 + wc * 32 + 8 * fq;
#pragma unroll
        for (int ai = 0; ai < 2; ++ai)
#pragma unroll
            for (int m = 0; m < 4; ++m) { bf16* rp = ymix + (size_t)(row0 + ai * 128 + m * 16) * 2048 + 1024 + c0;
#pragma unroll
                for (int bj = 0; bj < 2; ++bj) { const f32x4 s0 = *(const f32x4*)(scale + c0 + bj * 128), s1 = *(const f32x4*)(scale + c0 + bj * 128 + 4);
                    const f32x4 v0 = acc[ai][bj][m][0] * s0, v1 = acc[ai][bj][m][1] * s1;
                    v4u o; o.x = pg8::cvt_pk_bf16(v0[0], v0[1]); o.y = pg8::cvt_pk_bf16(v0[2], v0[3]); o.z = pg8::cvt_pk_bf16(v1[0], v1[1]); o.w = pg8::cvt_pk_bf16(v1[2], v1[3]);
                    *(v4u*)(rp + bj * 128) = o; } }
    }
};
struct EpiOut {
    static constexpr int PERMK = 1; static constexpr bool PROBE2 = false;
    bf16* y;
    __device__ __forceinline__ void operator()(const f32x4 (&acc)[2][2][4][2], const DenseU& u, int wr, int wc, int fr, int fq) const {
        const int row0 = u.pm * 256 + wr * 64 + fr, col0 = u.pn * 256 + wc * 32 + 8 * fq;
#pragma unroll
        for (int ai = 0; ai < 2; ++ai)
#pragma unroll
            for (int m = 0; m < 4; ++m) { bf16* rp = y + (size_t)(row0 + ai * 128 + m * 16) * 2048 + col0;
#pragma unroll
                for (int bj = 0; bj < 2; ++bj) { const f32x4 v0 = acc[ai][bj][m][0], v1 = acc[ai][bj][m][1];
                    v4u o; o.x = pg8::cvt_pk_bf16(v0[0], v0[1]); o.y = pg8::cvt_pk_bf16(v0[2], v0[3]); o.z = pg8::cvt_pk_bf16(v1[0], v1[1]); o.w = pg8::cvt_pk_bf16(v1[2], v1[3]);
                    *(v4u*)(rp + bj * 128) = o; } }
    }
};
constexpr float SC_W = 256.f, SC_H = 16.f, SC_A = 16.f;
__device__ __forceinline__ unsigned pk4_fp8(float a, float b, float c, float d) {
    a = fminf(fmaxf(a, -448.f), 448.f); b = fminf(fmaxf(b, -448.f), 448.f); c = fminf(fmaxf(c, -448.f), 448.f); d = fminf(fmaxf(d, -448.f), 448.f);
    unsigned w = 0; w = __builtin_amdgcn_cvt_pk_fp8_f32(a, b, w, false); w = __builtin_amdgcn_cvt_pk_fp8_f32(c, d, w, true); return w;
}
struct EpiGU {
    static constexpr int PERMK = 1; static constexpr bool PROBE2 = false;
    unsigned char* act; const float* slot_w;
    __device__ __forceinline__ void operator()(const f32x4 (&acc)[2][2][4][2], const MoeU& u, int wr, int wc, int fr, int fq) const {
        const int c0 = u.pn * 128 + wc * 32 + 8 * fq; constexpr float inv = 1.f / (SC_W * SC_H);
#pragma unroll
        for (int ai = 0; ai < 2; ++ai)
#pragma unroll
            for (int m = 0; m < 4; ++m) { const int r = ai * 128 + wr * 64 + m * 16 + fr;
                if (r < u.nrows) { const float w = slot_w[u.row0 + r] * SC_A; float o[8];
#pragma unroll
                    for (int n = 0; n < 2; ++n)
#pragma unroll
                        for (int j = 0; j < 4; ++j) { const float g = acc[ai][0][m][n][j] * inv, up = acc[ai][1][m][n][j] * inv; o[n * 4 + j] = silu_f(g) * up * w; }
                    v2u q; q.x = pk4_fp8(o[0], o[1], o[2], o[3]); q.y = pk4_fp8(o[4], o[5], o[6], o[7]);
                    *(v2u*)(act + (size_t)(u.row0 + r) * 512 + c0) = q; } }
    }
};
constexpr float SC_O = 32.f;
struct EpiDown {
    static constexpr int PERMK = 2; static constexpr bool PROBE2 = true;
    unsigned char* so;
    __device__ __forceinline__ void operator()(const f32x4 (&acc)[2][2][4][2], const MoeU& u, int wr, int wc, int fr, int fq) const {
        const int c0 = u.pn * 256 + wc * 64 + 16 * fq; constexpr float sc = SC_O / (SC_W * SC_A);
#pragma unroll
        for (int ai = 0; ai < 2; ++ai)
#pragma unroll
            for (int m = 0; m < 4; ++m) { const int r = ai * 128 + wr * 64 + m * 16 + fr;
                if (r < u.nrows) { const f32x4 a0 = acc[ai][0][m][0] * sc, a1 = acc[ai][0][m][1] * sc, b0 = acc[ai][1][m][0] * sc, b1 = acc[ai][1][m][1] * sc;
                    v4u o; o.x = pk4_fp8(a0[0], a0[1], a0[2], a0[3]); o.y = pk4_fp8(a1[0], a1[1], a1[2], a1[3]); o.z = pk4_fp8(b0[0], b0[1], b0[2], b0[3]); o.w = pk4_fp8(b1[0], b1[1], b1[2], b1[3]);
                    __builtin_nontemporal_store(o, (v4u*)(so + (size_t)(u.row0 + r) * 2048 + c0)); } }
    }
};

__device__ __forceinline__ void tr_item(const float* W, int ldn, bf16* WT, int Kd, int drow0, int k0, int n0, LAS float* scr, int lane) {
    f32x4 t[8];
#pragma unroll
    for (int i = 0; i < 8; ++i) t[i] = *(const f32x4*)(W + (size_t)(k0 + 8 * i + (lane >> 3)) * ldn + n0 + 4 * (lane & 7));
#pragma unroll
    for (int i = 0; i < 8; ++i) { LAS float* d = scr + (8 * i + (lane >> 3)) * 33 + 4 * (lane & 7); d[0] = t[i][0]; d[1] = t[i][1]; d[2] = t[i][2]; d[3] = t[i][3]; }
    LDS_WAIT(); asm volatile("" ::: "memory");
    const int c = lane & 7;
#pragma unroll
    for (int j = 0; j < 4; ++j) { const int n = (lane >> 3) + 8 * j; const LAS float* s = scr + (8 * c) * 33 + n;
        v4u o; o.x = pk2(s[0 * 33], s[1 * 33]); o.y = pk2(s[2 * 33], s[3 * 33]); o.z = pk2(s[4 * 33], s[5 * 33]); o.w = pk2(s[6 * 33], s[7 * 33]);
        *(v4u*)(WT + (size_t)(drow0 + n) * Kd + k0 + 8 * c) = o; }
    LDS_WAIT(); asm volatile("" ::: "memory");
}

__device__ __forceinline__ void tr_item8(const float* W, int ldn, unsigned char* WT, int Kd, int drow0, int k0, int n0, LAS float* scr, int lane) {
    f32x4 t[8];
#pragma unroll
    for (int i = 0; i < 8; ++i) t[i] = *(const f32x4*)(W + (size_t)(k0 + 8 * i + (lane >> 3)) * ldn + n0 + 4 * (lane & 7));
#pragma unroll
    for (int i = 0; i < 8; ++i) { LAS float* d = scr + (8 * i + (lane >> 3)) * 33 + 4 * (lane & 7); d[0] = t[i][0]; d[1] = t[i][1]; d[2] = t[i][2]; d[3] = t[i][3]; }
    LDS_WAIT(); asm volatile("" ::: "memory");
    const int c = lane & 7;
#pragma unroll
    for (int j = 0; j < 4; ++j) { const int n = (lane >> 3) + 8 * j; const LAS float* s = scr + (8 * c) * 33 + n;
        v2u o; o.x = pk4_fp8(s[0 * 33] * SC_W, s[1 * 33] * SC_W, s[2 * 33] * SC_W, s[3 * 33] * SC_W); o.y = pk4_fp8(s[4 * 33] * SC_W, s[5 * 33] * SC_W, s[6 * 33] * SC_W, s[7 * 33] * SC_W);
        *(v2u*)(WT + (size_t)(drow0 + n) * Kd + k0 + 8 * c) = o; }
    LDS_WAIT(); asm volatile("" ::: "memory");
}

__device__ __forceinline__ void phase0(const Args& a, LAS unsigned char* lds, int tid, int lane, int wave, int vcu, int G, bool do_mod = true, bool do_tr = true) {
    unsigned char* ws = a.ws;
    if (vcu < 192 && do_mod) {
        LAS float* sc = (LAS float*)lds;
        LAS float* red = (LAS float*)(lds + 73728);
        for (int i = tid; i < 9 * 2048; i += 512) { const int r = i >> 11, k = i & 2047; const float v = r < 8 ? a.in[1][r * 2048 + k] : a.in[3][k]; sc[i] = silu_f(v); }
        __syncthreads();
        const float* wm = a.in[4]; const float* bm = a.in[5]; float* mod = (float*)(ws + WS_MOD);
        for (int chunk = vcu; chunk < 192; chunk += G) {
            const int n0 = chunk * 64, ks = lane >> 4, n4 = (lane & 15) * 4;
            f32x4 acc[9];
#pragma unroll
            for (int r = 0; r < 9; ++r) acc[r] = (f32x4){0.f, 0.f, 0.f, 0.f};
#pragma unroll 4
            for (int kk = 0; kk < 256; kk += 4) { const int k = wave * 256 + kk + ks; const f32x4 wv = *(const f32x4*)(wm + (size_t)k * 12288 + n0 + n4);
#pragma unroll
                for (int r = 0; r < 9; ++r) { const float s = sc[r * 2048 + k]; acc[r] += wv * s; } }
#pragma unroll
            for (int r = 0; r < 9; ++r)
#pragma unroll
                for (int j = 0; j < 4; ++j) { float v = acc[r][j]; v += __shfl_xor(v, 16); v += __shfl_xor(v, 32); acc[r][j] = v; }
            if (lane < 16) {
#pragma unroll
                for (int r = 0; r < 9; ++r) *(LAS f32x4*)(red + (wave * 9 + r) * 64 + n4) = acc[r]; }
            __syncthreads();
            for (int i = tid; i < 9 * 64; i += 512) { const int r = i >> 6, n = i & 63; float s = 0.f;
#pragma unroll
                for (int w = 0; w < 8; ++w) s += red[(w * 9 + r) * 64 + n];
                mod[r * 12288 + n0 + n] = s + bm[n0 + n]; }
            __syncthreads();
        }
    }
    __syncthreads();
    LAS float* scr = (LAS float*)(lds + wave * 16384);
    const int gw = vcu * 8 + wave, NGW = G * 8;
    bf16* Win_t = (bf16*)(ws + WS_WIN); bf16* Wout_t = (bf16*)(ws + WS_WOUT); bf16* Wpool_t = (bf16*)(ws + WS_WPOOL); unsigned char* Wd_t = ws + WS_WD; unsigned char* Wgu_t = ws + WS_WGU;
    constexpr int I_IN = 32 * 129, I_OUT = 32 * 64, I_POOL = 4 * 4 * 8, I_E = 65 * 512;
    constexpr int NITEMS = I_IN + I_OUT + I_POOL + 3 * I_E;
    for (int it = gw; it < (do_tr ? NITEMS : 0); it += NGW) {
        int r = it;
        if (r < I_IN) { const int kb = r / 129, nb = r % 129, n0 = 32 * nb; const int drow = n0 < 3072 ? n0 : (n0 == 3072 ? 4096 : n0 - 32);
            tr_item(a.in[10], DIN, Win_t, 2048, drow, 64 * kb, n0, scr, lane); continue; } r -= I_IN;
        if (r < I_OUT) { const int kb = r / 64, nb = r % 64; tr_item(a.in[18], 2048, Wout_t, 2048, 32 * nb, 64 * kb, 32 * nb, scr, lane); continue; } r -= I_OUT;
        if (r < I_POOL) { const int g = r / 32, rr = r % 32, kb = rr / 8, nb = rr % 8; tr_item(a.in[16] + g * 65536, 256, Wpool_t + g * 65536, 256, 32 * nb, 64 * kb, 32 * nb, scr, lane); continue; } r -= I_POOL;
        if (r < I_E) { const int e = r / 512, rr = r % 512, kb = rr / 16, nb = rr % 16, n0 = 32 * nb; const float* src = e < 64 ? a.in[21] + (size_t)e * 2048 * 512 : a.in[24];
            tr_item8(src, 512, Wgu_t + (size_t)e * 1024 * 2048, 2048, (n0 / 128) * 256 + (n0 % 128), 64 * kb, n0, scr, lane); continue; } r -= I_E;
        if (r < I_E) { const int e = r / 512, rr = r % 512, kb = rr / 16, nb = rr % 16, n0 = 32 * nb; const float* src = e < 64 ? a.in[22] + (size_t)e * 2048 * 512 : a.in[25];
            tr_item8(src, 512, Wgu_t + (size_t)e * 1024 * 2048, 2048, (n0 / 128) * 256 + 128 + (n0 % 128), 64 * kb, n0, scr, lane); continue; } r -= I_E;
        { const int e = r / 512, rr = r % 512, kb = rr / 64, nb = rr % 64; const float* src = e < 64 ? a.in[23] + (size_t)e * 512 * 2048 : a.in[26];
            tr_item8(src, 2048, Wd_t + (size_t)e * 2048 * 512, 512, 32 * nb, 64 * kb, 32 * nb, scr, lane); }
    }
    { const float* wr = a.in[19]; bf16* whi = (bf16*)(ws + WS_WRT); bf16* wlo = whi + 64 * 2048;
      for (int idx = vcu * 512 + tid; idx < 64 * 256; idx += G * 512) { const int e = idx >> 8, k8 = idx & 255; unsigned hi[8], lo[8];
#pragma unroll
          for (int j = 0; j < 8; ++j) { const float v = wr[(size_t)(8 * k8 + j) * 64 + e]; hi[j] = f2bf(v); lo[j] = f2bf(v - __builtin_bit_cast(float, hi[j] << 16)); }
          v4u oh, ol; oh.x = hi[0] | (hi[1] << 16); oh.y = hi[2] | (hi[3] << 16); oh.z = hi[4] | (hi[5] << 16); oh.w = hi[6] | (hi[7] << 16);
          ol.x = lo[0] | (lo[1] << 16); ol.y = lo[2] | (lo[3] << 16); ol.z = lo[4] | (lo[5] << 16); ol.w = lo[6] | (lo[7] << 16);
          *(v4u*)(whi + (size_t)e * 2048 + 8 * k8) = oh; *(v4u*)(wlo + (size_t)e * 2048 + 8 * k8) = ol; } }
    { v4u* z = (v4u*)(Win_t + (size_t)DIN * 2048); const int nz = (DINP - DIN) * 2048 / 8;
      for (int i = vcu * 512 + tid; i < nz; i += G * 512) z[i] = (v4u){0u, 0u, 0u, 0u}; }
}

__device__ __forceinline__ void phase1(const Args& a, int lane, int wave, int vcu, int G) {
    const float* mod = (const float*)(a.ws + WS_MOD); bf16* H = (bf16*)(a.ws + RA_H); const float* g = a.in[6];
    for (int m = vcu * 8 + wave; m < MROWS; m += G * 8) {
        const float* xr = m < NT ? a.in[0] + (size_t)m * 2048 : a.in[2] + (size_t)(m - NT) * 2048;
        const float* mr = mod + (size_t)(m < NT ? (m >> 11) : 8) * 12288;
        f32x4 v[8]; float ss = 0.f;
#pragma unroll
        for (int j = 0; j < 8; ++j) { v[j] = *(const f32x4*)(xr + 4 * (lane + 64 * j)); ss += v[j][0] * v[j][0] + v[j][1] * v[j][1] + v[j][2] * v[j][2] + v[j][3] * v[j][3]; }
        const float rstd = rsqrtf(wave_sum(ss) * (1.f / 2048.f) + EPS);
#pragma unroll
        for (int j = 0; j < 8; ++j) { const int c = 4 * (lane + 64 * j); const f32x4 gg = *(const f32x4*)(g + c), sh = *(const f32x4*)(mr + c), sc = *(const f32x4*)(mr + 2048 + c);
            const f32x4 o = v[j] * rstd * gg * (sc + 1.f) + sh;
            v2u q; q.x = pk2(o[0], o[1]); q.y = pk2(o[2], o[3]); *(v2u*)(H + (size_t)m * 2048 + c) = q; }
    }
}

__device__ __forceinline__ int scan_row(int b, int dir, int s) {
    if (s < 256) { const int tc = dir ? 255 - s : s; return NT + b * 256 + tc; }
    const int t0 = s - 256; return b * 2048 + (dir ? 2047 - t0 : t0);
}
__device__ __forceinline__ void phase3_prep(const Args& a, LAS unsigned char* lds, int tid, int vcu, int G) {
    unsigned char* ws = a.ws;
    const bf16* Q = (const bf16*)(ws + RA_Q); const bf16* Kb = (const bf16*)(ws + RA_K); const float* ALR = (const float*)(ws + RA_ALR);
    bf16* QG = (bf16*)(ws + PQG); bf16* AM = (bf16*)(ws + PAM); bf16* KD = (bf16*)(ws + PKD); float* DEC = (float*)(ws + PDEC);
    constexpr int TS = 520;
    LAS float* alr = (LAS float*)lds;
    LAS bf16* Kt = (LAS bf16*)(lds + 4096);
    LAS bf16* Qt = (LAS bf16*)(lds + 4096 + 64 * TS * 2);
    const int col = tid, h = col >> 7, dk = col & 127;
    const int lane = tid & 63, wave = __builtin_amdgcn_readfirstlane(tid >> 6), l15 = lane & 15, l4 = lane >> 4;
    for (int item = vcu; item < 2 * 8 * 36; item += G) {
        const int ch = item % 36, b = (item / 36) & 7, dir = item / 288;
        const bool lat = ch >= 4;
        if (tid < 256) { const int i = tid >> 2, r4 = (tid & 3) * 4; const int row = scan_row(b, dir, ch * 64 + i);
            *(LAS f32x4*)(alr + i * 16 + r4) = *(const f32x4*)(ALR + (size_t)row * 32 + dir * 16 + r4); }
        { v4u kr[8], qr[8];
#pragma unroll
          for (int q = 0; q < 8; ++q) { const int p = tid + 512 * q, i = p >> 6, c8 = (p & 63) * 8; const int row = scan_row(b, dir, ch * 64 + i);
              kr[q] = *(const v4u*)(Kb + (size_t)row * 512 + c8); if (lat) qr[q] = *(const v4u*)(Q + (size_t)row * 512 + c8); }
#pragma unroll
          for (int q = 0; q < 8; ++q) { const int p = tid + 512 * q, i = p >> 6, c8 = (p & 63) * 8; *(LAS v4u*)(Kt + i * TS + c8) = kr[q]; if (lat) *(LAS v4u*)(Qt + i * TS + c8) = qr[q]; } }
        const float* wa2 = dir ? a.in[13] : a.in[11]; const float bia = (dir ? a.in[14] : a.in[12])[col];
        float w[16];
#pragma unroll
        for (int r = 0; r < 16; ++r) w[r] = wa2[r * 512 + col];
        __syncthreads();
        float Gc = 0.f, Gmid = 0.f;
#pragma unroll 4
        for (int i = 0; i < 64; ++i) { float z = bia;
#pragma unroll
            for (int r4 = 0; r4 < 4; ++r4) { const f32x4 x = *(const LAS f32x4*)(alr + i * 16 + 4 * r4); z += x[0] * w[4 * r4] + x[1] * w[4 * r4 + 1] + x[2] * w[4 * r4 + 2] + x[3] * w[4 * r4 + 3]; }
            Gc += (fminf(z, 0.f) - __logf(1.f + __expf(-fabsf(z)))) * (1.f / 16.f);
            if (i == 32) Gmid = Gc; }
        const float Gend = Gc;
        DEC[((size_t)(dir * 8 + b) * 36 + ch) * 512 + col] = __expf(Gend);
        bf16* kdrow = KD + ((((size_t)(dir * 8 + b) * 36 + ch) * 4 + h) * 128 + dk) * 64;
        const size_t lt = lat ? ((((size_t)(dir * 8 + b) * 32 + (ch - 4)) * 4 + h) * 64) * 128 + dk : 0;
        Gc = 0.f;
#pragma unroll 1
        for (int i0 = 0; i0 < 64; i0 += 8) { unsigned kd[8];
#pragma unroll
            for (int ii = 0; ii < 8; ++ii) { const int i = i0 + ii; float z = bia;
#pragma unroll
                for (int r4 = 0; r4 < 4; ++r4) { const f32x4 x = *(const LAS f32x4*)(alr + i * 16 + 4 * r4); z += x[0] * w[4 * r4] + x[1] * w[4 * r4 + 1] + x[2] * w[4 * r4 + 2] + x[3] * w[4 * r4 + 3]; }
                Gc += (fminf(z, 0.f) - __logf(1.f + __expf(-fabsf(z)))) * (1.f / 16.f);
                const float kv = bf1(Kt[i * TS + col]);
                kd[ii] = f2bf(kv * __expf(Gend - Gc));
                if (lat) { const float qv = bf1(Qt[i * TS + col]) * 0.08838834764831845f;
                    QG[lt + (size_t)i * 128] = (bf16)f2bf(qv * __expf(Gc));
                    Qt[i * TS + col] = (bf16)f2bf(qv * __expf(Gc - Gmid)); Kt[i * TS + col] = (bf16)f2bf(kv * __expf(Gmid - Gc)); } }
            v4u o; o.x = kd[0] | (kd[1] << 16); o.y = kd[2] | (kd[3] << 16); o.z = kd[4] | (kd[5] << 16); o.w = kd[6] | (kd[7] << 16);
            *(v4u*)(kdrow + i0) = o; }
        if (lat) {
            __syncthreads();
            const int hh = wave >> 1; bf16* amt = AM + ((((size_t)(dir * 8 + b) * 32 + (ch - 4)) * 4 + hh) * 64) * 64;
#pragma unroll
            for (int t2 = 0; t2 < 2; ++t2) { const int ti = (wave & 1) * 2 + t2; f32x4 c[4];
#pragma unroll
                for (int tj = 0; tj < 4; ++tj) c[tj] = (f32x4){0.f, 0.f, 0.f, 0.f};
#pragma unroll
                for (int ks = 0; ks < 4; ++ks) { const int ko = hh * 128 + 32 * ks + 8 * l4;
                    const bf16x8 bq = *(const LAS bf16x8*)(Qt + (16 * ti + l15) * TS + ko);
#pragma unroll
                    for (int tj = 0; tj < 4; ++tj) { const bf16x8 ak = *(const LAS bf16x8*)(Kt + (16 * tj + l15) * TS + ko);
                        c[tj] = __builtin_amdgcn_mfma_f32_16x16x32_bf16(ak, bq, c[tj], 0, 0, 0); } }
                const int i = 16 * ti + l15;
#pragma unroll
                for (int tj = 0; tj < 4; ++tj) { const int j0 = 16 * tj + 4 * l4;
                    v2u p; p.x = pk2(j0 <= i ? c[tj][0] : 0.f, j0 + 1 <= i ? c[tj][1] : 0.f); p.y = pk2(j0 + 2 <= i ? c[tj][2] : 0.f, j0 + 3 <= i ? c[tj][3] : 0.f);
                    *(v2u*)(amt + i * 64 + j0) = p; } }
        }
        __syncthreads();
    }
}

constexpr int GL_QG = 0, GL_ST = 17408, GL_KDT = 34816, GL_VT = 53248, GL_AM = 62464, GL_DEC = 71680;
__device__ __forceinline__ void phase_chain(const Args& a, LAS unsigned char* lds, int tid, int lane, int wave, int vcu, int G) {
    unsigned char* ws = a.ws;
    const v4u* QG = (const v4u*)(ws + PQG); const v4u* AM = (const v4u*)(ws + PAM); const v4u* KD = (const v4u*)(ws + PKD); const float* DEC = (const float*)(ws + PDEC);
    const bf16* V = (const bf16*)(ws + RA_V); bf16* OF = (bf16*)(ws + RA_OF);
    const int l15 = lane & 15, l4 = lane >> 4;
    for (int item = vcu; item < 256; item += G) {
        const int vs = item & 3, dir = (item >> 2) & 1, h = (item >> 3) & 3, b = item >> 5;
        f32x4 S[4];
#pragma unroll
        for (int tv = 0; tv < 4; ++tv) S[tv] = (f32x4){0.f, 0.f, 0.f, 0.f};
        v4u rq[2], ra, rk[2], rv; float rdec = 0.f;
#define GL_LOAD(ch_) do { const int ch__ = (ch_); \
            if (ch__ >= 4) { const size_t t_ = ((((size_t)(dir * 8 + b) * 32 + (ch__ - 4)) * 4 + h) * 1024); rq[0] = QG[t_ + tid]; rq[1] = QG[t_ + tid + 512]; ra = AM[t_ / 2 + tid]; } \
            { const size_t t_ = ((((size_t)(dir * 8 + b) * 36 + ch__) * 4 + h) * 1024); rk[0] = KD[t_ + tid]; rk[1] = KD[t_ + tid + 512]; } \
            { const int row_ = scan_row(b, dir, ch__ * 64 + (tid >> 3)); rv = *(const v4u*)(V + (size_t)row_ * 1024 + h * 256 + vs * 64 + 8 * (tid & 7)); } \
            if (tid < 128) rdec = DEC[((size_t)(dir * 8 + b) * 36 + ch__) * 512 + h * 128 + tid]; } while (0)
        GL_LOAD(0);
        for (int ch = 0; ch < 36; ++ch) {
            const bool lat = ch >= 4;
#pragma unroll
            for (int tv = 0; tv < 4; ++tv) { v2u p; p.x = pk2(S[tv][0], S[tv][1]); p.y = pk2(S[tv][2], S[tv][3]);
                *(LAS v2u*)(lds + GL_ST + (16 * tv + l15) * 272 + (16 * wave + 4 * l4) * 2) = p; }
            if (lat) {
#pragma unroll
                for (int q = 0; q < 2; ++q) { const int p = tid + 512 * q; *(LAS v4u*)(lds + GL_QG + (p >> 4) * 272 + (p & 15) * 16) = rq[q]; }
                *(LAS v4u*)(lds + GL_AM + (tid >> 3) * 144 + (tid & 7) * 16) = ra; }
#pragma unroll
            for (int q = 0; q < 2; ++q) { const int p = tid + 512 * q; *(LAS v4u*)(lds + GL_KDT + (p >> 3) * 144 + (p & 7) * 16) = rk[q]; }
            { const int i = tid >> 3, c = tid & 7; LAS bf16* vt = (LAS bf16*)(lds + GL_VT) + i;
              vt[(8 * c + 0) * 72] = (bf16)(rv.x & 0xffffu); vt[(8 * c + 1) * 72] = (bf16)(rv.x >> 16); vt[(8 * c + 2) * 72] = (bf16)(rv.y & 0xffffu); vt[(8 * c + 3) * 72] = (bf16)(rv.y >> 16);
              vt[(8 * c + 4) * 72] = (bf16)(rv.z & 0xffffu); vt[(8 * c + 5) * 72] = (bf16)(rv.z >> 16); vt[(8 * c + 6) * 72] = (bf16)(rv.w & 0xffffu); vt[(8 * c + 7) * 72] = (bf16)(rv.w >> 16); }
            if (tid < 128) *(LAS float*)(lds + GL_DEC + tid * 4) = rdec;
            __syncthreads();
            if (ch + 1 < 36) GL_LOAD(ch + 1);
            if (lat) {
                const int ti = wave >> 1, tv0 = (wave & 1) * 2; f32x4 c0 = (f32x4){0.f, 0.f, 0.f, 0.f}, c1 = c0;
#pragma unroll
                for (int ks = 0; ks < 4; ++ks) { const int ko = (32 * ks + 8 * l4) * 2;
                    const bf16x8 bq = *(const LAS bf16x8*)(lds + GL_QG + (16 * ti + l15) * 272 + ko);
                    const bf16x8 a0 = *(const LAS bf16x8*)(lds + GL_ST + (16 * tv0 + l15) * 272 + ko), a1 = *(const LAS bf16x8*)(lds + GL_ST + (16 * tv0 + 16 + l15) * 272 + ko);
                    c0 = __builtin_amdgcn_mfma_f32_16x16x32_bf16(a0, bq, c0, 0, 0, 0); c1 = __builtin_amdgcn_mfma_f32_16x16x32_bf16(a1, bq, c1, 0, 0, 0); }
#pragma unroll
                for (int ks = 0; ks < 2; ++ks) { const int ko = (32 * ks + 8 * l4) * 2;
                    const bf16x8 bq = *(const LAS bf16x8*)(lds + GL_AM + (16 * ti + l15) * 144 + ko);
                    const bf16x8 a0 = *(const LAS bf16x8*)(lds + GL_VT + (16 * tv0 + l15) * 144 + ko), a1 = *(const LAS bf16x8*)(lds + GL_VT + (16 * tv0 + 16 + l15) * 144 + ko);
                    c0 = __builtin_amdgcn_mfma_f32_16x16x32_bf16(a0, bq, c0, 0, 0, 0); c1 = __builtin_amdgcn_mfma_f32_16x16x32_bf16(a1, bq, c1, 0, 0, 0); }
                const int s_ = ch * 64 + 16 * ti + l15; const int t0 = s_ - 256; const int t = dir ? 2047 - t0 : t0;
                bf16* orow = OF + ((size_t)dir * NT + b * 2048 + t) * 1024 + h * 256 + vs * 64 + 16 * tv0 + 4 * l4;
                v2u p0, p1; p0.x = pk2(c0[0], c0[1]); p0.y = pk2(c0[2], c0[3]); p1.x = pk2(c1[0], c1[1]); p1.y = pk2(c1[2], c1[3]);
                *(v2u*)(orow) = p0; *(v2u*)(orow + 16) = p1;
            }
            { const f32x4 d4 = *(const LAS f32x4*)(lds + GL_DEC + (16 * wave + 4 * l4) * 4);
#pragma unroll
              for (int tv = 0; tv < 4; ++tv) S[tv] = S[tv] * d4;
#pragma unroll
              for (int ks = 0; ks < 2; ++ks) { const int ko = (32 * ks + 8 * l4) * 2;
                  const bf16x8 ak = *(const LAS bf16x8*)(lds + GL_KDT + (16 * wave + l15) * 144 + ko);
#pragma unroll
                  for (int tv = 0; tv < 4; ++tv) { const bf16x8 bv = *(const LAS bf16x8*)(lds + GL_VT + (16 * tv + l15) * 144 + ko);
                      S[tv] = __builtin_amdgcn_mfma_f32_16x16x32_bf16(ak, bv, S[tv], 0, 0, 0); } } }
            __syncthreads();
        }
#undef GL_LOAD
    }
}

template <int HALFW>
__device__ __forceinline__ void pool_item(const bf16* P, bf16* DP, LAS float* tmp, int tid, int b, int r, int g) {
    const int rlo = r - HALFW < 0 ? 0 : r - HALFW, rhi = r + HALFW > 32 ? 32 : r + HALFW;
    const float rinv = 1.f / (float)(rhi - rlo);
#pragma unroll 1
    for (int q = 0; q < 4; ++q) { const int p = tid + 512 * q, c = p >> 5, ch0 = (p & 31) * 8; float acc[8]; v4u x[2 * HALFW];
#pragma unroll
        for (int u = 0; u < 2 * HALFW; ++u) { const int rr = (rlo + u < rhi) ? rlo + u : rlo; x[u] = *(const v4u*)(P + ((size_t)(b * 2048 + rr * 64 + c)) * 1024 + g * 256 + ch0); }
#pragma unroll
        for (int j = 0; j < 8; ++j) acc[j] = 0.f;
#pragma unroll
        for (int u = 0; u < 2 * HALFW; ++u) { const float m = (rlo + u < rhi) ? 1.f : 0.f;
            acc[0] += m * bflo(x[u].x); acc[1] += m * bfhi(x[u].x); acc[2] += m * bflo(x[u].y); acc[3] += m * bfhi(x[u].y); acc[4] += m * bflo(x[u].z); acc[5] += m * bfhi(x[u].z); acc[6] += m * bflo(x[u].w); acc[7] += m * bfhi(x[u].w); }
        *(LAS f32x4*)(tmp + c * 256 + ch0) = (f32x4){acc[0] * rinv, acc[1] * rinv, acc[2] * rinv, acc[3] * rinv};
        *(LAS f32x4*)(tmp + c * 256 + ch0 + 4) = (f32x4){acc[4] * rinv, acc[5] * rinv, acc[6] * rinv, acc[7] * rinv}; }
    __syncthreads();
#pragma unroll 1
    for (int q = 0; q < 4; ++q) { const int p = tid + 512 * q, c = p >> 5, ch0 = (p & 31) * 8;
        const int clo = c - HALFW < 0 ? 0 : c - HALFW, chi = c + HALFW > 64 ? 64 : c + HALFW; const float cinv = 1.f / (float)(chi - clo);
        const size_t o = ((size_t)(b * 2048 + r * 64 + c)) * 1024 + g * 256 + ch0;
        const v4u x = *(const v4u*)(P + o);
        f32x4 a0 = (f32x4){0.f, 0.f, 0.f, 0.f}, a1 = a0;
#pragma unroll
        for (int u = 0; u < 2 * HALFW; ++u) { const int cc = (clo + u < chi) ? clo + u : clo; const float m = (clo + u < chi) ? 1.f : 0.f;
            a0 += *(const LAS f32x4*)(tmp + cc * 256 + ch0) * m; a1 += *(const LAS f32x4*)(tmp + cc * 256 + ch0 + 4) * m; }
        v4u d; d.x = pk2(a0[0] * cinv - bflo(x.x), a0[1] * cinv - bfhi(x.x)); d.y = pk2(a0[2] * cinv - bflo(x.y), a0[3] * cinv - bfhi(x.y));
        d.z = pk2(a1[0] * cinv - bflo(x.z), a1[1] * cinv - bfhi(x.z)); d.w = pk2(a1[2] * cinv - bflo(x.w), a1[3] * cinv - bfhi(x.w));
        *(v4u*)(DP + o) = d; }
    __syncthreads();
}
__device__ __forceinline__ void phase3_pool(const Args& a, LAS unsigned char* lds, int tid, int vcu, int G) {
    const bf16* P = (const bf16*)(a.ws + RA_P); bf16* DP = (bf16*)(a.ws + RA_DPOOL);
    LAS float* tmp = (LAS float*)lds;
    for (int item = vcu; item < 1024; item += G) {
        const int g = item >> 8, r = (item >> 3) & 31, b = item & 7;
        const int gg = 3 - g;
        if (gg == 0) pool_item<1>(P, DP, tmp, tid, b, r, gg); else if (gg == 1) pool_item<2>(P, DP, tmp, tid, b, r, gg); else if (gg == 2) pool_item<4>(P, DP, tmp, tid, b, r, gg); else pool_item<8>(P, DP, tmp, tid, b, r, gg);
    }
}

__device__ __forceinline__ void phase4_post(const Args& a, int lane, int wave, int vcu, int G) {
    const bf16* OF = (const bf16*)(a.ws + RA_OF); const bf16* OB = OF + (size_t)NT * 1024; const bf16* Rr = (const bf16*)(a.ws + RA_R); bf16* Y = (bf16*)(a.ws + RA_YMIX);
    const float* gn = a.in[15];
    for (int idx = vcu * 8 + wave; idx < NT * 4; idx += G * 8) {
        const int t = idx >> 2, h = idx & 3; const size_t o = (size_t)t * 1024 + h * 256 + 4 * lane;
        const v2u of = *(const v2u*)(OF + o), ob = *(const v2u*)(OB + o);
        const f32x4 x = (f32x4){bflo(of.x) + bflo(ob.x), bfhi(of.x) + bfhi(ob.x), bflo(of.y) + bflo(ob.y), bfhi(of.y) + bfhi(ob.y)};
        const float ms = wave_sum(x[0] * x[0] + x[1] * x[1] + x[2] * x[2] + x[3] * x[3]) * (1.f / 256.f);
        const float sc = rsqrtf(ms + EPS);
        const f32x4 g4 = *(const f32x4*)(gn + h * 256 + 4 * lane);
        const v2u rr = *(const v2u*)(Rr + o);
        const float r0 = bflo(rr.x), r1 = bfhi(rr.x), r2 = bflo(rr.y), r3 = bfhi(rr.y);
        v2u q; q.x = pk2(x[0] * sc * g4[0] * silu_f(r0), x[1] * sc * g4[1] * silu_f(r1)); q.y = pk2(x[2] * sc * g4[2] * silu_f(r2), x[3] * sc * g4[3] * silu_f(r3));
        *(v2u*)(Y + (size_t)t * 2048 + h * 256 + 4 * lane) = q;
    }
}

__device__ __forceinline__ void phase6(const Args& a, LAS unsigned char* lds, int tid, int lane, int wave, int vcu, int G) {
    unsigned char* ws = a.ws;
    const float* mod = (const float*)(ws + WS_MOD); const bf16* Y1 = (const bf16*)(ws + RA_Y1); unsigned char* H2 = ws + RA_H2;
    const float* gpost = a.in[7]; const float* gpre2 = a.in[8]; const float* rbias = a.in[20];
    const bf16* whi = (const bf16*)(ws + WS_WRT); const bf16* wlo = whi + 64 * 2048;
    LAS float* part = (LAS float*)lds;
    LAS float* logit = (LAS float*)(lds + LDS_LOGIT);
    LAS u64* masks = (LAS u64*)(lds + LDS_MASKS);
    int* cnt = (int*)(ws + T_CNT); u64* tmask = (u64*)(ws + T_MASK); float* tokw = (float*)(ws + T_TOKW);
    const int l15 = lane & 15, l4 = lane >> 4;
    for (int blk = vcu; blk < NT / 64; blk += G) {
        for (int it = 0; it < 4; ++it) {
#pragma unroll 1
            for (int rr = 0; rr < 2; ++rr) {
                const int lr = wave * 2 + rr, t = blk * 64 + it * 16 + lr; const float* mr = mod + (size_t)(t >> 11) * 12288;
                const bf16* yr = Y1 + (size_t)t * 2048; const float* xr = a.in[0] + (size_t)t * 2048;
                f32x4 y[8]; float ss = 0.f;
#pragma unroll
                for (int j = 0; j < 8; ++j) { const v2u yb = *(const v2u*)(yr + 4 * (lane + 64 * j)); y[j] = (f32x4){bflo(yb.x), bfhi(yb.x), bflo(yb.y), bfhi(yb.y)}; ss += y[j][0] * y[j][0] + y[j][1] * y[j][1] + y[j][2] * y[j][2] + y[j][3] * y[j][3]; }
                const float rstd1 = rsqrtf(wave_sum(ss) * (1.f / 2048.f) + EPS);
                if (lane == 0) ((float*)(ws + T_RSTD1))[t] = rstd1;
                float s2 = 0.f;
#pragma unroll
                for (int j = 0; j < 8; ++j) { const int c = 4 * (lane + 64 * j); const f32x4 x = *(const f32x4*)(xr + c), gp = *(const f32x4*)(gpost + c), gt = *(const f32x4*)(mr + 4096 + c);
                    const f32x4 x1 = x + gt * (y[j] * rstd1 * gp); y[j] = x1;
                    s2 += x1[0] * x1[0] + x1[1] * x1[1] + x1[2] * x1[2] + x1[3] * x1[3]; }
                const float rstd2 = rsqrtf(wave_sum(s2) * (1.f / 2048.f) + EPS);
#pragma unroll
                for (int j = 0; j < 8; ++j) { const int c = 4 * (lane + 64 * j); const f32x4 g2 = *(const f32x4*)(gpre2 + c), sh = *(const f32x4*)(mr + 6144 + c), sc = *(const f32x4*)(mr + 8192 + c);
                    const f32x4 hh = y[j] * rstd2 * g2 * (sc + 1.f) + sh;
                    unsigned hi[4], lo[4];
#pragma unroll
                    for (int q = 0; q < 4; ++q) { hi[q] = f2bf(hh[q]); lo[q] = f2bf(hh[q] - __builtin_bit_cast(float, hi[q] << 16)); }
                    v2u qh, ql; qh.x = hi[0] | (hi[1] << 16); qh.y = hi[2] | (hi[3] << 16); ql.x = lo[0] | (lo[1] << 16); ql.y = lo[2] | (lo[3] << 16);
                    *(LAS v2u*)(lds + RT_HI + lr * RT_ROWB + c * 2) = qh; *(LAS v2u*)(lds + RT_LO + lr * RT_ROWB + c * 2) = ql;
                    *(unsigned*)(H2 + (size_t)t * 2048 + c) = pk4_fp8(hh[0] * SC_H, hh[1] * SC_H, hh[2] * SC_H, hh[3] * SC_H); }
            }
            __syncthreads();
            { f32x4 acc[4];
#pragma unroll
              for (int et = 0; et < 4; ++et) acc[et] = (f32x4){0.f, 0.f, 0.f, 0.f};
#pragma unroll 1
              for (int ks = 0; ks < 8; ++ks) { const int k0 = 256 * wave + 32 * ks + 8 * l4;
                  const bf16x8 ah = *(const LAS bf16x8*)(lds + RT_HI + l15 * RT_ROWB + k0 * 2), al = *(const LAS bf16x8*)(lds + RT_LO + l15 * RT_ROWB + k0 * 2);
#pragma unroll
                  for (int et = 0; et < 4; ++et) { const bf16x8 bh = *(const bf16x8*)(whi + (size_t)(16 * et + l15) * 2048 + k0), bl = *(const bf16x8*)(wlo + (size_t)(16 * et + l15) * 2048 + k0);
                      acc[et] = __builtin_amdgcn_mfma_f32_16x16x32_bf16(ah, bh, acc[et], 0, 0, 0);
                      acc[et] = __builtin_amdgcn_mfma_f32_16x16x32_bf16(ah, bl, acc[et], 0, 0, 0);
                      acc[et] = __builtin_amdgcn_mfma_f32_16x16x32_bf16(al, bh, acc[et], 0, 0, 0); } }
              __syncthreads();
#pragma unroll
              for (int et = 0; et < 4; ++et)
#pragma unroll
                  for (int q = 0; q < 4; ++q) part[(wave * 16 + 4 * l4 + q) * 64 + 16 * et + l15] = acc[et][q]; }
            __syncthreads();
#pragma unroll
            for (int q = 0; q < 2; ++q) { const int idx = tid + 512 * q; float sacc = 0.f;
#pragma unroll
                for (int w = 0; w < 8; ++w) sacc += part[w * 1024 + idx];
                logit[idx] = sacc; }
            __syncthreads();
#pragma unroll 1
            for (int rr = 0; rr < 2; ++rr) {
                const int lr = wave * 2 + rr, t = blk * 64 + it * 16 + lr;
                const float lg = logit[lr * 64 + lane]; const float s = 1.f / (1.f + __expf(-lg)); const float sel = s + rbias[lane];
                float m1 = sel; m1 = fmaxf(m1, __shfl_xor(m1, 1)); m1 = fmaxf(m1, __shfl_xor(m1, 2)); m1 = fmaxf(m1, __shfl_xor(m1, 4));
                const u64 eq = __ballot(sel == m1); const unsigned gb = (unsigned)(eq >> (lane & ~7)) & 0xffu; const int first = __builtin_ctz(gb);
                float v2 = ((lane & 7) == first) ? -INFINITY : sel; v2 = fmaxf(v2, __shfl_xor(v2, 1)); v2 = fmaxf(v2, __shfl_xor(v2, 2)); v2 = fmaxf(v2, __shfl_xor(v2, 4));
                const float gs = m1 + v2; const int g = lane >> 3; int grank = 0;
#pragma unroll
                for (int g2 = 0; g2 < 8; ++g2) { const float o = __shfl(gs, g2 * 8); grank += (o > gs || (o == gs && g2 < g)) ? 1 : 0; }
                const bool gsel = grank < 4; const float mk = gsel ? sel : -INFINITY; int rank = 0;
                for (int e2 = 0; e2 < 64; ++e2) { const float o = __shfl(mk, e2); rank += (o > mk || (o == mk && e2 < lane)) ? 1 : 0; }
                const bool chosen = gsel && rank < 8;
                const u64 mask = __ballot(chosen); const float ssum = wave_sum(chosen ? s : 0.f);
                const int kidx = __popcll(mask & ((1ull << lane) - 1ull));
                if (chosen) tokw[(size_t)t * 8 + kidx] = s / ssum * 2.5f;
                if (lane == 0) { tmask[t] = mask; masks[it * 16 + lr] = mask; }
            }
            __syncthreads();
        }
        if (wave == 0) { const u64 m = masks[lane]; int mine = 0;
            for (int e = 0; e < 64; ++e) { const int c = __popcll(__ballot((m >> e) & 1ull)); mine = (lane == e) ? c : mine; }
            cnt[blk * 64 + lane] = mine; }
        __syncthreads();
    }
}

__device__ __forceinline__ void phase7(const Args& a, LAS unsigned char* lds, int tid, int lane, int wave, int vcu, int G) {
    unsigned char* ws = a.ws;
    const int* cnt = (const int*)(ws + T_CNT); const u64* tmask = (const u64*)(ws + T_MASK); const float* tokw = (const float*)(ws + T_TOKW);
    int* tokslot = (int*)(ws + T_TOKSLOT); int* slottok = (int*)(ws + T_SLOTTOK); float* slotw = (float*)(ws + T_SLOTW); int* tile = (int*)(ws + T_TILE);
    LAS int* part = (LAS int*)lds;
    LAS int* tot = (LAS int*)(lds + 4096);
    for (int blk = vcu; blk < NT / 64; blk += G) {
        int pre = 0, all = 0;
        for (int b2 = wave; b2 < 256; b2 += 8) { const int c = cnt[b2 * 64 + lane]; all += c; pre += (b2 < blk) ? c : 0; }
        part[(wave * 2) * 64 + lane] = pre; part[(wave * 2 + 1) * 64 + lane] = all;
        __syncthreads();
        if (wave == 0) {
            int p = 0, t = 0;
#pragma unroll
            for (int w = 0; w < 8; ++w) { p += part[(w * 2) * 64 + lane]; t += part[(w * 2 + 1) * 64 + lane]; }
            int incl = t;
#pragma unroll
            for (int o = 1; o < 64; o <<= 1) { const int v = __shfl_up(incl, o); if (lane >= o) incl += v; }
            const int start = incl - t; const int base = start + p;
            tot[lane] = t; tot[64 + lane] = start;
            const int tokn = blk * 64 + lane; const u64 m = tmask[tokn];
            for (int e = 0; e < 64; ++e) { const bool bit = (m >> e) & 1ull; const u64 bal = __ballot(bit); const int be = __shfl(base, e);
                if (bit) { const int rank = __popcll(bal & ((1ull << lane) - 1ull)); const int slot = be + rank; const int k = __popcll(m & ((1ull << e) - 1ull));
                    slottok[slot] = tokn; slotw[slot] = tokw[(size_t)tokn * 8 + k]; tokslot[(size_t)tokn * 8 + k] = slot; } }
            slottok[SH_ROW0 + tokn] = tokn; slotw[SH_ROW0 + tokn] = 1.f;
        }
        __syncthreads();
        if (blk == 0 && tid == 0) {
            int n = 0;
            for (int e = 0; e < 64; ++e) { const int te = tot[e], st = tot[64 + e];
                for (int j = 0; j * 256 < te; ++j) { tile[n] = e; tile[NTILE_MAX + n] = st + j * 256; tile[2 * NTILE_MAX + n] = (te - j * 256) < 256 ? (te - j * 256) : 256; ++n; } }
            for (int j = 0; j < 64; ++j) { tile[n] = 64; tile[NTILE_MAX + n] = SH_ROW0 + j * 256; tile[2 * NTILE_MAX + n] = 256; ++n; }
            tile[3 * NTILE_MAX] = n;
        }
        __syncthreads();
    }
}

__device__ __forceinline__ void phase10(const Args& a, LAS unsigned char* lds, int lane, int wave, int vcu, int G) {
    unsigned char* ws = a.ws;
    const float* mod = (const float*)(ws + WS_MOD); const unsigned char* SO = ws + WS_SLOTOUT; const int* tokslot = (const int*)(ws + T_TOKSLOT); const float* gp = a.in[9];
    LAS float* ysc = (LAS float*)(lds + wave * 8192);
    const unsigned lo16_ = 16u * (unsigned)lane;
#pragma unroll 1
    for (int t = vcu * 8 + wave; t < NT; t += G * 8) {
        const float* mr = mod + (size_t)(t >> 11) * 12288;
        const int myslot = lane < 8 ? tokslot[(size_t)t * 8 + lane] : SH_ROW0 + t;
        unsigned lo16 = lo16_; asm volatile("" : "+v"(lo16));
        v4u x[9][2]; f32x4 xo[8]; v2u yb[8];
        const unsigned char* x1r = (const unsigned char*)(a.in[0] + (size_t)t * 2048); const unsigned char* y1r = (const unsigned char*)((const bf16*)(ws + RA_Y1) + (size_t)t * 2048);
        const float rstd1 = ((const float*)(ws + T_RSTD1))[t];
#pragma unroll
        for (int k = 0; k < 9; ++k) { const int slot = __builtin_amdgcn_readfirstlane(__shfl(myslot, k)); const unsigned char* sr = SO + (size_t)slot * 2048;
#pragma unroll
            for (int j = 0; j < 2; ++j) x[k][j] = *(const v4u*)(sr + (lo16 + 1024u * j)); }
        float y[2][16];
#pragma unroll
        for (int j = 0; j < 2; ++j)
#pragma unroll
            for (int q = 0; q < 16; ++q) y[j][q] = 0.f;
#pragma unroll
        for (int k = 0; k < 9; ++k)
#pragma unroll
            for (int j = 0; j < 2; ++j) { v4u v = x[k][j]; asm volatile("" : "+v"(v) : "v"(y[j][0]), "v"(y[j][15]));
#pragma unroll
                for (int w = 0; w < 4; ++w) { const unsigned d = v[w]; const auto lo = __builtin_amdgcn_cvt_pk_f32_fp8(d, false), hi = __builtin_amdgcn_cvt_pk_f32_fp8(d, true);
                    y[j][4 * w] += lo[0]; y[j][4 * w + 1] += lo[1]; y[j][4 * w + 2] += hi[0]; y[j][4 * w + 3] += hi[1]; } }
        asm volatile("" ::: "memory");
#pragma unroll
        for (int j = 0; j < 8; ++j) { xo[j] = *(const f32x4*)(x1r + (lo16 + 1024u * j)); yb[j] = *(const v2u*)(y1r + (lo16 / 2u + 512u * j)); }
        float ss = 0.f;
#pragma unroll
        for (int j = 0; j < 2; ++j)
#pragma unroll
            for (int q = 0; q < 16; ++q) ss += y[j][q] * y[j][q];
        const float rstd = rsqrtf(wave_sum(ss) * (1.f / 2048.f) + EPS * SC_O * SC_O);
#pragma unroll
        for (int j = 0; j < 2; ++j)
#pragma unroll
            for (int q = 0; q < 4; ++q) *(LAS f32x4*)(ysc + 16 * (lane + 64 * j) + 4 * q) = (f32x4){y[j][4 * q], y[j][4 * q + 1], y[j][4 * q + 2], y[j][4 * q + 3]};
        LDS_WAIT(); asm volatile("" ::: "memory");
        unsigned char* outr = (unsigned char*)(a.out + (size_t)t * 2048); const unsigned char* gpb = (const unsigned char*)gp; const unsigned char* g1b = (const unsigned char*)a.in[7];
        const unsigned char* gt2b = (const unsigned char*)(mr + 10240); const unsigned char* gt1b = (const unsigned char*)(mr + 4096);
#pragma unroll
        for (int j = 0; j < 8; ++j) { const unsigned cb = lo16 + 1024u * j; const f32x4 yy = *(const LAS f32x4*)(ysc + 4 * (lane + 64 * j)), g = *(const f32x4*)(gpb + cb), gt = *(const f32x4*)(gt2b + cb);
            const f32x4 g1 = *(const f32x4*)(g1b + cb), gt1 = *(const f32x4*)(gt1b + cb); const f32x4 y1 = (f32x4){bflo(yb[j].x), bfhi(yb[j].x), bflo(yb[j].y), bfhi(yb[j].y)};
            const f32x4 x1 = xo[j] + gt1 * (y1 * rstd1 * g1);
            *(f32x4*)(outr + cb) = x1 + gt * (yy * rstd * g); }
        LDS_WAIT(); asm volatile("" ::: "memory");
    }
}

__global__ void __launch_bounds__(512, 2) fwd(Args args) {
    extern __shared__ __attribute__((aligned(16))) unsigned char lds_raw[];
    LAS unsigned char* lds = (LAS unsigned char*)lds_raw;
    const int tid = threadIdx.x, lane = tid & 63, wave = __builtin_amdgcn_readfirstlane(tid >> 6);
    const int G = gridDim.x, bx = blockIdx.x;
    const int vcu = (G % 8 == 0) ? (bx % 8) * (G / 8) + bx / 8 : bx;
    unsigned char* ws = args.ws;
    volatile LAS unsigned* MISC = (volatile LAS unsigned*)(lds + LDS_MISC);
    if (tid < 64) MISC[tid] = 0u;
    __syncthreads();
    const int lo = args.ph_lo, hi = args.ph_hi;
    XcdBarrier bar; bar.bar = (unsigned*)(ws + WS_CTL) + 4096; bar.x = 0; bar.st = nullptr;
    if (hi - lo > 1) bar = xcd_barrier_post((unsigned*)(ws + WS_CTL) + 4096, MISC + 8);
#ifndef PH_MASK
#define PH_MASK 0xfff
#endif
#define IN(k) (((PH_MASK >> (k)) & 1) && lo <= (k) && (k) < hi)
#define SEAM(k) do { if (IN(k) && IN((k) + 1)) xcd_barrier(bar); } while (0)

#ifndef REP_PHASE
#define REP_PHASE -1
#endif
#define PH_IDS int tz_ = threadIdx.x; asm volatile("" : "+v"(tz_)); const int tid = tz_, lane = tz_ & 63, wave = __builtin_amdgcn_readfirstlane(tz_ >> 6); (void)tid; (void)lane; (void)wave;
#define RUNPH(k, ...) do { if (IN(k)) { { PH_IDS __VA_ARGS__ } if (REP_PHASE == (k)) { xcd_barrier(bar); { PH_IDS __VA_ARGS__ } } SEAM(k); } } while (0)
#ifdef PROBE_P0
    if (IN(0)) { { PH_IDS phase0(args, lds, tid, lane, wave, vcu, G); } xcd_barrier(bar); { PH_IDS phase0(args, lds, tid, lane, wave, vcu, G, PROBE_P0 == 1, PROBE_P0 == 2); } SEAM(0); }
#else
    RUNPH(0, phase0(args, lds, tid, lane, wave, vcu, G););
#endif
    RUNPH(1, phase1(args, lane, wave, vcu, G););
    RUNPH(2, {
        DenseSched S; S.init(ws + RA_H, ws + WS_WIN, 2048, 2048, MROWS, DINP, G, bx);
        EpiIn E{ws};
        pg8::gemm_phase<EpiIn, DenseSched>(lds, 2048, S, E); });
    RUNPH(3, phase3_prep(args, lds, tid, vcu, G); phase3_pool(args, lds, tid, vcu, G););
    RUNPH(4, phase_chain(args, lds, tid, lane, wave, vcu, G););
    RUNPH(5, {
        phase4_post(args, lane, wave, vcu, G);
        PoolSched S{(const char*)(ws + RA_DPOOL), (const char*)(ws + WS_WPOOL), G, vcu};
        EpiPool E{(bf16*)(ws + RA_YMIX), args.in[17]};
        int kpool = 256; asm volatile("" : "+s"(kpool));
        pg8::gemm_phase<EpiPool, PoolSched>(lds, kpool, S, E); });
    RUNPH(6, {
        DenseSched S; S.init(ws + RA_YMIX, ws + WS_WOUT, 2048, 2048, NT, 2048, G, bx);
        EpiOut E{(bf16*)(ws + RA_Y1)};
        pg8::gemm_phase<EpiOut, DenseSched>(lds, 2048, S, E); });
    RUNPH(7, phase6(args, lds, tid, lane, wave, vcu, G););
    RUNPH(8, phase7(args, lds, tid, lane, wave, vcu, G););
    RUNPH(9, {
        MoeGUSched S{(const char*)(ws + RA_H2), (const char*)(ws + WS_WGU), (const int*)(ws + T_TILE), (const int*)(ws + T_SLOTTOK), G, vcu};
        EpiGU E{ws + WS_ACT, (const float*)(ws + T_SLOTW)};
        int kgu = 1024; asm volatile("" : "+s"(kgu));
        pg8::gemm_phase<EpiGU, MoeGUSched, true>(lds, kgu, S, E); });
    RUNPH(10, {
        MoeDownSched S{(const char*)(ws + WS_ACT), (const char*)(ws + WS_WD), (const int*)(ws + T_TILE), G, vcu};
        EpiDown E{ws + WS_SLOTOUT};
        int kdn = 256; asm volatile("" : "+s"(kdn));
        pg8::gemm_phase<EpiDown, MoeDownSched, true>(lds, kdn, S, E); });
    if (IN(11)) { { PH_IDS phase10(args, lds, lane, wave, vcu, G); } if (REP_PHASE == 11) { xcd_barrier(bar); { PH_IDS phase10(args, lds, lane, wave, vcu, G); } } }
#undef IN
#undef SEAM
}

extern "C" void kernel_launch(void* const* d_in, const int* in_sizes, int n_in, void* d_out, int out_size, void* d_ws, size_t ws_size, hipStream_t stream) {
    static int grid = 0;
    if (grid == 0) {
        if (n_in != 27 || out_size != NT * DM || ws_size < WS_NEED) { fprintf(stderr, "kernel_launch: unexpected problem: n_in %d out %d ws %zu (need %zu)\n", n_in, out_size, ws_size, (size_t)WS_NEED); grid = -1; return; }
        int dev = 0, cus = 0, per_cu = 0;
        if (hipGetDevice(&dev) != hipSuccess || hipDeviceGetAttribute(&cus, hipDeviceAttributeMultiprocessorCount, dev) != hipSuccess) { grid = -1; return; }
        if (hipFuncSetAttribute((const void*)fwd, hipFuncAttributeMaxDynamicSharedMemorySize, LDS_BYTES) != hipSuccess) { fprintf(stderr, "kernel_launch: hipFuncSetAttribute failed\n"); grid = -1; return; }
        if (hipOccupancyMaxActiveBlocksPerMultiprocessor(&per_cu, (const void*)fwd, 512, LDS_BYTES) != hipSuccess || per_cu < 1) { fprintf(stderr, "kernel_launch: occupancy query says %d\n", per_cu); }
        (void)hipGetLastError();
        grid = cus;
    }
    if (grid < 0) return;
    (void)hipMemsetAsync((char*)d_ws + WS_CTL, 0, CTL_ZERO_BYTES, stream);
    Args a{};
    for (int i = 0; i < 27; ++i) a.in[i] = (const float*)d_in[i];
    a.out = (float*)d_out; a.ws = (unsigned char*)d_ws;
    if (N_LAUNCHES == 1) {
        a.ph_lo = 0; a.ph_hi = NPH;
        hipLaunchKernelGGL(fwd, dim3(grid), dim3(512), LDS_BYTES, stream, a);
    } else {
        for (int p = 0; p < NPH; ++p) { a.ph_lo = p; a.ph_hi = p + 1; hipLaunchKernelGGL(fwd, dim3(grid), dim3(512), LDS_BYTES, stream, a); }
    }
}
```

```cpp
#include <hip/hip_runtime.h>
#include <cstdio>
#include <cstdint>

#ifndef N_LAUNCHES
#define N_LAUNCHES 1
#endif

#define GAS __attribute__((address_space(1)))
#define LAS __attribute__((address_space(3)))
typedef unsigned short bf16;
typedef unsigned v4u __attribute__((ext_vector_type(4)));
typedef unsigned v2u __attribute__((ext_vector_type(2)));
typedef float f32x4 __attribute__((ext_vector_type(4)));
typedef short bf16x8 __attribute__((ext_vector_type(8)));
typedef unsigned long long u64;

constexpr int NB = 8, SEQ = 2048, DM = 2048, CTXL = 256;
constexpr int NT = NB * SEQ;
constexpr int NTC = NB * CTXL;
constexpr int MROWS = NT + NTC;
constexpr int DIN = 4128, DINP = 4352;
constexpr int NE = 64, TOPK = 8, DE = 512;
constexpr int NSLOT_E = NT * TOPK;
constexpr int SH_ROW0 = NSLOT_E + 256;
constexpr int NSLOT = SH_ROW0 + NT;
constexpr int NTILE_MAX = 704;
constexpr float EPS = 1e-6f;
constexpr int NPH = 12;

constexpr size_t MiB = 1u << 20;
constexpr size_t WS_CTL = 0, CTL_ZERO_BYTES = 64 * 1024;
constexpr size_t WS_MOD = 1 * MiB;
constexpr size_t WS_WRT = 1 * MiB + 512 * 1024;
constexpr size_t WS_WIN = 2 * MiB;
constexpr size_t WS_WOUT = WS_WIN + 17 * MiB;
constexpr size_t WS_WPOOL = WS_WOUT + 8 * MiB;
constexpr size_t WS_WD = WS_WPOOL + 1 * MiB;
constexpr size_t WS_WGU = WS_WD + 130 * MiB;
constexpr size_t WS_RA = WS_WGU + 260 * MiB;
constexpr size_t RA_H = WS_RA;
constexpr size_t RA_OF = WS_RA;
constexpr size_t RA_H2 = WS_RA;
constexpr size_t RA_Q = WS_RA + 128 * MiB;
constexpr size_t RA_K = RA_Q + 16 * MiB;
constexpr size_t RA_V = RA_K + 18 * MiB;
constexpr size_t RA_R = RA_V + 36 * MiB;
constexpr size_t RA_P = RA_R + 32 * MiB;
constexpr size_t RA_ALR = RA_P + 32 * MiB;
constexpr size_t RA_DPOOL = RA_ALR + 3 * MiB;
constexpr size_t RA_YMIX = RA_DPOOL + 32 * MiB;
constexpr size_t RA_Y1 = WS_RA + 128 * MiB;
constexpr size_t RA_END = RA_YMIX + 64 * MiB;
constexpr size_t WS_SLOTOUT = WS_WGU;
constexpr size_t WS_ACT = RA_END > WS_SLOTOUT + 578 * MiB ? RA_END : WS_SLOTOUT + 578 * MiB;
constexpr size_t WS_END = WS_ACT + 145 * MiB;
constexpr size_t PQG = WS_ACT;
constexpr size_t PAM = WS_ACT + 32 * MiB;
constexpr size_t PKD = WS_ACT + 96 * MiB;
constexpr size_t PDEC = WS_ACT + 132 * MiB;
constexpr size_t WS_T0 = WS_END;
constexpr size_t T_CNT = WS_T0;
constexpr size_t T_MASK = T_CNT + 65536;
constexpr size_t T_TOKW = T_MASK + 131072;
constexpr size_t T_TOKSLOT = T_TOKW + 524288;
constexpr size_t T_SLOTTOK = T_TOKSLOT + 524288;
constexpr size_t T_SLOTW = T_SLOTTOK + 655360;
constexpr size_t T_TILE = T_SLOTW + 655360;
constexpr size_t T_RSTD1 = (T_TILE + 16384 + 4095) / 4096 * 4096;
constexpr size_t WS_NEED = T_RSTD1 + (size_t)NT * 4;

constexpr int RING_BYTES = 131072;
constexpr int LDS_BYTES = 147456;
constexpr int LDS_MISC = LDS_BYTES - 256;
constexpr int RT_ROWB = 4112;
constexpr int RT_HI = 0, RT_LO = 16 * RT_ROWB;
constexpr int LDS_LOGIT = 2 * 16 * RT_ROWB;
constexpr int LDS_MASKS = LDS_LOGIT + 4096;
static_assert(LDS_MASKS + 512 <= LDS_MISC, "LDS map");

#define LDS_WAIT() asm volatile("s_waitcnt lgkmcnt(0)" ::: "memory")
#define LDS_BARRIER() do { asm volatile("s_waitcnt lgkmcnt(0)" ::: "memory"); __builtin_amdgcn_s_barrier(); asm volatile("" ::: "memory"); } while (0)
#define VM_WAIT() asm volatile("s_waitcnt vmcnt(0)" ::: "memory")

__device__ __forceinline__ unsigned f2bf(float f) { unsigned u = __builtin_bit_cast(unsigned, f); return (u + 0x7fffu + ((u >> 16) & 1u)) >> 16; }
__device__ __forceinline__ unsigned pk2(float lo, float hi) { return f2bf(lo) | (f2bf(hi) << 16); }
__device__ __forceinline__ float bflo(unsigned u) { return __builtin_bit_cast(float, u << 16); }
__device__ __forceinline__ float bfhi(unsigned u) { return __builtin_bit_cast(float, u & 0xffff0000u); }
__device__ __forceinline__ float bf1(bf16 b) { return __builtin_bit_cast(float, ((unsigned)b) << 16); }
__device__ __forceinline__ float wave_sum(float v) {
#pragma unroll
    for (int o = 1; o < 64; o <<= 1) v += __shfl_xor(v, o);
    return v;
}
__device__ __forceinline__ float silu_f(float x) { return x / (1.f + __expf(-x)); }

#define XB_TMO      128
#define XB_XCNT(j)  (256  + 64 * (j))
#define XB_XSUB(j)  (1280 + 64 * (j))
#define XB_XGEN(j)  (2304 + 64 * (j))
#define XB_TOP      3328
#define XB_TOPGEN   3392
#define XCD_BAR_WORDS 3456
#define XB_SPIN_CAP (1u << 18)

__device__ __forceinline__ unsigned xb_ld(unsigned* p)              { return __hip_atomic_load(p, __ATOMIC_RELAXED, __HIP_MEMORY_SCOPE_AGENT); }
__device__ __forceinline__ unsigned xb_add(unsigned* p, unsigned v) { return __hip_atomic_fetch_add(p, v, __ATOMIC_RELAXED, __HIP_MEMORY_SCOPE_AGENT); }
__device__ __forceinline__ unsigned xb_xcc_id() { return (unsigned)__builtin_amdgcn_s_getreg((3 << 11) | 20) & 0xFu; }
#define XB_SPIN(cond, bar) do { unsigned _sp = 0; while (cond) { __builtin_amdgcn_s_sleep(1); \
    if ((++_sp & 255u) == 0u) { if (xb_ld(&(bar)[XB_TMO])) break; if (_sp > XB_SPIN_CAP) { atomicAdd(&(bar)[XB_TMO], 1u); break; } } } } while (0)

struct XcdBarrier { unsigned* bar; unsigned x; volatile LAS unsigned* st; };

__device__ __forceinline__ XcdBarrier xcd_barrier_post(unsigned* bar, volatile LAS unsigned* st) {
    XcdBarrier b; b.bar = bar; b.x = xb_xcc_id(); b.st = st;
    if (threadIdx.x == 0) (void)xb_add(&bar[XB_XCNT(b.x)], 1u);
    return b;
}
__device__ __forceinline__ void xcd_barrier_complete(unsigned* bar, unsigned x, unsigned& nloc, unsigned& nx) {
    const unsigned G = gridDim.x * gridDim.y * gridDim.z;
    unsigned sum, cnt, mine, sp = 0u;
    for (;;) {
        sum = 0u; cnt = 0u; mine = 0u;
#pragma unroll
        for (unsigned j = 0; j < 16; ++j) { const unsigned c = xb_ld(&bar[XB_XCNT(j)]); sum += c; cnt += (c > 0u) ? 1u : 0u; mine = (j == x) ? c : mine; }
        if (sum == G) break;
        __builtin_amdgcn_s_sleep(1);
        if ((++sp & 255u) == 0u) { if (xb_ld(&bar[XB_TMO])) break; if (sp > XB_SPIN_CAP) { atomicAdd(&bar[XB_TMO], 1u); break; } }
    }
    nloc = mine > 0u ? mine : 1u; nx = cnt > 0u ? cnt : 1u;
}
__device__ __forceinline__ void xcd_barrier(const XcdBarrier& b) {
    asm volatile("s_waitcnt vmcnt(0)" ::: "memory");
    __syncthreads();
    if (threadIdx.x == 0) {
        unsigned* bar = b.bar;
        __builtin_amdgcn_s_waitcnt(0);
        unsigned nloc = b.st[0], nx = b.st[1];
        if (nloc == 0u) { xcd_barrier_complete(bar, b.x, nloc, nx); b.st[0] = nloc; b.st[1] = nx; }
        const unsigned old = xb_add(&bar[XB_XSUB(b.x)], 1u);
        const unsigned gen = old / nloc;
        if (old + 1u == (gen + 1u) * nloc) {
            __builtin_amdgcn_fence(__ATOMIC_RELEASE, "agent");
            asm volatile("s_waitcnt vmcnt(0)" ::: "memory");
            const unsigned og = xb_add(&bar[XB_TOP], 1u);
            const unsigned tg = og / nx;
            if (og + 1u == (tg + 1u) * nx) xb_add(&bar[XB_TOPGEN], 1u);
            else XB_SPIN(xb_ld(&bar[XB_TOPGEN]) == tg, bar);
            __builtin_amdgcn_fence(__ATOMIC_ACQUIRE, "agent");
            xb_add(&bar[XB_XGEN(b.x)], 1u);
            asm volatile("s_waitcnt vmcnt(0)" ::: "memory");
        } else {
            XB_SPIN(xb_ld(&bar[XB_XGEN(b.x)]) == gen, bar);
            __builtin_amdgcn_fence(__ATOMIC_ACQUIRE, "agent");
            asm volatile("s_waitcnt vmcnt(0)" ::: "memory");
        }
    }
    __syncthreads();
}

namespace pg8 {
constexpr int BM = 256, BK = 64, HALF = 128, HTB = HALF * BK * 2, STAGE_BYTES = 8 * HTB, NXCD = 8, WGM = 8;
__device__ __forceinline__ int lds_byte(int r, int c) { const int st = (r >> 4) * 2 + (c >> 5), rr = r & 15, cc = c & 31, ob = rr * 64 + cc * 2; return st * 1024 + (ob ^ (((ob >> 9) & 1) << 5)); }
__device__ __forceinline__ void stage_rc(int b, int& R, int& C) { const int st = b / 1024, sb = b % 1024, swz = sb ^ (((sb >> 9) & 1) << 5); R = (st >> 1) * 16 + swz / 64; C = (st & 1) * 32 + (swz % 64) / 2; }
__device__ __forceinline__ int perm32(int rho) { const int n = rho >> 4, i = rho & 15; return 8 * (i >> 2) + 4 * n + (i & 3); }
__device__ __forceinline__ unsigned cvt_pk_bf16(float lo, float hi) { unsigned r; asm volatile("v_cvt_pk_bf16_f32 %0, %1, %2" : "=v"(r) : "v"(lo), "v"(hi)); return r; }

typedef int v8i __attribute__((ext_vector_type(8)));
typedef int v4i __attribute__((ext_vector_type(4)));
template <class Epi, class Sched, bool FP8 = false>
__device__ __forceinline__ void gemm_phase(LAS unsigned char* lds, const int K, const Sched& S, const Epi& E) {
    typedef typename Sched::U Unit;
    const int tid = threadIdx.x, wid = __builtin_amdgcn_readfirstlane(tid >> 6), lane = tid & 63, wr = wid >> 2, wc = wid & 3, fr = lane & 15, fq = lane >> 4;
    const int nt = K / BK;
    int R[2], C[2]; unsigned voffB[2];
#pragma unroll
    for (int i = 0; i < 2; ++i) { stage_rc(tid * 16 + i * 8192, R[i], C[i]);
        const int Rb = Epi::PERMK == 2 ? (64 * (R[i] >> 5) + 16 * ((R[i] & 15) >> 2) + 4 * ((R[i] >> 4) & 1) + (R[i] & 3)) : (Epi::PERMK == 1 ? ((R[i] & ~31) + perm32(R[i] & 31)) : R[i]);
        voffB[i] = (unsigned)(Rb * K + C[i]) * 2u; }
    const size_t kstep = (size_t)(BK * 2);
    const size_t hstepB = (size_t)(Epi::PERMK == 2 ? 8 : HALF) * K * 2;
    const unsigned ldsw = (unsigned)wid * 1024u;
    const int aoff = lds_byte(wr * 64 + fr, fq * 8), boff = lds_byte(wc * 32 + fr, fq * 8);
#define PG8_SA(b, h) (((b) * 2 + (h)) * HTB)
#define PG8_SB(b, h) ((4 + (b) * 2 + (h)) * HTB)
#define PG8_STAGE(bufoff, gbase, v0, v1) do { \
        __builtin_amdgcn_global_load_lds((const unsigned*)((const char*)(gbase) + (v0)), (LAS unsigned*)(lds + (bufoff) + ldsw), 16, 0, 0); \
        __builtin_amdgcn_global_load_lds((const unsigned*)((const char*)(gbase) + (v1)), (LAS unsigned*)(lds + (bufoff) + ldsw + 8192), 16, 0, 0); } while (0)
#define PG8_LDA(dst, b, h) do { _Pragma("unroll") for (int m = 0; m < 4; ++m) { const v4i lo_ = *(const LAS v4i*)(lds + PG8_SA(b, h) + aoff + m * 2048), hi_ = *(const LAS v4i*)(lds + PG8_SA(b, h) + aoff + m * 2048 + 1024); \
        dst[m] = __builtin_shufflevector(lo_, hi_, 0, 1, 2, 3, 4, 5, 6, 7); } } while (0)
#define PG8_LDB(dst, b, h) do { _Pragma("unroll") for (int n = 0; n < 2; ++n) { const v4i lo_ = *(const LAS v4i*)(lds + PG8_SB(b, h) + boff + n * 2048), hi_ = *(const LAS v4i*)(lds + PG8_SB(b, h) + boff + n * 2048 + 1024); \
        dst[n] = __builtin_shufflevector(lo_, hi_, 0, 1, 2, 3, 4, 5, 6, 7); } } while (0)
#define PG8_H0(x) ((bf16x8)__builtin_shufflevector(x, x, 0, 1, 2, 3))
#define PG8_H1(x) ((bf16x8)__builtin_shufflevector(x, x, 4, 5, 6, 7))
#define PG8_MMA(ai, bj, At, Bt) do { __builtin_amdgcn_s_setprio(1); if constexpr (FP8) asm volatile("s_nop 4"); _Pragma("unroll") for (int m = 0; m < 4; ++m) _Pragma("unroll") for (int n = 0; n < 2; ++n) { \
        if constexpr (FP8) asm volatile("v_mfma_f32_16x16x128_f8f6f4 %0, %1, %2, %0" : "+v"(acc[ai][bj][m][n]) : "v"(Bt[n]), "v"(At[m])); \
        else { acc[ai][bj][m][n] = __builtin_amdgcn_mfma_f32_16x16x32_bf16(PG8_H0(Bt[n]), PG8_H0(At[m]), acc[ai][bj][m][n], 0, 0, 0); \
               acc[ai][bj][m][n] = __builtin_amdgcn_mfma_f32_16x16x32_bf16(PG8_H1(Bt[n]), PG8_H1(At[m]), acc[ai][bj][m][n], 0, 0, 0); } } \
        __builtin_amdgcn_s_setprio(0); } while (0)
#define PG8_WAIT_V(n) asm volatile("s_waitcnt vmcnt(" #n ")" ::: "memory")
#define PG8_WAIT_L(n) asm volatile("s_waitcnt lgkmcnt(" #n ")" ::: "memory")
#define PG8_BAR __builtin_amdgcn_s_barrier()
#define PG8_SCHED __builtin_amdgcn_sched_barrier(0)
    Unit cur, nxt; int ui = 0;
    if (!S.next(0, cur)) return;
    f32x4 acc[2][2][4][2];
#pragma unroll
    for (int a = 0; a < 2; ++a)
#pragma unroll
        for (int b = 0; b < 2; ++b)
#pragma unroll
            for (int m = 0; m < 4; ++m)
#pragma unroll
                for (int n = 0; n < 2; ++n) acc[a][b][m][n] = (f32x4){0.f, 0.f, 0.f, 0.f};
    v8i At[4], B0[2], B1[2];
    unsigned vA[4], vN[4];
    S.aoffs(cur, R, C, vA);
    const char* cA = cur.A; const char* cB = cur.B;
    PG8_STAGE(PG8_SB(0, 0), cB, voffB[0], voffB[1]); PG8_STAGE(PG8_SB(0, 1), cB + hstepB, voffB[0], voffB[1]); PG8_STAGE(PG8_SA(0, 0), cA, vA[0], vA[1]); PG8_STAGE(PG8_SA(0, 1), cA, vA[2], vA[3]);
    if (wr == 1) PG8_BAR;
    PG8_WAIT_V(2); PG8_BAR;
    PG8_STAGE(PG8_SB(1, 0), cB + kstep, voffB[0], voffB[1]); PG8_STAGE(PG8_SA(1, 0), cA + kstep, vA[0], vA[1]); PG8_STAGE(PG8_SB(1, 1), cB + hstepB + kstep, voffB[0], voffB[1]);
    PG8_WAIT_V(6); PG8_BAR;
    for (;;) {
        const bool has_next = S.next(ui + 1, nxt);
        const char* nA = has_next ? nxt.A : cA; const char* nB = has_next ? nxt.B : cB;
        if (has_next) S.aoffs(nxt, R, C, vN); else { vN[0] = vA[0]; vN[1] = vA[1]; vN[2] = vA[2]; vN[3] = vA[3]; }
        for (int t = 0; t < nt; t += 2) {
            const bool last = (t == nt - 2);
            const char* a1 = cA + (size_t)(t + 1) * kstep;
            const char* a2 = last ? nA : cA + (size_t)(t + 2) * kstep; const char* b2 = last ? nB : cB + (size_t)(t + 2) * kstep;
            const char* a3 = a2 + kstep; const char* b3 = b2 + kstep;
            const unsigned x0 = last ? vN[0] : vA[0], x1 = last ? vN[1] : vA[1], x2 = last ? vN[2] : vA[2], x3 = last ? vN[3] : vA[3];
            PG8_LDB(B0, 0, 0); PG8_LDB(B1, 0, 1); PG8_SCHED; PG8_LDA(At, 0, 0); PG8_STAGE(PG8_SA(1, 1), a1, vA[2], vA[3]);
            PG8_WAIT_V(8); PG8_WAIT_L(0); PG8_BAR; PG8_MMA(0, 0, At, B0); PG8_MMA(0, 1, At, B1); PG8_BAR; PG8_SCHED;
            PG8_LDA(At, 0, 1); PG8_STAGE(PG8_SB(0, 0), b2, voffB[0], voffB[1]); PG8_STAGE(PG8_SB(0, 1), b2 + hstepB, voffB[0], voffB[1]); PG8_STAGE(PG8_SA(0, 0), a2, x0, x1);
            PG8_WAIT_V(8); PG8_WAIT_L(0); PG8_BAR; PG8_MMA(1, 0, At, B0); PG8_MMA(1, 1, At, B1); PG8_BAR; PG8_SCHED;
            PG8_LDB(B0, 1, 0); PG8_LDB(B1, 1, 1); PG8_SCHED; PG8_LDA(At, 1, 0); PG8_STAGE(PG8_SA(0, 1), a2, x2, x3);
            PG8_WAIT_V(8); PG8_WAIT_L(0); PG8_BAR; PG8_MMA(0, 0, At, B0); PG8_MMA(0, 1, At, B1); PG8_BAR; PG8_SCHED;
            PG8_LDA(At, 1, 1); PG8_STAGE(PG8_SB(1, 0), b3, voffB[0], voffB[1]); PG8_STAGE(PG8_SB(1, 1), b3 + hstepB, voffB[0], voffB[1]); PG8_STAGE(PG8_SA(1, 0), a3, x0, x1);
            PG8_WAIT_V(8); PG8_WAIT_L(0); PG8_BAR; PG8_MMA(1, 0, At, B0); PG8_MMA(1, 1, At, B1); PG8_BAR; PG8_SCHED;
        }
        if (wr == 0) PG8_BAR;
        if constexpr (FP8) asm volatile("s_nop 15\n\ts_nop 15");
        { int tz = threadIdx.x; asm volatile("" : "+v"(tz));
          const int wid_ = tz >> 6, lane_ = tz & 63; E(acc, cur, wid_ >> 2, wid_ & 3, lane_ & 15, lane_ >> 4);
#ifdef PROBE_EPI2
          if constexpr (Epi::PROBE2) { asm volatile("" : "+v"(tz)); const int w2 = tz >> 6, l2 = tz & 63; E(acc, cur, w2 >> 2, w2 & 3, l2 & 15, l2 >> 4); }
#endif
#ifdef PROBE_DRAIN
          if constexpr (Epi::PROBE2) { asm volatile("s_waitcnt vmcnt(0)" ::: "memory"); }
#endif
        }
        if (!has_next) break;
#pragma unroll
        for (int a = 0; a < 2; ++a)
#pragma unroll
            for (int b = 0; b < 2; ++b)
#pragma unroll
                for (int m = 0; m < 4; ++m)
#pragma unroll
                    for (int n = 0; n < 2; ++n) acc[a][b][m][n] = (f32x4){0.f, 0.f, 0.f, 0.f};
        cur = nxt; cA = nA; cB = nB; ++ui;
        vA[0] = vN[0]; vA[1] = vN[1]; vA[2] = vN[2]; vA[3] = vN[3];
        if (wr == 1) PG8_BAR;
    }
    PG8_WAIT_V(0);
    PG8_BAR;
#undef PG8_SA
#undef PG8_SB
#undef PG8_STAGE
#undef PG8_LDA
#undef PG8_LDB
#undef PG8_H0
#undef PG8_H1
#undef PG8_MMA
#undef PG8_WAIT_V
#undef PG8_WAIT_L
#undef PG8_BAR
#undef PG8_SCHED
}
}

struct Args { const float* in[27]; float* out; unsigned char* ws; int ph_lo, ph_hi; };
static_assert(sizeof(Args) == 27 * 8 + 8 + 8 + 8, "Args has no padding");

struct DenseU { const char* A; const char* B; int pm, pn; };
struct DenseSched {
    typedef DenseU U;
    const char* A; const char* B; int lda, K, nM, nN, nwg, G, c;
    __device__ __forceinline__ void init(const void* A_, const void* B_, int lda_, int K_, int M, int N, int G_, int c_) { A = (const char*)A_; B = (const char*)B_; lda = lda_; K = K_; nM = M / 256; nN = N / 256; nwg = nM * nN; G = G_; c = c_; }
    __device__ __forceinline__ bool next(int i, U& u) const {
        const long L = (long)i * G + c; if (L >= nwg) return false;
        int wgid = (int)L; { const int q = nwg / 8, r = nwg % 8, xcd = wgid % 8, off = wgid / 8; wgid = (xcd < r ? xcd * (q + 1) : r * (q + 1) + (xcd - r) * q) + off; }
        const int nig = 8 * nN, gid = wgid / nig, fm = gid * 8, gsz = (nM - fm) < 8 ? (nM - fm) : 8;
        u.pm = fm + ((wgid % nig) % gsz); u.pn = (wgid % nig) / gsz;
        u.A = A + (size_t)u.pm * 256 * lda * 2; u.B = B + (size_t)u.pn * 256 * K * 2; return true;
    }
    __device__ __forceinline__ void aoffs(const U&, const int (&R)[2], const int (&C)[2], unsigned (&v)[4]) const {
#pragma unroll
        for (int h = 0; h < 2; ++h)
#pragma unroll
            for (int i = 0; i < 2; ++i) v[h * 2 + i] = (unsigned)((h * 128 + R[i]) * lda + C[i]) * 2u;
    }
};
struct PoolU { const char* A; const char* B; int pm, g; };
struct PoolSched {
    typedef PoolU U;
    const char* A; const char* B; int G, c;
    __device__ __forceinline__ bool next(int i, U& u) const {
        const int L = i * G + c; if (L >= 256) return false;
        u.g = L & 3; u.pm = L >> 2;
        u.A = A + ((size_t)u.pm * 256 * 1024 + u.g * 256) * 2; u.B = B + (size_t)u.g * 256 * 256 * 2; return true;
    }
    __device__ __forceinline__ void aoffs(const U&, const int (&R)[2], const int (&C)[2], unsigned (&v)[4]) const {
#pragma unroll
        for (int h = 0; h < 2; ++h)
#pragma unroll
            for (int i = 0; i < 2; ++i) v[h * 2 + i] = (unsigned)((h * 128 + R[i]) * 1024 + C[i]) * 2u;
    }
};
struct MoeU { const char* A; const char* B; int row0, nrows, pn; };
struct MoeGUSched {
    typedef MoeU U;
    const char* H2; const char* W; const int* tile; const int* slot_tok; int G, c;
    __device__ __forceinline__ bool next(int i, U& u) const {
        const int nt = tile[3 * NTILE_MAX]; const int L = i * G + c; if (L >= nt * 4) return false;
        const int t = L >> 2; u.pn = L & 3; const int e = tile[t]; u.row0 = tile[NTILE_MAX + t]; u.nrows = tile[2 * NTILE_MAX + t];
        u.A = H2; u.B = W + ((size_t)e * 1024 + u.pn * 256) * 2048; return true;
    }
    __device__ __forceinline__ void aoffs(const U& u, const int (&R)[2], const int (&C)[2], unsigned (&v)[4]) const {
#pragma unroll
        for (int h = 0; h < 2; ++h)
#pragma unroll
            for (int i = 0; i < 2; ++i) { int r = h * 128 + R[i]; r = r < u.nrows ? r : u.nrows - 1; const int tok = slot_tok[u.row0 + r]; v[h * 2 + i] = (unsigned)(tok * 1024 + C[i]) * 2u; }
    }
};
struct MoeDownSched {
    typedef MoeU U;
    const char* ACT; const char* W; const int* tile; int G, c;
    __device__ __forceinline__ bool next(int i, U& u) const {
        const int nt = tile[3 * NTILE_MAX]; const int L = i * G + c; if (L >= nt * 8) return false;
        const int t = L >> 3; u.pn = L & 7; const int e = tile[t]; u.row0 = tile[NTILE_MAX + t]; u.nrows = tile[2 * NTILE_MAX + t];
        u.A = ACT + (size_t)u.row0 * 512; u.B = W + ((size_t)e * 2048 + u.pn * 256) * 512; return true;
    }
    __device__ __forceinline__ void aoffs(const U&, const int (&R)[2], const int (&C)[2], unsigned (&v)[4]) const {
#pragma unroll
        for (int h = 0; h < 2; ++h)
#pragma unroll
            for (int i = 0; i < 2; ++i) v[h * 2 + i] = (unsigned)((h * 128 + R[i]) * 256 + C[i]) * 2u;
    }
};

struct EpiIn {
    static constexpr int PERMK = 1; static constexpr bool PROBE2 = false;
    unsigned char* ws;
    __device__ __forceinline__ void operator()(const f32x4 (&acc)[2][2][4][2], const DenseU& u, int wr, int wc, int fr, int fq) const {
        const int pn = u.pn; const int row0 = u.pm * 256 + wr * 64 + fr;
        if (pn == 16) {
            if (wc != 0) return;
            float* alr = (float*)(ws + RA_ALR);
#pragma unroll
            for (int ai = 0; ai < 2; ++ai)
#pragma unroll
                for (int m = 0; m < 4; ++m) { float* rp = alr + (size_t)(row0 + ai * 128 + m * 16) * 32 + 8 * fq;
                    *(f32x4*)(rp) = acc[ai][0][m][0]; *(f32x4*)(rp + 4) = acc[ai][0][m][1]; }
            return;
        }
        bf16* base; int ld, colt; bool lat_only;
        if (pn < 2) { base = (bf16*)(ws + RA_Q); ld = 512; colt = pn * 256; lat_only = true; }
        else if (pn < 4) { base = (bf16*)(ws + RA_K); ld = 512; colt = (pn - 2) * 256; lat_only = false; }
        else if (pn < 8) { base = (bf16*)(ws + RA_V); ld = 1024; colt = (pn - 4) * 256; lat_only = false; }
        else if (pn < 12) { base = (bf16*)(ws + RA_R); ld = 1024; colt = (pn - 8) * 256; lat_only = true; }
        else { base = (bf16*)(ws + RA_P); ld = 1024; colt = (pn - 12) * 256; lat_only = true; }
        if (lat_only && u.pm >= 64) return;
        const int col0 = colt + wc * 32 + 8 * fq;
#pragma unroll
        for (int ai = 0; ai < 2; ++ai)
#pragma unroll
            for (int m = 0; m < 4; ++m) { bf16* rp = base + (size_t)(row0 + ai * 128 + m * 16) * ld + col0;
#pragma unroll
                for (int bj = 0; bj < 2; ++bj) { const f32x4 v0 = acc[ai][bj][m][0], v1 = acc[ai][bj][m][1];
                    v4u o; o.x = pg8::cvt_pk_bf16(v0[0], v0[1]); o.y = pg8::cvt_pk_bf16(v0[2], v0[3]); o.z = pg8::cvt_pk_bf16(v1[0], v1[1]); o.w = pg8::cvt_pk_bf16(v1[2], v1[3]);
                    *(v4u*)(rp + bj * 128) = o; } }
    }
};
struct EpiPool {
    static constexpr int PERMK = 1; static constexpr bool PROBE2 = false;
    bf16* ymix; const float* scale;
    __device__ __forceinline__ void operator()(const f32x4 (&acc)[2][2][4][2], const PoolU& u, int wr, int wc, int fr, int fq) const {
        const int row0 = u.pm * 256 + wr * 64 + fr; const int c0 = u.g * 256 + wc * 32 + 8 * fq;
#pragma unroll
        for (int ai = 0; ai < 2; ++ai)
#pragma unroll
            for (int m = 0; m < 4; ++m) { bf16* rp = ymix + (size_t)(row0 + ai * 128 + m * 16) * 2048 + 1024 + c0;
#pragma unroll
                for (int bj = 0; bj < 2; ++bj) { const f32x4 s0 = *(const f32x4*)(scale + c0 + bj * 128), s1 = *(const f32x4*)(scale + c0 + bj * 128 + 4);
                    const f32x4 v0 = acc[ai][bj][m][0] * s0, v1 = acc[ai][bj][m][1] * s1;
                    v4u o; o.x = pg8::cvt_pk_bf16(v0[0], v0[1]); o.y = pg8::cvt_pk_bf16(v0[2], v0[3]); o.z = pg8::cvt_pk_bf16(v1[0], v1[1]); o.w = pg8::cvt_pk_bf16(v1[2], v1[3]);
                    *(v4u*)(rp + bj * 128) = o; } }
    }
};
struct EpiOut {
    static constexpr int PERMK = 1; static constexpr bool PROBE2 = false;
    bf16* y;
    __device__ __forceinline__ void operator()(const f32x4 (&acc)[2][2][4][2], const DenseU& u, int wr, int wc, int fr, int fq) const {
        const int row0 = u.pm * 256 + wr * 64 + fr, col0 = u.pn * 256 + wc * 32 + 8 * fq;
#pragma unroll
        for (int ai = 0; ai < 2; ++ai)
#pragma unroll
            for (int m = 0; m < 4; ++m) { bf16* rp = y + (size_t)(row0 + ai * 128 + m * 16) * 2048 + col0;
#pragma unroll
                for (int bj = 0; bj < 2; ++bj) { const f32x4 v0 = acc[ai][bj][m][0], v1 = acc[ai][bj][m][1];
                    v4u o; o.x = pg8::cvt_pk_bf16(v0[0], v0[1]); o.y = pg8::cvt_pk_bf16(v0[2], v0[3]); o.z = pg8::cvt_pk_bf16(v1[0], v1[1]); o.w = pg8::cvt_pk_bf16(v1[2], v1[3]);
                    *(v4u*)(rp + bj * 128) = o; } }
    }
};
constexpr float SC_W = 256.f, SC_H = 16.f, SC_A = 16.f;
__device__ __forceinline__ unsigned pk4_fp8(float a, float b, float c, float d) {
    a = fminf(fmaxf(a, -448.f), 448.f); b = fminf(fmaxf(b, -448.f), 448.f); c = fminf(fmaxf(c, -448.f), 448.f); d = fminf(fmaxf(d, -448.f), 448.f);
    unsigned w = 0; w = __builtin_amdgcn_cvt_pk_fp8_f32(a, b, w, false); w = __builtin_amdgcn_cvt_pk_fp8_f32(c, d, w, true); return w;
}
struct EpiGU {
    static constexpr int PERMK = 1; static constexpr bool PROBE2 = false;
    unsigned char* act; const float* slot_w;
    __device__ __forceinline__ void operator()(const f32x4 (&acc)[2][2][4][2], const MoeU& u, int wr, int wc, int fr, int fq) const {
        const int c0 = u.pn * 128 + wc * 32 + 8 * fq; constexpr float inv = 1.f / (SC_W * SC_H);
#pragma unroll
        for (int ai = 0; ai < 2; ++ai)
#pragma unroll
            for (int m = 0; m < 4; ++m) { const int r = ai * 128 + wr * 64 + m * 16 + fr;
                if (r < u.nrows) { const float w = slot_w[u.row0 + r] * SC_A; float o[8];
#pragma unroll
                    for (int n = 0; n < 2; ++n)
#pragma unroll
                        for (int j = 0; j < 4; ++j) { const float g = acc[ai][0][m][n][j] * inv, up = acc[ai][1][m][n][j] * inv; o[n * 4 + j] = silu_f(g) * up * w; }
                    v2u q; q.x = pk4_fp8(o[0], o[1], o[2], o[3]); q.y = pk4_fp8(o[4], o[5], o[6], o[7]);
                    *(v2u*)(act + (size_t)(u.row0 + r) * 512 + c0) = q; } }
    }
};
constexpr float SC_O = 32.f;
struct EpiDown {
    static constexpr int PERMK = 2; static constexpr bool PROBE2 = true;
    unsigned char* so;
    __device__ __forceinline__ void operator()(const f32x4 (&acc)[2][2][4][2], const MoeU& u, int wr, int wc, int fr, int fq) const {
        const int c0 = u.pn * 256 + wc * 64 + 16 * fq; constexpr float sc = SC_O / (SC_W * SC_A);
#pragma unroll
        for (int ai = 0; ai < 2; ++ai)
#pragma unroll
            for (int m = 0; m < 4; ++m) { const int r = ai * 128 + wr * 64 + m * 16 + fr;
                if (r < u.nrows) { const f32x4 a0 = acc[ai][0][m][0] * sc, a1 = acc[ai][0][m][1] * sc, b0 = acc[ai][1][m][0] * sc, b1 = acc[ai][1][m][1] * sc;
                    v4u o; o.x = pk4_fp8(a0[0], a0[1], a0[2], a0[3]); o.y = pk4_fp8(a1[0], a1[1], a1[2], a1[3]); o.z = pk4_fp8(b0[0], b0[1], b0[2], b0[3]); o.w = pk4_fp8(b1[0], b1[1], b1[2], b1[3]);
                    __builtin_nontemporal_store(o, (v4u*)(so + (size_t)(u.row0 + r) * 2048 + c0)); } }
    }
};

__device__ __forceinline__ void tr_item(const float* W, int ldn, bf16* WT, int Kd, int drow0, int k0, int n0, LAS float* scr, int lane) {
    f32x4 t[8];
#pragma unroll
    for (int i = 0; i < 8; ++i) t[i] = *(const f32x4*)(W + (size_t)(k0 + 8 * i + (lane >> 3)) * ldn + n0 + 4 * (lane & 7));
#pragma unroll
    for (int i = 0; i < 8; ++i) { LAS float* d = scr + (8 * i + (lane >> 3)) * 33 + 4 * (lane & 7); d[0] = t[i][0]; d[1] = t[i][1]; d[2] = t[i][2]; d[3] = t[i][3]; }
    LDS_WAIT(); asm volatile("" ::: "memory");
    const int c = lane & 7;
#pragma unroll
    for (int j = 0; j < 4; ++j) { const int n = (lane >> 3) + 8 * j; const LAS float* s = scr + (8 * c) * 33 + n;
        v4u o; o.x = pk2(s[0 * 33], s[1 * 33]); o.y = pk2(s[2 * 33], s[3 * 33]); o.z = pk2(s[4 * 33], s[5 * 33]); o.w = pk2(s[6 * 33], s[7 * 33]);
        *(v4u*)(WT + (size_t)(drow0 + n) * Kd + k0 + 8 * c) = o; }
    LDS_WAIT(); asm volatile("" ::: "memory");
}

__device__ __forceinline__ void tr_item8(const float* W, int ldn, unsigned char* WT, int Kd, int drow0, int k0, int n0, LAS float* scr, int lane) {
    f32x4 t[8];
#pragma unroll
    for (int i = 0; i < 8; ++i) t[i] = *(const f32x4*)(W + (size_t)(k0 + 8 * i + (lane >> 3)) * ldn + n0 + 4 * (lane & 7));
#pragma unroll
    for (int i = 0; i < 8; ++i) { LAS float* d = scr + (8 * i + (lane >> 3)) * 33 + 4 * (lane & 7); d[0] = t[i][0]; d[1] = t[i][1]; d[2] = t[i][2]; d[3] = t[i][3]; }
    LDS_WAIT(); asm volatile("" ::: "memory");
    const int c = lane & 7;
#pragma unroll
    for (int j = 0; j < 4; ++j) { const int n = (lane >> 3) + 8 * j; const LAS float* s = scr + (8 * c) * 33 + n;
        v2u o; o.x = pk4_fp8(s[0 * 33] * SC_W, s[1 * 33] * SC_W, s[2 * 33] * SC_W, s[3 * 33] * SC_W); o.y = pk4_fp8(s[4 * 33] * SC_W, s[5 * 33] * SC_W, s[6 * 33] * SC_W, s[7 * 33] * SC_W);
        *(v2u*)(WT + (size_t)(drow0 + n) * Kd + k0 + 8 * c) = o; }
    LDS_WAIT(); asm volatile("" ::: "memory");
}

__device__ __forceinline__ void phase0(const Args& a, LAS unsigned char* lds, int tid, int lane, int wave, int vcu, int G, bool do_mod = true, bool do_tr = true) {
    unsigned char* ws = a.ws;
    if (vcu < 192 && do_mod) {
        LAS float* sc = (LAS float*)lds;
        LAS float* red = (LAS float*)(lds + 73728);
        for (int i = tid; i < 9 * 2048; i += 512) { const int r = i >> 11, k = i & 2047; const float v = r < 8 ? a.in[1][r * 2048 + k] : a.in[3][k]; sc[i] = silu_f(v); }
        __syncthreads();
        const float* wm = a.in[4]; const float* bm = a.in[5]; float* mod = (float*)(ws + WS_MOD);
        for (int chunk = vcu; chunk < 192; chunk += G) {
            const int n0 = chunk * 64, ks = lane >> 4, n4 = (lane & 15) * 4;
            f32x4 acc[9];
#pragma unroll
            for (int r = 0; r < 9; ++r) acc[r] = (f32x4){0.f, 0.f, 0.f, 0.f};
#pragma unroll 4
            for (int kk = 0; kk < 256; kk += 4) { const int k = wave * 256 + kk + ks; const f32x4 wv = *(const f32x4*)(wm + (size_t)k * 12288 + n0 + n4);
#pragma unroll
                for (int r = 0; r < 9; ++r) { const float s = sc[r * 2048 + k]; acc[r] += wv * s; } }
#pragma unroll
            for (int r = 0; r < 9; ++r)
#pragma unroll
                for (int j = 0; j < 4; ++j) { float v = acc[r][j]; v += __shfl_xor(v, 16); v += __shfl_xor(v, 32); acc[r][j] = v; }
            if (lane < 16) {
#pragma unroll
                for (int r = 0; r < 9; ++r) *(LAS f32x4*)(red + (wave * 9 + r) * 64 + n4) = acc[r]; }
            __syncthreads();
            for (int i = tid; i < 9 * 64; i += 512) { const int r = i >> 6, n = i & 63; float s = 0.f;
#pragma unroll
                for (int w = 0; w < 8; ++w) s += red[(w * 9 + r) * 64 + n];
                mod[r * 12288 + n0 + n] = s + bm[n0 + n]; }
            __syncthreads();
        }
    }
    __syncthreads();
    LAS float* scr = (LAS float*)(lds + wave * 16384);
    const int gw = vcu * 8 + wave, NGW = G * 8;
    bf16* Win_t = (bf16*)(ws + WS_WIN); bf16* Wout_t = (bf16*)(ws + WS_WOUT); bf16* Wpool_t = (bf16*)(ws + WS_WPOOL); unsigned char* Wd_t = ws + WS_WD; unsigned char* Wgu_t = ws + WS_WGU;
    constexpr int I_IN = 32 * 129, I_OUT = 32 * 64, I_POOL = 4 * 4 * 8, I_E = 65 * 512;
    constexpr int NITEMS = I_IN + I_OUT + I_POOL + 3 * I_E;
    for (int it = gw; it < (do_tr ? NITEMS : 0); it += NGW) {
        int r = it;
        if (r < I_IN) { const int kb = r / 129, nb = r % 129, n0 = 32 * nb; const int drow = n0 < 3072 ? n0 : (n0 == 3072 ? 4096 : n0 - 32);
            tr_item(a.in[10], DIN, Win_t, 2048, drow, 64 * kb, n0, scr, lane); continue; } r -= I_IN;
        if (r < I_OUT) { const int kb = r / 64, nb = r % 64; tr_item(a.in[18], 2048, Wout_t, 2048, 32 * nb, 64 * kb, 32 * nb, scr, lane); continue; } r -= I_OUT;
        if (r < I_POOL) { const int g = r / 32, rr = r % 32, kb = rr / 8, nb = rr % 8; tr_item(a.in[16] + g * 65536, 256, Wpool_t + g * 65536, 256, 32 * nb, 64 * kb, 32 * nb, scr, lane); continue; } r -= I_POOL;
        if (r < I_E) { const int e = r / 512, rr = r % 512, kb = rr / 16, nb = rr % 16, n0 = 32 * nb; const float* src = e < 64 ? a.in[21] + (size_t)e * 2048 * 512 : a.in[24];
            tr_item8(src, 512, Wgu_t + (size_t)e * 1024 * 2048, 2048, (n0 / 128) * 256 + (n0 % 128), 64 * kb, n0, scr, lane); continue; } r -= I_E;
        if (r < I_E) { const int e = r / 512, rr = r % 512, kb = rr / 16, nb = rr % 16, n0 = 32 * nb; const float* src = e < 64 ? a.in[22] + (size_t)e * 2048 * 512 : a.in[25];
            tr_item8(src, 512, Wgu_t + (size_t)e * 1024 * 2048, 2048, (n0 / 128) * 256 + 128 + (n0 % 128), 64 * kb, n0, scr, lane); continue; } r -= I_E;
        { const int e = r / 512, rr = r % 512, kb = rr / 64, nb = rr % 64; const float* src = e < 64 ? a.in[23] + (size_t)e * 512 * 2048 : a.in[26];
            tr_item8(src, 2048, Wd_t + (size_t)e * 2048 * 512, 512, 32 * nb, 64 * kb, 32 * nb, scr, lane); }
    }
    { const float* wr = a.in[19]; bf16* whi = (bf16*)(ws + WS_WRT); bf16* wlo = whi + 64 * 2048;
      for (int idx = vcu * 512 + tid; idx < 64 * 256; idx += G * 512) { const int e = idx >> 8, k8 = idx & 255; unsigned hi[8], lo[8];
#pragma unroll
          for (int j = 0; j < 8; ++j) { const float v = wr[(size_t)(8 * k8 + j) * 64 + e]; hi[j] = f2bf(v); lo[j] = f2bf(v - __builtin_bit_cast(float, hi[j] << 16)); }
          v4u oh, ol; oh.x = hi[0] | (hi[1] << 16); oh.y = hi[2] | (hi[3] << 16); oh.z = hi[4] | (hi[5] << 16); oh.w = hi[6] | (hi[7] << 16);
          ol.x = lo[0] | (lo[1] << 16); ol.y = lo[2] | (lo[3] << 16); ol.z = lo[4] | (lo[5] << 16); ol.w = lo[6] | (lo[7] << 16);
          *(v4u*)(whi + (size_t)e * 2048 + 8 * k8) = oh; *(v4u*)(wlo + (size_t)e * 2048 + 8 * k8) = ol; } }
    { v4u* z = (v4u*)(Win_t + (size_t)DIN * 2048); const int nz = (DINP - DIN) * 2048 / 8;
      for (int i = vcu * 512 + tid; i < nz; i += G * 512) z[i] = (v4u){0u, 0u, 0u, 0u}; }
}

__device__ __forceinline__ void phase1(const Args& a, int lane, int wave, int vcu, int G) {
    const float* mod = (const float*)(a.ws + WS_MOD); bf16* H = (bf16*)(a.ws + RA_H); const float* g = a.in[6];
    for (int m = vcu * 8 + wave; m < MROWS; m += G * 8) {
        const float* xr = m < NT ? a.in[0] + (size_t)m * 2048 : a.in[2] + (size_t)(m - NT) * 2048;
        const float* mr = mod + (size_t)(m < NT ? (m >> 11) : 8) * 12288;
        f32x4 v[8]; float ss = 0.f;
#pragma unroll
        for (int j = 0; j < 8; ++j) { v[j] = *(const f32x4*)(xr + 4 * (lane + 64 * j)); ss += v[j][0] * v[j][0] + v[j][1] * v[j][1] + v[j][2] * v[j][2] + v[j][3] * v[j][3]; }
        const float rstd = rsqrtf(wave_sum(ss) * (1.f / 2048.f) + EPS);
#pragma unroll
        for (int j = 0; j < 8; ++j) { const int c = 4 * (lane + 64 * j); const f32x4 gg = *(const f32x4*)(g + c), sh = *(const f32x4*)(mr + c), sc = *(const f32x4*)(mr + 2048 + c);
            const f32x4 o = v[j] * rstd * gg * (sc + 1.f) + sh;
            v2u q; q.x = pk2(o[0], o[1]); q.y = pk2(o[2], o[3]); *(v2u*)(H + (size_t)m * 2048 + c) = q; }
    }
}

__device__ __forceinline__ int scan_row(int b, int dir, int s) {
    if (s < 256) { const int tc = dir ? 255 - s : s; return NT + b * 256 + tc; }
    const int t0 = s - 256; return b * 2048 + (dir ? 2047 - t0 : t0);
}
__device__ __forceinline__ void phase3_prep(const Args& a, LAS unsigned char* lds, int tid, int vcu, int G) {
    unsigned char* ws = a.ws;
    const bf16* Q = (const bf16*)(ws + RA_Q); const bf16* Kb = (const bf16*)(ws + RA_K); const float* ALR = (const float*)(ws + RA_ALR);
    bf16* QG = (bf16*)(ws + PQG); bf16* AM = (bf16*)(ws + PAM); bf16* KD = (bf16*)(ws + PKD); float* DEC = (float*)(ws + PDEC);
    constexpr int TS = 520;
    LAS float* alr = (LAS float*)lds;
    LAS bf16* Kt = (LAS bf16*)(lds + 4096);
    LAS bf16* Qt = (LAS bf16*)(lds + 4096 + 64 * TS * 2);
    const int col = tid, h = col >> 7, dk = col & 127;
    const int lane = tid & 63, wave = __builtin_amdgcn_readfirstlane(tid >> 6), l15 = lane & 15, l4 = lane >> 4;
    for (int item = vcu; item < 2 * 8 * 36; item += G) {
        const int ch = item % 36, b = (item / 36) & 7, dir = item / 288;
        const bool lat = ch >= 4;
        if (tid < 256) { const int i = tid >> 2, r4 = (tid & 3) * 4; const int row = scan_row(b, dir, ch * 64 + i);
            *(LAS f32x4*)(alr + i * 16 + r4) = *(const f32x4*)(ALR + (size_t)row * 32 + dir * 16 + r4); }
        { v4u kr[8], qr[8];
#pragma unroll
          for (int q = 0; q < 8; ++q) { const int p = tid + 512 * q, i = p >> 6, c8 = (p & 63) * 8; const int row = scan_row(b, dir, ch * 64 + i);
              kr[q] = *(const v4u*)(Kb + (size_t)row * 512 + c8); if (lat) qr[q] = *(const v4u*)(Q + (size_t)row * 512 + c8); }
#pragma unroll
          for (int q = 0; q < 8; ++q) { const int p = tid + 512 * q, i = p >> 6, c8 = (p & 63) * 8; *(LAS v4u*)(Kt + i * TS + c8) = kr[q]; if (lat) *(LAS v4u*)(Qt + i * TS + c8) = qr[q]; } }
        const float* wa2 = dir ? a.in[13] : a.in[11]; const float bia = (dir ? a.in[14] : a.in[12])[col];
        float w[16];
#pragma unroll
        for (int r = 0; r < 16; ++r) w[r] = wa2[r * 512 + col];
        __syncthreads();
        float Gc = 0.f, Gmid = 0.f;
#pragma unroll 4
        for (int i = 0; i < 64; ++i) { float z = bia;
#pragma unroll
            for (int r4 = 0; r4 < 4; ++r4) { const f32x4 x = *(const LAS f32x4*)(alr + i * 16 + 4 * r4); z += x[0] * w[4 * r4] + x[1] * w[4 * r4 + 1] + x[2] * w[4 * r4 + 2] + x[3] * w[4 * r4 + 3]; }
            Gc += (fminf(z, 0.f) - __logf(1.f + __expf(-fabsf(z)))) * (1.f / 16.f);
            if (i == 32) Gmid = Gc; }
        const float Gend = Gc;
        DEC[((size_t)(dir * 8 + b) * 36 + ch) * 512 + col] = __expf(Gend);
        bf16* kdrow = KD + ((((size_t)(dir * 8 + b) * 36 + ch) * 4 + h) * 128 + dk) * 64;
        const size_t lt = lat ? ((((size_t)(dir * 8 + b) * 32 + (ch - 4)) * 4 + h) * 64) * 128 + dk : 0;
        Gc = 0.f;
#pragma unroll 1
        for (int i0 = 0; i0 < 64; i0 += 8) { unsigned kd[8];
#pragma unroll
            for (int ii = 0; ii < 8; ++ii) { const int i = i0 + ii; float z = bia;
#pragma unroll
                for (int r4 = 0; r4 < 4; ++r4) { const f32x4 x = *(const LAS f32x4*)(alr + i * 16 + 4 * r4); z += x[0] * w[4 * r4] + x[1] * w[4 * r4 + 1] + x[2] * w[4 * r4 + 2] + x[3] * w[4 * r4 + 3]; }
                Gc += (fminf(z, 0.f) - __logf(1.f + __expf(-fabsf(z)))) * (1.f / 16.f);
                const float kv = bf1(Kt[i * TS + col]);
                kd[ii] = f2bf(kv * __expf(Gend - Gc));
                if (lat) { const float qv = bf1(Qt[i * TS + col]) * 0.08838834764831845f;
                    QG[lt + (size_t)i * 128] = (bf16)f2bf(qv * __expf(Gc));
                    Qt[i * TS + col] = (bf16)f2bf(qv * __expf(Gc - Gmid)); Kt[i * TS + col] = (bf16)f2bf(kv * __expf(Gmid - Gc)); } }
            v4u o; o.x = kd[0] | (kd[1] << 16); o.y = kd[2] | (kd[3] << 16); o.z = kd[4] | (kd[5] << 16); o.w = kd[6] | (kd[7] << 16);
            *(v4u*)(kdrow + i0) = o; }
        if (lat) {
            __syncthreads();
            const int hh = wave >> 1; bf16* amt = AM + ((((size_t)(dir * 8 + b) * 32 + (ch - 4)) * 4 + hh) * 64) * 64;
#pragma unroll
            for (int t2 = 0; t2 < 2; ++t2) { const int ti = (wave & 1) * 2 + t2; f32x4 c[4];
#pragma unroll
                for (int tj = 0; tj < 4; ++tj) c[tj] = (f32x4){0.f, 0.f, 0.f, 0.f};
#pragma unroll
                for (int ks = 0; ks < 4; ++ks) { const int ko = hh * 128 + 32 * ks + 8 * l4;
                    const bf16x8 bq = *(const LAS bf16x8*)(Qt + (16 * ti + l15) * TS + ko);
#pragma unroll
                    for (int tj = 0; tj < 4; ++tj) { const bf16x8 ak = *(const LAS bf16x8*)(Kt + (16 * tj + l15) * TS + ko);
                        c[tj] = __builtin_amdgcn_mfma_f32_16x16x32_bf16(ak, bq, c[tj], 0, 0, 0); } }
                const int i = 16 * ti + l15;
#pragma unroll
                for (int tj = 0; tj < 4; ++tj) { const int j0 = 16 * tj + 4 * l4;
                    v2u p; p.x = pk2(j0 <= i ? c[tj][0] : 0.f, j0 + 1 <= i ? c[tj][1] : 0.f); p.y = pk2(j0 + 2 <= i ? c[tj][2] : 0.f, j0 + 3 <= i ? c[tj][3] : 0.f);
                    *(v2u*)(amt + i * 64 + j0) = p; } }
        }
        __syncthreads();
    }
}

constexpr int GL_QG = 0, GL_ST = 17408, GL_KDT = 34816, GL_VT = 53248, GL_AM = 62464, GL_DEC = 71680;
__device__ __forceinline__ void phase_chain(const Args& a, LAS unsigned char* lds, int tid, int lane, int wave, int vcu, int G) {
    unsigned char* ws = a.ws;
    const v4u* QG = (const v4u*)(ws + PQG); const v4u* AM = (const v4u*)(ws + PAM); const v4u* KD = (const v4u*)(ws + PKD); const float* DEC = (const float*)(ws + PDEC);
    const bf16* V = (const bf16*)(ws + RA_V); bf16* OF = (bf16*)(ws + RA_OF);
    const int l15 = lane & 15, l4 = lane >> 4;
    for (int item = vcu; item < 256; item += G) {
        const int vs = item & 3, dir = (item >> 2) & 1, h = (item >> 3) & 3, b = item >> 5;
        f32x4 S[4];
#pragma unroll
        for (int tv = 0; tv < 4; ++tv) S[tv] = (f32x4){0.f, 0.f, 0.f, 0.f};
        v4u rqA[2], raA, rkA[2], rvA, rqB[2], raB, rkB[2], rvB; float rdecA = 0.f, rdecB = 0.f;
#define GL_LOAD(ch_, LATL, rq, ra, rk, rv, rdec) do { const int ch__ = (ch_); \
            if (LATL) { const size_t t_ = ((((size_t)(dir * 8 + b) * 32 + (ch__ - 4)) * 4 + h) * 1024); rq[0] = QG[t_ + tid]; rq[1] = QG[t_ + tid + 512]; ra = AM[t_ / 2 + tid]; } \
            { const size_t t_ = ((((size_t)(dir * 8 + b) * 36 + ch__) * 4 + h) * 1024); rk[0] = KD[t_ + tid]; rk[1] = KD[t_ + tid + 512]; } \
            { const int row_ = scan_row(b, dir, ch__ * 64 + (tid >> 3)); rv = *(const v4u*)(V + (size_t)row_ * 1024 + h * 256 + vs * 64 + 8 * (tid & 7)); } \
            rdec = DEC[((size_t)(dir * 8 + b) * 36 + ch__) * 512 + h * 128 + (tid & 127)]; } while (0)
#define GL_STEP(ch_, LAT, LATN, MORE, rq, ra, rk, rv, rdec) do { const int ch = (ch_); \
              \
            _Pragma("unroll") for (int tv = 0; tv < 4; ++tv) { v2u p; p.x = pk2(S[tv][0], S[tv][1]); p.y = pk2(S[tv][2], S[tv][3]); \
                *(LAS v2u*)(lds + GL_ST + (16 * tv + l15) * 272 + (16 * wave + 4 * l4) * 2) = p; } \
            if (LAT) { _Pragma("unroll") for (int q = 0; q < 2; ++q) { const int p = tid + 512 * q; *(LAS v4u*)(lds + GL_QG + (p >> 4) * 272 + (p & 15) * 16) = rq[q]; } \
                *(LAS v4u*)(lds + GL_AM + (tid >> 3) * 144 + (tid & 7) * 16) = ra; } \
            _Pragma("unroll") for (int q = 0; q < 2; ++q) { const int p = tid + 512 * q; *(LAS v4u*)(lds + GL_KDT + (p >> 3) * 144 + (p & 7) * 16) = rk[q]; } \
            { const int i = tid >> 3, c = tid & 7; LAS bf16* vt = (LAS bf16*)(lds + GL_VT) + i; \
              vt[(8 * c + 0) * 72] = (bf16)(rv.x & 0xffffu); vt[(8 * c + 1) * 72] = (bf16)(rv.x >> 16); vt[(8 * c + 2) * 72] = (bf16)(rv.y & 0xffffu); vt[(8 * c + 3) * 72] = (bf16)(rv.y >> 16); \
              vt[(8 * c + 4) * 72] = (bf16)(rv.z & 0xffffu); vt[(8 * c + 5) * 72] = (bf16)(rv.z >> 16); vt[(8 * c + 6) * 72] = (bf16)(rv.w & 0xffffu); vt[(8 * c + 7) * 72] = (bf16)(rv.w >> 16); } \
            if (tid < 128) *(LAS float*)(lds + GL_DEC + tid * 4) = rdec; \
            LDS_BARRIER(); \
            if (MORE) GL_LOAD(ch + 2, LATN, rq, ra, rk, rv, rdec); \
            if (LAT) {   \
                const int ti = wave >> 1, tv0 = (wave & 1) * 2; f32x4 c0 = (f32x4){0.f, 0.f, 0.f, 0.f}, c1 = c0; bf16x8 fb[6], f0[6], f1[6]; \
                _Pragma("unroll") for (int ks = 0; ks < 4; ++ks) { const int ko = (32 * ks + 8 * l4) * 2; \
                    fb[ks] = *(const LAS bf16x8*)(lds + GL_QG + (16 * ti + l15) * 272 + ko); \
                    f0[ks] = *(const LAS bf16x8*)(lds + GL_ST + (16 * tv0 + l15) * 272 + ko); f1[ks] = *(const LAS bf16x8*)(lds + GL_ST + (16 * tv0 + 16 + l15) * 272 + ko); } \
                _Pragma("unroll") for (int ks = 0; ks < 2; ++ks) { const int ko = (32 * ks + 8 * l4) * 2; \
                    fb[4 + ks] = *(const LAS bf16x8*)(lds + GL_AM + (16 * ti + l15) * 144 + ko); \
                    f0[4 + ks] = *(const LAS bf16x8*)(lds + GL_VT + (16 * tv0 + l15) * 144 + ko); f1[4 + ks] = *(const LAS bf16x8*)(lds + GL_VT + (16 * tv0 + 16 + l15) * 144 + ko); } \
                _Pragma("unroll") for (int ks = 0; ks < 6; ++ks) { c0 = __builtin_amdgcn_mfma_f32_16x16x32_bf16(f0[ks], fb[ks], c0, 0, 0, 0); c1 = __builtin_amdgcn_mfma_f32_16x16x32_bf16(f1[ks], fb[ks], c1, 0, 0, 0); } \
                const int s_ = ch * 64 + 16 * ti + l15; const int t0 = s_ - 256; const int t = dir ? 2047 - t0 : t0; \
                bf16* orow = OF + ((size_t)dir * NT + b * 2048 + t) * 1024 + h * 256 + vs * 64 + 16 * tv0 + 4 * l4; \
                v2u p0, p1; p0.x = pk2(c0[0], c0[1]); p0.y = pk2(c0[2], c0[3]); p1.x = pk2(c1[0], c1[1]); p1.y = pk2(c1[2], c1[3]); \
                *(v2u*)(orow) = p0; *(v2u*)(orow + 16) = p1; } \
              \
            { const f32x4 d4 = *(const LAS f32x4*)(lds + GL_DEC + (16 * wave + 4 * l4) * 4); bf16x8 fk[2], fv[2][4]; \
              _Pragma("unroll") for (int ks = 0; ks < 2; ++ks) { const int ko = (32 * ks + 8 * l4) * 2; fk[ks] = *(const LAS bf16x8*)(lds + GL_KDT + (16 * wave + l15) * 144 + ko); \
                  _Pragma("unroll") for (int tv = 0; tv < 4; ++tv) fv[ks][tv] = *(const LAS bf16x8*)(lds + GL_VT + (16 * tv + l15) * 144 + ko); } \
              _Pragma("unroll") for (int tv = 0; tv < 4; ++tv) S[tv] = S[tv] * d4; \
              _Pragma("unroll") for (int ks = 0; ks < 2; ++ks) \
                  _Pragma("unroll") for (int tv = 0; tv < 4; ++tv) S[tv] = __builtin_amdgcn_mfma_f32_16x16x32_bf16(fk[ks], fv[ks][tv], S[tv], 0, 0, 0); } \
            LDS_BARRIER(); } while (0)
        GL_LOAD(0, false, rqA, raA, rkA, rvA, rdecA); GL_LOAD(1, false, rqB, raB, rkB, rvB, rdecB);
        GL_STEP(0, false, false, true, rqA, raA, rkA, rvA, rdecA); GL_STEP(1, false, false, true, rqB, raB, rkB, rvB, rdecB);
        GL_STEP(2, false, true, true, rqA, raA, rkA, rvA, rdecA);  GL_STEP(3, false, true, true, rqB, raB, rkB, rvB, rdecB);
#pragma unroll 1
        for (int c2 = 4; c2 < 34; c2 += 2) { GL_STEP(c2, true, true, true, rqA, raA, rkA, rvA, rdecA); GL_STEP(c2 + 1, true, true, true, rqB, raB, rkB, rvB, rdecB); }
        GL_STEP(34, true, true, false, rqA, raA, rkA, rvA, rdecA); GL_STEP(35, true, true, false, rqB, raB, rkB, rvB, rdecB);
#undef GL_STEP
#undef GL_LOAD
    }
}

template <int HALFW>
__device__ __forceinline__ void pool_item(const bf16* P, bf16* DP, LAS float* tmp, int tid, int b, int r, int g) {
    const int rlo = r - HALFW < 0 ? 0 : r - HALFW, rhi = r + HALFW > 32 ? 32 : r + HALFW;
    const float rinv = 1.f / (float)(rhi - rlo);
#pragma unroll 1
    for (int q = 0; q < 4; ++q) { const int p = tid + 512 * q, c = p >> 5, ch0 = (p & 31) * 8; float acc[8]; v4u x[2 * HALFW];
#pragma unroll
        for (int u = 0; u < 2 * HALFW; ++u) { const int rr = (rlo + u < rhi) ? rlo + u : rlo; x[u] = *(const v4u*)(P + ((size_t)(b * 2048 + rr * 64 + c)) * 1024 + g * 256 + ch0); }
#pragma unroll
        for (int j = 0; j < 8; ++j) acc[j] = 0.f;
#pragma unroll
        for (int u = 0; u < 2 * HALFW; ++u) { const float m = (rlo + u < rhi) ? 1.f : 0.f;
            acc[0] += m * bflo(x[u].x); acc[1] += m * bfhi(x[u].x); acc[2] += m * bflo(x[u].y); acc[3] += m * bfhi(x[u].y); acc[4] += m * bflo(x[u].z); acc[5] += m * bfhi(x[u].z); acc[6] += m * bflo(x[u].w); acc[7] += m * bfhi(x[u].w); }
        *(LAS f32x4*)(tmp + c * 256 + ch0) = (f32x4){acc[0] * rinv, acc[1] * rinv, acc[2] * rinv, acc[3] * rinv};
        *(LAS f32x4*)(tmp + c * 256 + ch0 + 4) = (f32x4){acc[4] * rinv, acc[5] * rinv, acc[6] * rinv, acc[7] * rinv}; }
    __syncthreads();
#pragma unroll 1
    for (int q = 0; q < 4; ++q) { const int p = tid + 512 * q, c = p >> 5, ch0 = (p & 31) * 8;
        const int clo = c - HALFW < 0 ? 0 : c - HALFW, chi = c + HALFW > 64 ? 64 : c + HALFW; const float cinv = 1.f / (float)(chi - clo);
        const size_t o = ((size_t)(b * 2048 + r * 64 + c)) * 1024 + g * 256 + ch0;
        const v4u x = *(const v4u*)(P + o);
        f32x4 a0 = (f32x4){0.f, 0.f, 0.f, 0.f}, a1 = a0;
#pragma unroll
        for (int u = 0; u < 2 * HALFW; ++u) { const int cc = (clo + u < chi) ? clo + u : clo; const float m = (clo + u < chi) ? 1.f : 0.f;
            a0 += *(const LAS f32x4*)(tmp + cc * 256 + ch0) * m; a1 += *(const LAS f32x4*)(tmp + cc * 256 + ch0 + 4) * m; }
        v4u d; d.x = pk2(a0[0] * cinv - bflo(x.x), a0[1] * cinv - bfhi(x.x)); d.y = pk2(a0[2] * cinv - bflo(x.y), a0[3] * cinv - bfhi(x.y));
        d.z = pk2(a1[0] * cinv - bflo(x.z), a1[1] * cinv - bfhi(x.z)); d.w = pk2(a1[2] * cinv - bflo(x.w), a1[3] * cinv - bfhi(x.w));
        *(v4u*)(DP + o) = d; }
    __syncthreads();
}
__device__ __forceinline__ void phase3_pool(const Args& a, LAS unsigned char* lds, int tid, int vcu, int G) {
    const bf16* P = (const bf16*)(a.ws + RA_P); bf16* DP = (bf16*)(a.ws + RA_DPOOL);
    LAS float* tmp = (LAS float*)lds;
    for (int item = vcu; item < 1024; item += G) {
        const int g = item >> 8, r = (item >> 3) & 31, b = item & 7;
        const int gg = 3 - g;
        if (gg == 0) pool_item<1>(P, DP, tmp, tid, b, r, gg); else if (gg == 1) pool_item<2>(P, DP, tmp, tid, b, r, gg); else if (gg == 2) pool_item<4>(P, DP, tmp, tid, b, r, gg); else pool_item<8>(P, DP, tmp, tid, b, r, gg);
    }
}

__device__ __forceinline__ void phase4_post(const Args& a, int lane, int wave, int vcu, int G) {
    const bf16* OF = (const bf16*)(a.ws + RA_OF); const bf16* OB = OF + (size_t)NT * 1024; const bf16* Rr = (const bf16*)(a.ws + RA_R); bf16* Y = (bf16*)(a.ws + RA_YMIX);
    const float* gn = a.in[15];
    for (int idx = vcu * 8 + wave; idx < NT * 4; idx += G * 8) {
        const int t = idx >> 2, h = idx & 3; const size_t o = (size_t)t * 1024 + h * 256 + 4 * lane;
        const v2u of = *(const v2u*)(OF + o), ob = *(const v2u*)(OB + o);
        const f32x4 x = (f32x4){bflo(of.x) + bflo(ob.x), bfhi(of.x) + bfhi(ob.x), bflo(of.y) + bflo(ob.y), bfhi(of.y) + bfhi(ob.y)};
        const float ms = wave_sum(x[0] * x[0] + x[1] * x[1] + x[2] * x[2] + x[3] * x[3]) * (1.f / 256.f);
        const float sc = rsqrtf(ms + EPS);
        const f32x4 g4 = *(const f32x4*)(gn + h * 256 + 4 * lane);
        const v2u rr = *(const v2u*)(Rr + o);
        const float r0 = bflo(rr.x), r1 = bfhi(rr.x), r2 = bflo(rr.y), r3 = bfhi(rr.y);
        v2u q; q.x = pk2(x[0] * sc * g4[0] * silu_f(r0), x[1] * sc * g4[1] * silu_f(r1)); q.y = pk2(x[2] * sc * g4[2] * silu_f(r2), x[3] * sc * g4[3] * silu_f(r3));
        *(v2u*)(Y + (size_t)t * 2048 + h * 256 + 4 * lane) = q;
    }
}

__device__ __forceinline__ void phase6(const Args& a, LAS unsigned char* lds, int tid, int lane, int wave, int vcu, int G) {
    unsigned char* ws = a.ws;
    const float* mod = (const float*)(ws + WS_MOD); const bf16* Y1 = (const bf16*)(ws + RA_Y1); unsigned char* H2 = ws + RA_H2;
    const float* gpost = a.in[7]; const float* gpre2 = a.in[8]; const float* rbias = a.in[20];
    const bf16* whi = (const bf16*)(ws + WS_WRT); const bf16* wlo = whi + 64 * 2048;
    LAS float* part = (LAS float*)lds;
    LAS float* logit = (LAS float*)(lds + LDS_LOGIT);
    LAS u64* masks = (LAS u64*)(lds + LDS_MASKS);
    int* cnt = (int*)(ws + T_CNT); u64* tmask = (u64*)(ws + T_MASK); float* tokw = (float*)(ws + T_TOKW);
    const int l15 = lane & 15, l4 = lane >> 4;
    for (int blk = vcu; blk < NT / 64; blk += G) {
        for (int it = 0; it < 4; ++it) {
#pragma unroll 1
            for (int rr = 0; rr < 2; ++rr) {
                const int lr = wave * 2 + rr, t = blk * 64 + it * 16 + lr; const float* mr = mod + (size_t)(t >> 11) * 12288;
                const bf16* yr = Y1 + (size_t)t * 2048; const float* xr = a.in[0] + (size_t)t * 2048;
                f32x4 y[8]; float ss = 0.f;
#pragma unroll
                for (int j = 0; j < 8; ++j) { const v2u yb = *(const v2u*)(yr + 4 * (lane + 64 * j)); y[j] = (f32x4){bflo(yb.x), bfhi(yb.x), bflo(yb.y), bfhi(yb.y)}; ss += y[j][0] * y[j][0] + y[j][1] * y[j][1] + y[j][2] * y[j][2] + y[j][3] * y[j][3]; }
                const float rstd1 = rsqrtf(wave_sum(ss) * (1.f / 2048.f) + EPS);
                if (lane == 0) ((float*)(ws + T_RSTD1))[t] = rstd1;
                float s2 = 0.f;
#pragma unroll
                for (int j = 0; j < 8; ++j) { const int c = 4 * (lane + 64 * j); const f32x4 x = *(const f32x4*)(xr + c), gp = *(const f32x4*)(gpost + c), gt = *(const f32x4*)(mr + 4096 + c);
                    const f32x4 x1 = x + gt * (y[j] * rstd1 * gp); y[j] = x1;
                    s2 += x1[0] * x1[0] + x1[1] * x1[1] + x1[2] * x1[2] + x1[3] * x1[3]; }
                const float rstd2 = rsqrtf(wave_sum(s2) * (1.f / 2048.f) + EPS);
#pragma unroll
                for (int j = 0; j < 8; ++j) { const int c = 4 * (lane + 64 * j); const f32x4 g2 = *(const f32x4*)(gpre2 + c), sh = *(const f32x4*)(mr + 6144 + c), sc = *(const f32x4*)(mr + 8192 + c);
                    const f32x4 hh = y[j] * rstd2 * g2 * (sc + 1.f) + sh;
                    unsigned hi[4], lo[4];
#pragma unroll
                    for (int q = 0; q < 4; ++q) { hi[q] = f2bf(hh[q]); lo[q] = f2bf(hh[q] - __builtin_bit_cast(float, hi[q] << 16)); }
                    v2u qh, ql; qh.x = hi[0] | (hi[1] << 16); qh.y = hi[2] | (hi[3] << 16); ql.x = lo[0] | (lo[1] << 16); ql.y = lo[2] | (lo[3] << 16);
                    *(LAS v2u*)(lds + RT_HI + lr * RT_ROWB + c * 2) = qh; *(LAS v2u*)(lds + RT_LO + lr * RT_ROWB + c * 2) = ql;
                    *(unsigned*)(H2 + (size_t)t * 2048 + c) = pk4_fp8(hh[0] * SC_H, hh[1] * SC_H, hh[2] * SC_H, hh[3] * SC_H); }
            }
            __syncthreads();
            { f32x4 acc[4];
#pragma unroll
              for (int et = 0; et < 4; ++et) acc[et] = (f32x4){0.f, 0.f, 0.f, 0.f};
#pragma unroll 1
              for (int ks = 0; ks < 8; ++ks) { const int k0 = 256 * wave + 32 * ks + 8 * l4;
                  const bf16x8 ah = *(const LAS bf16x8*)(lds + RT_HI + l15 * RT_ROWB + k0 * 2), al = *(const LAS bf16x8*)(lds + RT_LO + l15 * RT_ROWB + k0 * 2);
#pragma unroll
                  for (int et = 0; et < 4; ++et) { const bf16x8 bh = *(const bf16x8*)(whi + (size_t)(16 * et + l15) * 2048 + k0), bl = *(const bf16x8*)(wlo + (size_t)(16 * et + l15) * 2048 + k0);
                      acc[et] = __builtin_amdgcn_mfma_f32_16x16x32_bf16(ah, bh, acc[et], 0, 0, 0);
                      acc[et] = __builtin_amdgcn_mfma_f32_16x16x32_bf16(ah, bl, acc[et], 0, 0, 0);
                      acc[et] = __builtin_amdgcn_mfma_f32_16x16x32_bf16(al, bh, acc[et], 0, 0, 0); } }
              __syncthreads();
#pragma unroll
              for (int et = 0; et < 4; ++et)
#pragma unroll
                  for (int q = 0; q < 4; ++q) part[(wave * 16 + 4 * l4 + q) * 64 + 16 * et + l15] = acc[et][q]; }
            __syncthreads();
#pragma unroll
            for (int q = 0; q < 2; ++q) { const int idx = tid + 512 * q; float sacc = 0.f;
#pragma unroll
                for (int w = 0; w < 8; ++w) sacc += part[w * 1024 + idx];
                logit[idx] = sacc; }
            __syncthreads();
#pragma unroll 1
            for (int rr = 0; rr < 2; ++rr) {
                const int lr = wave * 2 + rr, t = blk * 64 + it * 16 + lr;
                const float lg = logit[lr * 64 + lane]; const float s = 1.f / (1.f + __expf(-lg)); const float sel = s + rbias[lane];
                float m1 = sel; m1 = fmaxf(m1, __shfl_xor(m1, 1)); m1 = fmaxf(m1, __shfl_xor(m1, 2)); m1 = fmaxf(m1, __shfl_xor(m1, 4));
                const u64 eq = __ballot(sel == m1); const unsigned gb = (unsigned)(eq >> (lane & ~7)) & 0xffu; const int first = __builtin_ctz(gb);
                float v2 = ((lane & 7) == first) ? -INFINITY : sel; v2 = fmaxf(v2, __shfl_xor(v2, 1)); v2 = fmaxf(v2, __shfl_xor(v2, 2)); v2 = fmaxf(v2, __shfl_xor(v2, 4));
                const float gs = m1 + v2; const int g = lane >> 3; int grank = 0;
#pragma unroll
                for (int g2 = 0; g2 < 8; ++g2) { const float o = __shfl(gs, g2 * 8); grank += (o > gs || (o == gs && g2 < g)) ? 1 : 0; }
                const bool gsel = grank < 4; const float mk = gsel ? sel : -INFINITY; int rank = 0;
                for (int e2 = 0; e2 < 64; ++e2) { const float o = __shfl(mk, e2); rank += (o > mk || (o == mk && e2 < lane)) ? 1 : 0; }
                const bool chosen = gsel && rank < 8;
                const u64 mask = __ballot(chosen); const float ssum = wave_sum(chosen ? s : 0.f);
                const int kidx = __popcll(mask & ((1ull << lane) - 1ull));
                if (chosen) tokw[(size_t)t * 8 + kidx] = s / ssum * 2.5f;
                if (lane == 0) { tmask[t] = mask; masks[it * 16 + lr] = mask; }
            }
            __syncthreads();
        }
        if (wave == 0) { const u64 m = masks[lane]; int mine = 0;
            for (int e = 0; e < 64; ++e) { const int c = __popcll(__ballot((m >> e) & 1ull)); mine = (lane == e) ? c : mine; }
            cnt[blk * 64 + lane] = mine; }
        __syncthreads();
    }
}

__device__ __forceinline__ void phase7(const Args& a, LAS unsigned char* lds, int tid, int lane, int wave, int vcu, int G) {
    unsigned char* ws = a.ws;
    const int* cnt = (const int*)(ws + T_CNT); const u64* tmask = (const u64*)(ws + T_MASK); const float* tokw = (const float*)(ws + T_TOKW);
    int* tokslot = (int*)(ws + T_TOKSLOT); int* slottok = (int*)(ws + T_SLOTTOK); float* slotw = (float*)(ws + T_SLOTW); int* tile = (int*)(ws + T_TILE);
    LAS int* part = (LAS int*)lds;
    LAS int* tot = (LAS int*)(lds + 4096);
    for (int blk = vcu; blk < NT / 64; blk += G) {
        int pre = 0, all = 0;
        for (int b2 = wave; b2 < 256; b2 += 8) { const int c = cnt[b2 * 64 + lane]; all += c; pre += (b2 < blk) ? c : 0; }
        part[(wave * 2) * 64 + lane] = pre; part[(wave * 2 + 1) * 64 + lane] = all;
        __syncthreads();
        if (wave == 0) {
            int p = 0, t = 0;
#pragma unroll
            for (int w = 0; w < 8; ++w) { p += part[(w * 2) * 64 + lane]; t += part[(w * 2 + 1) * 64 + lane]; }
            int incl = t;
#pragma unroll
            for (int o = 1; o < 64; o <<= 1) { const int v = __shfl_up(incl, o); if (lane >= o) incl += v; }
            const int start = incl - t; const int base = start + p;
            tot[lane] = t; tot[64 + lane] = start;
            const int tokn = blk * 64 + lane; const u64 m = tmask[tokn];
            for (int e = 0; e < 64; ++e) { const bool bit = (m >> e) & 1ull; const u64 bal = __ballot(bit); const int be = __shfl(base, e);
                if (bit) { const int rank = __popcll(bal & ((1ull << lane) - 1ull)); const int slot = be + rank; const int k = __popcll(m & ((1ull << e) - 1ull));
                    slottok[slot] = tokn; slotw[slot] = tokw[(size_t)tokn * 8 + k]; tokslot[(size_t)tokn * 8 + k] = slot; } }
            slottok[SH_ROW0 + tokn] = tokn; slotw[SH_ROW0 + tokn] = 1.f;
        }
        __syncthreads();
        if (blk == 0 && tid == 0) {
            int n = 0;
            for (int e = 0; e < 64; ++e) { const int te = tot[e], st = tot[64 + e];
                for (int j = 0; j * 256 < te; ++j) { tile[n] = e; tile[NTILE_MAX + n] = st + j * 256; tile[2 * NTILE_MAX + n] = (te - j * 256) < 256 ? (te - j * 256) : 256; ++n; } }
            for (int j = 0; j < 64; ++j) { tile[n] = 64; tile[NTILE_MAX + n] = SH_ROW0 + j * 256; tile[2 * NTILE_MAX + n] = 256; ++n; }
            tile[3 * NTILE_MAX] = n;
        }
        __syncthreads();
    }
}

__device__ __forceinline__ void phase10(const Args& a, LAS unsigned char* lds, int lane, int wave, int vcu, int G) {
    unsigned char* ws = a.ws;
    const float* mod = (const float*)(ws + WS_MOD); const unsigned char* SO = ws + WS_SLOTOUT; const int* tokslot = (const int*)(ws + T_TOKSLOT); const float* gp = a.in[9];
    LAS float* ysc = (LAS float*)(lds + wave * 8192);
    const unsigned lo16_ = 16u * (unsigned)lane;
#pragma unroll 1
    for (int t = vcu * 8 + wave; t < NT; t += G * 8) {
        const float* mr = mod + (size_t)(t >> 11) * 12288;
        const int myslot = lane < 8 ? tokslot[(size_t)t * 8 + lane] : SH_ROW0 + t;
        unsigned lo16 = lo16_; asm volatile("" : "+v"(lo16));
        v4u x[9][2]; f32x4 xo[8]; v2u yb[8];
        const unsigned char* x1r = (const unsigned char*)(a.in[0] + (size_t)t * 2048); const unsigned char* y1r = (const unsigned char*)((const bf16*)(ws + RA_Y1) + (size_t)t * 2048);
        const float rstd1 = ((const float*)(ws + T_RSTD1))[t];
#pragma unroll
        for (int k = 0; k < 9; ++k) { const int slot = __builtin_amdgcn_readfirstlane(__shfl(myslot, k)); const unsigned char* sr = SO + (size_t)slot * 2048;
#pragma unroll
            for (int j = 0; j < 2; ++j) x[k][j] = *(const v4u*)(sr + (lo16 + 1024u * j)); }
        float y[2][16];
#pragma unroll
        for (int j = 0; j < 2; ++j)
#pragma unroll
            for (int q = 0; q < 16; ++q) y[j][q] = 0.f;
#pragma unroll
        for (int k = 0; k < 9; ++k)
#pragma unroll
            for (int j = 0; j < 2; ++j) { v4u v = x[k][j]; asm volatile("" : "+v"(v) : "v"(y[j][0]), "v"(y[j][15]));
#pragma unroll
                for (int w = 0; w < 4; ++w) { const unsigned d = v[w]; const auto lo = __builtin_amdgcn_cvt_pk_f32_fp8(d, false), hi = __builtin_amdgcn_cvt_pk_f32_fp8(d, true);
                    y[j][4 * w] += lo[0]; y[j][4 * w + 1] += lo[1]; y[j][4 * w + 2] += hi[0]; y[j][4 * w + 3] += hi[1]; } }
        asm volatile("" ::: "memory");
#pragma unroll
        for (int j = 0; j < 8; ++j) { xo[j] = *(const f32x4*)(x1r + (lo16 + 1024u * j)); yb[j] = *(const v2u*)(y1r + (lo16 / 2u + 512u * j)); }
        float ss = 0.f;
#pragma unroll
        for (int j = 0; j < 2; ++j)
#pragma unroll
            for (int q = 0; q < 16; ++q) ss += y[j][q] * y[j][q];
        const float rstd = rsqrtf(wave_sum(ss) * (1.f / 2048.f) + EPS * SC_O * SC_O);
#pragma unroll
        for (int j = 0; j < 2; ++j)
#pragma unroll
            for (int q = 0; q < 4; ++q) *(LAS f32x4*)(ysc + 16 * (lane + 64 * j) + 4 * q) = (f32x4){y[j][4 * q], y[j][4 * q + 1], y[j][4 * q + 2], y[j][4 * q + 3]};
        LDS_WAIT(); asm volatile("" ::: "memory");
        unsigned char* outr = (unsigned char*)(a.out + (size_t)t * 2048); const unsigned char* gpb = (const unsigned char*)gp; const unsigned char* g1b = (const unsigned char*)a.in[7];
        const unsigned char* gt2b = (const unsigned char*)(mr + 10240); const unsigned char* gt1b = (const unsigned char*)(mr + 4096);
#pragma unroll
        for (int j = 0; j < 8; ++j) { const unsigned cb = lo16 + 1024u * j; const f32x4 yy = *(const LAS f32x4*)(ysc + 4 * (lane + 64 * j)), g = *(const f32x4*)(gpb + cb), gt = *(const f32x4*)(gt2b + cb);
            const f32x4 g1 = *(const f32x4*)(g1b + cb), gt1 = *(const f32x4*)(gt1b + cb); const f32x4 y1 = (f32x4){bflo(yb[j].x), bfhi(yb[j].x), bflo(yb[j].y), bfhi(yb[j].y)};
            const f32x4 x1 = xo[j] + gt1 * (y1 * rstd1 * g1);
            *(f32x4*)(outr + cb) = x1 + gt * (yy * rstd * g); }
        LDS_WAIT(); asm volatile("" ::: "memory");
    }
}

__global__ void __launch_bounds__(512, 2) fwd(Args args) {
    extern __shared__ __attribute__((aligned(16))) unsigned char lds_raw[];
    LAS unsigned char* lds = (LAS unsigned char*)lds_raw;
    const int tid = threadIdx.x, lane = tid & 63, wave = __builtin_amdgcn_readfirstlane(tid >> 6);
    const int G = gridDim.x, bx = blockIdx.x;
    const int vcu = (G % 8 == 0) ? (bx % 8) * (G / 8) + bx / 8 : bx;
    unsigned char* ws = args.ws;
    volatile LAS unsigned* MISC = (volatile LAS unsigned*)(lds + LDS_MISC);
    if (tid < 64) MISC[tid] = 0u;
    __syncthreads();
    const int lo = args.ph_lo, hi = args.ph_hi;
    XcdBarrier bar; bar.bar = (unsigned*)(ws + WS_CTL) + 4096; bar.x = 0; bar.st = nullptr;
    if (hi - lo > 1) bar = xcd_barrier_post((unsigned*)(ws + WS_CTL) + 4096, MISC + 8);
#ifndef PH_MASK
#define PH_MASK 0xfff
#endif
#define IN(k) (((PH_MASK >> (k)) & 1) && lo <= (k) && (k) < hi)
#define SEAM(k) do { if (IN(k) && IN((k) + 1)) xcd_barrier(bar); } while (0)

#ifndef REP_PHASE
#define REP_PHASE -1
#endif
#define PH_IDS int tz_ = threadIdx.x; asm volatile("" : "+v"(tz_)); const int tid = tz_, lane = tz_ & 63, wave = __builtin_amdgcn_readfirstlane(tz_ >> 6); (void)tid; (void)lane; (void)wave;
#define RUNPH(k, ...) do { if (IN(k)) { { PH_IDS __VA_ARGS__ } if (REP_PHASE == (k)) { xcd_barrier(bar); { PH_IDS __VA_ARGS__ } } SEAM(k); } } while (0)
#ifdef PROBE_P0
    if (IN(0)) { { PH_IDS phase0(args, lds, tid, lane, wave, vcu, G); } xcd_barrier(bar); { PH_IDS phase0(args, lds, tid, lane, wave, vcu, G, PROBE_P0 == 1, PROBE_P0 == 2); } SEAM(0); }
#else
    RUNPH(0, phase0(args, lds, tid, lane, wave, vcu, G););
#endif
    RUNPH(1, phase1(args, lane, wave, vcu, G););
    RUNPH(2, {
        DenseSched S; S.init(ws + RA_H, ws + WS_WIN, 2048, 2048, MROWS, DINP, G, bx);
        EpiIn E{ws};
        pg8::gemm_phase<EpiIn, DenseSched>(lds, 2048, S, E); });
    RUNPH(3, phase3_prep(args, lds, tid, vcu, G); phase3_pool(args, lds, tid, vcu, G););
    RUNPH(4, phase_chain(args, lds, tid, lane, wave, vcu, G););
    RUNPH(5, {
        phase4_post(args, lane, wave, vcu, G);
        PoolSched S{(const char*)(ws + RA_DPOOL), (const char*)(ws + WS_WPOOL), G, vcu};
        EpiPool E{(bf16*)(ws + RA_YMIX), args.in[17]};
        int kpool = 256; asm volatile("" : "+s"(kpool));
        pg8::gemm_phase<EpiPool, PoolSched>(lds, kpool, S, E); });
    RUNPH(6, {
        DenseSched S; S.init(ws + RA_YMIX, ws + WS_WOUT, 2048, 2048, NT, 2048, G, bx);
        EpiOut E{(bf16*)(ws + RA_Y1)};
        pg8::gemm_phase<EpiOut, DenseSched>(lds, 2048, S, E); });
    RUNPH(7, phase6(args, lds, tid, lane, wave, vcu, G););
    RUNPH(8, phase7(args, lds, tid, lane, wave, vcu, G););
    RUNPH(9, {
        MoeGUSched S{(const char*)(ws + RA_H2), (const char*)(ws + WS_WGU), (const int*)(ws + T_TILE), (const int*)(ws + T_SLOTTOK), G, vcu};
        EpiGU E{ws + WS_ACT, (const float*)(ws + T_SLOTW)};
        int kgu = 1024; asm volatile("" : "+s"(kgu));
        pg8::gemm_phase<EpiGU, MoeGUSched, true>(lds, kgu, S, E); });
    RUNPH(10, {
        MoeDownSched S{(const char*)(ws + WS_ACT), (const char*)(ws + WS_WD), (const int*)(ws + T_TILE), G, vcu};
        EpiDown E{ws + WS_SLOTOUT};
        int kdn = 256; asm volatile("" : "+s"(kdn));
        pg8::gemm_phase<EpiDown, MoeDownSched, true>(lds, kdn, S, E); });
    if (IN(11)) { { PH_IDS phase10(args, lds, lane, wave, vcu, G); } if (REP_PHASE == 11) { xcd_barrier(bar); { PH_IDS phase10(args, lds, lane, wave, vcu, G); } } }
#undef IN
#undef SEAM
}

extern "C" void kernel_launch(void* const* d_in, const int* in_sizes, int n_in, void* d_out, int out_size, void* d_ws, size_t ws_size, hipStream_t stream) {
    static int grid = 0;
    if (grid == 0) {
        if (n_in != 27 || out_size != NT * DM || ws_size < WS_NEED) { fprintf(stderr, "kernel_launch: unexpected problem: n_in %d out %d ws %zu (need %zu)\n", n_in, out_size, ws_size, (size_t)WS_NEED); grid = -1; return; }
        int dev = 0, cus = 0, per_cu = 0;
        if (hipGetDevice(&dev) != hipSuccess || hipDeviceGetAttribute(&cus, hipDeviceAttributeMultiprocessorCount, dev) != hipSuccess) { grid = -1; return; }
        if (hipFuncSetAttribute((const void*)fwd, hipFuncAttributeMaxDynamicSharedMemorySize, LDS_BYTES) != hipSuccess) { fprintf(stderr, "kernel_launch: hipFuncSetAttribute failed\n"); grid = -1; return; }
        if (hipOccupancyMaxActiveBlocksPerMultiprocessor(&per_cu, (const void*)fwd, 512, LDS_BYTES) != hipSuccess || per_cu < 1) { fprintf(stderr, "kernel_launch: occupancy query says %d\n", per_cu); }
        (void)hipGetLastError();
        grid = cus;
    }
    if (grid < 0) return;
    (void)hipMemsetAsync((char*)d_ws + WS_CTL, 0, CTL_ZERO_BYTES, stream);
    Args a{};
    for (int i = 0; i < 27; ++i) a.in[i] = (const float*)d_in[i];
    a.out = (float*)d_out; a.ws = (unsigned char*)d_ws;
    if (N_LAUNCHES == 1) {
        a.ph_lo = 0; a.ph_hi = NPH;
        hipLaunchKernelGGL(fwd, dim3(grid), dim3(512), LDS_BYTES, stream, a);
    } else {
        for (int p = 0; p < NPH; ++p) { a.ph_lo = p; a.ph_hi = p + 1; hipLaunchKernelGGL(fwd, dim3(grid), dim3(512), LDS_BYTES, stream, a); }
    }
}
```

```cpp
#include <hip/hip_runtime.h>
#include <cstdio>
#include <cstdint>

#ifndef P7_REP_ROWS
#define P7_REP_ROWS 1
#endif
#ifndef P7_REP_LOG
#define P7_REP_LOG 1
#endif
#ifndef P7_REP_RT
#define P7_REP_RT 1
#endif
#ifndef N_LAUNCHES
#define N_LAUNCHES 1
#endif

#define GAS __attribute__((address_space(1)))
#define LAS __attribute__((address_space(3)))
typedef unsigned short bf16;
typedef unsigned v4u __attribute__((ext_vector_type(4)));
typedef unsigned v2u __attribute__((ext_vector_type(2)));
typedef float f32x4 __attribute__((ext_vector_type(4)));
typedef short bf16x8 __attribute__((ext_vector_type(8)));
typedef unsigned long long u64;

constexpr int NB = 8, SEQ = 2048, DM = 2048, CTXL = 256;
constexpr int NT = NB * SEQ;
constexpr int NTC = NB * CTXL;
constexpr int MROWS = NT + NTC;
constexpr int DIN = 4128, DINP = 4352;
constexpr int NE = 64, TOPK = 8, DE = 512;
constexpr int NSLOT_E = NT * TOPK;
constexpr int SH_ROW0 = NSLOT_E + 256;
constexpr int NSLOT = SH_ROW0 + NT;
constexpr int NTILE_MAX = 704;
constexpr float EPS = 1e-6f;
constexpr int NPH = 12;

constexpr size_t MiB = 1u << 20;
constexpr size_t WS_CTL = 0, CTL_ZERO_BYTES = 64 * 1024;
constexpr size_t WS_MOD = 1 * MiB;
constexpr size_t WS_WRT = 1 * MiB + 512 * 1024;
constexpr size_t WS_WIN = 2 * MiB;
constexpr size_t WS_WOUT = WS_WIN + 17 * MiB;
constexpr size_t WS_WPOOL = WS_WOUT + 8 * MiB;
constexpr size_t WS_WD = WS_WPOOL + 1 * MiB;
constexpr size_t WS_WGU = WS_WD + 130 * MiB;
constexpr size_t WS_RA = WS_WGU + 260 * MiB;
constexpr size_t RA_H = WS_RA;
constexpr size_t RA_OF = WS_RA;
constexpr size_t RA_H2 = WS_RA;
constexpr size_t RA_Q = WS_RA + 128 * MiB;
constexpr size_t RA_K = RA_Q + 16 * MiB;
constexpr size_t RA_V = RA_K + 18 * MiB;
constexpr size_t RA_R = RA_V + 36 * MiB;
constexpr size_t RA_P = RA_R + 32 * MiB;
constexpr size_t RA_ALR = RA_P + 32 * MiB;
constexpr size_t RA_DPOOL = RA_ALR + 3 * MiB;
constexpr size_t RA_YMIX = RA_DPOOL + 32 * MiB;
constexpr size_t RA_Y1 = WS_RA + 128 * MiB;
constexpr size_t RA_END = RA_YMIX + 64 * MiB;
constexpr size_t WS_SLOTOUT = WS_WGU;
constexpr size_t WS_ACT = RA_END > WS_SLOTOUT + 578 * MiB ? RA_END : WS_SLOTOUT + 578 * MiB;
constexpr size_t WS_END = WS_ACT + 145 * MiB;
constexpr size_t PQG = WS_ACT;
constexpr size_t PAM = WS_ACT + 32 * MiB;
constexpr size_t PKD = WS_ACT + 96 * MiB;
constexpr size_t PDEC = WS_ACT + 132 * MiB;
constexpr size_t WS_T0 = WS_END;
constexpr size_t T_CNT = WS_T0;
constexpr size_t T_MASK = T_CNT + 65536;
constexpr size_t T_TOKW = T_MASK + 131072;
constexpr size_t T_TOKSLOT = T_TOKW + 524288;
constexpr size_t T_SLOTTOK = T_TOKSLOT + 524288;
constexpr size_t T_SLOTW = T_SLOTTOK + 655360;
constexpr size_t T_TILE = T_SLOTW + 655360;
constexpr size_t T_RSTD1 = (T_TILE + 16384 + 4095) / 4096 * 4096;
constexpr size_t WS_NEED = T_RSTD1 + (size_t)NT * 4;

constexpr int RING_BYTES = 131072;
constexpr int LDS_BYTES = 147456;
constexpr int LDS_MISC = LDS_BYTES - 256;
constexpr int RT_ROWB = 4112;
constexpr int RT_HI = 0;
constexpr int LDS_LOGIT = 32 * RT_ROWB;
constexpr int LDS_MASKS = LDS_LOGIT + 8192;
static_assert(LDS_MASKS + 512 <= LDS_MISC, "LDS map");

#define LDS_WAIT() asm volatile("s_waitcnt lgkmcnt(0)" ::: "memory")
#define LDS_BARRIER() do { asm volatile("s_waitcnt lgkmcnt(0)" ::: "memory"); __builtin_amdgcn_s_barrier(); asm volatile("" ::: "memory"); } while (0)
#define VM_WAIT() asm volatile("s_waitcnt vmcnt(0)" ::: "memory")

__device__ __forceinline__ unsigned f2bf(float f) { unsigned u = __builtin_bit_cast(unsigned, f); return (u + 0x7fffu + ((u >> 16) & 1u)) >> 16; }
__device__ __forceinline__ unsigned pk2(float lo, float hi) { return f2bf(lo) | (f2bf(hi) << 16); }
__device__ __forceinline__ float bflo(unsigned u) { return __builtin_bit_cast(float, u << 16); }
__device__ __forceinline__ float bfhi(unsigned u) { return __builtin_bit_cast(float, u & 0xffff0000u); }
__device__ __forceinline__ float bf1(bf16 b) { return __builtin_bit_cast(float, ((unsigned)b) << 16); }
__device__ __forceinline__ float wave_sum(float v) {
#pragma unroll
    for (int o = 1; o < 64; o <<= 1) v += __shfl_xor(v, o);
    return v;
}
__device__ __forceinline__ float silu_f(float x) { return x / (1.f + __expf(-x)); }

#define XB_TMO      128
#define XB_XCNT(j)  (256  + 64 * (j))
#define XB_XSUB(j)  (1280 + 64 * (j))
#define XB_XGEN(j)  (2304 + 64 * (j))
#define XB_TOP      3328
#define XB_TOPGEN   3392
#define XCD_BAR_WORDS 3456
#define XB_SPIN_CAP (1u << 18)

__device__ __forceinline__ unsigned xb_ld(unsigned* p)              { return __hip_atomic_load(p, __ATOMIC_RELAXED, __HIP_MEMORY_SCOPE_AGENT); }
__device__ __forceinline__ unsigned xb_add(unsigned* p, unsigned v) { return __hip_atomic_fetch_add(p, v, __ATOMIC_RELAXED, __HIP_MEMORY_SCOPE_AGENT); }
__device__ __forceinline__ unsigned xb_xcc_id() { return (unsigned)__builtin_amdgcn_s_getreg((3 << 11) | 20) & 0xFu; }
#define XB_SPIN(cond, bar) do { unsigned _sp = 0; while (cond) { __builtin_amdgcn_s_sleep(1); \
    if ((++_sp & 255u) == 0u) { if (xb_ld(&(bar)[XB_TMO])) break; if (_sp > XB_SPIN_CAP) { atomicAdd(&(bar)[XB_TMO], 1u); break; } } } } while (0)

struct XcdBarrier { unsigned* bar; unsigned x; volatile LAS unsigned* st; };

__device__ __forceinline__ XcdBarrier xcd_barrier_post(unsigned* bar, volatile LAS unsigned* st) {
    XcdBarrier b; b.bar = bar; b.x = xb_xcc_id(); b.st = st;
    if (threadIdx.x == 0) (void)xb_add(&bar[XB_XCNT(b.x)], 1u);
    return b;
}
__device__ __forceinline__ void xcd_barrier_complete(unsigned* bar, unsigned x, unsigned& nloc, unsigned& nx) {
    const unsigned G = gridDim.x * gridDim.y * gridDim.z;
    unsigned sum, cnt, mine, sp = 0u;
    for (;;) {
        sum = 0u; cnt = 0u; mine = 0u;
#pragma unroll
        for (unsigned j = 0; j < 16; ++j) { const unsigned c = xb_ld(&bar[XB_XCNT(j)]); sum += c; cnt += (c > 0u) ? 1u : 0u; mine = (j == x) ? c : mine; }
        if (sum == G) break;
        __builtin_amdgcn_s_sleep(1);
        if ((++sp & 255u) == 0u) { if (xb_ld(&bar[XB_TMO])) break; if (sp > XB_SPIN_CAP) { atomicAdd(&bar[XB_TMO], 1u); break; } }
    }
    nloc = mine > 0u ? mine : 1u; nx = cnt > 0u ? cnt : 1u;
}
__device__ __forceinline__ void xcd_barrier(const XcdBarrier& b) {
    asm volatile("s_waitcnt vmcnt(0)" ::: "memory");
    __syncthreads();
    if (threadIdx.x == 0) {
        unsigned* bar = b.bar;
        __builtin_amdgcn_s_waitcnt(0);
        unsigned nloc = b.st[0], nx = b.st[1];
        if (nloc == 0u) { xcd_barrier_complete(bar, b.x, nloc, nx); b.st[0] = nloc; b.st[1] = nx; }
        const unsigned old = xb_add(&bar[XB_XSUB(b.x)], 1u);
        const unsigned gen = old / nloc;
        if (old + 1u == (gen + 1u) * nloc) {
            __builtin_amdgcn_fence(__ATOMIC_RELEASE, "agent");
            asm volatile("s_waitcnt vmcnt(0)" ::: "memory");
            const unsigned og = xb_add(&bar[XB_TOP], 1u);
            const unsigned tg = og / nx;
            if (og + 1u == (tg + 1u) * nx) xb_add(&bar[XB_TOPGEN], 1u);
            else XB_SPIN(xb_ld(&bar[XB_TOPGEN]) == tg, bar);
            __builtin_amdgcn_fence(__ATOMIC_ACQUIRE, "agent");
            xb_add(&bar[XB_XGEN(b.x)], 1u);
            asm volatile("s_waitcnt vmcnt(0)" ::: "memory");
        } else {
            XB_SPIN(xb_ld(&bar[XB_XGEN(b.x)]) == gen, bar);
            __builtin_amdgcn_fence(__ATOMIC_ACQUIRE, "agent");
            asm volatile("s_waitcnt vmcnt(0)" ::: "memory");
        }
    }
    __syncthreads();
}

namespace pg8 {
constexpr int BM = 256, BK = 64, HALF = 128, HTB = HALF * BK * 2, STAGE_BYTES = 8 * HTB, NXCD = 8, WGM = 8;
__device__ __forceinline__ int lds_byte(int r, int c) { const int st = (r >> 4) * 2 + (c >> 5), rr = r & 15, cc = c & 31, ob = rr * 64 + cc * 2; return st * 1024 + (ob ^ (((ob >> 9) & 1) << 5)); }
__device__ __forceinline__ void stage_rc(int b, int& R, int& C) { const int st = b / 1024, sb = b % 1024, swz = sb ^ (((sb >> 9) & 1) << 5); R = (st >> 1) * 16 + swz / 64; C = (st & 1) * 32 + (swz % 64) / 2; }
__device__ __forceinline__ int perm32(int rho) { const int n = rho >> 4, i = rho & 15; return 8 * (i >> 2) + 4 * n + (i & 3); }
__device__ __forceinline__ unsigned cvt_pk_bf16(float lo, float hi) { unsigned r; asm volatile("v_cvt_pk_bf16_f32 %0, %1, %2" : "=v"(r) : "v"(lo), "v"(hi)); return r; }

typedef int v8i __attribute__((ext_vector_type(8)));
typedef int v4i __attribute__((ext_vector_type(4)));
template <class Epi, class Sched, bool FP8 = false>
__device__ __forceinline__ void gemm_phase(LAS unsigned char* lds, const int K, const Sched& S, const Epi& E) {
    typedef typename Sched::U Unit;
    const int tid = threadIdx.x, wid = __builtin_amdgcn_readfirstlane(tid >> 6), lane = tid & 63, wr = wid >> 2, wc = wid & 3, fr = lane & 15, fq = lane >> 4;
    const int nt = K / BK;
    int R[2], C[2]; unsigned voffB[2];
#pragma unroll
    for (int i = 0; i < 2; ++i) { stage_rc(tid * 16 + i * 8192, R[i], C[i]);
        const int Rb = Epi::PERMK == 2 ? (64 * (R[i] >> 5) + 16 * ((R[i] & 15) >> 2) + 4 * ((R[i] >> 4) & 1) + (R[i] & 3)) : (Epi::PERMK == 1 ? ((R[i] & ~31) + perm32(R[i] & 31)) : R[i]);
        voffB[i] = (unsigned)(Rb * K + C[i]) * 2u; }
    const size_t kstep = (size_t)(BK * 2);
    const size_t hstepB = (size_t)(Epi::PERMK == 2 ? 8 : HALF) * K * 2;
    const unsigned ldsw = (unsigned)wid * 1024u;
    const int aoff = lds_byte(wr * 64 + fr, fq * 8), boff = lds_byte(wc * 32 + fr, fq * 8);
#define PG8_SA(b, h) (((b) * 2 + (h)) * HTB)
#define PG8_SB(b, h) ((4 + (b) * 2 + (h)) * HTB)
#define PG8_STAGE(bufoff, gbase, v0, v1) do { \
        __builtin_amdgcn_global_load_lds((const unsigned*)((const char*)(gbase) + (v0)), (LAS unsigned*)(lds + (bufoff) + ldsw), 16, 0, 0); \
        __builtin_amdgcn_global_load_lds((const unsigned*)((const char*)(gbase) + (v1)), (LAS unsigned*)(lds + (bufoff) + ldsw + 8192), 16, 0, 0); } while (0)
#define PG8_LDA(dst, b, h) do { _Pragma("unroll") for (int m = 0; m < 4; ++m) { const v4i lo_ = *(const LAS v4i*)(lds + PG8_SA(b, h) + aoff + m * 2048), hi_ = *(const LAS v4i*)(lds + PG8_SA(b, h) + aoff + m * 2048 + 1024); \
        dst[m] = __builtin_shufflevector(lo_, hi_, 0, 1, 2, 3, 4, 5, 6, 7); } } while (0)
#define PG8_LDB(dst, b, h) do { _Pragma("unroll") for (int n = 0; n < 2; ++n) { const v4i lo_ = *(const LAS v4i*)(lds + PG8_SB(b, h) + boff + n * 2048), hi_ = *(const LAS v4i*)(lds + PG8_SB(b, h) + boff + n * 2048 + 1024); \
        dst[n] = __builtin_shufflevector(lo_, hi_, 0, 1, 2, 3, 4, 5, 6, 7); } } while (0)
#define PG8_H0(x) ((bf16x8)__builtin_shufflevector(x, x, 0, 1, 2, 3))
#define PG8_H1(x) ((bf16x8)__builtin_shufflevector(x, x, 4, 5, 6, 7))
#define PG8_MMA(ai, bj, At, Bt) do { __builtin_amdgcn_s_setprio(1); if constexpr (FP8) asm volatile("s_nop 4"); _Pragma("unroll") for (int m = 0; m < 4; ++m) _Pragma("unroll") for (int n = 0; n < 2; ++n) { \
        if constexpr (FP8) asm volatile("v_mfma_f32_16x16x128_f8f6f4 %0, %1, %2, %0" : "+v"(acc[ai][bj][m][n]) : "v"(Bt[n]), "v"(At[m])); \
        else { acc[ai][bj][m][n] = __builtin_amdgcn_mfma_f32_16x16x32_bf16(PG8_H0(Bt[n]), PG8_H0(At[m]), acc[ai][bj][m][n], 0, 0, 0); \
               acc[ai][bj][m][n] = __builtin_amdgcn_mfma_f32_16x16x32_bf16(PG8_H1(Bt[n]), PG8_H1(At[m]), acc[ai][bj][m][n], 0, 0, 0); } } \
        __builtin_amdgcn_s_setprio(0); } while (0)
#define PG8_WAIT_V(n) asm volatile("s_waitcnt vmcnt(" #n ")" ::: "memory")
#define PG8_WAIT_L(n) asm volatile("s_waitcnt lgkmcnt(" #n ")" ::: "memory")
#define PG8_BAR __builtin_amdgcn_s_barrier()
#define PG8_SCHED __builtin_amdgcn_sched_barrier(0)
    Unit cur, nxt; int ui = 0;
    if (!S.next(0, cur)) return;
    f32x4 acc[2][2][4][2];
#pragma unroll
    for (int a = 0; a < 2; ++a)
#pragma unroll
        for (int b = 0; b < 2; ++b)
#pragma unroll
            for (int m = 0; m < 4; ++m)
#pragma unroll
                for (int n = 0; n < 2; ++n) acc[a][b][m][n] = (f32x4){0.f, 0.f, 0.f, 0.f};
    v8i At[4], B0[2], B1[2];
    unsigned vA[4], vN[4];
    S.aoffs(cur, R, C, vA);
    const char* cA = cur.A; const char* cB = cur.B;
    PG8_STAGE(PG8_SB(0, 0), cB, voffB[0], voffB[1]); PG8_STAGE(PG8_SB(0, 1), cB + hstepB, voffB[0], voffB[1]); PG8_STAGE(PG8_SA(0, 0), cA, vA[0], vA[1]); PG8_STAGE(PG8_SA(0, 1), cA, vA[2], vA[3]);
    if (wr == 1) PG8_BAR;
    PG8_WAIT_V(2); PG8_BAR;
    PG8_STAGE(PG8_SB(1, 0), cB + kstep, voffB[0], voffB[1]); PG8_STAGE(PG8_SA(1, 0), cA + kstep, vA[0], vA[1]); PG8_STAGE(PG8_SB(1, 1), cB + hstepB + kstep, voffB[0], voffB[1]);
    PG8_WAIT_V(6); PG8_BAR;
    for (;;) {
        const bool has_next = S.next(ui + 1, nxt);
        const char* nA = has_next ? nxt.A : cA; const char* nB = has_next ? nxt.B : cB;
        if (has_next) S.aoffs(nxt, R, C, vN); else { vN[0] = vA[0]; vN[1] = vA[1]; vN[2] = vA[2]; vN[3] = vA[3]; }
        for (int t = 0; t < nt; t += 2) {
            const bool last = (t == nt - 2);
            const char* a1 = cA + (size_t)(t + 1) * kstep;
            const char* a2 = last ? nA : cA + (size_t)(t + 2) * kstep; const char* b2 = last ? nB : cB + (size_t)(t + 2) * kstep;
            const char* a3 = a2 + kstep; const char* b3 = b2 + kstep;
            const unsigned x0 = last ? vN[0] : vA[0], x1 = last ? vN[1] : vA[1], x2 = last ? vN[2] : vA[2], x3 = last ? vN[3] : vA[3];
            PG8_LDB(B0, 0, 0); PG8_LDB(B1, 0, 1); PG8_SCHED; PG8_LDA(At, 0, 0); PG8_STAGE(PG8_SA(1, 1), a1, vA[2], vA[3]);
            PG8_WAIT_V(8); PG8_WAIT_L(0); PG8_BAR; PG8_MMA(0, 0, At, B0); PG8_MMA(0, 1, At, B1); PG8_BAR; PG8_SCHED;
            PG8_LDA(At, 0, 1); PG8_STAGE(PG8_SB(0, 0), b2, voffB[0], voffB[1]); PG8_STAGE(PG8_SB(0, 1), b2 + hstepB, voffB[0], voffB[1]); PG8_STAGE(PG8_SA(0, 0), a2, x0, x1);
            PG8_WAIT_V(8); PG8_WAIT_L(0); PG8_BAR; PG8_MMA(1, 0, At, B0); PG8_MMA(1, 1, At, B1); PG8_BAR; PG8_SCHED;
            PG8_LDB(B0, 1, 0); PG8_LDB(B1, 1, 1); PG8_SCHED; PG8_LDA(At, 1, 0); PG8_STAGE(PG8_SA(0, 1), a2, x2, x3);
            PG8_WAIT_V(8); PG8_WAIT_L(0); PG8_BAR; PG8_MMA(0, 0, At, B0); PG8_MMA(0, 1, At, B1); PG8_BAR; PG8_SCHED;
            PG8_LDA(At, 1, 1); PG8_STAGE(PG8_SB(1, 0), b3, voffB[0], voffB[1]); PG8_STAGE(PG8_SB(1, 1), b3 + hstepB, voffB[0], voffB[1]); PG8_STAGE(PG8_SA(1, 0), a3, x0, x1);
            PG8_WAIT_V(8); PG8_WAIT_L(0); PG8_BAR; PG8_MMA(1, 0, At, B0); PG8_MMA(1, 1, At, B1); PG8_BAR; PG8_SCHED;
        }
        if (wr == 0) PG8_BAR;
        if constexpr (FP8) asm volatile("s_nop 15\n\ts_nop 15");
        { int tz = threadIdx.x; asm volatile("" : "+v"(tz));
          const int wid_ = tz >> 6, lane_ = tz & 63; E(acc, cur, wid_ >> 2, wid_ & 3, lane_ & 15, lane_ >> 4);
#ifdef PROBE_EPI2
          if constexpr (Epi::PROBE2) { asm volatile("" : "+v"(tz)); const int w2 = tz >> 6, l2 = tz & 63; E(acc, cur, w2 >> 2, w2 & 3, l2 & 15, l2 >> 4); }
#endif
#ifdef PROBE_DRAIN
          if constexpr (Epi::PROBE2) { asm volatile("s_waitcnt vmcnt(0)" ::: "memory"); }
#endif
        }
        if (!has_next) break;
#pragma unroll
        for (int a = 0; a < 2; ++a)
#pragma unroll
            for (int b = 0; b < 2; ++b)
#pragma unroll
                for (int m = 0; m < 4; ++m)
#pragma unroll
                    for (int n = 0; n < 2; ++n) acc[a][b][m][n] = (f32x4){0.f, 0.f, 0.f, 0.f};
        cur = nxt; cA = nA; cB = nB; ++ui;
        vA[0] = vN[0]; vA[1] = vN[1]; vA[2] = vN[2]; vA[3] = vN[3];
        if (wr == 1) PG8_BAR;
    }
    PG8_WAIT_V(0);
    PG8_BAR;
#undef PG8_SA
#undef PG8_SB
#undef PG8_STAGE
#undef PG8_LDA
#undef PG8_LDB
#undef PG8_H0
#undef PG8_H1
#undef PG8_MMA
#undef PG8_WAIT_V
#undef PG8_WAIT_L
#undef PG8_BAR
#undef PG8_SCHED
}
}

struct Args { const float* in[27]; float* out; unsigned char* ws; int ph_lo, ph_hi; };
static_assert(sizeof(Args) == 27 * 8 + 8 + 8 + 8, "Args has no padding");

struct DenseU { const char* A; const char* B; int pm, pn; };
struct DenseSched {
    typedef DenseU U;
    const char* A; const char* B; int lda, K, nM, nN, nwg, G, c;
    __device__ __forceinline__ void init(const void* A_, const void* B_, int lda_, int K_, int M, int N, int G_, int c_) { A = (const char*)A_; B = (const char*)B_; lda = lda_; K = K_; nM = M / 256; nN = N / 256; nwg = nM * nN; G = G_; c = c_; }
    __device__ __forceinline__ bool next(int i, U& u) const {
        const long L = (long)i * G + c; if (L >= nwg) return false;
        int wgid = (int)L; { const int q = nwg / 8, r = nwg % 8, xcd = wgid % 8, off = wgid / 8; wgid = (xcd < r ? xcd * (q + 1) : r * (q + 1) + (xcd - r) * q) + off; }
        const int nig = 8 * nN, gid = wgid / nig, fm = gid * 8, gsz = (nM - fm) < 8 ? (nM - fm) : 8;
        u.pm = fm + ((wgid % nig) % gsz); u.pn = (wgid % nig) / gsz;
        u.A = A + (size_t)u.pm * 256 * lda * 2; u.B = B + (size_t)u.pn * 256 * K * 2; return true;
    }
    __device__ __forceinline__ void aoffs(const U&, const int (&R)[2], const int (&C)[2], unsigned (&v)[4]) const {
#pragma unroll
        for (int h = 0; h < 2; ++h)
#pragma unroll
            for (int i = 0; i < 2; ++i) v[h * 2 + i] = (unsigned)((h * 128 + R[i]) * lda + C[i]) * 2u;
    }
};
struct PoolU { const char* A; const char* B; int pm, g; };
struct PoolSched {
    typedef PoolU U;
    const char* A; const char* B; int G, c;
    __device__ __forceinline__ bool next(int i, U& u) const {
        const int L = i * G + c; if (L >= 256) return false;
        u.g = L & 3; u.pm = L >> 2;
        u.A = A + ((size_t)u.pm * 256 * 1024 + u.g * 256) * 2; u.B = B + (size_t)u.g * 256 * 256 * 2; return true;
    }
    __device__ __forceinline__ void aoffs(const U&, const int (&R)[2], const int (&C)[2], unsigned (&v)[4]) const {
#pragma unroll
        for (int h = 0; h < 2; ++h)
#pragma unroll
            for (int i = 0; i < 2; ++i) v[h * 2 + i] = (unsigned)((h * 128 + R[i]) * 1024 + C[i]) * 2u;
    }
};
struct MoeU { const char* A; const char* B; int row0, nrows, pn; };
struct MoeGUSched {
    typedef MoeU U;
    const char* H2; const char* W; const int* tile; const int* slot_tok; int G, c;
    __device__ __forceinline__ bool next(int i, U& u) const {
        const int nt = tile[3 * NTILE_MAX]; const int L = i * G + c; if (L >= nt * 4) return false;
        const int t = L >> 2; u.pn = L & 3; const int e = tile[t]; u.row0 = tile[NTILE_MAX + t]; u.nrows = tile[2 * NTILE_MAX + t];
        u.A = H2; u.B = W + ((size_t)e * 1024 + u.pn * 256) * 2048; return true;
    }
    __device__ __forceinline__ void aoffs(const U& u, const int (&R)[2], const int (&C)[2], unsigned (&v)[4]) const {
#pragma unroll
        for (int h = 0; h < 2; ++h)
#pragma unroll
            for (int i = 0; i < 2; ++i) { int r = h * 128 + R[i]; r = r < u.nrows ? r : u.nrows - 1; const int tok = slot_tok[u.row0 + r]; v[h * 2 + i] = (unsigned)(tok * 1024 + C[i]) * 2u; }
    }
};
struct MoeDownSched {
    typedef MoeU U;
    const char* ACT; const char* W; const int* tile; int G, c;
    __device__ __forceinline__ bool next(int i, U& u) const {
        const int nt = tile[3 * NTILE_MAX]; const int L = i * G + c; if (L >= nt * 8) return false;
        const int t = L >> 3; u.pn = L & 7; const int e = tile[t]; u.row0 = tile[NTILE_MAX + t]; u.nrows = tile[2 * NTILE_MAX + t];
        u.A = ACT + (size_t)u.row0 * 512; u.B = W + ((size_t)e * 2048 + u.pn * 256) * 512; return true;
    }
    __device__ __forceinline__ void aoffs(const U&, const int (&R)[2], const int (&C)[2], unsigned (&v)[4]) const {
#pragma unroll
        for (int h = 0; h < 2; ++h)
#pragma unroll
            for (int i = 0; i < 2; ++i) v[h * 2 + i] = (unsigned)((h * 128 + R[i]) * 256 + C[i]) * 2u;
    }
};

struct EpiIn {
    static constexpr int PERMK = 1; static constexpr bool PROBE2 = false;
    unsigned char* ws;
    __device__ __forceinline__ void operator()(const f32x4 (&acc)[2][2][4][2], const DenseU& u, int wr, int wc, int fr, int fq) const {
        const int pn = u.pn; const int row0 = u.pm * 256 + wr * 64 + fr;
        if (pn == 16) {
            if (wc != 0) return;
            float* alr = (float*)(ws + RA_ALR);
#pragma unroll
            for (int ai = 0; ai < 2; ++ai)
#pragma unroll
                for (int m = 0; m < 4; ++m) { float* rp = alr + (size_t)(row0 + ai * 128 + m * 16) * 32 + 8 * fq;
                    *(f32x4*)(rp) = acc[ai][0][m][0]; *(f32x4*)(rp + 4) = acc[ai][0][m][1]; }
            return;
        }
        bf16* base; int ld, colt; bool lat_only;
        if (pn < 2) { base = (bf16*)(ws + RA_Q); ld = 512; colt = pn * 256; lat_only = true; }
        else if (pn < 4) { base = (bf16*)(ws + RA_K); ld = 512; colt = (pn - 2) * 256; lat_only = false; }
        else if (pn < 8) { base = (bf16*)(ws + RA_V); ld = 1024; colt = (pn - 4) * 256; lat_only = false; }
        else if (pn < 12) { base = (bf16*)(ws + RA_R); ld = 1024; colt = (pn - 8) * 256; lat_only = true; }
        else { base = (bf16*)(ws + RA_P); ld = 1024; colt = (pn - 12) * 256; lat_only = true; }
        if (lat_only && u.pm >= 64) return;
        const int col0 = colt + wc * 32 + 8 * fq;
#pragma unroll
        for (int ai = 0; ai < 2; ++ai)
#pragma unroll
            for (int m = 0; m < 4; ++m) { bf16* rp = base + (size_t)(row0 + ai * 128 + m * 16) * ld + col0;
#pragma unroll
                for (int bj = 0; bj < 2; ++bj) { const f32x4 v0 = acc[ai][bj][m][0], v1 = acc[ai][bj][m][1];
                    v4u o; o.x = pg8::cvt_pk_bf16(v0[0], v0[1]); o.y = pg8::cvt_pk_bf16(v0[2], v0[3]); o.z = pg8::cvt_pk_bf16(v1[0], v1[1]); o.w = pg8::cvt_pk_bf16(v1[2], v1[3]);
                    *(v4u*)(rp + bj * 128) = o; } }
    }
};
struct EpiPool {
    static constexpr int PERMK = 1; static constexpr bool PROBE2 = false;
    bf16* ymix; const float* scale;
    __device__ __forceinline__ void operator()(const f32x4 (&acc)[2][2][4][2], const PoolU& u, int wr, int wc, int fr, int fq) const {
        const int row0 = u.pm * 256 + wr * 64 + fr; const int c0 = u.g * 256 + wc * 32 + 8 * fq;
#pragma unroll
        for (int ai = 0; ai < 2; ++ai)
#pragma unroll
            for (int m = 0; m < 4; ++m) { bf16* rp = ymix + (size_t)(row0 + ai * 128 + m * 16) * 2048 + 1024 + c0;
#pragma unroll
                for (int bj = 0; bj < 2; ++bj) { const f32x4 s0 = *(const f32x4*)(scale + c0 + bj * 128), s1 = *(const f32x4*)(scale + c0 + bj * 128 + 4);
                    const f32x4 v0 = acc[ai][bj][m][0] * s0, v1 = acc[ai][bj][m][1] * s1;
                    v4u o; o.x = pg8::cvt_pk_bf16(v0[0], v0[1]); o.y = pg8::cvt_pk_bf16(v0[2], v0[3]); o.z = pg8::cvt_pk_bf16(v1[0], v1[1]); o.w = pg8::cvt_pk_bf16(v1[2], v1[3]);
                    *(v4u*)(rp + bj * 128) = o; } }
    }
};
struct EpiOut {
    static constexpr int PERMK = 1; static constexpr bool PROBE2 = false;
    bf16* y;
    __device__ __forceinline__ void operator()(const f32x4 (&acc)[2][2][4][2], const DenseU& u, int wr, int wc, int fr, int fq) const {
        const int row0 = u.pm * 256 + wr * 64 + fr, col0 = u.pn * 256 + wc * 32 + 8 * fq;
#pragma unroll
        for (int ai = 0; ai < 2; ++ai)
#pragma unroll
            for (int m = 0; m < 4; ++m) { bf16* rp = y + (size_t)(row0 + ai * 128 + m * 16) * 2048 + col0;
#pragma unroll
                for (int bj = 0; bj < 2; ++bj) { const f32x4 v0 = acc[ai][bj][m][0], v1 = acc[ai][bj][m][1];
                    v4u o; o.x = pg8::cvt_pk_bf16(v0[0], v0[1]); o.y = pg8::cvt_pk_bf16(v0[2], v0[3]); o.z = pg8::cvt_pk_bf16(v1[0], v1[1]); o.w = pg8::cvt_pk_bf16(v1[2], v1[3]);
                    *(v4u*)(rp + bj * 128) = o; } }
    }
};
constexpr float SC_W = 256.f, SC_H = 16.f, SC_A = 16.f;
__device__ __forceinline__ unsigned pk4_fp8(float a, float b, float c, float d) {
    a = fminf(fmaxf(a, -448.f), 448.f); b = fminf(fmaxf(b, -448.f), 448.f); c = fminf(fmaxf(c, -448.f), 448.f); d = fminf(fmaxf(d, -448.f), 448.f);
    unsigned w = 0; w = __builtin_amdgcn_cvt_pk_fp8_f32(a, b, w, false); w = __builtin_amdgcn_cvt_pk_fp8_f32(c, d, w, true); return w;
}
struct EpiGU {
    static constexpr int PERMK = 1; static constexpr bool PROBE2 = false;
    unsigned char* act; const float* slot_w;
    __device__ __forceinline__ void operator()(const f32x4 (&acc)[2][2][4][2], const MoeU& u, int wr, int wc, int fr, int fq) const {
        const int c0 = u.pn * 128 + wc * 32 + 8 * fq; constexpr float inv = 1.f / (SC_W * SC_H);
#pragma unroll
        for (int ai = 0; ai < 2; ++ai)
#pragma unroll
            for (int m = 0; m < 4; ++m) { const int r = ai * 128 + wr * 64 + m * 16 + fr;
                if (r < u.nrows) { const float w = slot_w[u.row0 + r] * SC_A; float o[8];
#pragma unroll
                    for (int n = 0; n < 2; ++n)
#pragma unroll
                        for (int j = 0; j < 4; ++j) { const float g = acc[ai][0][m][n][j] * inv, up = acc[ai][1][m][n][j] * inv; o[n * 4 + j] = silu_f(g) * up * w; }
                    v2u q; q.x = pk4_fp8(o[0], o[1], o[2], o[3]); q.y = pk4_fp8(o[4], o[5], o[6], o[7]);
                    *(v2u*)(act + (size_t)(u.row0 + r) * 512 + c0) = q; } }
    }
};
constexpr float SC_O = 32.f;
struct EpiDown {
    static constexpr int PERMK = 2; static constexpr bool PROBE2 = true;
    unsigned char* so;
    __device__ __forceinline__ void operator()(const f32x4 (&acc)[2][2][4][2], const MoeU& u, int wr, int wc, int fr, int fq) const {
        const int c0 = u.pn * 256 + wc * 64 + 16 * fq; constexpr float sc = SC_O / (SC_W * SC_A);
#pragma unroll
        for (int ai = 0; ai < 2; ++ai)
#pragma unroll
            for (int m = 0; m < 4; ++m) { const int r = ai * 128 + wr * 64 + m * 16 + fr;
                if (r < u.nrows) { const f32x4 a0 = acc[ai][0][m][0] * sc, a1 = acc[ai][0][m][1] * sc, b0 = acc[ai][1][m][0] * sc, b1 = acc[ai][1][m][1] * sc;
                    v4u o; o.x = pk4_fp8(a0[0], a0[1], a0[2], a0[3]); o.y = pk4_fp8(a1[0], a1[1], a1[2], a1[3]); o.z = pk4_fp8(b0[0], b0[1], b0[2], b0[3]); o.w = pk4_fp8(b1[0], b1[1], b1[2], b1[3]);
                    __builtin_nontemporal_store(o, (v4u*)(so + (size_t)(u.row0 + r) * 2048 + c0)); } }
    }
};

__device__ __forceinline__ void tr_item(const float* W, int ldn, bf16* WT, int Kd, int drow0, int k0, int n0, LAS float* scr, int lane) {
    f32x4 t[8];
#pragma unroll
    for (int i = 0; i < 8; ++i) t[i] = *(const f32x4*)(W + (size_t)(k0 + 8 * i + (lane >> 3)) * ldn + n0 + 4 * (lane & 7));
#pragma unroll
    for (int i = 0; i < 8; ++i) { LAS float* d = scr + (8 * i + (lane >> 3)) * 33 + 4 * (lane & 7); d[0] = t[i][0]; d[1] = t[i][1]; d[2] = t[i][2]; d[3] = t[i][3]; }
    LDS_WAIT(); asm volatile("" ::: "memory");
    const int c = lane & 7;
#pragma unroll
    for (int j = 0; j < 4; ++j) { const int n = (lane >> 3) + 8 * j; const LAS float* s = scr + (8 * c) * 33 + n;
        v4u o; o.x = pk2(s[0 * 33], s[1 * 33]); o.y = pk2(s[2 * 33], s[3 * 33]); o.z = pk2(s[4 * 33], s[5 * 33]); o.w = pk2(s[6 * 33], s[7 * 33]);
        *(v4u*)(WT + (size_t)(drow0 + n) * Kd + k0 + 8 * c) = o; }
    LDS_WAIT(); asm volatile("" ::: "memory");
}

__device__ __forceinline__ void tr_item8(const float* W, int ldn, unsigned char* WT, int Kd, int drow0, int k0, int n0, LAS float* scr, int lane) {
    f32x4 t[8];
#pragma unroll
    for (int i = 0; i < 8; ++i) t[i] = *(const f32x4*)(W + (size_t)(k0 + 8 * i + (lane >> 3)) * ldn + n0 + 4 * (lane & 7));
#pragma unroll
    for (int i = 0; i < 8; ++i) { LAS float* d = scr + (8 * i + (lane >> 3)) * 33 + 4 * (lane & 7); d[0] = t[i][0]; d[1] = t[i][1]; d[2] = t[i][2]; d[3] = t[i][3]; }
    LDS_WAIT(); asm volatile("" ::: "memory");
    const int c = lane & 7;
#pragma unroll
    for (int j = 0; j < 4; ++j) { const int n = (lane >> 3) + 8 * j; const LAS float* s = scr + (8 * c) * 33 + n;
        v2u o; o.x = pk4_fp8(s[0 * 33] * SC_W, s[1 * 33] * SC_W, s[2 * 33] * SC_W, s[3 * 33] * SC_W); o.y = pk4_fp8(s[4 * 33] * SC_W, s[5 * 33] * SC_W, s[6 * 33] * SC_W, s[7 * 33] * SC_W);
        *(v2u*)(WT + (size_t)(drow0 + n) * Kd + k0 + 8 * c) = o; }
    LDS_WAIT(); asm volatile("" ::: "memory");
}

__device__ __forceinline__ void phase0(const Args& a, LAS unsigned char* lds, int tid, int lane, int wave, int vcu, int G, bool do_mod = true, bool do_tr = true) {
    unsigned char* ws = a.ws;
    if (vcu < 192 && do_mod) {
        LAS float* sc = (LAS float*)lds;
        LAS float* red = (LAS float*)(lds + 73728);
        for (int i = tid; i < 9 * 2048; i += 512) { const int r = i >> 11, k = i & 2047; const float v = r < 8 ? a.in[1][r * 2048 + k] : a.in[3][k]; sc[i] = silu_f(v); }
        __syncthreads();
        const float* wm = a.in[4]; const float* bm = a.in[5]; float* mod = (float*)(ws + WS_MOD);
        for (int chunk = vcu; chunk < 192; chunk += G) {
            const int n0 = chunk * 64, ks = lane >> 4, n4 = (lane & 15) * 4;
            f32x4 acc[9];
#pragma unroll
            for (int r = 0; r < 9; ++r) acc[r] = (f32x4){0.f, 0.f, 0.f, 0.f};
#pragma unroll 4
            for (int kk = 0; kk < 256; kk += 4) { const int k = wave * 256 + kk + ks; const f32x4 wv = *(const f32x4*)(wm + (size_t)k * 12288 + n0 + n4);
#pragma unroll
                for (int r = 0; r < 9; ++r) { const float s = sc[r * 2048 + k]; acc[r] += wv * s; } }
#pragma unroll
            for (int r = 0; r < 9; ++r)
#pragma unroll
                for (int j = 0; j < 4; ++j) { float v = acc[r][j]; v += __shfl_xor(v, 16); v += __shfl_xor(v, 32); acc[r][j] = v; }
            if (lane < 16) {
#pragma unroll
                for (int r = 0; r < 9; ++r) *(LAS f32x4*)(red + (wave * 9 + r) * 64 + n4) = acc[r]; }
            __syncthreads();
            for (int i = tid; i < 9 * 64; i += 512) { const int r = i >> 6, n = i & 63; float s = 0.f;
#pragma unroll
                for (int w = 0; w < 8; ++w) s += red[(w * 9 + r) * 64 + n];
                mod[r * 12288 + n0 + n] = s + bm[n0 + n]; }
            __syncthreads();
        }
    }
    __syncthreads();
    LAS float* scr = (LAS float*)(lds + wave * 16384);
    const int gw = vcu * 8 + wave, NGW = G * 8;
    bf16* Win_t = (bf16*)(ws + WS_WIN); bf16* Wout_t = (bf16*)(ws + WS_WOUT); bf16* Wpool_t = (bf16*)(ws + WS_WPOOL); unsigned char* Wd_t = ws + WS_WD; unsigned char* Wgu_t = ws + WS_WGU;
    constexpr int I_IN = 32 * 129, I_OUT = 32 * 64, I_POOL = 4 * 4 * 8, I_E = 65 * 512;
    constexpr int NITEMS = I_IN + I_OUT + I_POOL + 3 * I_E;
    for (int it = gw; it < (do_tr ? NITEMS : 0); it += NGW) {
        int r = it;
        if (r < I_IN) { const int kb = r / 129, nb = r % 129, n0 = 32 * nb; const int drow = n0 < 3072 ? n0 : (n0 == 3072 ? 4096 : n0 - 32);
            tr_item(a.in[10], DIN, Win_t, 2048, drow, 64 * kb, n0, scr, lane); continue; } r -= I_IN;
        if (r < I_OUT) { const int kb = r / 64, nb = r % 64; tr_item(a.in[18], 2048, Wout_t, 2048, 32 * nb, 64 * kb, 32 * nb, scr, lane); continue; } r -= I_OUT;
        if (r < I_POOL) { const int g = r / 32, rr = r % 32, kb = rr / 8, nb = rr % 8; tr_item(a.in[16] + g * 65536, 256, Wpool_t + g * 65536, 256, 32 * nb, 64 * kb, 32 * nb, scr, lane); continue; } r -= I_POOL;
        if (r < I_E) { const int e = r / 512, rr = r % 512, kb = rr / 16, nb = rr % 16, n0 = 32 * nb; const float* src = e < 64 ? a.in[21] + (size_t)e * 2048 * 512 : a.in[24];
            tr_item8(src, 512, Wgu_t + (size_t)e * 1024 * 2048, 2048, (n0 / 128) * 256 + (n0 % 128), 64 * kb, n0, scr, lane); continue; } r -= I_E;
        if (r < I_E) { const int e = r / 512, rr = r % 512, kb = rr / 16, nb = rr % 16, n0 = 32 * nb; const float* src = e < 64 ? a.in[22] + (size_t)e * 2048 * 512 : a.in[25];
            tr_item8(src, 512, Wgu_t + (size_t)e * 1024 * 2048, 2048, (n0 / 128) * 256 + 128 + (n0 % 128), 64 * kb, n0, scr, lane); continue; } r -= I_E;
        { const int e = r / 512, rr = r % 512, kb = rr / 64, nb = rr % 64; const float* src = e < 64 ? a.in[23] + (size_t)e * 512 * 2048 : a.in[26];
            tr_item8(src, 2048, Wd_t + (size_t)e * 2048 * 512, 512, 32 * nb, 64 * kb, 32 * nb, scr, lane); }
    }
    { const float* wr = a.in[19]; bf16* whi = (bf16*)(ws + WS_WRT); bf16* wlo = whi + 64 * 2048;
      for (int idx = vcu * 512 + tid; idx < 64 * 256; idx += G * 512) { const int e = idx >> 8, k8 = idx & 255; unsigned hi[8], lo[8];
#pragma unroll
          for (int j = 0; j < 8; ++j) { const float v = wr[(size_t)(8 * k8 + j) * 64 + e]; hi[j] = f2bf(v); lo[j] = f2bf(v - __builtin_bit_cast(float, hi[j] << 16)); }
          v4u oh, ol; oh.x = hi[0] | (hi[1] << 16); oh.y = hi[2] | (hi[3] << 16); oh.z = hi[4] | (hi[5] << 16); oh.w = hi[6] | (hi[7] << 16);
          ol.x = lo[0] | (lo[1] << 16); ol.y = lo[2] | (lo[3] << 16); ol.z = lo[4] | (lo[5] << 16); ol.w = lo[6] | (lo[7] << 16);
          *(v4u*)(whi + (size_t)e * 2048 + 8 * k8) = oh; (void)ol; (void)wlo; } }
    { v4u* z = (v4u*)(Win_t + (size_t)DIN * 2048); const int nz = (DINP - DIN) * 2048 / 8;
      for (int i = vcu * 512 + tid; i < nz; i += G * 512) z[i] = (v4u){0u, 0u, 0u, 0u}; }
}

__device__ __forceinline__ void phase1(const Args& a, int lane, int wave, int vcu, int G) {
    const float* mod = (const float*)(a.ws + WS_MOD); bf16* H = (bf16*)(a.ws + RA_H); const float* g = a.in[6];
    for (int m = vcu * 8 + wave; m < MROWS; m += G * 8) {
        const float* xr = m < NT ? a.in[0] + (size_t)m * 2048 : a.in[2] + (size_t)(m - NT) * 2048;
        const float* mr = mod + (size_t)(m < NT ? (m >> 11) : 8) * 12288;
        f32x4 v[8]; float ss = 0.f;
#pragma unroll
        for (int j = 0; j < 8; ++j) { v[j] = *(const f32x4*)(xr + 4 * (lane + 64 * j)); ss += v[j][0] * v[j][0] + v[j][1] * v[j][1] + v[j][2] * v[j][2] + v[j][3] * v[j][3]; }
        const float rstd = rsqrtf(wave_sum(ss) * (1.f / 2048.f) + EPS);
#pragma unroll
        for (int j = 0; j < 8; ++j) { const int c = 4 * (lane + 64 * j); const f32x4 gg = *(const f32x4*)(g + c), sh = *(const f32x4*)(mr + c), sc = *(const f32x4*)(mr + 2048 + c);
            const f32x4 o = v[j] * rstd * gg * (sc + 1.f) + sh;
            v2u q; q.x = pk2(o[0], o[1]); q.y = pk2(o[2], o[3]); *(v2u*)(H + (size_t)m * 2048 + c) = q; }
    }
}

__device__ __forceinline__ int scan_row(int b, int dir, int s) {
    if (s < 256) { const int tc = dir ? 255 - s : s; return NT + b * 256 + tc; }
    const int t0 = s - 256; return b * 2048 + (dir ? 2047 - t0 : t0);
}
__device__ __forceinline__ void phase3_prep(const Args& a, LAS unsigned char* lds, int tid, int vcu, int G) {
    unsigned char* ws = a.ws;
    const bf16* Q = (const bf16*)(ws + RA_Q); const bf16* Kb = (const bf16*)(ws + RA_K); const float* ALR = (const float*)(ws + RA_ALR);
    bf16* QG = (bf16*)(ws + PQG); bf16* AM = (bf16*)(ws + PAM); bf16* KD = (bf16*)(ws + PKD); float* DEC = (float*)(ws + PDEC);
    constexpr int TS = 520;
    LAS float* alr = (LAS float*)lds;
    LAS bf16* Kt = (LAS bf16*)(lds + 4096);
    LAS bf16* Qt = (LAS bf16*)(lds + 4096 + 64 * TS * 2);
    const int col = tid, h = col >> 7, dk = col & 127;
    const int lane = tid & 63, wave = __builtin_amdgcn_readfirstlane(tid >> 6), l15 = lane & 15, l4 = lane >> 4;
    for (int item = vcu; item < 2 * 8 * 36; item += G) {
        const int ch = item % 36, b = (item / 36) & 7, dir = item / 288;
        const bool lat = ch >= 4;
        if (tid < 256) { const int i = tid >> 2, r4 = (tid & 3) * 4; const int row = scan_row(b, dir, ch * 64 + i);
            *(LAS f32x4*)(alr + i * 16 + r4) = *(const f32x4*)(ALR + (size_t)row * 32 + dir * 16 + r4); }
        { v4u kr[8], qr[8];
#pragma unroll
          for (int q = 0; q < 8; ++q) { const int p = tid + 512 * q, i = p >> 6, c8 = (p & 63) * 8; const int row = scan_row(b, dir, ch * 64 + i);
              kr[q] = *(const v4u*)(Kb + (size_t)row * 512 + c8); if (lat) qr[q] = *(const v4u*)(Q + (size_t)row * 512 + c8); }
#pragma unroll
          for (int q = 0; q < 8; ++q) { const int p = tid + 512 * q, i = p >> 6, c8 = (p & 63) * 8; *(LAS v4u*)(Kt + i * TS + c8) = kr[q]; if (lat) *(LAS v4u*)(Qt + i * TS + c8) = qr[q]; } }
        const float* wa2 = dir ? a.in[13] : a.in[11]; const float bia = (dir ? a.in[14] : a.in[12])[col];
        float w[16];
#pragma unroll
        for (int r = 0; r < 16; ++r) w[r] = wa2[r * 512 + col];
        __syncthreads();
        float Gc = 0.f, Gmid = 0.f;
#pragma unroll 4
        for (int i = 0; i < 64; ++i) { float z = bia;
#pragma unroll
            for (int r4 = 0; r4 < 4; ++r4) { const f32x4 x = *(const LAS f32x4*)(alr + i * 16 + 4 * r4); z += x[0] * w[4 * r4] + x[1] * w[4 * r4 + 1] + x[2] * w[4 * r4 + 2] + x[3] * w[4 * r4 + 3]; }
            Gc += (fminf(z, 0.f) - __logf(1.f + __expf(-fabsf(z)))) * (1.f / 16.f);
            if (i == 32) Gmid = Gc; }
        const float Gend = Gc;
        DEC[((size_t)(dir * 8 + b) * 36 + ch) * 512 + col] = __expf(Gend);
        bf16* kdrow = KD + ((((size_t)(dir * 8 + b) * 36 + ch) * 4 + h) * 128 + dk) * 64;
        const size_t lt = lat ? ((((size_t)(dir * 8 + b) * 32 + (ch - 4)) * 4 + h) * 64) * 128 + dk : 0;
        Gc = 0.f;
#pragma unroll 1
        for (int i0 = 0; i0 < 64; i0 += 8) { unsigned kd[8];
#pragma unroll
            for (int ii = 0; ii < 8; ++ii) { const int i = i0 + ii; float z = bia;
#pragma unroll
                for (int r4 = 0; r4 < 4; ++r4) { const f32x4 x = *(const LAS f32x4*)(alr + i * 16 + 4 * r4); z += x[0] * w[4 * r4] + x[1] * w[4 * r4 + 1] + x[2] * w[4 * r4 + 2] + x[3] * w[4 * r4 + 3]; }
                Gc += (fminf(z, 0.f) - __logf(1.f + __expf(-fabsf(z)))) * (1.f / 16.f);
                const float kv = bf1(Kt[i * TS + col]);
                kd[ii] = f2bf(kv * __expf(Gend - Gc));
                if (lat) { const float qv = bf1(Qt[i * TS + col]) * 0.08838834764831845f;
                    QG[lt + (size_t)i * 128] = (bf16)f2bf(qv * __expf(Gc));
                    Qt[i * TS + col] = (bf16)f2bf(qv * __expf(Gc - Gmid)); Kt[i * TS + col] = (bf16)f2bf(kv * __expf(Gmid - Gc)); } }
            v4u o; o.x = kd[0] | (kd[1] << 16); o.y = kd[2] | (kd[3] << 16); o.z = kd[4] | (kd[5] << 16); o.w = kd[6] | (kd[7] << 16);
            *(v4u*)(kdrow + i0) = o; }
        if (lat) {
            __syncthreads();
            const int hh = wave >> 1; bf16* amt = AM + ((((size_t)(dir * 8 + b) * 32 + (ch - 4)) * 4 + hh) * 64) * 64;
#pragma unroll
            for (int t2 = 0; t2 < 2; ++t2) { const int ti = (wave & 1) * 2 + t2; f32x4 c[4];
#pragma unroll
                for (int tj = 0; tj < 4; ++tj) c[tj] = (f32x4){0.f, 0.f, 0.f, 0.f};
#pragma unroll
                for (int ks = 0; ks < 4; ++ks) { const int ko = hh * 128 + 32 * ks + 8 * l4;
                    const bf16x8 bq = *(const LAS bf16x8*)(Qt + (16 * ti + l15) * TS + ko);
#pragma unroll
                    for (int tj = 0; tj < 4; ++tj) { const bf16x8 ak = *(const LAS bf16x8*)(Kt + (16 * tj + l15) * TS + ko);
                        c[tj] = __builtin_amdgcn_mfma_f32_16x16x32_bf16(ak, bq, c[tj], 0, 0, 0); } }
                const int i = 16 * ti + l15;
#pragma unroll
                for (int tj = 0; tj < 4; ++tj) { const int j0 = 16 * tj + 4 * l4;
                    v2u p; p.x = pk2(j0 <= i ? c[tj][0] : 0.f, j0 + 1 <= i ? c[tj][1] : 0.f); p.y = pk2(j0 + 2 <= i ? c[tj][2] : 0.f, j0 + 3 <= i ? c[tj][3] : 0.f);
                    *(v2u*)(amt + i * 64 + j0) = p; } }
        }
        __syncthreads();
    }
}

constexpr int GL_QG = 0, GL_ST = 17408, GL_KDT = 34816, GL_VT = 53248, GL_AM = 62464, GL_DEC = 71680;
__device__ __forceinline__ void phase_chain(const Args& a, LAS unsigned char* lds, int tid, int lane, int wave, int vcu, int G) {
    unsigned char* ws = a.ws;
    const v4u* QG = (const v4u*)(ws + PQG); const v4u* AM = (const v4u*)(ws + PAM); const v4u* KD = (const v4u*)(ws + PKD); const float* DEC = (const float*)(ws + PDEC);
    const bf16* V = (const bf16*)(ws + RA_V); bf16* OF = (bf16*)(ws + RA_OF);
    const int l15 = lane & 15, l4 = lane >> 4;
    for (int item = vcu; item < 256; item += G) {
        const int vs = item & 3, dir = (item >> 2) & 1, h = (item >> 3) & 3, b = item >> 5;
        f32x4 S[4];
#pragma unroll
        for (int tv = 0; tv < 4; ++tv) S[tv] = (f32x4){0.f, 0.f, 0.f, 0.f};
        v4u rqA[2], raA, rkA[2], rvA, rqB[2], raB, rkB[2], rvB; float rdecA = 0.f, rdecB = 0.f;
#define GL_LOAD(ch_, LATL, rq, ra, rk, rv, rdec) do { const int ch__ = (ch_); \
            if (LATL) { const size_t t_ = ((((size_t)(dir * 8 + b) * 32 + (ch__ - 4)) * 4 + h) * 1024); rq[0] = QG[t_ + tid]; rq[1] = QG[t_ + tid + 512]; ra = AM[t_ / 2 + tid]; } \
            { const size_t t_ = ((((size_t)(dir * 8 + b) * 36 + ch__) * 4 + h) * 1024); rk[0] = KD[t_ + tid]; rk[1] = KD[t_ + tid + 512]; } \
            { const int row_ = scan_row(b, dir, ch__ * 64 + (tid >> 3)); rv = *(const v4u*)(V + (size_t)row_ * 1024 + h * 256 + vs * 64 + 8 * (tid & 7)); } \
            rdec = DEC[((size_t)(dir * 8 + b) * 36 + ch__) * 512 + h * 128 + (tid & 127)]; } while (0)
#define GL_STEP(ch_, LAT, LATN, MORE, rq, ra, rk, rv, rdec) do { const int ch = (ch_); \
              \
            _Pragma("unroll") for (int tv = 0; tv < 4; ++tv) { v2u p; p.x = pk2(S[tv][0], S[tv][1]); p.y = pk2(S[tv][2], S[tv][3]); \
                *(LAS v2u*)(lds + GL_ST + (16 * tv + l15) * 272 + (16 * wave + 4 * l4) * 2) = p; } \
            if (LAT) { _Pragma("unroll") for (int q = 0; q < 2; ++q) { const int p = tid + 512 * q; *(LAS v4u*)(lds + GL_QG + (p >> 4) * 272 + (p & 15) * 16) = rq[q]; } \
                *(LAS v4u*)(lds + GL_AM + (tid >> 3) * 144 + (tid & 7) * 16) = ra; } \
            _Pragma("unroll") for (int q = 0; q < 2; ++q) { const int p = tid + 512 * q; *(LAS v4u*)(lds + GL_KDT + (p >> 3) * 144 + (p & 7) * 16) = rk[q]; } \
            { const int i = tid >> 3, c = tid & 7; LAS bf16* vt = (LAS bf16*)(lds + GL_VT) + i; \
              vt[(8 * c + 0) * 72] = (bf16)(rv.x & 0xffffu); vt[(8 * c + 1) * 72] = (bf16)(rv.x >> 16); vt[(8 * c + 2) * 72] = (bf16)(rv.y & 0xffffu); vt[(8 * c + 3) * 72] = (bf16)(rv.y >> 16); \
              vt[(8 * c + 4) * 72] = (bf16)(rv.z & 0xffffu); vt[(8 * c + 5) * 72] = (bf16)(rv.z >> 16); vt[(8 * c + 6) * 72] = (bf16)(rv.w & 0xffffu); vt[(8 * c + 7) * 72] = (bf16)(rv.w >> 16); } \
            if (tid < 128) *(LAS float*)(lds + GL_DEC + tid * 4) = rdec; \
            LDS_BARRIER(); \
            if (MORE) GL_LOAD(ch + 2, LATN, rq, ra, rk, rv, rdec); \
            if (LAT) {   \
                const int ti = wave >> 1, tv0 = (wave & 1) * 2; f32x4 c0 = (f32x4){0.f, 0.f, 0.f, 0.f}, c1 = c0; bf16x8 fb[6], f0[6], f1[6]; \
                _Pragma("unroll") for (int ks = 0; ks < 4; ++ks) { const int ko = (32 * ks + 8 * l4) * 2; \
                    fb[ks] = *(const LAS bf16x8*)(lds + GL_QG + (16 * ti + l15) * 272 + ko); \
                    f0[ks] = *(const LAS bf16x8*)(lds + GL_ST + (16 * tv0 + l15) * 272 + ko); f1[ks] = *(const LAS bf16x8*)(lds + GL_ST + (16 * tv0 + 16 + l15) * 272 + ko); } \
                _Pragma("unroll") for (int ks = 0; ks < 2; ++ks) { const int ko = (32 * ks + 8 * l4) * 2; \
                    fb[4 + ks] = *(const LAS bf16x8*)(lds + GL_AM + (16 * ti + l15) * 144 + ko); \
                    f0[4 + ks] = *(const LAS bf16x8*)(lds + GL_VT + (16 * tv0 + l15) * 144 + ko); f1[4 + ks] = *(const LAS bf16x8*)(lds + GL_VT + (16 * tv0 + 16 + l15) * 144 + ko); } \
                _Pragma("unroll") for (int ks = 0; ks < 6; ++ks) { c0 = __builtin_amdgcn_mfma_f32_16x16x32_bf16(f0[ks], fb[ks], c0, 0, 0, 0); c1 = __builtin_amdgcn_mfma_f32_16x16x32_bf16(f1[ks], fb[ks], c1, 0, 0, 0); } \
                const int s_ = ch * 64 + 16 * ti + l15; const int t0 = s_ - 256; const int t = dir ? 2047 - t0 : t0; \
                bf16* orow = OF + ((size_t)dir * NT + b * 2048 + t) * 1024 + h * 256 + vs * 64 + 16 * tv0 + 4 * l4; \
                v2u p0, p1; p0.x = pk2(c0[0], c0[1]); p0.y = pk2(c0[2], c0[3]); p1.x = pk2(c1[0], c1[1]); p1.y = pk2(c1[2], c1[3]); \
                *(v2u*)(orow) = p0; *(v2u*)(orow + 16) = p1; } \
              \
            { const f32x4 d4 = *(const LAS f32x4*)(lds + GL_DEC + (16 * wave + 4 * l4) * 4); bf16x8 fk[2], fv[2][4]; \
              _Pragma("unroll") for (int ks = 0; ks < 2; ++ks) { const int ko = (32 * ks + 8 * l4) * 2; fk[ks] = *(const LAS bf16x8*)(lds + GL_KDT + (16 * wave + l15) * 144 + ko); \
                  _Pragma("unroll") for (int tv = 0; tv < 4; ++tv) fv[ks][tv] = *(const LAS bf16x8*)(lds + GL_VT + (16 * tv + l15) * 144 + ko); } \
              _Pragma("unroll") for (int tv = 0; tv < 4; ++tv) S[tv] = S[tv] * d4; \
              _Pragma("unroll") for (int ks = 0; ks < 2; ++ks) \
                  _Pragma("unroll") for (int tv = 0; tv < 4; ++tv) S[tv] = __builtin_amdgcn_mfma_f32_16x16x32_bf16(fk[ks], fv[ks][tv], S[tv], 0, 0, 0); } \
            LDS_BARRIER(); } while (0)
        GL_LOAD(0, false, rqA, raA, rkA, rvA, rdecA); GL_LOAD(1, false, rqB, raB, rkB, rvB, rdecB);
        GL_STEP(0, false, false, true, rqA, raA, rkA, rvA, rdecA); GL_STEP(1, false, false, true, rqB, raB, rkB, rvB, rdecB);
        GL_STEP(2, false, true, true, rqA, raA, rkA, rvA, rdecA);  GL_STEP(3, false, true, true, rqB, raB, rkB, rvB, rdecB);
#pragma unroll 1
        for (int c2 = 4; c2 < 34; c2 += 2) { GL_STEP(c2, true, true, true, rqA, raA, rkA, rvA, rdecA); GL_STEP(c2 + 1, true, true, true, rqB, raB, rkB, rvB, rdecB); }
        GL_STEP(34, true, true, false, rqA, raA, rkA, rvA, rdecA); GL_STEP(35, true, true, false, rqB, raB, rkB, rvB, rdecB);
#undef GL_STEP
#undef GL_LOAD
    }
}

template <int HALFW>
__device__ __forceinline__ void pool_item(const bf16* P, bf16* DP, LAS float* tmp, int tid, int b, int r, int g) {
    const int rlo = r - HALFW < 0 ? 0 : r - HALFW, rhi = r + HALFW > 32 ? 32 : r + HALFW;
    const float rinv = 1.f / (float)(rhi - rlo);
#pragma unroll 1
    for (int q = 0; q < 4; ++q) { const int p = tid + 512 * q, c = p >> 5, ch0 = (p & 31) * 8; float acc[8]; v4u x[2 * HALFW];
#pragma unroll
        for (int u = 0; u < 2 * HALFW; ++u) { const int rr = (rlo + u < rhi) ? rlo + u : rlo; x[u] = *(const v4u*)(P + ((size_t)(b * 2048 + rr * 64 + c)) * 1024 + g * 256 + ch0); }
#pragma unroll
        for (int j = 0; j < 8; ++j) acc[j] = 0.f;
#pragma unroll
        for (int u = 0; u < 2 * HALFW; ++u) { const float m = (rlo + u < rhi) ? 1.f : 0.f;
            acc[0] += m * bflo(x[u].x); acc[1] += m * bfhi(x[u].x); acc[2] += m * bflo(x[u].y); acc[3] += m * bfhi(x[u].y); acc[4] += m * bflo(x[u].z); acc[5] += m * bfhi(x[u].z); acc[6] += m * bflo(x[u].w); acc[7] += m * bfhi(x[u].w); }
        *(LAS f32x4*)(tmp + c * 256 + ch0) = (f32x4){acc[0] * rinv, acc[1] * rinv, acc[2] * rinv, acc[3] * rinv};
        *(LAS f32x4*)(tmp + c * 256 + ch0 + 4) = (f32x4){acc[4] * rinv, acc[5] * rinv, acc[6] * rinv, acc[7] * rinv}; }
    __syncthreads();
#pragma unroll 1
    for (int q = 0; q < 4; ++q) { const int p = tid + 512 * q, c = p >> 5, ch0 = (p & 31) * 8;
        const int clo = c - HALFW < 0 ? 0 : c - HALFW, chi = c + HALFW > 64 ? 64 : c + HALFW; const float cinv = 1.f / (float)(chi - clo);
        const size_t o = ((size_t)(b * 2048 + r * 64 + c)) * 1024 + g * 256 + ch0;
        const v4u x = *(const v4u*)(P + o);
        f32x4 a0 = (f32x4){0.f, 0.f, 0.f, 0.f}, a1 = a0;
#pragma unroll
        for (int u = 0; u < 2 * HALFW; ++u) { const int cc = (clo + u < chi) ? clo + u : clo; const float m = (clo + u < chi) ? 1.f : 0.f;
            a0 += *(const LAS f32x4*)(tmp + cc * 256 + ch0) * m; a1 += *(const LAS f32x4*)(tmp + cc * 256 + ch0 + 4) * m; }
        v4u d; d.x = pk2(a0[0] * cinv - bflo(x.x), a0[1] * cinv - bfhi(x.x)); d.y = pk2(a0[2] * cinv - bflo(x.y), a0[3] * cinv - bfhi(x.y));
        d.z = pk2(a1[0] * cinv - bflo(x.z), a1[1] * cinv - bfhi(x.z)); d.w = pk2(a1[2] * cinv - bflo(x.w), a1[3] * cinv - bfhi(x.w));
        *(v4u*)(DP + o) = d; }
    __syncthreads();
}
__device__ __forceinline__ void phase3_pool(const Args& a, LAS unsigned char* lds, int tid, int vcu, int G) {
    const bf16* P = (const bf16*)(a.ws + RA_P); bf16* DP = (bf16*)(a.ws + RA_DPOOL);
    LAS float* tmp = (LAS float*)lds;
    for (int item = vcu; item < 1024; item += G) {
        const int g = item >> 8, r = (item >> 3) & 31, b = item & 7;
        const int gg = 3 - g;
        if (gg == 0) pool_item<1>(P, DP, tmp, tid, b, r, gg); else if (gg == 1) pool_item<2>(P, DP, tmp, tid, b, r, gg); else if (gg == 2) pool_item<4>(P, DP, tmp, tid, b, r, gg); else pool_item<8>(P, DP, tmp, tid, b, r, gg);
    }
}

__device__ __forceinline__ void phase4_post(const Args& a, int lane, int wave, int vcu, int G) {
    const bf16* OF = (const bf16*)(a.ws + RA_OF); const bf16* OB = OF + (size_t)NT * 1024; const bf16* Rr = (const bf16*)(a.ws + RA_R); bf16* Y = (bf16*)(a.ws + RA_YMIX);
    const float* gn = a.in[15];
    for (int idx = vcu * 8 + wave; idx < NT * 4; idx += G * 8) {
        const int t = idx >> 2, h = idx & 3; const size_t o = (size_t)t * 1024 + h * 256 + 4 * lane;
        const v2u of = *(const v2u*)(OF + o), ob = *(const v2u*)(OB + o);
        const f32x4 x = (f32x4){bflo(of.x) + bflo(ob.x), bfhi(of.x) + bfhi(ob.x), bflo(of.y) + bflo(ob.y), bfhi(of.y) + bfhi(ob.y)};
        const float ms = wave_sum(x[0] * x[0] + x[1] * x[1] + x[2] * x[2] + x[3] * x[3]) * (1.f / 256.f);
        const float sc = rsqrtf(ms + EPS);
        const f32x4 g4 = *(const f32x4*)(gn + h * 256 + 4 * lane);
        const v2u rr = *(const v2u*)(Rr + o);
        const float r0 = bflo(rr.x), r1 = bfhi(rr.x), r2 = bflo(rr.y), r3 = bfhi(rr.y);
        v2u q; q.x = pk2(x[0] * sc * g4[0] * silu_f(r0), x[1] * sc * g4[1] * silu_f(r1)); q.y = pk2(x[2] * sc * g4[2] * silu_f(r2), x[3] * sc * g4[3] * silu_f(r3));
        *(v2u*)(Y + (size_t)t * 2048 + h * 256 + 4 * lane) = q;
    }
}

__device__ __forceinline__ void phase6(const Args& a, LAS unsigned char* lds, int tid, int lane, int wave, int vcu, int G) {
    unsigned char* ws = a.ws;
    const float* mod = (const float*)(ws + WS_MOD); const bf16* Y1 = (const bf16*)(ws + RA_Y1); unsigned char* H2 = ws + RA_H2;
    const float* gpost = a.in[7]; const float* gpre2 = a.in[8]; const float* rbias = a.in[20];
    const bf16* whi = (const bf16*)(ws + WS_WRT);
    LAS float* part = (LAS float*)lds;
    LAS float* logit = (LAS float*)(lds + LDS_LOGIT);
    LAS u64* masks = (LAS u64*)(lds + LDS_MASKS);
    int* cnt = (int*)(ws + T_CNT); u64* tmask = (u64*)(ws + T_MASK); float* tokw = (float*)(ws + T_TOKW);
    const int l15 = lane & 15, l4 = lane >> 4;
    for (int blk = vcu; blk < NT / 64; blk += G) {
        for (int it = 0; it < 2; ++it) {
#pragma unroll 1
            for (int rep_ = 0; rep_ < P7_REP_ROWS; ++rep_) {
#pragma unroll 1
            for (int rr = 0; rr < 4; ++rr) {
                const int lr = wave * 4 + rr, t = blk * 64 + it * 32 + lr; const float* mr = mod + (size_t)(t >> 11) * 12288;
                const bf16* yr = Y1 + (size_t)t * 2048; const float* xr = a.in[0] + (size_t)t * 2048;
                f32x4 y[8]; float ss = 0.f;
#pragma unroll
                for (int j = 0; j < 8; ++j) { const v2u yb = *(const v2u*)(yr + 4 * (lane + 64 * j)); y[j] = (f32x4){bflo(yb.x), bfhi(yb.x), bflo(yb.y), bfhi(yb.y)}; ss += y[j][0] * y[j][0] + y[j][1] * y[j][1] + y[j][2] * y[j][2] + y[j][3] * y[j][3]; }
                const float rstd1 = rsqrtf(wave_sum(ss) * (1.f / 2048.f) + EPS);
                if (lane == 0) ((float*)(ws + T_RSTD1))[t] = rstd1;
                float s2 = 0.f;
#pragma unroll
                for (int j = 0; j < 8; ++j) { const int c = 4 * (lane + 64 * j); const f32x4 x = *(const f32x4*)(xr + c), gp = *(const f32x4*)(gpost + c), gt = *(const f32x4*)(mr + 4096 + c);
                    const f32x4 x1 = x + gt * (y[j] * rstd1 * gp); y[j] = x1;
                    s2 += x1[0] * x1[0] + x1[1] * x1[1] + x1[2] * x1[2] + x1[3] * x1[3]; }
                const float rstd2 = rsqrtf(wave_sum(s2) * (1.f / 2048.f) + EPS);
#pragma unroll
                for (int j = 0; j < 8; ++j) { const int c = 4 * (lane + 64 * j); const f32x4 g2 = *(const f32x4*)(gpre2 + c), sh = *(const f32x4*)(mr + 6144 + c), sc = *(const f32x4*)(mr + 8192 + c);
                    const f32x4 hh = y[j] * rstd2 * g2 * (sc + 1.f) + sh;
                    v2u qh; qh.x = pk2(hh[0], hh[1]); qh.y = pk2(hh[2], hh[3]);
                    *(LAS v2u*)(lds + RT_HI + lr * RT_ROWB + c * 2) = qh;
                    *(unsigned*)(H2 + (size_t)t * 2048 + c) = pk4_fp8(hh[0] * SC_H, hh[1] * SC_H, hh[2] * SC_H, hh[3] * SC_H); }
            }
            __syncthreads();
            }
            { f32x4 acc[2][4];
#pragma unroll
              for (int mt = 0; mt < 2; ++mt)
#pragma unroll
                  for (int et = 0; et < 4; ++et) acc[mt][et] = (f32x4){0.f, 0.f, 0.f, 0.f};
#pragma unroll 1
              for (int kh = 0; kh < 2; ++kh) {
                  bf16x8 bh[4][4];
#pragma unroll
                  for (int k4 = 0; k4 < 4; ++k4) { const int k0 = 256 * wave + 32 * (4 * kh + k4) + 8 * l4;
#pragma unroll
                      for (int et = 0; et < 4; ++et) bh[k4][et] = *(const bf16x8*)(whi + (size_t)(16 * et + l15) * 2048 + k0); }
#pragma unroll
                  for (int k4 = 0; k4 < 4; ++k4) { const int k0 = 256 * wave + 32 * (4 * kh + k4) + 8 * l4;
#pragma unroll
                      for (int mt = 0; mt < 2; ++mt) { const bf16x8 ah = *(const LAS bf16x8*)(lds + RT_HI + (16 * mt + l15) * RT_ROWB + k0 * 2);
#pragma unroll
                          for (int et = 0; et < 4; ++et) acc[mt][et] = __builtin_amdgcn_mfma_f32_16x16x32_bf16(ah, bh[k4][et], acc[mt][et], 0, 0, 0); } } }
              __syncthreads();
#pragma unroll
              for (int mt = 0; mt < 2; ++mt)
#pragma unroll
                  for (int et = 0; et < 4; ++et)
#pragma unroll
                      for (int q = 0; q < 4; ++q) part[(wave * 32 + 16 * mt + 4 * l4 + q) * 64 + 16 * et + l15] = acc[mt][et][q]; }
            __syncthreads();
#pragma unroll
            for (int q = 0; q < 4; ++q) { const int idx = tid + 512 * q; float sacc = 0.f;
#pragma unroll
                for (int w = 0; w < 8; ++w) sacc += part[w * 2048 + idx];
                logit[idx] = sacc; }
            __syncthreads();
#pragma unroll 1
            for (int rep_ = 0; rep_ < P7_REP_RT; ++rep_) {
#pragma unroll 1
            for (int rr = 0; rr < 4; ++rr) {
                const int lr = wave * 4 + rr, t = blk * 64 + it * 32 + lr;
                const float lg = logit[lr * 64 + lane]; const float s = 1.f / (1.f + __expf(-lg)); const float sel = s + rbias[lane];
                float m1 = sel; m1 = fmaxf(m1, __shfl_xor(m1, 1)); m1 = fmaxf(m1, __shfl_xor(m1, 2)); m1 = fmaxf(m1, __shfl_xor(m1, 4));
                const u64 eq = __ballot(sel == m1); const unsigned gb = (unsigned)(eq >> (lane & ~7)) & 0xffu; const int first = __builtin_ctz(gb);
                float v2 = ((lane & 7) == first) ? -INFINITY : sel; v2 = fmaxf(v2, __shfl_xor(v2, 1)); v2 = fmaxf(v2, __shfl_xor(v2, 2)); v2 = fmaxf(v2, __shfl_xor(v2, 4));
                const float gs = m1 + v2; const int g = lane >> 3; int grank = 0;
#pragma unroll
                for (int g2 = 0; g2 < 8; ++g2) { const float o = __shfl(gs, g2 * 8); grank += (o > gs || (o == gs && g2 < g)) ? 1 : 0; }
                const bool gsel = grank < 4; const float mk = gsel ? sel : -INFINITY; int rank = 0;
                for (int e2 = 0; e2 < 64; ++e2) { const float o = __shfl(mk, e2); rank += (o > mk || (o == mk && e2 < lane)) ? 1 : 0; }
                const bool chosen = gsel && rank < 8;
                const u64 mask = __ballot(chosen); const float ssum = wave_sum(chosen ? s : 0.f);
                const int kidx = __popcll(mask & ((1ull << lane) - 1ull));
                if (chosen) tokw[(size_t)t * 8 + kidx] = s / ssum * 2.5f;
                if (lane == 0) { tmask[t] = mask; masks[it * 32 + lr] = mask; }
            }
            __syncthreads();
            }
        }
        if (wave == 0) { const u64 m = masks[lane]; int mine = 0;
            for (int e = 0; e < 64; ++e) { const int c = __popcll(__ballot((m >> e) & 1ull)); mine = (lane == e) ? c : mine; }
            cnt[blk * 64 + lane] = mine; }
        __syncthreads();
    }
}

__device__ __forceinline__ void phase7(const Args& a, LAS unsigned char* lds, int tid, int lane, int wave, int vcu, int G) {
    unsigned char* ws = a.ws;
    const int* cnt = (const int*)(ws + T_CNT); const u64* tmask = (const u64*)(ws + T_MASK); const float* tokw = (const float*)(ws + T_TOKW);
    int* tokslot = (int*)(ws + T_TOKSLOT); int* slottok = (int*)(ws + T_SLOTTOK); float* slotw = (float*)(ws + T_SLOTW); int* tile = (int*)(ws + T_TILE);
    LAS int* part = (LAS int*)lds;
    LAS int* tot = (LAS int*)(lds + 4096);
    for (int blk = vcu; blk < NT / 64; blk += G) {
        int pre = 0, all = 0;
        for (int b2 = wave; b2 < 256; b2 += 8) { const int c = cnt[b2 * 64 + lane]; all += c; pre += (b2 < blk) ? c : 0; }
        part[(wave * 2) * 64 + lane] = pre; part[(wave * 2 + 1) * 64 + lane] = all;
        __syncthreads();
        if (wave == 0) {
            int p = 0, t = 0;
#pragma unroll
            for (int w = 0; w < 8; ++w) { p += part[(w * 2) * 64 + lane]; t += part[(w * 2 + 1) * 64 + lane]; }
            int incl = t;
#pragma unroll
            for (int o = 1; o < 64; o <<= 1) { const int v = __shfl_up(incl, o); if (lane >= o) incl += v; }
            const int start = incl - t; const int base = start + p;
            tot[lane] = t; tot[64 + lane] = start;
            const int tokn = blk * 64 + lane; const u64 m = tmask[tokn];
            for (int e = 0; e < 64; ++e) { const bool bit = (m >> e) & 1ull; const u64 bal = __ballot(bit); const int be = __shfl(base, e);
                if (bit) { const int rank = __popcll(bal & ((1ull << lane) - 1ull)); const int slot = be + rank; const int k = __popcll(m & ((1ull << e) - 1ull));
                    slottok[slot] = tokn; slotw[slot] = tokw[(size_t)tokn * 8 + k]; tokslot[(size_t)tokn * 8 + k] = slot; } }
            slottok[SH_ROW0 + tokn] = tokn; slotw[SH_ROW0 + tokn] = 1.f;
        }
        __syncthreads();
        if (blk == 0 && tid == 0) {
            int n = 0;
            for (int e = 0; e < 64; ++e) { const int te = tot[e], st = tot[64 + e];
                for (int j = 0; j * 256 < te; ++j) { tile[n] = e; tile[NTILE_MAX + n] = st + j * 256; tile[2 * NTILE_MAX + n] = (te - j * 256) < 256 ? (te - j * 256) : 256; ++n; } }
            for (int j = 0; j < 64; ++j) { tile[n] = 64; tile[NTILE_MAX + n] = SH_ROW0 + j * 256; tile[2 * NTILE_MAX + n] = 256; ++n; }
            tile[3 * NTILE_MAX] = n;
        }
        __syncthreads();
    }
}

__device__ __forceinline__ void phase10(const Args& a, LAS unsigned char* lds, int lane, int wave, int vcu, int G) {
    unsigned char* ws = a.ws;
    const float* mod = (const float*)(ws + WS_MOD); const unsigned char* SO = ws + WS_SLOTOUT; const int* tokslot = (const int*)(ws + T_TOKSLOT); const float* gp = a.in[9];
    LAS float* ysc = (LAS float*)(lds + wave * 8192);
    const unsigned lo16_ = 16u * (unsigned)lane;
#pragma unroll 1
    for (int t = vcu * 8 + wave; t < NT; t += G * 8) {
        const float* mr = mod + (size_t)(t >> 11) * 12288;
        const int myslot = lane < 8 ? tokslot[(size_t)t * 8 + lane] : SH_ROW0 + t;
        unsigned lo16 = lo16_; asm volatile("" : "+v"(lo16));
        v4u x[9][2]; f32x4 xo[8]; v2u yb[8];
        const unsigned char* x1r = (const unsigned char*)(a.in[0] + (size_t)t * 2048); const unsigned char* y1r = (const unsigned char*)((const bf16*)(ws + RA_Y1) + (size_t)t * 2048);
        const float rstd1 = ((const float*)(ws + T_RSTD1))[t];
#pragma unroll
        for (int k = 0; k < 9; ++k) { const int slot = __builtin_amdgcn_readfirstlane(__shfl(myslot, k)); const unsigned char* sr = SO + (size_t)slot * 2048;
#pragma unroll
            for (int j = 0; j < 2; ++j) x[k][j] = *(const v4u*)(sr + (lo16 + 1024u * j)); }
        float y[2][16];
#pragma unroll
        for (int j = 0; j < 2; ++j)
#pragma unroll
            for (int q = 0; q < 16; ++q) y[j][q] = 0.f;
#pragma unroll
        for (int k = 0; k < 9; ++k)
#pragma unroll
            for (int j = 0; j < 2; ++j) { v4u v = x[k][j]; asm volatile("" : "+v"(v) : "v"(y[j][0]), "v"(y[j][15]));
#pragma unroll
                for (int w = 0; w < 4; ++w) { const unsigned d = v[w]; const auto lo = __builtin_amdgcn_cvt_pk_f32_fp8(d, false), hi = __builtin_amdgcn_cvt_pk_f32_fp8(d, true);
                    y[j][4 * w] += lo[0]; y[j][4 * w + 1] += lo[1]; y[j][4 * w + 2] += hi[0]; y[j][4 * w + 3] += hi[1]; } }
        asm volatile("" ::: "memory");
#pragma unroll
        for (int j = 0; j < 8; ++j) { xo[j] = *(const f32x4*)(x1r + (lo16 + 1024u * j)); yb[j] = *(const v2u*)(y1r + (lo16 / 2u + 512u * j)); }
        float ss = 0.f;
#pragma unroll
        for (int j = 0; j < 2; ++j)
#pragma unroll
            for (int q = 0; q < 16; ++q) ss += y[j][q] * y[j][q];
        const float rstd = rsqrtf(wave_sum(ss) * (1.f / 2048.f) + EPS * SC_O * SC_O);
#pragma unroll
        for (int j = 0; j < 2; ++j)
#pragma unroll
            for (int q = 0; q < 4; ++q) *(LAS f32x4*)(ysc + 16 * (lane + 64 * j) + 4 * q) = (f32x4){y[j][4 * q], y[j][4 * q + 1], y[j][4 * q + 2], y[j][4 * q + 3]};
        LDS_WAIT(); asm volatile("" ::: "memory");
        unsigned char* outr = (unsigned char*)(a.out + (size_t)t * 2048); const unsigned char* gpb = (const unsigned char*)gp; const unsigned char* g1b = (const unsigned char*)a.in[7];
        const unsigned char* gt2b = (const unsigned char*)(mr + 10240); const unsigned char* gt1b = (const unsigned char*)(mr + 4096);
#pragma unroll
        for (int j = 0; j < 8; ++j) { const unsigned cb = lo16 + 1024u * j; const f32x4 yy = *(const LAS f32x4*)(ysc + 4 * (lane + 64 * j)), g = *(const f32x4*)(gpb + cb), gt = *(const f32x4*)(gt2b + cb);
            const f32x4 g1 = *(const f32x4*)(g1b + cb), gt1 = *(const f32x4*)(gt1b + cb); const f32x4 y1 = (f32x4){bflo(yb[j].x), bfhi(yb[j].x), bflo(yb[j].y), bfhi(yb[j].y)};
            const f32x4 x1 = xo[j] + gt1 * (y1 * rstd1 * g1);
            *(f32x4*)(outr + cb) = x1 + gt * (yy * rstd * g); }
        LDS_WAIT(); asm volatile("" ::: "memory");
    }
}

__global__ void __launch_bounds__(512, 2) fwd(Args args) {
    extern __shared__ __attribute__((aligned(16))) unsigned char lds_raw[];
    LAS unsigned char* lds = (LAS unsigned char*)lds_raw;
    const int tid = threadIdx.x, lane = tid & 63, wave = __builtin_amdgcn_readfirstlane(tid >> 6);
    const int G = gridDim.x, bx = blockIdx.x;
    const int vcu = (G % 8 == 0) ? (bx % 8) * (G / 8) + bx / 8 : bx;
    unsigned char* ws = args.ws;
    volatile LAS unsigned* MISC = (volatile LAS unsigned*)(lds + LDS_MISC);
    if (tid < 64) MISC[tid] = 0u;
    __syncthreads();
    const int lo = args.ph_lo, hi = args.ph_hi;
    XcdBarrier bar; bar.bar = (unsigned*)(ws + WS_CTL) + 4096; bar.x = 0; bar.st = nullptr;
    if (hi - lo > 1) bar = xcd_barrier_post((unsigned*)(ws + WS_CTL) + 4096, MISC + 8);
#ifndef PH_MASK
#define PH_MASK 0xfff
#endif
#define IN(k) (((PH_MASK >> (k)) & 1) && lo <= (k) && (k) < hi)
#define SEAM(k) do { if (IN(k) && IN((k) + 1)) xcd_barrier(bar); } while (0)

#ifndef REP_PHASE
#define REP_PHASE -1
#endif
#define PH_IDS int tz_ = threadIdx.x; asm volatile("" : "+v"(tz_)); const int tid = tz_, lane = tz_ & 63, wave = __builtin_amdgcn_readfirstlane(tz_ >> 6); (void)tid; (void)lane; (void)wave;
#define RUNPH(k, ...) do { if (IN(k)) { { PH_IDS __VA_ARGS__ } if (REP_PHASE == (k)) { xcd_barrier(bar); { PH_IDS __VA_ARGS__ } } SEAM(k); } } while (0)
#ifdef PROBE_P0
    if (IN(0)) { { PH_IDS phase0(args, lds, tid, lane, wave, vcu, G); } xcd_barrier(bar); { PH_IDS phase0(args, lds, tid, lane, wave, vcu, G, PROBE_P0 == 1, PROBE_P0 == 2); } SEAM(0); }
#else
    RUNPH(0, phase0(args, lds, tid, lane, wave, vcu, G););
#endif
    RUNPH(1, phase1(args, lane, wave, vcu, G););
    RUNPH(2, {
        DenseSched S; S.init(ws + RA_H, ws + WS_WIN, 2048, 2048, MROWS, DINP, G, bx);
        EpiIn E{ws};
        pg8::gemm_phase<EpiIn, DenseSched>(lds, 2048, S, E); });
    RUNPH(3, phase3_prep(args, lds, tid, vcu, G); phase3_pool(args, lds, tid, vcu, G););
    RUNPH(4, phase_chain(args, lds, tid, lane, wave, vcu, G););
    RUNPH(5, {
        phase4_post(args, lane, wave, vcu, G);
        PoolSched S{(const char*)(ws + RA_DPOOL), (const char*)(ws + WS_WPOOL), G, vcu};
        EpiPool E{(bf16*)(ws + RA_YMIX), args.in[17]};
        int kpool = 256; asm volatile("" : "+s"(kpool));
        pg8::gemm_phase<EpiPool, PoolSched>(lds, kpool, S, E); });
    RUNPH(6, {
        DenseSched S; S.init(ws + RA_YMIX, ws + WS_WOUT, 2048, 2048, NT, 2048, G, bx);
        EpiOut E{(bf16*)(ws + RA_Y1)};
        pg8::gemm_phase<EpiOut, DenseSched>(lds, 2048, S, E); });
    RUNPH(7, phase6(args, lds, tid, lane, wave, vcu, G););
    RUNPH(8, phase7(args, lds, tid, lane, wave, vcu, G););
    RUNPH(9, {
        MoeGUSched S{(const char*)(ws + RA_H2), (const char*)(ws + WS_WGU), (const int*)(ws + T_TILE), (const int*)(ws + T_SLOTTOK), G, vcu};
        EpiGU E{ws + WS_ACT, (const float*)(ws + T_SLOTW)};
        int kgu = 1024; asm volatile("" : "+s"(kgu));
        pg8::gemm_phase<EpiGU, MoeGUSched, true>(lds, kgu, S, E); });
    RUNPH(10, {
        MoeDownSched S{(const char*)(ws + WS_ACT), (const char*)(ws + WS_WD), (const int*)(ws + T_TILE), G, vcu};
        EpiDown E{ws + WS_SLOTOUT};
        int kdn = 256; asm volatile("" : "+s"(kdn));
        pg8::gemm_phase<EpiDown, MoeDownSched, true>(lds, kdn, S, E); });
    if (IN(11)) { { PH_IDS phase10(args, lds, lane, wave, vcu, G); } if (REP_PHASE == 11) { xcd_barrier(bar); { PH_IDS phase10(args, lds, lane, wave, vcu, G); } } }
#undef IN
#undef SEAM
}

extern "C" void kernel_launch(void* const* d_in, const int* in_sizes, int n_in, void* d_out, int out_size, void* d_ws, size_t ws_size, hipStream_t stream) {
    static int grid = 0;
    if (grid == 0) {
        if (n_in != 27 || out_size != NT * DM || ws_size < WS_NEED) { fprintf(stderr, "kernel_launch: unexpected problem: n_in %d out %d ws %zu (need %zu)\n", n_in, out_size, ws_size, (size_t)WS_NEED); grid = -1; return; }
        int dev = 0, cus = 0, per_cu = 0;
        if (hipGetDevice(&dev) != hipSuccess || hipDeviceGetAttribute(&cus, hipDeviceAttributeMultiprocessorCount, dev) != hipSuccess) { grid = -1; return; }
        if (hipFuncSetAttribute((const void*)fwd, hipFuncAttributeMaxDynamicSharedMemorySize, LDS_BYTES) != hipSuccess) { fprintf(stderr, "kernel_launch: hipFuncSetAttribute failed\n"); grid = -1; return; }
        if (hipOccupancyMaxActiveBlocksPerMultiprocessor(&per_cu, (const void*)fwd, 512, LDS_BYTES) != hipSuccess || per_cu < 1) { fprintf(stderr, "kernel_launch: occupancy query says %d\n", per_cu); }
        (void)hipGetLastError();
        grid = cus;
    }
    if (grid < 0) return;
    (void)hipMemsetAsync((char*)d_ws + WS_CTL, 0, CTL_ZERO_BYTES, stream);
    Args a{};
    for (int i = 0; i < 27; ++i) a.in[i] = (const float*)d_in[i];
    a.out = (float*)d_out; a.ws = (unsigned char*)d_ws;
    if (N_LAUNCHES == 1) {
        a.ph_lo = 0; a.ph_hi = NPH;
        hipLaunchKernelGGL(fwd, dim3(grid), dim3(512), LDS_BYTES, stream, a);
    } else {
        for (int p = 0; p < NPH; ++p) { a.ph_lo = p; a.ph_hi = p + 1; hipLaunchKernelGGL(fwd, dim3(grid), dim3(512), LDS_BYTES, stream, a); }
    }
}
```

```cpp
#include <hip/hip_runtime.h>
#include <cstdio>
#include <cstdint>

#ifndef P7_REP_ROWS
#define P7_REP_ROWS 1
#endif
#ifndef P7_REP_LOG
#define P7_REP_LOG 1
#endif
#ifndef P7_REP_RT
#define P7_REP_RT 1
#endif
#ifndef N_LAUNCHES
#define N_LAUNCHES 1
#endif

#define GAS __attribute__((address_space(1)))
#define LAS __attribute__((address_space(3)))
typedef unsigned short bf16;
typedef unsigned v4u __attribute__((ext_vector_type(4)));
typedef unsigned v2u __attribute__((ext_vector_type(2)));
typedef float f32x4 __attribute__((ext_vector_type(4)));
typedef short bf16x8 __attribute__((ext_vector_type(8)));
typedef unsigned long long u64;

constexpr int NB = 8, SEQ = 2048, DM = 2048, CTXL = 256;
constexpr int NT = NB * SEQ;
constexpr int NTC = NB * CTXL;
constexpr int MROWS = NT + NTC;
constexpr int DIN = 4128, DINP = 4352;
constexpr int NE = 64, TOPK = 8, DE = 512;
constexpr int NSLOT_E = NT * TOPK;
constexpr int SH_ROW0 = NSLOT_E + 256;
constexpr int NSLOT = SH_ROW0 + NT;
constexpr int NTILE_MAX = 704;
constexpr float EPS = 1e-6f;
constexpr int NPH = 12;

constexpr size_t MiB = 1u << 20;
constexpr size_t WS_CTL = 0, CTL_ZERO_BYTES = 64 * 1024;
constexpr size_t WS_MOD = 1 * MiB;
constexpr size_t WS_WRT = 1 * MiB + 512 * 1024;
constexpr size_t WS_WIN = 2 * MiB;
constexpr size_t WS_WOUT = WS_WIN + 17 * MiB;
constexpr size_t WS_WPOOL = WS_WOUT + 8 * MiB;
constexpr size_t WS_WD = WS_WPOOL + 1 * MiB;
constexpr size_t WS_WGU = WS_WD + 130 * MiB;
constexpr size_t WS_RA = WS_WGU + 260 * MiB;
constexpr size_t RA_H = WS_RA;
constexpr size_t RA_OF = WS_RA;
constexpr size_t RA_H2 = WS_RA;
constexpr size_t RA_Q = WS_RA + 128 * MiB;
constexpr size_t RA_K = RA_Q + 16 * MiB;
constexpr size_t RA_V = RA_K + 18 * MiB;
constexpr size_t RA_R = RA_V + 36 * MiB;
constexpr size_t RA_P = RA_R + 32 * MiB;
constexpr size_t RA_ALR = RA_P + 32 * MiB;
constexpr size_t RA_DPOOL = RA_ALR + 3 * MiB;
constexpr size_t RA_YMIX = RA_DPOOL + 32 * MiB;
constexpr size_t RA_Y1 = WS_RA + 128 * MiB;
constexpr size_t RA_END = RA_YMIX + 64 * MiB;
constexpr size_t WS_SLOTOUT = WS_WGU;
constexpr size_t WS_ACT = RA_END > WS_SLOTOUT + 578 * MiB ? RA_END : WS_SLOTOUT + 578 * MiB;
constexpr size_t WS_END = WS_ACT + 145 * MiB;
constexpr size_t PQG = WS_ACT;
constexpr size_t PAM = WS_ACT + 32 * MiB;
constexpr size_t PKD = WS_ACT + 96 * MiB;
constexpr size_t PDEC = WS_ACT + 132 * MiB;
constexpr size_t WS_T0 = WS_END;
constexpr size_t T_CNT = WS_T0;
constexpr size_t T_MASK = T_CNT + 65536;
constexpr size_t T_TOKW = T_MASK + 131072;
constexpr size_t T_TOKSLOT = T_TOKW + 524288;
constexpr size_t T_SLOTTOK = T_TOKSLOT + 524288;
constexpr size_t T_SLOTW = T_SLOTTOK + 655360;
constexpr size_t T_TILE = T_SLOTW + 655360;
constexpr size_t T_RSTD1 = (T_TILE + 16384 + 4095) / 4096 * 4096;
constexpr size_t WS_NEED = T_RSTD1 + (size_t)NT * 4;

constexpr int RING_BYTES = 131072;
constexpr int LDS_BYTES = 147456;
constexpr int LDS_MISC = LDS_BYTES - 256;
constexpr int RT_ROWB = 4112;
constexpr int RT_HI = 0;
constexpr int LDS_LOGIT = 32 * RT_ROWB;
constexpr int LDS_MASKS = LDS_LOGIT + 8192;
static_assert(LDS_MASKS + 512 <= LDS_MISC, "LDS map");

#define LDS_WAIT() asm volatile("s_waitcnt lgkmcnt(0)" ::: "memory")
#define LDS_BARRIER() do { asm volatile("s_waitcnt lgkmcnt(0)" ::: "memory"); __builtin_amdgcn_s_barrier(); asm volatile("" ::: "memory"); } while (0)
#define VM_WAIT() asm volatile("s_waitcnt vmcnt(0)" ::: "memory")

__device__ __forceinline__ unsigned f2bf(float f) { unsigned u = __builtin_bit_cast(unsigned, f); return (u + 0x7fffu + ((u >> 16) & 1u)) >> 16; }
__device__ __forceinline__ unsigned pk2(float lo, float hi) { return f2bf(lo) | (f2bf(hi) << 16); }
__device__ __forceinline__ float bflo(unsigned u) { return __builtin_bit_cast(float, u << 16); }
__device__ __forceinline__ float bfhi(unsigned u) { return __builtin_bit_cast(float, u & 0xffff0000u); }
__device__ __forceinline__ float bf1(bf16 b) { return __builtin_bit_cast(float, ((unsigned)b) << 16); }
__device__ __forceinline__ float wave_sum(float v) {
#pragma unroll
    for (int o = 1; o < 64; o <<= 1) v += __shfl_xor(v, o);
    return v;
}
__device__ __forceinline__ float silu_f(float x) { return x / (1.f + __expf(-x)); }

#define XB_TMO      128
#define XB_XCNT(j)  (256  + 64 * (j))
#define XB_XSUB(j)  (1280 + 64 * (j))
#define XB_XGEN(j)  (2304 + 64 * (j))
#define XB_TOP      3328
#define XB_TOPGEN   3392
#define XCD_BAR_WORDS 3456
#define XB_SPIN_CAP (1u << 18)

__device__ __forceinline__ unsigned xb_ld(unsigned* p)              { return __hip_atomic_load(p, __ATOMIC_RELAXED, __HIP_MEMORY_SCOPE_AGENT); }
__device__ __forceinline__ unsigned xb_add(unsigned* p, unsigned v) { return __hip_atomic_fetch_add(p, v, __ATOMIC_RELAXED, __HIP_MEMORY_SCOPE_AGENT); }
__device__ __forceinline__ unsigned xb_xcc_id() { return (unsigned)__builtin_amdgcn_s_getreg((3 << 11) | 20) & 0xFu; }
#define XB_SPIN(cond, bar) do { unsigned _sp = 0; while (cond) { __builtin_amdgcn_s_sleep(1); \
    if ((++_sp & 255u) == 0u) { if (xb_ld(&(bar)[XB_TMO])) break; if (_sp > XB_SPIN_CAP) { atomicAdd(&(bar)[XB_TMO], 1u); break; } } } } while (0)

struct XcdBarrier { unsigned* bar; unsigned x; volatile LAS unsigned* st; };

__device__ __forceinline__ XcdBarrier xcd_barrier_post(unsigned* bar, volatile LAS unsigned* st) {
    XcdBarrier b; b.bar = bar; b.x = xb_xcc_id(); b.st = st;
    if (threadIdx.x == 0) (void)xb_add(&bar[XB_XCNT(b.x)], 1u);
    return b;
}
__device__ __forceinline__ void xcd_barrier_complete(unsigned* bar, unsigned x, unsigned& nloc, unsigned& nx) {
    const unsigned G = gridDim.x * gridDim.y * gridDim.z;
    unsigned sum, cnt, mine, sp = 0u;
    for (;;) {
        sum = 0u; cnt = 0u; mine = 0u;
#pragma unroll
        for (unsigned j = 0; j < 16; ++j) { const unsigned c = xb_ld(&bar[XB_XCNT(j)]); sum += c; cnt += (c > 0u) ? 1u : 0u; mine = (j == x) ? c : mine; }
        if (sum == G) break;
        __builtin_amdgcn_s_sleep(1);
        if ((++sp & 255u) == 0u) { if (xb_ld(&bar[XB_TMO])) break; if (sp > XB_SPIN_CAP) { atomicAdd(&bar[XB_TMO], 1u); break; } }
    }
    nloc = mine > 0u ? mine : 1u; nx = cnt > 0u ? cnt : 1u;
}
__device__ __forceinline__ void xcd_barrier(const XcdBarrier& b) {
    asm volatile("s_waitcnt vmcnt(0)" ::: "memory");
    __syncthreads();
    if (threadIdx.x == 0) {
        unsigned* bar = b.bar;
        __builtin_amdgcn_s_waitcnt(0);
        unsigned nloc = b.st[0], nx = b.st[1];
        if (nloc == 0u) { xcd_barrier_complete(bar, b.x, nloc, nx); b.st[0] = nloc; b.st[1] = nx; }
        const unsigned old = xb_add(&bar[XB_XSUB(b.x)], 1u);
        const unsigned gen = old / nloc;
        if (old + 1u == (gen + 1u) * nloc) {
            __builtin_amdgcn_fence(__ATOMIC_RELEASE, "agent");
            asm volatile("s_waitcnt vmcnt(0)" ::: "memory");
            const unsigned og = xb_add(&bar[XB_TOP], 1u);
            const unsigned tg = og / nx;
            if (og + 1u == (tg + 1u) * nx) xb_add(&bar[XB_TOPGEN], 1u);
            else XB_SPIN(xb_ld(&bar[XB_TOPGEN]) == tg, bar);
            __builtin_amdgcn_fence(__ATOMIC_ACQUIRE, "agent");
            xb_add(&bar[XB_XGEN(b.x)], 1u);
            asm volatile("s_waitcnt vmcnt(0)" ::: "memory");
        } else {
            XB_SPIN(xb_ld(&bar[XB_XGEN(b.x)]) == gen, bar);
            __builtin_amdgcn_fence(__ATOMIC_ACQUIRE, "agent");
            asm volatile("s_waitcnt vmcnt(0)" ::: "memory");
        }
    }
    __syncthreads();
}

namespace pg8 {
constexpr int BM = 256, BK = 64, HALF = 128, HTB = HALF * BK * 2, STAGE_BYTES = 8 * HTB, NXCD = 8, WGM = 8;
__device__ __forceinline__ int lds_byte(int r, int c) { const int st = (r >> 4) * 2 + (c >> 5), rr = r & 15, cc = c & 31, ob = rr * 64 + cc * 2; return st * 1024 + (ob ^ (((ob >> 9) & 1) << 5)); }
__device__ __forceinline__ void stage_rc(int b, int& R, int& C) { const int st = b / 1024, sb = b % 1024, swz = sb ^ (((sb >> 9) & 1) << 5); R = (st >> 1) * 16 + swz / 64; C = (st & 1) * 32 + (swz % 64) / 2; }
__device__ __forceinline__ int perm32(int rho) { const int n = rho >> 4, i = rho & 15; return 8 * (i >> 2) + 4 * n + (i & 3); }
__device__ __forceinline__ unsigned cvt_pk_bf16(float lo, float hi) { unsigned r; asm volatile("v_cvt_pk_bf16_f32 %0, %1, %2" : "=v"(r) : "v"(lo), "v"(hi)); return r; }

typedef int v8i __attribute__((ext_vector_type(8)));
typedef int v4i __attribute__((ext_vector_type(4)));
template <class Epi, class Sched, bool FP8 = false>
__device__ __forceinline__ void gemm_phase(LAS unsigned char* lds, const int K, const Sched& S, const Epi& E) {
    typedef typename Sched::U Unit;
    const int tid = threadIdx.x, wid = __builtin_amdgcn_readfirstlane(tid >> 6), lane = tid & 63, wr = wid >> 2, wc = wid & 3, fr = lane & 15, fq = lane >> 4;
    const int nt = K / BK;
    int R[2], C[2]; unsigned voffB[2];
#pragma unroll
    for (int i = 0; i < 2; ++i) { stage_rc(tid * 16 + i * 8192, R[i], C[i]);
        const int Rb = Epi::PERMK == 2 ? (64 * (R[i] >> 5) + 16 * ((R[i] & 15) >> 2) + 4 * ((R[i] >> 4) & 1) + (R[i] & 3)) : (Epi::PERMK == 1 ? ((R[i] & ~31) + perm32(R[i] & 31)) : R[i]);
        voffB[i] = (unsigned)(Rb * K + C[i]) * 2u; }
    const size_t kstep = (size_t)(BK * 2);
    const size_t hstepB = (size_t)(Epi::PERMK == 2 ? 8 : HALF) * K * 2;
    const unsigned ldsw = (unsigned)wid * 1024u;
    const int aoff = lds_byte(wr * 64 + fr, fq * 8), boff = lds_byte(wc * 32 + fr, fq * 8);
#define PG8_SA(b, h) (((b) * 2 + (h)) * HTB)
#define PG8_SB(b, h) ((4 + (b) * 2 + (h)) * HTB)
#define PG8_STAGE(bufoff, gbase, v0, v1) do { \
        __builtin_amdgcn_global_load_lds((const unsigned*)((const char*)(gbase) + (v0)), (LAS unsigned*)(lds + (bufoff) + ldsw), 16, 0, 0); \
        __builtin_amdgcn_global_load_lds((const unsigned*)((const char*)(gbase) + (v1)), (LAS unsigned*)(lds + (bufoff) + ldsw + 8192), 16, 0, 0); } while (0)
#define PG8_LDA(dst, b, h) do { _Pragma("unroll") for (int m = 0; m < 4; ++m) { const v4i lo_ = *(const LAS v4i*)(lds + PG8_SA(b, h) + aoff + m * 2048), hi_ = *(const LAS v4i*)(lds + PG8_SA(b, h) + aoff + m * 2048 + 1024); \
        dst[m] = __builtin_shufflevector(lo_, hi_, 0, 1, 2, 3, 4, 5, 6, 7); } } while (0)
#define PG8_LDB(dst, b, h) do { _Pragma("unroll") for (int n = 0; n < 2; ++n) { const v4i lo_ = *(const LAS v4i*)(lds + PG8_SB(b, h) + boff + n * 2048), hi_ = *(const LAS v4i*)(lds + PG8_SB(b, h) + boff + n * 2048 + 1024); \
        dst[n] = __builtin_shufflevector(lo_, hi_, 0, 1, 2, 3, 4, 5, 6, 7); } } while (0)
#define PG8_H0(x) ((bf16x8)__builtin_shufflevector(x, x, 0, 1, 2, 3))
#define PG8_H1(x) ((bf16x8)__builtin_shufflevector(x, x, 4, 5, 6, 7))
#define PG8_MMA(ai, bj, At, Bt) do { __builtin_amdgcn_s_setprio(1); if constexpr (FP8) asm volatile("s_nop 4"); _Pragma("unroll") for (int m = 0; m < 4; ++m) _Pragma("unroll") for (int n = 0; n < 2; ++n) { \
        if constexpr (FP8) asm volatile("v_mfma_f32_16x16x128_f8f6f4 %0, %1, %2, %0" : "+v"(acc[ai][bj][m][n]) : "v"(Bt[n]), "v"(At[m])); \
        else { acc[ai][bj][m][n] = __builtin_amdgcn_mfma_f32_16x16x32_bf16(PG8_H0(Bt[n]), PG8_H0(At[m]), acc[ai][bj][m][n], 0, 0, 0); \
               acc[ai][bj][m][n] = __builtin_amdgcn_mfma_f32_16x16x32_bf16(PG8_H1(Bt[n]), PG8_H1(At[m]), acc[ai][bj][m][n], 0, 0, 0); } } \
        __builtin_amdgcn_s_setprio(0); } while (0)
#define PG8_WAIT_V(n) asm volatile("s_waitcnt vmcnt(" #n ")" ::: "memory")
#define PG8_WAIT_L(n) asm volatile("s_waitcnt lgkmcnt(" #n ")" ::: "memory")
#define PG8_BAR __builtin_amdgcn_s_barrier()
#define PG8_SCHED __builtin_amdgcn_sched_barrier(0)
    Unit cur, nxt; int ui = 0;
    if (!S.next(0, cur)) return;
    f32x4 acc[2][2][4][2];
#pragma unroll
    for (int a = 0; a < 2; ++a)
#pragma unroll
        for (int b = 0; b < 2; ++b)
#pragma unroll
            for (int m = 0; m < 4; ++m)
#pragma unroll
                for (int n = 0; n < 2; ++n) acc[a][b][m][n] = (f32x4){0.f, 0.f, 0.f, 0.f};
    v8i At[4], B0[2], B1[2];
    unsigned vA[4], vN[4];
    S.aoffs(cur, R, C, vA);
    const char* cA = cur.A; const char* cB = cur.B;
    PG8_STAGE(PG8_SB(0, 0), cB, voffB[0], voffB[1]); PG8_STAGE(PG8_SB(0, 1), cB + hstepB, voffB[0], voffB[1]); PG8_STAGE(PG8_SA(0, 0), cA, vA[0], vA[1]); PG8_STAGE(PG8_SA(0, 1), cA, vA[2], vA[3]);
    if (wr == 1) PG8_BAR;
    PG8_WAIT_V(2); PG8_BAR;
    PG8_STAGE(PG8_SB(1, 0), cB + kstep, voffB[0], voffB[1]); PG8_STAGE(PG8_SA(1, 0), cA + kstep, vA[0], vA[1]); PG8_STAGE(PG8_SB(1, 1), cB + hstepB + kstep, voffB[0], voffB[1]);
    PG8_WAIT_V(6); PG8_BAR;
    for (;;) {
        const bool has_next = S.next(ui + 1, nxt);
        const char* nA = has_next ? nxt.A : cA; const char* nB = has_next ? nxt.B : cB;
        if (has_next) S.aoffs(nxt, R, C, vN); else { vN[0] = vA[0]; vN[1] = vA[1]; vN[2] = vA[2]; vN[3] = vA[3]; }
        for (int t = 0; t < nt; t += 2) {
            const bool last = (t == nt - 2);
            const char* a1 = cA + (size_t)(t + 1) * kstep;
            const char* a2 = last ? nA : cA + (size_t)(t + 2) * kstep; const char* b2 = last ? nB : cB + (size_t)(t + 2) * kstep;
            const char* a3 = a2 + kstep; const char* b3 = b2 + kstep;
            const unsigned x0 = last ? vN[0] : vA[0], x1 = last ? vN[1] : vA[1], x2 = last ? vN[2] : vA[2], x3 = last ? vN[3] : vA[3];
            PG8_LDB(B0, 0, 0); PG8_LDB(B1, 0, 1); PG8_SCHED; PG8_LDA(At, 0, 0); PG8_STAGE(PG8_SA(1, 1), a1, vA[2], vA[3]);
            PG8_WAIT_V(8); PG8_WAIT_L(0); PG8_BAR; PG8_MMA(0, 0, At, B0); PG8_MMA(0, 1, At, B1); PG8_BAR; PG8_SCHED;
            PG8_LDA(At, 0, 1); PG8_STAGE(PG8_SB(0, 0), b2, voffB[0], voffB[1]); PG8_STAGE(PG8_SB(0, 1), b2 + hstepB, voffB[0], voffB[1]); PG8_STAGE(PG8_SA(0, 0), a2, x0, x1);
            PG8_WAIT_V(8); PG8_WAIT_L(0); PG8_BAR; PG8_MMA(1, 0, At, B0); PG8_MMA(1, 1, At, B1); PG8_BAR; PG8_SCHED;
            PG8_LDB(B0, 1, 0); PG8_LDB(B1, 1, 1); PG8_SCHED; PG8_LDA(At, 1, 0); PG8_STAGE(PG8_SA(0, 1), a2, x2, x3);
            PG8_WAIT_V(8); PG8_WAIT_L(0); PG8_BAR; PG8_MMA(0, 0, At, B0); PG8_MMA(0, 1, At, B1); PG8_BAR; PG8_SCHED;
            PG8_LDA(At, 1, 1); PG8_STAGE(PG8_SB(1, 0), b3, voffB[0], voffB[1]); PG8_STAGE(PG8_SB(1, 1), b3 + hstepB, voffB[0], voffB[1]); PG8_STAGE(PG8_SA(1, 0), a3, x0, x1);
            PG8_WAIT_V(8); PG8_WAIT_L(0); PG8_BAR; PG8_MMA(1, 0, At, B0); PG8_MMA(1, 1, At, B1); PG8_BAR; PG8_SCHED;
        }
        if (wr == 0) PG8_BAR;
        if constexpr (FP8) asm volatile("s_nop 15\n\ts_nop 15");
        { int tz = threadIdx.x; asm volatile("" : "+v"(tz));
          const int wid_ = tz >> 6, lane_ = tz & 63; E(acc, cur, wid_ >> 2, wid_ & 3, lane_ & 15, lane_ >> 4);
#ifdef PROBE_EPI2
          if constexpr (Epi::PROBE2) { asm volatile("" : "+v"(tz)); const int w2 = tz >> 6, l2 = tz & 63; E(acc, cur, w2 >> 2, w2 & 3, l2 & 15, l2 >> 4); }
#endif
#ifdef PROBE_DRAIN
          if constexpr (Epi::PROBE2) { asm volatile("s_waitcnt vmcnt(0)" ::: "memory"); }
#endif
        }
        if (!has_next) break;
#pragma unroll
        for (int a = 0; a < 2; ++a)
#pragma unroll
            for (int b = 0; b < 2; ++b)
#pragma unroll
                for (int m = 0; m < 4; ++m)
#pragma unroll
                    for (int n = 0; n < 2; ++n) acc[a][b][m][n] = (f32x4){0.f, 0.f, 0.f, 0.f};
        cur = nxt; cA = nA; cB = nB; ++ui;
        vA[0] = vN[0]; vA[1] = vN[1]; vA[2] = vN[2]; vA[3] = vN[3];
        if (wr == 1) PG8_BAR;
    }
    PG8_WAIT_V(0);
    PG8_BAR;
#undef PG8_SA
#undef PG8_SB
#undef PG8_STAGE
#undef PG8_LDA
#undef PG8_LDB
#undef PG8_H0
#undef PG8_H1
#undef PG8_MMA
#undef PG8_WAIT_V
#undef PG8_WAIT_L
#undef PG8_BAR
#undef PG8_SCHED
}
}

struct Args { const float* in[27]; float* out; unsigned char* ws; int ph_lo, ph_hi; };
static_assert(sizeof(Args) == 27 * 8 + 8 + 8 + 8, "Args has no padding");

struct DenseU { const char* A; const char* B; int pm, pn; };
struct DenseSched {
    typedef DenseU U;
    const char* A; const char* B; int lda, K, nM, nN, nwg, G, c;
    __device__ __forceinline__ void init(const void* A_, const void* B_, int lda_, int K_, int M, int N, int G_, int c_) { A = (const char*)A_; B = (const char*)B_; lda = lda_; K = K_; nM = M / 256; nN = N / 256; nwg = nM * nN; G = G_; c = c_; }
    __device__ __forceinline__ bool next(int i, U& u) const {
        const long L = (long)i * G + c; if (L >= nwg) return false;
        int wgid = (int)L; { const int q = nwg / 8, r = nwg % 8, xcd = wgid % 8, off = wgid / 8; wgid = (xcd < r ? xcd * (q + 1) : r * (q + 1) + (xcd - r) * q) + off; }
        const int nig = 8 * nN, gid = wgid / nig, fm = gid * 8, gsz = (nM - fm) < 8 ? (nM - fm) : 8;
        u.pm = fm + ((wgid % nig) % gsz); u.pn = (wgid % nig) / gsz;
        u.A = A + (size_t)u.pm * 256 * lda * 2; u.B = B + (size_t)u.pn * 256 * K * 2; return true;
    }
    __device__ __forceinline__ void aoffs(const U&, const int (&R)[2], const int (&C)[2], unsigned (&v)[4]) const {
#pragma unroll
        for (int h = 0; h < 2; ++h)
#pragma unroll
            for (int i = 0; i < 2; ++i) v[h * 2 + i] = (unsigned)((h * 128 + R[i]) * lda + C[i]) * 2u;
    }
};
struct PoolU { const char* A; const char* B; int pm, g; };
struct PoolSched {
    typedef PoolU U;
    const char* A; const char* B; int G, c;
    __device__ __forceinline__ bool next(int i, U& u) const {
        const int L = i * G + c; if (L >= 256) return false;
        u.g = L & 3; u.pm = L >> 2;
        u.A = A + ((size_t)u.pm * 256 * 1024 + u.g * 256) * 2; u.B = B + (size_t)u.g * 256 * 256 * 2; return true;
    }
    __device__ __forceinline__ void aoffs(const U&, const int (&R)[2], const int (&C)[2], unsigned (&v)[4]) const {
#pragma unroll
        for (int h = 0; h < 2; ++h)
#pragma unroll
            for (int i = 0; i < 2; ++i) v[h * 2 + i] = (unsigned)((h * 128 + R[i]) * 1024 + C[i]) * 2u;
    }
};
struct MoeU { const char* A; const char* B; int row0, nrows, pn; };
struct MoeGUSched {
    typedef MoeU U;
    const char* H2; const char* W; const int* tile; const int* slot_tok; int G, c;
    __device__ __forceinline__ bool next(int i, U& u) const {
        const int nt = tile[3 * NTILE_MAX]; const int L = i * G + c; if (L >= nt * 4) return false;
        const int t = L >> 2; u.pn = L & 3; const int e = tile[t]; u.row0 = tile[NTILE_MAX + t]; u.nrows = tile[2 * NTILE_MAX + t];
        u.A = H2; u.B = W + ((size_t)e * 1024 + u.pn * 256) * 2048; return true;
    }
    __device__ __forceinline__ void aoffs(const U& u, const int (&R)[2], const int (&C)[2], unsigned (&v)[4]) const {
#pragma unroll
        for (int h = 0; h < 2; ++h)
#pragma unroll
            for (int i = 0; i < 2; ++i) { int r = h * 128 + R[i]; r = r < u.nrows ? r : u.nrows - 1; const int tok = slot_tok[u.row0 + r]; v[h * 2 + i] = (unsigned)(tok * 1024 + C[i]) * 2u; }
    }
};
struct MoeDownSched {
    typedef MoeU U;
    const char* ACT; const char* W; const int* tile; int G, c;
    __device__ __forceinline__ bool next(int i, U& u) const {
        const int nt = tile[3 * NTILE_MAX]; const int L = i * G + c; if (L >= nt * 8) return false;
        const int t = L >> 3; u.pn = L & 7; const int e = tile[t]; u.row0 = tile[NTILE_MAX + t]; u.nrows = tile[2 * NTILE_MAX + t];
        u.A = ACT + (size_t)u.row0 * 512; u.B = W + ((size_t)e * 2048 + u.pn * 256) * 512; return true;
    }
    __device__ __forceinline__ void aoffs(const U&, const int (&R)[2], const int (&C)[2], unsigned (&v)[4]) const {
#pragma unroll
        for (int h = 0; h < 2; ++h)
#pragma unroll
            for (int i = 0; i < 2; ++i) v[h * 2 + i] = (unsigned)((h * 128 + R[i]) * 256 + C[i]) * 2u;
    }
};

struct EpiIn {
    static constexpr int PERMK = 1; static constexpr bool PROBE2 = false;
    unsigned char* ws;
    __device__ __forceinline__ void operator()(const f32x4 (&acc)[2][2][4][2], const DenseU& u, int wr, int wc, int fr, int fq) const {
        const int pn = u.pn; const int row0 = u.pm * 256 + wr * 64 + fr;
        if (pn == 16) {
            if (wc != 0) return;
            float* alr = (float*)(ws + RA_ALR);
#pragma unroll
            for (int ai = 0; ai < 2; ++ai)
#pragma unroll
                for (int m = 0; m < 4; ++m) { float* rp = alr + (size_t)(row0 + ai * 128 + m * 16) * 32 + 8 * fq;
                    *(f32x4*)(rp) = acc[ai][0][m][0]; *(f32x4*)(rp + 4) = acc[ai][0][m][1]; }
            return;
        }
        bf16* base; int ld, colt; bool lat_only;
        if (pn < 2) { base = (bf16*)(ws + RA_Q); ld = 512; colt = pn * 256; lat_only = true; }
        else if (pn < 4) { base = (bf16*)(ws + RA_K); ld = 512; colt = (pn - 2) * 256; lat_only = false; }
        else if (pn < 8) { base = (bf16*)(ws + RA_V); ld = 1024; colt = (pn - 4) * 256; lat_only = false; }
        else if (pn < 12) { base = (bf16*)(ws + RA_R); ld = 1024; colt = (pn - 8) * 256; lat_only = true; }
        else { base = (bf16*)(ws + RA_P); ld = 1024; colt = (pn - 12) * 256; lat_only = true; }
        if (lat_only && u.pm >= 64) return;
        const int col0 = colt + wc * 32 + 8 * fq;
#pragma unroll
        for (int ai = 0; ai < 2; ++ai)
#pragma unroll
            for (int m = 0; m < 4; ++m) { bf16* rp = base + (size_t)(row0 + ai * 128 + m * 16) * ld + col0;
#pragma unroll
                for (int bj = 0; bj < 2; ++bj) { const f32x4 v0 = acc[ai][bj][m][0], v1 = acc[ai][bj][m][1];
                    v4u o; o.x = pg8::cvt_pk_bf16(v0[0], v0[1]); o.y = pg8::cvt_pk_bf16(v0[2], v0[3]); o.z = pg8::cvt_pk_bf16(v1[0], v1[1]); o.w = pg8::cvt_pk_bf16(v1[2], v1[3]);
                    *(v4u*)(rp + bj * 128) = o; } }
    }
};
struct EpiPool {
    static constexpr int PERMK = 1; static constexpr bool PROBE2 = false;
    bf16* ymix; const float* scale;
    __device__ __forceinline__ void operator()(const f32x4 (&acc)[2][2][4][2], const PoolU& u, int wr, int wc, int fr, int fq) const {
        const int row0 = u.pm * 256 + wr * 64 + fr; const int c0 = u.g * 256 + wc * 32 + 8 * fq;
#pragma unroll
        for (int ai = 0; ai < 2; ++ai)
#pragma unroll
            for (int m = 0; m < 4; ++m) { bf16* rp = ymix + (size_t)(row0 + ai * 128 + m * 16) * 2048 + 1024 + c0;
#pragma unroll
                for (int bj = 0; bj < 2; ++bj) { const f32x4 s0 = *(const f32x4*)(scale + c0 + bj * 128), s1 = *(const f32x4*)(scale + c0 + bj * 128 + 4);
                    const f32x4 v0 = acc[ai][bj][m][0] * s0, v1 = acc[ai][bj][m][1] * s1;
                    v4u o; o.x = pg8::cvt_pk_bf16(v0[0], v0[1]); o.y = pg8::cvt_pk_bf16(v0[2], v0[3]); o.z = pg8::cvt_pk_bf16(v1[0], v1[1]); o.w = pg8::cvt_pk_bf16(v1[2], v1[3]);
                    *(v4u*)(rp + bj * 128) = o; } }
    }
};
struct EpiOut {
    static constexpr int PERMK = 1; static constexpr bool PROBE2 = false;
    bf16* y;
    __device__ __forceinline__ void operator()(const f32x4 (&acc)[2][2][4][2], const DenseU& u, int wr, int wc, int fr, int fq) const {
        const int row0 = u.pm * 256 + wr * 64 + fr, col0 = u.pn * 256 + wc * 32 + 8 * fq;
#pragma unroll
        for (int ai = 0; ai < 2; ++ai)
#pragma unroll
            for (int m = 0; m < 4; ++m) { bf16* rp = y + (size_t)(row0 + ai * 128 + m * 16) * 2048 + col0;
#pragma unroll
                for (int bj = 0; bj < 2; ++bj) { const f32x4 v0 = acc[ai][bj][m][0], v1 = acc[ai][bj][m][1];
                    v4u o; o.x = pg8::cvt_pk_bf16(v0[0], v0[1]); o.y = pg8::cvt_pk_bf16(v0[2], v0[3]); o.z = pg8::cvt_pk_bf16(v1[0], v1[1]); o.w = pg8::cvt_pk_bf16(v1[2], v1[3]);
                    *(v4u*)(rp + bj * 128) = o; } }
    }
};
constexpr float SC_W = 256.f, SC_H = 16.f, SC_A = 16.f;
__device__ __forceinline__ unsigned pk4_fp8(float a, float b, float c, float d) {
    a = fminf(fmaxf(a, -448.f), 448.f); b = fminf(fmaxf(b, -448.f), 448.f); c = fminf(fmaxf(c, -448.f), 448.f); d = fminf(fmaxf(d, -448.f), 448.f);
    unsigned w = 0; w = __builtin_amdgcn_cvt_pk_fp8_f32(a, b, w, false); w = __builtin_amdgcn_cvt_pk_fp8_f32(c, d, w, true); return w;
}
struct EpiGU {
    static constexpr int PERMK = 1; static constexpr bool PROBE2 = false;
    unsigned char* act; const float* slot_w;
    __device__ __forceinline__ void operator()(const f32x4 (&acc)[2][2][4][2], const MoeU& u, int wr, int wc, int fr, int fq) const {
        const int c0 = u.pn * 128 + wc * 32 + 8 * fq; constexpr float inv = 1.f / (SC_W * SC_H);
#pragma unroll
        for (int ai = 0; ai < 2; ++ai)
#pragma unroll
            for (int m = 0; m < 4; ++m) { const int r = ai * 128 + wr * 64 + m * 16 + fr;
                if (r < u.nrows) { const float w = slot_w[u.row0 + r] * SC_A; float o[8];
#pragma unroll
                    for (int n = 0; n < 2; ++n)
#pragma unroll
                        for (int j = 0; j < 4; ++j) { const float g = acc[ai][0][m][n][j] * inv, up = acc[ai][1][m][n][j] * inv; o[n * 4 + j] = silu_f(g) * up * w; }
                    v2u q; q.x = pk4_fp8(o[0], o[1], o[2], o[3]); q.y = pk4_fp8(o[4], o[5], o[6], o[7]);
                    *(v2u*)(act + (size_t)(u.row0 + r) * 512 + c0) = q; } }
    }
};
constexpr float SC_O = 32.f;
struct EpiDown {
    static constexpr int PERMK = 2; static constexpr bool PROBE2 = true;
    unsigned char* so;
    __device__ __forceinline__ void operator()(const f32x4 (&acc)[2][2][4][2], const MoeU& u, int wr, int wc, int fr, int fq) const {
        const int c0 = u.pn * 256 + wc * 64 + 16 * fq; constexpr float sc = SC_O / (SC_W * SC_A);
#pragma unroll
        for (int ai = 0; ai < 2; ++ai)
#pragma unroll
            for (int m = 0; m < 4; ++m) { const int r = ai * 128 + wr * 64 + m * 16 + fr;
                if (r < u.nrows) { const f32x4 a0 = acc[ai][0][m][0] * sc, a1 = acc[ai][0][m][1] * sc, b0 = acc[ai][1][m][0] * sc, b1 = acc[ai][1][m][1] * sc;
                    v4u o; o.x = pk4_fp8(a0[0], a0[1], a0[2], a0[3]); o.y = pk4_fp8(a1[0], a1[1], a1[2], a1[3]); o.z = pk4_fp8(b0[0], b0[1], b0[2], b0[3]); o.w = pk4_fp8(b1[0], b1[1], b1[2], b1[3]);
                    __builtin_nontemporal_store(o, (v4u*)(so + (size_t)(u.row0 + r) * 2048 + c0)); } }
    }
};

__device__ __forceinline__ void tr_item(const float* W, int ldn, bf16* WT, int Kd, int drow0, int k0, int n0, LAS float* scr, int lane) {
    f32x4 t[8];
#pragma unroll
    for (int i = 0; i < 8; ++i) t[i] = *(const f32x4*)(W + (size_t)(k0 + 8 * i + (lane >> 3)) * ldn + n0 + 4 * (lane & 7));
#pragma unroll
    for (int i = 0; i < 8; ++i) { LAS float* d = scr + (8 * i + (lane >> 3)) * 33 + 4 * (lane & 7); d[0] = t[i][0]; d[1] = t[i][1]; d[2] = t[i][2]; d[3] = t[i][3]; }
    LDS_WAIT(); asm volatile("" ::: "memory");
    const int c = lane & 7;
#pragma unroll
    for (int j = 0; j < 4; ++j) { const int n = (lane >> 3) + 8 * j; const LAS float* s = scr + (8 * c) * 33 + n;
        v4u o; o.x = pk2(s[0 * 33], s[1 * 33]); o.y = pk2(s[2 * 33], s[3 * 33]); o.z = pk2(s[4 * 33], s[5 * 33]); o.w = pk2(s[6 * 33], s[7 * 33]);
        *(v4u*)(WT + (size_t)(drow0 + n) * Kd + k0 + 8 * c) = o; }
    LDS_WAIT(); asm volatile("" ::: "memory");
}

__device__ __forceinline__ void tr_item8(const float* W, int ldn, unsigned char* WT, int Kd, int drow0, int k0, int n0, LAS float* scr, int lane) {
    f32x4 t[8];
#pragma unroll
    for (int i = 0; i < 8; ++i) t[i] = *(const f32x4*)(W + (size_t)(k0 + 8 * i + (lane >> 3)) * ldn + n0 + 4 * (lane & 7));
#pragma unroll
    for (int i = 0; i < 8; ++i) { LAS float* d = scr + (8 * i + (lane >> 3)) * 33 + 4 * (lane & 7); d[0] = t[i][0]; d[1] = t[i][1]; d[2] = t[i][2]; d[3] = t[i][3]; }
    LDS_WAIT(); asm volatile("" ::: "memory");
    const int c = lane & 7;
#pragma unroll
    for (int j = 0; j < 4; ++j) { const int n = (lane >> 3) + 8 * j; const LAS float* s = scr + (8 * c) * 33 + n;
        v2u o; o.x = pk4_fp8(s[0 * 33] * SC_W, s[1 * 33] * SC_W, s[2 * 33] * SC_W, s[3 * 33] * SC_W); o.y = pk4_fp8(s[4 * 33] * SC_W, s[5 * 33] * SC_W, s[6 * 33] * SC_W, s[7 * 33] * SC_W);
        *(v2u*)(WT + (size_t)(drow0 + n) * Kd + k0 + 8 * c) = o; }
    LDS_WAIT(); asm volatile("" ::: "memory");
}

__device__ __forceinline__ void phase0(const Args& a, LAS unsigned char* lds, int tid, int lane, int wave, int vcu, int G, bool do_mod = true, bool do_tr = true) {
    unsigned char* ws = a.ws;
    if (vcu < 192 && do_mod) {
        LAS float* sc = (LAS float*)lds;
        LAS float* red = (LAS float*)(lds + 73728);
        for (int i = tid; i < 9 * 2048; i += 512) { const int r = i >> 11, k = i & 2047; const float v = r < 8 ? a.in[1][r * 2048 + k] : a.in[3][k]; sc[i] = silu_f(v); }
        __syncthreads();
        const float* wm = a.in[4]; const float* bm = a.in[5]; float* mod = (float*)(ws + WS_MOD);
        for (int chunk = vcu; chunk < 192; chunk += G) {
            const int n0 = chunk * 64, ks = lane >> 4, n4 = (lane & 15) * 4;
            f32x4 acc[9];
#pragma unroll
            for (int r = 0; r < 9; ++r) acc[r] = (f32x4){0.f, 0.f, 0.f, 0.f};
#pragma unroll 4
            for (int kk = 0; kk < 256; kk += 4) { const int k = wave * 256 + kk + ks; const f32x4 wv = *(const f32x4*)(wm + (size_t)k * 12288 + n0 + n4);
#pragma unroll
                for (int r = 0; r < 9; ++r) { const float s = sc[r * 2048 + k]; acc[r] += wv * s; } }
#pragma unroll
            for (int r = 0; r < 9; ++r)
#pragma unroll
                for (int j = 0; j < 4; ++j) { float v = acc[r][j]; v += __shfl_xor(v, 16); v += __shfl_xor(v, 32); acc[r][j] = v; }
            if (lane < 16) {
#pragma unroll
                for (int r = 0; r < 9; ++r) *(LAS f32x4*)(red + (wave * 9 + r) * 64 + n4) = acc[r]; }
            __syncthreads();
            for (int i = tid; i < 9 * 64; i += 512) { const int r = i >> 6, n = i & 63; float s = 0.f;
#pragma unroll
                for (int w = 0; w < 8; ++w) s += red[(w * 9 + r) * 64 + n];
                mod[r * 12288 + n0 + n] = s + bm[n0 + n]; }
            __syncthreads();
        }
    }
    __syncthreads();
    LAS float* scr = (LAS float*)(lds + wave * 16384);
    const int gw = vcu * 8 + wave, NGW = G * 8;
    bf16* Win_t = (bf16*)(ws + WS_WIN); bf16* Wout_t = (bf16*)(ws + WS_WOUT); bf16* Wpool_t = (bf16*)(ws + WS_WPOOL); unsigned char* Wd_t = ws + WS_WD; unsigned char* Wgu_t = ws + WS_WGU;
    constexpr int I_IN = 32 * 129, I_OUT = 32 * 64, I_POOL = 4 * 4 * 8, I_E = 65 * 512;
    constexpr int NITEMS = I_IN + I_OUT + I_POOL + 3 * I_E;
    for (int it = gw; it < (do_tr ? NITEMS : 0); it += NGW) {
        int r = it;
        if (r < I_IN) { const int kb = r / 129, nb = r % 129, n0 = 32 * nb; const int drow = n0 < 3072 ? n0 : (n0 == 3072 ? 4096 : n0 - 32);
            tr_item(a.in[10], DIN, Win_t, 2048, drow, 64 * kb, n0, scr, lane); continue; } r -= I_IN;
        if (r < I_OUT) { const int kb = r / 64, nb = r % 64; tr_item(a.in[18], 2048, Wout_t, 2048, 32 * nb, 64 * kb, 32 * nb, scr, lane); continue; } r -= I_OUT;
        if (r < I_POOL) { const int g = r / 32, rr = r % 32, kb = rr / 8, nb = rr % 8; tr_item(a.in[16] + g * 65536, 256, Wpool_t + g * 65536, 256, 32 * nb, 64 * kb, 32 * nb, scr, lane); continue; } r -= I_POOL;
        if (r < I_E) { const int e = r / 512, rr = r % 512, kb = rr / 16, nb = rr % 16, n0 = 32 * nb; const float* src = e < 64 ? a.in[21] + (size_t)e * 2048 * 512 : a.in[24];
            tr_item8(src, 512, Wgu_t + (size_t)e * 1024 * 2048, 2048, (n0 / 128) * 256 + (n0 % 128), 64 * kb, n0, scr, lane); continue; } r -= I_E;
        if (r < I_E) { const int e = r / 512, rr = r % 512, kb = rr / 16, nb = rr % 16, n0 = 32 * nb; const float* src = e < 64 ? a.in[22] + (size_t)e * 2048 * 512 : a.in[25];
            tr_item8(src, 512, Wgu_t + (size_t)e * 1024 * 2048, 2048, (n0 / 128) * 256 + 128 + (n0 % 128), 64 * kb, n0, scr, lane); continue; } r -= I_E;
        { const int e = r / 512, rr = r % 512, kb = rr / 64, nb = rr % 64; const float* src = e < 64 ? a.in[23] + (size_t)e * 512 * 2048 : a.in[26];
            tr_item8(src, 2048, Wd_t + (size_t)e * 2048 * 512, 512, 32 * nb, 64 * kb, 32 * nb, scr, lane); }
    }
    { const float* wr = a.in[19]; bf16* whi = (bf16*)(ws + WS_WRT); bf16* wlo = whi + 64 * 2048;
      for (int idx = vcu * 512 + tid; idx < 64 * 256; idx += G * 512) { const int e = idx >> 8, k8 = idx & 255; unsigned hi[8], lo[8];
#pragma unroll
          for (int j = 0; j < 8; ++j) { const float v = wr[(size_t)(8 * k8 + j) * 64 + e]; hi[j] = f2bf(v); lo[j] = f2bf(v - __builtin_bit_cast(float, hi[j] << 16)); }
          v4u oh, ol; oh.x = hi[0] | (hi[1] << 16); oh.y = hi[2] | (hi[3] << 16); oh.z = hi[4] | (hi[5] << 16); oh.w = hi[6] | (hi[7] << 16);
          ol.x = lo[0] | (lo[1] << 16); ol.y = lo[2] | (lo[3] << 16); ol.z = lo[4] | (lo[5] << 16); ol.w = lo[6] | (lo[7] << 16);
          *(v4u*)(whi + (size_t)e * 2048 + 8 * k8) = oh; (void)ol; (void)wlo; } }
    { v4u* z = (v4u*)(Win_t + (size_t)DIN * 2048); const int nz = (DINP - DIN) * 2048 / 8;
      for (int i = vcu * 512 + tid; i < nz; i += G * 512) z[i] = (v4u){0u, 0u, 0u, 0u}; }
}

__device__ __forceinline__ void phase1(const Args& a, int lane, int wave, int vcu, int G) {
    const float* mod = (const float*)(a.ws + WS_MOD); bf16* H = (bf16*)(a.ws + RA_H); const float* g = a.in[6];
    for (int m = vcu * 8 + wave; m < MROWS; m += G * 8) {
        const float* xr = m < NT ? a.in[0] + (size_t)m * 2048 : a.in[2] + (size_t)(m - NT) * 2048;
        const float* mr = mod + (size_t)(m < NT ? (m >> 11) : 8) * 12288;
        f32x4 v[8]; float ss = 0.f;
#pragma unroll
        for (int j = 0; j < 8; ++j) { v[j] = *(const f32x4*)(xr + 4 * (lane + 64 * j)); ss += v[j][0] * v[j][0] + v[j][1] * v[j][1] + v[j][2] * v[j][2] + v[j][3] * v[j][3]; }
        const float rstd = rsqrtf(wave_sum(ss) * (1.f / 2048.f) + EPS);
#pragma unroll
        for (int j = 0; j < 8; ++j) { const int c = 4 * (lane + 64 * j); const f32x4 gg = *(const f32x4*)(g + c), sh = *(const f32x4*)(mr + c), sc = *(const f32x4*)(mr + 2048 + c);
            const f32x4 o = v[j] * rstd * gg * (sc + 1.f) + sh;
            v2u q; q.x = pk2(o[0], o[1]); q.y = pk2(o[2], o[3]); *(v2u*)(H + (size_t)m * 2048 + c) = q; }
    }
}

__device__ __forceinline__ int scan_row(int b, int dir, int s) {
    if (s < 256) { const int tc = dir ? 255 - s : s; return NT + b * 256 + tc; }
    const int t0 = s - 256; return b * 2048 + (dir ? 2047 - t0 : t0);
}
__device__ __forceinline__ void prep_item(const Args& a, LAS unsigned char* lds, int tid, int dir, int b, int ch) {
    unsigned char* ws = a.ws;
    const bf16* Q = (const bf16*)(ws + RA_Q); const bf16* Kb = (const bf16*)(ws + RA_K); const float* ALR = (const float*)(ws + RA_ALR);
    v4u* QG = (v4u*)(ws + PQG); bf16* AM = (bf16*)(ws + PAM); bf16* KD = (bf16*)(ws + PKD); float* DEC = (float*)(ws + PDEC);
    constexpr int TS = 520;
    LAS float* alr = (LAS float*)lds;
    LAS bf16* Kt = (LAS bf16*)(lds + 4096);
    LAS bf16* Qt = (LAS bf16*)(lds + 4096 + 64 * TS * 2);
    const int col = tid, h = col >> 7, dk = col & 127;
    const int lane = tid & 63, wave = __builtin_amdgcn_readfirstlane(tid >> 6), l15 = lane & 15, l4 = lane >> 4;
    const bool lat = ch >= 4;
    if (tid < 256) { const int i = tid >> 2, r4 = (tid & 3) * 4; const int row = scan_row(b, dir, ch * 64 + i);
        *(LAS f32x4*)(alr + i * 16 + r4) = *(const f32x4*)(ALR + (size_t)row * 32 + dir * 16 + r4); }
    { v4u kr[8], qr[8];
#pragma unroll
      for (int q = 0; q < 8; ++q) { const int p = tid + 512 * q, i = p >> 6, c8 = (p & 63) * 8; const int row = scan_row(b, dir, ch * 64 + i);
          kr[q] = *(const v4u*)(Kb + (size_t)row * 512 + c8); if (lat) qr[q] = *(const v4u*)(Q + (size_t)row * 512 + c8); }
#pragma unroll
      for (int q = 0; q < 8; ++q) { const int p = tid + 512 * q, i = p >> 6, c8 = (p & 63) * 8; *(LAS v4u*)(Kt + i * TS + c8) = kr[q]; if (lat) *(LAS v4u*)(Qt + i * TS + c8) = qr[q]; } }
    const float* wa2 = dir ? a.in[13] : a.in[11]; const float bia = (dir ? a.in[14] : a.in[12])[col];
    float w[16];
#pragma unroll
    for (int r = 0; r < 16; ++r) w[r] = wa2[r * 512 + col];
    LDS_BARRIER();
    float Gv[64]; float Gc = 0.f;
#pragma unroll
    for (int i = 0; i < 64; ++i) { float z = bia;
#pragma unroll
        for (int r4 = 0; r4 < 4; ++r4) { const f32x4 x = *(const LAS f32x4*)(alr + i * 16 + 4 * r4); z += x[0] * w[4 * r4] + x[1] * w[4 * r4 + 1] + x[2] * w[4 * r4 + 2] + x[3] * w[4 * r4 + 3]; }
        Gc += (fminf(z, 0.f) - __logf(1.f + __expf(-fabsf(z)))) * (1.f / 16.f); Gv[i] = Gc; }
    const float Gmid = Gv[32], Gend = Gv[63];
    DEC[((size_t)(dir * 8 + b) * 36 + ch) * 512 + col] = __expf(Gend);
    bf16* kdrow = KD + ((((size_t)(dir * 8 + b) * 36 + ch) * 4 + h) * 128 + dk) * 64;
#pragma unroll
    for (int i0 = 0; i0 < 64; i0 += 8) { unsigned kd[8];
#pragma unroll
        for (int ii = 0; ii < 8; ++ii) { const int i = i0 + ii; const float kv = bf1(Kt[i * TS + col]);
            kd[ii] = f2bf(kv * __expf(Gend - Gv[i]));
            if (lat) { const float qv = bf1(Qt[i * TS + col]) * 0.08838834764831845f;
                Qt[i * TS + col] = (bf16)f2bf(qv * __expf(Gv[i] - Gmid)); Kt[i * TS + col] = (bf16)f2bf(kv * __expf(Gmid - Gv[i])); } }
        v4u o; o.x = kd[0] | (kd[1] << 16); o.y = kd[2] | (kd[3] << 16); o.z = kd[4] | (kd[5] << 16); o.w = kd[6] | (kd[7] << 16);
        *(v4u*)(kdrow + i0) = o; }
    if (lat) {
        LDS_BARRIER();
        const int hh = wave >> 1; bf16* amt = AM + ((((size_t)(dir * 8 + b) * 32 + (ch - 4)) * 4 + hh) * 64) * 64;
#pragma unroll
        for (int t2 = 0; t2 < 2; ++t2) { const int ti = (wave & 1) * 2 + t2; f32x4 c[4];
#pragma unroll
            for (int tj = 0; tj < 4; ++tj) c[tj] = (f32x4){0.f, 0.f, 0.f, 0.f};
#pragma unroll
            for (int ks = 0; ks < 4; ++ks) { const int ko = hh * 128 + 32 * ks + 8 * l4;
                const bf16x8 bq = *(const LAS bf16x8*)(Qt + (16 * ti + l15) * TS + ko);
#pragma unroll
                for (int tj = 0; tj < 4; ++tj) { const bf16x8 ak = *(const LAS bf16x8*)(Kt + (16 * tj + l15) * TS + ko);
                    c[tj] = __builtin_amdgcn_mfma_f32_16x16x32_bf16(ak, bq, c[tj], 0, 0, 0); } }
            const int i = 16 * ti + l15;
#pragma unroll
            for (int tj = 0; tj < 4; ++tj) { const int j0 = 16 * tj + 4 * l4;
                v2u p; p.x = pk2(j0 <= i ? c[tj][0] : 0.f, j0 + 1 <= i ? c[tj][1] : 0.f); p.y = pk2(j0 + 2 <= i ? c[tj][2] : 0.f, j0 + 3 <= i ? c[tj][3] : 0.f);
                *(v2u*)(amt + i * 64 + j0) = p; } }
        LDS_BARRIER();
        { const float eg = __expf(Gmid);
#pragma unroll 8
          for (int i = 0; i < 64; ++i) Qt[i * TS + col] = (bf16)f2bf(bf1(Qt[i * TS + col]) * eg); }
        LDS_BARRIER();
        { v4u* qgt = QG + ((((size_t)(dir * 8 + b) * 32 + (ch - 4)) * 4) * 1024);
#pragma unroll
          for (int q = 0; q < 8; ++q) { const int p = tid + 512 * q; const int hq = p >> 10, rem = p & 1023, i = rem >> 4, c16 = rem & 15;
              qgt[p] = *(const LAS v4u*)(Qt + i * TS + hq * 128 + c16 * 8); } }
    }
    LDS_BARRIER();
}
__device__ __forceinline__ void phase3_prep(const Args& a, LAS unsigned char* lds, int tid, int vcu, int G) {
    for (int item = vcu; item < 2 * 8 * 32; item += G) { const int lc = item & 31, b = (item >> 5) & 7, dir = item >> 8; prep_item(a, lds, tid, dir, b, 4 + lc); }
    for (int item = vcu; item < 2 * 8 * 4; item += G) { const int cc = item & 3, b = (item >> 2) & 7, dir = item >> 5; prep_item(a, lds, tid, dir, b, cc); }
}

constexpr int GL_QG = 0, GL_ST = 17408, GL_KDT = 34816, GL_VT = 53248, GL_AM = 62464, GL_DEC = 71680;
__device__ __forceinline__ void phase_chain(const Args& a, LAS unsigned char* lds, int tid, int lane, int wave, int vcu, int G) {
    unsigned char* ws = a.ws;
    const v4u* QG = (const v4u*)(ws + PQG); const v4u* AM = (const v4u*)(ws + PAM); const v4u* KD = (const v4u*)(ws + PKD); const float* DEC = (const float*)(ws + PDEC);
    const bf16* V = (const bf16*)(ws + RA_V); bf16* OF = (bf16*)(ws + RA_OF);
    const int l15 = lane & 15, l4 = lane >> 4;
    for (int item = vcu; item < 256; item += G) {
        const int vs = item & 3, dir = (item >> 2) & 1, h = (item >> 3) & 3, b = item >> 5;
        f32x4 S[4];
#pragma unroll
        for (int tv = 0; tv < 4; ++tv) S[tv] = (f32x4){0.f, 0.f, 0.f, 0.f};
        v4u rqA[2], raA, rkA[2], rvA, rqB[2], raB, rkB[2], rvB; float rdecA = 0.f, rdecB = 0.f;
#define GL_LOAD(ch_, LATL, rq, ra, rk, rv, rdec) do { const int ch__ = (ch_); \
            if (LATL) { const size_t t_ = ((((size_t)(dir * 8 + b) * 32 + (ch__ - 4)) * 4 + h) * 1024); rq[0] = QG[t_ + tid]; rq[1] = QG[t_ + tid + 512]; ra = AM[t_ / 2 + tid]; } \
            { const size_t t_ = ((((size_t)(dir * 8 + b) * 36 + ch__) * 4 + h) * 1024); rk[0] = KD[t_ + tid]; rk[1] = KD[t_ + tid + 512]; } \
            { const int row_ = scan_row(b, dir, ch__ * 64 + (tid >> 3)); rv = *(const v4u*)(V + (size_t)row_ * 1024 + h * 256 + vs * 64 + 8 * (tid & 7)); } \
            rdec = DEC[((size_t)(dir * 8 + b) * 36 + ch__) * 512 + h * 128 + (tid & 127)]; } while (0)
#define GL_STEP(ch_, LAT, LATN, MORE, rq, ra, rk, rv, rdec) do { const int ch = (ch_); \
              \
            _Pragma("unroll") for (int tv = 0; tv < 4; ++tv) { v2u p; p.x = pk2(S[tv][0], S[tv][1]); p.y = pk2(S[tv][2], S[tv][3]); \
                *(LAS v2u*)(lds + GL_ST + (16 * tv + l15) * 272 + (16 * wave + 4 * l4) * 2) = p; } \
            if (LAT) { _Pragma("unroll") for (int q = 0; q < 2; ++q) { const int p = tid + 512 * q; *(LAS v4u*)(lds + GL_QG + (p >> 4) * 272 + (p & 15) * 16) = rq[q]; } \
                *(LAS v4u*)(lds + GL_AM + (tid >> 3) * 144 + (tid & 7) * 16) = ra; } \
            _Pragma("unroll") for (int q = 0; q < 2; ++q) { const int p = tid + 512 * q; *(LAS v4u*)(lds + GL_KDT + (p >> 3) * 144 + (p & 7) * 16) = rk[q]; } \
            { const int i = tid >> 3, c = tid & 7; LAS bf16* vt = (LAS bf16*)(lds + GL_VT) + i; \
              vt[(8 * c + 0) * 72] = (bf16)(rv.x & 0xffffu); vt[(8 * c + 1) * 72] = (bf16)(rv.x >> 16); vt[(8 * c + 2) * 72] = (bf16)(rv.y & 0xffffu); vt[(8 * c + 3) * 72] = (bf16)(rv.y >> 16); \
              vt[(8 * c + 4) * 72] = (bf16)(rv.z & 0xffffu); vt[(8 * c + 5) * 72] = (bf16)(rv.z >> 16); vt[(8 * c + 6) * 72] = (bf16)(rv.w & 0xffffu); vt[(8 * c + 7) * 72] = (bf16)(rv.w >> 16); } \
            if (tid < 128) *(LAS float*)(lds + GL_DEC + tid * 4) = rdec; \
            LDS_BARRIER(); \
            if (MORE) GL_LOAD(ch + 2, LATN, rq, ra, rk, rv, rdec); \
            if (LAT) {   \
                const int ti = wave >> 1, tv0 = (wave & 1) * 2; f32x4 c0 = (f32x4){0.f, 0.f, 0.f, 0.f}, c1 = c0; bf16x8 fb[6], f0[6], f1[6]; \
                _Pragma("unroll") for (int ks = 0; ks < 4; ++ks) { const int ko = (32 * ks + 8 * l4) * 2; \
                    fb[ks] = *(const LAS bf16x8*)(lds + GL_QG + (16 * ti + l15) * 272 + ko); \
                    f0[ks] = *(const LAS bf16x8*)(lds + GL_ST + (16 * tv0 + l15) * 272 + ko); f1[ks] = *(const LAS bf16x8*)(lds + GL_ST + (16 * tv0 + 16 + l15) * 272 + ko); } \
                _Pragma("unroll") for (int ks = 0; ks < 2; ++ks) { const int ko = (32 * ks + 8 * l4) * 2; \
                    fb[4 + ks] = *(const LAS bf16x8*)(lds + GL_AM + (16 * ti + l15) * 144 + ko); \
                    f0[4 + ks] = *(const LAS bf16x8*)(lds + GL_VT + (16 * tv0 + l15) * 144 + ko); f1[4 + ks] = *(const LAS bf16x8*)(lds + GL_VT + (16 * tv0 + 16 + l15) * 144 + ko); } \
                _Pragma("unroll") for (int ks = 0; ks < 6; ++ks) { c0 = __builtin_amdgcn_mfma_f32_16x16x32_bf16(f0[ks], fb[ks], c0, 0, 0, 0); c1 = __builtin_amdgcn_mfma_f32_16x16x32_bf16(f1[ks], fb[ks], c1, 0, 0, 0); } \
                const int s_ = ch * 64 + 16 * ti + l15; const int t0 = s_ - 256; const int t = dir ? 2047 - t0 : t0; \
                bf16* orow = OF + ((size_t)dir * NT + b * 2048 + t) * 1024 + h * 256 + vs * 64 + 16 * tv0 + 4 * l4; \
                v2u p0, p1; p0.x = pk2(c0[0], c0[1]); p0.y = pk2(c0[2], c0[3]); p1.x = pk2(c1[0], c1[1]); p1.y = pk2(c1[2], c1[3]); \
                *(v2u*)(orow) = p0; *(v2u*)(orow + 16) = p1; } \
              \
            { const f32x4 d4 = *(const LAS f32x4*)(lds + GL_DEC + (16 * wave + 4 * l4) * 4); bf16x8 fk[2], fv[2][4]; \
              _Pragma("unroll") for (int ks = 0; ks < 2; ++ks) { const int ko = (32 * ks + 8 * l4) * 2; fk[ks] = *(const LAS bf16x8*)(lds + GL_KDT + (16 * wave + l15) * 144 + ko); \
                  _Pragma("unroll") for (int tv = 0; tv < 4; ++tv) fv[ks][tv] = *(const LAS bf16x8*)(lds + GL_VT + (16 * tv + l15) * 144 + ko); } \
              _Pragma("unroll") for (int tv = 0; tv < 4; ++tv) S[tv] = S[tv] * d4; \
              _Pragma("unroll") for (int ks = 0; ks < 2; ++ks) \
                  _Pragma("unroll") for (int tv = 0; tv < 4; ++tv) S[tv] = __builtin_amdgcn_mfma_f32_16x16x32_bf16(fk[ks], fv[ks][tv], S[tv], 0, 0, 0); } \
            LDS_BARRIER(); } while (0)
        GL_LOAD(0, false, rqA, raA, rkA, rvA, rdecA); GL_LOAD(1, false, rqB, raB, rkB, rvB, rdecB);
        GL_STEP(0, false, false, true, rqA, raA, rkA, rvA, rdecA); GL_STEP(1, false, false, true, rqB, raB, rkB, rvB, rdecB);
        GL_STEP(2, false, true, true, rqA, raA, rkA, rvA, rdecA);  GL_STEP(3, false, true, true, rqB, raB, rkB, rvB, rdecB);
#pragma unroll 1
        for (int c2 = 4; c2 < 34; c2 += 2) { GL_STEP(c2, true, true, true, rqA, raA, rkA, rvA, rdecA); GL_STEP(c2 + 1, true, true, true, rqB, raB, rkB, rvB, rdecB); }
        GL_STEP(34, true, true, false, rqA, raA, rkA, rvA, rdecA); GL_STEP(35, true, true, false, rqB, raB, rkB, rvB, rdecB);
#undef GL_STEP
#undef GL_LOAD
    }
}

template <int HALFW>
__device__ __forceinline__ void pool_item(const bf16* P, bf16* DP, LAS float* tmp, int tid, int b, int r, int g) {
    const int rlo = r - HALFW < 0 ? 0 : r - HALFW, rhi = r + HALFW > 32 ? 32 : r + HALFW;
    const float rinv = 1.f / (float)(rhi - rlo);
#pragma unroll 1
    for (int q = 0; q < 4; ++q) { const int p = tid + 512 * q, c = p >> 5, ch0 = (p & 31) * 8; float acc[8]; v4u x[2 * HALFW];
#pragma unroll
        for (int u = 0; u < 2 * HALFW; ++u) { const int rr = (rlo + u < rhi) ? rlo + u : rlo; x[u] = *(const v4u*)(P + ((size_t)(b * 2048 + rr * 64 + c)) * 1024 + g * 256 + ch0); }
#pragma unroll
        for (int j = 0; j < 8; ++j) acc[j] = 0.f;
#pragma unroll
        for (int u = 0; u < 2 * HALFW; ++u) { const float m = (rlo + u < rhi) ? 1.f : 0.f;
            acc[0] += m * bflo(x[u].x); acc[1] += m * bfhi(x[u].x); acc[2] += m * bflo(x[u].y); acc[3] += m * bfhi(x[u].y); acc[4] += m * bflo(x[u].z); acc[5] += m * bfhi(x[u].z); acc[6] += m * bflo(x[u].w); acc[7] += m * bfhi(x[u].w); }
        *(LAS f32x4*)(tmp + c * 256 + ch0) = (f32x4){acc[0] * rinv, acc[1] * rinv, acc[2] * rinv, acc[3] * rinv};
        *(LAS f32x4*)(tmp + c * 256 + ch0 + 4) = (f32x4){acc[4] * rinv, acc[5] * rinv, acc[6] * rinv, acc[7] * rinv}; }
    __syncthreads();
#pragma unroll 1
    for (int q = 0; q < 4; ++q) { const int p = tid + 512 * q, c = p >> 5, ch0 = (p & 31) * 8;
        const int clo = c - HALFW < 0 ? 0 : c - HALFW, chi = c + HALFW > 64 ? 64 : c + HALFW; const float cinv = 1.f / (float)(chi - clo);
        const size_t o = ((size_t)(b * 2048 + r * 64 + c)) * 1024 + g * 256 + ch0;
        const v4u x = *(const v4u*)(P + o);
        f32x4 a0 = (f32x4){0.f, 0.f, 0.f, 0.f}, a1 = a0;
#pragma unroll
        for (int u = 0; u < 2 * HALFW; ++u) { const int cc = (clo + u < chi) ? clo + u : clo; const float m = (clo + u < chi) ? 1.f : 0.f;
            a0 += *(const LAS f32x4*)(tmp + cc * 256 + ch0) * m; a1 += *(const LAS f32x4*)(tmp + cc * 256 + ch0 + 4) * m; }
        v4u d; d.x = pk2(a0[0] * cinv - bflo(x.x), a0[1] * cinv - bfhi(x.x)); d.y = pk2(a0[2] * cinv - bflo(x.y), a0[3] * cinv - bfhi(x.y));
        d.z = pk2(a1[0] * cinv - bflo(x.z), a1[1] * cinv - bfhi(x.z)); d.w = pk2(a1[2] * cinv - bflo(x.w), a1[3] * cinv - bfhi(x.w));
        *(v4u*)(DP + o) = d; }
    __syncthreads();
}
__device__ __forceinline__ void phase3_pool(const Args& a, LAS unsigned char* lds, int tid, int vcu, int G) {
    const bf16* P = (const bf16*)(a.ws + RA_P); bf16* DP = (bf16*)(a.ws + RA_DPOOL);
    LAS float* tmp = (LAS float*)lds;
    for (int item = vcu; item < 1024; item += G) {
        const int g = item >> 8, r = (item >> 3) & 31, b = item & 7;
        const int gg = 3 - g;
        if (gg == 0) pool_item<1>(P, DP, tmp, tid, b, r, gg); else if (gg == 1) pool_item<2>(P, DP, tmp, tid, b, r, gg); else if (gg == 2) pool_item<4>(P, DP, tmp, tid, b, r, gg); else pool_item<8>(P, DP, tmp, tid, b, r, gg);
    }
}

__device__ __forceinline__ void phase4_post(const Args& a, int lane, int wave, int vcu, int G) {
    const bf16* OF = (const bf16*)(a.ws + RA_OF); const bf16* OB = OF + (size_t)NT * 1024; const bf16* Rr = (const bf16*)(a.ws + RA_R); bf16* Y = (bf16*)(a.ws + RA_YMIX);
    const float* gn = a.in[15];
    for (int idx = vcu * 8 + wave; idx < NT * 4; idx += G * 8) {
        const int t = idx >> 2, h = idx & 3; const size_t o = (size_t)t * 1024 + h * 256 + 4 * lane;
        const v2u of = *(const v2u*)(OF + o), ob = *(const v2u*)(OB + o);
        const f32x4 x = (f32x4){bflo(of.x) + bflo(ob.x), bfhi(of.x) + bfhi(ob.x), bflo(of.y) + bflo(ob.y), bfhi(of.y) + bfhi(ob.y)};
        const float ms = wave_sum(x[0] * x[0] + x[1] * x[1] + x[2] * x[2] + x[3] * x[3]) * (1.f / 256.f);
        const float sc = rsqrtf(ms + EPS);
        const f32x4 g4 = *(const f32x4*)(gn + h * 256 + 4 * lane);
        const v2u rr = *(const v2u*)(Rr + o);
        const float r0 = bflo(rr.x), r1 = bfhi(rr.x), r2 = bflo(rr.y), r3 = bfhi(rr.y);
        v2u q; q.x = pk2(x[0] * sc * g4[0] * silu_f(r0), x[1] * sc * g4[1] * silu_f(r1)); q.y = pk2(x[2] * sc * g4[2] * silu_f(r2), x[3] * sc * g4[3] * silu_f(r3));
        *(v2u*)(Y + (size_t)t * 2048 + h * 256 + 4 * lane) = q;
    }
}

__device__ __forceinline__ void phase6(const Args& a, LAS unsigned char* lds, int tid, int lane, int wave, int vcu, int G) {
    unsigned char* ws = a.ws;
    const float* mod = (const float*)(ws + WS_MOD); const bf16* Y1 = (const bf16*)(ws + RA_Y1); unsigned char* H2 = ws + RA_H2;
    const float* gpost = a.in[7]; const float* gpre2 = a.in[8]; const float* rbias = a.in[20];
    const bf16* whi = (const bf16*)(ws + WS_WRT);
    LAS float* part = (LAS float*)lds;
    LAS float* logit = (LAS float*)(lds + LDS_LOGIT);
    LAS u64* masks = (LAS u64*)(lds + LDS_MASKS);
    int* cnt = (int*)(ws + T_CNT); u64* tmask = (u64*)(ws + T_MASK); float* tokw = (float*)(ws + T_TOKW);
    const int l15 = lane & 15, l4 = lane >> 4;
    for (int blk = vcu; blk < NT / 64; blk += G) {
        for (int it = 0; it < 2; ++it) {
#pragma unroll 1
            for (int rep_ = 0; rep_ < P7_REP_ROWS; ++rep_) {
#pragma unroll 1
            for (int rr = 0; rr < 4; ++rr) {
                const int lr = wave * 4 + rr, t = blk * 64 + it * 32 + lr; const float* mr = mod + (size_t)(t >> 11) * 12288;
                const bf16* yr = Y1 + (size_t)t * 2048; const float* xr = a.in[0] + (size_t)t * 2048;
                f32x4 y[8]; float ss = 0.f;
#pragma unroll
                for (int j = 0; j < 8; ++j) { const v2u yb = *(const v2u*)(yr + 4 * (lane + 64 * j)); y[j] = (f32x4){bflo(yb.x), bfhi(yb.x), bflo(yb.y), bfhi(yb.y)}; ss += y[j][0] * y[j][0] + y[j][1] * y[j][1] + y[j][2] * y[j][2] + y[j][3] * y[j][3]; }
                const float rstd1 = rsqrtf(wave_sum(ss) * (1.f / 2048.f) + EPS);
                if (lane == 0) ((float*)(ws + T_RSTD1))[t] = rstd1;
                float s2 = 0.f;
#pragma unroll
                for (int j = 0; j < 8; ++j) { const int c = 4 * (lane + 64 * j); const f32x4 x = *(const f32x4*)(xr + c), gp = *(const f32x4*)(gpost + c), gt = *(const f32x4*)(mr + 4096 + c);
                    const f32x4 x1 = x + gt * (y[j] * rstd1 * gp); y[j] = x1;
                    s2 += x1[0] * x1[0] + x1[1] * x1[1] + x1[2] * x1[2] + x1[3] * x1[3]; }
                const float rstd2 = rsqrtf(wave_sum(s2) * (1.f / 2048.f) + EPS);
#pragma unroll
                for (int j = 0; j < 8; ++j) { const int c = 4 * (lane + 64 * j); const f32x4 g2 = *(const f32x4*)(gpre2 + c), sh = *(const f32x4*)(mr + 6144 + c), sc = *(const f32x4*)(mr + 8192 + c);
                    const f32x4 hh = y[j] * rstd2 * g2 * (sc + 1.f) + sh;
                    v2u qh; qh.x = pk2(hh[0], hh[1]); qh.y = pk2(hh[2], hh[3]);
                    *(LAS v2u*)(lds + RT_HI + lr * RT_ROWB + c * 2) = qh;
                    *(unsigned*)(H2 + (size_t)t * 2048 + c) = pk4_fp8(hh[0] * SC_H, hh[1] * SC_H, hh[2] * SC_H, hh[3] * SC_H); }
            }
            __syncthreads();
            }
            { f32x4 acc[2][4];
#pragma unroll
              for (int mt = 0; mt < 2; ++mt)
#pragma unroll
                  for (int et = 0; et < 4; ++et) acc[mt][et] = (f32x4){0.f, 0.f, 0.f, 0.f};
#pragma unroll 1
              for (int kh = 0; kh < 2; ++kh) {
                  bf16x8 bh[4][4];
#pragma unroll
                  for (int k4 = 0; k4 < 4; ++k4) { const int k0 = 256 * wave + 32 * (4 * kh + k4) + 8 * l4;
#pragma unroll
                      for (int et = 0; et < 4; ++et) bh[k4][et] = *(const bf16x8*)(whi + (size_t)(16 * et + l15) * 2048 + k0); }
#pragma unroll
                  for (int k4 = 0; k4 < 4; ++k4) { const int k0 = 256 * wave + 32 * (4 * kh + k4) + 8 * l4;
#pragma unroll
                      for (int mt = 0; mt < 2; ++mt) { const bf16x8 ah = *(const LAS bf16x8*)(lds + RT_HI + (16 * mt + l15) * RT_ROWB + k0 * 2);
#pragma unroll
                          for (int et = 0; et < 4; ++et) acc[mt][et] = __builtin_amdgcn_mfma_f32_16x16x32_bf16(ah, bh[k4][et], acc[mt][et], 0, 0, 0); } } }
              __syncthreads();
#pragma unroll
              for (int mt = 0; mt < 2; ++mt)
#pragma unroll
                  for (int et = 0; et < 4; ++et)
#pragma unroll
                      for (int q = 0; q < 4; ++q) part[(wave * 32 + 16 * mt + 4 * l4 + q) * 64 + 16 * et + l15] = acc[mt][et][q]; }
            __syncthreads();
#pragma unroll
            for (int q = 0; q < 4; ++q) { const int idx = tid + 512 * q; float sacc = 0.f;
#pragma unroll
                for (int w = 0; w < 8; ++w) sacc += part[w * 2048 + idx];
                logit[idx] = sacc; }
            __syncthreads();
#pragma unroll 1
            for (int rep_ = 0; rep_ < P7_REP_RT; ++rep_) {
#pragma unroll 1
            for (int rr = 0; rr < 4; ++rr) {
                const int lr = wave * 4 + rr, t = blk * 64 + it * 32 + lr;
                const float lg = logit[lr * 64 + lane]; const float s = 1.f / (1.f + __expf(-lg)); const float sel = s + rbias[lane];
                float m1 = sel; m1 = fmaxf(m1, __shfl_xor(m1, 1)); m1 = fmaxf(m1, __shfl_xor(m1, 2)); m1 = fmaxf(m1, __shfl_xor(m1, 4));
                const u64 eq = __ballot(sel == m1); const unsigned gb = (unsigned)(eq >> (lane & ~7)) & 0xffu; const int first = __builtin_ctz(gb);
                float v2 = ((lane & 7) == first) ? -INFINITY : sel; v2 = fmaxf(v2, __shfl_xor(v2, 1)); v2 = fmaxf(v2, __shfl_xor(v2, 2)); v2 = fmaxf(v2, __shfl_xor(v2, 4));
                const float gs = m1 + v2; const int g = lane >> 3; int grank = 0;
#pragma unroll
                for (int g2 = 0; g2 < 8; ++g2) { const float o = __shfl(gs, g2 * 8); grank += (o > gs || (o == gs && g2 < g)) ? 1 : 0; }
                const bool gsel = grank < 4; const float mk = gsel ? sel : -INFINITY; int rank = 0;
                for (int e2 = 0; e2 < 64; ++e2) { const float o = __shfl(mk, e2); rank += (o > mk || (o == mk && e2 < lane)) ? 1 : 0; }
                const bool chosen = gsel && rank < 8;
                const u64 mask = __ballot(chosen); const float ssum = wave_sum(chosen ? s : 0.f);
                const int kidx = __popcll(mask & ((1ull << lane) - 1ull));
                if (chosen) tokw[(size_t)t * 8 + kidx] = s / ssum * 2.5f;
                if (lane == 0) { tmask[t] = mask; masks[it * 32 + lr] = mask; }
            }
            __syncthreads();
            }
        }
        if (wave == 0) { const u64 m = masks[lane]; int mine = 0;
            for (int e = 0; e < 64; ++e) { const int c = __popcll(__ballot((m >> e) & 1ull)); mine = (lane == e) ? c : mine; }
            cnt[blk * 64 + lane] = mine; }
        __syncthreads();
    }
}

__device__ __forceinline__ void phase7(const Args& a, LAS unsigned char* lds, int tid, int lane, int wave, int vcu, int G) {
    unsigned char* ws = a.ws;
    const int* cnt = (const int*)(ws + T_CNT); const u64* tmask = (const u64*)(ws + T_MASK); const float* tokw = (const float*)(ws + T_TOKW);
    int* tokslot = (int*)(ws + T_TOKSLOT); int* slottok = (int*)(ws + T_SLOTTOK); float* slotw = (float*)(ws + T_SLOTW); int* tile = (int*)(ws + T_TILE);
    LAS int* part = (LAS int*)lds;
    LAS int* tot = (LAS int*)(lds + 4096);
    for (int blk = vcu; blk < NT / 64; blk += G) {
        int pre = 0, all = 0;
        for (int b2 = wave; b2 < 256; b2 += 8) { const int c = cnt[b2 * 64 + lane]; all += c; pre += (b2 < blk) ? c : 0; }
        part[(wave * 2) * 64 + lane] = pre; part[(wave * 2 + 1) * 64 + lane] = all;
        __syncthreads();
        if (wave == 0) {
            int p = 0, t = 0;
#pragma unroll
            for (int w = 0; w < 8; ++w) { p += part[(w * 2) * 64 + lane]; t += part[(w * 2 + 1) * 64 + lane]; }
            int incl = t;
#pragma unroll
            for (int o = 1; o < 64; o <<= 1) { const int v = __shfl_up(incl, o); if (lane >= o) incl += v; }
            const int start = incl - t; const int base = start + p;
            tot[lane] = t; tot[64 + lane] = start;
            const int tokn = blk * 64 + lane; const u64 m = tmask[tokn];
            for (int e = 0; e < 64; ++e) { const bool bit = (m >> e) & 1ull; const u64 bal = __ballot(bit); const int be = __shfl(base, e);
                if (bit) { const int rank = __popcll(bal & ((1ull << lane) - 1ull)); const int slot = be + rank; const int k = __popcll(m & ((1ull << e) - 1ull));
                    slottok[slot] = tokn; slotw[slot] = tokw[(size_t)tokn * 8 + k]; tokslot[(size_t)tokn * 8 + k] = slot; } }
            slottok[SH_ROW0 + tokn] = tokn; slotw[SH_ROW0 + tokn] = 1.f;
        }
        __syncthreads();
        if (blk == 0 && tid == 0) {
            int n = 0;
            for (int e = 0; e < 64; ++e) { const int te = tot[e], st = tot[64 + e];
                for (int j = 0; j * 256 < te; ++j) { tile[n] = e; tile[NTILE_MAX + n] = st + j * 256; tile[2 * NTILE_MAX + n] = (te - j * 256) < 256 ? (te - j * 256) : 256; ++n; } }
            for (int j = 0; j < 64; ++j) { tile[n] = 64; tile[NTILE_MAX + n] = SH_ROW0 + j * 256; tile[2 * NTILE_MAX + n] = 256; ++n; }
            tile[3 * NTILE_MAX] = n;
        }
        __syncthreads();
    }
}

__device__ __forceinline__ void phase10(const Args& a, LAS unsigned char* lds, int lane, int wave, int vcu, int G) {
    unsigned char* ws = a.ws;
    const float* mod = (const float*)(ws + WS_MOD); const unsigned char* SO = ws + WS_SLOTOUT; const int* tokslot = (const int*)(ws + T_TOKSLOT); const float* gp = a.in[9];
    LAS float* ysc = (LAS float*)(lds + wave * 8192);
    const unsigned lo16_ = 16u * (unsigned)lane;
#pragma unroll 1
    for (int t = vcu * 8 + wave; t < NT; t += G * 8) {
        const float* mr = mod + (size_t)(t >> 11) * 12288;
        const int myslot = lane < 8 ? tokslot[(size_t)t * 8 + lane] : SH_ROW0 + t;
        unsigned lo16 = lo16_; asm volatile("" : "+v"(lo16));
        v4u x[9][2]; f32x4 xo[8]; v2u yb[8];
        const unsigned char* x1r = (const unsigned char*)(a.in[0] + (size_t)t * 2048); const unsigned char* y1r = (const unsigned char*)((const bf16*)(ws + RA_Y1) + (size_t)t * 2048);
        const float rstd1 = ((const float*)(ws + T_RSTD1))[t];
#pragma unroll
        for (int k = 0; k < 9; ++k) { const int slot = __builtin_amdgcn_readfirstlane(__shfl(myslot, k)); const unsigned char* sr = SO + (size_t)slot * 2048;
#pragma unroll
            for (int j = 0; j < 2; ++j) x[k][j] = *(const v4u*)(sr + (lo16 + 1024u * j)); }
        float y[2][16];
#pragma unroll
        for (int j = 0; j < 2; ++j)
#pragma unroll
            for (int q = 0; q < 16; ++q) y[j][q] = 0.f;
#pragma unroll
        for (int k = 0; k < 9; ++k)
#pragma unroll
            for (int j = 0; j < 2; ++j) { v4u v = x[k][j]; asm volatile("" : "+v"(v) : "v"(y[j][0]), "v"(y[j][15]));
#pragma unroll
                for (int w = 0; w < 4; ++w) { const unsigned d = v[w]; const auto lo = __builtin_amdgcn_cvt_pk_f32_fp8(d, false), hi = __builtin_amdgcn_cvt_pk_f32_fp8(d, true);
                    y[j][4 * w] += lo[0]; y[j][4 * w + 1] += lo[1]; y[j][4 * w + 2] += hi[0]; y[j][4 * w + 3] += hi[1]; } }
        asm volatile("" ::: "memory");
#pragma unroll
        for (int j = 0; j < 8; ++j) { xo[j] = *(const f32x4*)(x1r + (lo16 + 1024u * j)); yb[j] = *(const v2u*)(y1r + (lo16 / 2u + 512u * j)); }
        float ss = 0.f;
#pragma unroll
        for (int j = 0; j < 2; ++j)
#pragma unroll
            for (int q = 0; q < 16; ++q) ss += y[j][q] * y[j][q];
        const float rstd = rsqrtf(wave_sum(ss) * (1.f / 2048.f) + EPS * SC_O * SC_O);
#pragma unroll
        for (int j = 0; j < 2; ++j)
#pragma unroll
            for (int q = 0; q < 4; ++q) *(LAS f32x4*)(ysc + 16 * (lane + 64 * j) + 4 * q) = (f32x4){y[j][4 * q], y[j][4 * q + 1], y[j][4 * q + 2], y[j][4 * q + 3]};
        LDS_WAIT(); asm volatile("" ::: "memory");
        unsigned char* outr = (unsigned char*)(a.out + (size_t)t * 2048); const unsigned char* gpb = (const unsigned char*)gp; const unsigned char* g1b = (const unsigned char*)a.in[7];
        const unsigned char* gt2b = (const unsigned char*)(mr + 10240); const unsigned char* gt1b = (const unsigned char*)(mr + 4096);
#pragma unroll
        for (int j = 0; j < 8; ++j) { const unsigned cb = lo16 + 1024u * j; const f32x4 yy = *(const LAS f32x4*)(ysc + 4 * (lane + 64 * j)), g = *(const f32x4*)(gpb + cb), gt = *(const f32x4*)(gt2b + cb);
            const f32x4 g1 = *(const f32x4*)(g1b + cb), gt1 = *(const f32x4*)(gt1b + cb); const f32x4 y1 = (f32x4){bflo(yb[j].x), bfhi(yb[j].x), bflo(yb[j].y), bfhi(yb[j].y)};
            const f32x4 x1 = xo[j] + gt1 * (y1 * rstd1 * g1);
            *(f32x4*)(outr + cb) = x1 + gt * (yy * rstd * g); }
        LDS_WAIT(); asm volatile("" ::: "memory");
    }
}

__global__ void __launch_bounds__(512, 2) fwd(Args args) {
    extern __shared__ __attribute__((aligned(16))) unsigned char lds_raw[];
    LAS unsigned char* lds = (LAS unsigned char*)lds_raw;
    const int tid = threadIdx.x, lane = tid & 63, wave = __builtin_amdgcn_readfirstlane(tid >> 6);
    const int G = gridDim.x, bx = blockIdx.x;
    const int vcu = (G % 8 == 0) ? (bx % 8) * (G / 8) + bx / 8 : bx;
    unsigned char* ws = args.ws;
    volatile LAS unsigned* MISC = (volatile LAS unsigned*)(lds + LDS_MISC);
    if (tid < 64) MISC[tid] = 0u;
    __syncthreads();
    const int lo = args.ph_lo, hi = args.ph_hi;
    XcdBarrier bar; bar.bar = (unsigned*)(ws + WS_CTL) + 4096; bar.x = 0; bar.st = nullptr;
    if (hi - lo > 1) bar = xcd_barrier_post((unsigned*)(ws + WS_CTL) + 4096, MISC + 8);
#ifndef PH_MASK
#define PH_MASK 0xfff
#endif
#define IN(k) (((PH_MASK >> (k)) & 1) && lo <= (k) && (k) < hi)
#define SEAM(k) do { if (IN(k) && IN((k) + 1)) xcd_barrier(bar); } while (0)

#ifndef REP_PHASE
#define REP_PHASE -1
#endif
#define PH_IDS int tz_ = threadIdx.x; asm volatile("" : "+v"(tz_)); const int tid = tz_, lane = tz_ & 63, wave = __builtin_amdgcn_readfirstlane(tz_ >> 6); (void)tid; (void)lane; (void)wave;
#define RUNPH(k, ...) do { if (IN(k)) { { PH_IDS __VA_ARGS__ } if (REP_PHASE == (k)) { xcd_barrier(bar); { PH_IDS __VA_ARGS__ } } SEAM(k); } } while (0)
#ifdef PROBE_P0
    if (IN(0)) { { PH_IDS phase0(args, lds, tid, lane, wave, vcu, G); } xcd_barrier(bar); { PH_IDS phase0(args, lds, tid, lane, wave, vcu, G, PROBE_P0 == 1, PROBE_P0 == 2); } SEAM(0); }
#else
    RUNPH(0, phase0(args, lds, tid, lane, wave, vcu, G););
#endif
    RUNPH(1, phase1(args, lane, wave, vcu, G););
    RUNPH(2, {
        DenseSched S; S.init(ws + RA_H, ws + WS_WIN, 2048, 2048, MROWS, DINP, G, bx);
        EpiIn E{ws};
        pg8::gemm_phase<EpiIn, DenseSched>(lds, 2048, S, E); });
#ifndef P3_REP_PREP
#define P3_REP_PREP 1
#endif
#ifndef P3_REP_POOL
#define P3_REP_POOL 1
#endif
    RUNPH(3, for (int r_ = 0; r_ < P3_REP_PREP; ++r_) phase3_prep(args, lds, tid, vcu, G); for (int r_ = 0; r_ < P3_REP_POOL; ++r_) phase3_pool(args, lds, tid, vcu, G););
    RUNPH(4, phase_chain(args, lds, tid, lane, wave, vcu, G););
    RUNPH(5, {
        phase4_post(args, lane, wave, vcu, G);
        PoolSched S{(const char*)(ws + RA_DPOOL), (const char*)(ws + WS_WPOOL), G, vcu};
        EpiPool E{(bf16*)(ws + RA_YMIX), args.in[17]};
        int kpool = 256; asm volatile("" : "+s"(kpool));
        pg8::gemm_phase<EpiPool, PoolSched>(lds, kpool, S, E); });
    RUNPH(6, {
        DenseSched S; S.init(ws + RA_YMIX, ws + WS_WOUT, 2048, 2048, NT, 2048, G, bx);
        EpiOut E{(bf16*)(ws + RA_Y1)};
        pg8::gemm_phase<EpiOut, DenseSched>(lds, 2048, S, E); });
    RUNPH(7, phase6(args, lds, tid, lane, wave, vcu, G););
    RUNPH(8, phase7(args, lds, tid, lane, wave, vcu, G););
    RUNPH(9, {
        MoeGUSched S{(const char*)(ws + RA_H2), (const char*)(ws + WS_WGU), (const int*)(ws + T_TILE), (const int*)(ws + T_SLOTTOK), G, vcu};
        EpiGU E{ws + WS_ACT, (const float*)(ws + T_SLOTW)};
        int kgu = 1024; asm volatile("" : "+s"(kgu));
        pg8::gemm_phase<EpiGU, MoeGUSched, true>(lds, kgu, S, E); });
    RUNPH(10, {
        MoeDownSched S{(const char*)(ws + WS_ACT), (const char*)(ws + WS_WD), (const int*)(ws + T_TILE), G, vcu};
        EpiDown E{ws + WS_SLOTOUT};
        int kdn = 256; asm volatile("" : "+s"(kdn));
        pg8::gemm_phase<EpiDown, MoeDownSched, true>(lds, kdn, S, E); });
    if (IN(11)) { { PH_IDS phase10(args, lds, lane, wave, vcu, G); } if (REP_PHASE == 11) { xcd_barrier(bar); { PH_IDS phase10(args, lds, lane, wave, vcu, G); } } }
#undef IN
#undef SEAM
}

extern "C" void kernel_launch(void* const* d_in, const int* in_sizes, int n_in, void* d_out, int out_size, void* d_ws, size_t ws_size, hipStream_t stream) {
    static int grid = 0;
    if (grid == 0) {
        if (n_in != 27 || out_size != NT * DM || ws_size < WS_NEED) { fprintf(stderr, "kernel_launch: unexpected problem: n_in %d out %d ws %zu (need %zu)\n", n_in, out_size, ws_size, (size_t)WS_NEED); grid = -1; return; }
        int dev = 0, cus = 0, per_cu = 0;
        if (hipGetDevice(&dev) != hipSuccess || hipDeviceGetAttribute(&cus, hipDeviceAttributeMultiprocessorCount, dev) != hipSuccess) { grid = -1; return; }
        if (hipFuncSetAttribute((const void*)fwd, hipFuncAttributeMaxDynamicSharedMemorySize, LDS_BYTES) != hipSuccess) { fprintf(stderr, "kernel_launch: hipFuncSetAttribute failed\n"); grid = -1; return; }
        if (hipOccupancyMaxActiveBlocksPerMultiprocessor(&per_cu, (const void*)fwd, 512, LDS_BYTES) != hipSuccess || per_cu < 1) { fprintf(stderr, "kernel_launch: occupancy query says %d\n", per_cu); }
        (void)hipGetLastError();
        grid = cus;
    }
    if (grid < 0) return;
    (void)hipMemsetAsync((char*)d_ws + WS_CTL, 0, CTL_ZERO_BYTES, stream);
    Args a{};
    for (int i = 0; i < 27; ++i) a.in[i] = (const float*)d_in[i];
    a.out = (float*)d_out; a.ws = (unsigned char*)d_ws;
    if (N_LAUNCHES == 1) {
        a.ph_lo = 0; a.ph_hi = NPH;
        hipLaunchKernelGGL(fwd, dim3(grid), dim3(512), LDS_BYTES, stream, a);
    } else {
        for (int p = 0; p < NPH; ++p) { a.ph_lo = p; a.ph_hi = p + 1; hipLaunchKernelGGL(fwd, dim3(grid), dim3(512), LDS_BYTES, stream, a); }
    }
}
```

```cpp
#include <hip/hip_runtime.h>
#include <cstdio>
#include <cstdint>

#ifndef P7_REP_ROWS
#define P7_REP_ROWS 1
#endif
#ifndef P7_REP_LOG
#define P7_REP_LOG 1
#endif
#ifndef P7_REP_RT
#define P7_REP_RT 1
#endif
#ifndef N_LAUNCHES
#define N_LAUNCHES 1
#endif

#define GAS __attribute__((address_space(1)))
#define LAS __attribute__((address_space(3)))
typedef unsigned short bf16;
typedef unsigned v4u __attribute__((ext_vector_type(4)));
typedef unsigned v2u __attribute__((ext_vector_type(2)));
typedef float f32x4 __attribute__((ext_vector_type(4)));
typedef short bf16x8 __attribute__((ext_vector_type(8)));
typedef unsigned long long u64;

constexpr int NB = 8, SEQ = 2048, DM = 2048, CTXL = 256;
constexpr int NT = NB * SEQ;
constexpr int NTC = NB * CTXL;
constexpr int MROWS = NT + NTC;
constexpr int DIN = 4128, DINP = 4352;
constexpr int NE = 64, TOPK = 8, DE = 512;
constexpr int NSLOT_E = NT * TOPK;
constexpr int SH_ROW0 = NSLOT_E + 256;
constexpr int NSLOT = SH_ROW0 + NT;
constexpr int NTILE_MAX = 704;
constexpr float EPS = 1e-6f;
constexpr int NPH = 12;

constexpr size_t MiB = 1u << 20;
constexpr size_t WS_CTL = 0, CTL_ZERO_BYTES = 64 * 1024;
constexpr size_t WS_MOD = 1 * MiB;
constexpr size_t WS_WRT = 1 * MiB + 512 * 1024;
constexpr size_t WS_WIN = 2 * MiB;
constexpr size_t WS_WOUT = WS_WIN + 17 * MiB;
constexpr size_t WS_WPOOL = WS_WOUT + 8 * MiB;
constexpr size_t WS_WD = WS_WPOOL + 1 * MiB;
constexpr size_t WS_WGU = WS_WD + 130 * MiB;
constexpr size_t WS_RA = WS_WGU + 260 * MiB;
constexpr size_t RA_H = WS_RA;
constexpr size_t RA_OF = WS_RA;
constexpr size_t RA_H2 = WS_RA;
constexpr size_t RA_Q = WS_RA + 128 * MiB;
constexpr size_t RA_K = RA_Q + 16 * MiB;
constexpr size_t RA_V = RA_K + 18 * MiB;
constexpr size_t RA_R = RA_V + 36 * MiB;
constexpr size_t RA_P = RA_R + 32 * MiB;
constexpr size_t RA_ALR = RA_P + 32 * MiB;
constexpr size_t RA_DPOOL = RA_ALR + 3 * MiB;
constexpr size_t RA_YMIX = RA_DPOOL + 32 * MiB;
constexpr size_t RA_Y1 = WS_RA + 128 * MiB;
constexpr size_t RA_END = RA_YMIX + 64 * MiB;
constexpr size_t WS_SLOTOUT = WS_WGU;
constexpr size_t WS_ACT = RA_END > WS_SLOTOUT + 578 * MiB ? RA_END : WS_SLOTOUT + 578 * MiB;
constexpr size_t WS_END = WS_ACT + 145 * MiB;
constexpr size_t PQG = WS_ACT;
constexpr size_t PAM = WS_ACT + 32 * MiB;
constexpr size_t PKD = WS_ACT + 96 * MiB;
constexpr size_t PDEC = WS_ACT + 132 * MiB;
constexpr size_t WS_T0 = WS_END;
constexpr size_t T_CNT = WS_T0;
constexpr size_t T_MASK = T_CNT + 65536;
constexpr size_t T_TOKW = T_MASK + 131072;
constexpr size_t T_TOKSLOT = T_TOKW + 524288;
constexpr size_t T_SLOTTOK = T_TOKSLOT + 524288;
constexpr size_t T_SLOTW = T_SLOTTOK + 655360;
constexpr size_t T_TILE = T_SLOTW + 655360;
constexpr size_t T_RSTD1 = (T_TILE + 16384 + 4095) / 4096 * 4096;
constexpr size_t WS_NEED = T_RSTD1 + (size_t)NT * 4;

constexpr int RING_BYTES = 131072;
constexpr int LDS_BYTES = 147456;
constexpr int LDS_MISC = LDS_BYTES - 256;
constexpr int RT_ROWB = 4112;
constexpr int RT_HI = 0;
constexpr int LDS_LOGIT = 32 * RT_ROWB;
constexpr int LDS_MASKS = LDS_LOGIT + 8192;
static_assert(LDS_MASKS + 512 <= LDS_MISC, "LDS map");

#define LDS_WAIT() asm volatile("s_waitcnt lgkmcnt(0)" ::: "memory")
#define LDS_BARRIER() do { asm volatile("s_waitcnt lgkmcnt(0)" ::: "memory"); __builtin_amdgcn_s_barrier(); asm volatile("" ::: "memory"); } while (0)
#define VM_WAIT() asm volatile("s_waitcnt vmcnt(0)" ::: "memory")

__device__ __forceinline__ unsigned f2bf(float f) { unsigned u = __builtin_bit_cast(unsigned, f); return (u + 0x7fffu + ((u >> 16) & 1u)) >> 16; }
__device__ __forceinline__ unsigned pk2(float lo, float hi) { return f2bf(lo) | (f2bf(hi) << 16); }
__device__ __forceinline__ float bflo(unsigned u) { return __builtin_bit_cast(float, u << 16); }
__device__ __forceinline__ float bfhi(unsigned u) { return __builtin_bit_cast(float, u & 0xffff0000u); }
__device__ __forceinline__ float bf1(bf16 b) { return __builtin_bit_cast(float, ((unsigned)b) << 16); }
__device__ __forceinline__ float wave_sum(float v) {
#pragma unroll
    for (int o = 1; o < 64; o <<= 1) v += __shfl_xor(v, o);
    return v;
}
__device__ __forceinline__ float silu_f(float x) { return x / (1.f + __expf(-x)); }

#define XB_TMO      128
#define XB_XCNT(j)  (256  + 64 * (j))
#define XB_XSUB(j)  (1280 + 64 * (j))
#define XB_XGEN(j)  (2304 + 64 * (j))
#define XB_TOP      3328
#define XB_TOPGEN   3392
#define XCD_BAR_WORDS 3456
#define XB_SPIN_CAP (1u << 18)

__device__ __forceinline__ unsigned xb_ld(unsigned* p)              { return __hip_atomic_load(p, __ATOMIC_RELAXED, __HIP_MEMORY_SCOPE_AGENT); }
__device__ __forceinline__ unsigned xb_add(unsigned* p, unsigned v) { return __hip_atomic_fetch_add(p, v, __ATOMIC_RELAXED, __HIP_MEMORY_SCOPE_AGENT); }
__device__ __forceinline__ unsigned xb_xcc_id() { return (unsigned)__builtin_amdgcn_s_getreg((3 << 11) | 20) & 0xFu; }
#define XB_SPIN(cond, bar) do { unsigned _sp = 0; while (cond) { __builtin_amdgcn_s_sleep(1); \
    if ((++_sp & 255u) == 0u) { if (xb_ld(&(bar)[XB_TMO])) break; if (_sp > XB_SPIN_CAP) { atomicAdd(&(bar)[XB_TMO], 1u); break; } } } } while (0)

struct XcdBarrier { unsigned* bar; unsigned x; volatile LAS unsigned* st; };

__device__ __forceinline__ XcdBarrier xcd_barrier_post(unsigned* bar, volatile LAS unsigned* st) {
    XcdBarrier b; b.bar = bar; b.x = xb_xcc_id(); b.st = st;
    if (threadIdx.x == 0) (void)xb_add(&bar[XB_XCNT(b.x)], 1u);
    return b;
}
__device__ __forceinline__ void xcd_barrier_complete(unsigned* bar, unsigned x, unsigned& nloc, unsigned& nx) {
    const unsigned G = gridDim.x * gridDim.y * gridDim.z;
    unsigned sum, cnt, mine, sp = 0u;
    for (;;) {
        sum = 0u; cnt = 0u; mine = 0u;
#pragma unroll
        for (unsigned j = 0; j < 16; ++j) { const unsigned c = xb_ld(&bar[XB_XCNT(j)]); sum += c; cnt += (c > 0u) ? 1u : 0u; mine = (j == x) ? c : mine; }
        if (sum == G) break;
        __builtin_amdgcn_s_sleep(1);
        if ((++sp & 255u) == 0u) { if (xb_ld(&bar[XB_TMO])) break; if (sp > XB_SPIN_CAP) { atomicAdd(&bar[XB_TMO], 1u); break; } }
    }
    nloc = mine > 0u ? mine : 1u; nx = cnt > 0u ? cnt : 1u;
}
__device__ __forceinline__ void xcd_barrier(const XcdBarrier& b) {
    asm volatile("s_waitcnt vmcnt(0)" ::: "memory");
    __syncthreads();
    if (threadIdx.x == 0) {
        unsigned* bar = b.bar;
        __builtin_amdgcn_s_waitcnt(0);
        unsigned nloc = b.st[0], nx = b.st[1];
        if (nloc == 0u) { xcd_barrier_complete(bar, b.x, nloc, nx); b.st[0] = nloc; b.st[1] = nx; }
        const unsigned old = xb_add(&bar[XB_XSUB(b.x)], 1u);
        const unsigned gen = old / nloc;
        if (old + 1u == (gen + 1u) * nloc) {
            __builtin_amdgcn_fence(__ATOMIC_RELEASE, "agent");
            asm volatile("s_waitcnt vmcnt(0)" ::: "memory");
            const unsigned og = xb_add(&bar[XB_TOP], 1u);
            const unsigned tg = og / nx;
            if (og + 1u == (tg + 1u) * nx) xb_add(&bar[XB_TOPGEN], 1u);
            else XB_SPIN(xb_ld(&bar[XB_TOPGEN]) == tg, bar);
            __builtin_amdgcn_fence(__ATOMIC_ACQUIRE, "agent");
            xb_add(&bar[XB_XGEN(b.x)], 1u);
            asm volatile("s_waitcnt vmcnt(0)" ::: "memory");
        } else {
            XB_SPIN(xb_ld(&bar[XB_XGEN(b.x)]) == gen, bar);
            __builtin_amdgcn_fence(__ATOMIC_ACQUIRE, "agent");
            asm volatile("s_waitcnt vmcnt(0)" ::: "memory");
        }
    }
    __syncthreads();
}

namespace pg8 {
constexpr int BM = 256, BK = 64, HALF = 128, HTB = HALF * BK * 2, STAGE_BYTES = 8 * HTB, NXCD = 8, WGM = 8;
__device__ __forceinline__ int lds_byte(int r, int c) { const int st = (r >> 4) * 2 + (c >> 5), rr = r & 15, cc = c & 31, ob = rr * 64 + cc * 2; return st * 1024 + (ob ^ (((ob >> 9) & 1) << 5)); }
__device__ __forceinline__ void stage_rc(int b, int& R, int& C) { const int st = b / 1024, sb = b % 1024, swz = sb ^ (((sb >> 9) & 1) << 5); R = (st >> 1) * 16 + swz / 64; C = (st & 1) * 32 + (swz % 64) / 2; }
__device__ __forceinline__ int perm32(int rho) { const int n = rho >> 4, i = rho & 15; return 8 * (i >> 2) + 4 * n + (i & 3); }
__device__ __forceinline__ unsigned cvt_pk_bf16(float lo, float hi) { unsigned r; asm volatile("v_cvt_pk_bf16_f32 %0, %1, %2" : "=v"(r) : "v"(lo), "v"(hi)); return r; }

typedef int v8i __attribute__((ext_vector_type(8)));
typedef int v4i __attribute__((ext_vector_type(4)));
template <class Epi, class Sched, bool FP8 = false>
__device__ __forceinline__ void gemm_phase(LAS unsigned char* lds, const int K, const Sched& S, const Epi& E) {
    typedef typename Sched::U Unit;
    const int tid = threadIdx.x, wid = __builtin_amdgcn_readfirstlane(tid >> 6), lane = tid & 63, wr = wid >> 2, wc = wid & 3, fr = lane & 15, fq = lane >> 4;
    const int nt = K / BK;
    int R[2], C[2]; unsigned voffB[2];
#pragma unroll
    for (int i = 0; i < 2; ++i) { stage_rc(tid * 16 + i * 8192, R[i], C[i]);
        const int Rb = Epi::PERMK == 2 ? (64 * (R[i] >> 5) + 16 * ((R[i] & 15) >> 2) + 4 * ((R[i] >> 4) & 1) + (R[i] & 3)) : (Epi::PERMK == 1 ? ((R[i] & ~31) + perm32(R[i] & 31)) : R[i]);
        voffB[i] = (unsigned)(Rb * K + C[i]) * 2u; }
    const size_t kstep = (size_t)(BK * 2);
    const size_t hstepB = (size_t)(Epi::PERMK == 2 ? 8 : HALF) * K * 2;
    const unsigned ldsw = (unsigned)wid * 1024u;
    const int aoff = lds_byte(wr * 64 + fr, fq * 8), boff = lds_byte(wc * 32 + fr, fq * 8);
#define PG8_SA(b, h) (((b) * 2 + (h)) * HTB)
#define PG8_SB(b, h) ((4 + (b) * 2 + (h)) * HTB)
#define PG8_STAGE(bufoff, gbase, v0, v1) do { \
        __builtin_amdgcn_global_load_lds((const unsigned*)((const char*)(gbase) + (v0)), (LAS unsigned*)(lds + (bufoff) + ldsw), 16, 0, 0); \
        __builtin_amdgcn_global_load_lds((const unsigned*)((const char*)(gbase) + (v1)), (LAS unsigned*)(lds + (bufoff) + ldsw + 8192), 16, 0, 0); } while (0)
#define PG8_LDA(dst, b, h) do { _Pragma("unroll") for (int m = 0; m < 4; ++m) { const v4i lo_ = *(const LAS v4i*)(lds + PG8_SA(b, h) + aoff + m * 2048), hi_ = *(const LAS v4i*)(lds + PG8_SA(b, h) + aoff + m * 2048 + 1024); \
        dst[m] = __builtin_shufflevector(lo_, hi_, 0, 1, 2, 3, 4, 5, 6, 7); } } while (0)
#define PG8_LDB(dst, b, h) do { _Pragma("unroll") for (int n = 0; n < 2; ++n) { const v4i lo_ = *(const LAS v4i*)(lds + PG8_SB(b, h) + boff + n * 2048), hi_ = *(const LAS v4i*)(lds + PG8_SB(b, h) + boff + n * 2048 + 1024); \
        dst[n] = __builtin_shufflevector(lo_, hi_, 0, 1, 2, 3, 4, 5, 6, 7); } } while (0)
#define PG8_H0(x) ((bf16x8)__builtin_shufflevector(x, x, 0, 1, 2, 3))
#define PG8_H1(x) ((bf16x8)__builtin_shufflevector(x, x, 4, 5, 6, 7))
#define PG8_MMA(ai, bj, At, Bt) do { __builtin_amdgcn_s_setprio(1); if constexpr (FP8) asm volatile("s_nop 4"); _Pragma("unroll") for (int m = 0; m < 4; ++m) _Pragma("unroll") for (int n = 0; n < 2; ++n) { \
        if constexpr (FP8) asm volatile("v_mfma_f32_16x16x128_f8f6f4 %0, %1, %2, %0" : "+v"(acc[ai][bj][m][n]) : "v"(Bt[n]), "v"(At[m])); \
        else { acc[ai][bj][m][n] = __builtin_amdgcn_mfma_f32_16x16x32_bf16(PG8_H0(Bt[n]), PG8_H0(At[m]), acc[ai][bj][m][n], 0, 0, 0); \
               acc[ai][bj][m][n] = __builtin_amdgcn_mfma_f32_16x16x32_bf16(PG8_H1(Bt[n]), PG8_H1(At[m]), acc[ai][bj][m][n], 0, 0, 0); } } \
        __builtin_amdgcn_s_setprio(0); } while (0)
#define PG8_WAIT_V(n) asm volatile("s_waitcnt vmcnt(" #n ")" ::: "memory")
#define PG8_WAIT_L(n) asm volatile("s_waitcnt lgkmcnt(" #n ")" ::: "memory")
#define PG8_BAR __builtin_amdgcn_s_barrier()
#define PG8_SCHED __builtin_amdgcn_sched_barrier(0)
    Unit cur, nxt; int ui = 0;
    if (!S.next(0, cur)) return;
    f32x4 acc[2][2][4][2];
#pragma unroll
    for (int a = 0; a < 2; ++a)
#pragma unroll
        for (int b = 0; b < 2; ++b)
#pragma unroll
            for (int m = 0; m < 4; ++m)
#pragma unroll
                for (int n = 0; n < 2; ++n) acc[a][b][m][n] = (f32x4){0.f, 0.f, 0.f, 0.f};
    v8i At[4], B0[2], B1[2];
    unsigned vA[4], vN[4];
    S.aoffs(cur, R, C, vA);
    const char* cA = cur.A; const char* cB = cur.B;
    PG8_STAGE(PG8_SB(0, 0), cB, voffB[0], voffB[1]); PG8_STAGE(PG8_SB(0, 1), cB + hstepB, voffB[0], voffB[1]); PG8_STAGE(PG8_SA(0, 0), cA, vA[0], vA[1]); PG8_STAGE(PG8_SA(0, 1), cA, vA[2], vA[3]);
    if (wr == 1) PG8_BAR;
    PG8_WAIT_V(2); PG8_BAR;
    PG8_STAGE(PG8_SB(1, 0), cB + kstep, voffB[0], voffB[1]); PG8_STAGE(PG8_SA(1, 0), cA + kstep, vA[0], vA[1]); PG8_STAGE(PG8_SB(1, 1), cB + hstepB + kstep, voffB[0], voffB[1]);
    PG8_WAIT_V(6); PG8_BAR;
    for (;;) {
        const bool has_next = S.next(ui + 1, nxt);
        const char* nA = has_next ? nxt.A : cA; const char* nB = has_next ? nxt.B : cB;
        if (has_next) S.aoffs(nxt, R, C, vN); else { vN[0] = vA[0]; vN[1] = vA[1]; vN[2] = vA[2]; vN[3] = vA[3]; }
        for (int t = 0; t < nt; t += 2) {
            const bool last = (t == nt - 2);
            const char* a1 = cA + (size_t)(t + 1) * kstep;
            const char* a2 = last ? nA : cA + (size_t)(t + 2) * kstep; const char* b2 = last ? nB : cB + (size_t)(t + 2) * kstep;
            const char* a3 = a2 + kstep; const char* b3 = b2 + kstep;
            const unsigned x0 = last ? vN[0] : vA[0], x1 = last ? vN[1] : vA[1], x2 = last ? vN[2] : vA[2], x3 = last ? vN[3] : vA[3];
            PG8_LDB(B0, 0, 0); PG8_LDB(B1, 0, 1); PG8_SCHED; PG8_LDA(At, 0, 0); PG8_STAGE(PG8_SA(1, 1), a1, vA[2], vA[3]);
            PG8_WAIT_V(8); PG8_WAIT_L(0); PG8_BAR; PG8_MMA(0, 0, At, B0); PG8_MMA(0, 1, At, B1); PG8_BAR; PG8_SCHED;
            PG8_LDA(At, 0, 1); PG8_STAGE(PG8_SB(0, 0), b2, voffB[0], voffB[1]); PG8_STAGE(PG8_SB(0, 1), b2 + hstepB, voffB[0], voffB[1]); PG8_STAGE(PG8_SA(0, 0), a2, x0, x1);
            PG8_WAIT_V(8); PG8_WAIT_L(0); PG8_BAR; PG8_MMA(1, 0, At, B0); PG8_MMA(1, 1, At, B1); PG8_BAR; PG8_SCHED;
            PG8_LDB(B0, 1, 0); PG8_LDB(B1, 1, 1); PG8_SCHED; PG8_LDA(At, 1, 0); PG8_STAGE(PG8_SA(0, 1), a2, x2, x3);
            PG8_WAIT_V(8); PG8_WAIT_L(0); PG8_BAR; PG8_MMA(0, 0, At, B0); PG8_MMA(0, 1, At, B1); PG8_BAR; PG8_SCHED;
            PG8_LDA(At, 1, 1); PG8_STAGE(PG8_SB(1, 0), b3, voffB[0], voffB[1]); PG8_STAGE(PG8_SB(1, 1), b3 + hstepB, voffB[0], voffB[1]); PG8_STAGE(PG8_SA(1, 0), a3, x0, x1);
            PG8_WAIT_V(8); PG8_WAIT_L(0); PG8_BAR; PG8_MMA(1, 0, At, B0); PG8_MMA(1, 1, At, B1); PG8_BAR; PG8_SCHED;
        }
        if (wr == 0) PG8_BAR;
        if constexpr (FP8) asm volatile("s_nop 15\n\ts_nop 15");
        { int tz = threadIdx.x; asm volatile("" : "+v"(tz));
          const int wid_ = tz >> 6, lane_ = tz & 63; E(acc, cur, wid_ >> 2, wid_ & 3, lane_ & 15, lane_ >> 4);
#ifdef PROBE_EPI2
          if constexpr (Epi::PROBE2) { asm volatile("" : "+v"(tz)); const int w2 = tz >> 6, l2 = tz & 63; E(acc, cur, w2 >> 2, w2 & 3, l2 & 15, l2 >> 4); }
#endif
#ifdef PROBE_DRAIN
          if constexpr (Epi::PROBE2) { asm volatile("s_waitcnt vmcnt(0)" ::: "memory"); }
#endif
        }
        if (!has_next) break;
#pragma unroll
        for (int a = 0; a < 2; ++a)
#pragma unroll
            for (int b = 0; b < 2; ++b)
#pragma unroll
                for (int m = 0; m < 4; ++m)
#pragma unroll
                    for (int n = 0; n < 2; ++n) acc[a][b][m][n] = (f32x4){0.f, 0.f, 0.f, 0.f};
        cur = nxt; cA = nA; cB = nB; ++ui;
        vA[0] = vN[0]; vA[1] = vN[1]; vA[2] = vN[2]; vA[3] = vN[3];
        if (wr == 1) PG8_BAR;
    }
    PG8_WAIT_V(0);
    PG8_BAR;
#undef PG8_SA
#undef PG8_SB
#undef PG8_STAGE
#undef PG8_LDA
#undef PG8_LDB
#undef PG8_H0
#undef PG8_H1
#undef PG8_MMA
#undef PG8_WAIT_V
#undef PG8_WAIT_L
#undef PG8_BAR
#undef PG8_SCHED
}
}

struct Args { const float* in[27]; float* out; unsigned char* ws; int ph_lo, ph_hi; };
static_assert(sizeof(Args) == 27 * 8 + 8 + 8 + 8, "Args has no padding");

struct DenseU { const char* A; const char* B; int pm, pn; };
struct DenseSched {
    typedef DenseU U;
    const char* A; const char* B; int lda, K, nM, nN, nwg, G, c;
    __device__ __forceinline__ void init(const void* A_, const void* B_, int lda_, int K_, int M, int N, int G_, int c_) { A = (const char*)A_; B = (const char*)B_; lda = lda_; K = K_; nM = M / 256; nN = N / 256; nwg = nM * nN; G = G_; c = c_; }
    __device__ __forceinline__ bool next(int i, U& u) const {
        const long L = (long)i * G + c; if (L >= nwg) return false;
        int wgid = (int)L; { const int q = nwg / 8, r = nwg % 8, xcd = wgid % 8, off = wgid / 8; wgid = (xcd < r ? xcd * (q + 1) : r * (q + 1) + (xcd - r) * q) + off; }
        const int nig = 8 * nN, gid = wgid / nig, fm = gid * 8, gsz = (nM - fm) < 8 ? (nM - fm) : 8;
        u.pm = fm + ((wgid % nig) % gsz); u.pn = (wgid % nig) / gsz;
        u.A = A + (size_t)u.pm * 256 * lda * 2; u.B = B + (size_t)u.pn * 256 * K * 2; return true;
    }
    __device__ __forceinline__ void aoffs(const U&, const int (&R)[2], const int (&C)[2], unsigned (&v)[4]) const {
#pragma unroll
        for (int h = 0; h < 2; ++h)
#pragma unroll
            for (int i = 0; i < 2; ++i) v[h * 2 + i] = (unsigned)((h * 128 + R[i]) * lda + C[i]) * 2u;
    }
};
struct PoolU { const char* A; const char* B; int pm, g; };
struct PoolSched {
    typedef PoolU U;
    const char* A; const char* B; int G, c;
    __device__ __forceinline__ bool next(int i, U& u) const {
        const int L = i * G + c; if (L >= 256) return false;
        u.g = L & 3; u.pm = L >> 2;
        u.A = A + ((size_t)u.pm * 256 * 1024 + u.g * 256) * 2; u.B = B + (size_t)u.g * 256 * 256 * 2; return true;
    }
    __device__ __forceinline__ void aoffs(const U&, const int (&R)[2], const int (&C)[2], unsigned (&v)[4]) const {
#pragma unroll
        for (int h = 0; h < 2; ++h)
#pragma unroll
            for (int i = 0; i < 2; ++i) v[h * 2 + i] = (unsigned)((h * 128 + R[i]) * 1024 + C[i]) * 2u;
    }
};
struct MoeU { const char* A; const char* B; int row0, nrows, pn; };
struct MoeGUSched {
    typedef MoeU U;
    const char* H2; const char* W; const int* tile; const int* slot_tok; int G, c;
    __device__ __forceinline__ bool next(int i, U& u) const {
        const int nt = tile[3 * NTILE_MAX]; const int L = i * G + c; if (L >= nt * 4) return false;
        const int t = L >> 2; u.pn = L & 3; const int e = tile[t]; u.row0 = tile[NTILE_MAX + t]; u.nrows = tile[2 * NTILE_MAX + t];
        u.A = H2; u.B = W + ((size_t)e * 1024 + u.pn * 256) * 2048; return true;
    }
    __device__ __forceinline__ void aoffs(const U& u, const int (&R)[2], const int (&C)[2], unsigned (&v)[4]) const {
#pragma unroll
        for (int h = 0; h < 2; ++h)
#pragma unroll
            for (int i = 0; i < 2; ++i) { int r = h * 128 + R[i]; r = r < u.nrows ? r : u.nrows - 1; const int tok = slot_tok[u.row0 + r]; v[h * 2 + i] = (unsigned)(tok * 1024 + C[i]) * 2u; }
    }
};
struct MoeDownSched {
    typedef MoeU U;
    const char* ACT; const char* W; const int* tile; int G, c;
    __device__ __forceinline__ bool next(int i, U& u) const {
        const int nt = tile[3 * NTILE_MAX]; const int L = i * G + c; if (L >= nt * 8) return false;
        const int t = L >> 3; u.pn = L & 7; const int e = tile[t]; u.row0 = tile[NTILE_MAX + t]; u.nrows = tile[2 * NTILE_MAX + t];
        u.A = ACT + (size_t)u.row0 * 512; u.B = W + ((size_t)e * 2048 + u.pn * 256) * 512; return true;
    }
    __device__ __forceinline__ void aoffs(const U&, const int (&R)[2], const int (&C)[2], unsigned (&v)[4]) const {
#pragma unroll
        for (int h = 0; h < 2; ++h)
#pragma unroll
            for (int i = 0; i < 2; ++i) v[h * 2 + i] = (unsigned)((h * 128 + R[i]) * 256 + C[i]) * 2u;
    }
};

struct EpiIn {
    static constexpr int PERMK = 1; static constexpr bool PROBE2 = false;
    unsigned char* ws;
    __device__ __forceinline__ void operator()(const f32x4 (&acc)[2][2][4][2], const DenseU& u, int wr, int wc, int fr, int fq) const {
        const int pn = u.pn; const int row0 = u.pm * 256 + wr * 64 + fr;
        if (pn == 16) {
            if (wc != 0) return;
            float* alr = (float*)(ws + RA_ALR);
#pragma unroll
            for (int ai = 0; ai < 2; ++ai)
#pragma unroll
                for (int m = 0; m < 4; ++m) { float* rp = alr + (size_t)(row0 + ai * 128 + m * 16) * 32 + 8 * fq;
                    *(f32x4*)(rp) = acc[ai][0][m][0]; *(f32x4*)(rp + 4) = acc[ai][0][m][1]; }
            return;
        }
        bf16* base; int ld, colt; bool lat_only;
        if (pn < 2) { base = (bf16*)(ws + RA_Q); ld = 512; colt = pn * 256; lat_only = true; }
        else if (pn < 4) { base = (bf16*)(ws + RA_K); ld = 512; colt = (pn - 2) * 256; lat_only = false; }
        else if (pn < 8) { base = (bf16*)(ws + RA_V); ld = 1024; colt = (pn - 4) * 256; lat_only = false; }
        else if (pn < 12) { base = (bf16*)(ws + RA_R); ld = 1024; colt = (pn - 8) * 256; lat_only = true; }
        else { base = (bf16*)(ws + RA_P); ld = 1024; colt = (pn - 12) * 256; lat_only = true; }
        if (lat_only && u.pm >= 64) return;
        const int col0 = colt + wc * 32 + 8 * fq;
#pragma unroll
        for (int ai = 0; ai < 2; ++ai)
#pragma unroll
            for (int m = 0; m < 4; ++m) { bf16* rp = base + (size_t)(row0 + ai * 128 + m * 16) * ld + col0;
#pragma unroll
                for (int bj = 0; bj < 2; ++bj) { const f32x4 v0 = acc[ai][bj][m][0], v1 = acc[ai][bj][m][1];
                    v4u o; o.x = pg8::cvt_pk_bf16(v0[0], v0[1]); o.y = pg8::cvt_pk_bf16(v0[2], v0[3]); o.z = pg8::cvt_pk_bf16(v1[0], v1[1]); o.w = pg8::cvt_pk_bf16(v1[2], v1[3]);
                    *(v4u*)(rp + bj * 128) = o; } }
    }
};
struct EpiPool {
    static constexpr int PERMK = 1; static constexpr bool PROBE2 = false;
    bf16* ymix; const float* scale;
    __device__ __forceinline__ void operator()(const f32x4 (&acc)[2][2][4][2], const PoolU& u, int wr, int wc, int fr, int fq) const {
        const int row0 = u.pm * 256 + wr * 64 + fr; const int c0 = u.g * 256 + wc * 32 + 8 * fq;
#pragma unroll
        for (int ai = 0; ai < 2; ++ai)
#pragma unroll
            for (int m = 0; m < 4; ++m) { bf16* rp = ymix + (size_t)(row0 + ai * 128 + m * 16) * 2048 + 1024 + c0;
#pragma unroll
                for (int bj = 0; bj < 2; ++bj) { const f32x4 s0 = *(const f32x4*)(scale + c0 + bj * 128), s1 = *(const f32x4*)(scale + c0 + bj * 128 + 4);
                    const f32x4 v0 = acc[ai][bj][m][0] * s0, v1 = acc[ai][bj][m][1] * s1;
                    v4u o; o.x = pg8::cvt_pk_bf16(v0[0], v0[1]); o.y = pg8::cvt_pk_bf16(v0[2], v0[3]); o.z = pg8::cvt_pk_bf16(v1[0], v1[1]); o.w = pg8::cvt_pk_bf16(v1[2], v1[3]);
                    *(v4u*)(rp + bj * 128) = o; } }
    }
};
struct EpiOut {
    static constexpr int PERMK = 1; static constexpr bool PROBE2 = false;
    bf16* y;
    __device__ __forceinline__ void operator()(const f32x4 (&acc)[2][2][4][2], const DenseU& u, int wr, int wc, int fr, int fq) const {
        const int row0 = u.pm * 256 + wr * 64 + fr, col0 = u.pn * 256 + wc * 32 + 8 * fq;
#pragma unroll
        for (int ai = 0; ai < 2; ++ai)
#pragma unroll
            for (int m = 0; m < 4; ++m) { bf16* rp = y + (size_t)(row0 + ai * 128 + m * 16) * 2048 + col0;
#pragma unroll
                for (int bj = 0; bj < 2; ++bj) { const f32x4 v0 = acc[ai][bj][m][0], v1 = acc[ai][bj][m][1];
                    v4u o; o.x = pg8::cvt_pk_bf16(v0[0], v0[1]); o.y = pg8::cvt_pk_bf16(v0[2], v0[3]); o.z = pg8::cvt_pk_bf16(v1[0], v1[1]); o.w = pg8::cvt_pk_bf16(v1[2], v1[3]);
                    *(v4u*)(rp + bj * 128) = o; } }
    }
};
constexpr float SC_W = 256.f, SC_H = 16.f, SC_A = 16.f;
__device__ __forceinline__ unsigned pk4_fp8(float a, float b, float c, float d) {
    a = fminf(fmaxf(a, -448.f), 448.f); b = fminf(fmaxf(b, -448.f), 448.f); c = fminf(fmaxf(c, -448.f), 448.f); d = fminf(fmaxf(d, -448.f), 448.f);
    unsigned w = 0; w = __builtin_amdgcn_cvt_pk_fp8_f32(a, b, w, false); w = __builtin_amdgcn_cvt_pk_fp8_f32(c, d, w, true); return w;
}
struct EpiGU {
    static constexpr int PERMK = 1; static constexpr bool PROBE2 = false;
    unsigned char* act; const float* slot_w;
    __device__ __forceinline__ void operator()(const f32x4 (&acc)[2][2][4][2], const MoeU& u, int wr, int wc, int fr, int fq) const {
        const int c0 = u.pn * 128 + wc * 32 + 8 * fq; constexpr float inv = 1.f / (SC_W * SC_H);
#pragma unroll
        for (int ai = 0; ai < 2; ++ai)
#pragma unroll
            for (int m = 0; m < 4; ++m) { const int r = ai * 128 + wr * 64 + m * 16 + fr;
                if (r < u.nrows) { const float w = slot_w[u.row0 + r] * SC_A; float o[8];
#pragma unroll
                    for (int n = 0; n < 2; ++n)
#pragma unroll
                        for (int j = 0; j < 4; ++j) { const float g = acc[ai][0][m][n][j] * inv, up = acc[ai][1][m][n][j] * inv; o[n * 4 + j] = silu_f(g) * up * w; }
                    v2u q; q.x = pk4_fp8(o[0], o[1], o[2], o[3]); q.y = pk4_fp8(o[4], o[5], o[6], o[7]);
                    *(v2u*)(act + (size_t)(u.row0 + r) * 512 + c0) = q; } }
    }
};
constexpr float SC_O = 32.f;
struct EpiDown {
    static constexpr int PERMK = 2; static constexpr bool PROBE2 = true;
    unsigned char* so;
    __device__ __forceinline__ void operator()(const f32x4 (&acc)[2][2][4][2], const MoeU& u, int wr, int wc, int fr, int fq) const {
        const int c0 = u.pn * 256 + wc * 64 + 16 * fq; constexpr float sc = SC_O / (SC_W * SC_A);
#pragma unroll
        for (int ai = 0; ai < 2; ++ai)
#pragma unroll
            for (int m = 0; m < 4; ++m) { const int r = ai * 128 + wr * 64 + m * 16 + fr;
                if (r < u.nrows) { const f32x4 a0 = acc[ai][0][m][0] * sc, a1 = acc[ai][0][m][1] * sc, b0 = acc[ai][1][m][0] * sc, b1 = acc[ai][1][m][1] * sc;
                    v4u o; o.x = pk4_fp8(a0[0], a0[1], a0[2], a0[3]); o.y = pk4_fp8(a1[0], a1[1], a1[2], a1[3]); o.z = pk4_fp8(b0[0], b0[1], b0[2], b0[3]); o.w = pk4_fp8(b1[0], b1[1], b1[2], b1[3]);
                    __builtin_nontemporal_store(o, (v4u*)(so + (size_t)(u.row0 + r) * 2048 + c0)); } }
    }
};

__device__ __forceinline__ void tr_item(const float* W, int ldn, bf16* WT, int Kd, int drow0, int k0, int n0, LAS float* scr, int lane) {
    f32x4 t[8];
#pragma unroll
    for (int i = 0; i < 8; ++i) t[i] = *(const f32x4*)(W + (size_t)(k0 + 8 * i + (lane >> 3)) * ldn + n0 + 4 * (lane & 7));
#pragma unroll
    for (int i = 0; i < 8; ++i) { LAS float* d = scr + (8 * i + (lane >> 3)) * 33 + 4 * (lane & 7); d[0] = t[i][0]; d[1] = t[i][1]; d[2] = t[i][2]; d[3] = t[i][3]; }
    LDS_WAIT(); asm volatile("" ::: "memory");
    const int c = lane & 7;
#pragma unroll
    for (int j = 0; j < 4; ++j) { const int n = (lane >> 3) + 8 * j; const LAS float* s = scr + (8 * c) * 33 + n;
        v4u o; o.x = pk2(s[0 * 33], s[1 * 33]); o.y = pk2(s[2 * 33], s[3 * 33]); o.z = pk2(s[4 * 33], s[5 * 33]); o.w = pk2(s[6 * 33], s[7 * 33]);
        *(v4u*)(WT + (size_t)(drow0 + n) * Kd + k0 + 8 * c) = o; }
    LDS_WAIT(); asm volatile("" ::: "memory");
}

__device__ __forceinline__ void tr_item8(const float* W, int ldn, unsigned char* WT, int Kd, int drow0, int k0, int n0, LAS float* scr, int lane) {
    f32x4 t[8];
#pragma unroll
    for (int i = 0; i < 8; ++i) t[i] = *(const f32x4*)(W + (size_t)(k0 + 8 * i + (lane >> 3)) * ldn + n0 + 4 * (lane & 7));
#pragma unroll
    for (int i = 0; i < 8; ++i) { LAS float* d = scr + (8 * i + (lane >> 3)) * 33 + 4 * (lane & 7); d[0] = t[i][0]; d[1] = t[i][1]; d[2] = t[i][2]; d[3] = t[i][3]; }
    LDS_WAIT(); asm volatile("" ::: "memory");
    const int c = lane & 7;
#pragma unroll
    for (int j = 0; j < 4; ++j) { const int n = (lane >> 3) + 8 * j; const LAS float* s = scr + (8 * c) * 33 + n;
        v2u o; o.x = pk4_fp8(s[0 * 33] * SC_W, s[1 * 33] * SC_W, s[2 * 33] * SC_W, s[3 * 33] * SC_W); o.y = pk4_fp8(s[4 * 33] * SC_W, s[5 * 33] * SC_W, s[6 * 33] * SC_W, s[7 * 33] * SC_W);
        *(v2u*)(WT + (size_t)(drow0 + n) * Kd + k0 + 8 * c) = o; }
    LDS_WAIT(); asm volatile("" ::: "memory");
}

constexpr int I_IN = 32 * 129, I_OUT = 32 * 64, I_POOL = 4 * 4 * 8, I_E = 65 * 512;
constexpr int NITEMS = I_IN + I_OUT + I_POOL + 3 * I_E;
constexpr int NITEMS_P0 = NITEMS - 28672;
__device__ __forceinline__ void convert_items(const Args& a, LAS float* scr, int lane, int first, int step, int end) {
    unsigned char* ws = a.ws;
    bf16* Win_t = (bf16*)(ws + WS_WIN); bf16* Wout_t = (bf16*)(ws + WS_WOUT); bf16* Wpool_t = (bf16*)(ws + WS_WPOOL); unsigned char* Wd_t = ws + WS_WD; unsigned char* Wgu_t = ws + WS_WGU;
    for (int it = first; it < end; it += step) {
        int r = it;
        if (r < I_IN) { const int kb = r / 129, nb = r % 129, n0 = 32 * nb; const int drow = n0 < 3072 ? n0 : (n0 == 3072 ? 4096 : n0 - 32);
            tr_item(a.in[10], DIN, Win_t, 2048, drow, 64 * kb, n0, scr, lane); continue; } r -= I_IN;
        if (r < I_OUT) { const int kb = r / 64, nb = r % 64; tr_item(a.in[18], 2048, Wout_t, 2048, 32 * nb, 64 * kb, 32 * nb, scr, lane); continue; } r -= I_OUT;
        if (r < I_POOL) { const int g = r / 32, rr = r % 32, kb = rr / 8, nb = rr % 8; tr_item(a.in[16] + g * 65536, 256, Wpool_t + g * 65536, 256, 32 * nb, 64 * kb, 32 * nb, scr, lane); continue; } r -= I_POOL;
        if (r < I_E) { const int e = r / 512, rr = r % 512, kb = rr / 16, nb = rr % 16, n0 = 32 * nb; const float* src = e < 64 ? a.in[21] + (size_t)e * 2048 * 512 : a.in[24];
            tr_item8(src, 512, Wgu_t + (size_t)e * 1024 * 2048, 2048, (n0 / 128) * 256 + (n0 % 128), 64 * kb, n0, scr, lane); continue; } r -= I_E;
        if (r < I_E) { const int e = r / 512, rr = r % 512, kb = rr / 16, nb = rr % 16, n0 = 32 * nb; const float* src = e < 64 ? a.in[22] + (size_t)e * 2048 * 512 : a.in[25];
            tr_item8(src, 512, Wgu_t + (size_t)e * 1024 * 2048, 2048, (n0 / 128) * 256 + 128 + (n0 % 128), 64 * kb, n0, scr, lane); continue; } r -= I_E;
        { const int e = 64 - r / 512, rr = r % 512, kb = rr / 64, nb = rr % 64; const float* src = e < 64 ? a.in[23] + (size_t)e * 512 * 2048 : a.in[26];
            tr_item8(src, 2048, Wd_t + (size_t)e * 2048 * 512, 512, 32 * nb, 64 * kb, 32 * nb, scr, lane); }
    }
}

__device__ __forceinline__ void phase0(const Args& a, LAS unsigned char* lds, int tid, int lane, int wave, int vcu, int G, bool do_mod = true, bool do_tr = true) {
    unsigned char* ws = a.ws;
    if (vcu < 192 && do_mod) {
        LAS float* sc = (LAS float*)lds;
        LAS float* red = (LAS float*)(lds + 73728);
        for (int i = tid; i < 9 * 2048; i += 512) { const int r = i >> 11, k = i & 2047; const float v = r < 8 ? a.in[1][r * 2048 + k] : a.in[3][k]; sc[i] = silu_f(v); }
        __syncthreads();
        const float* wm = a.in[4]; const float* bm = a.in[5]; float* mod = (float*)(ws + WS_MOD);
        for (int chunk = vcu; chunk < 192; chunk += G) {
            const int n0 = chunk * 64, ks = lane >> 4, n4 = (lane & 15) * 4;
            f32x4 acc[9];
#pragma unroll
            for (int r = 0; r < 9; ++r) acc[r] = (f32x4){0.f, 0.f, 0.f, 0.f};
#pragma unroll 4
            for (int kk = 0; kk < 256; kk += 4) { const int k = wave * 256 + kk + ks; const f32x4 wv = *(const f32x4*)(wm + (size_t)k * 12288 + n0 + n4);
#pragma unroll
                for (int r = 0; r < 9; ++r) { const float s = sc[r * 2048 + k]; acc[r] += wv * s; } }
#pragma unroll
            for (int r = 0; r < 9; ++r)
#pragma unroll
                for (int j = 0; j < 4; ++j) { float v = acc[r][j]; v += __shfl_xor(v, 16); v += __shfl_xor(v, 32); acc[r][j] = v; }
            if (lane < 16) {
#pragma unroll
                for (int r = 0; r < 9; ++r) *(LAS f32x4*)(red + (wave * 9 + r) * 64 + n4) = acc[r]; }
            __syncthreads();
            for (int i = tid; i < 9 * 64; i += 512) { const int r = i >> 6, n = i & 63; float s = 0.f;
#pragma unroll
                for (int w = 0; w < 8; ++w) s += red[(w * 9 + r) * 64 + n];
                mod[r * 12288 + n0 + n] = s + bm[n0 + n]; }
            __syncthreads();
        }
    }
    __syncthreads();
    if (do_tr) convert_items(a, (LAS float*)(lds + wave * 16384), lane, vcu * 8 + wave, G * 8, NITEMS_P0);
    { const float* wr = a.in[19]; bf16* whi = (bf16*)(ws + WS_WRT); bf16* wlo = whi + 64 * 2048;
      for (int idx = vcu * 512 + tid; idx < 64 * 256; idx += G * 512) { const int e = idx >> 8, k8 = idx & 255; unsigned hi[8], lo[8];
#pragma unroll
          for (int j = 0; j < 8; ++j) { const float v = wr[(size_t)(8 * k8 + j) * 64 + e]; hi[j] = f2bf(v); lo[j] = f2bf(v - __builtin_bit_cast(float, hi[j] << 16)); }
          v4u oh, ol; oh.x = hi[0] | (hi[1] << 16); oh.y = hi[2] | (hi[3] << 16); oh.z = hi[4] | (hi[5] << 16); oh.w = hi[6] | (hi[7] << 16);
          ol.x = lo[0] | (lo[1] << 16); ol.y = lo[2] | (lo[3] << 16); ol.z = lo[4] | (lo[5] << 16); ol.w = lo[6] | (lo[7] << 16);
          *(v4u*)(whi + (size_t)e * 2048 + 8 * k8) = oh; (void)ol; (void)wlo; } }
    { v4u* z = (v4u*)((bf16*)(ws + WS_WIN) + (size_t)DIN * 2048); const int nz = (DINP - DIN) * 2048 / 8;
      for (int i = vcu * 512 + tid; i < nz; i += G * 512) z[i] = (v4u){0u, 0u, 0u, 0u}; }
}

__device__ __forceinline__ void phase1(const Args& a, int lane, int wave, int vcu, int G) {
    const float* mod = (const float*)(a.ws + WS_MOD); bf16* H = (bf16*)(a.ws + RA_H); const float* g = a.in[6];
    for (int m = vcu * 8 + wave; m < MROWS; m += G * 8) {
        const float* xr = m < NT ? a.in[0] + (size_t)m * 2048 : a.in[2] + (size_t)(m - NT) * 2048;
        const float* mr = mod + (size_t)(m < NT ? (m >> 11) : 8) * 12288;
        f32x4 v[8]; float ss = 0.f;
#pragma unroll
        for (int j = 0; j < 8; ++j) { v[j] = *(const f32x4*)(xr + 4 * (lane + 64 * j)); ss += v[j][0] * v[j][0] + v[j][1] * v[j][1] + v[j][2] * v[j][2] + v[j][3] * v[j][3]; }
        const float rstd = rsqrtf(wave_sum(ss) * (1.f / 2048.f) + EPS);
#pragma unroll
        for (int j = 0; j < 8; ++j) { const int c = 4 * (lane + 64 * j); const f32x4 gg = *(const f32x4*)(g + c), sh = *(const f32x4*)(mr + c), sc = *(const f32x4*)(mr + 2048 + c);
            const f32x4 o = v[j] * rstd * gg * (sc + 1.f) + sh;
            v2u q; q.x = pk2(o[0], o[1]); q.y = pk2(o[2], o[3]); *(v2u*)(H + (size_t)m * 2048 + c) = q; }
    }
}

__device__ __forceinline__ int scan_row(int b, int dir, int s) {
    if (s < 256) { const int tc = dir ? 255 - s : s; return NT + b * 256 + tc; }
    const int t0 = s - 256; return b * 2048 + (dir ? 2047 - t0 : t0);
}
__device__ __forceinline__ void prep_item(const Args& a, LAS unsigned char* lds, int tid, int dir, int b, int ch) {
    unsigned char* ws = a.ws;
    const bf16* Q = (const bf16*)(ws + RA_Q); const bf16* Kb = (const bf16*)(ws + RA_K); const float* ALR = (const float*)(ws + RA_ALR);
    v4u* QG = (v4u*)(ws + PQG); bf16* AM = (bf16*)(ws + PAM); bf16* KD = (bf16*)(ws + PKD); float* DEC = (float*)(ws + PDEC);
    constexpr int TS = 520;
    LAS float* alr = (LAS float*)lds;
    LAS bf16* Kt = (LAS bf16*)(lds + 4096);
    LAS bf16* Qt = (LAS bf16*)(lds + 4096 + 64 * TS * 2);
    const int col = tid, h = col >> 7, dk = col & 127;
    const int lane = tid & 63, wave = __builtin_amdgcn_readfirstlane(tid >> 6), l15 = lane & 15, l4 = lane >> 4;
    const bool lat = ch >= 4;
    if (tid < 256) { const int i = tid >> 2, r4 = (tid & 3) * 4; const int row = scan_row(b, dir, ch * 64 + i);
        *(LAS f32x4*)(alr + i * 16 + r4) = *(const f32x4*)(ALR + (size_t)row * 32 + dir * 16 + r4); }
    { v4u kr[8], qr[8];
#pragma unroll
      for (int q = 0; q < 8; ++q) { const int p = tid + 512 * q, i = p >> 6, c8 = (p & 63) * 8; const int row = scan_row(b, dir, ch * 64 + i);
          kr[q] = *(const v4u*)(Kb + (size_t)row * 512 + c8); if (lat) qr[q] = *(const v4u*)(Q + (size_t)row * 512 + c8); }
#pragma unroll
      for (int q = 0; q < 8; ++q) { const int p = tid + 512 * q, i = p >> 6, c8 = (p & 63) * 8; *(LAS v4u*)(Kt + i * TS + c8) = kr[q]; if (lat) *(LAS v4u*)(Qt + i * TS + c8) = qr[q]; } }
    const float* wa2 = dir ? a.in[13] : a.in[11]; const float bia = (dir ? a.in[14] : a.in[12])[col];
    float w[16];
#pragma unroll
    for (int r = 0; r < 16; ++r) w[r] = wa2[r * 512 + col];
    LDS_BARRIER();
    float Gv[64]; float Gc = 0.f;
#pragma unroll
    for (int i = 0; i < 64; ++i) { float z = bia;
#pragma unroll
        for (int r4 = 0; r4 < 4; ++r4) { const f32x4 x = *(const LAS f32x4*)(alr + i * 16 + 4 * r4); z += x[0] * w[4 * r4] + x[1] * w[4 * r4 + 1] + x[2] * w[4 * r4 + 2] + x[3] * w[4 * r4 + 3]; }
        Gc += (fminf(z, 0.f) - __logf(1.f + __expf(-fabsf(z)))) * (1.f / 16.f); Gv[i] = Gc; }
    const float Gmid = Gv[32], Gend = Gv[63];
    DEC[((size_t)(dir * 8 + b) * 36 + ch) * 512 + col] = __expf(Gend);
    bf16* kdrow = KD + ((((size_t)(dir * 8 + b) * 36 + ch) * 4 + h) * 128 + dk) * 64;
#pragma unroll
    for (int i0 = 0; i0 < 64; i0 += 8) { unsigned kd[8];
#pragma unroll
        for (int ii = 0; ii < 8; ++ii) { const int i = i0 + ii; const float kv = bf1(Kt[i * TS + col]);
            kd[ii] = f2bf(kv * __expf(Gend - Gv[i]));
            if (lat) { const float qv = bf1(Qt[i * TS + col]) * 0.08838834764831845f;
                Qt[i * TS + col] = (bf16)f2bf(qv * __expf(Gv[i] - Gmid)); Kt[i * TS + col] = (bf16)f2bf(kv * __expf(Gmid - Gv[i])); } }
        v4u o; o.x = kd[0] | (kd[1] << 16); o.y = kd[2] | (kd[3] << 16); o.z = kd[4] | (kd[5] << 16); o.w = kd[6] | (kd[7] << 16);
        *(v4u*)(kdrow + i0) = o; }
    if (lat) {
        LDS_BARRIER();
        const int hh = wave >> 1; bf16* amt = AM + ((((size_t)(dir * 8 + b) * 32 + (ch - 4)) * 4 + hh) * 64) * 64;
#pragma unroll
        for (int t2 = 0; t2 < 2; ++t2) { const int ti = (wave & 1) * 2 + t2; f32x4 c[4];
#pragma unroll
            for (int tj = 0; tj < 4; ++tj) c[tj] = (f32x4){0.f, 0.f, 0.f, 0.f};
#pragma unroll
            for (int ks = 0; ks < 4; ++ks) { const int ko = hh * 128 + 32 * ks + 8 * l4;
                const bf16x8 bq = *(const LAS bf16x8*)(Qt + (16 * ti + l15) * TS + ko);
#pragma unroll
                for (int tj = 0; tj < 4; ++tj) { const bf16x8 ak = *(const LAS bf16x8*)(Kt + (16 * tj + l15) * TS + ko);
                    c[tj] = __builtin_amdgcn_mfma_f32_16x16x32_bf16(ak, bq, c[tj], 0, 0, 0); } }
            const int i = 16 * ti + l15;
#pragma unroll
            for (int tj = 0; tj < 4; ++tj) { const int j0 = 16 * tj + 4 * l4;
                v2u p; p.x = pk2(j0 <= i ? c[tj][0] : 0.f, j0 + 1 <= i ? c[tj][1] : 0.f); p.y = pk2(j0 + 2 <= i ? c[tj][2] : 0.f, j0 + 3 <= i ? c[tj][3] : 0.f);
                *(v2u*)(amt + i * 64 + j0) = p; } }
        LDS_BARRIER();
        { const float eg = __expf(Gmid);
#pragma unroll 8
          for (int i = 0; i < 64; ++i) Qt[i * TS + col] = (bf16)f2bf(bf1(Qt[i * TS + col]) * eg); }
        LDS_BARRIER();
        { v4u* qgt = QG + ((((size_t)(dir * 8 + b) * 32 + (ch - 4)) * 4) * 1024);
#pragma unroll
          for (int q = 0; q < 8; ++q) { const int p = tid + 512 * q; const int hq = p >> 10, rem = p & 1023, i = rem >> 4, c16 = rem & 15;
              qgt[p] = *(const LAS v4u*)(Qt + i * TS + hq * 128 + c16 * 8); } }
    }
    LDS_BARRIER();
}
__device__ __forceinline__ void phase3_prep(const Args& a, LAS unsigned char* lds, int tid, int vcu, int G) {
    for (int item = vcu; item < 2 * 8 * 32; item += G) { const int lc = item & 31, b = (item >> 5) & 7, dir = item >> 8; prep_item(a, lds, tid, dir, b, 4 + lc); }
    for (int item = vcu; item < 2 * 8 * 4; item += G) { const int cc = item & 3, b = (item >> 2) & 7, dir = item >> 5; prep_item(a, lds, tid, dir, b, cc); }
}

constexpr int GL_QG = 0, GL_ST = 17408, GL_KDT = 34816, GL_VT = 53248, GL_AM = 62464, GL_DEC = 71680;
__device__ __forceinline__ void phase_chain(const Args& a, LAS unsigned char* lds, int tid, int lane, int wave, int vcu, int G) {
    unsigned char* ws = a.ws;
    const v4u* QG = (const v4u*)(ws + PQG); const v4u* AM = (const v4u*)(ws + PAM); const v4u* KD = (const v4u*)(ws + PKD); const float* DEC = (const float*)(ws + PDEC);
    const bf16* V = (const bf16*)(ws + RA_V); bf16* OF = (bf16*)(ws + RA_OF);
    const int l15 = lane & 15, l4 = lane >> 4;
    for (int item = vcu; item < 256; item += G) {
        const int vs = item & 3, dir = (item >> 2) & 1, h = (item >> 3) & 3, b = item >> 5;
        f32x4 S[4];
#pragma unroll
        for (int tv = 0; tv < 4; ++tv) S[tv] = (f32x4){0.f, 0.f, 0.f, 0.f};
        v4u rqA[2], raA, rkA[2], rvA, rqB[2], raB, rkB[2], rvB; float rdecA = 0.f, rdecB = 0.f;
#define GL_LOAD(ch_, LATL, rq, ra, rk, rv, rdec) do { const int ch__ = (ch_); \
            if (LATL) { const size_t t_ = ((((size_t)(dir * 8 + b) * 32 + (ch__ - 4)) * 4 + h) * 1024); rq[0] = QG[t_ + tid]; rq[1] = QG[t_ + tid + 512]; ra = AM[t_ / 2 + tid]; } \
            { const size_t t_ = ((((size_t)(dir * 8 + b) * 36 + ch__) * 4 + h) * 1024); rk[0] = KD[t_ + tid]; rk[1] = KD[t_ + tid + 512]; } \
            { const int row_ = scan_row(b, dir, ch__ * 64 + (tid >> 3)); rv = *(const v4u*)(V + (size_t)row_ * 1024 + h * 256 + vs * 64 + 8 * (tid & 7)); } \
            rdec = DEC[((size_t)(dir * 8 + b) * 36 + ch__) * 512 + h * 128 + (tid & 127)]; } while (0)
#define GL_STEP(ch_, LAT, LATN, MORE, rq, ra, rk, rv, rdec) do { const int ch = (ch_); \
              \
            _Pragma("unroll") for (int tv = 0; tv < 4; ++tv) { v2u p; p.x = pk2(S[tv][0], S[tv][1]); p.y = pk2(S[tv][2], S[tv][3]); \
                *(LAS v2u*)(lds + GL_ST + (16 * tv + l15) * 272 + (16 * wave + 4 * l4) * 2) = p; } \
            if (LAT) { _Pragma("unroll") for (int q = 0; q < 2; ++q) { const int p = tid + 512 * q; *(LAS v4u*)(lds + GL_QG + (p >> 4) * 272 + (p & 15) * 16) = rq[q]; } \
                *(LAS v4u*)(lds + GL_AM + (tid >> 3) * 144 + (tid & 7) * 16) = ra; } \
            _Pragma("unroll") for (int q = 0; q < 2; ++q) { const int p = tid + 512 * q; *(LAS v4u*)(lds + GL_KDT + (p >> 3) * 144 + (p & 7) * 16) = rk[q]; } \
            { const int i = tid >> 3, c = tid & 7; LAS bf16* vt = (LAS bf16*)(lds + GL_VT) + i; \
              vt[(8 * c + 0) * 72] = (bf16)(rv.x & 0xffffu); vt[(8 * c + 1) * 72] = (bf16)(rv.x >> 16); vt[(8 * c + 2) * 72] = (bf16)(rv.y & 0xffffu); vt[(8 * c + 3) * 72] = (bf16)(rv.y >> 16); \
              vt[(8 * c + 4) * 72] = (bf16)(rv.z & 0xffffu); vt[(8 * c + 5) * 72] = (bf16)(rv.z >> 16); vt[(8 * c + 6) * 72] = (bf16)(rv.w & 0xffffu); vt[(8 * c + 7) * 72] = (bf16)(rv.w >> 16); } \
            if (tid < 128) *(LAS float*)(lds + GL_DEC + tid * 4) = rdec; \
            LDS_BARRIER(); \
            if (MORE) GL_LOAD(ch + 2, LATN, rq, ra, rk, rv, rdec); \
            if (LAT) {   \
                const int ti = wave >> 1, tv0 = (wave & 1) * 2; f32x4 c0 = (f32x4){0.f, 0.f, 0.f, 0.f}, c1 = c0; bf16x8 fb[6], f0[6], f1[6]; \
                _Pragma("unroll") for (int ks = 0; ks < 4; ++ks) { const int ko = (32 * ks + 8 * l4) * 2; \
                    fb[ks] = *(const LAS bf16x8*)(lds + GL_QG + (16 * ti + l15) * 272 + ko); \
                    f0[ks] = *(const LAS bf16x8*)(lds + GL_ST + (16 * tv0 + l15) * 272 + ko); f1[ks] = *(const LAS bf16x8*)(lds + GL_ST + (16 * tv0 + 16 + l15) * 272 + ko); } \
                _Pragma("unroll") for (int ks = 0; ks < 2; ++ks) { const int ko = (32 * ks + 8 * l4) * 2; \
                    fb[4 + ks] = *(const LAS bf16x8*)(lds + GL_AM + (16 * ti + l15) * 144 + ko); \
                    f0[4 + ks] = *(const LAS bf16x8*)(lds + GL_VT + (16 * tv0 + l15) * 144 + ko); f1[4 + ks] = *(const LAS bf16x8*)(lds + GL_VT + (16 * tv0 + 16 + l15) * 144 + ko); } \
                _Pragma("unroll") for (int ks = 0; ks < 6; ++ks) { c0 = __builtin_amdgcn_mfma_f32_16x16x32_bf16(f0[ks], fb[ks], c0, 0, 0, 0); c1 = __builtin_amdgcn_mfma_f32_16x16x32_bf16(f1[ks], fb[ks], c1, 0, 0, 0); } \
                const int s_ = ch * 64 + 16 * ti + l15; const int t0 = s_ - 256; const int t = dir ? 2047 - t0 : t0; \
                bf16* orow = OF + ((size_t)dir * NT + b * 2048 + t) * 1024 + h * 256 + vs * 64 + 16 * tv0 + 4 * l4; \
                v2u p0, p1; p0.x = pk2(c0[0], c0[1]); p0.y = pk2(c0[2], c0[3]); p1.x = pk2(c1[0], c1[1]); p1.y = pk2(c1[2], c1[3]); \
                *(v2u*)(orow) = p0; *(v2u*)(orow + 16) = p1; } \
              \
            { const f32x4 d4 = *(const LAS f32x4*)(lds + GL_DEC + (16 * wave + 4 * l4) * 4); bf16x8 fk[2], fv[2][4]; \
              _Pragma("unroll") for (int ks = 0; ks < 2; ++ks) { const int ko = (32 * ks + 8 * l4) * 2; fk[ks] = *(const LAS bf16x8*)(lds + GL_KDT + (16 * wave + l15) * 144 + ko); \
                  _Pragma("unroll") for (int tv = 0; tv < 4; ++tv) fv[ks][tv] = *(const LAS bf16x8*)(lds + GL_VT + (16 * tv + l15) * 144 + ko); } \
              _Pragma("unroll") for (int tv = 0; tv < 4; ++tv) S[tv] = S[tv] * d4; \
              _Pragma("unroll") for (int ks = 0; ks < 2; ++ks) \
                  _Pragma("unroll") for (int tv = 0; tv < 4; ++tv) S[tv] = __builtin_amdgcn_mfma_f32_16x16x32_bf16(fk[ks], fv[ks][tv], S[tv], 0, 0, 0); } \
            LDS_BARRIER(); } while (0)
        GL_LOAD(0, false, rqA, raA, rkA, rvA, rdecA); GL_LOAD(1, false, rqB, raB, rkB, rvB, rdecB);
        GL_STEP(0, false, false, true, rqA, raA, rkA, rvA, rdecA); GL_STEP(1, false, false, true, rqB, raB, rkB, rvB, rdecB);
        GL_STEP(2, false, true, true, rqA, raA, rkA, rvA, rdecA);  GL_STEP(3, false, true, true, rqB, raB, rkB, rvB, rdecB);
#pragma unroll 1
        for (int c2 = 4; c2 < 34; c2 += 2) { GL_STEP(c2, true, true, true, rqA, raA, rkA, rvA, rdecA); GL_STEP(c2 + 1, true, true, true, rqB, raB, rkB, rvB, rdecB); }
        GL_STEP(34, true, true, false, rqA, raA, rkA, rvA, rdecA); GL_STEP(35, true, true, false, rqB, raB, rkB, rvB, rdecB);
#undef GL_STEP
#undef GL_LOAD
    }
}

template <int HALFW>
__device__ __forceinline__ void pool_item(const bf16* P, bf16* DP, LAS float* tmp, int tid, int b, int r, int g) {
    const int rlo = r - HALFW < 0 ? 0 : r - HALFW, rhi = r + HALFW > 32 ? 32 : r + HALFW;
    const float rinv = 1.f / (float)(rhi - rlo);
#pragma unroll 1
    for (int q = 0; q < 4; ++q) { const int p = tid + 512 * q, c = p >> 5, ch0 = (p & 31) * 8; float acc[8]; v4u x[2 * HALFW];
#pragma unroll
        for (int u = 0; u < 2 * HALFW; ++u) { const int rr = (rlo + u < rhi) ? rlo + u : rlo; x[u] = *(const v4u*)(P + ((size_t)(b * 2048 + rr * 64 + c)) * 1024 + g * 256 + ch0); }
#pragma unroll
        for (int j = 0; j < 8; ++j) acc[j] = 0.f;
#pragma unroll
        for (int u = 0; u < 2 * HALFW; ++u) { const float m = (rlo + u < rhi) ? 1.f : 0.f;
            acc[0] += m * bflo(x[u].x); acc[1] += m * bfhi(x[u].x); acc[2] += m * bflo(x[u].y); acc[3] += m * bfhi(x[u].y); acc[4] += m * bflo(x[u].z); acc[5] += m * bfhi(x[u].z); acc[6] += m * bflo(x[u].w); acc[7] += m * bfhi(x[u].w); }
        *(LAS f32x4*)(tmp + c * 256 + ch0) = (f32x4){acc[0] * rinv, acc[1] * rinv, acc[2] * rinv, acc[3] * rinv};
        *(LAS f32x4*)(tmp + c * 256 + ch0 + 4) = (f32x4){acc[4] * rinv, acc[5] * rinv, acc[6] * rinv, acc[7] * rinv}; }
    __syncthreads();
#pragma unroll 1
    for (int q = 0; q < 4; ++q) { const int p = tid + 512 * q, c = p >> 5, ch0 = (p & 31) * 8;
        const int clo = c - HALFW < 0 ? 0 : c - HALFW, chi = c + HALFW > 64 ? 64 : c + HALFW; const float cinv = 1.f / (float)(chi - clo);
        const size_t o = ((size_t)(b * 2048 + r * 64 + c)) * 1024 + g * 256 + ch0;
        const v4u x = *(const v4u*)(P + o);
        f32x4 a0 = (f32x4){0.f, 0.f, 0.f, 0.f}, a1 = a0;
#pragma unroll
        for (int u = 0; u < 2 * HALFW; ++u) { const int cc = (clo + u < chi) ? clo + u : clo; const float m = (clo + u < chi) ? 1.f : 0.f;
            a0 += *(const LAS f32x4*)(tmp + cc * 256 + ch0) * m; a1 += *(const LAS f32x4*)(tmp + cc * 256 + ch0 + 4) * m; }
        v4u d; d.x = pk2(a0[0] * cinv - bflo(x.x), a0[1] * cinv - bfhi(x.x)); d.y = pk2(a0[2] * cinv - bflo(x.y), a0[3] * cinv - bfhi(x.y));
        d.z = pk2(a1[0] * cinv - bflo(x.z), a1[1] * cinv - bfhi(x.z)); d.w = pk2(a1[2] * cinv - bflo(x.w), a1[3] * cinv - bfhi(x.w));
        *(v4u*)(DP + o) = d; }
    __syncthreads();
}
__device__ __forceinline__ void phase3_pool(const Args& a, LAS unsigned char* lds, int tid, int vcu, int G) {
    const bf16* P = (const bf16*)(a.ws + RA_P); bf16* DP = (bf16*)(a.ws + RA_DPOOL);
    LAS float* tmp = (LAS float*)lds;
    for (int item = vcu; item < 1024; item += G) {
        const int g = item >> 8, r = (item >> 3) & 31, b = item & 7;
        const int gg = 3 - g;
        if (gg == 0) pool_item<1>(P, DP, tmp, tid, b, r, gg); else if (gg == 1) pool_item<2>(P, DP, tmp, tid, b, r, gg); else if (gg == 2) pool_item<4>(P, DP, tmp, tid, b, r, gg); else pool_item<8>(P, DP, tmp, tid, b, r, gg);
    }
}

__device__ __forceinline__ void phase4_post(const Args& a, int lane, int wave, int vcu, int G) {
    const bf16* OF = (const bf16*)(a.ws + RA_OF); const bf16* OB = OF + (size_t)NT * 1024; const bf16* Rr = (const bf16*)(a.ws + RA_R); bf16* Y = (bf16*)(a.ws + RA_YMIX);
    const float* gn = a.in[15];
    f32x4 g4[4];
#pragma unroll
    for (int q = 0; q < 4; ++q) g4[q] = *(const f32x4*)(gn + 16 * lane + 4 * q);
#pragma unroll 2
    for (int t = vcu * 8 + wave; t < NT; t += G * 8) {
        const size_t o = (size_t)t * 1024 + 16 * lane;
        const v4u f0 = *(const v4u*)(OF + o), f1 = *(const v4u*)(OF + o + 8), b0 = *(const v4u*)(OB + o), b1 = *(const v4u*)(OB + o + 8), r0 = *(const v4u*)(Rr + o), r1 = *(const v4u*)(Rr + o + 8);
        float x[16], r[16];
#pragma unroll
        for (int w = 0; w < 4; ++w) { x[2 * w] = bflo(f0[w]) + bflo(b0[w]); x[2 * w + 1] = bfhi(f0[w]) + bfhi(b0[w]); x[8 + 2 * w] = bflo(f1[w]) + bflo(b1[w]); x[8 + 2 * w + 1] = bfhi(f1[w]) + bfhi(b1[w]);
            r[2 * w] = bflo(r0[w]); r[2 * w + 1] = bfhi(r0[w]); r[8 + 2 * w] = bflo(r1[w]); r[8 + 2 * w + 1] = bfhi(r1[w]); }
        float ss = 0.f;
#pragma unroll
        for (int q = 0; q < 16; ++q) ss += x[q] * x[q];
        ss += __shfl_xor(ss, 1); ss += __shfl_xor(ss, 2); ss += __shfl_xor(ss, 4); ss += __shfl_xor(ss, 8);
        const float sc = rsqrtf(ss * (1.f / 256.f) + EPS);
        float y[16];
#pragma unroll
        for (int q = 0; q < 16; ++q) y[q] = x[q] * sc * g4[q >> 2][q & 3] * silu_f(r[q]);
        v4u o0, o1;
#pragma unroll
        for (int w = 0; w < 4; ++w) { o0[w] = pk2(y[2 * w], y[2 * w + 1]); o1[w] = pk2(y[8 + 2 * w], y[8 + 2 * w + 1]); }
        bf16* yr = Y + (size_t)t * 2048 + 16 * lane;
        *(v4u*)(yr) = o0; *(v4u*)(yr + 8) = o1;
    }
}

__device__ __forceinline__ void phase6(const Args& a, LAS unsigned char* lds, int tid, int lane, int wave, int vcu, int G) {
    unsigned char* ws = a.ws;
    const float* mod = (const float*)(ws + WS_MOD); const bf16* Y1 = (const bf16*)(ws + RA_Y1); unsigned char* H2 = ws + RA_H2;
    const float* gpost = a.in[7]; const float* gpre2 = a.in[8]; const float* rbias = a.in[20];
    const bf16* whi = (const bf16*)(ws + WS_WRT);
    LAS float* part = (LAS float*)lds;
    LAS float* logit = (LAS float*)(lds + LDS_LOGIT);
    LAS u64* masks = (LAS u64*)(lds + LDS_MASKS);
    int* cnt = (int*)(ws + T_CNT); u64* tmask = (u64*)(ws + T_MASK); float* tokw = (float*)(ws + T_TOKW);
    const int l15 = lane & 15, l4 = lane >> 4;
    for (int blk = vcu; blk < NT / 64; blk += G) {
        for (int it = 0; it < 2; ++it) {
#pragma unroll 1
            for (int rep_ = 0; rep_ < P7_REP_ROWS; ++rep_) {
#pragma unroll 1
            for (int rr = 0; rr < 4; ++rr) {
                const int lr = wave * 4 + rr, t = blk * 64 + it * 32 + lr; const float* mr = mod + (size_t)(t >> 11) * 12288;
                const bf16* yr = Y1 + (size_t)t * 2048; const float* xr = a.in[0] + (size_t)t * 2048;
                f32x4 y[8]; float ss = 0.f;
#pragma unroll
                for (int j = 0; j < 8; ++j) { const v2u yb = *(const v2u*)(yr + 4 * (lane + 64 * j)); y[j] = (f32x4){bflo(yb.x), bfhi(yb.x), bflo(yb.y), bfhi(yb.y)}; ss += y[j][0] * y[j][0] + y[j][1] * y[j][1] + y[j][2] * y[j][2] + y[j][3] * y[j][3]; }
                const float rstd1 = rsqrtf(wave_sum(ss) * (1.f / 2048.f) + EPS);
                if (lane == 0) ((float*)(ws + T_RSTD1))[t] = rstd1;
                float s2 = 0.f;
#pragma unroll
                for (int j = 0; j < 8; ++j) { const int c = 4 * (lane + 64 * j); const f32x4 x = *(const f32x4*)(xr + c), gp = *(const f32x4*)(gpost + c), gt = *(const f32x4*)(mr + 4096 + c);
                    const f32x4 x1 = x + gt * (y[j] * rstd1 * gp); y[j] = x1;
                    s2 += x1[0] * x1[0] + x1[1] * x1[1] + x1[2] * x1[2] + x1[3] * x1[3]; }
                const float rstd2 = rsqrtf(wave_sum(s2) * (1.f / 2048.f) + EPS);
#pragma unroll
                for (int j = 0; j < 8; ++j) { const int c = 4 * (lane + 64 * j); const f32x4 g2 = *(const f32x4*)(gpre2 + c), sh = *(const f32x4*)(mr + 6144 + c), sc = *(const f32x4*)(mr + 8192 + c);
                    const f32x4 hh = y[j] * rstd2 * g2 * (sc + 1.f) + sh;
                    v2u qh; qh.x = pk2(hh[0], hh[1]); qh.y = pk2(hh[2], hh[3]);
                    *(LAS v2u*)(lds + RT_HI + lr * RT_ROWB + c * 2) = qh;
                    *(unsigned*)(H2 + (size_t)t * 2048 + c) = pk4_fp8(hh[0] * SC_H, hh[1] * SC_H, hh[2] * SC_H, hh[3] * SC_H); }
            }
            __syncthreads();
            }
            { f32x4 acc[2][4];
#pragma unroll
              for (int mt = 0; mt < 2; ++mt)
#pragma unroll
                  for (int et = 0; et < 4; ++et) acc[mt][et] = (f32x4){0.f, 0.f, 0.f, 0.f};
#pragma unroll 1
              for (int kh = 0; kh < 2; ++kh) {
                  bf16x8 bh[4][4];
#pragma unroll
                  for (int k4 = 0; k4 < 4; ++k4) { const int k0 = 256 * wave + 32 * (4 * kh + k4) + 8 * l4;
#pragma unroll
                      for (int et = 0; et < 4; ++et) bh[k4][et] = *(const bf16x8*)(whi + (size_t)(16 * et + l15) * 2048 + k0); }
#pragma unroll
                  for (int k4 = 0; k4 < 4; ++k4) { const int k0 = 256 * wave + 32 * (4 * kh + k4) + 8 * l4;
#pragma unroll
                      for (int mt = 0; mt < 2; ++mt) { const bf16x8 ah = *(const LAS bf16x8*)(lds + RT_HI + (16 * mt + l15) * RT_ROWB + k0 * 2);
#pragma unroll
                          for (int et = 0; et < 4; ++et) acc[mt][et] = __builtin_amdgcn_mfma_f32_16x16x32_bf16(ah, bh[k4][et], acc[mt][et], 0, 0, 0); } } }
              __syncthreads();
#pragma unroll
              for (int mt = 0; mt < 2; ++mt)
#pragma unroll
                  for (int et = 0; et < 4; ++et)
#pragma unroll
                      for (int q = 0; q < 4; ++q) part[(wave * 32 + 16 * mt + 4 * l4 + q) * 64 + 16 * et + l15] = acc[mt][et][q]; }
            __syncthreads();
#pragma unroll
            for (int q = 0; q < 4; ++q) { const int idx = tid + 512 * q; float sacc = 0.f;
#pragma unroll
                for (int w = 0; w < 8; ++w) sacc += part[w * 2048 + idx];
                logit[idx] = sacc; }
            __syncthreads();
#pragma unroll 1
            for (int rep_ = 0; rep_ < P7_REP_RT; ++rep_) {
#pragma unroll 1
            for (int rr = 0; rr < 4; ++rr) {
                const int lr = wave * 4 + rr, t = blk * 64 + it * 32 + lr;
                const float lg = logit[lr * 64 + lane]; const float s = 1.f / (1.f + __expf(-lg)); const float sel = s + rbias[lane];
                float m1 = sel; m1 = fmaxf(m1, __shfl_xor(m1, 1)); m1 = fmaxf(m1, __shfl_xor(m1, 2)); m1 = fmaxf(m1, __shfl_xor(m1, 4));
                const u64 eq = __ballot(sel == m1); const unsigned gb = (unsigned)(eq >> (lane & ~7)) & 0xffu; const int first = __builtin_ctz(gb);
                float v2 = ((lane & 7) == first) ? -INFINITY : sel; v2 = fmaxf(v2, __shfl_xor(v2, 1)); v2 = fmaxf(v2, __shfl_xor(v2, 2)); v2 = fmaxf(v2, __shfl_xor(v2, 4));
                const float gs = m1 + v2; const int g = lane >> 3; int grank = 0;
#pragma unroll
                for (int g2 = 0; g2 < 8; ++g2) { const float o = __builtin_bit_cast(float, __builtin_amdgcn_readlane(__builtin_bit_cast(int, gs), g2 * 8)); grank += (o > gs || (o == gs && g2 < g)) ? 1 : 0; }
                const bool gsel = grank < 4; const float mk = gsel ? sel : -INFINITY; int rank = 0;
#pragma unroll 8
                for (int e2 = 0; e2 < 64; ++e2) { const float o = __builtin_bit_cast(float, __builtin_amdgcn_readlane(__builtin_bit_cast(int, mk), e2)); rank += (o > mk || (o == mk && e2 < lane)) ? 1 : 0; }
                const bool chosen = gsel && rank < 8;
                const u64 mask = __ballot(chosen); const float ssum = wave_sum(chosen ? s : 0.f);
                const int kidx = __popcll(mask & ((1ull << lane) - 1ull));
                if (chosen) tokw[(size_t)t * 8 + kidx] = s / ssum * 2.5f;
                if (lane == 0) { tmask[t] = mask; masks[it * 32 + lr] = mask; }
            }
            __syncthreads();
            }
        }
        if (wave == 0) { const u64 m = masks[lane]; int mine = 0;
#pragma unroll 8
            for (int e = 0; e < 64; ++e) { const int c = __popcll(__ballot((m >> e) & 1ull)); mine = (lane == e) ? c : mine; }
            cnt[blk * 64 + lane] = mine; }
        __syncthreads();
    }
}

__device__ __forceinline__ void phase7(const Args& a, LAS unsigned char* lds, int tid, int lane, int wave, int vcu, int G) {
    unsigned char* ws = a.ws;
    const int* cnt = (const int*)(ws + T_CNT); const u64* tmask = (const u64*)(ws + T_MASK); const float* tokw = (const float*)(ws + T_TOKW);
    int* tokslot = (int*)(ws + T_TOKSLOT); int* slottok = (int*)(ws + T_SLOTTOK); float* slotw = (float*)(ws + T_SLOTW); int* tile = (int*)(ws + T_TILE);
    LAS int* part = (LAS int*)(lds + 131072);
    bool converted = false;
    for (int blk = vcu; blk < NT / 64; blk += G) {
        int pre = 0, all = 0;
#pragma unroll 8
        for (int b2 = wave; b2 < 256; b2 += 8) { const int c = cnt[b2 * 64 + lane]; all += c; pre += (b2 < blk) ? c : 0; }
        part[(wave * 2) * 64 + lane] = pre; part[(wave * 2 + 1) * 64 + lane] = all;
        LDS_BARRIER();
        if (wave == 0) {
            int p = 0, t = 0;
#pragma unroll
            for (int w = 0; w < 8; ++w) { p += part[(w * 2) * 64 + lane]; t += part[(w * 2 + 1) * 64 + lane]; }
            int incl = t;
#pragma unroll
            for (int o = 1; o < 64; o <<= 1) { const int v = __shfl_up(incl, o); if (lane >= o) incl += v; }
            const int start = incl - t; const int base = start + p;
            const int tokn = blk * 64 + lane; const u64 m = tmask[tokn];
#pragma unroll 8
            for (int e = 0; e < 64; ++e) { const bool bit = (m >> e) & 1ull; const u64 bal = __ballot(bit); const int be = __builtin_amdgcn_readlane(base, e);
                if (bit) { const int rank = __popcll(bal & ((1ull << lane) - 1ull)); const int slot = be + rank; const int k = __popcll(m & ((1ull << e) - 1ull));
                    slottok[slot] = tokn; slotw[slot] = tokw[(size_t)tokn * 8 + k]; tokslot[(size_t)tokn * 8 + k] = slot; } }
            slottok[SH_ROW0 + tokn] = tokn; slotw[SH_ROW0 + tokn] = 1.f;
            if (blk == 0) {
                const int nte = (t + 255) >> 8; int inc2 = nte;
#pragma unroll
                for (int o = 1; o < 64; o <<= 1) { const int v = __shfl_up(inc2, o); if (lane >= o) inc2 += v; }
                const int n0 = inc2 - nte; const int ntot = __builtin_amdgcn_readlane(inc2, 63);
                for (int j = 0; j < nte; ++j) { tile[n0 + j] = lane; tile[NTILE_MAX + n0 + j] = start + j * 256; tile[2 * NTILE_MAX + n0 + j] = (t - j * 256) < 256 ? (t - j * 256) : 256; }
                tile[ntot + lane] = 64; tile[NTILE_MAX + ntot + lane] = SH_ROW0 + lane * 256; tile[2 * NTILE_MAX + ntot + lane] = 256;
                if (lane == 0) tile[3 * NTILE_MAX] = ntot + 64;
            }
        } else if (!converted) {
            converted = true;
            convert_items(a, (LAS float*)(lds + wave * 16384), lane, NITEMS_P0 + vcu * 7 + (wave - 1), G * 7, NITEMS);
        }
        LDS_BARRIER();
    }
}

__device__ __forceinline__ void phase10(const Args& a, LAS unsigned char* lds, int lane, int wave, int vcu, int G) {
    unsigned char* ws = a.ws;
    const float* mod = (const float*)(ws + WS_MOD); const unsigned char* SO = ws + WS_SLOTOUT; const int* tokslot = (const int*)(ws + T_TOKSLOT); const float* gp = a.in[9];
    LAS float* ysc = (LAS float*)(lds + wave * 8192);
    const unsigned lo16_ = 16u * (unsigned)lane;
#pragma unroll 1
    for (int t = vcu * 8 + wave; t < NT; t += G * 8) {
        const float* mr = mod + (size_t)(t >> 11) * 12288;
        const int myslot = lane < 8 ? tokslot[(size_t)t * 8 + lane] : SH_ROW0 + t;
        unsigned lo16 = lo16_; asm volatile("" : "+v"(lo16));
        v4u x[9][2]; f32x4 xo[8]; v2u yb[8];
        const unsigned char* x1r = (const unsigned char*)(a.in[0] + (size_t)t * 2048); const unsigned char* y1r = (const unsigned char*)((const bf16*)(ws + RA_Y1) + (size_t)t * 2048);
        const float rstd1 = ((const float*)(ws + T_RSTD1))[t];
#pragma unroll
        for (int k = 0; k < 9; ++k) { const int slot = __builtin_amdgcn_readlane(myslot, k); const unsigned char* sr = SO + (size_t)slot * 2048;
#pragma unroll
            for (int j = 0; j < 2; ++j) x[k][j] = *(const v4u*)(sr + (lo16 + 1024u * j)); }
        float y[2][16];
#pragma unroll
        for (int j = 0; j < 2; ++j)
#pragma unroll
            for (int q = 0; q < 16; ++q) y[j][q] = 0.f;
#pragma unroll
        for (int k = 0; k < 9; ++k)
#pragma unroll
            for (int j = 0; j < 2; ++j) { v4u v = x[k][j]; asm volatile("" : "+v"(v) : "v"(y[j][0]), "v"(y[j][15]));
#pragma unroll
                for (int w = 0; w < 4; ++w) { const unsigned d = v[w]; const auto lo = __builtin_amdgcn_cvt_pk_f32_fp8(d, false), hi = __builtin_amdgcn_cvt_pk_f32_fp8(d, true);
                    y[j][4 * w] += lo[0]; y[j][4 * w + 1] += lo[1]; y[j][4 * w + 2] += hi[0]; y[j][4 * w + 3] += hi[1]; } }
        asm volatile("" ::: "memory");
#pragma unroll
        for (int j = 0; j < 8; ++j) { xo[j] = *(const f32x4*)(x1r + (lo16 + 1024u * j)); yb[j] = *(const v2u*)(y1r + (lo16 / 2u + 512u * j)); }
        float ss = 0.f;
#pragma unroll
        for (int j = 0; j < 2; ++j)
#pragma unroll
            for (int q = 0; q < 16; ++q) ss += y[j][q] * y[j][q];
        const float rstd = rsqrtf(wave_sum(ss) * (1.f / 2048.f) + EPS * SC_O * SC_O);
#pragma unroll
        for (int j = 0; j < 2; ++j)
#pragma unroll
            for (int q = 0; q < 4; ++q) *(LAS f32x4*)(ysc + 16 * (lane + 64 * j) + 4 * q) = (f32x4){y[j][4 * q], y[j][4 * q + 1], y[j][4 * q + 2], y[j][4 * q + 3]};
        LDS_WAIT(); asm volatile("" ::: "memory");
        unsigned char* outr = (unsigned char*)(a.out + (size_t)t * 2048); const unsigned char* gpb = (const unsigned char*)gp; const unsigned char* g1b = (const unsigned char*)a.in[7];
        const unsigned char* gt2b = (const unsigned char*)(mr + 10240); const unsigned char* gt1b = (const unsigned char*)(mr + 4096);
#pragma unroll
        for (int j = 0; j < 8; ++j) { const unsigned cb = lo16 + 1024u * j; const f32x4 yy = *(const LAS f32x4*)(ysc + 4 * (lane + 64 * j)), g = *(const f32x4*)(gpb + cb), gt = *(const f32x4*)(gt2b + cb);
            const f32x4 g1 = *(const f32x4*)(g1b + cb), gt1 = *(const f32x4*)(gt1b + cb); const f32x4 y1 = (f32x4){bflo(yb[j].x), bfhi(yb[j].x), bflo(yb[j].y), bfhi(yb[j].y)};
            const f32x4 x1 = xo[j] + gt1 * (y1 * rstd1 * g1);
            *(f32x4*)(outr + cb) = x1 + gt * (yy * rstd * g); }
        LDS_WAIT(); asm volatile("" ::: "memory");
    }
}

__global__ void __launch_bounds__(512, 2) fwd(Args args) {
    extern __shared__ __attribute__((aligned(16))) unsigned char lds_raw[];
    LAS unsigned char* lds = (LAS unsigned char*)lds_raw;
    const int tid = threadIdx.x, lane = tid & 63, wave = __builtin_amdgcn_readfirstlane(tid >> 6);
    const int G = gridDim.x, bx = blockIdx.x;
    const int vcu = (G % 8 == 0) ? (bx % 8) * (G / 8) + bx / 8 : bx;
    unsigned char* ws = args.ws;
    volatile LAS unsigned* MISC = (volatile LAS unsigned*)(lds + LDS_MISC);
    if (tid < 64) MISC[tid] = 0u;
    __syncthreads();
    const int lo = args.ph_lo, hi = args.ph_hi;
    XcdBarrier bar; bar.bar = (unsigned*)(ws + WS_CTL) + 4096; bar.x = 0; bar.st = nullptr;
    if (hi - lo > 1) bar = xcd_barrier_post((unsigned*)(ws + WS_CTL) + 4096, MISC + 8);
#ifndef PH_MASK
#define PH_MASK 0xfff
#endif
#define IN(k) (((PH_MASK >> (k)) & 1) && lo <= (k) && (k) < hi)
#define SEAM(k) do { if (IN(k) && IN((k) + 1)) xcd_barrier(bar); } while (0)

#ifndef REP_PHASE
#define REP_PHASE -1
#endif
#define PH_IDS int tz_ = threadIdx.x; asm volatile("" : "+v"(tz_)); const int tid = tz_, lane = tz_ & 63, wave = __builtin_amdgcn_readfirstlane(tz_ >> 6); (void)tid; (void)lane; (void)wave;
#define RUNPH(k, ...) do { if (IN(k)) { { PH_IDS __VA_ARGS__ } if (REP_PHASE == (k)) { xcd_barrier(bar); { PH_IDS __VA_ARGS__ } } SEAM(k); } } while (0)
#ifdef PROBE_P0
    if (IN(0)) { { PH_IDS phase0(args, lds, tid, lane, wave, vcu, G); } xcd_barrier(bar); { PH_IDS phase0(args, lds, tid, lane, wave, vcu, G, PROBE_P0 == 1, PROBE_P0 == 2); } SEAM(0); }
#else
    RUNPH(0, phase0(args, lds, tid, lane, wave, vcu, G););
#endif
    RUNPH(1, phase1(args, lane, wave, vcu, G););
    RUNPH(2, {
        DenseSched S; S.init(ws + RA_H, ws + WS_WIN, 2048, 2048, MROWS, DINP, G, bx);
        EpiIn E{ws};
        pg8::gemm_phase<EpiIn, DenseSched>(lds, 2048, S, E); });
#ifndef P3_REP_PREP
#define P3_REP_PREP 1
#endif
#ifndef P3_REP_POOL
#define P3_REP_POOL 1
#endif
    RUNPH(3, for (int r_ = 0; r_ < P3_REP_PREP; ++r_) phase3_prep(args, lds, tid, vcu, G); for (int r_ = 0; r_ < P3_REP_POOL; ++r_) phase3_pool(args, lds, tid, vcu, G););
    RUNPH(4, phase_chain(args, lds, tid, lane, wave, vcu, G););
    RUNPH(5, {
        phase4_post(args, lane, wave, vcu, G);
        PoolSched S{(const char*)(ws + RA_DPOOL), (const char*)(ws + WS_WPOOL), G, vcu};
        EpiPool E{(bf16*)(ws + RA_YMIX), args.in[17]};
        int kpool = 256; asm volatile("" : "+s"(kpool));
        pg8::gemm_phase<EpiPool, PoolSched>(lds, kpool, S, E); });
    RUNPH(6, {
        DenseSched S; S.init(ws + RA_YMIX, ws + WS_WOUT, 2048, 2048, NT, 2048, G, bx);
        EpiOut E{(bf16*)(ws + RA_Y1)};
        pg8::gemm_phase<EpiOut, DenseSched>(lds, 2048, S, E); });
    RUNPH(7, phase6(args, lds, tid, lane, wave, vcu, G););
    RUNPH(8, phase7(args, lds, tid, lane, wave, vcu, G););
    RUNPH(9, {
        MoeGUSched S{(const char*)(ws + RA_H2), (const char*)(ws + WS_WGU), (const int*)(ws + T_TILE), (const int*)(ws + T_SLOTTOK), G, vcu};
        EpiGU E{ws + WS_ACT, (const float*)(ws + T_SLOTW)};
        int kgu = 1024; asm volatile("" : "+s"(kgu));
        pg8::gemm_phase<EpiGU, MoeGUSched, true>(lds, kgu, S, E); });
    RUNPH(10, {
        MoeDownSched S{(const char*)(ws + WS_ACT), (const char*)(ws + WS_WD), (const int*)(ws + T_TILE), G, vcu};
        EpiDown E{ws + WS_SLOTOUT};
        int kdn = 256; asm volatile("" : "+s"(kdn));
        pg8::gemm_phase<EpiDown, MoeDownSched, true>(lds, kdn, S, E); });
    if (IN(11)) { { PH_IDS phase10(args, lds, lane, wave, vcu, G); } if (REP_PHASE == 11) { xcd_barrier(bar); { PH_IDS phase10(args, lds, lane, wave, vcu, G); } } }
#undef IN
#undef SEAM
}

extern "C" void kernel_launch(void* const* d_in, const int* in_sizes, int n_in, void* d_out, int out_size, void* d_ws, size_t ws_size, hipStream_t stream) {
    static int grid = 0;
    if (grid == 0) {
        if (n_in != 27 || out_size != NT * DM || ws_size < WS_NEED) { fprintf(stderr, "kernel_launch: unexpected problem: n_in %d out %d ws %zu (need %zu)\n", n_in, out_size, ws_size, (size_t)WS_NEED); grid = -1; return; }
        int dev = 0, cus = 0, per_cu = 0;
        if (hipGetDevice(&dev) != hipSuccess || hipDeviceGetAttribute(&cus, hipDeviceAttributeMultiprocessorCount, dev) != hipSuccess) { grid = -1; return; }
        if (hipFuncSetAttribute((const void*)fwd, hipFuncAttributeMaxDynamicSharedMemorySize, LDS_BYTES) != hipSuccess) { fprintf(stderr, "kernel_launch: hipFuncSetAttribute failed\n"); grid = -1; return; }
        if (hipOccupancyMaxActiveBlocksPerMultiprocessor(&per_cu, (const void*)fwd, 512, LDS_BYTES) != hipSuccess || per_cu < 1) { fprintf(stderr, "kernel_launch: occupancy query says %d\n", per_cu); }
        (void)hipGetLastError();
        grid = cus;
    }
    if (grid < 0) return;
    (void)hipMemsetAsync((char*)d_ws + WS_CTL, 0, CTL_ZERO_BYTES, stream);
    Args a{};
    for (int i = 0; i < 27; ++i) a.in[i] = (const float*)d_in[i];
    a.out = (float*)d_out; a.ws = (unsigned char*)d_ws;
    if (N_LAUNCHES == 1) {
        a.ph_lo = 0; a.ph_hi = NPH;
        hipLaunchKernelGGL(fwd, dim3(grid), dim3(512), LDS_BYTES, stream, a);
    } else {
        for (int p = 0; p < NPH; ++p) { a.ph_lo = p; a.ph_hi = p + 1; hipLaunchKernelGGL(fwd, dim3(grid), dim3(512), LDS_BYTES, stream, a); }
    }
}
```

```cpp
#include <hip/hip_runtime.h>
#include <cstdio>
#include <cstdint>

#ifndef P7_REP_ROWS
#define P7_REP_ROWS 1
#endif
#ifndef P7_REP_LOG
#define P7_REP_LOG 1
#endif
#ifndef P7_REP_RT
#define P7_REP_RT 1
#endif
#ifndef N_LAUNCHES
#define N_LAUNCHES 1
#endif

#define GAS __attribute__((address_space(1)))
#define LAS __attribute__((address_space(3)))
typedef unsigned short bf16;
typedef unsigned v4u __attribute__((ext_vector_type(4)));
typedef unsigned v2u __attribute__((ext_vector_type(2)));
typedef float f32x4 __attribute__((ext_vector_type(4)));
typedef short bf16x8 __attribute__((ext_vector_type(8)));
typedef unsigned long long u64;

constexpr int NB = 8, SEQ = 2048, DM = 2048, CTXL = 256;
constexpr int NT = NB * SEQ;
constexpr int NTC = NB * CTXL;
constexpr int MROWS = NT + NTC;
constexpr int DIN = 4128, DINP = 4352;
constexpr int NE = 64, TOPK = 8, DE = 512;
constexpr int NSLOT_E = NT * TOPK;
constexpr int SH_ROW0 = NSLOT_E + 256;
constexpr int NSLOT = SH_ROW0 + NT;
constexpr int NTILE_MAX = 704;
constexpr float EPS = 1e-6f;
constexpr int NPH = 12;

constexpr size_t MiB = 1u << 20;
constexpr size_t WS_CTL = 0, CTL_ZERO_BYTES = 64 * 1024;
constexpr size_t WS_MOD = 1 * MiB;
constexpr size_t WS_WRT = 1 * MiB + 512 * 1024;
constexpr size_t WS_WIN = 2 * MiB;
constexpr size_t WS_WOUT = WS_WIN + 17 * MiB;
constexpr size_t WS_WPOOL = WS_WOUT + 8 * MiB;
constexpr size_t WS_WD = WS_WPOOL + 1 * MiB;
constexpr size_t WS_WGU = WS_WD + 130 * MiB;
constexpr size_t WS_RA = WS_WGU + 260 * MiB;
constexpr size_t RA_H = WS_RA;
constexpr size_t RA_OF = WS_RA;
constexpr size_t RA_H2 = WS_RA;
constexpr size_t RA_Q = WS_RA + 128 * MiB;
constexpr size_t RA_K = RA_Q + 16 * MiB;
constexpr size_t RA_V = RA_K + 18 * MiB;
constexpr size_t RA_R = RA_V + 36 * MiB;
constexpr size_t RA_P = RA_R + 32 * MiB;
constexpr size_t RA_ALR = RA_P + 32 * MiB;
constexpr size_t RA_DPOOL = RA_ALR + 3 * MiB;
constexpr size_t RA_YMIX = RA_DPOOL + 32 * MiB;
constexpr size_t RA_Y1 = WS_RA + 128 * MiB;
constexpr size_t RA_END = RA_YMIX + 64 * MiB;
constexpr size_t WS_SLOTOUT = WS_WGU;
constexpr size_t WS_ACT = RA_END > WS_SLOTOUT + 578 * MiB ? RA_END : WS_SLOTOUT + 578 * MiB;
constexpr size_t WS_END = WS_ACT + 145 * MiB;
constexpr size_t PQG = WS_ACT;
constexpr size_t PAM = WS_ACT + 32 * MiB;
constexpr size_t PKD = WS_ACT + 96 * MiB;
constexpr size_t PDEC = WS_ACT + 132 * MiB;
constexpr size_t WS_T0 = WS_END;
constexpr size_t T_CNT = WS_T0;
constexpr size_t T_MASK = T_CNT + 65536;
constexpr size_t T_TOKW = T_MASK + 131072;
constexpr size_t T_TOKSLOT = T_TOKW + 524288;
constexpr size_t T_SLOTTOK = T_TOKSLOT + 524288;
constexpr size_t T_SLOTW = T_SLOTTOK + 655360;
constexpr size_t T_TILE = T_SLOTW + 655360;
constexpr size_t T_RSTD1 = (T_TILE + 16384 + 4095) / 4096 * 4096;
constexpr size_t WS_NEED = T_RSTD1 + (size_t)NT * 4;

constexpr int RING_BYTES = 131072;
constexpr int LDS_BYTES = 147456;
constexpr int LDS_MISC = LDS_BYTES - 256;
constexpr int RT_ROWB = 4112;
constexpr int RT_HI = 0;
constexpr int LDS_LOGIT = 32 * RT_ROWB;
constexpr int LDS_MASKS = LDS_LOGIT + 8192;
static_assert(LDS_MASKS + 512 <= LDS_MISC, "LDS map");

#define LDS_WAIT() asm volatile("s_waitcnt lgkmcnt(0)" ::: "memory")
#define LDS_BARRIER() do { asm volatile("s_waitcnt lgkmcnt(0)" ::: "memory"); __builtin_amdgcn_s_barrier(); asm volatile("" ::: "memory"); } while (0)
#define VM_WAIT() asm volatile("s_waitcnt vmcnt(0)" ::: "memory")

__device__ __forceinline__ unsigned f2bf(float f) { unsigned u = __builtin_bit_cast(unsigned, f); return (u + 0x7fffu + ((u >> 16) & 1u)) >> 16; }
__device__ __forceinline__ unsigned pk2(float lo, float hi) { return f2bf(lo) | (f2bf(hi) << 16); }
__device__ __forceinline__ float bflo(unsigned u) { return __builtin_bit_cast(float, u << 16); }
__device__ __forceinline__ float bfhi(unsigned u) { return __builtin_bit_cast(float, u & 0xffff0000u); }
__device__ __forceinline__ float bf1(bf16 b) { return __builtin_bit_cast(float, ((unsigned)b) << 16); }
__device__ __forceinline__ float wave_sum(float v) {
#pragma unroll
    for (int o = 1; o < 64; o <<= 1) v += __shfl_xor(v, o);
    return v;
}
__device__ __forceinline__ float silu_f(float x) { return x / (1.f + __expf(-x)); }

#define XB_TMO      128
#define XB_XCNT(j)  (256  + 64 * (j))
#define XB_XSUB(j)  (1280 + 64 * (j))
#define XB_XGEN(j)  (2304 + 64 * (j))
#define XB_TOP      3328
#define XB_TOPGEN   3392
#define XCD_BAR_WORDS 3456
#define XB_SPIN_CAP (1u << 18)

__device__ __forceinline__ unsigned xb_ld(unsigned* p)              { return __hip_atomic_load(p, __ATOMIC_RELAXED, __HIP_MEMORY_SCOPE_AGENT); }
__device__ __forceinline__ unsigned xb_add(unsigned* p, unsigned v) { return __hip_atomic_fetch_add(p, v, __ATOMIC_RELAXED, __HIP_MEMORY_SCOPE_AGENT); }
__device__ __forceinline__ unsigned xb_xcc_id() { return (unsigned)__builtin_amdgcn_s_getreg((3 << 11) | 20) & 0xFu; }
#define XB_SPIN(cond, bar) do { unsigned _sp = 0; while (cond) { __builtin_amdgcn_s_sleep(1); \
    if ((++_sp & 255u) == 0u) { if (xb_ld(&(bar)[XB_TMO])) break; if (_sp > XB_SPIN_CAP) { atomicAdd(&(bar)[XB_TMO], 1u); break; } } } } while (0)

struct XcdBarrier { unsigned* bar; unsigned x; volatile LAS unsigned* st; };

__device__ __forceinline__ XcdBarrier xcd_barrier_post(unsigned* bar, volatile LAS unsigned* st) {
    XcdBarrier b; b.bar = bar; b.x = xb_xcc_id(); b.st = st;
    if (threadIdx.x == 0) (void)xb_add(&bar[XB_XCNT(b.x)], 1u);
    return b;
}
__device__ __forceinline__ void xcd_barrier_complete(unsigned* bar, unsigned x, unsigned& nloc, unsigned& nx) {
    const unsigned G = gridDim.x * gridDim.y * gridDim.z;
    unsigned sum, cnt, mine, sp = 0u;
    for (;;) {
        sum = 0u; cnt = 0u; mine = 0u;
#pragma unroll
        for (unsigned j = 0; j < 16; ++j) { const unsigned c = xb_ld(&bar[XB_XCNT(j)]); sum += c; cnt += (c > 0u) ? 1u : 0u; mine = (j == x) ? c : mine; }
        if (sum == G) break;
        __builtin_amdgcn_s_sleep(1);
        if ((++sp & 255u) == 0u) { if (xb_ld(&bar[XB_TMO])) break; if (sp > XB_SPIN_CAP) { atomicAdd(&bar[XB_TMO], 1u); break; } }
    }
    nloc = mine > 0u ? mine : 1u; nx = cnt > 0u ? cnt : 1u;
}
__device__ __forceinline__ void xcd_barrier(const XcdBarrier& b) {
    asm volatile("s_waitcnt vmcnt(0)" ::: "memory");
    __syncthreads();
    if (threadIdx.x == 0) {
        unsigned* bar = b.bar;
        __builtin_amdgcn_s_waitcnt(0);
        unsigned nloc = b.st[0], nx = b.st[1];
        if (nloc == 0u) { xcd_barrier_complete(bar, b.x, nloc, nx); b.st[0] = nloc; b.st[1] = nx; }
        const unsigned old = xb_add(&bar[XB_XSUB(b.x)], 1u);
        const unsigned gen = old / nloc;
        if (old + 1u == (gen + 1u) * nloc) {
            __builtin_amdgcn_fence(__ATOMIC_RELEASE, "agent");
            asm volatile("s_waitcnt vmcnt(0)" ::: "memory");
            const unsigned og = xb_add(&bar[XB_TOP], 1u);
            const unsigned tg = og / nx;
            if (og + 1u == (tg + 1u) * nx) xb_add(&bar[XB_TOPGEN], 1u);
            else XB_SPIN(xb_ld(&bar[XB_TOPGEN]) == tg, bar);
            __builtin_amdgcn_fence(__ATOMIC_ACQUIRE, "agent");
            xb_add(&bar[XB_XGEN(b.x)], 1u);
            asm volatile("s_waitcnt vmcnt(0)" ::: "memory");
        } else {
            XB_SPIN(xb_ld(&bar[XB_XGEN(b.x)]) == gen, bar);
            __builtin_amdgcn_fence(__ATOMIC_ACQUIRE, "agent");
            asm volatile("s_waitcnt vmcnt(0)" ::: "memory");
        }
    }
    __syncthreads();
}

namespace pg8 {
constexpr int BM = 256, BK = 64, HALF = 128, HTB = HALF * BK * 2, STAGE_BYTES = 8 * HTB, NXCD = 8, WGM = 8;
__device__ __forceinline__ int lds_byte(int r, int c) { const int st = (r >> 4) * 2 + (c >> 5), rr = r & 15, cc = c & 31, ob = rr * 64 + cc * 2; return st * 1024 + (ob ^ (((ob >> 9) & 1) << 5)); }
__device__ __forceinline__ void stage_rc(int b, int& R, int& C) { const int st = b / 1024, sb = b % 1024, swz = sb ^ (((sb >> 9) & 1) << 5); R = (st >> 1) * 16 + swz / 64; C = (st & 1) * 32 + (swz % 64) / 2; }
__device__ __forceinline__ int perm32(int rho) { const int n = rho >> 4, i = rho & 15; return 8 * (i >> 2) + 4 * n + (i & 3); }
__device__ __forceinline__ unsigned cvt_pk_bf16(float lo, float hi) { unsigned r; asm volatile("v_cvt_pk_bf16_f32 %0, %1, %2" : "=v"(r) : "v"(lo), "v"(hi)); return r; }

typedef int v8i __attribute__((ext_vector_type(8)));
typedef int v4i __attribute__((ext_vector_type(4)));
template <class Epi, class Sched, bool FP8 = false>
__device__ __forceinline__ void gemm_phase(LAS unsigned char* lds, const int K, const Sched& S, const Epi& E) {
    typedef typename Sched::U Unit;
    const int tid = threadIdx.x, wid = __builtin_amdgcn_readfirstlane(tid >> 6), lane = tid & 63, wr = wid >> 2, wc = wid & 3, fr = lane & 15, fq = lane >> 4;
    const int nt = K / BK;
    int R[2], C[2]; unsigned voffB[2];
#pragma unroll
    for (int i = 0; i < 2; ++i) { stage_rc(tid * 16 + i * 8192, R[i], C[i]);
        const int Rb = Epi::PERMK == 2 ? (64 * (R[i] >> 5) + 16 * ((R[i] & 15) >> 2) + 4 * ((R[i] >> 4) & 1) + (R[i] & 3)) : (Epi::PERMK == 1 ? ((R[i] & ~31) + perm32(R[i] & 31)) : R[i]);
        voffB[i] = (unsigned)(Rb * K + C[i]) * 2u; }
    const size_t kstep = (size_t)(BK * 2);
    const size_t hstepB = (size_t)(Epi::PERMK == 2 ? 8 : HALF) * K * 2;
    const unsigned ldsw = (unsigned)wid * 1024u;
    const int aoff = lds_byte(wr * 64 + fr, fq * 8), boff = lds_byte(wc * 32 + fr, fq * 8);
#define PG8_SA(b, h) (((b) * 2 + (h)) * HTB)
#define PG8_SB(b, h) ((4 + (b) * 2 + (h)) * HTB)
#define PG8_STAGE(bufoff, gbase, v0, v1) do { \
        __builtin_amdgcn_global_load_lds((const unsigned*)((const char*)(gbase) + (v0)), (LAS unsigned*)(lds + (bufoff) + ldsw), 16, 0, 0); \
        __builtin_amdgcn_global_load_lds((const unsigned*)((const char*)(gbase) + (v1)), (LAS unsigned*)(lds + (bufoff) + ldsw + 8192), 16, 0, 0); } while (0)
#define PG8_LDA(dst, b, h) do { _Pragma("unroll") for (int m = 0; m < 4; ++m) { const v4i lo_ = *(const LAS v4i*)(lds + PG8_SA(b, h) + aoff + m * 2048), hi_ = *(const LAS v4i*)(lds + PG8_SA(b, h) + aoff + m * 2048 + 1024); \
        dst[m] = __builtin_shufflevector(lo_, hi_, 0, 1, 2, 3, 4, 5, 6, 7); } } while (0)
#define PG8_LDB(dst, b, h) do { _Pragma("unroll") for (int n = 0; n < 2; ++n) { const v4i lo_ = *(const LAS v4i*)(lds + PG8_SB(b, h) + boff + n * 2048), hi_ = *(const LAS v4i*)(lds + PG8_SB(b, h) + boff + n * 2048 + 1024); \
        dst[n] = __builtin_shufflevector(lo_, hi_, 0, 1, 2, 3, 4, 5, 6, 7); } } while (0)
#define PG8_H0(x) ((bf16x8)__builtin_shufflevector(x, x, 0, 1, 2, 3))
#define PG8_H1(x) ((bf16x8)__builtin_shufflevector(x, x, 4, 5, 6, 7))
#define PG8_MMA(ai, bj, At, Bt) do { __builtin_amdgcn_s_setprio(1); if constexpr (FP8) asm volatile("s_nop 4"); _Pragma("unroll") for (int m = 0; m < 4; ++m) _Pragma("unroll") for (int n = 0; n < 2; ++n) { \
        if constexpr (FP8) asm volatile("v_mfma_f32_16x16x128_f8f6f4 %0, %1, %2, %0" : "+v"(acc[ai][bj][m][n]) : "v"(Bt[n]), "v"(At[m])); \
        else { acc[ai][bj][m][n] = __builtin_amdgcn_mfma_f32_16x16x32_bf16(PG8_H0(Bt[n]), PG8_H0(At[m]), acc[ai][bj][m][n], 0, 0, 0); \
               acc[ai][bj][m][n] = __builtin_amdgcn_mfma_f32_16x16x32_bf16(PG8_H1(Bt[n]), PG8_H1(At[m]), acc[ai][bj][m][n], 0, 0, 0); } } \
        __builtin_amdgcn_s_setprio(0); } while (0)
#define PG8_WAIT_V(n) asm volatile("s_waitcnt vmcnt(" #n ")" ::: "memory")
#define PG8_WAIT_L(n) asm volatile("s_waitcnt lgkmcnt(" #n ")" ::: "memory")
#define PG8_BAR __builtin_amdgcn_s_barrier()
#define PG8_SCHED __builtin_amdgcn_sched_barrier(0)
    Unit cur, nxt; int ui = 0;
    if (!S.next(0, cur)) return;
    f32x4 acc[2][2][4][2];
#pragma unroll
    for (int a = 0; a < 2; ++a)
#pragma unroll
        for (int b = 0; b < 2; ++b)
#pragma unroll
            for (int m = 0; m < 4; ++m)
#pragma unroll
                for (int n = 0; n < 2; ++n) acc[a][b][m][n] = (f32x4){0.f, 0.f, 0.f, 0.f};
    v8i At[4], B0[2], B1[2];
    unsigned vA[4], vN[4];
    S.aoffs(cur, R, C, vA);
    const char* cA = cur.A; const char* cB = cur.B;
    PG8_STAGE(PG8_SB(0, 0), cB, voffB[0], voffB[1]); PG8_STAGE(PG8_SB(0, 1), cB + hstepB, voffB[0], voffB[1]); PG8_STAGE(PG8_SA(0, 0), cA, vA[0], vA[1]); PG8_STAGE(PG8_SA(0, 1), cA, vA[2], vA[3]);
    if (wr == 1) PG8_BAR;
    PG8_WAIT_V(2); PG8_BAR;
    PG8_STAGE(PG8_SB(1, 0), cB + kstep, voffB[0], voffB[1]); PG8_STAGE(PG8_SA(1, 0), cA + kstep, vA[0], vA[1]); PG8_STAGE(PG8_SB(1, 1), cB + hstepB + kstep, voffB[0], voffB[1]);
    PG8_WAIT_V(6); PG8_BAR;
    for (;;) {
        const bool has_next = S.next(ui + 1, nxt);
        const char* nA = has_next ? nxt.A : cA; const char* nB = has_next ? nxt.B : cB;
        if (has_next) S.aoffs(nxt, R, C, vN); else { vN[0] = vA[0]; vN[1] = vA[1]; vN[2] = vA[2]; vN[3] = vA[3]; }
        for (int t = 0; t < nt; t += 2) {
            const bool last = (t == nt - 2);
            const char* a1 = cA + (size_t)(t + 1) * kstep;
            const char* a2 = last ? nA : cA + (size_t)(t + 2) * kstep; const char* b2 = last ? nB : cB + (size_t)(t + 2) * kstep;
            const char* a3 = a2 + kstep; const char* b3 = b2 + kstep;
            const unsigned x0 = last ? vN[0] : vA[0], x1 = last ? vN[1] : vA[1], x2 = last ? vN[2] : vA[2], x3 = last ? vN[3] : vA[3];
            PG8_LDB(B0, 0, 0); PG8_LDB(B1, 0, 1); PG8_SCHED; PG8_LDA(At, 0, 0); PG8_STAGE(PG8_SA(1, 1), a1, vA[2], vA[3]);
            PG8_WAIT_V(8); PG8_WAIT_L(0); PG8_BAR; PG8_MMA(0, 0, At, B0); PG8_MMA(0, 1, At, B1); PG8_BAR; PG8_SCHED;
            PG8_LDA(At, 0, 1); PG8_STAGE(PG8_SB(0, 0), b2, voffB[0], voffB[1]); PG8_STAGE(PG8_SB(0, 1), b2 + hstepB, voffB[0], voffB[1]); PG8_STAGE(PG8_SA(0, 0), a2, x0, x1);
            PG8_WAIT_V(8); PG8_WAIT_L(0); PG8_BAR; PG8_MMA(1, 0, At, B0); PG8_MMA(1, 1, At, B1); PG8_BAR; PG8_SCHED;
            PG8_LDB(B0, 1, 0); PG8_LDB(B1, 1, 1); PG8_SCHED; PG8_LDA(At, 1, 0); PG8_STAGE(PG8_SA(0, 1), a2, x2, x3);
            PG8_WAIT_V(8); PG8_WAIT_L(0); PG8_BAR; PG8_MMA(0, 0, At, B0); PG8_MMA(0, 1, At, B1); PG8_BAR; PG8_SCHED;
            PG8_LDA(At, 1, 1); PG8_STAGE(PG8_SB(1, 0), b3, voffB[0], voffB[1]); PG8_STAGE(PG8_SB(1, 1), b3 + hstepB, voffB[0], voffB[1]); PG8_STAGE(PG8_SA(1, 0), a3, x0, x1);
            PG8_WAIT_V(8); PG8_WAIT_L(0); PG8_BAR; PG8_MMA(1, 0, At, B0); PG8_MMA(1, 1, At, B1); PG8_BAR; PG8_SCHED;
        }
        if (wr == 0) PG8_BAR;
        if constexpr (FP8) asm volatile("s_nop 15\n\ts_nop 15");
        { int tz = threadIdx.x; asm volatile("" : "+v"(tz));
          const int wid_ = tz >> 6, lane_ = tz & 63; E(acc, cur, wid_ >> 2, wid_ & 3, lane_ & 15, lane_ >> 4);
#ifdef PROBE_EPI2
          if constexpr (Epi::PROBE2) { asm volatile("" : "+v"(tz)); const int w2 = tz >> 6, l2 = tz & 63; E(acc, cur, w2 >> 2, w2 & 3, l2 & 15, l2 >> 4); }
#endif
#ifdef PROBE_DRAIN
          if constexpr (Epi::PROBE2) { asm volatile("s_waitcnt vmcnt(0)" ::: "memory"); }
#endif
        }
        if (!has_next) break;
#pragma unroll
        for (int a = 0; a < 2; ++a)
#pragma unroll
            for (int b = 0; b < 2; ++b)
#pragma unroll
                for (int m = 0; m < 4; ++m)
#pragma unroll
                    for (int n = 0; n < 2; ++n) acc[a][b][m][n] = (f32x4){0.f, 0.f, 0.f, 0.f};
        cur = nxt; cA = nA; cB = nB; ++ui;
        vA[0] = vN[0]; vA[1] = vN[1]; vA[2] = vN[2]; vA[3] = vN[3];
        if (wr == 1) PG8_BAR;
    }
    PG8_WAIT_V(0);
    PG8_BAR;
#undef PG8_SA
#undef PG8_SB
#undef PG8_STAGE
#undef PG8_LDA
#undef PG8_LDB
#undef PG8_H0
#undef PG8_H1
#undef PG8_MMA
#undef PG8_WAIT_V
#undef PG8_WAIT_L
#undef PG8_BAR
#undef PG8_SCHED
}
}

struct Args { const float* in[27]; float* out; unsigned char* ws; int ph_lo, ph_hi; };
static_assert(sizeof(Args) == 27 * 8 + 8 + 8 + 8, "Args has no padding");

struct DenseU { const char* A; const char* B; int pm, pn; };
struct DenseSched {
    typedef DenseU U;
    const char* A; const char* B; int lda, K, nM, nN, nwg, G, c;
    __device__ __forceinline__ void init(const void* A_, const void* B_, int lda_, int K_, int M, int N, int G_, int c_) { A = (const char*)A_; B = (const char*)B_; lda = lda_; K = K_; nM = M / 256; nN = N / 256; nwg = nM * nN; G = G_; c = c_; }
    __device__ __forceinline__ bool next(int i, U& u) const {
        const long L = (long)i * G + c; if (L >= nwg) return false;
        int wgid = (int)L; { const int q = nwg / 8, r = nwg % 8, xcd = wgid % 8, off = wgid / 8; wgid = (xcd < r ? xcd * (q + 1) : r * (q + 1) + (xcd - r) * q) + off; }
        const int nig = 8 * nN, gid = wgid / nig, fm = gid * 8, gsz = (nM - fm) < 8 ? (nM - fm) : 8;
        u.pm = fm + ((wgid % nig) % gsz); u.pn = (wgid % nig) / gsz;
        u.A = A + (size_t)u.pm * 256 * lda * 2; u.B = B + (size_t)u.pn * 256 * K * 2; return true;
    }
    __device__ __forceinline__ void aoffs(const U&, const int (&R)[2], const int (&C)[2], unsigned (&v)[4]) const {
#pragma unroll
        for (int h = 0; h < 2; ++h)
#pragma unroll
            for (int i = 0; i < 2; ++i) v[h * 2 + i] = (unsigned)((h * 128 + R[i]) * lda + C[i]) * 2u;
    }
};
struct PoolU { const char* A; const char* B; int pm, g; };
struct PoolSched {
    typedef PoolU U;
    const char* A; const char* B; int G, c;
    __device__ __forceinline__ bool next(int i, U& u) const {
        const int L = i * G + c; if (L >= 256) return false;
        u.g = L & 3; u.pm = L >> 2;
        u.A = A + ((size_t)u.pm * 256 * 1024 + u.g * 256) * 2; u.B = B + (size_t)u.g * 256 * 256 * 2; return true;
    }
    __device__ __forceinline__ void aoffs(const U&, const int (&R)[2], const int (&C)[2], unsigned (&v)[4]) const {
#pragma unroll
        for (int h = 0; h < 2; ++h)
#pragma unroll
            for (int i = 0; i < 2; ++i) v[h * 2 + i] = (unsigned)((h * 128 + R[i]) * 1024 + C[i]) * 2u;
    }
};
struct MoeU { const char* A; const char* B; int row0, nrows, pn; };
struct MoeGUSched {
    typedef MoeU U;
    const char* H2; const char* W; const int* tile; const int* slot_tok; int G, c;
    __device__ __forceinline__ bool next(int i, U& u) const {
        const int nt = tile[3 * NTILE_MAX]; const int L = i * G + c; if (L >= nt * 4) return false;
        const int t = L >> 2; u.pn = L & 3; const int e = tile[t]; u.row0 = tile[NTILE_MAX + t]; u.nrows = tile[2 * NTILE_MAX + t];
        u.A = H2; u.B = W + ((size_t)e * 1024 + u.pn * 256) * 2048; return true;
    }
    __device__ __forceinline__ void aoffs(const U& u, const int (&R)[2], const int (&C)[2], unsigned (&v)[4]) const {
#pragma unroll
        for (int h = 0; h < 2; ++h)
#pragma unroll
            for (int i = 0; i < 2; ++i) { int r = h * 128 + R[i]; r = r < u.nrows ? r : u.nrows - 1; const int tok = slot_tok[u.row0 + r]; v[h * 2 + i] = (unsigned)(tok * 1024 + C[i]) * 2u; }
    }
};
struct MoeDownSched {
    typedef MoeU U;
    const char* ACT; const char* W; const int* tile; int G, c;
    __device__ __forceinline__ bool next(int i, U& u) const {
        const int nt = tile[3 * NTILE_MAX]; const int L = i * G + c; if (L >= nt * 8) return false;
        const int t = L >> 3; u.pn = L & 7; const int e = tile[t]; u.row0 = tile[NTILE_MAX + t]; u.nrows = tile[2 * NTILE_MAX + t];
        u.A = ACT + (size_t)u.row0 * 512; u.B = W + ((size_t)e * 2048 + u.pn * 256) * 512; return true;
    }
    __device__ __forceinline__ void aoffs(const U&, const int (&R)[2], const int (&C)[2], unsigned (&v)[4]) const {
#pragma unroll
        for (int h = 0; h < 2; ++h)
#pragma unroll
            for (int i = 0; i < 2; ++i) v[h * 2 + i] = (unsigned)((h * 128 + R[i]) * 256 + C[i]) * 2u;
    }
};

struct EpiIn {
    static constexpr int PERMK = 1; static constexpr bool PROBE2 = false;
    unsigned char* ws;
    __device__ __forceinline__ void operator()(const f32x4 (&acc)[2][2][4][2], const DenseU& u, int wr, int wc, int fr, int fq) const {
        const int pn = u.pn; const int row0 = u.pm * 256 + wr * 64 + fr;
        if (pn == 16) {
            if (wc != 0) return;
            float* alr = (float*)(ws + RA_ALR);
#pragma unroll
            for (int ai = 0; ai < 2; ++ai)
#pragma unroll
                for (int m = 0; m < 4; ++m) { float* rp = alr + (size_t)(row0 + ai * 128 + m * 16) * 32 + 8 * fq;
                    *(f32x4*)(rp) = acc[ai][0][m][0]; *(f32x4*)(rp + 4) = acc[ai][0][m][1]; }
            return;
        }
        bf16* base; int ld, colt; bool lat_only;
        if (pn < 2) { base = (bf16*)(ws + RA_Q); ld = 512; colt = pn * 256; lat_only = true; }
        else if (pn < 4) { base = (bf16*)(ws + RA_K); ld = 512; colt = (pn - 2) * 256; lat_only = false; }
        else if (pn < 8) { base = (bf16*)(ws + RA_V); ld = 1024; colt = (pn - 4) * 256; lat_only = false; }
        else if (pn < 12) { base = (bf16*)(ws + RA_R); ld = 1024; colt = (pn - 8) * 256; lat_only = true; }
        else { base = (bf16*)(ws + RA_P); ld = 1024; colt = (pn - 12) * 256; lat_only = true; }
        if (lat_only && u.pm >= 64) return;
        const int col0 = colt + wc * 32 + 8 * fq;
#pragma unroll
        for (int ai = 0; ai < 2; ++ai)
#pragma unroll
            for (int m = 0; m < 4; ++m) { bf16* rp = base + (size_t)(row0 + ai * 128 + m * 16) * ld + col0;
#pragma unroll
                for (int bj = 0; bj < 2; ++bj) { const f32x4 v0 = acc[ai][bj][m][0], v1 = acc[ai][bj][m][1];
                    v4u o; o.x = pg8::cvt_pk_bf16(v0[0], v0[1]); o.y = pg8::cvt_pk_bf16(v0[2], v0[3]); o.z = pg8::cvt_pk_bf16(v1[0], v1[1]); o.w = pg8::cvt_pk_bf16(v1[2], v1[3]);
                    *(v4u*)(rp + bj * 128) = o; } }
    }
};
struct EpiPool {
    static constexpr int PERMK = 1; static constexpr bool PROBE2 = false;
    bf16* ymix; const float* scale;
    __device__ __forceinline__ void operator()(const f32x4 (&acc)[2][2][4][2], const PoolU& u, int wr, int wc, int fr, int fq) const {
        const int row0 = u.pm * 256 + wr * 64 + fr; const int c0 = u.g * 256 + wc * 32 + 8 * fq;
#pragma unroll
        for (int ai = 0; ai < 2; ++ai)
#pragma unroll
            for (int m = 0; m < 4; ++m) { bf16* rp = ymix + (size_t)(row0 + ai * 128 + m * 16) * 2048 + 1024 + c0;
#pragma unroll
                for (int bj = 0; bj < 2; ++bj) { const f32x4 s0 = *(const f32x4*)(scale + c0 + bj * 128), s1 = *(const f32x4*)(scale + c0 + bj * 128 + 4);
                    const f32x4 v0 = acc[ai][bj][m][0] * s0, v1 = acc[ai][bj][m][1] * s1;
                    v4u o; o.x = pg8::cvt_pk_bf16(v0[0], v0[1]); o.y = pg8::cvt_pk_bf16(v0[2], v0[3]); o.z = pg8::cvt_pk_bf16(v1[0], v1[1]); o.w = pg8::cvt_pk_bf16(v1[2], v1[3]);
                    *(v4u*)(rp + bj * 128) = o; } }
    }
};
struct EpiOut {
    static constexpr int PERMK = 1; static constexpr bool PROBE2 = false;
    bf16* y;
    __device__ __forceinline__ void operator()(const f32x4 (&acc)[2][2][4][2], const DenseU& u, int wr, int wc, int fr, int fq) const {
        const int row0 = u.pm * 256 + wr * 64 + fr, col0 = u.pn * 256 + wc * 32 + 8 * fq;
#pragma unroll
        for (int ai = 0; ai < 2; ++ai)
#pragma unroll
            for (int m = 0; m < 4; ++m) { bf16* rp = y + (size_t)(row0 + ai * 128 + m * 16) * 2048 + col0;
#pragma unroll
                for (int bj = 0; bj < 2; ++bj) { const f32x4 v0 = acc[ai][bj][m][0], v1 = acc[ai][bj][m][1];
                    v4u o; o.x = pg8::cvt_pk_bf16(v0[0], v0[1]); o.y = pg8::cvt_pk_bf16(v0[2], v0[3]); o.z = pg8::cvt_pk_bf16(v1[0], v1[1]); o.w = pg8::cvt_pk_bf16(v1[2], v1[3]);
                    *(v4u*)(rp + bj * 128) = o; } }
    }
};
constexpr float SC_W = 256.f, SC_H = 16.f, SC_A = 16.f;
__device__ __forceinline__ unsigned pk4_fp8(float a, float b, float c, float d) {
    a = fminf(fmaxf(a, -448.f), 448.f); b = fminf(fmaxf(b, -448.f), 448.f); c = fminf(fmaxf(c, -448.f), 448.f); d = fminf(fmaxf(d, -448.f), 448.f);
    unsigned w = 0; w = __builtin_amdgcn_cvt_pk_fp8_f32(a, b, w, false); w = __builtin_amdgcn_cvt_pk_fp8_f32(c, d, w, true); return w;
}
struct EpiGU {
    static constexpr int PERMK = 1; static constexpr bool PROBE2 = false;
    unsigned char* act; const float* slot_w;
    __device__ __forceinline__ void operator()(const f32x4 (&acc)[2][2][4][2], const MoeU& u, int wr, int wc, int fr, int fq) const {
        const int c0 = u.pn * 128 + wc * 32 + 8 * fq; constexpr float inv = 1.f / (SC_W * SC_H);
#pragma unroll
        for (int ai = 0; ai < 2; ++ai)
#pragma unroll
            for (int m = 0; m < 4; ++m) { const int r = ai * 128 + wr * 64 + m * 16 + fr;
                if (r < u.nrows) { const float w = slot_w[u.row0 + r] * SC_A; float o[8];
#pragma unroll
                    for (int n = 0; n < 2; ++n)
#pragma unroll
                        for (int j = 0; j < 4; ++j) { const float g = acc[ai][0][m][n][j] * inv, up = acc[ai][1][m][n][j] * inv; o[n * 4 + j] = silu_f(g) * up * w; }
                    v2u q; q.x = pk4_fp8(o[0], o[1], o[2], o[3]); q.y = pk4_fp8(o[4], o[5], o[6], o[7]);
                    *(v2u*)(act + (size_t)(u.row0 + r) * 512 + c0) = q; } }
    }
};
constexpr float SC_O = 32.f;
struct EpiDown {
    static constexpr int PERMK = 2; static constexpr bool PROBE2 = true;
    unsigned char* so;
    __device__ __forceinline__ void operator()(const f32x4 (&acc)[2][2][4][2], const MoeU& u, int wr, int wc, int fr, int fq) const {
        const int c0 = u.pn * 256 + wc * 64 + 16 * fq; constexpr float sc = SC_O / (SC_W * SC_A);
#pragma unroll
        for (int ai = 0; ai < 2; ++ai)
#pragma unroll
            for (int m = 0; m < 4; ++m) { const int r = ai * 128 + wr * 64 + m * 16 + fr;
                if (r < u.nrows) { const f32x4 a0 = acc[ai][0][m][0] * sc, a1 = acc[ai][0][m][1] * sc, b0 = acc[ai][1][m][0] * sc, b1 = acc[ai][1][m][1] * sc;
                    v4u o; o.x = pk4_fp8(a0[0], a0[1], a0[2], a0[3]); o.y = pk4_fp8(a1[0], a1[1], a1[2], a1[3]); o.z = pk4_fp8(b0[0], b0[1], b0[2], b0[3]); o.w = pk4_fp8(b1[0], b1[1], b1[2], b1[3]);
                    __builtin_nontemporal_store(o, (v4u*)(so + (size_t)(u.row0 + r) * 2048 + c0)); } }
    }
};

__device__ __forceinline__ void tr_item(const float* W, int ldn, bf16* WT, int Kd, int drow0, int k0, int n0, LAS float* scr, int lane) {
    f32x4 t[8];
#pragma unroll
    for (int i = 0; i < 8; ++i) t[i] = *(const f32x4*)(W + (size_t)(k0 + 8 * i + (lane >> 3)) * ldn + n0 + 4 * (lane & 7));
#pragma unroll
    for (int i = 0; i < 8; ++i) { LAS float* d = scr + (8 * i + (lane >> 3)) * 33 + 4 * (lane & 7); d[0] = t[i][0]; d[1] = t[i][1]; d[2] = t[i][2]; d[3] = t[i][3]; }
    LDS_WAIT(); asm volatile("" ::: "memory");
    const int c = lane & 7;
#pragma unroll
    for (int j = 0; j < 4; ++j) { const int n = (lane >> 3) + 8 * j; const LAS float* s = scr + (8 * c) * 33 + n;
        v4u o; o.x = pk2(s[0 * 33], s[1 * 33]); o.y = pk2(s[2 * 33], s[3 * 33]); o.z = pk2(s[4 * 33], s[5 * 33]); o.w = pk2(s[6 * 33], s[7 * 33]);
        *(v4u*)(WT + (size_t)(drow0 + n) * Kd + k0 + 8 * c) = o; }
    LDS_WAIT(); asm volatile("" ::: "memory");
}

__device__ __forceinline__ void tr_item8(const float* W, int ldn, unsigned char* WT, int Kd, int drow0, int k0, int n0, LAS float* scr, int lane) {
    f32x4 t[8];
#pragma unroll
    for (int i = 0; i < 8; ++i) t[i] = *(const f32x4*)(W + (size_t)(k0 + 8 * i + (lane >> 3)) * ldn + n0 + 4 * (lane & 7));
#pragma unroll
    for (int i = 0; i < 8; ++i) { LAS float* d = scr + (8 * i + (lane >> 3)) * 33 + 4 * (lane & 7); d[0] = t[i][0]; d[1] = t[i][1]; d[2] = t[i][2]; d[3] = t[i][3]; }
    LDS_WAIT(); asm volatile("" ::: "memory");
    const int c = lane & 7;
#pragma unroll
    for (int j = 0; j < 4; ++j) { const int n = (lane >> 3) + 8 * j; const LAS float* s = scr + (8 * c) * 33 + n;
        v2u o; o.x = pk4_fp8(s[0 * 33] * SC_W, s[1 * 33] * SC_W, s[2 * 33] * SC_W, s[3 * 33] * SC_W); o.y = pk4_fp8(s[4 * 33] * SC_W, s[5 * 33] * SC_W, s[6 * 33] * SC_W, s[7 * 33] * SC_W);
        *(v2u*)(WT + (size_t)(drow0 + n) * Kd + k0 + 8 * c) = o; }
    LDS_WAIT(); asm volatile("" ::: "memory");
}

constexpr int I_IN = 32 * 129, I_OUT = 32 * 64, I_POOL = 4 * 4 * 8, I_E = 65 * 512;
constexpr int NITEMS = I_IN + I_OUT + I_POOL + 3 * I_E;
constexpr int NITEMS_P0 = NITEMS - 28672;
__device__ __forceinline__ void convert_items(const Args& a, LAS float* scr, int lane, int first, int step, int end, int skip = 0) {
    unsigned char* ws = a.ws;
    bf16* Win_t = (bf16*)(ws + WS_WIN); bf16* Wout_t = (bf16*)(ws + WS_WOUT); bf16* Wpool_t = (bf16*)(ws + WS_WPOOL); unsigned char* Wd_t = ws + WS_WD; unsigned char* Wgu_t = ws + WS_WGU;
    for (int it = first; it < end; it += step) {
        int r = it < I_IN + I_OUT + I_POOL ? it : it + skip;
        if (r < I_IN) { const int kb = r / 129, nb = r % 129, n0 = 32 * nb; const int drow = n0 < 3072 ? n0 : (n0 == 3072 ? 4096 : n0 - 32);
            tr_item(a.in[10], DIN, Win_t, 2048, drow, 64 * kb, n0, scr, lane); continue; } r -= I_IN;
        if (r < I_OUT) { const int kb = r / 64, nb = r % 64; tr_item(a.in[18], 2048, Wout_t, 2048, 32 * nb, 64 * kb, 32 * nb, scr, lane); continue; } r -= I_OUT;
        if (r < I_POOL) { const int g = r / 32, rr = r % 32, kb = rr / 8, nb = rr % 8; tr_item(a.in[16] + g * 65536, 256, Wpool_t + g * 65536, 256, 32 * nb, 64 * kb, 32 * nb, scr, lane); continue; } r -= I_POOL;
        if (r < I_E) { const int e = r / 512, rr = r % 512, kb = rr / 16, nb = rr % 16, n0 = 32 * nb; const float* src = e < 64 ? a.in[21] + (size_t)e * 2048 * 512 : a.in[24];
            tr_item8(src, 512, Wgu_t + (size_t)e * 1024 * 2048, 2048, (n0 / 128) * 256 + (n0 % 128), 64 * kb, n0, scr, lane); continue; } r -= I_E;
        if (r < I_E) { const int e = r / 512, rr = r % 512, kb = rr / 16, nb = rr % 16, n0 = 32 * nb; const float* src = e < 64 ? a.in[22] + (size_t)e * 2048 * 512 : a.in[25];
            tr_item8(src, 512, Wgu_t + (size_t)e * 1024 * 2048, 2048, (n0 / 128) * 256 + 128 + (n0 % 128), 64 * kb, n0, scr, lane); continue; } r -= I_E;
        { const int e = 64 - r / 512, rr = r % 512, kb = rr / 64, nb = rr % 64; const float* src = e < 64 ? a.in[23] + (size_t)e * 512 * 2048 : a.in[26];
            tr_item8(src, 2048, Wd_t + (size_t)e * 2048 * 512, 512, 32 * nb, 64 * kb, 32 * nb, scr, lane); }
    }
}

__device__ __forceinline__ void phase0(const Args& a, LAS unsigned char* lds, int tid, int lane, int wave, int vcu, int G, bool do_mod = true, bool do_tr = true) {
    unsigned char* ws = a.ws;
    if (vcu < 192 && do_mod) {
        LAS float* sc = (LAS float*)lds;
        LAS float* red = (LAS float*)(lds + 73728);
        for (int i = tid; i < 9 * 2048; i += 512) { const int r = i >> 11, k = i & 2047; const float v = r < 8 ? a.in[1][r * 2048 + k] : a.in[3][k]; sc[i] = silu_f(v); }
        __syncthreads();
        const float* wm = a.in[4]; const float* bm = a.in[5]; float* mod = (float*)(ws + WS_MOD);
        for (int chunk = vcu; chunk < 192; chunk += G) {
            const int n0 = chunk * 64, ks = lane >> 4, n4 = (lane & 15) * 4;
            f32x4 acc[9];
#pragma unroll
            for (int r = 0; r < 9; ++r) acc[r] = (f32x4){0.f, 0.f, 0.f, 0.f};
#pragma unroll 4
            for (int kk = 0; kk < 256; kk += 4) { const int k = wave * 256 + kk + ks; const f32x4 wv = *(const f32x4*)(wm + (size_t)k * 12288 + n0 + n4);
#pragma unroll
                for (int r = 0; r < 9; ++r) { const float s = sc[r * 2048 + k]; acc[r] += wv * s; } }
#pragma unroll
            for (int r = 0; r < 9; ++r)
#pragma unroll
                for (int j = 0; j < 4; ++j) { float v = acc[r][j]; v += __shfl_xor(v, 16); v += __shfl_xor(v, 32); acc[r][j] = v; }
            if (lane < 16) {
#pragma unroll
                for (int r = 0; r < 9; ++r) *(LAS f32x4*)(red + (wave * 9 + r) * 64 + n4) = acc[r]; }
            __syncthreads();
            for (int i = tid; i < 9 * 64; i += 512) { const int r = i >> 6, n = i & 63; float s = 0.f;
#pragma unroll
                for (int w = 0; w < 8; ++w) s += red[(w * 9 + r) * 64 + n];
                mod[r * 12288 + n0 + n] = s + bm[n0 + n]; }
            __syncthreads();
        }
    }
    __syncthreads();
    if (do_tr) convert_items(a, (LAS float*)(lds + wave * 16384), lane, vcu * 8 + wave, G * 8, NITEMS_P0 - 2 * I_E, 2 * I_E);
    { const float* wr = a.in[19]; bf16* whi = (bf16*)(ws + WS_WRT); bf16* wlo = whi + 64 * 2048;
      for (int idx = vcu * 512 + tid; idx < 64 * 256; idx += G * 512) { const int e = idx >> 8, k8 = idx & 255; unsigned hi[8], lo[8];
#pragma unroll
          for (int j = 0; j < 8; ++j) { const float v = wr[(size_t)(8 * k8 + j) * 64 + e]; hi[j] = f2bf(v); lo[j] = f2bf(v - __builtin_bit_cast(float, hi[j] << 16)); }
          v4u oh, ol; oh.x = hi[0] | (hi[1] << 16); oh.y = hi[2] | (hi[3] << 16); oh.z = hi[4] | (hi[5] << 16); oh.w = hi[6] | (hi[7] << 16);
          ol.x = lo[0] | (lo[1] << 16); ol.y = lo[2] | (lo[3] << 16); ol.z = lo[4] | (lo[5] << 16); ol.w = lo[6] | (lo[7] << 16);
          *(v4u*)(whi + (size_t)e * 2048 + 8 * k8) = oh; (void)ol; (void)wlo; } }
    { v4u* z = (v4u*)((bf16*)(ws + WS_WIN) + (size_t)DIN * 2048); const int nz = (DINP - DIN) * 2048 / 8;
      for (int i = vcu * 512 + tid; i < nz; i += G * 512) z[i] = (v4u){0u, 0u, 0u, 0u}; }
}

__device__ __forceinline__ void phase1(const Args& a, int lane, int wave, int vcu, int G) {
    const float* mod = (const float*)(a.ws + WS_MOD); bf16* H = (bf16*)(a.ws + RA_H); const float* g = a.in[6];
    for (int m = vcu * 8 + wave; m < MROWS; m += G * 8) {
        const float* xr = m < NT ? a.in[0] + (size_t)m * 2048 : a.in[2] + (size_t)(m - NT) * 2048;
        const float* mr = mod + (size_t)(m < NT ? (m >> 11) : 8) * 12288;
        f32x4 v[8]; float ss = 0.f;
#pragma unroll
        for (int j = 0; j < 8; ++j) { v[j] = *(const f32x4*)(xr + 4 * (lane + 64 * j)); ss += v[j][0] * v[j][0] + v[j][1] * v[j][1] + v[j][2] * v[j][2] + v[j][3] * v[j][3]; }
        const float rstd = rsqrtf(wave_sum(ss) * (1.f / 2048.f) + EPS);
#pragma unroll
        for (int j = 0; j < 8; ++j) { const int c = 4 * (lane + 64 * j); const f32x4 gg = *(const f32x4*)(g + c), sh = *(const f32x4*)(mr + c), sc = *(const f32x4*)(mr + 2048 + c);
            const f32x4 o = v[j] * rstd * gg * (sc + 1.f) + sh;
            v2u q; q.x = pk2(o[0], o[1]); q.y = pk2(o[2], o[3]); *(v2u*)(H + (size_t)m * 2048 + c) = q; }
    }
}

__device__ __forceinline__ int scan_row(int b, int dir, int s) {
    if (s < 256) { const int tc = dir ? 255 - s : s; return NT + b * 256 + tc; }
    const int t0 = s - 256; return b * 2048 + (dir ? 2047 - t0 : t0);
}
__device__ __forceinline__ void prep_item(const Args& a, LAS unsigned char* lds, int tid, int dir, int b, int ch) {
    unsigned char* ws = a.ws;
    const bf16* Q = (const bf16*)(ws + RA_Q); const bf16* Kb = (const bf16*)(ws + RA_K); const float* ALR = (const float*)(ws + RA_ALR);
    v4u* QG = (v4u*)(ws + PQG); bf16* AM = (bf16*)(ws + PAM); bf16* KD = (bf16*)(ws + PKD); float* DEC = (float*)(ws + PDEC);
    constexpr int TS = 520;
    LAS float* alr = (LAS float*)lds;
    LAS bf16* Kt = (LAS bf16*)(lds + 4096);
    LAS bf16* Qt = (LAS bf16*)(lds + 4096 + 64 * TS * 2);
    const int col = tid, h = col >> 7, dk = col & 127;
    const int lane = tid & 63, wave = __builtin_amdgcn_readfirstlane(tid >> 6), l15 = lane & 15, l4 = lane >> 4;
    const bool lat = ch >= 4;
    if (tid < 256) { const int i = tid >> 2, r4 = (tid & 3) * 4; const int row = scan_row(b, dir, ch * 64 + i);
        *(LAS f32x4*)(alr + i * 16 + r4) = *(const f32x4*)(ALR + (size_t)row * 32 + dir * 16 + r4); }
    { v4u kr[8], qr[8];
#pragma unroll
      for (int q = 0; q < 8; ++q) { const int p = tid + 512 * q, i = p >> 6, c8 = (p & 63) * 8; const int row = scan_row(b, dir, ch * 64 + i);
          kr[q] = *(const v4u*)(Kb + (size_t)row * 512 + c8); if (lat) qr[q] = *(const v4u*)(Q + (size_t)row * 512 + c8); }
#pragma unroll
      for (int q = 0; q < 8; ++q) { const int p = tid + 512 * q, i = p >> 6, c8 = (p & 63) * 8; *(LAS v4u*)(Kt + i * TS + c8) = kr[q]; if (lat) *(LAS v4u*)(Qt + i * TS + c8) = qr[q]; } }
    const float* wa2 = dir ? a.in[13] : a.in[11]; const float bia = (dir ? a.in[14] : a.in[12])[col];
    float w[16];
#pragma unroll
    for (int r = 0; r < 16; ++r) w[r] = wa2[r * 512 + col];
    LDS_BARRIER();
    float Gv[64]; float Gc = 0.f;
#pragma unroll
    for (int i = 0; i < 64; ++i) { float z = bia;
#pragma unroll
        for (int r4 = 0; r4 < 4; ++r4) { const f32x4 x = *(const LAS f32x4*)(alr + i * 16 + 4 * r4); z += x[0] * w[4 * r4] + x[1] * w[4 * r4 + 1] + x[2] * w[4 * r4 + 2] + x[3] * w[4 * r4 + 3]; }
        Gc += (fminf(z, 0.f) - __logf(1.f + __expf(-fabsf(z)))) * (1.f / 16.f); Gv[i] = Gc; }
    const float Gmid = Gv[32], Gend = Gv[63];
    DEC[((size_t)(dir * 8 + b) * 36 + ch) * 512 + col] = __expf(Gend);
    bf16* kdrow = KD + ((((size_t)(dir * 8 + b) * 36 + ch) * 4 + h) * 128 + dk) * 64;
#pragma unroll
    for (int i0 = 0; i0 < 64; i0 += 8) { unsigned kd[8];
#pragma unroll
        for (int ii = 0; ii < 8; ++ii) { const int i = i0 + ii; const float kv = bf1(Kt[i * TS + col]);
            kd[ii] = f2bf(kv * __expf(Gend - Gv[i]));
            if (lat) { const float qv = bf1(Qt[i * TS + col]) * 0.08838834764831845f;
                Qt[i * TS + col] = (bf16)f2bf(qv * __expf(Gv[i] - Gmid)); Kt[i * TS + col] = (bf16)f2bf(kv * __expf(Gmid - Gv[i])); } }
        v4u o; o.x = kd[0] | (kd[1] << 16); o.y = kd[2] | (kd[3] << 16); o.z = kd[4] | (kd[5] << 16); o.w = kd[6] | (kd[7] << 16);
        *(v4u*)(kdrow + i0) = o; }
    if (lat) {
        LDS_BARRIER();
        const int hh = wave >> 1; bf16* amt = AM + ((((size_t)(dir * 8 + b) * 32 + (ch - 4)) * 4 + hh) * 64) * 64;
#pragma unroll
        for (int t2 = 0; t2 < 2; ++t2) { const int ti = (wave & 1) * 2 + t2; f32x4 c[4];
#pragma unroll
            for (int tj = 0; tj < 4; ++tj) c[tj] = (f32x4){0.f, 0.f, 0.f, 0.f};
#pragma unroll
            for (int ks = 0; ks < 4; ++ks) { const int ko = hh * 128 + 32 * ks + 8 * l4;
                const bf16x8 bq = *(const LAS bf16x8*)(Qt + (16 * ti + l15) * TS + ko);
#pragma unroll
                for (int tj = 0; tj < 4; ++tj) { const bf16x8 ak = *(const LAS bf16x8*)(Kt + (16 * tj + l15) * TS + ko);
                    c[tj] = __builtin_amdgcn_mfma_f32_16x16x32_bf16(ak, bq, c[tj], 0, 0, 0); } }
            const int i = 16 * ti + l15;
#pragma unroll
            for (int tj = 0; tj < 4; ++tj) { const int j0 = 16 * tj + 4 * l4;
                v2u p; p.x = pk2(j0 <= i ? c[tj][0] : 0.f, j0 + 1 <= i ? c[tj][1] : 0.f); p.y = pk2(j0 + 2 <= i ? c[tj][2] : 0.f, j0 + 3 <= i ? c[tj][3] : 0.f);
                *(v2u*)(amt + i * 64 + j0) = p; } }
        LDS_BARRIER();
        { const float eg = __expf(Gmid);
#pragma unroll 8
          for (int i = 0; i < 64; ++i) Qt[i * TS + col] = (bf16)f2bf(bf1(Qt[i * TS + col]) * eg); }
        LDS_BARRIER();
        { v4u* qgt = QG + ((((size_t)(dir * 8 + b) * 32 + (ch - 4)) * 4) * 1024);
#pragma unroll
          for (int q = 0; q < 8; ++q) { const int p = tid + 512 * q; const int hq = p >> 10, rem = p & 1023, i = rem >> 4, c16 = rem & 15;
              qgt[p] = *(const LAS v4u*)(Qt + i * TS + hq * 128 + c16 * 8); } }
    }
    LDS_BARRIER();
}
__device__ __forceinline__ void phase3_prep(const Args& a, LAS unsigned char* lds, int tid, int vcu, int G) {
    for (int item = vcu; item < 2 * 8 * 32; item += G) { const int lc = item & 31, b = (item >> 5) & 7, dir = item >> 8; prep_item(a, lds, tid, dir, b, 4 + lc); }
    for (int item = vcu; item < 2 * 8 * 4; item += G) { const int cc = item & 3, b = (item >> 2) & 7, dir = item >> 5; prep_item(a, lds, tid, dir, b, cc); }
}

struct ConvItem { const float* src; unsigned char* dst; int drow, k0, n0; };
__device__ __forceinline__ ConvItem conv_decode(const Args& a, int id) {
    id = id < 2 * I_E ? id : id - 2 * I_E * (id / (2 * I_E));
    const int up = id >= I_E ? 1 : 0; const int r = id - up * I_E; const int e = r / 512, rr = r % 512, kb = rr / 16, nb = rr % 16;
    ConvItem c; c.n0 = 32 * nb; c.k0 = 64 * kb;
    c.src = e < 64 ? a.in[21 + up] + (size_t)e * 2048 * 512 : a.in[24 + up];
    c.dst = a.ws + WS_WGU + (size_t)e * 1024 * 2048; c.drow = (c.n0 / 128) * 256 + up * 128 + (c.n0 % 128); return c;
}
__device__ __forceinline__ void conv_load(f32x4 (&t)[8], const ConvItem& c, int lane) {
#pragma unroll
    for (int i = 0; i < 8; ++i) t[i] = *(const f32x4*)(c.src + (size_t)(c.k0 + 8 * i + (lane >> 3)) * 512 + c.n0 + 4 * (lane & 7));
}
__device__ __forceinline__ void conv_finish(const f32x4 (&t)[8], const ConvItem& c, LAS float* scr, int lane) {
#pragma unroll
    for (int i = 0; i < 8; ++i) { LAS float* d = scr + (8 * i + (lane >> 3)) * 33 + 4 * (lane & 7); d[0] = t[i][0]; d[1] = t[i][1]; d[2] = t[i][2]; d[3] = t[i][3]; }
    LDS_WAIT(); asm volatile("" ::: "memory");
    const int cc = lane & 7;
#pragma unroll
    for (int j = 0; j < 4; ++j) { const int n = (lane >> 3) + 8 * j; const LAS float* sp = scr + (8 * cc) * 33 + n;
        v2u o; o.x = pk4_fp8(sp[0 * 33] * SC_W, sp[1 * 33] * SC_W, sp[2 * 33] * SC_W, sp[3 * 33] * SC_W); o.y = pk4_fp8(sp[4 * 33] * SC_W, sp[5 * 33] * SC_W, sp[6 * 33] * SC_W, sp[7 * 33] * SC_W);
        *(v2u*)(c.dst + (size_t)(c.drow + n) * 2048 + c.k0 + 8 * cc) = o; }
    LDS_WAIT(); asm volatile("" ::: "memory");
}
constexpr int GL_CONV = 73728;
constexpr int GL_QG = 0, GL_ST = 17408, GL_KDT = 34816, GL_VT = 53248, GL_AM = 62464, GL_DEC = 71680;
__device__ __forceinline__ void phase_chain(const Args& a, LAS unsigned char* lds, int tid, int lane, int wave, int vcu, int G) {
    unsigned char* ws = a.ws;
    const v4u* QG = (const v4u*)(ws + PQG); const v4u* AM = (const v4u*)(ws + PAM); const v4u* KD = (const v4u*)(ws + PKD); const float* DEC = (const float*)(ws + PDEC);
    const bf16* V = (const bf16*)(ws + RA_V); bf16* OF = (bf16*)(ws + RA_OF);
    const int l15 = lane & 15, l4 = lane >> 4;
    int cstep = 0;
    for (int item = vcu; item < 256; item += G) {
        const int vs = item & 3, dir = (item >> 2) & 1, h = (item >> 3) & 3, b = item >> 5;
        f32x4 S[4];
#pragma unroll
        for (int tv = 0; tv < 4; ++tv) S[tv] = (f32x4){0.f, 0.f, 0.f, 0.f};
        v4u rq[2], ra, rk[2], rv; float rdec = 0.f; f32x4 ct[8]; ConvItem ci;
#define GL_LOAD(ch_, LATL) do { const int ch__ = (ch_); \
            if (LATL) { const size_t t_ = ((((size_t)(dir * 8 + b) * 32 + (ch__ - 4)) * 4 + h) * 1024); rq[0] = QG[t_ + tid]; rq[1] = QG[t_ + tid + 512]; ra = AM[t_ / 2 + tid]; } \
            { const size_t t_ = ((((size_t)(dir * 8 + b) * 36 + ch__) * 4 + h) * 1024); rk[0] = KD[t_ + tid]; rk[1] = KD[t_ + tid + 512]; } \
            { const int row_ = scan_row(b, dir, ch__ * 64 + (tid >> 3)); rv = *(const v4u*)(V + (size_t)row_ * 1024 + h * 256 + vs * 64 + 8 * (tid & 7)); } \
            rdec = DEC[((size_t)(dir * 8 + b) * 36 + ch__) * 512 + h * 128 + (tid & 127)]; } while (0)
#define GL_STEP(ch_, LAT, LATN, MORE) do { const int ch = (ch_); \
              \
            _Pragma("unroll") for (int tv = 0; tv < 4; ++tv) { v2u p; p.x = pk2(S[tv][0], S[tv][1]); p.y = pk2(S[tv][2], S[tv][3]); \
                *(LAS v2u*)(lds + GL_ST + (16 * tv + l15) * 272 + (16 * wave + 4 * l4) * 2) = p; } \
            if (LAT) { _Pragma("unroll") for (int q = 0; q < 2; ++q) { const int p = tid + 512 * q; *(LAS v4u*)(lds + GL_QG + (p >> 4) * 272 + (p & 15) * 16) = rq[q]; } \
                *(LAS v4u*)(lds + GL_AM + (tid >> 3) * 144 + (tid & 7) * 16) = ra; } \
            _Pragma("unroll") for (int q = 0; q < 2; ++q) { const int p = tid + 512 * q; *(LAS v4u*)(lds + GL_KDT + (p >> 3) * 144 + (p & 7) * 16) = rk[q]; } \
            { const int i = tid >> 3, c = tid & 7; LAS bf16* vt = (LAS bf16*)(lds + GL_VT) + i; \
              vt[(8 * c + 0) * 72] = (bf16)(rv.x & 0xffffu); vt[(8 * c + 1) * 72] = (bf16)(rv.x >> 16); vt[(8 * c + 2) * 72] = (bf16)(rv.y & 0xffffu); vt[(8 * c + 3) * 72] = (bf16)(rv.y >> 16); \
              vt[(8 * c + 4) * 72] = (bf16)(rv.z & 0xffffu); vt[(8 * c + 5) * 72] = (bf16)(rv.z >> 16); vt[(8 * c + 6) * 72] = (bf16)(rv.w & 0xffffu); vt[(8 * c + 7) * 72] = (bf16)(rv.w >> 16); } \
            if (tid < 128) *(LAS float*)(lds + GL_DEC + tid * 4) = rdec; \
            LDS_BARRIER(); \
            if (MORE) GL_LOAD(ch + 1, LATN); \
            if (LAT) {   \
                const int ti = wave >> 1, tv0 = (wave & 1) * 2; f32x4 c0 = (f32x4){0.f, 0.f, 0.f, 0.f}, c1 = c0; bf16x8 fb[6], f0[6], f1[6]; \
                _Pragma("unroll") for (int ks = 0; ks < 4; ++ks) { const int ko = (32 * ks + 8 * l4) * 2; \
                    fb[ks] = *(const LAS bf16x8*)(lds + GL_QG + (16 * ti + l15) * 272 + ko); \
                    f0[ks] = *(const LAS bf16x8*)(lds + GL_ST + (16 * tv0 + l15) * 272 + ko); f1[ks] = *(const LAS bf16x8*)(lds + GL_ST + (16 * tv0 + 16 + l15) * 272 + ko); } \
                _Pragma("unroll") for (int ks = 0; ks < 2; ++ks) { const int ko = (32 * ks + 8 * l4) * 2; \
                    fb[4 + ks] = *(const LAS bf16x8*)(lds + GL_AM + (16 * ti + l15) * 144 + ko); \
                    f0[4 + ks] = *(const LAS bf16x8*)(lds + GL_VT + (16 * tv0 + l15) * 144 + ko); f1[4 + ks] = *(const LAS bf16x8*)(lds + GL_VT + (16 * tv0 + 16 + l15) * 144 + ko); } \
                _Pragma("unroll") for (int ks = 0; ks < 6; ++ks) { c0 = __builtin_amdgcn_mfma_f32_16x16x32_bf16(f0[ks], fb[ks], c0, 0, 0, 0); c1 = __builtin_amdgcn_mfma_f32_16x16x32_bf16(f1[ks], fb[ks], c1, 0, 0, 0); } \
                const int s_ = ch * 64 + 16 * ti + l15; const int t0 = s_ - 256; const int t = dir ? 2047 - t0 : t0; \
                bf16* orow = OF + ((size_t)dir * NT + b * 2048 + t) * 1024 + h * 256 + vs * 64 + 16 * tv0 + 4 * l4; \
                v2u p0, p1; p0.x = pk2(c0[0], c0[1]); p0.y = pk2(c0[2], c0[3]); p1.x = pk2(c1[0], c1[1]); p1.y = pk2(c1[2], c1[3]); \
                *(v2u*)(orow) = p0; *(v2u*)(orow + 16) = p1; } \
              \
            { const f32x4 d4 = *(const LAS f32x4*)(lds + GL_DEC + (16 * wave + 4 * l4) * 4); bf16x8 fk[2], fv[2][4]; \
              _Pragma("unroll") for (int ks = 0; ks < 2; ++ks) { const int ko = (32 * ks + 8 * l4) * 2; fk[ks] = *(const LAS bf16x8*)(lds + GL_KDT + (16 * wave + l15) * 144 + ko); \
                  _Pragma("unroll") for (int tv = 0; tv < 4; ++tv) fv[ks][tv] = *(const LAS bf16x8*)(lds + GL_VT + (16 * tv + l15) * 144 + ko); } \
              _Pragma("unroll") for (int tv = 0; tv < 4; ++tv) S[tv] = S[tv] * d4; \
              _Pragma("unroll") for (int ks = 0; ks < 2; ++ks) \
                  _Pragma("unroll") for (int tv = 0; tv < 4; ++tv) S[tv] = __builtin_amdgcn_mfma_f32_16x16x32_bf16(fk[ks], fv[ks][tv], S[tv], 0, 0, 0); } \
              \
            conv_finish(ct, ci, (LAS float*)(lds + GL_CONV + wave * 8448), lane); ++cstep; ci = conv_decode(a, cstep * (G * 8) + vcu * 8 + wave); conv_load(ct, ci, lane); \
            LDS_BARRIER(); } while (0)
        ci = conv_decode(a, cstep * (G * 8) + vcu * 8 + wave); conv_load(ct, ci, lane);
        GL_LOAD(0, false);
        GL_STEP(0, false, false, true); GL_STEP(1, false, false, true); GL_STEP(2, false, false, true); GL_STEP(3, false, true, true);
#pragma unroll 1
        for (int c2 = 4; c2 < 35; ++c2) { GL_STEP(c2, true, true, true); }
        GL_STEP(35, true, true, false);
#undef GL_STEP
#undef GL_LOAD
    }
    for (int id = cstep * (G * 8) + vcu * 8 + wave; id < 2 * I_E; id += G * 8) { const ConvItem c = conv_decode(a, id); f32x4 t[8]; conv_load(t, c, lane); conv_finish(t, c, (LAS float*)(lds + GL_CONV + wave * 8448), lane); }
}

template <int HALFW>
__device__ __forceinline__ void pool_item(const bf16* P, bf16* DP, LAS float* tmp, int tid, int b, int r, int g) {
    const int rlo = r - HALFW < 0 ? 0 : r - HALFW, rhi = r + HALFW > 32 ? 32 : r + HALFW;
    const float rinv = 1.f / (float)(rhi - rlo);
#pragma unroll 1
    for (int q = 0; q < 4; ++q) { const int p = tid + 512 * q, c = p >> 5, ch0 = (p & 31) * 8; float acc[8]; v4u x[2 * HALFW];
#pragma unroll
        for (int u = 0; u < 2 * HALFW; ++u) { const int rr = (rlo + u < rhi) ? rlo + u : rlo; x[u] = *(const v4u*)(P + ((size_t)(b * 2048 + rr * 64 + c)) * 1024 + g * 256 + ch0); }
#pragma unroll
        for (int j = 0; j < 8; ++j) acc[j] = 0.f;
#pragma unroll
        for (int u = 0; u < 2 * HALFW; ++u) { const float m = (rlo + u < rhi) ? 1.f : 0.f;
            acc[0] += m * bflo(x[u].x); acc[1] += m * bfhi(x[u].x); acc[2] += m * bflo(x[u].y); acc[3] += m * bfhi(x[u].y); acc[4] += m * bflo(x[u].z); acc[5] += m * bfhi(x[u].z); acc[6] += m * bflo(x[u].w); acc[7] += m * bfhi(x[u].w); }
        *(LAS f32x4*)(tmp + c * 256 + ch0) = (f32x4){acc[0] * rinv, acc[1] * rinv, acc[2] * rinv, acc[3] * rinv};
        *(LAS f32x4*)(tmp + c * 256 + ch0 + 4) = (f32x4){acc[4] * rinv, acc[5] * rinv, acc[6] * rinv, acc[7] * rinv}; }
    __syncthreads();
#pragma unroll 1
    for (int q = 0; q < 4; ++q) { const int p = tid + 512 * q, c = p >> 5, ch0 = (p & 31) * 8;
        const int clo = c - HALFW < 0 ? 0 : c - HALFW, chi = c + HALFW > 64 ? 64 : c + HALFW; const float cinv = 1.f / (float)(chi - clo);
        const size_t o = ((size_t)(b * 2048 + r * 64 + c)) * 1024 + g * 256 + ch0;
        const v4u x = *(const v4u*)(P + o);
        f32x4 a0 = (f32x4){0.f, 0.f, 0.f, 0.f}, a1 = a0;
#pragma unroll
        for (int u = 0; u < 2 * HALFW; ++u) { const int cc = (clo + u < chi) ? clo + u : clo; const float m = (clo + u < chi) ? 1.f : 0.f;
            a0 += *(const LAS f32x4*)(tmp + cc * 256 + ch0) * m; a1 += *(const LAS f32x4*)(tmp + cc * 256 + ch0 + 4) * m; }
        v4u d; d.x = pk2(a0[0] * cinv - bflo(x.x), a0[1] * cinv - bfhi(x.x)); d.y = pk2(a0[2] * cinv - bflo(x.y), a0[3] * cinv - bfhi(x.y));
        d.z = pk2(a1[0] * cinv - bflo(x.z), a1[1] * cinv - bfhi(x.z)); d.w = pk2(a1[2] * cinv - bflo(x.w), a1[3] * cinv - bfhi(x.w));
        *(v4u*)(DP + o) = d; }
    __syncthreads();
}
__device__ __forceinline__ void phase3_pool(const Args& a, LAS unsigned char* lds, int tid, int vcu, int G) {
    const bf16* P = (const bf16*)(a.ws + RA_P); bf16* DP = (bf16*)(a.ws + RA_DPOOL);
    LAS float* tmp = (LAS float*)lds;
    for (int item = vcu; item < 1024; item += G) {
        const int g = item >> 8, r = (item >> 3) & 31, b = item & 7;
        const int gg = 3 - g;
        if (gg == 0) pool_item<1>(P, DP, tmp, tid, b, r, gg); else if (gg == 1) pool_item<2>(P, DP, tmp, tid, b, r, gg); else if (gg == 2) pool_item<4>(P, DP, tmp, tid, b, r, gg); else pool_item<8>(P, DP, tmp, tid, b, r, gg);
    }
}

__device__ __forceinline__ void phase4_post(const Args& a, int lane, int wave, int vcu, int G) {
    const bf16* OF = (const bf16*)(a.ws + RA_OF); const bf16* OB = OF + (size_t)NT * 1024; const bf16* Rr = (const bf16*)(a.ws + RA_R); bf16* Y = (bf16*)(a.ws + RA_YMIX);
    const float* gn = a.in[15];
    f32x4 g4[4];
#pragma unroll
    for (int q = 0; q < 4; ++q) g4[q] = *(const f32x4*)(gn + 16 * lane + 4 * q);
#pragma unroll 2
    for (int t = vcu * 8 + wave; t < NT; t += G * 8) {
        const size_t o = (size_t)t * 1024 + 16 * lane;
        const v4u f0 = *(const v4u*)(OF + o), f1 = *(const v4u*)(OF + o + 8), b0 = *(const v4u*)(OB + o), b1 = *(const v4u*)(OB + o + 8), r0 = *(const v4u*)(Rr + o), r1 = *(const v4u*)(Rr + o + 8);
        float x[16], r[16];
#pragma unroll
        for (int w = 0; w < 4; ++w) { x[2 * w] = bflo(f0[w]) + bflo(b0[w]); x[2 * w + 1] = bfhi(f0[w]) + bfhi(b0[w]); x[8 + 2 * w] = bflo(f1[w]) + bflo(b1[w]); x[8 + 2 * w + 1] = bfhi(f1[w]) + bfhi(b1[w]);
            r[2 * w] = bflo(r0[w]); r[2 * w + 1] = bfhi(r0[w]); r[8 + 2 * w] = bflo(r1[w]); r[8 + 2 * w + 1] = bfhi(r1[w]); }
        float ss = 0.f;
#pragma unroll
        for (int q = 0; q < 16; ++q) ss += x[q] * x[q];
        ss += __shfl_xor(ss, 1); ss += __shfl_xor(ss, 2); ss += __shfl_xor(ss, 4); ss += __shfl_xor(ss, 8);
        const float sc = rsqrtf(ss * (1.f / 256.f) + EPS);
        float y[16];
#pragma unroll
        for (int q = 0; q < 16; ++q) y[q] = x[q] * sc * g4[q >> 2][q & 3] * silu_f(r[q]);
        v4u o0, o1;
#pragma unroll
        for (int w = 0; w < 4; ++w) { o0[w] = pk2(y[2 * w], y[2 * w + 1]); o1[w] = pk2(y[8 + 2 * w], y[8 + 2 * w + 1]); }
        bf16* yr = Y + (size_t)t * 2048 + 16 * lane;
        *(v4u*)(yr) = o0; *(v4u*)(yr + 8) = o1;
    }
}

__device__ __forceinline__ void phase6(const Args& a, LAS unsigned char* lds, int tid, int lane, int wave, int vcu, int G) {
    unsigned char* ws = a.ws;
    const float* mod = (const float*)(ws + WS_MOD); const bf16* Y1 = (const bf16*)(ws + RA_Y1); unsigned char* H2 = ws + RA_H2;
    const float* gpost = a.in[7]; const float* gpre2 = a.in[8]; const float* rbias = a.in[20];
    const bf16* whi = (const bf16*)(ws + WS_WRT);
    LAS float* part = (LAS float*)lds;
    LAS float* logit = (LAS float*)(lds + LDS_LOGIT);
    LAS u64* masks = (LAS u64*)(lds + LDS_MASKS);
    int* cnt = (int*)(ws + T_CNT); u64* tmask = (u64*)(ws + T_MASK); float* tokw = (float*)(ws + T_TOKW);
    const int l15 = lane & 15, l4 = lane >> 4;
    for (int blk = vcu; blk < NT / 64; blk += G) {
        for (int it = 0; it < 2; ++it) {
#pragma unroll 1
            for (int rep_ = 0; rep_ < P7_REP_ROWS; ++rep_) {
#pragma unroll 1
            for (int rr = 0; rr < 4; ++rr) {
                const int lr = wave * 4 + rr, t = blk * 64 + it * 32 + lr; const float* mr = mod + (size_t)(t >> 11) * 12288;
                const bf16* yr = Y1 + (size_t)t * 2048; const float* xr = a.in[0] + (size_t)t * 2048;
                f32x4 y[8]; float ss = 0.f;
#pragma unroll
                for (int j = 0; j < 8; ++j) { const v2u yb = *(const v2u*)(yr + 4 * (lane + 64 * j)); y[j] = (f32x4){bflo(yb.x), bfhi(yb.x), bflo(yb.y), bfhi(yb.y)}; ss += y[j][0] * y[j][0] + y[j][1] * y[j][1] + y[j][2] * y[j][2] + y[j][3] * y[j][3]; }
                const float rstd1 = rsqrtf(wave_sum(ss) * (1.f / 2048.f) + EPS);
                if (lane == 0) ((float*)(ws + T_RSTD1))[t] = rstd1;
                float s2 = 0.f;
#pragma unroll
                for (int j = 0; j < 8; ++j) { const int c = 4 * (lane + 64 * j); const f32x4 x = *(const f32x4*)(xr + c), gp = *(const f32x4*)(gpost + c), gt = *(const f32x4*)(mr + 4096 + c);
                    const f32x4 x1 = x + gt * (y[j] * rstd1 * gp); y[j] = x1;
                    s2 += x1[0] * x1[0] + x1[1] * x1[1] + x1[2] * x1[2] + x1[3] * x1[3]; }
                const float rstd2 = rsqrtf(wave_sum(s2) * (1.f / 2048.f) + EPS);
#pragma unroll
                for (int j = 0; j < 8; ++j) { const int c = 4 * (lane + 64 * j); const f32x4 g2 = *(const f32x4*)(gpre2 + c), sh = *(const f32x4*)(mr + 6144 + c), sc = *(const f32x4*)(mr + 8192 + c);
                    const f32x4 hh = y[j] * rstd2 * g2 * (sc + 1.f) + sh;
                    v2u qh; qh.x = pk2(hh[0], hh[1]); qh.y = pk2(hh[2], hh[3]);
                    *(LAS v2u*)(lds + RT_HI + lr * RT_ROWB + c * 2) = qh;
                    *(unsigned*)(H2 + (size_t)t * 2048 + c) = pk4_fp8(hh[0] * SC_H, hh[1] * SC_H, hh[2] * SC_H, hh[3] * SC_H); }
            }
            __syncthreads();
            }
            { f32x4 acc[2][4];
#pragma unroll
              for (int mt = 0; mt < 2; ++mt)
#pragma unroll
                  for (int et = 0; et < 4; ++et) acc[mt][et] = (f32x4){0.f, 0.f, 0.f, 0.f};
#pragma unroll 1
              for (int kh = 0; kh < 2; ++kh) {
                  bf16x8 bh[4][4];
#pragma unroll
                  for (int k4 = 0; k4 < 4; ++k4) { const int k0 = 256 * wave + 32 * (4 * kh + k4) + 8 * l4;
#pragma unroll
                      for (int et = 0; et < 4; ++et) bh[k4][et] = *(const bf16x8*)(whi + (size_t)(16 * et + l15) * 2048 + k0); }
#pragma unroll
                  for (int k4 = 0; k4 < 4; ++k4) { const int k0 = 256 * wave + 32 * (4 * kh + k4) + 8 * l4;
#pragma unroll
                      for (int mt = 0; mt < 2; ++mt) { const bf16x8 ah = *(const LAS bf16x8*)(lds + RT_HI + (16 * mt + l15) * RT_ROWB + k0 * 2);
#pragma unroll
                          for (int et = 0; et < 4; ++et) acc[mt][et] = __builtin_amdgcn_mfma_f32_16x16x32_bf16(ah, bh[k4][et], acc[mt][et], 0, 0, 0); } } }
              __syncthreads();
#pragma unroll
              for (int mt = 0; mt < 2; ++mt)
#pragma unroll
                  for (int et = 0; et < 4; ++et)
#pragma unroll
                      for (int q = 0; q < 4; ++q) part[(wave * 32 + 16 * mt + 4 * l4 + q) * 64 + 16 * et + l15] = acc[mt][et][q]; }
            __syncthreads();
#pragma unroll
            for (int q = 0; q < 4; ++q) { const int idx = tid + 512 * q; float sacc = 0.f;
#pragma unroll
                for (int w = 0; w < 8; ++w) sacc += part[w * 2048 + idx];
                logit[idx] = sacc; }
            __syncthreads();
#pragma unroll 1
            for (int rep_ = 0; rep_ < P7_REP_RT; ++rep_) {
#pragma unroll 1
            for (int rr = 0; rr < 4; ++rr) {
                const int lr = wave * 4 + rr, t = blk * 64 + it * 32 + lr;
                const float lg = logit[lr * 64 + lane]; const float s = 1.f / (1.f + __expf(-lg)); const float sel = s + rbias[lane];
                float m1 = sel; m1 = fmaxf(m1, __shfl_xor(m1, 1)); m1 = fmaxf(m1, __shfl_xor(m1, 2)); m1 = fmaxf(m1, __shfl_xor(m1, 4));
                const u64 eq = __ballot(sel == m1); const unsigned gb = (unsigned)(eq >> (lane & ~7)) & 0xffu; const int first = __builtin_ctz(gb);
                float v2 = ((lane & 7) == first) ? -INFINITY : sel; v2 = fmaxf(v2, __shfl_xor(v2, 1)); v2 = fmaxf(v2, __shfl_xor(v2, 2)); v2 = fmaxf(v2, __shfl_xor(v2, 4));
                const float gs = m1 + v2; const int g = lane >> 3; int grank = 0;
#pragma unroll
                for (int g2 = 0; g2 < 8; ++g2) { const float o = __builtin_bit_cast(float, __builtin_amdgcn_readlane(__builtin_bit_cast(int, gs), g2 * 8)); grank += (o > gs || (o == gs && g2 < g)) ? 1 : 0; }
                const bool gsel = grank < 4; const float mk = gsel ? sel : -INFINITY; int rank = 0;
#pragma unroll 8
                for (int e2 = 0; e2 < 64; ++e2) { const float o = __builtin_bit_cast(float, __builtin_amdgcn_readlane(__builtin_bit_cast(int, mk), e2)); rank += (o > mk || (o == mk && e2 < lane)) ? 1 : 0; }
                const bool chosen = gsel && rank < 8;
                const u64 mask = __ballot(chosen); const float ssum = wave_sum(chosen ? s : 0.f);
                const int kidx = __popcll(mask & ((1ull << lane) - 1ull));
                if (chosen) tokw[(size_t)t * 8 + kidx] = s / ssum * 2.5f;
                if (lane == 0) { tmask[t] = mask; masks[it * 32 + lr] = mask; }
            }
            __syncthreads();
            }
        }
        if (wave == 0) { const u64 m = masks[lane]; int mine = 0;
#pragma unroll 8
            for (int e = 0; e < 64; ++e) { const int c = __popcll(__ballot((m >> e) & 1ull)); mine = (lane == e) ? c : mine; }
            cnt[blk * 64 + lane] = mine; }
        __syncthreads();
    }
}

__device__ __forceinline__ void phase7(const Args& a, LAS unsigned char* lds, int tid, int lane, int wave, int vcu, int G) {
    unsigned char* ws = a.ws;
    const int* cnt = (const int*)(ws + T_CNT); const u64* tmask = (const u64*)(ws + T_MASK); const float* tokw = (const float*)(ws + T_TOKW);
    int* tokslot = (int*)(ws + T_TOKSLOT); int* slottok = (int*)(ws + T_SLOTTOK); float* slotw = (float*)(ws + T_SLOTW); int* tile = (int*)(ws + T_TILE);
    LAS int* part = (LAS int*)(lds + 131072);
    bool converted = false;
    for (int blk = vcu; blk < NT / 64; blk += G) {
        int pre = 0, all = 0;
#pragma unroll 8
        for (int b2 = wave; b2 < 256; b2 += 8) { const int c = cnt[b2 * 64 + lane]; all += c; pre += (b2 < blk) ? c : 0; }
        part[(wave * 2) * 64 + lane] = pre; part[(wave * 2 + 1) * 64 + lane] = all;
        LDS_BARRIER();
        if (wave == 0) {
            int p = 0, t = 0;
#pragma unroll
            for (int w = 0; w < 8; ++w) { p += part[(w * 2) * 64 + lane]; t += part[(w * 2 + 1) * 64 + lane]; }
            int incl = t;
#pragma unroll
            for (int o = 1; o < 64; o <<= 1) { const int v = __shfl_up(incl, o); if (lane >= o) incl += v; }
            const int start = incl - t; const int base = start + p;
            const int tokn = blk * 64 + lane; const u64 m = tmask[tokn];
#pragma unroll 8
            for (int e = 0; e < 64; ++e) { const bool bit = (m >> e) & 1ull; const u64 bal = __ballot(bit); const int be = __builtin_amdgcn_readlane(base, e);
                if (bit) { const int rank = __popcll(bal & ((1ull << lane) - 1ull)); const int slot = be + rank; const int k = __popcll(m & ((1ull << e) - 1ull));
                    slottok[slot] = tokn; slotw[slot] = tokw[(size_t)tokn * 8 + k]; tokslot[(size_t)tokn * 8 + k] = slot; } }
            slottok[SH_ROW0 + tokn] = tokn; slotw[SH_ROW0 + tokn] = 1.f;
            if (blk == 0) {
                const int nte = (t + 255) >> 8; int inc2 = nte;
#pragma unroll
                for (int o = 1; o < 64; o <<= 1) { const int v = __shfl_up(inc2, o); if (lane >= o) inc2 += v; }
                const int n0 = inc2 - nte; const int ntot = __builtin_amdgcn_readlane(inc2, 63);
                for (int j = 0; j < nte; ++j) { tile[n0 + j] = lane; tile[NTILE_MAX + n0 + j] = start + j * 256; tile[2 * NTILE_MAX + n0 + j] = (t - j * 256) < 256 ? (t - j * 256) : 256; }
                tile[ntot + lane] = 64; tile[NTILE_MAX + ntot + lane] = SH_ROW0 + lane * 256; tile[2 * NTILE_MAX + ntot + lane] = 256;
                if (lane == 0) tile[3 * NTILE_MAX] = ntot + 64;
            }
        } else if (!converted) {
            converted = true;
            convert_items(a, (LAS float*)(lds + wave * 16384), lane, NITEMS_P0 + vcu * 7 + (wave - 1), G * 7, NITEMS);
        }
        LDS_BARRIER();
    }
}

__device__ __forceinline__ void phase10(const Args& a, LAS unsigned char* lds, int lane, int wave, int vcu, int G) {
    unsigned char* ws = a.ws;
    const float* mod = (const float*)(ws + WS_MOD); const unsigned char* SO = ws + WS_SLOTOUT; const int* tokslot = (const int*)(ws + T_TOKSLOT); const float* gp = a.in[9];
    LAS float* ysc = (LAS float*)(lds + wave * 8192);
    const unsigned lo16_ = 16u * (unsigned)lane;
#pragma unroll 1
    for (int t = vcu * 8 + wave; t < NT; t += G * 8) {
        const float* mr = mod + (size_t)(t >> 11) * 12288;
        const int myslot = lane < 8 ? tokslot[(size_t)t * 8 + lane] : SH_ROW0 + t;
        unsigned lo16 = lo16_; asm volatile("" : "+v"(lo16));
        v4u x[9][2]; f32x4 xo[8]; v2u yb[8];
        const unsigned char* x1r = (const unsigned char*)(a.in[0] + (size_t)t * 2048); const unsigned char* y1r = (const unsigned char*)((const bf16*)(ws + RA_Y1) + (size_t)t * 2048);
        const float rstd1 = ((const float*)(ws + T_RSTD1))[t];
#pragma unroll
        for (int k = 0; k < 9; ++k) { const int slot = __builtin_amdgcn_readlane(myslot, k); const unsigned char* sr = SO + (size_t)slot * 2048;
#pragma unroll
            for (int j = 0; j < 2; ++j) x[k][j] = *(const v4u*)(sr + (lo16 + 1024u * j)); }
        float y[2][16];
#pragma unroll
        for (int j = 0; j < 2; ++j)
#pragma unroll
            for (int q = 0; q < 16; ++q) y[j][q] = 0.f;
#pragma unroll
        for (int k = 0; k < 9; ++k)
#pragma unroll
            for (int j = 0; j < 2; ++j) { v4u v = x[k][j]; asm volatile("" : "+v"(v) : "v"(y[j][0]), "v"(y[j][15]));
#pragma unroll
                for (int w = 0; w < 4; ++w) { const unsigned d = v[w]; const auto lo = __builtin_amdgcn_cvt_pk_f32_fp8(d, false), hi = __builtin_amdgcn_cvt_pk_f32_fp8(d, true);
                    y[j][4 * w] += lo[0]; y[j][4 * w + 1] += lo[1]; y[j][4 * w + 2] += hi[0]; y[j][4 * w + 3] += hi[1]; } }
        asm volatile("" ::: "memory");
#pragma unroll
        for (int j = 0; j < 8; ++j) { xo[j] = *(const f32x4*)(x1r + (lo16 + 1024u * j)); yb[j] = *(const v2u*)(y1r + (lo16 / 2u + 512u * j)); }
        float ss = 0.f;
#pragma unroll
        for (int j = 0; j < 2; ++j)
#pragma unroll
            for (int q = 0; q < 16; ++q) ss += y[j][q] * y[j][q];
        const float rstd = rsqrtf(wave_sum(ss) * (1.f / 2048.f) + EPS * SC_O * SC_O);
#pragma unroll
        for (int j = 0; j < 2; ++j)
#pragma unroll
            for (int q = 0; q < 4; ++q) *(LAS f32x4*)(ysc + 16 * (lane + 64 * j) + 4 * q) = (f32x4){y[j][4 * q], y[j][4 * q + 1], y[j][4 * q + 2], y[j][4 * q + 3]};
        LDS_WAIT(); asm volatile("" ::: "memory");
        unsigned char* outr = (unsigned char*)(a.out + (size_t)t * 2048); const unsigned char* gpb = (const unsigned char*)gp; const unsigned char* g1b = (const unsigned char*)a.in[7];
        const unsigned char* gt2b = (const unsigned char*)(mr + 10240); const unsigned char* gt1b = (const unsigned char*)(mr + 4096);
#pragma unroll
        for (int j = 0; j < 8; ++j) { const unsigned cb = lo16 + 1024u * j; const f32x4 yy = *(const LAS f32x4*)(ysc + 4 * (lane + 64 * j)), g = *(const f32x4*)(gpb + cb), gt = *(const f32x4*)(gt2b + cb);
            const f32x4 g1 = *(const f32x4*)(g1b + cb), gt1 = *(const f32x4*)(gt1b + cb); const f32x4 y1 = (f32x4){bflo(yb[j].x), bfhi(yb[j].x), bflo(yb[j].y), bfhi(yb[j].y)};
            const f32x4 x1 = xo[j] + gt1 * (y1 * rstd1 * g1);
            *(f32x4*)(outr + cb) = x1 + gt * (yy * rstd * g); }
        LDS_WAIT(); asm volatile("" ::: "memory");
    }
}

__global__ void __launch_bounds__(512, 2) fwd(Args args) {
    extern __shared__ __attribute__((aligned(16))) unsigned char lds_raw[];
    LAS unsigned char* lds = (LAS unsigned char*)lds_raw;
    const int tid = threadIdx.x, lane = tid & 63, wave = __builtin_amdgcn_readfirstlane(tid >> 6);
    const int G = gridDim.x, bx = blockIdx.x;
    const int vcu = (G % 8 == 0) ? (bx % 8) * (G / 8) + bx / 8 : bx;
    unsigned char* ws = args.ws;
    volatile LAS unsigned* MISC = (volatile LAS unsigned*)(lds + LDS_MISC);
    if (tid < 64) MISC[tid] = 0u;
    __syncthreads();
    const int lo = args.ph_lo, hi = args.ph_hi;
    XcdBarrier bar; bar.bar = (unsigned*)(ws + WS_CTL) + 4096; bar.x = 0; bar.st = nullptr;
    if (hi - lo > 1) bar = xcd_barrier_post((unsigned*)(ws + WS_CTL) + 4096, MISC + 8);
#ifndef PH_MASK
#define PH_MASK 0xfff
#endif
#define IN(k) (((PH_MASK >> (k)) & 1) && lo <= (k) && (k) < hi)
#define SEAM(k) do { if (IN(k) && IN((k) + 1)) xcd_barrier(bar); } while (0)

#ifndef REP_PHASE
#define REP_PHASE -1
#endif
#define PH_IDS int tz_ = threadIdx.x; asm volatile("" : "+v"(tz_)); const int tid = tz_, lane = tz_ & 63, wave = __builtin_amdgcn_readfirstlane(tz_ >> 6); (void)tid; (void)lane; (void)wave;
#define RUNPH(k, ...) do { if (IN(k)) { { PH_IDS __VA_ARGS__ } if (REP_PHASE == (k)) { xcd_barrier(bar); { PH_IDS __VA_ARGS__ } } SEAM(k); } } while (0)
#ifdef PROBE_P0
    if (IN(0)) { { PH_IDS phase0(args, lds, tid, lane, wave, vcu, G); } xcd_barrier(bar); { PH_IDS phase0(args, lds, tid, lane, wave, vcu, G, PROBE_P0 == 1, PROBE_P0 == 2); } SEAM(0); }
#else
    RUNPH(0, phase0(args, lds, tid, lane, wave, vcu, G););
#endif
    RUNPH(1, phase1(args, lane, wave, vcu, G););
    RUNPH(2, {
        DenseSched S; S.init(ws + RA_H, ws + WS_WIN, 2048, 2048, MROWS, DINP, G, bx);
        EpiIn E{ws};
        pg8::gemm_phase<EpiIn, DenseSched>(lds, 2048, S, E); });
#ifndef P3_REP_PREP
#define P3_REP_PREP 1
#endif
#ifndef P3_REP_POOL
#define P3_REP_POOL 1
#endif
    RUNPH(3, for (int r_ = 0; r_ < P3_REP_PREP; ++r_) phase3_prep(args, lds, tid, vcu, G); for (int r_ = 0; r_ < P3_REP_POOL; ++r_) phase3_pool(args, lds, tid, vcu, G););
    RUNPH(4, phase_chain(args, lds, tid, lane, wave, vcu, G););
    RUNPH(5, {
        phase4_post(args, lane, wave, vcu, G);
        PoolSched S{(const char*)(ws + RA_DPOOL), (const char*)(ws + WS_WPOOL), G, vcu};
        EpiPool E{(bf16*)(ws + RA_YMIX), args.in[17]};
        int kpool = 256; asm volatile("" : "+s"(kpool));
        pg8::gemm_phase<EpiPool, PoolSched>(lds, kpool, S, E); });
    RUNPH(6, {
        DenseSched S; S.init(ws + RA_YMIX, ws + WS_WOUT, 2048, 2048, NT, 2048, G, bx);
        EpiOut E{(bf16*)(ws + RA_Y1)};
        pg8::gemm_phase<EpiOut, DenseSched>(lds, 2048, S, E); });
    RUNPH(7, phase6(args, lds, tid, lane, wave, vcu, G););
    RUNPH(8, phase7(args, lds, tid, lane, wave, vcu, G););
    RUNPH(9, {
        MoeGUSched S{(const char*)(ws + RA_H2), (const char*)(ws + WS_WGU), (const int*)(ws + T_TILE), (const int*)(ws + T_SLOTTOK), G, vcu};
        EpiGU E{ws + WS_ACT, (const float*)(ws + T_SLOTW)};
        int kgu = 1024; asm volatile("" : "+s"(kgu));
        pg8::gemm_phase<EpiGU, MoeGUSched, true>(lds, kgu, S, E); });
    RUNPH(10, {
        MoeDownSched S{(const char*)(ws + WS_ACT), (const char*)(ws + WS_WD), (const int*)(ws + T_TILE), G, vcu};
        EpiDown E{ws + WS_SLOTOUT};
        int kdn = 256; asm volatile("" : "+s"(kdn));
        pg8::gemm_phase<EpiDown, MoeDownSched, true>(lds, kdn, S, E); });
    if (IN(11)) { { PH_IDS phase10(args, lds, lane, wave, vcu, G); } if (REP_PHASE == 11) { xcd_barrier(bar); { PH_IDS phase10(args, lds, lane, wave, vcu, G); } } }
#undef IN
#undef SEAM
}

extern "C" void kernel_launch(void* const* d_in, const int* in_sizes, int n_in, void* d_out, int out_size, void* d_ws, size_t ws_size, hipStream_t stream) {
    static int grid = 0;
    if (grid == 0) {
        if (n_in != 27 || out_size != NT * DM || ws_size < WS_NEED) { fprintf(stderr, "kernel_launch: unexpected problem: n_in %d out %d ws %zu (need %zu)\n", n_in, out_size, ws_size, (size_t)WS_NEED); grid = -1; return; }
        int dev = 0, cus = 0, per_cu = 0;
        if (hipGetDevice(&dev) != hipSuccess || hipDeviceGetAttribute(&cus, hipDeviceAttributeMultiprocessorCount, dev) != hipSuccess) { grid = -1; return; }
        if (hipFuncSetAttribute((const void*)fwd, hipFuncAttributeMaxDynamicSharedMemorySize, LDS_BYTES) != hipSuccess) { fprintf(stderr, "kernel_launch: hipFuncSetAttribute failed\n"); grid = -1; return; }
        if (hipOccupancyMaxActiveBlocksPerMultiprocessor(&per_cu, (const void*)fwd, 512, LDS_BYTES) != hipSuccess || per_cu < 1) { fprintf(stderr, "kernel_launch: occupancy query says %d\n", per_cu); }
        (void)hipGetLastError();
        grid = cus;
    }
    if (grid < 0) return;
    (void)hipMemsetAsync((char*)d_ws + WS_CTL, 0, CTL_ZERO_BYTES, stream);
    Args a{};
    for (int i = 0; i < 27; ++i) a.in[i] = (const float*)d_in[i];
    a.out = (float*)d_out; a.ws = (unsigned char*)d_ws;
    if (N_LAUNCHES == 1) {
        a.ph_lo = 0; a.ph_hi = NPH;
        hipLaunchKernelGGL(fwd, dim3(grid), dim3(512), LDS_BYTES, stream, a);
    } else {
        for (int p = 0; p < NPH; ++p) { a.ph_lo = p; a.ph_hi = p + 1; hipLaunchKernelGGL(fwd, dim3(grid), dim3(512), LDS_BYTES, stream, a); }
    }
}
```

```cpp
#include <hip/hip_runtime.h>
#include <cstdio>
#include <cstdint>

#ifndef P7_REP_ROWS
#define P7_REP_ROWS 1
#endif
#ifndef P7_REP_LOG
#define P7_REP_LOG 1
#endif
#ifndef P7_REP_RT
#define P7_REP_RT 1
#endif
#ifndef N_LAUNCHES
#define N_LAUNCHES 1
#endif

#define GAS __attribute__((address_space(1)))
#define LAS __attribute__((address_space(3)))
typedef unsigned short bf16;
typedef unsigned v4u __attribute__((ext_vector_type(4)));
typedef unsigned v2u __attribute__((ext_vector_type(2)));
typedef float f32x4 __attribute__((ext_vector_type(4)));
typedef short bf16x8 __attribute__((ext_vector_type(8)));
typedef unsigned long long u64;

constexpr int NB = 8, SEQ = 2048, DM = 2048, CTXL = 256;
constexpr int NT = NB * SEQ;
constexpr int NTC = NB * CTXL;
constexpr int MROWS = NT + NTC;
constexpr int DIN = 4128, DINP = 4352;
constexpr int NE = 64, TOPK = 8, DE = 512;
constexpr int NSLOT_E = NT * TOPK;
constexpr int SH_ROW0 = NSLOT_E + 256;
constexpr int NSLOT = SH_ROW0 + NT;
constexpr int NTILE_MAX = 704;
constexpr float EPS = 1e-6f;
constexpr int NPH = 12;

constexpr size_t MiB = 1u << 20;
constexpr size_t WS_CTL = 0, CTL_ZERO_BYTES = 64 * 1024;
constexpr size_t WS_MOD = 1 * MiB;
constexpr size_t WS_WRT = 1 * MiB + 512 * 1024;
constexpr size_t WS_WIN = 2 * MiB;
constexpr size_t WS_WOUT = WS_WIN + 17 * MiB;
constexpr size_t WS_WPOOL = WS_WOUT + 8 * MiB;
constexpr size_t WS_WD = WS_WPOOL + 1 * MiB;
constexpr size_t WS_WGU = WS_WD + 130 * MiB;
constexpr size_t WS_RA = WS_WGU + 260 * MiB;
constexpr size_t RA_H = WS_RA;
constexpr size_t RA_OF = WS_RA;
constexpr size_t RA_H2 = WS_RA;
constexpr size_t RA_Q = WS_RA + 128 * MiB;
constexpr size_t RA_K = RA_Q + 16 * MiB;
constexpr size_t RA_V = RA_K + 18 * MiB;
constexpr size_t RA_R = RA_V + 36 * MiB;
constexpr size_t RA_P = RA_R + 32 * MiB;
constexpr size_t RA_ALR = RA_P + 32 * MiB;
constexpr size_t RA_DPOOL = RA_ALR + 3 * MiB;
constexpr size_t RA_YMIX = RA_DPOOL + 32 * MiB;
constexpr size_t RA_Y1 = WS_RA + 128 * MiB;
constexpr size_t RA_END = RA_YMIX + 64 * MiB;
constexpr size_t WS_SLOTOUT = WS_WGU;
constexpr size_t WS_ACT = RA_END > WS_SLOTOUT + 578 * MiB ? RA_END : WS_SLOTOUT + 578 * MiB;
constexpr size_t WS_END = WS_ACT + 145 * MiB;
constexpr size_t PQG = WS_ACT;
constexpr size_t PAM = WS_ACT + 32 * MiB;
constexpr size_t PKD = WS_ACT + 96 * MiB;
constexpr size_t PDEC = WS_ACT + 132 * MiB;
constexpr size_t WS_T0 = WS_END;
constexpr size_t T_CNT = WS_T0;
constexpr size_t T_MASK = T_CNT + 65536;
constexpr size_t T_TOKW = T_MASK + 131072;
constexpr size_t T_TOKSLOT = T_TOKW + 524288;
constexpr size_t T_SLOTTOK = T_TOKSLOT + 524288;
constexpr size_t T_SLOTW = T_SLOTTOK + 655360;
constexpr size_t T_TILE = T_SLOTW + 655360;
constexpr size_t T_RSTD1 = (T_TILE + 16384 + 4095) / 4096 * 4096;
constexpr size_t WS_NEED = T_RSTD1 + (size_t)NT * 4;

constexpr int RING_BYTES = 131072;
constexpr int LDS_BYTES = 147456;
constexpr int LDS_MISC = LDS_BYTES - 256;
constexpr int RT_ROWB = 4112;
constexpr int RT_HI = 0;
constexpr int LDS_LOGIT = 32 * RT_ROWB;
constexpr int LDS_MASKS = LDS_LOGIT + 8192;
static_assert(LDS_MASKS + 512 <= LDS_MISC, "LDS map");

#define LDS_WAIT() asm volatile("s_waitcnt lgkmcnt(0)" ::: "memory")
#define LDS_BARRIER() do { asm volatile("s_waitcnt lgkmcnt(0)" ::: "memory"); __builtin_amdgcn_s_barrier(); asm volatile("" ::: "memory"); } while (0)
#define VM_WAIT() asm volatile("s_waitcnt vmcnt(0)" ::: "memory")

__device__ __forceinline__ unsigned f2bf(float f) { unsigned u = __builtin_bit_cast(unsigned, f); return (u + 0x7fffu + ((u >> 16) & 1u)) >> 16; }
__device__ __forceinline__ unsigned pk2(float lo, float hi) { return f2bf(lo) | (f2bf(hi) << 16); }
__device__ __forceinline__ float bflo(unsigned u) { return __builtin_bit_cast(float, u << 16); }
__device__ __forceinline__ float bfhi(unsigned u) { return __builtin_bit_cast(float, u & 0xffff0000u); }
__device__ __forceinline__ float bf1(bf16 b) { return __builtin_bit_cast(float, ((unsigned)b) << 16); }
__device__ __forceinline__ float wave_sum(float v) {
#pragma unroll
    for (int o = 1; o < 64; o <<= 1) v += __shfl_xor(v, o);
    return v;
}
__device__ __forceinline__ float silu_f(float x) { return x / (1.f + __expf(-x)); }

#define XB_TMO      128
#define XB_XCNT(j)  (256  + 64 * (j))
#define XB_XSUB(j)  (1280 + 64 * (j))
#define XB_XGEN(j)  (2304 + 64 * (j))
#define XB_TOP      3328
#define XB_TOPGEN   3392
#define XCD_BAR_WORDS 3456
#define XB_SPIN_CAP (1u << 18)

__device__ __forceinline__ unsigned xb_ld(unsigned* p)              { return __hip_atomic_load(p, __ATOMIC_RELAXED, __HIP_MEMORY_SCOPE_AGENT); }
__device__ __forceinline__ unsigned xb_add(unsigned* p, unsigned v) { return __hip_atomic_fetch_add(p, v, __ATOMIC_RELAXED, __HIP_MEMORY_SCOPE_AGENT); }
__device__ __forceinline__ unsigned xb_xcc_id() { return (unsigned)__builtin_amdgcn_s_getreg((3 << 11) | 20) & 0xFu; }
#define XB_SPIN(cond, bar) do { unsigned _sp = 0; while (cond) { __builtin_amdgcn_s_sleep(1); \
    if ((++_sp & 255u) == 0u) { if (xb_ld(&(bar)[XB_TMO])) break; if (_sp > XB_SPIN_CAP) { atomicAdd(&(bar)[XB_TMO], 1u); break; } } } } while (0)

struct XcdBarrier { unsigned* bar; unsigned x; volatile LAS unsigned* st; };

__device__ __forceinline__ XcdBarrier xcd_barrier_post(unsigned* bar, volatile LAS unsigned* st) {
    XcdBarrier b; b.bar = bar; b.x = xb_xcc_id(); b.st = st;
    if (threadIdx.x == 0) (void)xb_add(&bar[XB_XCNT(b.x)], 1u);
    return b;
}
__device__ __forceinline__ void xcd_barrier_complete(unsigned* bar, unsigned x, unsigned& nloc, unsigned& nx) {
    const unsigned G = gridDim.x * gridDim.y * gridDim.z;
    unsigned sum, cnt, mine, sp = 0u;
    for (;;) {
        sum = 0u; cnt = 0u; mine = 0u;
#pragma unroll
        for (unsigned j = 0; j < 16; ++j) { const unsigned c = xb_ld(&bar[XB_XCNT(j)]); sum += c; cnt += (c > 0u) ? 1u : 0u; mine = (j == x) ? c : mine; }
        if (sum == G) break;
        __builtin_amdgcn_s_sleep(1);
        if ((++sp & 255u) == 0u) { if (xb_ld(&bar[XB_TMO])) break; if (sp > XB_SPIN_CAP) { atomicAdd(&bar[XB_TMO], 1u); break; } }
    }
    nloc = mine > 0u ? mine : 1u; nx = cnt > 0u ? cnt : 1u;
}
__device__ __forceinline__ void xcd_barrier(const XcdBarrier& b) {
    asm volatile("s_waitcnt vmcnt(0)" ::: "memory");
    __syncthreads();
    if (threadIdx.x == 0) {
        unsigned* bar = b.bar;
        __builtin_amdgcn_s_waitcnt(0);
        unsigned nloc = b.st[0], nx = b.st[1];
        if (nloc == 0u) { xcd_barrier_complete(bar, b.x, nloc, nx); b.st[0] = nloc; b.st[1] = nx; }
        const unsigned old = xb_add(&bar[XB_XSUB(b.x)], 1u);
        const unsigned gen = old / nloc;
        if (old + 1u == (gen + 1u) * nloc) {
            __builtin_amdgcn_fence(__ATOMIC_RELEASE, "agent");
            asm volatile("s_waitcnt vmcnt(0)" ::: "memory");
            const unsigned og = xb_add(&bar[XB_TOP], 1u);
            const unsigned tg = og / nx;
            if (og + 1u == (tg + 1u) * nx) xb_add(&bar[XB_TOPGEN], 1u);
            else XB_SPIN(xb_ld(&bar[XB_TOPGEN]) == tg, bar);
            __builtin_amdgcn_fence(__ATOMIC_ACQUIRE, "agent");
            xb_add(&bar[XB_XGEN(b.x)], 1u);
            asm volatile("s_waitcnt vmcnt(0)" ::: "memory");
        } else {
            XB_SPIN(xb_ld(&bar[XB_XGEN(b.x)]) == gen, bar);
            __builtin_amdgcn_fence(__ATOMIC_ACQUIRE, "agent");
            asm volatile("s_waitcnt vmcnt(0)" ::: "memory");
        }
    }
    __syncthreads();
}

namespace pg8 {
constexpr int BM = 256, BK = 64, HALF = 128, HTB = HALF * BK * 2, STAGE_BYTES = 8 * HTB, NXCD = 8, WGM = 8;
__device__ __forceinline__ int lds_byte(int r, int c) { const int st = (r >> 4) * 2 + (c >> 5), rr = r & 15, cc = c & 31, ob = rr * 64 + cc * 2; return st * 1024 + (ob ^ (((ob >> 9) & 1) << 5)); }
__device__ __forceinline__ void stage_rc(int b, int& R, int& C) { const int st = b / 1024, sb = b % 1024, swz = sb ^ (((sb >> 9) & 1) << 5); R = (st >> 1) * 16 + swz / 64; C = (st & 1) * 32 + (swz % 64) / 2; }
__device__ __forceinline__ int perm32(int rho) { const int n = rho >> 4, i = rho & 15; return 8 * (i >> 2) + 4 * n + (i & 3); }
__device__ __forceinline__ unsigned cvt_pk_bf16(float lo, float hi) { unsigned r; asm volatile("v_cvt_pk_bf16_f32 %0, %1, %2" : "=v"(r) : "v"(lo), "v"(hi)); return r; }

typedef int v8i __attribute__((ext_vector_type(8)));
typedef int v4i __attribute__((ext_vector_type(4)));
template <class Epi, class Sched, bool FP8 = false>
__device__ __forceinline__ void gemm_phase(LAS unsigned char* lds, const int K, const Sched& S, const Epi& E) {
    typedef typename Sched::U Unit;
    const int tid = threadIdx.x, wid = __builtin_amdgcn_readfirstlane(tid >> 6), lane = tid & 63, wr = wid >> 2, wc = wid & 3, fr = lane & 15, fq = lane >> 4;
    const int nt = K / BK;
    int R[2], C[2]; unsigned voffB[2];
#pragma unroll
    for (int i = 0; i < 2; ++i) { stage_rc(tid * 16 + i * 8192, R[i], C[i]);
        const int Rb = Epi::PERMK == 2 ? (64 * (R[i] >> 5) + 16 * ((R[i] & 15) >> 2) + 4 * ((R[i] >> 4) & 1) + (R[i] & 3)) : (Epi::PERMK == 1 ? ((R[i] & ~31) + perm32(R[i] & 31)) : R[i]);
        voffB[i] = (unsigned)(Rb * K + C[i]) * 2u; }
    const size_t kstep = (size_t)(BK * 2);
    const size_t hstepB = (size_t)(Epi::PERMK == 2 ? 8 : HALF) * K * 2;
    const unsigned ldsw = (unsigned)wid * 1024u;
    const int aoff = lds_byte(wr * 64 + fr, fq * 8), boff = lds_byte(wc * 32 + fr, fq * 8);
#define PG8_SA(b, h) (((b) * 2 + (h)) * HTB)
#define PG8_SB(b, h) ((4 + (b) * 2 + (h)) * HTB)
#define PG8_STAGE(bufoff, gbase, v0, v1) do { \
        __builtin_amdgcn_global_load_lds((const unsigned*)((const char*)(gbase) + (v0)), (LAS unsigned*)(lds + (bufoff) + ldsw), 16, 0, 0); \
        __builtin_amdgcn_global_load_lds((const unsigned*)((const char*)(gbase) + (v1)), (LAS unsigned*)(lds + (bufoff) + ldsw + 8192), 16, 0, 0); } while (0)
#define PG8_LDA(dst, b, h) do { _Pragma("unroll") for (int m = 0; m < 4; ++m) { const v4i lo_ = *(const LAS v4i*)(lds + PG8_SA(b, h) + aoff + m * 2048), hi_ = *(const LAS v4i*)(lds + PG8_SA(b, h) + aoff + m * 2048 + 1024); \
        dst[m] = __builtin_shufflevector(lo_, hi_, 0, 1, 2, 3, 4, 5, 6, 7); } } while (0)
#define PG8_LDB(dst, b, h) do { _Pragma("unroll") for (int n = 0; n < 2; ++n) { const v4i lo_ = *(const LAS v4i*)(lds + PG8_SB(b, h) + boff + n * 2048), hi_ = *(const LAS v4i*)(lds + PG8_SB(b, h) + boff + n * 2048 + 1024); \
        dst[n] = __builtin_shufflevector(lo_, hi_, 0, 1, 2, 3, 4, 5, 6, 7); } } while (0)
#define PG8_H0(x) ((bf16x8)__builtin_shufflevector(x, x, 0, 1, 2, 3))
#define PG8_H1(x) ((bf16x8)__builtin_shufflevector(x, x, 4, 5, 6, 7))
#define PG8_MMA(ai, bj, At, Bt) do { __builtin_amdgcn_s_setprio(1); if constexpr (FP8) asm volatile("s_nop 4"); _Pragma("unroll") for (int m = 0; m < 4; ++m) _Pragma("unroll") for (int n = 0; n < 2; ++n) { \
        if constexpr (FP8) asm volatile("v_mfma_f32_16x16x128_f8f6f4 %0, %1, %2, %0" : "+v"(acc[ai][bj][m][n]) : "v"(Bt[n]), "v"(At[m])); \
        else { acc[ai][bj][m][n] = __builtin_amdgcn_mfma_f32_16x16x32_bf16(PG8_H0(Bt[n]), PG8_H0(At[m]), acc[ai][bj][m][n], 0, 0, 0); \
               acc[ai][bj][m][n] = __builtin_amdgcn_mfma_f32_16x16x32_bf16(PG8_H1(Bt[n]), PG8_H1(At[m]), acc[ai][bj][m][n], 0, 0, 0); } } \
        __builtin_amdgcn_s_setprio(0); } while (0)
#define PG8_WAIT_V(n) asm volatile("s_waitcnt vmcnt(" #n ")" ::: "memory")
#define PG8_WAIT_L(n) asm volatile("s_waitcnt lgkmcnt(" #n ")" ::: "memory")
#define PG8_BAR __builtin_amdgcn_s_barrier()
#define PG8_SCHED __builtin_amdgcn_sched_barrier(0)
    Unit cur, nxt; int ui = 0;
    if (!S.next(0, cur)) return;
    f32x4 acc[2][2][4][2];
#pragma unroll
    for (int a = 0; a < 2; ++a)
#pragma unroll
        for (int b = 0; b < 2; ++b)
#pragma unroll
            for (int m = 0; m < 4; ++m)
#pragma unroll
                for (int n = 0; n < 2; ++n) acc[a][b][m][n] = (f32x4){0.f, 0.f, 0.f, 0.f};
    v8i At[4], B0[2], B1[2];
    unsigned vA[4], vN[4];
    S.aoffs(cur, R, C, vA);
    const char* cA = cur.A; const char* cB = cur.B;
    PG8_STAGE(PG8_SB(0, 0), cB, voffB[0], voffB[1]); PG8_STAGE(PG8_SB(0, 1), cB + hstepB, voffB[0], voffB[1]); PG8_STAGE(PG8_SA(0, 0), cA, vA[0], vA[1]); PG8_STAGE(PG8_SA(0, 1), cA, vA[2], vA[3]);
    if (wr == 1) PG8_BAR;
    PG8_WAIT_V(2); PG8_BAR;
    PG8_STAGE(PG8_SB(1, 0), cB + kstep, voffB[0], voffB[1]); PG8_STAGE(PG8_SA(1, 0), cA + kstep, vA[0], vA[1]); PG8_STAGE(PG8_SB(1, 1), cB + hstepB + kstep, voffB[0], voffB[1]);
    PG8_WAIT_V(6); PG8_BAR;
    for (;;) {
        const bool has_next = S.next(ui + 1, nxt);
        const char* nA = has_next ? nxt.A : cA; const char* nB = has_next ? nxt.B : cB;
        if (has_next) S.aoffs(nxt, R, C, vN); else { vN[0] = vA[0]; vN[1] = vA[1]; vN[2] = vA[2]; vN[3] = vA[3]; }
        for (int t = 0; t < nt; t += 2) {
            const bool last = (t == nt - 2);
            const char* a1 = cA + (size_t)(t + 1) * kstep;
            const char* a2 = last ? nA : cA + (size_t)(t + 2) * kstep; const char* b2 = last ? nB : cB + (size_t)(t + 2) * kstep;
            const char* a3 = a2 + kstep; const char* b3 = b2 + kstep;
            const unsigned x0 = last ? vN[0] : vA[0], x1 = last ? vN[1] : vA[1], x2 = last ? vN[2] : vA[2], x3 = last ? vN[3] : vA[3];
            PG8_LDB(B0, 0, 0); PG8_LDB(B1, 0, 1); PG8_SCHED; PG8_LDA(At, 0, 0); PG8_STAGE(PG8_SA(1, 1), a1, vA[2], vA[3]);
            PG8_WAIT_V(8); PG8_WAIT_L(0); PG8_BAR; PG8_MMA(0, 0, At, B0); PG8_MMA(0, 1, At, B1); PG8_BAR; PG8_SCHED;
            PG8_LDA(At, 0, 1); PG8_STAGE(PG8_SB(0, 0), b2, voffB[0], voffB[1]); PG8_STAGE(PG8_SB(0, 1), b2 + hstepB, voffB[0], voffB[1]); PG8_STAGE(PG8_SA(0, 0), a2, x0, x1);
            PG8_WAIT_V(8); PG8_WAIT_L(0); PG8_BAR; PG8_MMA(1, 0, At, B0); PG8_MMA(1, 1, At, B1); PG8_BAR; PG8_SCHED;
            PG8_LDB(B0, 1, 0); PG8_LDB(B1, 1, 1); PG8_SCHED; PG8_LDA(At, 1, 0); PG8_STAGE(PG8_SA(0, 1), a2, x2, x3);
            PG8_WAIT_V(8); PG8_WAIT_L(0); PG8_BAR; PG8_MMA(0, 0, At, B0); PG8_MMA(0, 1, At, B1); PG8_BAR; PG8_SCHED;
            PG8_LDA(At, 1, 1); PG8_STAGE(PG8_SB(1, 0), b3, voffB[0], voffB[1]); PG8_STAGE(PG8_SB(1, 1), b3 + hstepB, voffB[0], voffB[1]); PG8_STAGE(PG8_SA(1, 0), a3, x0, x1);
            PG8_WAIT_V(8); PG8_WAIT_L(0); PG8_BAR; PG8_MMA(1, 0, At, B0); PG8_MMA(1, 1, At, B1); PG8_BAR; PG8_SCHED;
        }
        if (wr == 0) PG8_BAR;
        if constexpr (FP8) asm volatile("s_nop 15\n\ts_nop 15");
        { int tz = threadIdx.x; asm volatile("" : "+v"(tz));
          const int wid_ = tz >> 6, lane_ = tz & 63; E(acc, cur, wid_ >> 2, wid_ & 3, lane_ & 15, lane_ >> 4);
#ifdef PROBE_EPI2
          if constexpr (Epi::PROBE2) { asm volatile("" : "+v"(tz)); const int w2 = tz >> 6, l2 = tz & 63; E(acc, cur, w2 >> 2, w2 & 3, l2 & 15, l2 >> 4); }
#endif
#ifdef PROBE_DRAIN
          if constexpr (Epi::PROBE2) { asm volatile("s_waitcnt vmcnt(0)" ::: "memory"); }
#endif
        }
        if (!has_next) break;
#pragma unroll
        for (int a = 0; a < 2; ++a)
#pragma unroll
            for (int b = 0; b < 2; ++b)
#pragma unroll
                for (int m = 0; m < 4; ++m)
#pragma unroll
                    for (int n = 0; n < 2; ++n) acc[a][b][m][n] = (f32x4){0.f, 0.f, 0.f, 0.f};
        cur = nxt; cA = nA; cB = nB; ++ui;
        vA[0] = vN[0]; vA[1] = vN[1]; vA[2] = vN[2]; vA[3] = vN[3];
        if (wr == 1) PG8_BAR;
    }
    PG8_WAIT_V(0);
    PG8_BAR;
#undef PG8_SA
#undef PG8_SB
#undef PG8_STAGE
#undef PG8_LDA
#undef PG8_LDB
#undef PG8_H0
#undef PG8_H1
#undef PG8_MMA
#undef PG8_WAIT_V
#undef PG8_WAIT_L
#undef PG8_BAR
#undef PG8_SCHED
}
}

struct Args { const float* in[27]; float* out; unsigned char* ws; int ph_lo, ph_hi; };
static_assert(sizeof(Args) == 27 * 8 + 8 + 8 + 8, "Args has no padding");

struct DenseU { const char* A; const char* B; int pm, pn; };
struct DenseSched {
    typedef DenseU U;
    const char* A; const char* B; int lda, K, nM, nN, nwg, G, c;
    __device__ __forceinline__ void init(const void* A_, const void* B_, int lda_, int K_, int M, int N, int G_, int c_) { A = (const char*)A_; B = (const char*)B_; lda = lda_; K = K_; nM = M / 256; nN = N / 256; nwg = nM * nN; G = G_; c = c_; }
    __device__ __forceinline__ bool next(int i, U& u) const {
        const long L = (long)i * G + c; if (L >= nwg) return false;
        int wgid = (int)L; { const int q = nwg / 8, r = nwg % 8, xcd = wgid % 8, off = wgid / 8; wgid = (xcd < r ? xcd * (q + 1) : r * (q + 1) + (xcd - r) * q) + off; }
        const int nig = 8 * nN, gid = wgid / nig, fm = gid * 8, gsz = (nM - fm) < 8 ? (nM - fm) : 8;
        u.pm = fm + ((wgid % nig) % gsz); u.pn = (wgid % nig) / gsz;
        u.A = A + (size_t)u.pm * 256 * lda * 2; u.B = B + (size_t)u.pn * 256 * K * 2; return true;
    }
    __device__ __forceinline__ void aoffs(const U&, const int (&R)[2], const int (&C)[2], unsigned (&v)[4]) const {
#pragma unroll
        for (int h = 0; h < 2; ++h)
#pragma unroll
            for (int i = 0; i < 2; ++i) v[h * 2 + i] = (unsigned)((h * 128 + R[i]) * lda + C[i]) * 2u;
    }
};
struct PoolU { const char* A; const char* B; int pm, g; };
struct PoolSched {
    typedef PoolU U;
    const char* A; const char* B; int G, c;
    __device__ __forceinline__ bool next(int i, U& u) const {
        const int L = i * G + c; if (L >= 256) return false;
        u.g = L & 3; u.pm = L >> 2;
        u.A = A + ((size_t)u.pm * 256 * 1024 + u.g * 256) * 2; u.B = B + (size_t)u.g * 256 * 256 * 2; return true;
    }
    __device__ __forceinline__ void aoffs(const U&, const int (&R)[2], const int (&C)[2], unsigned (&v)[4]) const {
#pragma unroll
        for (int h = 0; h < 2; ++h)
#pragma unroll
            for (int i = 0; i < 2; ++i) v[h * 2 + i] = (unsigned)((h * 128 + R[i]) * 1024 + C[i]) * 2u;
    }
};
struct MoeU { const char* A; const char* B; int row0, nrows, pn; };
struct MoeGUSched {
    typedef MoeU U;
    const char* H2; const char* W; const int* tile; const int* slot_tok; int G, c;
    __device__ __forceinline__ bool next(int i, U& u) const {
        const int nt = tile[3 * NTILE_MAX]; const int L = i * G + c; if (L >= nt * 4) return false;
        const int t = L >> 2; u.pn = L & 3; const int e = tile[t]; u.row0 = tile[NTILE_MAX + t]; u.nrows = tile[2 * NTILE_MAX + t];
        u.A = H2; u.B = W + ((size_t)e * 1024 + u.pn * 256) * 2048; return true;
    }
    __device__ __forceinline__ void aoffs(const U& u, const int (&R)[2], const int (&C)[2], unsigned (&v)[4]) const {
#pragma unroll
        for (int h = 0; h < 2; ++h)
#pragma unroll
            for (int i = 0; i < 2; ++i) { int r = h * 128 + R[i]; r = r < u.nrows ? r : u.nrows - 1; const int tok = slot_tok[u.row0 + r]; v[h * 2 + i] = (unsigned)(tok * 1024 + C[i]) * 2u; }
    }
};
struct MoeDownSched {
    typedef MoeU U;
    const char* ACT; const char* W; const int* tile; int G, c;
    __device__ __forceinline__ bool next(int i, U& u) const {
        const int nt = tile[3 * NTILE_MAX]; const int L = i * G + c; if (L >= nt * 8) return false;
        const int t = L >> 3; u.pn = L & 7; const int e = tile[t]; u.row0 = tile[NTILE_MAX + t]; u.nrows = tile[2 * NTILE_MAX + t];
        u.A = ACT + (size_t)u.row0 * 512; u.B = W + ((size_t)e * 2048 + u.pn * 256) * 512; return true;
    }
    __device__ __forceinline__ void aoffs(const U&, const int (&R)[2], const int (&C)[2], unsigned (&v)[4]) const {
#pragma unroll
        for (int h = 0; h < 2; ++h)
#pragma unroll
            for (int i = 0; i < 2; ++i) v[h * 2 + i] = (unsigned)((h * 128 + R[i]) * 256 + C[i]) * 2u;
    }
};

struct EpiIn {
    static constexpr int PERMK = 1; static constexpr bool PROBE2 = false;
    unsigned char* ws;
    __device__ __forceinline__ void operator()(const f32x4 (&acc)[2][2][4][2], const DenseU& u, int wr, int wc, int fr, int fq) const {
        const int pn = u.pn; const int row0 = u.pm * 256 + wr * 64 + fr;
        if (pn == 16) {
            if (wc != 0) return;
            float* alr = (float*)(ws + RA_ALR);
#pragma unroll
            for (int ai = 0; ai < 2; ++ai)
#pragma unroll
                for (int m = 0; m < 4; ++m) { float* rp = alr + (size_t)(row0 + ai * 128 + m * 16) * 32 + 8 * fq;
                    *(f32x4*)(rp) = acc[ai][0][m][0]; *(f32x4*)(rp + 4) = acc[ai][0][m][1]; }
            return;
        }
        bf16* base; int ld, colt; bool lat_only;
        if (pn < 2) { base = (bf16*)(ws + RA_Q); ld = 512; colt = pn * 256; lat_only = true; }
        else if (pn < 4) { base = (bf16*)(ws + RA_K); ld = 512; colt = (pn - 2) * 256; lat_only = false; }
        else if (pn < 8) { base = (bf16*)(ws + RA_V); ld = 1024; colt = (pn - 4) * 256; lat_only = false; }
        else if (pn < 12) { base = (bf16*)(ws + RA_R); ld = 1024; colt = (pn - 8) * 256; lat_only = true; }
        else { base = (bf16*)(ws + RA_P); ld = 1024; colt = (pn - 12) * 256; lat_only = true; }
        if (lat_only && u.pm >= 64) return;
        const int col0 = colt + wc * 32 + 8 * fq;
#pragma unroll
        for (int ai = 0; ai < 2; ++ai)
#pragma unroll
            for (int m = 0; m < 4; ++m) { bf16* rp = base + (size_t)(row0 + ai * 128 + m * 16) * ld + col0;
#pragma unroll
                for (int bj = 0; bj < 2; ++bj) { const f32x4 v0 = acc[ai][bj][m][0], v1 = acc[ai][bj][m][1];
                    v4u o; o.x = pg8::cvt_pk_bf16(v0[0], v0[1]); o.y = pg8::cvt_pk_bf16(v0[2], v0[3]); o.z = pg8::cvt_pk_bf16(v1[0], v1[1]); o.w = pg8::cvt_pk_bf16(v1[2], v1[3]);
                    *(v4u*)(rp + bj * 128) = o; } }
    }
};
struct EpiPool {
    static constexpr int PERMK = 1; static constexpr bool PROBE2 = false;
    bf16* ymix; const float* scale;
    __device__ __forceinline__ void operator()(const f32x4 (&acc)[2][2][4][2], const PoolU& u, int wr, int wc, int fr, int fq) const {
        const int row0 = u.pm * 256 + wr * 64 + fr; const int c0 = u.g * 256 + wc * 32 + 8 * fq;
#pragma unroll
        for (int ai = 0; ai < 2; ++ai)
#pragma unroll
            for (int m = 0; m < 4; ++m) { bf16* rp = ymix + (size_t)(row0 + ai * 128 + m * 16) * 2048 + 1024 + c0;
#pragma unroll
                for (int bj = 0; bj < 2; ++bj) { const f32x4 s0 = *(const f32x4*)(scale + c0 + bj * 128), s1 = *(const f32x4*)(scale + c0 + bj * 128 + 4);
                    const f32x4 v0 = acc[ai][bj][m][0] * s0, v1 = acc[ai][bj][m][1] * s1;
                    v4u o; o.x = pg8::cvt_pk_bf16(v0[0], v0[1]); o.y = pg8::cvt_pk_bf16(v0[2], v0[3]); o.z = pg8::cvt_pk_bf16(v1[0], v1[1]); o.w = pg8::cvt_pk_bf16(v1[2], v1[3]);
                    *(v4u*)(rp + bj * 128) = o; } }
    }
};
struct EpiOut {
    static constexpr int PERMK = 1; static constexpr bool PROBE2 = false;
    bf16* y;
    __device__ __forceinline__ void operator()(const f32x4 (&acc)[2][2][4][2], const DenseU& u, int wr, int wc, int fr, int fq) const {
        const int row0 = u.pm * 256 + wr * 64 + fr, col0 = u.pn * 256 + wc * 32 + 8 * fq;
#pragma unroll
        for (int ai = 0; ai < 2; ++ai)
#pragma unroll
            for (int m = 0; m < 4; ++m) { bf16* rp = y + (size_t)(row0 + ai * 128 + m * 16) * 2048 + col0;
#pragma unroll
                for (int bj = 0; bj < 2; ++bj) { const f32x4 v0 = acc[ai][bj][m][0], v1 = acc[ai][bj][m][1];
                    v4u o; o.x = pg8::cvt_pk_bf16(v0[0], v0[1]); o.y = pg8::cvt_pk_bf16(v0[2], v0[3]); o.z = pg8::cvt_pk_bf16(v1[0], v1[1]); o.w = pg8::cvt_pk_bf16(v1[2], v1[3]);
                    *(v4u*)(rp + bj * 128) = o; } }
    }
};
constexpr float SC_W = 256.f, SC_H = 16.f, SC_A = 16.f;
__device__ __forceinline__ unsigned pk4_fp8(float a, float b, float c, float d) {
    a = fminf(fmaxf(a, -448.f), 448.f); b = fminf(fmaxf(b, -448.f), 448.f); c = fminf(fmaxf(c, -448.f), 448.f); d = fminf(fmaxf(d, -448.f), 448.f);
    unsigned w = 0; w = __builtin_amdgcn_cvt_pk_fp8_f32(a, b, w, false); w = __builtin_amdgcn_cvt_pk_fp8_f32(c, d, w, true); return w;
}
struct EpiGU {
    static constexpr int PERMK = 1; static constexpr bool PROBE2 = false;
    unsigned char* act; const float* slot_w;
    __device__ __forceinline__ void operator()(const f32x4 (&acc)[2][2][4][2], const MoeU& u, int wr, int wc, int fr, int fq) const {
        const int c0 = u.pn * 128 + wc * 32 + 8 * fq; constexpr float inv = 1.f / (SC_W * SC_H);
#pragma unroll
        for (int ai = 0; ai < 2; ++ai)
#pragma unroll
            for (int m = 0; m < 4; ++m) { const int r = ai * 128 + wr * 64 + m * 16 + fr;
                if (r < u.nrows) { const float w = slot_w[u.row0 + r] * SC_A; float o[8];
#pragma unroll
                    for (int n = 0; n < 2; ++n)
#pragma unroll
                        for (int j = 0; j < 4; ++j) { const float g = acc[ai][0][m][n][j] * inv, up = acc[ai][1][m][n][j] * inv; o[n * 4 + j] = silu_f(g) * up * w; }
                    v2u q; q.x = pk4_fp8(o[0], o[1], o[2], o[3]); q.y = pk4_fp8(o[4], o[5], o[6], o[7]);
                    *(v2u*)(act + (size_t)(u.row0 + r) * 512 + c0) = q; } }
    }
};
constexpr float SC_O = 32.f;
struct EpiDown {
    static constexpr int PERMK = 2; static constexpr bool PROBE2 = true;
    unsigned char* so;
    __device__ __forceinline__ void operator()(const f32x4 (&acc)[2][2][4][2], const MoeU& u, int wr, int wc, int fr, int fq) const {
        const int c0 = u.pn * 256 + wc * 64 + 16 * fq; constexpr float sc = SC_O / (SC_W * SC_A);
#pragma unroll
        for (int ai = 0; ai < 2; ++ai)
#pragma unroll
            for (int m = 0; m < 4; ++m) { const int r = ai * 128 + wr * 64 + m * 16 + fr;
                if (r < u.nrows) { const f32x4 a0 = acc[ai][0][m][0] * sc, a1 = acc[ai][0][m][1] * sc, b0 = acc[ai][1][m][0] * sc, b1 = acc[ai][1][m][1] * sc;
                    v4u o; o.x = pk4_fp8(a0[0], a0[1], a0[2], a0[3]); o.y = pk4_fp8(a1[0], a1[1], a1[2], a1[3]); o.z = pk4_fp8(b0[0], b0[1], b0[2], b0[3]); o.w = pk4_fp8(b1[0], b1[1], b1[2], b1[3]);
                    __builtin_nontemporal_store(o, (v4u*)(so + (size_t)(u.row0 + r) * 2048 + c0)); } }
    }
};

__device__ __forceinline__ void tr_item(const float* W, int ldn, bf16* WT, int Kd, int drow0, int k0, int n0, LAS float* scr, int lane) {
    f32x4 t[8];
#pragma unroll
    for (int i = 0; i < 8; ++i) t[i] = *(const f32x4*)(W + (size_t)(k0 + 8 * i + (lane >> 3)) * ldn + n0 + 4 * (lane & 7));
#pragma unroll
    for (int i = 0; i < 8; ++i) { LAS float* d = scr + (8 * i + (lane >> 3)) * 33 + 4 * (lane & 7); d[0] = t[i][0]; d[1] = t[i][1]; d[2] = t[i][2]; d[3] = t[i][3]; }
    LDS_WAIT(); asm volatile("" ::: "memory");
    const int c = lane & 7;
#pragma unroll
    for (int j = 0; j < 4; ++j) { const int n = (lane >> 3) + 8 * j; const LAS float* s = scr + (8 * c) * 33 + n;
        v4u o; o.x = pk2(s[0 * 33], s[1 * 33]); o.y = pk2(s[2 * 33], s[3 * 33]); o.z = pk2(s[4 * 33], s[5 * 33]); o.w = pk2(s[6 * 33], s[7 * 33]);
        *(v4u*)(WT + (size_t)(drow0 + n) * Kd + k0 + 8 * c) = o; }
    LDS_WAIT(); asm volatile("" ::: "memory");
}

__device__ __forceinline__ void tr_item8(const float* W, int ldn, unsigned char* WT, int Kd, int drow0, int k0, int n0, LAS float* scr, int lane) {
    f32x4 t[8];
#pragma unroll
    for (int i = 0; i < 8; ++i) t[i] = *(const f32x4*)(W + (size_t)(k0 + 8 * i + (lane >> 3)) * ldn + n0 + 4 * (lane & 7));
#pragma unroll
    for (int i = 0; i < 8; ++i) { LAS float* d = scr + (8 * i + (lane >> 3)) * 33 + 4 * (lane & 7); d[0] = t[i][0]; d[1] = t[i][1]; d[2] = t[i][2]; d[3] = t[i][3]; }
    LDS_WAIT(); asm volatile("" ::: "memory");
    const int c = lane & 7;
#pragma unroll
    for (int j = 0; j < 4; ++j) { const int n = (lane >> 3) + 8 * j; const LAS float* s = scr + (8 * c) * 33 + n;
        v2u o; o.x = pk4_fp8(s[0 * 33] * SC_W, s[1 * 33] * SC_W, s[2 * 33] * SC_W, s[3 * 33] * SC_W); o.y = pk4_fp8(s[4 * 33] * SC_W, s[5 * 33] * SC_W, s[6 * 33] * SC_W, s[7 * 33] * SC_W);
        *(v2u*)(WT + (size_t)(drow0 + n) * Kd + k0 + 8 * c) = o; }
    LDS_WAIT(); asm volatile("" ::: "memory");
}

constexpr int I_IN = 32 * 129, I_OUT = 32 * 64, I_POOL = 4 * 4 * 8, I_E = 65 * 512;
constexpr int NITEMS = I_IN + I_OUT + I_POOL + 3 * I_E;
constexpr int NITEMS_P0 = NITEMS - 33280;
__device__ __forceinline__ void convert_items(const Args& a, LAS float* scr, int lane, int first, int step, int end, int skip = 0) {
    unsigned char* ws = a.ws;
    bf16* Win_t = (bf16*)(ws + WS_WIN); bf16* Wout_t = (bf16*)(ws + WS_WOUT); bf16* Wpool_t = (bf16*)(ws + WS_WPOOL); unsigned char* Wd_t = ws + WS_WD; unsigned char* Wgu_t = ws + WS_WGU;
    for (int it = first; it < end; it += step) {
        int r = it < I_IN + I_OUT + I_POOL ? it : it + skip;
        if (r < I_IN) { const int kb = r / 129, nb = r % 129, n0 = 32 * nb; const int drow = n0 < 3072 ? n0 : (n0 == 3072 ? 4096 : n0 - 32);
            tr_item(a.in[10], DIN, Win_t, 2048, drow, 64 * kb, n0, scr, lane); continue; } r -= I_IN;
        if (r < I_OUT) { const int kb = r / 64, nb = r % 64; tr_item(a.in[18], 2048, Wout_t, 2048, 32 * nb, 64 * kb, 32 * nb, scr, lane); continue; } r -= I_OUT;
        if (r < I_POOL) { const int g = r / 32, rr = r % 32, kb = rr / 8, nb = rr % 8; tr_item(a.in[16] + g * 65536, 256, Wpool_t + g * 65536, 256, 32 * nb, 64 * kb, 32 * nb, scr, lane); continue; } r -= I_POOL;
        if (r < I_E) { const int e = r / 512, rr = r % 512, kb = rr / 16, nb = rr % 16, n0 = 32 * nb; const float* src = e < 64 ? a.in[21] + (size_t)e * 2048 * 512 : a.in[24];
            tr_item8(src, 512, Wgu_t + (size_t)e * 1024 * 2048, 2048, (n0 / 128) * 256 + (n0 % 128), 64 * kb, n0, scr, lane); continue; } r -= I_E;
        if (r < I_E) { const int e = r / 512, rr = r % 512, kb = rr / 16, nb = rr % 16, n0 = 32 * nb; const float* src = e < 64 ? a.in[22] + (size_t)e * 2048 * 512 : a.in[25];
            tr_item8(src, 512, Wgu_t + (size_t)e * 1024 * 2048, 2048, (n0 / 128) * 256 + 128 + (n0 % 128), 64 * kb, n0, scr, lane); continue; } r -= I_E;
        { const int e = 64 - r / 512, rr = r % 512, kb = rr / 64, nb = rr % 64; const float* src = e < 64 ? a.in[23] + (size_t)e * 512 * 2048 : a.in[26];
            tr_item8(src, 2048, Wd_t + (size_t)e * 2048 * 512, 512, 32 * nb, 64 * kb, 32 * nb, scr, lane); }
    }
}

__device__ __forceinline__ void phase0(const Args& a, LAS unsigned char* lds, int tid, int lane, int wave, int vcu, int G, bool do_mod = true, bool do_tr = true) {
    unsigned char* ws = a.ws;
    if (vcu < 192 && do_mod) {
        LAS float* sc = (LAS float*)lds;
        LAS float* red = (LAS float*)(lds + 73728);
        for (int i = tid; i < 9 * 2048; i += 512) { const int r = i >> 11, k = i & 2047; const float v = r < 8 ? a.in[1][r * 2048 + k] : a.in[3][k]; sc[i] = silu_f(v); }
        __syncthreads();
        const float* wm = a.in[4]; const float* bm = a.in[5]; float* mod = (float*)(ws + WS_MOD);
        for (int chunk = vcu; chunk < 192; chunk += G) {
            const int n0 = chunk * 64, ks = lane >> 4, n4 = (lane & 15) * 4;
            f32x4 acc[9];
#pragma unroll
            for (int r = 0; r < 9; ++r) acc[r] = (f32x4){0.f, 0.f, 0.f, 0.f};
#pragma unroll 4
            for (int kk = 0; kk < 256; kk += 4) { const int k = wave * 256 + kk + ks; const f32x4 wv = *(const f32x4*)(wm + (size_t)k * 12288 + n0 + n4);
#pragma unroll
                for (int r = 0; r < 9; ++r) { const float s = sc[r * 2048 + k]; acc[r] += wv * s; } }
#pragma unroll
            for (int r = 0; r < 9; ++r)
#pragma unroll
                for (int j = 0; j < 4; ++j) { float v = acc[r][j]; v += __shfl_xor(v, 16); v += __shfl_xor(v, 32); acc[r][j] = v; }
            if (lane < 16) {
#pragma unroll
                for (int r = 0; r < 9; ++r) *(LAS f32x4*)(red + (wave * 9 + r) * 64 + n4) = acc[r]; }
            __syncthreads();
            for (int i = tid; i < 9 * 64; i += 512) { const int r = i >> 6, n = i & 63; float s = 0.f;
#pragma unroll
                for (int w = 0; w < 8; ++w) s += red[(w * 9 + r) * 64 + n];
                mod[r * 12288 + n0 + n] = s + bm[n0 + n]; }
            __syncthreads();
        }
    }
    __syncthreads();
    if (do_tr) convert_items(a, (LAS float*)(lds + wave * 16384), lane, vcu * 8 + wave, G * 8, NITEMS_P0 - 2 * I_E, 2 * I_E);
    { const float* wr = a.in[19]; bf16* whi = (bf16*)(ws + WS_WRT); bf16* wlo = whi + 64 * 2048;
      for (int idx = vcu * 512 + tid; idx < 64 * 256; idx += G * 512) { const int e = idx >> 8, k8 = idx & 255; unsigned hi[8], lo[8];
#pragma unroll
          for (int j = 0; j < 8; ++j) { const float v = wr[(size_t)(8 * k8 + j) * 64 + e]; hi[j] = f2bf(v); lo[j] = f2bf(v - __builtin_bit_cast(float, hi[j] << 16)); }
          v4u oh, ol; oh.x = hi[0] | (hi[1] << 16); oh.y = hi[2] | (hi[3] << 16); oh.z = hi[4] | (hi[5] << 16); oh.w = hi[6] | (hi[7] << 16);
          ol.x = lo[0] | (lo[1] << 16); ol.y = lo[2] | (lo[3] << 16); ol.z = lo[4] | (lo[5] << 16); ol.w = lo[6] | (lo[7] << 16);
          *(v4u*)(whi + (size_t)e * 2048 + 8 * k8) = oh; (void)ol; (void)wlo; } }
    { v4u* z = (v4u*)((bf16*)(ws + WS_WIN) + (size_t)DIN * 2048); const int nz = (DINP - DIN) * 2048 / 8;
      for (int i = vcu * 512 + tid; i < nz; i += G * 512) z[i] = (v4u){0u, 0u, 0u, 0u}; }
}

__device__ __forceinline__ void phase1(const Args& a, int lane, int wave, int vcu, int G) {
    const float* mod = (const float*)(a.ws + WS_MOD); bf16* H = (bf16*)(a.ws + RA_H); const float* g = a.in[6];
    for (int m = vcu * 8 + wave; m < MROWS; m += G * 8) {
        const float* xr = m < NT ? a.in[0] + (size_t)m * 2048 : a.in[2] + (size_t)(m - NT) * 2048;
        const float* mr = mod + (size_t)(m < NT ? (m >> 11) : 8) * 12288;
        f32x4 v[8]; float ss = 0.f;
#pragma unroll
        for (int j = 0; j < 8; ++j) { v[j] = *(const f32x4*)(xr + 4 * (lane + 64 * j)); ss += v[j][0] * v[j][0] + v[j][1] * v[j][1] + v[j][2] * v[j][2] + v[j][3] * v[j][3]; }
        const float rstd = rsqrtf(wave_sum(ss) * (1.f / 2048.f) + EPS);
#pragma unroll
        for (int j = 0; j < 8; ++j) { const int c = 4 * (lane + 64 * j); const f32x4 gg = *(const f32x4*)(g + c), sh = *(const f32x4*)(mr + c), sc = *(const f32x4*)(mr + 2048 + c);
            const f32x4 o = v[j] * rstd * gg * (sc + 1.f) + sh;
            v2u q; q.x = pk2(o[0], o[1]); q.y = pk2(o[2], o[3]); *(v2u*)(H + (size_t)m * 2048 + c) = q; }
    }
}

__device__ __forceinline__ int scan_row(int b, int dir, int s) {
    if (s < 256) { const int tc = dir ? 255 - s : s; return NT + b * 256 + tc; }
    const int t0 = s - 256; return b * 2048 + (dir ? 2047 - t0 : t0);
}
__device__ __forceinline__ void prep_item(const Args& a, LAS unsigned char* lds, int tid, int dir, int b, int ch) {
    unsigned char* ws = a.ws;
    const bf16* Q = (const bf16*)(ws + RA_Q); const bf16* Kb = (const bf16*)(ws + RA_K); const float* ALR = (const float*)(ws + RA_ALR);
    v4u* QG = (v4u*)(ws + PQG); bf16* AM = (bf16*)(ws + PAM); bf16* KD = (bf16*)(ws + PKD); float* DEC = (float*)(ws + PDEC);
    constexpr int TS = 520;
    LAS float* alr = (LAS float*)lds;
    LAS bf16* Kt = (LAS bf16*)(lds + 4096);
    LAS bf16* Qt = (LAS bf16*)(lds + 4096 + 64 * TS * 2);
    const int col = tid, h = col >> 7, dk = col & 127;
    const int lane = tid & 63, wave = __builtin_amdgcn_readfirstlane(tid >> 6), l15 = lane & 15, l4 = lane >> 4;
    const bool lat = ch >= 4;
    if (tid < 256) { const int i = tid >> 2, r4 = (tid & 3) * 4; const int row = scan_row(b, dir, ch * 64 + i);
        *(LAS f32x4*)(alr + i * 16 + r4) = *(const f32x4*)(ALR + (size_t)row * 32 + dir * 16 + r4); }
    { v4u kr[8], qr[8];
#pragma unroll
      for (int q = 0; q < 8; ++q) { const int p = tid + 512 * q, i = p >> 6, c8 = (p & 63) * 8; const int row = scan_row(b, dir, ch * 64 + i);
          kr[q] = *(const v4u*)(Kb + (size_t)row * 512 + c8); if (lat) qr[q] = *(const v4u*)(Q + (size_t)row * 512 + c8); }
#pragma unroll
      for (int q = 0; q < 8; ++q) { const int p = tid + 512 * q, i = p >> 6, c8 = (p & 63) * 8; *(LAS v4u*)(Kt + i * TS + c8) = kr[q]; if (lat) *(LAS v4u*)(Qt + i * TS + c8) = qr[q]; } }
    const float* wa2 = dir ? a.in[13] : a.in[11]; const float bia = (dir ? a.in[14] : a.in[12])[col];
    float w[16];
#pragma unroll
    for (int r = 0; r < 16; ++r) w[r] = wa2[r * 512 + col];
    LDS_BARRIER();
    float Gv[64]; float Gc = 0.f;
#pragma unroll
    for (int i = 0; i < 64; ++i) { float z = bia;
#pragma unroll
        for (int r4 = 0; r4 < 4; ++r4) { const f32x4 x = *(const LAS f32x4*)(alr + i * 16 + 4 * r4); z += x[0] * w[4 * r4] + x[1] * w[4 * r4 + 1] + x[2] * w[4 * r4 + 2] + x[3] * w[4 * r4 + 3]; }
        Gc += (fminf(z, 0.f) - __logf(1.f + __expf(-fabsf(z)))) * (1.f / 16.f); Gv[i] = Gc; }
    const float Gmid = Gv[32], Gend = Gv[63];
    DEC[((size_t)(dir * 8 + b) * 36 + ch) * 512 + col] = __expf(Gend);
    bf16* kdrow = KD + ((((size_t)(dir * 8 + b) * 36 + ch) * 4 + h) * 128 + dk) * 64;
#pragma unroll
    for (int i0 = 0; i0 < 64; i0 += 8) { unsigned kd[8];
#pragma unroll
        for (int ii = 0; ii < 8; ++ii) { const int i = i0 + ii; const float kv = bf1(Kt[i * TS + col]);
            kd[ii] = f2bf(kv * __expf(Gend - Gv[i]));
            if (lat) { const float qv = bf1(Qt[i * TS + col]) * 0.08838834764831845f;
                Qt[i * TS + col] = (bf16)f2bf(qv * __expf(Gv[i] - Gmid)); Kt[i * TS + col] = (bf16)f2bf(kv * __expf(Gmid - Gv[i])); } }
        v4u o; o.x = kd[0] | (kd[1] << 16); o.y = kd[2] | (kd[3] << 16); o.z = kd[4] | (kd[5] << 16); o.w = kd[6] | (kd[7] << 16);
        *(v4u*)(kdrow + i0) = o; }
    if (lat) {
        LDS_BARRIER();
        const int hh = wave >> 1; bf16* amt = AM + ((((size_t)(dir * 8 + b) * 32 + (ch - 4)) * 4 + hh) * 64) * 64;
#pragma unroll
        for (int t2 = 0; t2 < 2; ++t2) { const int ti = (wave & 1) * 2 + t2; f32x4 c[4];
#pragma unroll
            for (int tj = 0; tj < 4; ++tj) c[tj] = (f32x4){0.f, 0.f, 0.f, 0.f};
#pragma unroll
            for (int ks = 0; ks < 4; ++ks) { const int ko = hh * 128 + 32 * ks + 8 * l4;
                const bf16x8 bq = *(const LAS bf16x8*)(Qt + (16 * ti + l15) * TS + ko);
#pragma unroll
                for (int tj = 0; tj < 4; ++tj) { const bf16x8 ak = *(const LAS bf16x8*)(Kt + (16 * tj + l15) * TS + ko);
                    c[tj] = __builtin_amdgcn_mfma_f32_16x16x32_bf16(ak, bq, c[tj], 0, 0, 0); } }
            const int i = 16 * ti + l15;
#pragma unroll
            for (int tj = 0; tj < 4; ++tj) { const int j0 = 16 * tj + 4 * l4;
                v2u p; p.x = pk2(j0 <= i ? c[tj][0] : 0.f, j0 + 1 <= i ? c[tj][1] : 0.f); p.y = pk2(j0 + 2 <= i ? c[tj][2] : 0.f, j0 + 3 <= i ? c[tj][3] : 0.f);
                *(v2u*)(amt + i * 64 + j0) = p; } }
        LDS_BARRIER();
        { const float eg = __expf(Gmid);
#pragma unroll 8
          for (int i = 0; i < 64; ++i) Qt[i * TS + col] = (bf16)f2bf(bf1(Qt[i * TS + col]) * eg); }
        LDS_BARRIER();
        { v4u* qgt = QG + ((((size_t)(dir * 8 + b) * 32 + (ch - 4)) * 4) * 1024);
#pragma unroll
          for (int q = 0; q < 8; ++q) { const int p = tid + 512 * q; const int hq = p >> 10, rem = p & 1023, i = rem >> 4, c16 = rem & 15;
              qgt[p] = *(const LAS v4u*)(Qt + i * TS + hq * 128 + c16 * 8); } }
    }
    LDS_BARRIER();
}
__device__ __forceinline__ void phase3_prep(const Args& a, LAS unsigned char* lds, int tid, int vcu, int G) {
    for (int item = vcu; item < 2 * 8 * 32; item += G) { const int lc = item & 31, b = (item >> 5) & 7, dir = item >> 8; prep_item(a, lds, tid, dir, b, 4 + lc); }
    for (int item = vcu; item < 2 * 8 * 4; item += G) { const int cc = item & 3, b = (item >> 2) & 7, dir = item >> 5; prep_item(a, lds, tid, dir, b, cc); }
}

struct ConvItem { const float* src; unsigned char* dst; int drow, k0, n0; };
__device__ __forceinline__ ConvItem conv_decode(const Args& a, int id) {
    id = id < 2 * I_E ? id : id - 2 * I_E * (id / (2 * I_E));
    const int up = id >= I_E ? 1 : 0; const int r = id - up * I_E; const int e = r / 512, rr = r % 512, kb = rr / 16, nb = rr % 16;
    ConvItem c; c.n0 = 32 * nb; c.k0 = 64 * kb;
    c.src = e < 64 ? a.in[21 + up] + (size_t)e * 2048 * 512 : a.in[24 + up];
    c.dst = a.ws + WS_WGU + (size_t)e * 1024 * 2048; c.drow = (c.n0 / 128) * 256 + up * 128 + (c.n0 % 128); return c;
}
__device__ __forceinline__ void conv_load(f32x4 (&t)[8], const ConvItem& c, int lane) {
#pragma unroll
    for (int i = 0; i < 8; ++i) t[i] = *(const f32x4*)(c.src + (size_t)(c.k0 + 8 * i + (lane >> 3)) * 512 + c.n0 + 4 * (lane & 7));
}
__device__ __forceinline__ void conv_finish(const f32x4 (&t)[8], const ConvItem& c, LAS float* scr, int lane) {
#pragma unroll
    for (int i = 0; i < 8; ++i) { LAS float* d = scr + (8 * i + (lane >> 3)) * 33 + 4 * (lane & 7); d[0] = t[i][0]; d[1] = t[i][1]; d[2] = t[i][2]; d[3] = t[i][3]; }
    LDS_WAIT(); asm volatile("" ::: "memory");
    const int cc = lane & 7;
#pragma unroll
    for (int j = 0; j < 4; ++j) { const int n = (lane >> 3) + 8 * j; const LAS float* sp = scr + (8 * cc) * 33 + n;
        v2u o; o.x = pk4_fp8(sp[0 * 33] * SC_W, sp[1 * 33] * SC_W, sp[2 * 33] * SC_W, sp[3 * 33] * SC_W); o.y = pk4_fp8(sp[4 * 33] * SC_W, sp[5 * 33] * SC_W, sp[6 * 33] * SC_W, sp[7 * 33] * SC_W);
        *(v2u*)(c.dst + (size_t)(c.drow + n) * 2048 + c.k0 + 8 * cc) = o; }
    LDS_WAIT(); asm volatile("" ::: "memory");
}
constexpr int GL_CONV = 73728;
constexpr int GL_QG = 0, GL_ST = 17408, GL_KDT = 34816, GL_VT = 53248, GL_AM = 62464, GL_DEC = 71680;
__device__ __forceinline__ void phase_chain(const Args& a, LAS unsigned char* lds, int tid, int lane, int wave, int vcu, int G) {
    unsigned char* ws = a.ws;
    const v4u* QG = (const v4u*)(ws + PQG); const v4u* AM = (const v4u*)(ws + PAM); const v4u* KD = (const v4u*)(ws + PKD); const float* DEC = (const float*)(ws + PDEC);
    const bf16* V = (const bf16*)(ws + RA_V); bf16* OF = (bf16*)(ws + RA_OF);
    const int l15 = lane & 15, l4 = lane >> 4;
    int cstep = 0;
    for (int item = vcu; item < 256; item += G) {
        const int vs = item & 3, dir = (item >> 2) & 1, h = (item >> 3) & 3, b = item >> 5;
        f32x4 S[4];
#pragma unroll
        for (int tv = 0; tv < 4; ++tv) S[tv] = (f32x4){0.f, 0.f, 0.f, 0.f};
        v4u rq[2], ra, rk[2], rv; float rdec = 0.f; f32x4 ct[8]; ConvItem ci;
#define GL_LOAD(ch_, LATL) do { const int ch__ = (ch_); \
            if (LATL) { const size_t t_ = ((((size_t)(dir * 8 + b) * 32 + (ch__ - 4)) * 4 + h) * 1024); rq[0] = QG[t_ + tid]; rq[1] = QG[t_ + tid + 512]; ra = AM[t_ / 2 + tid]; } \
            { const size_t t_ = ((((size_t)(dir * 8 + b) * 36 + ch__) * 4 + h) * 1024); rk[0] = KD[t_ + tid]; rk[1] = KD[t_ + tid + 512]; } \
            { const int row_ = scan_row(b, dir, ch__ * 64 + (tid >> 3)); rv = *(const v4u*)(V + (size_t)row_ * 1024 + h * 256 + vs * 64 + 8 * (tid & 7)); } \
            rdec = DEC[((size_t)(dir * 8 + b) * 36 + ch__) * 512 + h * 128 + (tid & 127)]; } while (0)
#define GL_STEP(ch_, LAT, LATN, MORE) do { const int ch = (ch_); \
              \
            _Pragma("unroll") for (int tv = 0; tv < 4; ++tv) { v2u p; p.x = pk2(S[tv][0], S[tv][1]); p.y = pk2(S[tv][2], S[tv][3]); \
                *(LAS v2u*)(lds + GL_ST + (16 * tv + l15) * 272 + (16 * wave + 4 * l4) * 2) = p; } \
            if (LAT) { _Pragma("unroll") for (int q = 0; q < 2; ++q) { const int p = tid + 512 * q; *(LAS v4u*)(lds + GL_QG + (p >> 4) * 272 + (p & 15) * 16) = rq[q]; } \
                *(LAS v4u*)(lds + GL_AM + (tid >> 3) * 144 + (tid & 7) * 16) = ra; } \
            _Pragma("unroll") for (int q = 0; q < 2; ++q) { const int p = tid + 512 * q; *(LAS v4u*)(lds + GL_KDT + (p >> 3) * 144 + (p & 7) * 16) = rk[q]; } \
            { const int i = tid >> 3, c = tid & 7; LAS bf16* vt = (LAS bf16*)(lds + GL_VT) + i; \
              vt[(8 * c + 0) * 72] = (bf16)(rv.x & 0xffffu); vt[(8 * c + 1) * 72] = (bf16)(rv.x >> 16); vt[(8 * c + 2) * 72] = (bf16)(rv.y & 0xffffu); vt[(8 * c + 3) * 72] = (bf16)(rv.y >> 16); \
              vt[(8 * c + 4) * 72] = (bf16)(rv.z & 0xffffu); vt[(8 * c + 5) * 72] = (bf16)(rv.z >> 16); vt[(8 * c + 6) * 72] = (bf16)(rv.w & 0xffffu); vt[(8 * c + 7) * 72] = (bf16)(rv.w >> 16); } \
            if (tid < 128) *(LAS float*)(lds + GL_DEC + tid * 4) = rdec; \
            LDS_BARRIER(); \
            if (MORE) GL_LOAD(ch + 1, LATN); \
            if (LAT) {   \
                const int ti = wave >> 1, tv0 = (wave & 1) * 2; f32x4 c0 = (f32x4){0.f, 0.f, 0.f, 0.f}, c1 = c0; bf16x8 fb[6], f0[6], f1[6]; \
                _Pragma("unroll") for (int ks = 0; ks < 4; ++ks) { const int ko = (32 * ks + 8 * l4) * 2; \
                    fb[ks] = *(const LAS bf16x8*)(lds + GL_QG + (16 * ti + l15) * 272 + ko); \
                    f0[ks] = *(const LAS bf16x8*)(lds + GL_ST + (16 * tv0 + l15) * 272 + ko); f1[ks] = *(const LAS bf16x8*)(lds + GL_ST + (16 * tv0 + 16 + l15) * 272 + ko); } \
                _Pragma("unroll") for (int ks = 0; ks < 2; ++ks) { const int ko = (32 * ks + 8 * l4) * 2; \
                    fb[4 + ks] = *(const LAS bf16x8*)(lds + GL_AM + (16 * ti + l15) * 144 + ko); \
                    f0[4 + ks] = *(const LAS bf16x8*)(lds + GL_VT + (16 * tv0 + l15) * 144 + ko); f1[4 + ks] = *(const LAS bf16x8*)(lds + GL_VT + (16 * tv0 + 16 + l15) * 144 + ko); } \
                _Pragma("unroll") for (int ks = 0; ks < 6; ++ks) { c0 = __builtin_amdgcn_mfma_f32_16x16x32_bf16(f0[ks], fb[ks], c0, 0, 0, 0); c1 = __builtin_amdgcn_mfma_f32_16x16x32_bf16(f1[ks], fb[ks], c1, 0, 0, 0); } \
                const int s_ = ch * 64 + 16 * ti + l15; const int t0 = s_ - 256; const int t = dir ? 2047 - t0 : t0; \
                bf16* orow = OF + ((size_t)dir * NT + b * 2048 + t) * 1024 + h * 256 + vs * 64 + 16 * tv0 + 4 * l4; \
                v2u p0, p1; p0.x = pk2(c0[0], c0[1]); p0.y = pk2(c0[2], c0[3]); p1.x = pk2(c1[0], c1[1]); p1.y = pk2(c1[2], c1[3]); \
                *(v2u*)(orow) = p0; *(v2u*)(orow + 16) = p1; } \
              \
            { const f32x4 d4 = *(const LAS f32x4*)(lds + GL_DEC + (16 * wave + 4 * l4) * 4); bf16x8 fk[2], fv[2][4]; \
              _Pragma("unroll") for (int ks = 0; ks < 2; ++ks) { const int ko = (32 * ks + 8 * l4) * 2; fk[ks] = *(const LAS bf16x8*)(lds + GL_KDT + (16 * wave + l15) * 144 + ko); \
                  _Pragma("unroll") for (int tv = 0; tv < 4; ++tv) fv[ks][tv] = *(const LAS bf16x8*)(lds + GL_VT + (16 * tv + l15) * 144 + ko); } \
              _Pragma("unroll") for (int tv = 0; tv < 4; ++tv) S[tv] = S[tv] * d4; \
              _Pragma("unroll") for (int ks = 0; ks < 2; ++ks) \
                  _Pragma("unroll") for (int tv = 0; tv < 4; ++tv) S[tv] = __builtin_amdgcn_mfma_f32_16x16x32_bf16(fk[ks], fv[ks][tv], S[tv], 0, 0, 0); } \
              \
            conv_finish(ct, ci, (LAS float*)(lds + GL_CONV + wave * 8448), lane); ++cstep; ci = conv_decode(a, cstep * (G * 8) + vcu * 8 + wave); conv_load(ct, ci, lane); \
            LDS_BARRIER(); } while (0)
        ci = conv_decode(a, cstep * (G * 8) + vcu * 8 + wave); conv_load(ct, ci, lane);
        GL_LOAD(0, false);
        GL_STEP(0, false, false, true); GL_STEP(1, false, false, true); GL_STEP(2, false, false, true); GL_STEP(3, false, true, true);
#pragma unroll 1
        for (int c2 = 4; c2 < 35; ++c2) { GL_STEP(c2, true, true, true); }
        GL_STEP(35, true, true, false);
#undef GL_STEP
#undef GL_LOAD
    }
    for (int id = cstep * (G * 8) + vcu * 8 + wave; id < 2 * I_E; id += G * 8) { const ConvItem c = conv_decode(a, id); f32x4 t[8]; conv_load(t, c, lane); conv_finish(t, c, (LAS float*)(lds + GL_CONV + wave * 8448), lane); }
}

template <int HALFW>
__device__ __forceinline__ void pool_item(const bf16* P, bf16* DP, LAS float* tmp, int tid, int b, int r, int g) {
    const int rlo = r - HALFW < 0 ? 0 : r - HALFW, rhi = r + HALFW > 32 ? 32 : r + HALFW;
    const float rinv = 1.f / (float)(rhi - rlo);
#pragma unroll 1
    for (int q = 0; q < 4; ++q) { const int p = tid + 512 * q, c = p >> 5, ch0 = (p & 31) * 8; float acc[8]; v4u x[2 * HALFW];
#pragma unroll
        for (int u = 0; u < 2 * HALFW; ++u) { const int rr = (rlo + u < rhi) ? rlo + u : rlo; x[u] = *(const v4u*)(P + ((size_t)(b * 2048 + rr * 64 + c)) * 1024 + g * 256 + ch0); }
#pragma unroll
        for (int j = 0; j < 8; ++j) acc[j] = 0.f;
#pragma unroll
        for (int u = 0; u < 2 * HALFW; ++u) { const float m = (rlo + u < rhi) ? 1.f : 0.f;
            acc[0] += m * bflo(x[u].x); acc[1] += m * bfhi(x[u].x); acc[2] += m * bflo(x[u].y); acc[3] += m * bfhi(x[u].y); acc[4] += m * bflo(x[u].z); acc[5] += m * bfhi(x[u].z); acc[6] += m * bflo(x[u].w); acc[7] += m * bfhi(x[u].w); }
        *(LAS f32x4*)(tmp + c * 256 + ch0) = (f32x4){acc[0] * rinv, acc[1] * rinv, acc[2] * rinv, acc[3] * rinv};
        *(LAS f32x4*)(tmp + c * 256 + ch0 + 4) = (f32x4){acc[4] * rinv, acc[5] * rinv, acc[6] * rinv, acc[7] * rinv}; }
    __syncthreads();
#pragma unroll 1
    for (int q = 0; q < 4; ++q) { const int p = tid + 512 * q, c = p >> 5, ch0 = (p & 31) * 8;
        const int clo = c - HALFW < 0 ? 0 : c - HALFW, chi = c + HALFW > 64 ? 64 : c + HALFW; const float cinv = 1.f / (float)(chi - clo);
        const size_t o = ((size_t)(b * 2048 + r * 64 + c)) * 1024 + g * 256 + ch0;
        const v4u x = *(const v4u*)(P + o);
        f32x4 a0 = (f32x4){0.f, 0.f, 0.f, 0.f}, a1 = a0;
#pragma unroll
        for (int u = 0; u < 2 * HALFW; ++u) { const int cc = (clo + u < chi) ? clo + u : clo; const float m = (clo + u < chi) ? 1.f : 0.f;
            a0 += *(const LAS f32x4*)(tmp + cc * 256 + ch0) * m; a1 += *(const LAS f32x4*)(tmp + cc * 256 + ch0 + 4) * m; }
        v4u d; d.x = pk2(a0[0] * cinv - bflo(x.x), a0[1] * cinv - bfhi(x.x)); d.y = pk2(a0[2] * cinv - bflo(x.y), a0[3] * cinv - bfhi(x.y));
        d.z = pk2(a1[0] * cinv - bflo(x.z), a1[1] * cinv - bfhi(x.z)); d.w = pk2(a1[2] * cinv - bflo(x.w), a1[3] * cinv - bfhi(x.w));
        *(v4u*)(DP + o) = d; }
    __syncthreads();
}
__device__ __forceinline__ void phase3_pool(const Args& a, LAS unsigned char* lds, int tid, int vcu, int G) {
    const bf16* P = (const bf16*)(a.ws + RA_P); bf16* DP = (bf16*)(a.ws + RA_DPOOL);
    LAS float* tmp = (LAS float*)lds;
    for (int item = vcu; item < 1024; item += G) {
        const int g = item >> 8, r = (item >> 3) & 31, b = item & 7;
        const int gg = 3 - g;
        if (gg == 0) pool_item<1>(P, DP, tmp, tid, b, r, gg); else if (gg == 1) pool_item<2>(P, DP, tmp, tid, b, r, gg); else if (gg == 2) pool_item<4>(P, DP, tmp, tid, b, r, gg); else pool_item<8>(P, DP, tmp, tid, b, r, gg);
    }
}

__device__ __forceinline__ void phase4_post(const Args& a, int lane, int wave, int vcu, int G) {
    const bf16* OF = (const bf16*)(a.ws + RA_OF); const bf16* OB = OF + (size_t)NT * 1024; const bf16* Rr = (const bf16*)(a.ws + RA_R); bf16* Y = (bf16*)(a.ws + RA_YMIX);
    const float* gn = a.in[15];
    f32x4 g4[4];
#pragma unroll
    for (int q = 0; q < 4; ++q) g4[q] = *(const f32x4*)(gn + 16 * lane + 4 * q);
#pragma unroll 2
    for (int t = vcu * 8 + wave; t < NT; t += G * 8) {
        const size_t o = (size_t)t * 1024 + 16 * lane;
        const v4u f0 = *(const v4u*)(OF + o), f1 = *(const v4u*)(OF + o + 8), b0 = *(const v4u*)(OB + o), b1 = *(const v4u*)(OB + o + 8), r0 = *(const v4u*)(Rr + o), r1 = *(const v4u*)(Rr + o + 8);
        float x[16], r[16];
#pragma unroll
        for (int w = 0; w < 4; ++w) { x[2 * w] = bflo(f0[w]) + bflo(b0[w]); x[2 * w + 1] = bfhi(f0[w]) + bfhi(b0[w]); x[8 + 2 * w] = bflo(f1[w]) + bflo(b1[w]); x[8 + 2 * w + 1] = bfhi(f1[w]) + bfhi(b1[w]);
            r[2 * w] = bflo(r0[w]); r[2 * w + 1] = bfhi(r0[w]); r[8 + 2 * w] = bflo(r1[w]); r[8 + 2 * w + 1] = bfhi(r1[w]); }
        float ss = 0.f;
#pragma unroll
        for (int q = 0; q < 16; ++q) ss += x[q] * x[q];
        ss += __shfl_xor(ss, 1); ss += __shfl_xor(ss, 2); ss += __shfl_xor(ss, 4); ss += __shfl_xor(ss, 8);
        const float sc = rsqrtf(ss * (1.f / 256.f) + EPS);
        float y[16];
#pragma unroll
        for (int q = 0; q < 16; ++q) y[q] = x[q] * sc * g4[q >> 2][q & 3] * silu_f(r[q]);
        v4u o0, o1;
#pragma unroll
        for (int w = 0; w < 4; ++w) { o0[w] = pk2(y[2 * w], y[2 * w + 1]); o1[w] = pk2(y[8 + 2 * w], y[8 + 2 * w + 1]); }
        bf16* yr = Y + (size_t)t * 2048 + 16 * lane;
        *(v4u*)(yr) = o0; *(v4u*)(yr + 8) = o1;
    }
}

__device__ __forceinline__ void phase6(const Args& a, LAS unsigned char* lds, int tid, int lane, int wave, int vcu, int G) {
    unsigned char* ws = a.ws;
    const float* mod = (const float*)(ws + WS_MOD); const bf16* Y1 = (const bf16*)(ws + RA_Y1); unsigned char* H2 = ws + RA_H2;
    const float* gpost = a.in[7]; const float* gpre2 = a.in[8]; const float* rbias = a.in[20];
    const bf16* whi = (const bf16*)(ws + WS_WRT);
    LAS float* part = (LAS float*)lds;
    LAS float* logit = (LAS float*)(lds + LDS_LOGIT);
    LAS u64* masks = (LAS u64*)(lds + LDS_MASKS);
    int* cnt = (int*)(ws + T_CNT); u64* tmask = (u64*)(ws + T_MASK); float* tokw = (float*)(ws + T_TOKW);
    const int l15 = lane & 15, l4 = lane >> 4;
    for (int blk = vcu; blk < NT / 64; blk += G) {
        for (int it = 0; it < 2; ++it) {
#pragma unroll 1
            for (int rep_ = 0; rep_ < P7_REP_ROWS; ++rep_) {
#pragma unroll 1
            for (int rr = 0; rr < 4; ++rr) {
                const int lr = wave * 4 + rr, t = blk * 64 + it * 32 + lr; const float* mr = mod + (size_t)(t >> 11) * 12288;
                const bf16* yr = Y1 + (size_t)t * 2048; const float* xr = a.in[0] + (size_t)t * 2048;
                f32x4 y[8]; float ss = 0.f;
#pragma unroll
                for (int j = 0; j < 8; ++j) { const v2u yb = *(const v2u*)(yr + 4 * (lane + 64 * j)); y[j] = (f32x4){bflo(yb.x), bfhi(yb.x), bflo(yb.y), bfhi(yb.y)}; ss += y[j][0] * y[j][0] + y[j][1] * y[j][1] + y[j][2] * y[j][2] + y[j][3] * y[j][3]; }
                const float rstd1 = rsqrtf(wave_sum(ss) * (1.f / 2048.f) + EPS);
                if (lane == 0) ((float*)(ws + T_RSTD1))[t] = rstd1;
                float s2 = 0.f;
#pragma unroll
                for (int j = 0; j < 8; ++j) { const int c = 4 * (lane + 64 * j); const f32x4 x = *(const f32x4*)(xr + c), gp = *(const f32x4*)(gpost + c), gt = *(const f32x4*)(mr + 4096 + c);
                    const f32x4 x1 = x + gt * (y[j] * rstd1 * gp); y[j] = x1;
                    s2 += x1[0] * x1[0] + x1[1] * x1[1] + x1[2] * x1[2] + x1[3] * x1[3]; }
                const float rstd2 = rsqrtf(wave_sum(s2) * (1.f / 2048.f) + EPS);
#pragma unroll
                for (int j = 0; j < 8; ++j) { const int c = 4 * (lane + 64 * j); const f32x4 g2 = *(const f32x4*)(gpre2 + c), sh = *(const f32x4*)(mr + 6144 + c), sc = *(const f32x4*)(mr + 8192 + c);
                    const f32x4 hh = y[j] * rstd2 * g2 * (sc + 1.f) + sh;
                    v2u qh; qh.x = pk2(hh[0], hh[1]); qh.y = pk2(hh[2], hh[3]);
                    *(LAS v2u*)(lds + RT_HI + lr * RT_ROWB + c * 2) = qh;
                    *(unsigned*)(H2 + (size_t)t * 2048 + c) = pk4_fp8(hh[0] * SC_H, hh[1] * SC_H, hh[2] * SC_H, hh[3] * SC_H); }
            }
            __syncthreads();
            }
            { f32x4 acc[2][4];
#pragma unroll
              for (int mt = 0; mt < 2; ++mt)
#pragma unroll
                  for (int et = 0; et < 4; ++et) acc[mt][et] = (f32x4){0.f, 0.f, 0.f, 0.f};
#pragma unroll 1
              for (int kh = 0; kh < 2; ++kh) {
                  bf16x8 bh[4][4];
#pragma unroll
                  for (int k4 = 0; k4 < 4; ++k4) { const int k0 = 256 * wave + 32 * (4 * kh + k4) + 8 * l4;
#pragma unroll
                      for (int et = 0; et < 4; ++et) bh[k4][et] = *(const bf16x8*)(whi + (size_t)(16 * et + l15) * 2048 + k0); }
#pragma unroll
                  for (int k4 = 0; k4 < 4; ++k4) { const int k0 = 256 * wave + 32 * (4 * kh + k4) + 8 * l4;
#pragma unroll
                      for (int mt = 0; mt < 2; ++mt) { const bf16x8 ah = *(const LAS bf16x8*)(lds + RT_HI + (16 * mt + l15) * RT_ROWB + k0 * 2);
#pragma unroll
                          for (int et = 0; et < 4; ++et) acc[mt][et] = __builtin_amdgcn_mfma_f32_16x16x32_bf16(ah, bh[k4][et], acc[mt][et], 0, 0, 0); } } }
              __syncthreads();
#pragma unroll
              for (int mt = 0; mt < 2; ++mt)
#pragma unroll
                  for (int et = 0; et < 4; ++et)
#pragma unroll
                      for (int q = 0; q < 4; ++q) part[(wave * 32 + 16 * mt + 4 * l4 + q) * 64 + 16 * et + l15] = acc[mt][et][q]; }
            __syncthreads();
#pragma unroll
            for (int q = 0; q < 4; ++q) { const int idx = tid + 512 * q; float sacc = 0.f;
#pragma unroll
                for (int w = 0; w < 8; ++w) sacc += part[w * 2048 + idx];
                logit[idx] = sacc; }
            __syncthreads();
#pragma unroll 1
            for (int rep_ = 0; rep_ < P7_REP_RT; ++rep_) {
#pragma unroll 1
            for (int rr = 0; rr < 4; ++rr) {
                const int lr = wave * 4 + rr, t = blk * 64 + it * 32 + lr;
                const float lg = logit[lr * 64 + lane]; const float s = 1.f / (1.f + __expf(-lg)); const float sel = s + rbias[lane];
                float m1 = sel; m1 = fmaxf(m1, __shfl_xor(m1, 1)); m1 = fmaxf(m1, __shfl_xor(m1, 2)); m1 = fmaxf(m1, __shfl_xor(m1, 4));
                const u64 eq = __ballot(sel == m1); const unsigned gb = (unsigned)(eq >> (lane & ~7)) & 0xffu; const int first = __builtin_ctz(gb);
                float v2 = ((lane & 7) == first) ? -INFINITY : sel; v2 = fmaxf(v2, __shfl_xor(v2, 1)); v2 = fmaxf(v2, __shfl_xor(v2, 2)); v2 = fmaxf(v2, __shfl_xor(v2, 4));
                const float gs = m1 + v2; const int g = lane >> 3; int grank = 0;
#pragma unroll
                for (int g2 = 0; g2 < 8; ++g2) { const float o = __builtin_bit_cast(float, __builtin_amdgcn_readlane(__builtin_bit_cast(int, gs), g2 * 8)); grank += (o > gs || (o == gs && g2 < g)) ? 1 : 0; }
                const bool gsel = grank < 4; const float mk = gsel ? sel : -INFINITY; int rank = 0;
#pragma unroll 8
                for (int e2 = 0; e2 < 64; ++e2) { const float o = __builtin_bit_cast(float, __builtin_amdgcn_readlane(__builtin_bit_cast(int, mk), e2)); rank += (o > mk || (o == mk && e2 < lane)) ? 1 : 0; }
                const bool chosen = gsel && rank < 8;
                const u64 mask = __ballot(chosen); const float ssum = wave_sum(chosen ? s : 0.f);
                const int kidx = __popcll(mask & ((1ull << lane) - 1ull));
                if (chosen) tokw[(size_t)t * 8 + kidx] = s / ssum * 2.5f;
                if (lane == 0) { tmask[t] = mask; masks[it * 32 + lr] = mask; }
            }
            __syncthreads();
            }
        }
        if (wave == 0) { const u64 m = masks[lane]; int mine = 0;
#pragma unroll 8
            for (int e = 0; e < 64; ++e) { const int c = __popcll(__ballot((m >> e) & 1ull)); mine = (lane == e) ? c : mine; }
            cnt[blk * 64 + lane] = mine; }
        __syncthreads();
    }
}

__device__ __forceinline__ void phase7(const Args& a, LAS unsigned char* lds, int tid, int lane, int wave, int vcu, int G) {
    unsigned char* ws = a.ws;
    const int* cnt = (const int*)(ws + T_CNT); const u64* tmask = (const u64*)(ws + T_MASK); const float* tokw = (const float*)(ws + T_TOKW);
    int* tokslot = (int*)(ws + T_TOKSLOT); int* slottok = (int*)(ws + T_SLOTTOK); float* slotw = (float*)(ws + T_SLOTW); int* tile = (int*)(ws + T_TILE);
    LAS int* part = (LAS int*)(lds + 131072);
    bool converted = false;
    for (int blk = vcu; blk < NT / 64; blk += G) {
        int pre = 0, all = 0;
#pragma unroll 8
        for (int b2 = wave; b2 < 256; b2 += 8) { const int c = cnt[b2 * 64 + lane]; all += c; pre += (b2 < blk) ? c : 0; }
        part[(wave * 2) * 64 + lane] = pre; part[(wave * 2 + 1) * 64 + lane] = all;
        LDS_BARRIER();
        if (wave == 0) {
            int p = 0, t = 0;
#pragma unroll
            for (int w = 0; w < 8; ++w) { p += part[(w * 2) * 64 + lane]; t += part[(w * 2 + 1) * 64 + lane]; }
            int incl = t;
#pragma unroll
            for (int o = 1; o < 64; o <<= 1) { const int v = __shfl_up(incl, o); if (lane >= o) incl += v; }
            const int start = incl - t; const int base = start + p;
            const int tokn = blk * 64 + lane; const u64 m = tmask[tokn];
#pragma unroll 8
            for (int e = 0; e < 64; ++e) { const bool bit = (m >> e) & 1ull; const u64 bal = __ballot(bit); const int be = __builtin_amdgcn_readlane(base, e);
                if (bit) { const int rank = __popcll(bal & ((1ull << lane) - 1ull)); const int slot = be + rank; const int k = __popcll(m & ((1ull << e) - 1ull));
                    slottok[slot] = tokn; slotw[slot] = tokw[(size_t)tokn * 8 + k]; tokslot[(size_t)tokn * 8 + k] = slot; } }
            slottok[SH_ROW0 + tokn] = tokn; slotw[SH_ROW0 + tokn] = 1.f;
            if (blk == 0) {
                const int nte = (t + 255) >> 8; int inc2 = nte;
#pragma unroll
                for (int o = 1; o < 64; o <<= 1) { const int v = __shfl_up(inc2, o); if (lane >= o) inc2 += v; }
                const int n0 = inc2 - nte; const int ntot = __builtin_amdgcn_readlane(inc2, 63);
                for (int j = 0; j < nte; ++j) { tile[n0 + j] = lane; tile[NTILE_MAX + n0 + j] = start + j * 256; tile[2 * NTILE_MAX + n0 + j] = (t - j * 256) < 256 ? (t - j * 256) : 256; }
                tile[ntot + lane] = 64; tile[NTILE_MAX + ntot + lane] = SH_ROW0 + lane * 256; tile[2 * NTILE_MAX + ntot + lane] = 256;
                if (lane == 0) tile[3 * NTILE_MAX] = ntot + 64;
            }
        } else if (!converted) {
            converted = true;
            convert_items(a, (LAS float*)(lds + wave * 16384), lane, NITEMS_P0 + vcu * 7 + (wave - 1), G * 7, NITEMS);
        }
        LDS_BARRIER();
    }
}

__device__ __forceinline__ void phase10(const Args& a, LAS unsigned char* lds, int lane, int wave, int vcu, int G) {
    unsigned char* ws = a.ws;
    const float* mod = (const float*)(ws + WS_MOD); const unsigned char* SO = ws + WS_SLOTOUT; const int* tokslot = (const int*)(ws + T_TOKSLOT); const float* gp = a.in[9];
    LAS float* ysc = (LAS float*)(lds + wave * 8192);
    const unsigned lo16_ = 16u * (unsigned)lane;
#pragma unroll 1
    for (int t = vcu * 8 + wave; t < NT; t += G * 8) {
        const float* mr = mod + (size_t)(t >> 11) * 12288;
        const int myslot = lane < 8 ? tokslot[(size_t)t * 8 + lane] : SH_ROW0 + t;
        unsigned lo16 = lo16_; asm volatile("" : "+v"(lo16));
        v4u x[9][2]; f32x4 xo[8]; v2u yb[8];
        const unsigned char* x1r = (const unsigned char*)(a.in[0] + (size_t)t * 2048); const unsigned char* y1r = (const unsigned char*)((const bf16*)(ws + RA_Y1) + (size_t)t * 2048);
        const float rstd1 = ((const float*)(ws + T_RSTD1))[t];
#pragma unroll
        for (int k = 0; k < 9; ++k) { const int slot = __builtin_amdgcn_readlane(myslot, k); const unsigned char* sr = SO + (size_t)slot * 2048;
#pragma unroll
            for (int j = 0; j < 2; ++j) x[k][j] = *(const v4u*)(sr + (lo16 + 1024u * j)); }
        float y[2][16];
#pragma unroll
        for (int j = 0; j < 2; ++j)
#pragma unroll
            for (int q = 0; q < 16; ++q) y[j][q] = 0.f;
#pragma unroll
        for (int k = 0; k < 9; ++k)
#pragma unroll
            for (int j = 0; j < 2; ++j) { v4u v = x[k][j]; asm volatile("" : "+v"(v) : "v"(y[j][0]), "v"(y[j][15]));
#pragma unroll
                for (int w = 0; w < 4; ++w) { const unsigned d = v[w]; const auto lo = __builtin_amdgcn_cvt_pk_f32_fp8(d, false), hi = __builtin_amdgcn_cvt_pk_f32_fp8(d, true);
                    y[j][4 * w] += lo[0]; y[j][4 * w + 1] += lo[1]; y[j][4 * w + 2] += hi[0]; y[j][4 * w + 3] += hi[1]; } }
        asm volatile("" ::: "memory");
#pragma unroll
        for (int j = 0; j < 8; ++j) { xo[j] = *(const f32x4*)(x1r + (lo16 + 1024u * j)); yb[j] = *(const v2u*)(y1r + (lo16 / 2u + 512u * j)); }
        float ss = 0.f;
#pragma unroll
        for (int j = 0; j < 2; ++j)
#pragma unroll
            for (int q = 0; q < 16; ++q) ss += y[j][q] * y[j][q];
        const float rstd = rsqrtf(wave_sum(ss) * (1.f / 2048.f) + EPS * SC_O * SC_O);
#pragma unroll
        for (int j = 0; j < 2; ++j)
#pragma unroll
            for (int q = 0; q < 4; ++q) *(LAS f32x4*)(ysc + 16 * (lane + 64 * j) + 4 * q) = (f32x4){y[j][4 * q], y[j][4 * q + 1], y[j][4 * q + 2], y[j][4 * q + 3]};
        LDS_WAIT(); asm volatile("" ::: "memory");
        unsigned char* outr = (unsigned char*)(a.out + (size_t)t * 2048); const unsigned char* gpb = (const unsigned char*)gp; const unsigned char* g1b = (const unsigned char*)a.in[7];
        const unsigned char* gt2b = (const unsigned char*)(mr + 10240); const unsigned char* gt1b = (const unsigned char*)(mr + 4096);
#pragma unroll
        for (int j = 0; j < 8; ++j) { const unsigned cb = lo16 + 1024u * j; const f32x4 yy = *(const LAS f32x4*)(ysc + 4 * (lane + 64 * j)), g = *(const f32x4*)(gpb + cb), gt = *(const f32x4*)(gt2b + cb);
            const f32x4 g1 = *(const f32x4*)(g1b + cb), gt1 = *(const f32x4*)(gt1b + cb); const f32x4 y1 = (f32x4){bflo(yb[j].x), bfhi(yb[j].x), bflo(yb[j].y), bfhi(yb[j].y)};
            const f32x4 x1 = xo[j] + gt1 * (y1 * rstd1 * g1);
            *(f32x4*)(outr + cb) = x1 + gt * (yy * rstd * g); }
        LDS_WAIT(); asm volatile("" ::: "memory");
    }
}

__global__ void __launch_bounds__(512, 2) fwd(Args args) {
    extern __shared__ __attribute__((aligned(16))) unsigned char lds_raw[];
    LAS unsigned char* lds = (LAS unsigned char*)lds_raw;
    const int tid = threadIdx.x, lane = tid & 63, wave = __builtin_amdgcn_readfirstlane(tid >> 6);
    const int G = gridDim.x, bx = blockIdx.x;
    const int vcu = (G % 8 == 0) ? (bx % 8) * (G / 8) + bx / 8 : bx;
    unsigned char* ws = args.ws;
    volatile LAS unsigned* MISC = (volatile LAS unsigned*)(lds + LDS_MISC);
    if (tid < 64) MISC[tid] = 0u;
    __syncthreads();
    const int lo = args.ph_lo, hi = args.ph_hi;
    XcdBarrier bar; bar.bar = (unsigned*)(ws + WS_CTL) + 4096; bar.x = 0; bar.st = nullptr;
    if (hi - lo > 1) bar = xcd_barrier_post((unsigned*)(ws + WS_CTL) + 4096, MISC + 8);
#ifndef PH_MASK
#define PH_MASK 0xfff
#endif
#define IN(k) (((PH_MASK >> (k)) & 1) && lo <= (k) && (k) < hi)
#define SEAM(k) do { if (IN(k) && IN((k) + 1)) xcd_barrier(bar); } while (0)

#ifndef REP_PHASE
#define REP_PHASE -1
#endif
#define PH_IDS int tz_ = threadIdx.x; asm volatile("" : "+v"(tz_)); const int tid = tz_, lane = tz_ & 63, wave = __builtin_amdgcn_readfirstlane(tz_ >> 6); (void)tid; (void)lane; (void)wave;
#define RUNPH(k, ...) do { if (IN(k)) { { PH_IDS __VA_ARGS__ } if (REP_PHASE == (k)) { xcd_barrier(bar); { PH_IDS __VA_ARGS__ } } SEAM(k); } } while (0)
#ifdef PROBE_P0
    if (IN(0)) { { PH_IDS phase0(args, lds, tid, lane, wave, vcu, G); } xcd_barrier(bar); { PH_IDS phase0(args, lds, tid, lane, wave, vcu, G, PROBE_P0 == 1, PROBE_P0 == 2); } SEAM(0); }
#else
    RUNPH(0, phase0(args, lds, tid, lane, wave, vcu, G););
#endif
    RUNPH(1, phase1(args, lane, wave, vcu, G););
    RUNPH(2, {
        DenseSched S; S.init(ws + RA_H, ws + WS_WIN, 2048, 2048, MROWS, DINP, G, bx);
        EpiIn E{ws};
        pg8::gemm_phase<EpiIn, DenseSched>(lds, 2048, S, E); });
#ifndef P3_REP_PREP
#define P3_REP_PREP 1
#endif
#ifndef P3_REP_POOL
#define P3_REP_POOL 1
#endif
    RUNPH(3, for (int r_ = 0; r_ < P3_REP_PREP; ++r_) phase3_prep(args, lds, tid, vcu, G); for (int r_ = 0; r_ < P3_REP_POOL; ++r_) phase3_pool(args, lds, tid, vcu, G););
    RUNPH(4, phase_chain(args, lds, tid, lane, wave, vcu, G););
    RUNPH(5, {
        phase4_post(args, lane, wave, vcu, G);
        PoolSched S{(const char*)(ws + RA_DPOOL), (const char*)(ws + WS_WPOOL), G, vcu};
        EpiPool E{(bf16*)(ws + RA_YMIX), args.in[17]};
        int kpool = 256; asm volatile("" : "+s"(kpool));
        pg8::gemm_phase<EpiPool, PoolSched>(lds, kpool, S, E); });
    RUNPH(6, {
        DenseSched S; S.init(ws + RA_YMIX, ws + WS_WOUT, 2048, 2048, NT, 2048, G, bx);
        EpiOut E{(bf16*)(ws + RA_Y1)};
        pg8::gemm_phase<EpiOut, DenseSched>(lds, 2048, S, E); });
    RUNPH(7, phase6(args, lds, tid, lane, wave, vcu, G););
    RUNPH(8, phase7(args, lds, tid, lane, wave, vcu, G););
    RUNPH(9, {
        MoeGUSched S{(const char*)(ws + RA_H2), (const char*)(ws + WS_WGU), (const int*)(ws + T_TILE), (const int*)(ws + T_SLOTTOK), G, vcu};
        EpiGU E{ws + WS_ACT, (const float*)(ws + T_SLOTW)};
        int kgu = 1024; asm volatile("" : "+s"(kgu));
        pg8::gemm_phase<EpiGU, MoeGUSched, true>(lds, kgu, S, E); });
    RUNPH(10, {
        MoeDownSched S{(const char*)(ws + WS_ACT), (const char*)(ws + WS_WD), (const int*)(ws + T_TILE), G, vcu};
        EpiDown E{ws + WS_SLOTOUT};
        int kdn = 256; asm volatile("" : "+s"(kdn));
        pg8::gemm_phase<EpiDown, MoeDownSched, true>(lds, kdn, S, E); });
    if (IN(11)) { { PH_IDS phase10(args, lds, lane, wave, vcu, G); } if (REP_PHASE == 11) { xcd_barrier(bar); { PH_IDS phase10(args, lds, lane, wave, vcu, G); } } }
#undef IN
#undef SEAM
}

extern "C" void kernel_launch(void* const* d_in, const int* in_sizes, int n_in, void* d_out, int out_size, void* d_ws, size_t ws_size, hipStream_t stream) {
    static int grid = 0;
    if (grid == 0) {
        if (n_in != 27 || out_size != NT * DM || ws_size < WS_NEED) { fprintf(stderr, "kernel_launch: unexpected problem: n_in %d out %d ws %zu (need %zu)\n", n_in, out_size, ws_size, (size_t)WS_NEED); grid = -1; return; }
        int dev = 0, cus = 0, per_cu = 0;
        if (hipGetDevice(&dev) != hipSuccess || hipDeviceGetAttribute(&cus, hipDeviceAttributeMultiprocessorCount, dev) != hipSuccess) { grid = -1; return; }
        if (hipFuncSetAttribute((const void*)fwd, hipFuncAttributeMaxDynamicSharedMemorySize, LDS_BYTES) != hipSuccess) { fprintf(stderr, "kernel_launch: hipFuncSetAttribute failed\n"); grid = -1; return; }
        if (hipOccupancyMaxActiveBlocksPerMultiprocessor(&per_cu, (const void*)fwd, 512, LDS_BYTES) != hipSuccess || per_cu < 1) { fprintf(stderr, "kernel_launch: occupancy query says %d\n", per_cu); }
        (void)hipGetLastError();
        grid = cus;
    }
    if (grid < 0) return;
    (void)hipMemsetAsync((char*)d_ws + WS_CTL, 0, CTL_ZERO_BYTES, stream);
    Args a{};
    for (int i = 0; i < 27; ++i) a.in[i] = (const float*)d_in[i];
    a.out = (float*)d_out; a.ws = (unsigned char*)d_ws;
    if (N_LAUNCHES == 1) {
        a.ph_lo = 0; a.ph_hi = NPH;
        hipLaunchKernelGGL(fwd, dim3(grid), dim3(512), LDS_BYTES, stream, a);
    } else {
        for (int p = 0; p < NPH; ++p) { a.ph_lo = p; a.ph_hi = p + 1; hipLaunchKernelGGL(fwd, dim3(grid), dim3(512), LDS_BYTES, stream, a); }
    }
}
```

```cpp
#include <hip/hip_runtime.h>
#include <cstdio>
#include <cstdint>

#ifndef P7_REP_ROWS
#define P7_REP_ROWS 1
#endif
#ifndef P7_REP_LOG
#define P7_REP_LOG 1
#endif
#ifndef P7_REP_RT
#define P7_REP_RT 1
#endif
#ifndef N_LAUNCHES
#define N_LAUNCHES 1
#endif

#define GAS __attribute__((address_space(1)))
#define LAS __attribute__((address_space(3)))
typedef unsigned short bf16;
typedef unsigned v4u __attribute__((ext_vector_type(4)));
typedef unsigned v2u __attribute__((ext_vector_type(2)));
typedef float f32x4 __attribute__((ext_vector_type(4)));
typedef short bf16x8 __attribute__((ext_vector_type(8)));
typedef unsigned long long u64;

constexpr int NB = 8, SEQ = 2048, DM = 2048, CTXL = 256;
constexpr int NT = NB * SEQ;
constexpr int NTC = NB * CTXL;
constexpr int MROWS = NT + NTC;
constexpr int DIN = 4128, DINP = 4352;
constexpr int NE = 64, TOPK = 8, DE = 512;
constexpr int NSLOT_E = NT * TOPK;
constexpr int SH_ROW0 = NSLOT_E + 256;
constexpr int NSLOT = SH_ROW0 + NT;
constexpr int NTILE_MAX = 704;
constexpr float EPS = 1e-6f;
constexpr int NPH = 12;

constexpr size_t MiB = 1u << 20;
constexpr size_t WS_CTL = 0, CTL_ZERO_BYTES = 64 * 1024;
constexpr size_t WS_MOD = 1 * MiB;
constexpr size_t WS_WRT = 1 * MiB + 512 * 1024;
constexpr size_t WS_WIN = 2 * MiB;
constexpr size_t WS_WOUT = WS_WIN + 17 * MiB;
constexpr size_t WS_WPOOL = WS_WOUT + 8 * MiB;
constexpr size_t WS_WD = WS_WPOOL + 1 * MiB;
constexpr size_t WS_WGU = WS_WD + 130 * MiB;
constexpr size_t WS_RA = WS_WGU + 260 * MiB;
constexpr size_t RA_H = WS_RA;
constexpr size_t RA_OF = WS_RA;
constexpr size_t RA_H2 = WS_RA;
constexpr size_t RA_Q = WS_RA + 128 * MiB;
constexpr size_t RA_K = RA_Q + 16 * MiB;
constexpr size_t RA_V = RA_K + 18 * MiB;
constexpr size_t RA_R = RA_V + 36 * MiB;
constexpr size_t RA_P = RA_R + 32 * MiB;
constexpr size_t RA_ALR = RA_P + 32 * MiB;
constexpr size_t RA_DPOOL = RA_ALR + 3 * MiB;
constexpr size_t RA_YMIX = RA_DPOOL + 32 * MiB;
constexpr size_t RA_Y1 = WS_RA + 128 * MiB;
constexpr size_t RA_X1 = WS_RA + 192 * MiB;
constexpr size_t RA_END = RA_YMIX + 64 * MiB;
constexpr size_t WS_SLOTOUT = WS_WGU;
constexpr size_t WS_ACT = RA_END > WS_SLOTOUT + 578 * MiB ? RA_END : WS_SLOTOUT + 578 * MiB;
constexpr size_t WS_END = WS_ACT + 145 * MiB;
constexpr size_t PQG = WS_ACT;
constexpr size_t PAM = WS_ACT + 32 * MiB;
constexpr size_t PKD = WS_ACT + 96 * MiB;
constexpr size_t PDEC = WS_ACT + 132 * MiB;
constexpr size_t WS_T0 = WS_END;
constexpr size_t T_CNT = WS_T0;
constexpr size_t T_MASK = T_CNT + 65536;
constexpr size_t T_TOKW = T_MASK + 131072;
constexpr size_t T_TOKSLOT = T_TOKW + 524288;
constexpr size_t T_SLOTTOK = T_TOKSLOT + 524288;
constexpr size_t T_SLOTW = T_SLOTTOK + 655360;
constexpr size_t T_TILE = T_SLOTW + 655360;
constexpr size_t WS_NEED = (T_TILE + 16384 + 4095) / 4096 * 4096;

constexpr int RING_BYTES = 131072;
constexpr int LDS_BYTES = 147456;
constexpr int LDS_MISC = LDS_BYTES - 256;
constexpr int RT_ROWB = 4112;
constexpr int RT_HI = 0;
constexpr int LDS_LOGIT = 32 * RT_ROWB;
constexpr int LDS_MASKS = LDS_LOGIT + 8192;
static_assert(LDS_MASKS + 512 <= LDS_MISC, "LDS map");

#define LDS_WAIT() asm volatile("s_waitcnt lgkmcnt(0)" ::: "memory")
#define LDS_BARRIER() do { asm volatile("s_waitcnt lgkmcnt(0)" ::: "memory"); __builtin_amdgcn_s_barrier(); asm volatile("" ::: "memory"); } while (0)
#define VM_WAIT() asm volatile("s_waitcnt vmcnt(0)" ::: "memory")

__device__ __forceinline__ unsigned f2bf(float f) { unsigned u = __builtin_bit_cast(unsigned, f); return (u + 0x7fffu + ((u >> 16) & 1u)) >> 16; }
__device__ __forceinline__ unsigned pk2(float lo, float hi) { return f2bf(lo) | (f2bf(hi) << 16); }
__device__ __forceinline__ float bflo(unsigned u) { return __builtin_bit_cast(float, u << 16); }
__device__ __forceinline__ float bfhi(unsigned u) { return __builtin_bit_cast(float, u & 0xffff0000u); }
__device__ __forceinline__ float bf1(bf16 b) { return __builtin_bit_cast(float, ((unsigned)b) << 16); }
__device__ __forceinline__ float wave_sum(float v) {
#pragma unroll
    for (int o = 1; o < 64; o <<= 1) v += __shfl_xor(v, o);
    return v;
}
__device__ __forceinline__ float silu_f(float x) { return x / (1.f + __expf(-x)); }

#define XB_TMO      128
#define XB_XCNT(j)  (256  + 64 * (j))
#define XB_XSUB(j)  (1280 + 64 * (j))
#define XB_XGEN(j)  (2304 + 64 * (j))
#define XB_TOP      3328
#define XB_TOPGEN   3392
#define XCD_BAR_WORDS 3456
#define XB_SPIN_CAP (1u << 18)

__device__ __forceinline__ unsigned xb_ld(unsigned* p)              { return __hip_atomic_load(p, __ATOMIC_RELAXED, __HIP_MEMORY_SCOPE_AGENT); }
__device__ __forceinline__ unsigned xb_add(unsigned* p, unsigned v) { return __hip_atomic_fetch_add(p, v, __ATOMIC_RELAXED, __HIP_MEMORY_SCOPE_AGENT); }
__device__ __forceinline__ unsigned xb_xcc_id() { return (unsigned)__builtin_amdgcn_s_getreg((3 << 11) | 20) & 0xFu; }
#define XB_SPIN(cond, bar) do { unsigned _sp = 0; while (cond) { __builtin_amdgcn_s_sleep(1); \
    if ((++_sp & 255u) == 0u) { if (xb_ld(&(bar)[XB_TMO])) break; if (_sp > XB_SPIN_CAP) { atomicAdd(&(bar)[XB_TMO], 1u); break; } } } } while (0)

struct XcdBarrier { unsigned* bar; unsigned x; volatile LAS unsigned* st; };

__device__ __forceinline__ XcdBarrier xcd_barrier_post(unsigned* bar, volatile LAS unsigned* st) {
    XcdBarrier b; b.bar = bar; b.x = xb_xcc_id(); b.st = st;
    if (threadIdx.x == 0) (void)xb_add(&bar[XB_XCNT(b.x)], 1u);
    return b;
}
__device__ __forceinline__ void xcd_barrier_complete(unsigned* bar, unsigned x, unsigned& nloc, unsigned& nx) {
    const unsigned G = gridDim.x * gridDim.y * gridDim.z;
    unsigned sum, cnt, mine, sp = 0u;
    for (;;) {
        sum = 0u; cnt = 0u; mine = 0u;
#pragma unroll
        for (unsigned j = 0; j < 16; ++j) { const unsigned c = xb_ld(&bar[XB_XCNT(j)]); sum += c; cnt += (c > 0u) ? 1u : 0u; mine = (j == x) ? c : mine; }
        if (sum == G) break;
        __builtin_amdgcn_s_sleep(1);
        if ((++sp & 255u) == 0u) { if (xb_ld(&bar[XB_TMO])) break; if (sp > XB_SPIN_CAP) { atomicAdd(&bar[XB_TMO], 1u); break; } }
    }
    nloc = mine > 0u ? mine : 1u; nx = cnt > 0u ? cnt : 1u;
}
__device__ __forceinline__ void xcd_barrier(const XcdBarrier& b) {
    asm volatile("s_waitcnt vmcnt(0)" ::: "memory");
    __syncthreads();
    if (threadIdx.x == 0) {
        unsigned* bar = b.bar;
        __builtin_amdgcn_s_waitcnt(0);
        unsigned nloc = b.st[0], nx = b.st[1];
        if (nloc == 0u) { xcd_barrier_complete(bar, b.x, nloc, nx); b.st[0] = nloc; b.st[1] = nx; }
        const unsigned old = xb_add(&bar[XB_XSUB(b.x)], 1u);
        const unsigned gen = old / nloc;
        if (old + 1u == (gen + 1u) * nloc) {
            __builtin_amdgcn_fence(__ATOMIC_RELEASE, "agent");
            asm volatile("s_waitcnt vmcnt(0)" ::: "memory");
            const unsigned og = xb_add(&bar[XB_TOP], 1u);
            const unsigned tg = og / nx;
            if (og + 1u == (tg + 1u) * nx) xb_add(&bar[XB_TOPGEN], 1u);
            else XB_SPIN(xb_ld(&bar[XB_TOPGEN]) == tg, bar);
            __builtin_amdgcn_fence(__ATOMIC_ACQUIRE, "agent");
            xb_add(&bar[XB_XGEN(b.x)], 1u);
            asm volatile("s_waitcnt vmcnt(0)" ::: "memory");
        } else {
            XB_SPIN(xb_ld(&bar[XB_XGEN(b.x)]) == gen, bar);
            __builtin_amdgcn_fence(__ATOMIC_ACQUIRE, "agent");
            asm volatile("s_waitcnt vmcnt(0)" ::: "memory");
        }
    }
    __syncthreads();
}

namespace pg8 {
constexpr int BM = 256, BK = 64, HALF = 128, HTB = HALF * BK * 2, STAGE_BYTES = 8 * HTB, NXCD = 8, WGM = 8;
__device__ __forceinline__ int lds_byte(int r, int c) { const int st = (r >> 4) * 2 + (c >> 5), rr = r & 15, cc = c & 31, ob = rr * 64 + cc * 2; return st * 1024 + (ob ^ (((ob >> 9) & 1) << 5)); }
__device__ __forceinline__ void stage_rc(int b, int& R, int& C) { const int st = b / 1024, sb = b % 1024, swz = sb ^ (((sb >> 9) & 1) << 5); R = (st >> 1) * 16 + swz / 64; C = (st & 1) * 32 + (swz % 64) / 2; }
__device__ __forceinline__ int perm32(int rho) { const int n = rho >> 4, i = rho & 15; return 8 * (i >> 2) + 4 * n + (i & 3); }
__device__ __forceinline__ unsigned cvt_pk_bf16(float lo, float hi) { unsigned r; asm volatile("v_cvt_pk_bf16_f32 %0, %1, %2" : "=v"(r) : "v"(lo), "v"(hi)); return r; }

typedef int v8i __attribute__((ext_vector_type(8)));
typedef int v4i __attribute__((ext_vector_type(4)));
template <class Epi, class Sched, bool FP8 = false>
__device__ __forceinline__ void gemm_phase(LAS unsigned char* lds, const int K, const Sched& S, const Epi& E) {
    typedef typename Sched::U Unit;
    const int tid = threadIdx.x, wid = __builtin_amdgcn_readfirstlane(tid >> 6), lane = tid & 63, wr = wid >> 2, wc = wid & 3, fr = lane & 15, fq = lane >> 4;
    const int nt = K / BK;
    int R[2], C[2]; unsigned voffB[2];
#pragma unroll
    for (int i = 0; i < 2; ++i) { stage_rc(tid * 16 + i * 8192, R[i], C[i]);
        const int Rb = Epi::PERMK == 2 ? (64 * (R[i] >> 5) + 16 * ((R[i] & 15) >> 2) + 4 * ((R[i] >> 4) & 1) + (R[i] & 3)) : (Epi::PERMK == 1 ? ((R[i] & ~31) + perm32(R[i] & 31)) : R[i]);
        voffB[i] = (unsigned)(Rb * K + C[i]) * 2u; }
    const size_t kstep = (size_t)(BK * 2);
    const size_t hstepB = (size_t)(Epi::PERMK == 2 ? 8 : HALF) * K * 2;
    const unsigned ldsw = (unsigned)wid * 1024u;
    const int aoff = lds_byte(wr * 64 + fr, fq * 8), boff = lds_byte(wc * 32 + fr, fq * 8);
#define PG8_SA(b, h) (((b) * 2 + (h)) * HTB)
#define PG8_SB(b, h) ((4 + (b) * 2 + (h)) * HTB)
#define PG8_STAGE(bufoff, gbase, v0, v1) do { \
        __builtin_amdgcn_global_load_lds((const unsigned*)((const char*)(gbase) + (v0)), (LAS unsigned*)(lds + (bufoff) + ldsw), 16, 0, 0); \
        __builtin_amdgcn_global_load_lds((const unsigned*)((const char*)(gbase) + (v1)), (LAS unsigned*)(lds + (bufoff) + ldsw + 8192), 16, 0, 0); } while (0)
#define PG8_LDA(dst, b, h) do { _Pragma("unroll") for (int m = 0; m < 4; ++m) { const v4i lo_ = *(const LAS v4i*)(lds + PG8_SA(b, h) + aoff + m * 2048), hi_ = *(const LAS v4i*)(lds + PG8_SA(b, h) + aoff + m * 2048 + 1024); \
        dst[m] = __builtin_shufflevector(lo_, hi_, 0, 1, 2, 3, 4, 5, 6, 7); } } while (0)
#define PG8_LDB(dst, b, h) do { _Pragma("unroll") for (int n = 0; n < 2; ++n) { const v4i lo_ = *(const LAS v4i*)(lds + PG8_SB(b, h) + boff + n * 2048), hi_ = *(const LAS v4i*)(lds + PG8_SB(b, h) + boff + n * 2048 + 1024); \
        dst[n] = __builtin_shufflevector(lo_, hi_, 0, 1, 2, 3, 4, 5, 6, 7); } } while (0)
#define PG8_H0(x) ((bf16x8)__builtin_shufflevector(x, x, 0, 1, 2, 3))
#define PG8_H1(x) ((bf16x8)__builtin_shufflevector(x, x, 4, 5, 6, 7))
#define PG8_MMA(ai, bj, At, Bt) do { __builtin_amdgcn_s_setprio(1); if constexpr (FP8) asm volatile("s_nop 4"); _Pragma("unroll") for (int m = 0; m < 4; ++m) _Pragma("unroll") for (int n = 0; n < 2; ++n) { \
        if constexpr (FP8) asm volatile("v_mfma_f32_16x16x128_f8f6f4 %0, %1, %2, %0" : "+v"(acc[ai][bj][m][n]) : "v"(Bt[n]), "v"(At[m])); \
        else { acc[ai][bj][m][n] = __builtin_amdgcn_mfma_f32_16x16x32_bf16(PG8_H0(Bt[n]), PG8_H0(At[m]), acc[ai][bj][m][n], 0, 0, 0); \
               acc[ai][bj][m][n] = __builtin_amdgcn_mfma_f32_16x16x32_bf16(PG8_H1(Bt[n]), PG8_H1(At[m]), acc[ai][bj][m][n], 0, 0, 0); } } \
        __builtin_amdgcn_s_setprio(0); } while (0)
#define PG8_WAIT_V(n) asm volatile("s_waitcnt vmcnt(" #n ")" ::: "memory")
#define PG8_WAIT_L(n) asm volatile("s_waitcnt lgkmcnt(" #n ")" ::: "memory")
#define PG8_BAR __builtin_amdgcn_s_barrier()
#define PG8_SCHED __builtin_amdgcn_sched_barrier(0)
    Unit cur, nxt; int ui = 0;
    if (!S.next(0, cur)) return;
    f32x4 acc[2][2][4][2];
#pragma unroll
    for (int a = 0; a < 2; ++a)
#pragma unroll
        for (int b = 0; b < 2; ++b)
#pragma unroll
            for (int m = 0; m < 4; ++m)
#pragma unroll
                for (int n = 0; n < 2; ++n) acc[a][b][m][n] = (f32x4){0.f, 0.f, 0.f, 0.f};
    v8i At[4], B0[2], B1[2];
    unsigned vA[4], vN[4];
    S.aoffs(cur, R, C, vA);
    const char* cA = cur.A; const char* cB = cur.B;
    PG8_STAGE(PG8_SB(0, 0), cB, voffB[0], voffB[1]); PG8_STAGE(PG8_SB(0, 1), cB + hstepB, voffB[0], voffB[1]); PG8_STAGE(PG8_SA(0, 0), cA, vA[0], vA[1]); PG8_STAGE(PG8_SA(0, 1), cA, vA[2], vA[3]);
    if (wr == 1) PG8_BAR;
    PG8_WAIT_V(2); PG8_BAR;
    PG8_STAGE(PG8_SB(1, 0), cB + kstep, voffB[0], voffB[1]); PG8_STAGE(PG8_SA(1, 0), cA + kstep, vA[0], vA[1]); PG8_STAGE(PG8_SB(1, 1), cB + hstepB + kstep, voffB[0], voffB[1]);
    PG8_WAIT_V(6); PG8_BAR;
    for (;;) {
        const bool has_next = S.next(ui + 1, nxt);
        const char* nA = has_next ? nxt.A : cA; const char* nB = has_next ? nxt.B : cB;
        if (has_next) S.aoffs(nxt, R, C, vN); else { vN[0] = vA[0]; vN[1] = vA[1]; vN[2] = vA[2]; vN[3] = vA[3]; }
        for (int t = 0; t < nt; t += 2) {
            const bool last = (t == nt - 2);
            const char* a1 = cA + (size_t)(t + 1) * kstep;
            const char* a2 = last ? nA : cA + (size_t)(t + 2) * kstep; const char* b2 = last ? nB : cB + (size_t)(t + 2) * kstep;
            const char* a3 = a2 + kstep; const char* b3 = b2 + kstep;
            const unsigned x0 = last ? vN[0] : vA[0], x1 = last ? vN[1] : vA[1], x2 = last ? vN[2] : vA[2], x3 = last ? vN[3] : vA[3];
            PG8_LDB(B0, 0, 0); PG8_LDB(B1, 0, 1); PG8_SCHED; PG8_LDA(At, 0, 0); PG8_STAGE(PG8_SA(1, 1), a1, vA[2], vA[3]);
            PG8_WAIT_V(8); PG8_WAIT_L(0); PG8_BAR; PG8_MMA(0, 0, At, B0); PG8_MMA(0, 1, At, B1); PG8_BAR; PG8_SCHED;
            PG8_LDA(At, 0, 1); PG8_STAGE(PG8_SB(0, 0), b2, voffB[0], voffB[1]); PG8_STAGE(PG8_SB(0, 1), b2 + hstepB, voffB[0], voffB[1]); PG8_STAGE(PG8_SA(0, 0), a2, x0, x1);
            PG8_WAIT_V(8); PG8_WAIT_L(0); PG8_BAR; PG8_MMA(1, 0, At, B0); PG8_MMA(1, 1, At, B1); PG8_BAR; PG8_SCHED;
            PG8_LDB(B0, 1, 0); PG8_LDB(B1, 1, 1); PG8_SCHED; PG8_LDA(At, 1, 0); PG8_STAGE(PG8_SA(0, 1), a2, x2, x3);
            PG8_WAIT_V(8); PG8_WAIT_L(0); PG8_BAR; PG8_MMA(0, 0, At, B0); PG8_MMA(0, 1, At, B1); PG8_BAR; PG8_SCHED;
            PG8_LDA(At, 1, 1); PG8_STAGE(PG8_SB(1, 0), b3, voffB[0], voffB[1]); PG8_STAGE(PG8_SB(1, 1), b3 + hstepB, voffB[0], voffB[1]); PG8_STAGE(PG8_SA(1, 0), a3, x0, x1);
            PG8_WAIT_V(8); PG8_WAIT_L(0); PG8_BAR; PG8_MMA(1, 0, At, B0); PG8_MMA(1, 1, At, B1); PG8_BAR; PG8_SCHED;
        }
        if (wr == 0) PG8_BAR;
        if constexpr (FP8) asm volatile("s_nop 15\n\ts_nop 15");
        { int tz = threadIdx.x; asm volatile("" : "+v"(tz));
          const int wid_ = tz >> 6, lane_ = tz & 63; E(acc, cur, wid_ >> 2, wid_ & 3, lane_ & 15, lane_ >> 4);
#ifdef PROBE_EPI2
          if constexpr (Epi::PROBE2) { asm volatile("" : "+v"(tz)); const int w2 = tz >> 6, l2 = tz & 63; E(acc, cur, w2 >> 2, w2 & 3, l2 & 15, l2 >> 4); }
#endif
#ifdef PROBE_DRAIN
          if constexpr (Epi::PROBE2) { asm volatile("s_waitcnt vmcnt(0)" ::: "memory"); }
#endif
        }
        if (!has_next) break;
#pragma unroll
        for (int a = 0; a < 2; ++a)
#pragma unroll
            for (int b = 0; b < 2; ++b)
#pragma unroll
                for (int m = 0; m < 4; ++m)
#pragma unroll
                    for (int n = 0; n < 2; ++n) acc[a][b][m][n] = (f32x4){0.f, 0.f, 0.f, 0.f};
        cur = nxt; cA = nA; cB = nB; ++ui;
        vA[0] = vN[0]; vA[1] = vN[1]; vA[2] = vN[2]; vA[3] = vN[3];
        if (wr == 1) PG8_BAR;
    }
    PG8_WAIT_V(0);
    PG8_BAR;
#undef PG8_SA
#undef PG8_SB
#undef PG8_STAGE
#undef PG8_LDA
#undef PG8_LDB
#undef PG8_H0
#undef PG8_H1
#undef PG8_MMA
#undef PG8_WAIT_V
#undef PG8_WAIT_L
#undef PG8_BAR
#undef PG8_SCHED
}
}

struct Args { const float* in[27]; float* out; unsigned char* ws; int ph_lo, ph_hi; };
static_assert(sizeof(Args) == 27 * 8 + 8 + 8 + 8, "Args has no padding");

struct DenseU { const char* A; const char* B; int pm, pn; };
struct DenseSched {
    typedef DenseU U;
    const char* A; const char* B; int lda, K, nM, nN, nwg, G, c;
    __device__ __forceinline__ void init(const void* A_, const void* B_, int lda_, int K_, int M, int N, int G_, int c_) { A = (const char*)A_; B = (const char*)B_; lda = lda_; K = K_; nM = M / 256; nN = N / 256; nwg = nM * nN; G = G_; c = c_; }
    __device__ __forceinline__ bool next(int i, U& u) const {
        const long L = (long)i * G + c; if (L >= nwg) return false;
        int wgid = (int)L; { const int q = nwg / 8, r = nwg % 8, xcd = wgid % 8, off = wgid / 8; wgid = (xcd < r ? xcd * (q + 1) : r * (q + 1) + (xcd - r) * q) + off; }
        const int nig = 8 * nN, gid = wgid / nig, fm = gid * 8, gsz = (nM - fm) < 8 ? (nM - fm) : 8;
        u.pm = fm + ((wgid % nig) % gsz); u.pn = (wgid % nig) / gsz;
        u.A = A + (size_t)u.pm * 256 * lda * 2; u.B = B + (size_t)u.pn * 256 * K * 2; return true;
    }
    __device__ __forceinline__ void aoffs(const U&, const int (&R)[2], const int (&C)[2], unsigned (&v)[4]) const {
#pragma unroll
        for (int h = 0; h < 2; ++h)
#pragma unroll
            for (int i = 0; i < 2; ++i) v[h * 2 + i] = (unsigned)((h * 128 + R[i]) * lda + C[i]) * 2u;
    }
};
struct InSched {
    typedef DenseU U;
    DenseSched D;
    static constexpr int NLAT = 64 * 17, NCTX = 8 * 7;
    __device__ __forceinline__ bool next(int i, U& u) const {
        const int L = i * D.G + D.c;
        if (L < NLAT) return D.next(i, u);
        const int j = L - NLAT; if (j >= NCTX) return false;
        const int q = j % 7; u.pm = 64 + j / 7; u.pn = q < 6 ? q + 2 : 16;
        u.A = D.A + (size_t)u.pm * 256 * D.lda * 2; u.B = D.B + (size_t)u.pn * 256 * D.K * 2; return true;
    }
    __device__ __forceinline__ void aoffs(const U& u, const int (&R)[2], const int (&C)[2], unsigned (&v)[4]) const { D.aoffs(u, R, C, v); }
};
struct PoolU { const char* A; const char* B; int pm, g; };
struct PoolSched {
    typedef PoolU U;
    const char* A; const char* B; int G, c;
    __device__ __forceinline__ bool next(int i, U& u) const {
        const int L = i * G + c; if (L >= 256) return false;
        u.g = L & 3; u.pm = L >> 2;
        u.A = A + ((size_t)u.pm * 256 * 1024 + u.g * 256) * 2; u.B = B + (size_t)u.g * 256 * 256 * 2; return true;
    }
    __device__ __forceinline__ void aoffs(const U&, const int (&R)[2], const int (&C)[2], unsigned (&v)[4]) const {
#pragma unroll
        for (int h = 0; h < 2; ++h)
#pragma unroll
            for (int i = 0; i < 2; ++i) v[h * 2 + i] = (unsigned)((h * 128 + R[i]) * 1024 + C[i]) * 2u;
    }
};
struct MoeU { const char* A; const char* B; int row0, nrows, pn; };
struct MoeGUSched {
    typedef MoeU U;
    const char* H2; const char* W; const int* tile; const int* slot_tok; int G, c;
    __device__ __forceinline__ bool next(int i, U& u) const {
        const int nt = tile[3 * NTILE_MAX]; const int L = i * G + c; if (L >= nt * 4) return false;
        const int t = L >> 2; u.pn = L & 3; const int e = tile[t]; u.row0 = tile[NTILE_MAX + t]; u.nrows = tile[2 * NTILE_MAX + t];
        u.A = H2; u.B = W + ((size_t)e * 1024 + u.pn * 256) * 2048; return true;
    }
    __device__ __forceinline__ void aoffs(const U& u, const int (&R)[2], const int (&C)[2], unsigned (&v)[4]) const {
#pragma unroll
        for (int h = 0; h < 2; ++h)
#pragma unroll
            for (int i = 0; i < 2; ++i) { int r = h * 128 + R[i]; r = r < u.nrows ? r : u.nrows - 1; const int tok = slot_tok[u.row0 + r]; v[h * 2 + i] = (unsigned)(tok * 1024 + C[i]) * 2u; }
    }
};
struct MoeDownSched {
    typedef MoeU U;
    const char* ACT; const char* W; const int* tile; int G, c;
    __device__ __forceinline__ bool next(int i, U& u) const {
        const int nt = tile[3 * NTILE_MAX]; const int L = i * G + c; if (L >= nt * 8) return false;
        const int t = L >> 3; u.pn = L & 7; const int e = tile[t]; u.row0 = tile[NTILE_MAX + t]; u.nrows = tile[2 * NTILE_MAX + t];
        u.A = ACT + (size_t)u.row0 * 512; u.B = W + ((size_t)e * 2048 + u.pn * 256) * 512; return true;
    }
    __device__ __forceinline__ void aoffs(const U&, const int (&R)[2], const int (&C)[2], unsigned (&v)[4]) const {
#pragma unroll
        for (int h = 0; h < 2; ++h)
#pragma unroll
            for (int i = 0; i < 2; ++i) v[h * 2 + i] = (unsigned)((h * 128 + R[i]) * 256 + C[i]) * 2u;
    }
};

constexpr float SC_W = 256.f, SC_H = 16.f, SC_A = 16.f, SC_Y = 8.f;
__device__ __forceinline__ unsigned pk4_fp8(float a, float b, float c, float d) {
    a = fminf(fmaxf(a, -448.f), 448.f); b = fminf(fmaxf(b, -448.f), 448.f); c = fminf(fmaxf(c, -448.f), 448.f); d = fminf(fmaxf(d, -448.f), 448.f);
    unsigned w = 0; w = __builtin_amdgcn_cvt_pk_fp8_f32(a, b, w, false); w = __builtin_amdgcn_cvt_pk_fp8_f32(c, d, w, true); return w;
}
struct EpiIn {
    static constexpr int PERMK = 1; static constexpr bool PROBE2 = false;
    unsigned char* ws;
    __device__ __forceinline__ void operator()(const f32x4 (&acc)[2][2][4][2], const DenseU& u, int wr, int wc, int fr, int fq) const {
        const int pn = u.pn; const int row0 = u.pm * 256 + wr * 64 + fr;
        if (pn == 16) {
            if (wc != 0) return;
            float* alr = (float*)(ws + RA_ALR);
#pragma unroll
            for (int ai = 0; ai < 2; ++ai)
#pragma unroll
                for (int m = 0; m < 4; ++m) { float* rp = alr + (size_t)(row0 + ai * 128 + m * 16) * 32 + 8 * fq;
                    *(f32x4*)(rp) = acc[ai][0][m][0]; *(f32x4*)(rp + 4) = acc[ai][0][m][1]; }
            return;
        }
        bf16* base; int ld, colt; bool lat_only;
        if (pn < 2) { base = (bf16*)(ws + RA_Q); ld = 512; colt = pn * 256; lat_only = true; }
        else if (pn < 4) { base = (bf16*)(ws + RA_K); ld = 512; colt = (pn - 2) * 256; lat_only = false; }
        else if (pn < 8) { base = (bf16*)(ws + RA_V); ld = 1024; colt = (pn - 4) * 256; lat_only = false; }
        else if (pn < 12) { base = (bf16*)(ws + RA_R); ld = 1024; colt = (pn - 8) * 256; lat_only = true; }
        else { base = (bf16*)(ws + RA_P); ld = 1024; colt = (pn - 12) * 256; lat_only = true; }
        if (lat_only && u.pm >= 64) return;
        const int col0 = colt + wc * 32 + 8 * fq;
#pragma unroll
        for (int ai = 0; ai < 2; ++ai)
#pragma unroll
            for (int m = 0; m < 4; ++m) { bf16* rp = base + (size_t)(row0 + ai * 128 + m * 16) * ld + col0;
#pragma unroll
                for (int bj = 0; bj < 2; ++bj) { const f32x4 v0 = acc[ai][bj][m][0], v1 = acc[ai][bj][m][1];
                    v4u o; o.x = pg8::cvt_pk_bf16(v0[0], v0[1]); o.y = pg8::cvt_pk_bf16(v0[2], v0[3]); o.z = pg8::cvt_pk_bf16(v1[0], v1[1]); o.w = pg8::cvt_pk_bf16(v1[2], v1[3]);
                    *(v4u*)(rp + bj * 128) = o; } }
    }
};
struct EpiPool {
    static constexpr int PERMK = 1; static constexpr bool PROBE2 = false;
    unsigned char* ymix; const float* scale;
    __device__ __forceinline__ void operator()(const f32x4 (&acc)[2][2][4][2], const PoolU& u, int wr, int wc, int fr, int fq) const {
        const int row0 = u.pm * 256 + wr * 64 + fr; const int c0 = u.g * 256 + wc * 32 + 8 * fq;
#pragma unroll
        for (int ai = 0; ai < 2; ++ai)
#pragma unroll
            for (int m = 0; m < 4; ++m) { unsigned char* rp = ymix + (size_t)(row0 + ai * 128 + m * 16) * 2048 + 1024 + c0;
#pragma unroll
                for (int bj = 0; bj < 2; ++bj) { const f32x4 s0 = *(const f32x4*)(scale + c0 + bj * 128) * SC_Y, s1 = *(const f32x4*)(scale + c0 + bj * 128 + 4) * SC_Y;
                    const f32x4 v0 = acc[ai][bj][m][0] * s0, v1 = acc[ai][bj][m][1] * s1;
                    v2u o; o.x = pk4_fp8(v0[0], v0[1], v0[2], v0[3]); o.y = pk4_fp8(v1[0], v1[1], v1[2], v1[3]);
                    *(v2u*)(rp + bj * 128) = o; } }
    }
};
struct EpiOut {
    static constexpr int PERMK = 1; static constexpr bool PROBE2 = false;
    bf16* y;
    __device__ __forceinline__ void operator()(const f32x4 (&acc)[2][2][4][2], const DenseU& u, int wr, int wc, int fr, int fq) const {
        const int row0 = u.pm * 256 + wr * 64 + fr, col0 = u.pn * 256 + wc * 32 + 8 * fq;
#pragma unroll
        for (int ai = 0; ai < 2; ++ai)
#pragma unroll
            for (int m = 0; m < 4; ++m) { bf16* rp = y + (size_t)(row0 + ai * 128 + m * 16) * 2048 + col0;
#pragma unroll
                for (int bj = 0; bj < 2; ++bj) { constexpr float inv = 1.f / (SC_W * SC_Y); const f32x4 v0 = acc[ai][bj][m][0] * inv, v1 = acc[ai][bj][m][1] * inv;
                    v4u o; o.x = pg8::cvt_pk_bf16(v0[0], v0[1]); o.y = pg8::cvt_pk_bf16(v0[2], v0[3]); o.z = pg8::cvt_pk_bf16(v1[0], v1[1]); o.w = pg8::cvt_pk_bf16(v1[2], v1[3]);
                    *(v4u*)(rp + bj * 128) = o; } }
    }
};
struct EpiGU {
    static constexpr int PERMK = 1; static constexpr bool PROBE2 = false;
    unsigned char* act; const float* slot_w;
    __device__ __forceinline__ void operator()(const f32x4 (&acc)[2][2][4][2], const MoeU& u, int wr, int wc, int fr, int fq) const {
        const int c0 = u.pn * 128 + wc * 32 + 8 * fq; constexpr float inv = 1.f / (SC_W * SC_H);
#pragma unroll
        for (int ai = 0; ai < 2; ++ai)
#pragma unroll
            for (int m = 0; m < 4; ++m) { const int r = ai * 128 + wr * 64 + m * 16 + fr;
                if (r < u.nrows) { const float w = slot_w[u.row0 + r] * SC_A; float o[8];
#pragma unroll
                    for (int n = 0; n < 2; ++n)
#pragma unroll
                        for (int j = 0; j < 4; ++j) { const float g = acc[ai][0][m][n][j] * inv, up = acc[ai][1][m][n][j] * inv; o[n * 4 + j] = silu_f(g) * up * w; }
                    v2u q; q.x = pk4_fp8(o[0], o[1], o[2], o[3]); q.y = pk4_fp8(o[4], o[5], o[6], o[7]);
                    *(v2u*)(act + (size_t)(u.row0 + r) * 512 + c0) = q; } }
    }
};
constexpr float SC_O = 32.f;
struct EpiDown {
    static constexpr int PERMK = 2; static constexpr bool PROBE2 = true;
    unsigned char* so;
    __device__ __forceinline__ void operator()(const f32x4 (&acc)[2][2][4][2], const MoeU& u, int wr, int wc, int fr, int fq) const {
        const int c0 = u.pn * 256 + wc * 64 + 16 * fq; constexpr float sc = SC_O / (SC_W * SC_A);
#pragma unroll
        for (int ai = 0; ai < 2; ++ai)
#pragma unroll
            for (int m = 0; m < 4; ++m) { const int r = ai * 128 + wr * 64 + m * 16 + fr;
                if (r < u.nrows) { const f32x4 a0 = acc[ai][0][m][0] * sc, a1 = acc[ai][0][m][1] * sc, b0 = acc[ai][1][m][0] * sc, b1 = acc[ai][1][m][1] * sc;
                    v4u o; o.x = pk4_fp8(a0[0], a0[1], a0[2], a0[3]); o.y = pk4_fp8(a1[0], a1[1], a1[2], a1[3]); o.z = pk4_fp8(b0[0], b0[1], b0[2], b0[3]); o.w = pk4_fp8(b1[0], b1[1], b1[2], b1[3]);
                    __builtin_nontemporal_store(o, (v4u*)(so + (size_t)(u.row0 + r) * 2048 + c0)); } }
    }
};

__device__ __forceinline__ void tr_item(const float* W, int ldn, bf16* WT, int Kd, int drow0, int k0, int n0, LAS float* scr, int lane) {
    f32x4 t[8];
#pragma unroll
    for (int i = 0; i < 8; ++i) t[i] = __builtin_nontemporal_load((const f32x4*)(W + (size_t)(k0 + 8 * i + (lane >> 3)) * ldn + n0 + 4 * (lane & 7)));
#pragma unroll
    for (int i = 0; i < 8; ++i) { LAS float* d = scr + (8 * i + (lane >> 3)) * 33 + 4 * (lane & 7); d[0] = t[i][0]; d[1] = t[i][1]; d[2] = t[i][2]; d[3] = t[i][3]; }
    LDS_WAIT(); asm volatile("" ::: "memory");
    const int c = lane & 7;
#pragma unroll
    for (int j = 0; j < 4; ++j) { const int n = (lane >> 3) + 8 * j; const LAS float* s = scr + (8 * c) * 33 + n;
        v4u o; o.x = pk2(s[0 * 33], s[1 * 33]); o.y = pk2(s[2 * 33], s[3 * 33]); o.z = pk2(s[4 * 33], s[5 * 33]); o.w = pk2(s[6 * 33], s[7 * 33]);
        *(v4u*)(WT + (size_t)(drow0 + n) * Kd + k0 + 8 * c) = o; }
    LDS_WAIT(); asm volatile("" ::: "memory");
}

__device__ __forceinline__ void tr_item8(const float* W, int ldn, unsigned char* WT, int Kd, int drow0, int k0, int n0, LAS float* scr, int lane) {
    f32x4 t[8];
#pragma unroll
    for (int i = 0; i < 8; ++i) t[i] = __builtin_nontemporal_load((const f32x4*)(W + (size_t)(k0 + 8 * i + (lane >> 3)) * ldn + n0 + 4 * (lane & 7)));
#pragma unroll
    for (int i = 0; i < 8; ++i) { LAS float* d = scr + (8 * i + (lane >> 3)) * 33 + 4 * (lane & 7); d[0] = t[i][0]; d[1] = t[i][1]; d[2] = t[i][2]; d[3] = t[i][3]; }
    LDS_WAIT(); asm volatile("" ::: "memory");
    const int c = lane & 7;
#pragma unroll
    for (int j = 0; j < 4; ++j) { const int n = (lane >> 3) + 8 * j; const LAS float* s = scr + (8 * c) * 33 + n;
        v2u o; o.x = pk4_fp8(s[0 * 33] * SC_W, s[1 * 33] * SC_W, s[2 * 33] * SC_W, s[3 * 33] * SC_W); o.y = pk4_fp8(s[4 * 33] * SC_W, s[5 * 33] * SC_W, s[6 * 33] * SC_W, s[7 * 33] * SC_W);
        *(v2u*)(WT + (size_t)(drow0 + n) * Kd + k0 + 8 * c) = o; }
    LDS_WAIT(); asm volatile("" ::: "memory");
}

constexpr int I_IN = 32 * 129, I_OUT = 32 * 64, I_POOL = 4 * 4 * 8, I_E = 65 * 512;
constexpr int NITEMS = I_IN + I_OUT + I_POOL + 3 * I_E;
#ifndef N_DOWN_EARLY_
#define N_DOWN_EARLY_ 16384
#endif
constexpr int N_DOWN_EARLY = N_DOWN_EARLY_;
constexpr int NITEMS_P0 = NITEMS - 33280;
__device__ __forceinline__ void convert_items(const Args& a, LAS float* scr, int lane, int first, int step, int end, int skip = 0) {
    unsigned char* ws = a.ws;
    bf16* Win_t = (bf16*)(ws + WS_WIN); unsigned char* Wout_t = ws + WS_WOUT; bf16* Wpool_t = (bf16*)(ws + WS_WPOOL); unsigned char* Wd_t = ws + WS_WD; unsigned char* Wgu_t = ws + WS_WGU;
    for (int it = first; it < end; it += step) {
        int r = it < I_IN + I_OUT + I_POOL ? it : it + skip;
        if (r < I_IN) { const int kb = r / 129, nb = r % 129, n0 = 32 * nb; const int drow = n0 < 3072 ? n0 : (n0 == 3072 ? 4096 : n0 - 32);
            tr_item(a.in[10], DIN, Win_t, 2048, drow, 64 * kb, n0, scr, lane); continue; } r -= I_IN;
        if (r < I_OUT) { const int kb = r / 64, nb = r % 64; tr_item8(a.in[18], 2048, Wout_t, 2048, 32 * nb, 64 * kb, 32 * nb, scr, lane); continue; } r -= I_OUT;
        if (r < I_POOL) { const int g = r / 32, rr = r % 32, kb = rr / 8, nb = rr % 8; tr_item(a.in[16] + g * 65536, 256, Wpool_t + g * 65536, 256, 32 * nb, 64 * kb, 32 * nb, scr, lane); continue; } r -= I_POOL;
        if (r < I_E) { const int e = r / 512, rr = r % 512, kb = rr / 16, nb = rr % 16, n0 = 32 * nb; const float* src = e < 64 ? a.in[21] + (size_t)e * 2048 * 512 : a.in[24];
            tr_item8(src, 512, Wgu_t + (size_t)e * 1024 * 2048, 2048, (n0 / 128) * 256 + (n0 % 128), 64 * kb, n0, scr, lane); continue; } r -= I_E;
        if (r < I_E) { const int e = r / 512, rr = r % 512, kb = rr / 16, nb = rr % 16, n0 = 32 * nb; const float* src = e < 64 ? a.in[22] + (size_t)e * 2048 * 512 : a.in[25];
            tr_item8(src, 512, Wgu_t + (size_t)e * 1024 * 2048, 2048, (n0 / 128) * 256 + 128 + (n0 % 128), 64 * kb, n0, scr, lane); continue; } r -= I_E;
        { const int e = 64 - r / 512, rr = r % 512, kb = rr / 64, nb = rr % 64; const float* src = e < 64 ? a.in[23] + (size_t)e * 512 * 2048 : a.in[26];
            tr_item8(src, 2048, Wd_t + (size_t)e * 2048 * 512, 512, 32 * nb, 64 * kb, 32 * nb, scr, lane); }
    }
}

__device__ __forceinline__ void phase0(const Args& a, LAS unsigned char* lds, int tid, int lane, int wave, int vcu, int G, bool do_mod = true, bool do_tr = true) {
    unsigned char* ws = a.ws;
    if (vcu < 192 && do_mod) {
        LAS float* sc = (LAS float*)lds;
        LAS float* red = (LAS float*)(lds + 73728);
        for (int i = tid; i < 9 * 2048; i += 512) { const int r = i >> 11, k = i & 2047; const float v = r < 8 ? a.in[1][r * 2048 + k] : a.in[3][k]; sc[i] = silu_f(v); }
        __syncthreads();
        const float* wm = a.in[4]; const float* bm = a.in[5]; float* mod = (float*)(ws + WS_MOD);
        for (int chunk = vcu; chunk < 192; chunk += G) {
            const int n0 = chunk * 64, ks = lane >> 4, n4 = (lane & 15) * 4;
            f32x4 acc[9];
#pragma unroll
            for (int r = 0; r < 9; ++r) acc[r] = (f32x4){0.f, 0.f, 0.f, 0.f};
#pragma unroll 4
            for (int kk = 0; kk < 256; kk += 4) { const int k = wave * 256 + kk + ks; const f32x4 wv = __builtin_nontemporal_load((const f32x4*)(wm + (size_t)k * 12288 + n0 + n4));
#pragma unroll
                for (int r = 0; r < 9; ++r) { const float s = sc[r * 2048 + k]; acc[r] += wv * s; } }
#pragma unroll
            for (int r = 0; r < 9; ++r)
#pragma unroll
                for (int j = 0; j < 4; ++j) { float v = acc[r][j]; v += __shfl_xor(v, 16); v += __shfl_xor(v, 32); acc[r][j] = v; }
            if (lane < 16) {
#pragma unroll
                for (int r = 0; r < 9; ++r) *(LAS f32x4*)(red + (wave * 9 + r) * 64 + n4) = acc[r]; }
            __syncthreads();
            for (int i = tid; i < 9 * 64; i += 512) { const int r = i >> 6, n = i & 63; float s = 0.f;
#pragma unroll
                for (int w = 0; w < 8; ++w) s += red[(w * 9 + r) * 64 + n];
                mod[r * 12288 + n0 + n] = s + bm[n0 + n]; }
            __syncthreads();
        }
    }
    __syncthreads();
    if (do_tr) convert_items(a, (LAS float*)(lds + wave * 16384), lane, vcu * 8 + wave, G * 8, NITEMS_P0 - 2 * I_E, 2 * I_E);
    { const float* wr = a.in[19]; bf16* whi = (bf16*)(ws + WS_WRT); bf16* wlo = whi + 64 * 2048;
      for (int idx = vcu * 512 + tid; idx < 64 * 256; idx += G * 512) { const int e = idx >> 8, k8 = idx & 255; unsigned hi[8], lo[8];
#pragma unroll
          for (int j = 0; j < 8; ++j) { const float v = wr[(size_t)(8 * k8 + j) * 64 + e]; hi[j] = f2bf(v); lo[j] = f2bf(v - __builtin_bit_cast(float, hi[j] << 16)); }
          v4u oh, ol; oh.x = hi[0] | (hi[1] << 16); oh.y = hi[2] | (hi[3] << 16); oh.z = hi[4] | (hi[5] << 16); oh.w = hi[6] | (hi[7] << 16);
          ol.x = lo[0] | (lo[1] << 16); ol.y = lo[2] | (lo[3] << 16); ol.z = lo[4] | (lo[5] << 16); ol.w = lo[6] | (lo[7] << 16);
          *(v4u*)(whi + (size_t)e * 2048 + 8 * k8) = oh; (void)ol; (void)wlo; } }
    { v4u* z = (v4u*)((bf16*)(ws + WS_WIN) + (size_t)DIN * 2048); const int nz = (DINP - DIN) * 2048 / 8;
      for (int i = vcu * 512 + tid; i < nz; i += G * 512) z[i] = (v4u){0u, 0u, 0u, 0u}; }
}

__device__ __forceinline__ void phase1(const Args& a, int lane, int wave, int vcu, int G) {
    const float* mod = (const float*)(a.ws + WS_MOD); bf16* H = (bf16*)(a.ws + RA_H); const float* g = a.in[6];
    for (int m = vcu * 8 + wave; m < MROWS; m += G * 8) {
        const float* xr = m < NT ? a.in[0] + (size_t)m * 2048 : a.in[2] + (size_t)(m - NT) * 2048;
        const float* mr = mod + (size_t)(m < NT ? (m >> 11) : 8) * 12288;
        f32x4 v[8]; float ss = 0.f;
#pragma unroll
        for (int j = 0; j < 8; ++j) { v[j] = __builtin_nontemporal_load((const f32x4*)(xr + 4 * (lane + 64 * j))); ss += v[j][0] * v[j][0] + v[j][1] * v[j][1] + v[j][2] * v[j][2] + v[j][3] * v[j][3]; }
        const float rstd = rsqrtf(wave_sum(ss) * (1.f / 2048.f) + EPS);
#pragma unroll
        for (int j = 0; j < 8; ++j) { const int c = 4 * (lane + 64 * j); const f32x4 gg = *(const f32x4*)(g + c), sh = *(const f32x4*)(mr + c), sc = *(const f32x4*)(mr + 2048 + c);
            const f32x4 o = v[j] * rstd * gg * (sc + 1.f) + sh;
            v2u q; q.x = pk2(o[0], o[1]); q.y = pk2(o[2], o[3]); *(v2u*)(H + (size_t)m * 2048 + c) = q; }
    }
}

__device__ __forceinline__ int scan_row(int b, int dir, int s) {
    if (s < 256) { const int tc = dir ? 255 - s : s; return NT + b * 256 + tc; }
    const int t0 = s - 256; return b * 2048 + (dir ? 2047 - t0 : t0);
}
__device__ __forceinline__ void prep_item(const Args& a, LAS unsigned char* lds, int tid, int dir, int b, int ch) {
    unsigned char* ws = a.ws;
    const bf16* Q = (const bf16*)(ws + RA_Q); const bf16* Kb = (const bf16*)(ws + RA_K); const float* ALR = (const float*)(ws + RA_ALR);
    v4u* QG = (v4u*)(ws + PQG); bf16* AM = (bf16*)(ws + PAM); bf16* KD = (bf16*)(ws + PKD); float* DEC = (float*)(ws + PDEC);
    constexpr int TS = 520;
    LAS float* alr = (LAS float*)lds;
    LAS bf16* Kt = (LAS bf16*)(lds + 4096);
    LAS bf16* Qt = (LAS bf16*)(lds + 4096 + 64 * TS * 2);
    const int col = tid, h = col >> 7, dk = col & 127;
    const int lane = tid & 63, wave = __builtin_amdgcn_readfirstlane(tid >> 6), l15 = lane & 15, l4 = lane >> 4;
    const bool lat = ch >= 4;
    if (tid < 256) { const int i = tid >> 2, r4 = (tid & 3) * 4; const int row = scan_row(b, dir, ch * 64 + i);
        *(LAS f32x4*)(alr + i * 16 + r4) = *(const f32x4*)(ALR + (size_t)row * 32 + dir * 16 + r4); }
    { v4u kr[8], qr[8];
#pragma unroll
      for (int q = 0; q < 8; ++q) { const int p = tid + 512 * q, i = p >> 6, c8 = (p & 63) * 8; const int row = scan_row(b, dir, ch * 64 + i);
          kr[q] = *(const v4u*)(Kb + (size_t)row * 512 + c8); if (lat) qr[q] = *(const v4u*)(Q + (size_t)row * 512 + c8); }
#pragma unroll
      for (int q = 0; q < 8; ++q) { const int p = tid + 512 * q, i = p >> 6, c8 = (p & 63) * 8; *(LAS v4u*)(Kt + i * TS + c8) = kr[q]; if (lat) *(LAS v4u*)(Qt + i * TS + c8) = qr[q]; } }
    const float* wa2 = dir ? a.in[13] : a.in[11]; const float bia = (dir ? a.in[14] : a.in[12])[col];
    float w[16];
#pragma unroll
    for (int r = 0; r < 16; ++r) w[r] = wa2[r * 512 + col];
    LDS_BARRIER();
    float Gv[64]; float Gc = 0.f;
#pragma unroll
    for (int i = 0; i < 64; ++i) { float z = bia;
#pragma unroll
        for (int r4 = 0; r4 < 4; ++r4) { const f32x4 x = *(const LAS f32x4*)(alr + i * 16 + 4 * r4); z += x[0] * w[4 * r4] + x[1] * w[4 * r4 + 1] + x[2] * w[4 * r4 + 2] + x[3] * w[4 * r4 + 3]; }
        Gc += (fminf(z, 0.f) - __logf(1.f + __expf(-fabsf(z)))) * (1.f / 16.f); Gv[i] = Gc; }
    const float Gmid = Gv[32], Gend = Gv[63];
    DEC[((size_t)(dir * 8 + b) * 36 + ch) * 512 + col] = __expf(Gend);
    bf16* kdrow = KD + ((((size_t)(dir * 8 + b) * 36 + ch) * 4 + h) * 128 + dk) * 64;
#pragma unroll
    for (int i0 = 0; i0 < 64; i0 += 8) { unsigned kd[8];
#pragma unroll
        for (int ii = 0; ii < 8; ++ii) { const int i = i0 + ii; const float kv = bf1(Kt[i * TS + col]);
            kd[ii] = f2bf(kv * __expf(Gend - Gv[i]));
            if (lat) { const float qv = bf1(Qt[i * TS + col]) * 0.08838834764831845f;
                Qt[i * TS + col] = (bf16)f2bf(qv * __expf(Gv[i] - Gmid)); Kt[i * TS + col] = (bf16)f2bf(kv * __expf(Gmid - Gv[i])); } }
        v4u o; o.x = kd[0] | (kd[1] << 16); o.y = kd[2] | (kd[3] << 16); o.z = kd[4] | (kd[5] << 16); o.w = kd[6] | (kd[7] << 16);
        *(v4u*)(kdrow + i0) = o; }
    if (lat) {
        LDS_BARRIER();
        const int hh = wave >> 1; bf16* amt = AM + ((((size_t)(dir * 8 + b) * 32 + (ch - 4)) * 4 + hh) * 64) * 64;
#pragma unroll
        for (int t2 = 0; t2 < 2; ++t2) { const int ti = (wave & 1) * 2 + t2; f32x4 c[4];
#pragma unroll
            for (int tj = 0; tj < 4; ++tj) c[tj] = (f32x4){0.f, 0.f, 0.f, 0.f};
#pragma unroll
            for (int ks = 0; ks < 4; ++ks) { const int ko = hh * 128 + 32 * ks + 8 * l4;
                const bf16x8 bq = *(const LAS bf16x8*)(Qt + (16 * ti + l15) * TS + ko);
#pragma unroll
                for (int tj = 0; tj < 4; ++tj) { const bf16x8 ak = *(const LAS bf16x8*)(Kt + (16 * tj + l15) * TS + ko);
                    c[tj] = __builtin_amdgcn_mfma_f32_16x16x32_bf16(ak, bq, c[tj], 0, 0, 0); } }
            const int i = 16 * ti + l15;
#pragma unroll
            for (int tj = 0; tj < 4; ++tj) { const int j0 = 16 * tj + 4 * l4;
                v2u p; p.x = pk2(j0 <= i ? c[tj][0] : 0.f, j0 + 1 <= i ? c[tj][1] : 0.f); p.y = pk2(j0 + 2 <= i ? c[tj][2] : 0.f, j0 + 3 <= i ? c[tj][3] : 0.f);
                *(v2u*)(amt + i * 64 + j0) = p; } }
        LDS_BARRIER();
        { const float eg = __expf(Gmid);
#pragma unroll 8
          for (int i = 0; i < 64; ++i) Qt[i * TS + col] = (bf16)f2bf(bf1(Qt[i * TS + col]) * eg); }
        LDS_BARRIER();
        { v4u* qgt = QG + ((((size_t)(dir * 8 + b) * 32 + (ch - 4)) * 4) * 1024);
#pragma unroll
          for (int q = 0; q < 8; ++q) { const int p = tid + 512 * q; const int hq = p >> 10, rem = p & 1023, i = rem >> 4, c16 = rem & 15;
              qgt[p] = *(const LAS v4u*)(Qt + i * TS + hq * 128 + c16 * 8); } }
    }
    LDS_BARRIER();
}
__device__ __forceinline__ void phase3_prep(const Args& a, LAS unsigned char* lds, int tid, int vcu, int G) {
    for (int item = vcu; item < 2 * 8 * 32; item += G) { const int lc = item & 31, b = (item >> 5) & 7, dir = item >> 8; prep_item(a, lds, tid, dir, b, 4 + lc); }
    for (int item = vcu; item < 2 * 8 * 4; item += G) { const int cc = item & 3, b = (item >> 2) & 7, dir = item >> 5; prep_item(a, lds, tid, dir, b, cc); }
}

struct ConvItem { const float* src; unsigned char* dst; int drow, k0, n0; };
__device__ __forceinline__ ConvItem conv_decode(const Args& a, int id) {
    id = id < 2 * I_E ? id : id - 2 * I_E * (id / (2 * I_E));
    const int up = id >= I_E ? 1 : 0; const int r = id - up * I_E; const int e = r / 512, rr = r % 512, kb = rr / 16, nb = rr % 16;
    ConvItem c; c.n0 = 32 * nb; c.k0 = 64 * kb;
    c.src = e < 64 ? a.in[21 + up] + (size_t)e * 2048 * 512 : a.in[24 + up];
    c.dst = a.ws + WS_WGU + (size_t)e * 1024 * 2048; c.drow = (c.n0 / 128) * 256 + up * 128 + (c.n0 % 128); return c;
}
__device__ __forceinline__ void conv_load(f32x4 (&t)[8], const ConvItem& c, int lane) {
#pragma unroll
    for (int i = 0; i < 8; ++i) t[i] = __builtin_nontemporal_load((const f32x4*)(c.src + (size_t)(c.k0 + 8 * i + (lane >> 3)) * 512 + c.n0 + 4 * (lane & 7)));
}
__device__ __forceinline__ void conv_finish(const f32x4 (&t)[8], const ConvItem& c, LAS float* scr, int lane) {
#pragma unroll
    for (int i = 0; i < 8; ++i) { LAS float* d = scr + (8 * i + (lane >> 3)) * 33 + 4 * (lane & 7); d[0] = t[i][0]; d[1] = t[i][1]; d[2] = t[i][2]; d[3] = t[i][3]; }
    LDS_WAIT(); asm volatile("" ::: "memory");
    const int cc = lane & 7;
#pragma unroll
    for (int j = 0; j < 4; ++j) { const int n = (lane >> 3) + 8 * j; const LAS float* sp = scr + (8 * cc) * 33 + n;
        v2u o; o.x = pk4_fp8(sp[0 * 33] * SC_W, sp[1 * 33] * SC_W, sp[2 * 33] * SC_W, sp[3 * 33] * SC_W); o.y = pk4_fp8(sp[4 * 33] * SC_W, sp[5 * 33] * SC_W, sp[6 * 33] * SC_W, sp[7 * 33] * SC_W);
        __builtin_nontemporal_store(o, (v2u*)(c.dst + (size_t)(c.drow + n) * 2048 + c.k0 + 8 * cc)); }
    LDS_WAIT(); asm volatile("" ::: "memory");
}
constexpr int GL_CONV = 73728;
constexpr int GL_QG = 0, GL_ST = 17408, GL_KDT = 34816, GL_VT = 53248, GL_AM = 62464, GL_DEC = 71680;
__device__ __forceinline__ void phase_chain(const Args& a, LAS unsigned char* lds, int tid, int lane, int wave, int vcu, int G) {
    unsigned char* ws = a.ws;
    const v4u* QG = (const v4u*)(ws + PQG); const v4u* AM = (const v4u*)(ws + PAM); const v4u* KD = (const v4u*)(ws + PKD); const float* DEC = (const float*)(ws + PDEC);
    const bf16* V = (const bf16*)(ws + RA_V); bf16* OF = (bf16*)(ws + RA_OF);
    const int l15 = lane & 15, l4 = lane >> 4;
    int cstep = 0;
    for (int item = vcu; item < 256; item += G) {
        const int vs = item & 3, dir = (item >> 2) & 1, h = (item >> 3) & 3, b = item >> 5;
        f32x4 S[4];
#pragma unroll
        for (int tv = 0; tv < 4; ++tv) S[tv] = (f32x4){0.f, 0.f, 0.f, 0.f};
        v4u rq[2], ra, rk[2], rv; float rdec = 0.f; f32x4 ct[8]; ConvItem ci;
#define GL_LOAD(ch_, LATL) do { const int ch__ = (ch_); \
            if (LATL) { const size_t t_ = ((((size_t)(dir * 8 + b) * 32 + (ch__ - 4)) * 4 + h) * 1024); rq[0] = QG[t_ + tid]; rq[1] = QG[t_ + tid + 512]; ra = AM[t_ / 2 + tid]; } \
            { const size_t t_ = ((((size_t)(dir * 8 + b) * 36 + ch__) * 4 + h) * 1024); rk[0] = KD[t_ + tid]; rk[1] = KD[t_ + tid + 512]; } \
            { const int row_ = scan_row(b, dir, ch__ * 64 + (tid >> 3)); rv = *(const v4u*)(V + (size_t)row_ * 1024 + h * 256 + vs * 64 + 8 * (tid & 7)); } \
            rdec = DEC[((size_t)(dir * 8 + b) * 36 + ch__) * 512 + h * 128 + (tid & 127)]; } while (0)
#define GL_STEP(ch_, LAT, LATN, MORE) do { const int ch = (ch_); \
              \
            _Pragma("unroll") for (int tv = 0; tv < 4; ++tv) { v2u p; p.x = pk2(S[tv][0], S[tv][1]); p.y = pk2(S[tv][2], S[tv][3]); \
                *(LAS v2u*)(lds + GL_ST + (16 * tv + l15) * 272 + (16 * wave + 4 * l4) * 2) = p; } \
            if (LAT) { _Pragma("unroll") for (int q = 0; q < 2; ++q) { const int p = tid + 512 * q; *(LAS v4u*)(lds + GL_QG + (p >> 4) * 272 + (p & 15) * 16) = rq[q]; } \
                *(LAS v4u*)(lds + GL_AM + (tid >> 3) * 144 + (tid & 7) * 16) = ra; } \
            _Pragma("unroll") for (int q = 0; q < 2; ++q) { const int p = tid + 512 * q; *(LAS v4u*)(lds + GL_KDT + (p >> 3) * 144 + (p & 7) * 16) = rk[q]; } \
            { const int i = tid >> 3, c = tid & 7; LAS bf16* vt = (LAS bf16*)(lds + GL_VT) + i; \
              vt[(8 * c + 0) * 72] = (bf16)(rv.x & 0xffffu); vt[(8 * c + 1) * 72] = (bf16)(rv.x >> 16); vt[(8 * c + 2) * 72] = (bf16)(rv.y & 0xffffu); vt[(8 * c + 3) * 72] = (bf16)(rv.y >> 16); \
              vt[(8 * c + 4) * 72] = (bf16)(rv.z & 0xffffu); vt[(8 * c + 5) * 72] = (bf16)(rv.z >> 16); vt[(8 * c + 6) * 72] = (bf16)(rv.w & 0xffffu); vt[(8 * c + 7) * 72] = (bf16)(rv.w >> 16); } \
            if (tid < 128) *(LAS float*)(lds + GL_DEC + tid * 4) = rdec; \
            LDS_BARRIER(); \
            if (MORE) GL_LOAD(ch + 1, LATN); \
            if (LAT) {   \
                const int ti = wave >> 1, tv0 = (wave & 1) * 2; f32x4 c0 = (f32x4){0.f, 0.f, 0.f, 0.f}, c1 = c0; bf16x8 fb[6], f0[6], f1[6]; \
                _Pragma("unroll") for (int ks = 0; ks < 4; ++ks) { const int ko = (32 * ks + 8 * l4) * 2; \
                    fb[ks] = *(const LAS bf16x8*)(lds + GL_QG + (16 * ti + l15) * 272 + ko); \
                    f0[ks] = *(const LAS bf16x8*)(lds + GL_ST + (16 * tv0 + l15) * 272 + ko); f1[ks] = *(const LAS bf16x8*)(lds + GL_ST + (16 * tv0 + 16 + l15) * 272 + ko); } \
                _Pragma("unroll") for (int ks = 0; ks < 2; ++ks) { const int ko = (32 * ks + 8 * l4) * 2; \
                    fb[4 + ks] = *(const LAS bf16x8*)(lds + GL_AM + (16 * ti + l15) * 144 + ko); \
                    f0[4 + ks] = *(const LAS bf16x8*)(lds + GL_VT + (16 * tv0 + l15) * 144 + ko); f1[4 + ks] = *(const LAS bf16x8*)(lds + GL_VT + (16 * tv0 + 16 + l15) * 144 + ko); } \
                _Pragma("unroll") for (int ks = 0; ks < 6; ++ks) { c0 = __builtin_amdgcn_mfma_f32_16x16x32_bf16(f0[ks], fb[ks], c0, 0, 0, 0); c1 = __builtin_amdgcn_mfma_f32_16x16x32_bf16(f1[ks], fb[ks], c1, 0, 0, 0); } \
                const int s_ = ch * 64 + 16 * ti + l15; const int t0 = s_ - 256; const int t = dir ? 2047 - t0 : t0; \
                bf16* orow = OF + ((size_t)dir * NT + b * 2048 + t) * 1024 + h * 256 + vs * 64 + 16 * tv0 + 4 * l4; \
                v2u p0, p1; p0.x = pk2(c0[0], c0[1]); p0.y = pk2(c0[2], c0[3]); p1.x = pk2(c1[0], c1[1]); p1.y = pk2(c1[2], c1[3]); \
                *(v2u*)(orow) = p0; *(v2u*)(orow + 16) = p1; } \
              \
            { const f32x4 d4 = *(const LAS f32x4*)(lds + GL_DEC + (16 * wave + 4 * l4) * 4); bf16x8 fk[2], fv[2][4]; \
              _Pragma("unroll") for (int ks = 0; ks < 2; ++ks) { const int ko = (32 * ks + 8 * l4) * 2; fk[ks] = *(const LAS bf16x8*)(lds + GL_KDT + (16 * wave + l15) * 144 + ko); \
                  _Pragma("unroll") for (int tv = 0; tv < 4; ++tv) fv[ks][tv] = *(const LAS bf16x8*)(lds + GL_VT + (16 * tv + l15) * 144 + ko); } \
              _Pragma("unroll") for (int tv = 0; tv < 4; ++tv) S[tv] = S[tv] * d4; \
              _Pragma("unroll") for (int ks = 0; ks < 2; ++ks) \
                  _Pragma("unroll") for (int tv = 0; tv < 4; ++tv) S[tv] = __builtin_amdgcn_mfma_f32_16x16x32_bf16(fk[ks], fv[ks][tv], S[tv], 0, 0, 0); } \
              \
            conv_finish(ct, ci, (LAS float*)(lds + GL_CONV + wave * 8448), lane); ++cstep; ci = conv_decode(a, cstep * (G * 8) + vcu * 8 + wave); conv_load(ct, ci, lane); \
            LDS_BARRIER(); } while (0)
        ci = conv_decode(a, cstep * (G * 8) + vcu * 8 + wave); conv_load(ct, ci, lane);
        GL_LOAD(0, false);
        GL_STEP(0, false, false, true); GL_STEP(1, false, false, true); GL_STEP(2, false, false, true); GL_STEP(3, false, true, true);
#pragma unroll 1
        for (int c2 = 4; c2 < 35; ++c2) { GL_STEP(c2, true, true, true); }
        GL_STEP(35, true, true, false);
#undef GL_STEP
#undef GL_LOAD
    }
    for (int id = cstep * (G * 8) + vcu * 8 + wave; id < 2 * I_E; id += G * 8) { const ConvItem c = conv_decode(a, id); f32x4 t[8]; conv_load(t, c, lane); conv_finish(t, c, (LAS float*)(lds + GL_CONV + wave * 8448), lane); }
}

template <int HALFW>
__device__ __forceinline__ void pool_item(const bf16* P, bf16* DP, LAS float* tmp, int tid, int b, int r, int g) {
    const int rlo = r - HALFW < 0 ? 0 : r - HALFW, rhi = r + HALFW > 32 ? 32 : r + HALFW;
    const float rinv = 1.f / (float)(rhi - rlo);
#pragma unroll 1
    for (int q = 0; q < 4; ++q) { const int p = tid + 512 * q, c = p >> 5, ch0 = (p & 31) * 8; float acc[8]; v4u x[2 * HALFW];
#pragma unroll
        for (int u = 0; u < 2 * HALFW; ++u) { const int rr = (rlo + u < rhi) ? rlo + u : rlo; x[u] = *(const v4u*)(P + ((size_t)(b * 2048 + rr * 64 + c)) * 1024 + g * 256 + ch0); }
#pragma unroll
        for (int j = 0; j < 8; ++j) acc[j] = 0.f;
#pragma unroll
        for (int u = 0; u < 2 * HALFW; ++u) { const float m = (rlo + u < rhi) ? 1.f : 0.f;
            acc[0] += m * bflo(x[u].x); acc[1] += m * bfhi(x[u].x); acc[2] += m * bflo(x[u].y); acc[3] += m * bfhi(x[u].y); acc[4] += m * bflo(x[u].z); acc[5] += m * bfhi(x[u].z); acc[6] += m * bflo(x[u].w); acc[7] += m * bfhi(x[u].w); }
        *(LAS f32x4*)(tmp + c * 256 + ch0) = (f32x4){acc[0] * rinv, acc[1] * rinv, acc[2] * rinv, acc[3] * rinv};
        *(LAS f32x4*)(tmp + c * 256 + ch0 + 4) = (f32x4){acc[4] * rinv, acc[5] * rinv, acc[6] * rinv, acc[7] * rinv}; }
    __syncthreads();
#pragma unroll 1
    for (int q = 0; q < 4; ++q) { const int p = tid + 512 * q, c = p >> 5, ch0 = (p & 31) * 8;
        const int clo = c - HALFW < 0 ? 0 : c - HALFW, chi = c + HALFW > 64 ? 64 : c + HALFW; const float cinv = 1.f / (float)(chi - clo);
        const size_t o = ((size_t)(b * 2048 + r * 64 + c)) * 1024 + g * 256 + ch0;
        const v4u x = *(const v4u*)(P + o);
        f32x4 a0 = (f32x4){0.f, 0.f, 0.f, 0.f}, a1 = a0;
#pragma unroll
        for (int u = 0; u < 2 * HALFW; ++u) { const int cc = (clo + u < chi) ? clo + u : clo; const float m = (clo + u < chi) ? 1.f : 0.f;
            a0 += *(const LAS f32x4*)(tmp + cc * 256 + ch0) * m; a1 += *(const LAS f32x4*)(tmp + cc * 256 + ch0 + 4) * m; }
        v4u d; d.x = pk2(a0[0] * cinv - bflo(x.x), a0[1] * cinv - bfhi(x.x)); d.y = pk2(a0[2] * cinv - bflo(x.y), a0[3] * cinv - bfhi(x.y));
        d.z = pk2(a1[0] * cinv - bflo(x.z), a1[1] * cinv - bfhi(x.z)); d.w = pk2(a1[2] * cinv - bflo(x.w), a1[3] * cinv - bfhi(x.w));
        *(v4u*)(DP + o) = d; }
    __syncthreads();
}
__device__ __forceinline__ void phase3_pool(const Args& a, LAS unsigned char* lds, int tid, int vcu, int G) {
    const bf16* P = (const bf16*)(a.ws + RA_P); bf16* DP = (bf16*)(a.ws + RA_DPOOL);
    LAS float* tmp = (LAS float*)lds;
    for (int item = vcu; item < 1024; item += G) {
        const int g = item >> 8, r = (item >> 3) & 31, b = item & 7;
        const int gg = 3 - g;
        if (gg == 0) pool_item<1>(P, DP, tmp, tid, b, r, gg); else if (gg == 1) pool_item<2>(P, DP, tmp, tid, b, r, gg); else if (gg == 2) pool_item<4>(P, DP, tmp, tid, b, r, gg); else pool_item<8>(P, DP, tmp, tid, b, r, gg);
    }
}

__device__ __forceinline__ void phase4_post(const Args& a, int lane, int wave, int vcu, int G) {
    const bf16* OF = (const bf16*)(a.ws + RA_OF); const bf16* OB = OF + (size_t)NT * 1024; const bf16* Rr = (const bf16*)(a.ws + RA_R); unsigned char* Y = a.ws + RA_YMIX;
    const float* gn = a.in[15];
    f32x4 g4[4];
#pragma unroll
    for (int q = 0; q < 4; ++q) g4[q] = *(const f32x4*)(gn + 16 * lane + 4 * q);
#pragma unroll 2
    for (int t = vcu * 8 + wave; t < NT; t += G * 8) {
        const size_t o = (size_t)t * 1024 + 16 * lane;
        const v4u f0 = __builtin_nontemporal_load((const v4u*)(OF + o)), f1 = __builtin_nontemporal_load((const v4u*)(OF + o + 8)), b0 = __builtin_nontemporal_load((const v4u*)(OB + o)), b1 = __builtin_nontemporal_load((const v4u*)(OB + o + 8)), r0 = __builtin_nontemporal_load((const v4u*)(Rr + o)), r1 = __builtin_nontemporal_load((const v4u*)(Rr + o + 8));
        float x[16], r[16];
#pragma unroll
        for (int w = 0; w < 4; ++w) { x[2 * w] = bflo(f0[w]) + bflo(b0[w]); x[2 * w + 1] = bfhi(f0[w]) + bfhi(b0[w]); x[8 + 2 * w] = bflo(f1[w]) + bflo(b1[w]); x[8 + 2 * w + 1] = bfhi(f1[w]) + bfhi(b1[w]);
            r[2 * w] = bflo(r0[w]); r[2 * w + 1] = bfhi(r0[w]); r[8 + 2 * w] = bflo(r1[w]); r[8 + 2 * w + 1] = bfhi(r1[w]); }
        float ss = 0.f;
#pragma unroll
        for (int q = 0; q < 16; ++q) ss += x[q] * x[q];
        ss += __shfl_xor(ss, 1); ss += __shfl_xor(ss, 2); ss += __shfl_xor(ss, 4); ss += __shfl_xor(ss, 8);
        const float sc = rsqrtf(ss * (1.f / 256.f) + EPS);
        float y[16];
#pragma unroll
        for (int q = 0; q < 16; ++q) y[q] = x[q] * sc * g4[q >> 2][q & 3] * silu_f(r[q]);
        v4u o0;
#pragma unroll
        for (int w = 0; w < 4; ++w) o0[w] = pk4_fp8(y[4 * w] * SC_Y, y[4 * w + 1] * SC_Y, y[4 * w + 2] * SC_Y, y[4 * w + 3] * SC_Y);
        *(v4u*)(Y + (size_t)t * 2048 + 16 * lane) = o0;
    }
}

__device__ __forceinline__ void phase6(const Args& a, LAS unsigned char* lds, int tid, int lane, int wave, int vcu, int G) {
    unsigned char* ws = a.ws;
    const float* mod = (const float*)(ws + WS_MOD); const bf16* Y1 = (const bf16*)(ws + RA_Y1); bf16* X1 = (bf16*)(ws + RA_X1); unsigned char* H2 = ws + RA_H2;
    const float* gpost = a.in[7]; const float* gpre2 = a.in[8]; const float* rbias = a.in[20];
    const bf16* whi = (const bf16*)(ws + WS_WRT);
    LAS float* part = (LAS float*)lds;
    LAS float* logit = (LAS float*)(lds + LDS_LOGIT);
    LAS u64* masks = (LAS u64*)(lds + LDS_MASKS);
    int* cnt = (int*)(ws + T_CNT); u64* tmask = (u64*)(ws + T_MASK); float* tokw = (float*)(ws + T_TOKW);
    const int l15 = lane & 15, l4 = lane >> 4;
    for (int blk = vcu; blk < NT / 64; blk += G) {
        for (int it = 0; it < 2; ++it) {
#pragma unroll 1
            for (int rep_ = 0; rep_ < P7_REP_ROWS; ++rep_) {
#pragma unroll 1
            for (int rr = 0; rr < 4; ++rr) {
                const int lr = wave * 4 + rr, t = blk * 64 + it * 32 + lr; const float* mr = mod + (size_t)(t >> 11) * 12288;
                const bf16* yr = Y1 + (size_t)t * 2048; const float* xr = a.in[0] + (size_t)t * 2048;
                f32x4 y[8]; float ss = 0.f;
#pragma unroll
                for (int j = 0; j < 8; ++j) { const v2u yb = __builtin_nontemporal_load((const v2u*)(yr + 4 * (lane + 64 * j))); y[j] = (f32x4){bflo(yb.x), bfhi(yb.x), bflo(yb.y), bfhi(yb.y)}; ss += y[j][0] * y[j][0] + y[j][1] * y[j][1] + y[j][2] * y[j][2] + y[j][3] * y[j][3]; }
                const float rstd1 = rsqrtf(wave_sum(ss) * (1.f / 2048.f) + EPS);
                float s2 = 0.f;
#pragma unroll
                for (int j = 0; j < 8; ++j) { const int c = 4 * (lane + 64 * j); const f32x4 x = __builtin_nontemporal_load((const f32x4*)(xr + c)), gp = *(const f32x4*)(gpost + c), gt = *(const f32x4*)(mr + 4096 + c);
                    const f32x4 x1 = x + gt * (y[j] * rstd1 * gp); y[j] = x1;
                    v2u xb; xb.x = pk2(x1[0], x1[1]); xb.y = pk2(x1[2], x1[3]); __builtin_nontemporal_store(xb, (v2u*)(X1 + (size_t)t * 2048 + c));
                    s2 += x1[0] * x1[0] + x1[1] * x1[1] + x1[2] * x1[2] + x1[3] * x1[3]; }
                const float rstd2 = rsqrtf(wave_sum(s2) * (1.f / 2048.f) + EPS);
#pragma unroll
                for (int j = 0; j < 8; ++j) { const int c = 4 * (lane + 64 * j); const f32x4 g2 = *(const f32x4*)(gpre2 + c), sh = *(const f32x4*)(mr + 6144 + c), sc = *(const f32x4*)(mr + 8192 + c);
                    const f32x4 hh = y[j] * rstd2 * g2 * (sc + 1.f) + sh;
                    v2u qh; qh.x = pk2(hh[0], hh[1]); qh.y = pk2(hh[2], hh[3]);
                    *(LAS v2u*)(lds + RT_HI + lr * RT_ROWB + c * 2) = qh;
                    *(unsigned*)(H2 + (size_t)t * 2048 + c) = pk4_fp8(hh[0] * SC_H, hh[1] * SC_H, hh[2] * SC_H, hh[3] * SC_H); }
            }
            __syncthreads();
            }
            { f32x4 acc[2][4];
#pragma unroll
              for (int mt = 0; mt < 2; ++mt)
#pragma unroll
                  for (int et = 0; et < 4; ++et) acc[mt][et] = (f32x4){0.f, 0.f, 0.f, 0.f};
#pragma unroll 1
              for (int kh = 0; kh < 2; ++kh) {
                  bf16x8 bh[4][4];
#pragma unroll
                  for (int k4 = 0; k4 < 4; ++k4) { const int k0 = 256 * wave + 32 * (4 * kh + k4) + 8 * l4;
#pragma unroll
                      for (int et = 0; et < 4; ++et) bh[k4][et] = *(const bf16x8*)(whi + (size_t)(16 * et + l15) * 2048 + k0); }
#pragma unroll
                  for (int k4 = 0; k4 < 4; ++k4) { const int k0 = 256 * wave + 32 * (4 * kh + k4) + 8 * l4;
#pragma unroll
                      for (int mt = 0; mt < 2; ++mt) { const bf16x8 ah = *(const LAS bf16x8*)(lds + RT_HI + (16 * mt + l15) * RT_ROWB + k0 * 2);
#pragma unroll
                          for (int et = 0; et < 4; ++et) acc[mt][et] = __builtin_amdgcn_mfma_f32_16x16x32_bf16(ah, bh[k4][et], acc[mt][et], 0, 0, 0); } } }
              __syncthreads();
#pragma unroll
              for (int mt = 0; mt < 2; ++mt)
#pragma unroll
                  for (int et = 0; et < 4; ++et)
#pragma unroll
                      for (int q = 0; q < 4; ++q) part[(wave * 32 + 16 * mt + 4 * l4 + q) * 64 + 16 * et + l15] = acc[mt][et][q]; }
            __syncthreads();
#pragma unroll
            for (int q = 0; q < 4; ++q) { const int idx = tid + 512 * q; float sacc = 0.f;
#pragma unroll
                for (int w = 0; w < 8; ++w) sacc += part[w * 2048 + idx];
                logit[idx] = sacc; }
            __syncthreads();
#pragma unroll 1
            for (int rep_ = 0; rep_ < P7_REP_RT; ++rep_) {
#pragma unroll 1
            for (int rr = 0; rr < 4; ++rr) {
                const int lr = wave * 4 + rr, t = blk * 64 + it * 32 + lr;
                const float lg = logit[lr * 64 + lane]; const float s = 1.f / (1.f + __expf(-lg)); const float sel = s + rbias[lane];
                float m1 = sel; m1 = fmaxf(m1, __shfl_xor(m1, 1)); m1 = fmaxf(m1, __shfl_xor(m1, 2)); m1 = fmaxf(m1, __shfl_xor(m1, 4));
                const u64 eq = __ballot(sel == m1); const unsigned gb = (unsigned)(eq >> (lane & ~7)) & 0xffu; const int first = __builtin_ctz(gb);
                float v2 = ((lane & 7) == first) ? -INFINITY : sel; v2 = fmaxf(v2, __shfl_xor(v2, 1)); v2 = fmaxf(v2, __shfl_xor(v2, 2)); v2 = fmaxf(v2, __shfl_xor(v2, 4));
                const float gs = m1 + v2; const int g = lane >> 3; int grank = 0;
#pragma unroll
                for (int g2 = 0; g2 < 8; ++g2) { const float o = __builtin_bit_cast(float, __builtin_amdgcn_readlane(__builtin_bit_cast(int, gs), g2 * 8)); grank += (o > gs || (o == gs && g2 < g)) ? 1 : 0; }
                const bool gsel = grank < 4; const float mk = gsel ? sel : -INFINITY; int rank = 0;
#pragma unroll 8
                for (int e2 = 0; e2 < 64; ++e2) { const float o = __builtin_bit_cast(float, __builtin_amdgcn_readlane(__builtin_bit_cast(int, mk), e2)); rank += (o > mk || (o == mk && e2 < lane)) ? 1 : 0; }
                const bool chosen = gsel && rank < 8;
                const u64 mask = __ballot(chosen); const float ssum = wave_sum(chosen ? s : 0.f);
                const int kidx = __popcll(mask & ((1ull << lane) - 1ull));
                if (chosen) tokw[(size_t)t * 8 + kidx] = s / ssum * 2.5f;
                if (lane == 0) { tmask[t] = mask; masks[it * 32 + lr] = mask; }
            }
            __syncthreads();
            }
        }
        if (wave == 0) { const u64 m = masks[lane]; int mine = 0;
#pragma unroll 8
            for (int e = 0; e < 64; ++e) { const int c = __popcll(__ballot((m >> e) & 1ull)); mine = (lane == e) ? c : mine; }
            cnt[blk * 64 + lane] = mine; }
        __syncthreads();
    }
}

__device__ __forceinline__ void phase7(const Args& a, LAS unsigned char* lds, int tid, int lane, int wave, int vcu, int G) {
    unsigned char* ws = a.ws;
    const int* cnt = (const int*)(ws + T_CNT); const u64* tmask = (const u64*)(ws + T_MASK); const float* tokw = (const float*)(ws + T_TOKW);
    int* tokslot = (int*)(ws + T_TOKSLOT); int* slottok = (int*)(ws + T_SLOTTOK); float* slotw = (float*)(ws + T_SLOTW); int* tile = (int*)(ws + T_TILE);
    LAS int* part = (LAS int*)(lds + 131072);
    bool converted = false;
    for (int blk = vcu; blk < NT / 64; blk += G) {
        int pre = 0, all = 0;
#pragma unroll 8
        for (int b2 = wave; b2 < 256; b2 += 8) { const int c = cnt[b2 * 64 + lane]; all += c; pre += (b2 < blk) ? c : 0; }
        part[(wave * 2) * 64 + lane] = pre; part[(wave * 2 + 1) * 64 + lane] = all;
        LDS_BARRIER();
        if (wave == 0) {
            int p = 0, t = 0;
#pragma unroll
            for (int w = 0; w < 8; ++w) { p += part[(w * 2) * 64 + lane]; t += part[(w * 2 + 1) * 64 + lane]; }
            int incl = t;
#pragma unroll
            for (int o = 1; o < 64; o <<= 1) { const int v = __shfl_up(incl, o); if (lane >= o) incl += v; }
            const int start = incl - t; const int base = start + p;
            const int tokn = blk * 64 + lane; const u64 m = tmask[tokn];
#pragma unroll 8
            for (int e = 0; e < 64; ++e) { const bool bit = (m >> e) & 1ull; const u64 bal = __ballot(bit); const int be = __builtin_amdgcn_readlane(base, e);
                if (bit) { const int rank = __popcll(bal & ((1ull << lane) - 1ull)); const int slot = be + rank; const int k = __popcll(m & ((1ull << e) - 1ull));
                    slottok[slot] = tokn; slotw[slot] = tokw[(size_t)tokn * 8 + k]; tokslot[(size_t)tokn * 8 + k] = slot; } }
            slottok[SH_ROW0 + tokn] = tokn; slotw[SH_ROW0 + tokn] = 1.f;
            if (blk == 0) {
                const int nte = (t + 255) >> 8; int inc2 = nte;
#pragma unroll
                for (int o = 1; o < 64; o <<= 1) { const int v = __shfl_up(inc2, o); if (lane >= o) inc2 += v; }
                const int n0 = inc2 - nte; const int ntot = __builtin_amdgcn_readlane(inc2, 63);
                for (int j = 0; j < nte; ++j) { tile[n0 + j] = lane; tile[NTILE_MAX + n0 + j] = start + j * 256; tile[2 * NTILE_MAX + n0 + j] = (t - j * 256) < 256 ? (t - j * 256) : 256; }
                tile[ntot + lane] = 64; tile[NTILE_MAX + ntot + lane] = SH_ROW0 + lane * 256; tile[2 * NTILE_MAX + ntot + lane] = 256;
                if (lane == 0) tile[3 * NTILE_MAX] = ntot + 64;
            }
        } else if (!converted) {
            converted = true;
            convert_items(a, (LAS float*)(lds + wave * 16384), lane, NITEMS_P0 + (G == 256 ? N_DOWN_EARLY : 0) + vcu * 7 + (wave - 1), G * 7, NITEMS);
        }
        LDS_BARRIER();
    }
}

__device__ __forceinline__ void phase10(const Args& a, LAS unsigned char* lds, int lane, int wave, int vcu, int G) {
    unsigned char* ws = a.ws;
    const float* mod = (const float*)(ws + WS_MOD); const unsigned char* SO = ws + WS_SLOTOUT; const int* tokslot = (const int*)(ws + T_TOKSLOT); const float* gp = a.in[9];
    LAS float* ysc = (LAS float*)(lds + wave * 8192);
    const unsigned lo16_ = 16u * (unsigned)lane;
#pragma unroll 1
    for (int t = vcu * 8 + wave; t < NT; t += G * 8) {
        const float* mr = mod + (size_t)(t >> 11) * 12288;
        const int myslot = lane < 8 ? tokslot[(size_t)t * 8 + lane] : SH_ROW0 + t;
        unsigned lo16 = lo16_; asm volatile("" : "+v"(lo16));
        v4u x[9][2]; v2u xb[8];
        const unsigned char* x1r = (const unsigned char*)((const bf16*)(ws + RA_X1) + (size_t)t * 2048);
#pragma unroll
        for (int k = 0; k < 9; ++k) { const int slot = __builtin_amdgcn_readlane(myslot, k); const unsigned char* sr = SO + (size_t)slot * 2048;
#pragma unroll
            for (int j = 0; j < 2; ++j) x[k][j] = __builtin_nontemporal_load((const v4u*)(sr + (lo16 + 1024u * j))); }
        float y[2][16];
#pragma unroll
        for (int j = 0; j < 2; ++j)
#pragma unroll
            for (int q = 0; q < 16; ++q) y[j][q] = 0.f;
#pragma unroll
        for (int k = 0; k < 9; ++k)
#pragma unroll
            for (int j = 0; j < 2; ++j) { v4u v = x[k][j]; asm volatile("" : "+v"(v) : "v"(y[j][0]), "v"(y[j][15]));
#pragma unroll
                for (int w = 0; w < 4; ++w) { const unsigned d = v[w]; const auto lo = __builtin_amdgcn_cvt_pk_f32_fp8(d, false), hi = __builtin_amdgcn_cvt_pk_f32_fp8(d, true);
                    y[j][4 * w] += lo[0]; y[j][4 * w + 1] += lo[1]; y[j][4 * w + 2] += hi[0]; y[j][4 * w + 3] += hi[1]; } }
        asm volatile("" ::: "memory");
#pragma unroll
        for (int j = 0; j < 8; ++j) xb[j] = __builtin_nontemporal_load((const v2u*)(x1r + (lo16 / 2u + 512u * j)));
        float ss = 0.f;
#pragma unroll
        for (int j = 0; j < 2; ++j)
#pragma unroll
            for (int q = 0; q < 16; ++q) ss += y[j][q] * y[j][q];
        const float rstd = rsqrtf(wave_sum(ss) * (1.f / 2048.f) + EPS * SC_O * SC_O);
#pragma unroll
        for (int j = 0; j < 2; ++j)
#pragma unroll
            for (int q = 0; q < 4; ++q) *(LAS f32x4*)(ysc + 16 * (lane + 64 * j) + 4 * q) = (f32x4){y[j][4 * q], y[j][4 * q + 1], y[j][4 * q + 2], y[j][4 * q + 3]};
        LDS_WAIT(); asm volatile("" ::: "memory");
        unsigned char* outr = (unsigned char*)(a.out + (size_t)t * 2048); const unsigned char* gpb = (const unsigned char*)gp;
        const unsigned char* gt2b = (const unsigned char*)(mr + 10240);
#pragma unroll
        for (int j = 0; j < 8; ++j) { const unsigned cb = lo16 + 1024u * j; const f32x4 yy = *(const LAS f32x4*)(ysc + 4 * (lane + 64 * j)), g = *(const f32x4*)(gpb + cb), gt = *(const f32x4*)(gt2b + cb);
            const f32x4 x1 = (f32x4){bflo(xb[j].x), bfhi(xb[j].x), bflo(xb[j].y), bfhi(xb[j].y)};
            *(f32x4*)(outr + cb) = x1 + gt * (yy * rstd * g); }
        LDS_WAIT(); asm volatile("" ::: "memory");
    }
}

__global__ void __launch_bounds__(512, 2) fwd(Args args) {
    extern __shared__ __attribute__((aligned(16))) unsigned char lds_raw[];
    LAS unsigned char* lds = (LAS unsigned char*)lds_raw;
    const int tid = threadIdx.x, lane = tid & 63, wave = __builtin_amdgcn_readfirstlane(tid >> 6);
    const int G = gridDim.x, bx = blockIdx.x;
    const int vcu = (G % 8 == 0) ? (bx % 8) * (G / 8) + bx / 8 : bx;
    unsigned char* ws = args.ws;
    volatile LAS unsigned* MISC = (volatile LAS unsigned*)(lds + LDS_MISC);
    if (tid < 64) MISC[tid] = 0u;
    __syncthreads();
    const int lo = args.ph_lo, hi = args.ph_hi;
    XcdBarrier bar; bar.bar = (unsigned*)(ws + WS_CTL) + 4096; bar.x = 0; bar.st = nullptr;
    if (hi - lo > 1) bar = xcd_barrier_post((unsigned*)(ws + WS_CTL) + 4096, MISC + 8);
#ifndef PH_MASK
#define PH_MASK 0xfff
#endif
#define IN(k) (((PH_MASK >> (k)) & 1) && lo <= (k) && (k) < hi)
#define SEAM(k) do { if (IN(k) && IN((k) + 1)) xcd_barrier(bar); } while (0)

#ifndef REP_PHASE
#define REP_PHASE -1
#endif
#define PH_IDS int tz_ = threadIdx.x; asm volatile("" : "+v"(tz_)); const int tid = tz_, lane = tz_ & 63, wave = __builtin_amdgcn_readfirstlane(tz_ >> 6); (void)tid; (void)lane; (void)wave;
#define RUNPH(k, ...) do { if (IN(k)) { { PH_IDS __VA_ARGS__ } if (REP_PHASE == (k)) { xcd_barrier(bar); { PH_IDS __VA_ARGS__ } } SEAM(k); } } while (0)
#ifdef PROBE_P0
    if (IN(0)) { { PH_IDS phase0(args, lds, tid, lane, wave, vcu, G); } xcd_barrier(bar); { PH_IDS phase0(args, lds, tid, lane, wave, vcu, G, PROBE_P0 == 1, PROBE_P0 == 2); } SEAM(0); }
#else
    RUNPH(0, phase0(args, lds, tid, lane, wave, vcu, G););
#endif
    RUNPH(1, phase1(args, lane, wave, vcu, G););
    RUNPH(2, {
        InSched S; S.D.init(ws + RA_H, ws + WS_WIN, 2048, 2048, NT, DINP, G, bx);
        EpiIn E{ws};
        pg8::gemm_phase<EpiIn, InSched>(lds, 2048, S, E);
        { const int nbusy = (InSched::NLAT + InSched::NCTX) % G; const int nidle = G - nbusy;
          if (G == 256 && bx >= nbusy) convert_items(args, (LAS float*)(lds + wave * 16384), lane, NITEMS_P0 + (bx - nbusy) * 8 + wave, nidle * 8, NITEMS_P0 + N_DOWN_EARLY); } });
#ifndef P3_REP_PREP
#define P3_REP_PREP 1
#endif
#ifndef P3_REP_POOL
#define P3_REP_POOL 1
#endif
    RUNPH(3, for (int r_ = 0; r_ < P3_REP_PREP; ++r_) phase3_prep(args, lds, tid, vcu, G); for (int r_ = 0; r_ < P3_REP_POOL; ++r_) phase3_pool(args, lds, tid, vcu, G););
    RUNPH(4, phase_chain(args, lds, tid, lane, wave, vcu, G););
    RUNPH(5, {
        phase4_post(args, lane, wave, vcu, G);
        PoolSched S{(const char*)(ws + RA_DPOOL), (const char*)(ws + WS_WPOOL), G, vcu};
        EpiPool E{ws + RA_YMIX, args.in[17]};
        int kpool = 256; asm volatile("" : "+s"(kpool));
        pg8::gemm_phase<EpiPool, PoolSched>(lds, kpool, S, E); });
    RUNPH(6, {
        DenseSched S; S.init(ws + RA_YMIX, ws + WS_WOUT, 1024, 1024, NT, 2048, G, bx);
        EpiOut E{(bf16*)(ws + RA_Y1)};
        int kout = 1024; asm volatile("" : "+s"(kout));
        pg8::gemm_phase<EpiOut, DenseSched, true>(lds, kout, S, E); });
    RUNPH(7, phase6(args, lds, tid, lane, wave, vcu, G););
    RUNPH(8, phase7(args, lds, tid, lane, wave, vcu, G););
    RUNPH(9, {
        MoeGUSched S{(const char*)(ws + RA_H2), (const char*)(ws + WS_WGU), (const int*)(ws + T_TILE), (const int*)(ws + T_SLOTTOK), G, vcu};
        EpiGU E{ws + WS_ACT, (const float*)(ws + T_SLOTW)};
        int kgu = 1024; asm volatile("" : "+s"(kgu));
        pg8::gemm_phase<EpiGU, MoeGUSched, true>(lds, kgu, S, E); });
    RUNPH(10, {
        MoeDownSched S{(const char*)(ws + WS_ACT), (const char*)(ws + WS_WD), (const int*)(ws + T_TILE), G, vcu};
        EpiDown E{ws + WS_SLOTOUT};
        int kdn = 256; asm volatile("" : "+s"(kdn));
        pg8::gemm_phase<EpiDown, MoeDownSched, true>(lds, kdn, S, E); });
    if (IN(11)) { { PH_IDS phase10(args, lds, lane, wave, vcu, G); } if (REP_PHASE == 11) { xcd_barrier(bar); { PH_IDS phase10(args, lds, lane, wave, vcu, G); } } }
#undef IN
#undef SEAM
}

extern "C" void kernel_launch(void* const* d_in, const int* in_sizes, int n_in, void* d_out, int out_size, void* d_ws, size_t ws_size, hipStream_t stream) {
    static int grid = 0;
    if (grid == 0) {
        if (n_in != 27 || out_size != NT * DM || ws_size < WS_NEED) { fprintf(stderr, "kernel_launch: unexpected problem: n_in %d out %d ws %zu (need %zu)\n", n_in, out_size, ws_size, (size_t)WS_NEED); grid = -1; return; }
        int dev = 0, cus = 0, per_cu = 0;
        if (hipGetDevice(&dev) != hipSuccess || hipDeviceGetAttribute(&cus, hipDeviceAttributeMultiprocessorCount, dev) != hipSuccess) { grid = -1; return; }
        if (hipFuncSetAttribute((const void*)fwd, hipFuncAttributeMaxDynamicSharedMemorySize, LDS_BYTES) != hipSuccess) { fprintf(stderr, "kernel_launch: hipFuncSetAttribute failed\n"); grid = -1; return; }
        if (hipOccupancyMaxActiveBlocksPerMultiprocessor(&per_cu, (const void*)fwd, 512, LDS_BYTES) != hipSuccess || per_cu < 1) { fprintf(stderr, "kernel_launch: occupancy query says %d\n", per_cu); }
        (void)hipGetLastError();
        grid = cus;
    }
    if (grid < 0) return;
    (void)hipMemsetAsync((char*)d_ws + WS_CTL, 0, CTL_ZERO_BYTES, stream);
    Args a{};
    for (int i = 0; i < 27; ++i) a.in[i] = (const float*)d_in[i];
    a.out = (float*)d_out; a.ws = (unsigned char*)d_ws;
    if (N_LAUNCHES == 1) {
        a.ph_lo = 0; a.ph_hi = NPH;
        hipLaunchKernelGGL(fwd, dim3(grid), dim3(512), LDS_BYTES, stream, a);
    } else {
        for (int p = 0; p < NPH; ++p) { a.ph_lo = p; a.ph_hi = p + 1; hipLaunchKernelGGL(fwd, dim3(grid), dim3(512), LDS_BYTES, stream, a); }
    }
}
```

```cpp
#include <hip/hip_runtime.h>
#include <cstdio>
#include <cstdint>

#ifndef P7_REP_ROWS
#define P7_REP_ROWS 1
#endif
#ifndef P7_REP_LOG
#define P7_REP_LOG 1
#endif
#ifndef P7_REP_RT
#define P7_REP_RT 1
#endif
#ifndef N_LAUNCHES
#define N_LAUNCHES 1
#endif

#define GAS __attribute__((address_space(1)))
#define LAS __attribute__((address_space(3)))
typedef unsigned short bf16;
typedef unsigned v4u __attribute__((ext_vector_type(4)));
typedef unsigned v2u __attribute__((ext_vector_type(2)));
typedef float f32x4 __attribute__((ext_vector_type(4)));
typedef short bf16x8 __attribute__((ext_vector_type(8)));
typedef unsigned long long u64;

constexpr int NB = 8, SEQ = 2048, DM = 2048, CTXL = 256;
constexpr int NT = NB * SEQ;
constexpr int NTC = NB * CTXL;
constexpr int MROWS = NT + NTC;
constexpr int DIN = 4128, DINP = 4352;
constexpr int NE = 64, TOPK = 8, DE = 512;
constexpr int NSLOT_E = NT * TOPK;
constexpr int SH_ROW0 = NSLOT_E + 256;
constexpr int NSLOT = SH_ROW0 + NT;
constexpr int NTILE_MAX = 704;
constexpr float EPS = 1e-6f;
constexpr int NPH = 12;

constexpr size_t MiB = 1u << 20;
constexpr size_t WS_CTL = 0, CTL_ZERO_BYTES = 64 * 1024;
constexpr size_t WS_MOD = 1 * MiB;
constexpr size_t WS_WRT = 1 * MiB + 512 * 1024;
constexpr size_t WS_WIN = 2 * MiB;
constexpr size_t WS_WOUT = WS_WIN + 17 * MiB;
constexpr size_t WS_WPOOL = WS_WOUT + 8 * MiB;
constexpr size_t WS_WD = WS_WPOOL + 1 * MiB;
constexpr size_t WS_WGU = WS_WD + 130 * MiB;
constexpr size_t WS_RA = WS_WGU + 260 * MiB;
constexpr size_t RA_H = WS_RA;
constexpr size_t RA_OF = WS_RA;
constexpr size_t RA_H2 = WS_RA;
constexpr size_t RA_Q = WS_RA + 128 * MiB;
constexpr size_t RA_K = RA_Q + 16 * MiB;
constexpr size_t RA_V = RA_K + 18 * MiB;
constexpr size_t RA_R = RA_V + 36 * MiB;
constexpr size_t RA_P = RA_R + 32 * MiB;
constexpr size_t RA_ALR = RA_P + 32 * MiB;
constexpr size_t RA_DPOOL = RA_ALR + 3 * MiB;
constexpr size_t RA_YMIX = RA_DPOOL + 32 * MiB;
constexpr size_t RA_Y1 = WS_RA + 128 * MiB;
constexpr size_t RA_X1 = WS_RA + 192 * MiB;
constexpr size_t RA_END = RA_YMIX + 64 * MiB;
constexpr size_t WS_SLOTOUT = WS_WGU;
constexpr size_t WS_ACT = RA_END > WS_SLOTOUT + 578 * MiB ? RA_END : WS_SLOTOUT + 578 * MiB;
constexpr size_t WS_END = WS_ACT + 145 * MiB;
constexpr size_t PQG = WS_ACT;
constexpr size_t PAM = WS_ACT + 32 * MiB;
constexpr size_t PKD = WS_ACT + 96 * MiB;
constexpr size_t PDEC = WS_ACT + 132 * MiB;
constexpr size_t WS_T0 = WS_END;
constexpr size_t T_CNT = WS_T0;
constexpr size_t T_MASK = T_CNT + 65536;
constexpr size_t T_TOKW = T_MASK + 131072;
constexpr size_t T_TOKSLOT = T_TOKW + 524288;
constexpr size_t T_SLOTTOK = T_TOKSLOT + 524288;
constexpr size_t T_SLOTW = T_SLOTTOK + 655360;
constexpr size_t T_TILE = T_SLOTW + 655360;
constexpr size_t WS_NEED = (T_TILE + 16384 + 4095) / 4096 * 4096;

constexpr int RING_BYTES = 131072;
constexpr int LDS_BYTES = 147456;
constexpr int LDS_MISC = LDS_BYTES - 256;
constexpr int RT_ROWB = 4112;
constexpr int RT_HI = 0;
constexpr int LDS_LOGIT = 32 * RT_ROWB;
constexpr int LDS_MASKS = LDS_LOGIT + 8192;
static_assert(LDS_MASKS + 512 <= LDS_MISC, "LDS map");

#define LDS_WAIT() asm volatile("s_waitcnt lgkmcnt(0)" ::: "memory")
#define LDS_BARRIER() do { asm volatile("s_waitcnt lgkmcnt(0)" ::: "memory"); __builtin_amdgcn_s_barrier(); asm volatile("" ::: "memory"); } while (0)
#define VM_WAIT() asm volatile("s_waitcnt vmcnt(0)" ::: "memory")

__device__ __forceinline__ unsigned f2bf(float f) { unsigned u = __builtin_bit_cast(unsigned, f); return (u + 0x7fffu + ((u >> 16) & 1u)) >> 16; }
__device__ __forceinline__ unsigned pk2(float lo, float hi) { return f2bf(lo) | (f2bf(hi) << 16); }
__device__ __forceinline__ float bflo(unsigned u) { return __builtin_bit_cast(float, u << 16); }
__device__ __forceinline__ float bfhi(unsigned u) { return __builtin_bit_cast(float, u & 0xffff0000u); }
__device__ __forceinline__ float bf1(bf16 b) { return __builtin_bit_cast(float, ((unsigned)b) << 16); }
__device__ __forceinline__ float wave_sum(float v) {
#pragma unroll
    for (int o = 1; o < 64; o <<= 1) v += __shfl_xor(v, o);
    return v;
}
__device__ __forceinline__ float silu_f(float x) { return x / (1.f + __expf(-x)); }

#define XB_TMO      128
#define XB_XCNT(j)  (256  + 64 * (j))
#define XB_XSUB(j)  (1280 + 64 * (j))
#define XB_XGEN(j)  (2304 + 64 * (j))
#define XB_TOP      3328
#define XB_TOPGEN   3392
#define XCD_BAR_WORDS 3456
#define XB_SPIN_CAP (1u << 18)

__device__ __forceinline__ unsigned xb_ld(unsigned* p)              { return __hip_atomic_load(p, __ATOMIC_RELAXED, __HIP_MEMORY_SCOPE_AGENT); }
__device__ __forceinline__ unsigned xb_add(unsigned* p, unsigned v) { return __hip_atomic_fetch_add(p, v, __ATOMIC_RELAXED, __HIP_MEMORY_SCOPE_AGENT); }
__device__ __forceinline__ unsigned xb_xcc_id() { return (unsigned)__builtin_amdgcn_s_getreg((3 << 11) | 20) & 0xFu; }
#define XB_SPIN(cond, bar) do { unsigned _sp = 0; while (cond) { __builtin_amdgcn_s_sleep(1); \
    if ((++_sp & 255u) == 0u) { if (xb_ld(&(bar)[XB_TMO])) break; if (_sp > XB_SPIN_CAP) { atomicAdd(&(bar)[XB_TMO], 1u); break; } } } } while (0)

struct XcdBarrier { unsigned* bar; unsigned x; volatile LAS unsigned* st; };

__device__ __forceinline__ XcdBarrier xcd_barrier_post(unsigned* bar, volatile LAS unsigned* st) {
    XcdBarrier b; b.bar = bar; b.x = xb_xcc_id(); b.st = st;
    if (threadIdx.x == 0) (void)xb_add(&bar[XB_XCNT(b.x)], 1u);
    return b;
}
__device__ __forceinline__ void xcd_barrier_complete(unsigned* bar, unsigned x, unsigned& nloc, unsigned& nx) {
    const unsigned G = gridDim.x * gridDim.y * gridDim.z;
    unsigned sum, cnt, mine, sp = 0u;
    for (;;) {
        sum = 0u; cnt = 0u; mine = 0u;
#pragma unroll
        for (unsigned j = 0; j < 16; ++j) { const unsigned c = xb_ld(&bar[XB_XCNT(j)]); sum += c; cnt += (c > 0u) ? 1u : 0u; mine = (j == x) ? c : mine; }
        if (sum == G) break;
        __builtin_amdgcn_s_sleep(1);
        if ((++sp & 255u) == 0u) { if (xb_ld(&bar[XB_TMO])) break; if (sp > XB_SPIN_CAP) { atomicAdd(&bar[XB_TMO], 1u); break; } }
    }
    nloc = mine > 0u ? mine : 1u; nx = cnt > 0u ? cnt : 1u;
}
__device__ __forceinline__ void xcd_barrier(const XcdBarrier& b) {
    asm volatile("s_waitcnt vmcnt(0)" ::: "memory");
    __syncthreads();
    if (threadIdx.x == 0) {
        unsigned* bar = b.bar;
        __builtin_amdgcn_s_waitcnt(0);
        unsigned nloc = b.st[0], nx = b.st[1];
        if (nloc == 0u) { xcd_barrier_complete(bar, b.x, nloc, nx); b.st[0] = nloc; b.st[1] = nx; }
        const unsigned old = xb_add(&bar[XB_XSUB(b.x)], 1u);
        const unsigned gen = old / nloc;
        if (old + 1u == (gen + 1u) * nloc) {
            __builtin_amdgcn_fence(__ATOMIC_RELEASE, "agent");
            asm volatile("s_waitcnt vmcnt(0)" ::: "memory");
            const unsigned og = xb_add(&bar[XB_TOP], 1u);
            const unsigned tg = og / nx;
            if (og + 1u == (tg + 1u) * nx) xb_add(&bar[XB_TOPGEN], 1u);
            else XB_SPIN(xb_ld(&bar[XB_TOPGEN]) == tg, bar);
            __builtin_amdgcn_fence(__ATOMIC_ACQUIRE, "agent");
            xb_add(&bar[XB_XGEN(b.x)], 1u);
            asm volatile("s_waitcnt vmcnt(0)" ::: "memory");
        } else {
            XB_SPIN(xb_ld(&bar[XB_XGEN(b.x)]) == gen, bar);
            __builtin_amdgcn_fence(__ATOMIC_ACQUIRE, "agent");
            asm volatile("s_waitcnt vmcnt(0)" ::: "memory");
        }
    }
    __syncthreads();
}

namespace pg8 {
constexpr int BM = 256, BK = 64, HALF = 128, HTB = HALF * BK * 2, STAGE_BYTES = 8 * HTB, NXCD = 8, WGM = 8;
__device__ __forceinline__ int lds_byte(int r, int c) { const int st = (r >> 4) * 2 + (c >> 5), rr = r & 15, cc = c & 31, ob = rr * 64 + cc * 2; return st * 1024 + (ob ^ (((ob >> 9) & 1) << 5)); }
__device__ __forceinline__ void stage_rc(int b, int& R, int& C) { const int st = b / 1024, sb = b % 1024, swz = sb ^ (((sb >> 9) & 1) << 5); R = (st >> 1) * 16 + swz / 64; C = (st & 1) * 32 + (swz % 64) / 2; }
__device__ __forceinline__ int perm32(int rho) { const int n = rho >> 4, i = rho & 15; return 8 * (i >> 2) + 4 * n + (i & 3); }
__device__ __forceinline__ unsigned cvt_pk_bf16(float lo, float hi) { unsigned r; asm volatile("v_cvt_pk_bf16_f32 %0, %1, %2" : "=v"(r) : "v"(lo), "v"(hi)); return r; }

typedef int v8i __attribute__((ext_vector_type(8)));
typedef int v4i __attribute__((ext_vector_type(4)));
template <class Epi, class Sched, bool FP8 = false>
__device__ __forceinline__ void gemm_phase(LAS unsigned char* lds, const int K, const Sched& S, const Epi& E) {
    typedef typename Sched::U Unit;
    const int tid = threadIdx.x, wid = __builtin_amdgcn_readfirstlane(tid >> 6), lane = tid & 63, wr = wid >> 2, wc = wid & 3, fr = lane & 15, fq = lane >> 4;
    const int nt = K / BK;
    int R[2], C[2]; unsigned voffB[2];
#pragma unroll
    for (int i = 0; i < 2; ++i) { stage_rc(tid * 16 + i * 8192, R[i], C[i]);
        const int Rb = Epi::PERMK == 2 ? (64 * (R[i] >> 5) + 16 * ((R[i] & 15) >> 2) + 4 * ((R[i] >> 4) & 1) + (R[i] & 3)) : (Epi::PERMK == 1 ? ((R[i] & ~31) + perm32(R[i] & 31)) : R[i]);
        voffB[i] = (unsigned)(Rb * K + C[i]) * 2u; }
    const size_t kstep = (size_t)(BK * 2);
    const size_t hstepB = (size_t)(Epi::PERMK == 2 ? 8 : HALF) * K * 2;
    const unsigned ldsw = (unsigned)wid * 1024u;
    const int aoff = lds_byte(wr * 64 + fr, fq * 8), boff = lds_byte(wc * 32 + fr, fq * 8);
#define PG8_SA(b, h) (((b) * 2 + (h)) * HTB)
#define PG8_SB(b, h) ((4 + (b) * 2 + (h)) * HTB)
#define PG8_STAGE(bufoff, gbase, v0, v1) do { \
        __builtin_amdgcn_global_load_lds((const unsigned*)((const char*)(gbase) + (v0)), (LAS unsigned*)(lds + (bufoff) + ldsw), 16, 0, 0); \
        __builtin_amdgcn_global_load_lds((const unsigned*)((const char*)(gbase) + (v1)), (LAS unsigned*)(lds + (bufoff) + ldsw + 8192), 16, 0, 0); } while (0)
#define PG8_LDA(dst, b, h) do { _Pragma("unroll") for (int m = 0; m < 4; ++m) { const v4i lo_ = *(const LAS v4i*)(lds + PG8_SA(b, h) + aoff + m * 2048), hi_ = *(const LAS v4i*)(lds + PG8_SA(b, h) + aoff + m * 2048 + 1024); \
        dst[m] = __builtin_shufflevector(lo_, hi_, 0, 1, 2, 3, 4, 5, 6, 7); } } while (0)
#define PG8_LDB(dst, b, h) do { _Pragma("unroll") for (int n = 0; n < 2; ++n) { const v4i lo_ = *(const LAS v4i*)(lds + PG8_SB(b, h) + boff + n * 2048), hi_ = *(const LAS v4i*)(lds + PG8_SB(b, h) + boff + n * 2048 + 1024); \
        dst[n] = __builtin_shufflevector(lo_, hi_, 0, 1, 2, 3, 4, 5, 6, 7); } } while (0)
#define PG8_H0(x) ((bf16x8)__builtin_shufflevector(x, x, 0, 1, 2, 3))
#define PG8_H1(x) ((bf16x8)__builtin_shufflevector(x, x, 4, 5, 6, 7))
#define PG8_MMA(ai, bj, At, Bt) do { __builtin_amdgcn_s_setprio(1); if constexpr (FP8) asm volatile("s_nop 4"); _Pragma("unroll") for (int m = 0; m < 4; ++m) _Pragma("unroll") for (int n = 0; n < 2; ++n) { \
        if constexpr (FP8) asm volatile("v_mfma_f32_16x16x128_f8f6f4 %0, %1, %2, %0" : "+v"(acc[ai][bj][m][n]) : "v"(Bt[n]), "v"(At[m])); \
        else { acc[ai][bj][m][n] = __builtin_amdgcn_mfma_f32_16x16x32_bf16(PG8_H0(Bt[n]), PG8_H0(At[m]), acc[ai][bj][m][n], 0, 0, 0); \
               acc[ai][bj][m][n] = __builtin_amdgcn_mfma_f32_16x16x32_bf16(PG8_H1(Bt[n]), PG8_H1(At[m]), acc[ai][bj][m][n], 0, 0, 0); } } \
        __builtin_amdgcn_s_setprio(0); } while (0)
#define PG8_WAIT_V(n) asm volatile("s_waitcnt vmcnt(" #n ")" ::: "memory")
#define PG8_WAIT_L(n) asm volatile("s_waitcnt lgkmcnt(" #n ")" ::: "memory")
#define PG8_BAR __builtin_amdgcn_s_barrier()
#define PG8_SCHED __builtin_amdgcn_sched_barrier(0)
    Unit cur, nxt; int ui = 0;
    if (!S.next(0, cur)) return;
    f32x4 acc[2][2][4][2];
#pragma unroll
    for (int a = 0; a < 2; ++a)
#pragma unroll
        for (int b = 0; b < 2; ++b)
#pragma unroll
            for (int m = 0; m < 4; ++m)
#pragma unroll
                for (int n = 0; n < 2; ++n) acc[a][b][m][n] = (f32x4){0.f, 0.f, 0.f, 0.f};
    v8i At[4], B0[2], B1[2];
    unsigned vA[4], vN[4];
    S.aoffs(cur, R, C, vA);
    const char* cA = cur.A; const char* cB = cur.B;
    PG8_STAGE(PG8_SB(0, 0), cB, voffB[0], voffB[1]); PG8_STAGE(PG8_SB(0, 1), cB + hstepB, voffB[0], voffB[1]); PG8_STAGE(PG8_SA(0, 0), cA, vA[0], vA[1]); PG8_STAGE(PG8_SA(0, 1), cA, vA[2], vA[3]);
    if (wr == 1) PG8_BAR;
    PG8_WAIT_V(2); PG8_BAR;
    PG8_STAGE(PG8_SB(1, 0), cB + kstep, voffB[0], voffB[1]); PG8_STAGE(PG8_SA(1, 0), cA + kstep, vA[0], vA[1]); PG8_STAGE(PG8_SB(1, 1), cB + hstepB + kstep, voffB[0], voffB[1]);
    PG8_WAIT_V(6); PG8_BAR;
    for (;;) {
        const bool has_next = S.next(ui + 1, nxt);
        const char* nA = has_next ? nxt.A : cA; const char* nB = has_next ? nxt.B : cB;
        if (has_next) S.aoffs(nxt, R, C, vN); else { vN[0] = vA[0]; vN[1] = vA[1]; vN[2] = vA[2]; vN[3] = vA[3]; }
        for (int t = 0; t < nt; t += 2) {
            const bool last = (t == nt - 2);
            const char* a1 = cA + (size_t)(t + 1) * kstep;
            const char* a2 = last ? nA : cA + (size_t)(t + 2) * kstep; const char* b2 = last ? nB : cB + (size_t)(t + 2) * kstep;
            const char* a3 = a2 + kstep; const char* b3 = b2 + kstep;
            const unsigned x0 = last ? vN[0] : vA[0], x1 = last ? vN[1] : vA[1], x2 = last ? vN[2] : vA[2], x3 = last ? vN[3] : vA[3];
            PG8_LDB(B0, 0, 0); PG8_LDB(B1, 0, 1); PG8_SCHED; PG8_LDA(At, 0, 0); PG8_STAGE(PG8_SA(1, 1), a1, vA[2], vA[3]);
            PG8_WAIT_V(8); PG8_WAIT_L(0); PG8_BAR; PG8_MMA(0, 0, At, B0); PG8_MMA(0, 1, At, B1); PG8_BAR; PG8_SCHED;
            PG8_LDA(At, 0, 1); PG8_STAGE(PG8_SB(0, 0), b2, voffB[0], voffB[1]); PG8_STAGE(PG8_SB(0, 1), b2 + hstepB, voffB[0], voffB[1]); PG8_STAGE(PG8_SA(0, 0), a2, x0, x1);
            PG8_WAIT_V(8); PG8_WAIT_L(0); PG8_BAR; PG8_MMA(1, 0, At, B0); PG8_MMA(1, 1, At, B1); PG8_BAR; PG8_SCHED;
            PG8_LDB(B0, 1, 0); PG8_LDB(B1, 1, 1); PG8_SCHED; PG8_LDA(At, 1, 0); PG8_STAGE(PG8_SA(0, 1), a2, x2, x3);
            PG8_WAIT_V(8); PG8_WAIT_L(0); PG8_BAR; PG8_MMA(0, 0, At, B0); PG8_MMA(0, 1, At, B1); PG8_BAR; PG8_SCHED;
            PG8_LDA(At, 1, 1); PG8_STAGE(PG8_SB(1, 0), b3, voffB[0], voffB[1]); PG8_STAGE(PG8_SB(1, 1), b3 + hstepB, voffB[0], voffB[1]); PG8_STAGE(PG8_SA(1, 0), a3, x0, x1);
            PG8_WAIT_V(8); PG8_WAIT_L(0); PG8_BAR; PG8_MMA(1, 0, At, B0); PG8_MMA(1, 1, At, B1); PG8_BAR; PG8_SCHED;
        }
        if (wr == 0) PG8_BAR;
        if constexpr (FP8) asm volatile("s_nop 15\n\ts_nop 15");
        { int tz = threadIdx.x; asm volatile("" : "+v"(tz));
          const int wid_ = tz >> 6, lane_ = tz & 63; E(acc, cur, wid_ >> 2, wid_ & 3, lane_ & 15, lane_ >> 4);
#ifdef PROBE_EPI2
          if constexpr (Epi::PROBE2) { asm volatile("" : "+v"(tz)); const int w2 = tz >> 6, l2 = tz & 63; E(acc, cur, w2 >> 2, w2 & 3, l2 & 15, l2 >> 4); }
#endif
#ifdef PROBE_DRAIN
          if constexpr (Epi::PROBE2) { asm volatile("s_waitcnt vmcnt(0)" ::: "memory"); }
#endif
        }
        if (!has_next) break;
#pragma unroll
        for (int a = 0; a < 2; ++a)
#pragma unroll
            for (int b = 0; b < 2; ++b)
#pragma unroll
                for (int m = 0; m < 4; ++m)
#pragma unroll
                    for (int n = 0; n < 2; ++n) acc[a][b][m][n] = (f32x4){0.f, 0.f, 0.f, 0.f};
        cur = nxt; cA = nA; cB = nB; ++ui;
        vA[0] = vN[0]; vA[1] = vN[1]; vA[2] = vN[2]; vA[3] = vN[3];
        if (wr == 1) PG8_BAR;
    }
    PG8_WAIT_V(0);
    PG8_BAR;
#undef PG8_SA
#undef PG8_SB
#undef PG8_STAGE
#undef PG8_LDA
#undef PG8_LDB
#undef PG8_H0
#undef PG8_H1
#undef PG8_MMA
#undef PG8_WAIT_V
#undef PG8_WAIT_L
#undef PG8_BAR
#undef PG8_SCHED
}
}

struct Args { const float* in[27]; float* out; unsigned char* ws; int ph_lo, ph_hi; };
static_assert(sizeof(Args) == 27 * 8 + 8 + 8 + 8, "Args has no padding");

struct DenseU { const char* A; const char* B; int pm, pn; };
struct DenseSched {
    typedef DenseU U;
    const char* A; const char* B; int lda, K, nM, nN, nwg, G, c;
    __device__ __forceinline__ void init(const void* A_, const void* B_, int lda_, int K_, int M, int N, int G_, int c_) { A = (const char*)A_; B = (const char*)B_; lda = lda_; K = K_; nM = M / 256; nN = N / 256; nwg = nM * nN; G = G_; c = c_; }
    __device__ __forceinline__ bool next(int i, U& u) const {
        const long L = (long)i * G + c; if (L >= nwg) return false;
        int wgid = (int)L; { const int q = nwg / 8, r = nwg % 8, xcd = wgid % 8, off = wgid / 8; wgid = (xcd < r ? xcd * (q + 1) : r * (q + 1) + (xcd - r) * q) + off; }
        const int nig = 8 * nN, gid = wgid / nig, fm = gid * 8, gsz = (nM - fm) < 8 ? (nM - fm) : 8;
        u.pm = fm + ((wgid % nig) % gsz); u.pn = (wgid % nig) / gsz;
        u.A = A + (size_t)u.pm * 256 * lda * 2; u.B = B + (size_t)u.pn * 256 * K * 2; return true;
    }
    __device__ __forceinline__ void aoffs(const U&, const int (&R)[2], const int (&C)[2], unsigned (&v)[4]) const {
#pragma unroll
        for (int h = 0; h < 2; ++h)
#pragma unroll
            for (int i = 0; i < 2; ++i) v[h * 2 + i] = (unsigned)((h * 128 + R[i]) * lda + C[i]) * 2u;
    }
};
struct InSched {
    typedef DenseU U;
    DenseSched D;
    static constexpr int NLAT = 64 * 17, NCTX = 8 * 7;
    __device__ __forceinline__ bool next(int i, U& u) const {
        const int L = i * D.G + D.c;
        if (L < NLAT) return D.next(i, u);
        const int j = L - NLAT; if (j >= NCTX) return false;
        const int q = j % 7; u.pm = 64 + j / 7; u.pn = q < 6 ? q + 2 : 16;
        u.A = D.A + (size_t)u.pm * 256 * D.lda * 2; u.B = D.B + (size_t)u.pn * 256 * D.K * 2; return true;
    }
    __device__ __forceinline__ void aoffs(const U& u, const int (&R)[2], const int (&C)[2], unsigned (&v)[4]) const { D.aoffs(u, R, C, v); }
};
struct PoolU { const char* A; const char* B; int pm, g; };
struct PoolSched {
    typedef PoolU U;
    const char* A; const char* B; int G, c;
    __device__ __forceinline__ bool next(int i, U& u) const {
        const int L = i * G + c; if (L >= 256) return false;
        u.g = L & 3; u.pm = L >> 2;
        u.A = A + ((size_t)u.pm * 256 * 1024 + u.g * 256) * 2; u.B = B + (size_t)u.g * 256 * 256 * 2; return true;
    }
    __device__ __forceinline__ void aoffs(const U&, const int (&R)[2], const int (&C)[2], unsigned (&v)[4]) const {
#pragma unroll
        for (int h = 0; h < 2; ++h)
#pragma unroll
            for (int i = 0; i < 2; ++i) v[h * 2 + i] = (unsigned)((h * 128 + R[i]) * 1024 + C[i]) * 2u;
    }
};
struct MoeU { const char* A; const char* B; int row0, nrows, pn; };
struct MoeGUSched {
    typedef MoeU U;
    const char* H2; const char* W; const int* tile; const int* slot_tok; int G, c;
    __device__ __forceinline__ bool next(int i, U& u) const {
        const int nt = tile[3 * NTILE_MAX]; const int L = i * G + c; if (L >= nt * 4) return false;
        const int t = L >> 2; u.pn = L & 3; const int e = tile[t]; u.row0 = tile[NTILE_MAX + t]; u.nrows = tile[2 * NTILE_MAX + t];
        u.A = H2; u.B = W + ((size_t)e * 1024 + u.pn * 256) * 2048; return true;
    }
    __device__ __forceinline__ void aoffs(const U& u, const int (&R)[2], const int (&C)[2], unsigned (&v)[4]) const {
#pragma unroll
        for (int h = 0; h < 2; ++h)
#pragma unroll
            for (int i = 0; i < 2; ++i) { int r = h * 128 + R[i]; r = r < u.nrows ? r : u.nrows - 1; const int tok = slot_tok[u.row0 + r]; v[h * 2 + i] = (unsigned)(tok * 1024 + C[i]) * 2u; }
    }
};
struct MoeDownSched {
    typedef MoeU U;
    const char* ACT; const char* W; const int* tile; int G, c;
    __device__ __forceinline__ bool next(int i, U& u) const {
        const int nt = tile[3 * NTILE_MAX]; const int L = i * G + c; if (L >= nt * 8) return false;
        const int t = L >> 3; u.pn = L & 7; const int e = tile[t]; u.row0 = tile[NTILE_MAX + t]; u.nrows = tile[2 * NTILE_MAX + t];
        u.A = ACT + (size_t)u.row0 * 512; u.B = W + ((size_t)e * 2048 + u.pn * 256) * 512; return true;
    }
    __device__ __forceinline__ void aoffs(const U&, const int (&R)[2], const int (&C)[2], unsigned (&v)[4]) const {
#pragma unroll
        for (int h = 0; h < 2; ++h)
#pragma unroll
            for (int i = 0; i < 2; ++i) v[h * 2 + i] = (unsigned)((h * 128 + R[i]) * 256 + C[i]) * 2u;
    }
};

constexpr float SC_W = 256.f, SC_H = 16.f, SC_A = 16.f, SC_Y = 8.f;
__device__ __forceinline__ unsigned pk4_fp8(float a, float b, float c, float d) {
    a = fminf(fmaxf(a, -448.f), 448.f); b = fminf(fmaxf(b, -448.f), 448.f); c = fminf(fmaxf(c, -448.f), 448.f); d = fminf(fmaxf(d, -448.f), 448.f);
    unsigned w = 0; w = __builtin_amdgcn_cvt_pk_fp8_f32(a, b, w, false); w = __builtin_amdgcn_cvt_pk_fp8_f32(c, d, w, true); return w;
}
struct EpiIn {
    static constexpr int PERMK = 1; static constexpr bool PROBE2 = false;
    unsigned char* ws;
    __device__ __forceinline__ void operator()(const f32x4 (&acc)[2][2][4][2], const DenseU& u, int wr, int wc, int fr, int fq) const {
        const int pn = u.pn; const int row0 = u.pm * 256 + wr * 64 + fr;
        if (pn == 16) {
            if (wc != 0) return;
            float* alr = (float*)(ws + RA_ALR);
#pragma unroll
            for (int ai = 0; ai < 2; ++ai)
#pragma unroll
                for (int m = 0; m < 4; ++m) { float* rp = alr + (size_t)(row0 + ai * 128 + m * 16) * 32 + 8 * fq;
                    *(f32x4*)(rp) = acc[ai][0][m][0]; *(f32x4*)(rp + 4) = acc[ai][0][m][1]; }
            return;
        }
        bf16* base; int ld, colt; bool lat_only;
        if (pn < 2) { base = (bf16*)(ws + RA_Q); ld = 512; colt = pn * 256; lat_only = true; }
        else if (pn < 4) { base = (bf16*)(ws + RA_K); ld = 512; colt = (pn - 2) * 256; lat_only = false; }
        else if (pn < 8) { base = (bf16*)(ws + RA_V); ld = 1024; colt = (pn - 4) * 256; lat_only = false; }
        else if (pn < 12) { base = (bf16*)(ws + RA_R); ld = 1024; colt = (pn - 8) * 256; lat_only = true; }
        else { base = (bf16*)(ws + RA_P); ld = 1024; colt = (pn - 12) * 256; lat_only = true; }
        if (lat_only && u.pm >= 64) return;
        const int col0 = colt + wc * 32 + 8 * fq;
#pragma unroll
        for (int ai = 0; ai < 2; ++ai)
#pragma unroll
            for (int m = 0; m < 4; ++m) { bf16* rp = base + (size_t)(row0 + ai * 128 + m * 16) * ld + col0;
#pragma unroll
                for (int bj = 0; bj < 2; ++bj) { const f32x4 v0 = acc[ai][bj][m][0], v1 = acc[ai][bj][m][1];
                    v4u o; o.x = pg8::cvt_pk_bf16(v0[0], v0[1]); o.y = pg8::cvt_pk_bf16(v0[2], v0[3]); o.z = pg8::cvt_pk_bf16(v1[0], v1[1]); o.w = pg8::cvt_pk_bf16(v1[2], v1[3]);
                    *(v4u*)(rp + bj * 128) = o; } }
    }
};
struct EpiPool {
    static constexpr int PERMK = 1; static constexpr bool PROBE2 = false;
    unsigned char* ymix; const float* scale;
    __device__ __forceinline__ void operator()(const f32x4 (&acc)[2][2][4][2], const PoolU& u, int wr, int wc, int fr, int fq) const {
        const int row0 = u.pm * 256 + wr * 64 + fr; const int c0 = u.g * 256 + wc * 32 + 8 * fq;
#pragma unroll
        for (int ai = 0; ai < 2; ++ai)
#pragma unroll
            for (int m = 0; m < 4; ++m) { unsigned char* rp = ymix + (size_t)(row0 + ai * 128 + m * 16) * 2048 + 1024 + c0;
#pragma unroll
                for (int bj = 0; bj < 2; ++bj) { const f32x4 s0 = *(const f32x4*)(scale + c0 + bj * 128) * SC_Y, s1 = *(const f32x4*)(scale + c0 + bj * 128 + 4) * SC_Y;
                    const f32x4 v0 = acc[ai][bj][m][0] * s0, v1 = acc[ai][bj][m][1] * s1;
                    v2u o; o.x = pk4_fp8(v0[0], v0[1], v0[2], v0[3]); o.y = pk4_fp8(v1[0], v1[1], v1[2], v1[3]);
                    *(v2u*)(rp + bj * 128) = o; } }
    }
};
struct EpiOut {
    static constexpr int PERMK = 1; static constexpr bool PROBE2 = false;
    bf16* y;
    __device__ __forceinline__ void operator()(const f32x4 (&acc)[2][2][4][2], const DenseU& u, int wr, int wc, int fr, int fq) const {
        const int row0 = u.pm * 256 + wr * 64 + fr, col0 = u.pn * 256 + wc * 32 + 8 * fq;
#pragma unroll
        for (int ai = 0; ai < 2; ++ai)
#pragma unroll
            for (int m = 0; m < 4; ++m) { bf16* rp = y + (size_t)(row0 + ai * 128 + m * 16) * 2048 + col0;
#pragma unroll
                for (int bj = 0; bj < 2; ++bj) { constexpr float inv = 1.f / (SC_W * SC_Y); const f32x4 v0 = acc[ai][bj][m][0] * inv, v1 = acc[ai][bj][m][1] * inv;
                    v4u o; o.x = pg8::cvt_pk_bf16(v0[0], v0[1]); o.y = pg8::cvt_pk_bf16(v0[2], v0[3]); o.z = pg8::cvt_pk_bf16(v1[0], v1[1]); o.w = pg8::cvt_pk_bf16(v1[2], v1[3]);
                    *(v4u*)(rp + bj * 128) = o; } }
    }
};
struct EpiGU {
    static constexpr int PERMK = 1; static constexpr bool PROBE2 = false;
    unsigned char* act; const float* slot_w;
    __device__ __forceinline__ void operator()(const f32x4 (&acc)[2][2][4][2], const MoeU& u, int wr, int wc, int fr, int fq) const {
        const int c0 = u.pn * 128 + wc * 32 + 8 * fq; constexpr float inv = 1.f / (SC_W * SC_H);
#pragma unroll
        for (int ai = 0; ai < 2; ++ai)
#pragma unroll
            for (int m = 0; m < 4; ++m) { const int r = ai * 128 + wr * 64 + m * 16 + fr;
                if (r < u.nrows) { const float w = slot_w[u.row0 + r] * SC_A; float o[8];
#pragma unroll
                    for (int n = 0; n < 2; ++n)
#pragma unroll
                        for (int j = 0; j < 4; ++j) { const float g = acc[ai][0][m][n][j] * inv, up = acc[ai][1][m][n][j] * inv; o[n * 4 + j] = silu_f(g) * up * w; }
                    v2u q; q.x = pk4_fp8(o[0], o[1], o[2], o[3]); q.y = pk4_fp8(o[4], o[5], o[6], o[7]);
                    *(v2u*)(act + (size_t)(u.row0 + r) * 512 + c0) = q; } }
    }
};
constexpr float SC_O = 32.f;
struct EpiDown {
    static constexpr int PERMK = 2; static constexpr bool PROBE2 = true;
    unsigned char* so;
    __device__ __forceinline__ void operator()(const f32x4 (&acc)[2][2][4][2], const MoeU& u, int wr, int wc, int fr, int fq) const {
        const int c0 = u.pn * 256 + wc * 64 + 16 * fq; constexpr float sc = SC_O / (SC_W * SC_A);
#pragma unroll
        for (int ai = 0; ai < 2; ++ai)
#pragma unroll
            for (int m = 0; m < 4; ++m) { const int r = ai * 128 + wr * 64 + m * 16 + fr;
                if (r < u.nrows) { const f32x4 a0 = acc[ai][0][m][0] * sc, a1 = acc[ai][0][m][1] * sc, b0 = acc[ai][1][m][0] * sc, b1 = acc[ai][1][m][1] * sc;
                    v4u o; o.x = pk4_fp8(a0[0], a0[1], a0[2], a0[3]); o.y = pk4_fp8(a1[0], a1[1], a1[2], a1[3]); o.z = pk4_fp8(b0[0], b0[1], b0[2], b0[3]); o.w = pk4_fp8(b1[0], b1[1], b1[2], b1[3]);
                    __builtin_nontemporal_store(o, (v4u*)(so + (size_t)(u.row0 + r) * 2048 + c0)); } }
    }
};

__device__ __forceinline__ void tr_item(const float* W, int ldn, bf16* WT, int Kd, int drow0, int k0, int n0, LAS float* scr, int lane) {
    f32x4 t[8];
#pragma unroll
    for (int i = 0; i < 8; ++i) t[i] = __builtin_nontemporal_load((const f32x4*)(W + (size_t)(k0 + 8 * i + (lane >> 3)) * ldn + n0 + 4 * (lane & 7)));
#pragma unroll
    for (int i = 0; i < 8; ++i) { LAS float* d = scr + (8 * i + (lane >> 3)) * 33 + 4 * (lane & 7); d[0] = t[i][0]; d[1] = t[i][1]; d[2] = t[i][2]; d[3] = t[i][3]; }
    LDS_WAIT(); asm volatile("" ::: "memory");
    const int c = lane & 7;
#pragma unroll
    for (int j = 0; j < 4; ++j) { const int n = (lane >> 3) + 8 * j; const LAS float* s = scr + (8 * c) * 33 + n;
        v4u o; o.x = pk2(s[0 * 33], s[1 * 33]); o.y = pk2(s[2 * 33], s[3 * 33]); o.z = pk2(s[4 * 33], s[5 * 33]); o.w = pk2(s[6 * 33], s[7 * 33]);
        *(v4u*)(WT + (size_t)(drow0 + n) * Kd + k0 + 8 * c) = o; }
    LDS_WAIT(); asm volatile("" ::: "memory");
}

__device__ __forceinline__ void tr_item8(const float* W, int ldn, unsigned char* WT, int Kd, int drow0, int k0, int n0, LAS float* scr, int lane) {
    f32x4 t[8];
#pragma unroll
    for (int i = 0; i < 8; ++i) t[i] = __builtin_nontemporal_load((const f32x4*)(W + (size_t)(k0 + 8 * i + (lane >> 3)) * ldn + n0 + 4 * (lane & 7)));
#pragma unroll
    for (int i = 0; i < 8; ++i) { LAS float* d = scr + (8 * i + (lane >> 3)) * 33 + 4 * (lane & 7); d[0] = t[i][0]; d[1] = t[i][1]; d[2] = t[i][2]; d[3] = t[i][3]; }
    LDS_WAIT(); asm volatile("" ::: "memory");
    const int c = lane & 7;
#pragma unroll
    for (int j = 0; j < 4; ++j) { const int n = (lane >> 3) + 8 * j; const LAS float* s = scr + (8 * c) * 33 + n;
        v2u o; o.x = pk4_fp8(s[0 * 33] * SC_W, s[1 * 33] * SC_W, s[2 * 33] * SC_W, s[3 * 33] * SC_W); o.y = pk4_fp8(s[4 * 33] * SC_W, s[5 * 33] * SC_W, s[6 * 33] * SC_W, s[7 * 33] * SC_W);
        *(v2u*)(WT + (size_t)(drow0 + n) * Kd + k0 + 8 * c) = o; }
    LDS_WAIT(); asm volatile("" ::: "memory");
}

constexpr int I_IN = 32 * 129, I_OUT = 32 * 64, I_POOL = 4 * 4 * 8, I_E = 65 * 512;
constexpr int NITEMS = I_IN + I_OUT + I_POOL + 3 * I_E;
#ifndef N_DOWN_EARLY_
#define N_DOWN_EARLY_ 8192
#endif
constexpr int N_DOWN_EARLY = N_DOWN_EARLY_;
constexpr int NITEMS_P0 = NITEMS - 33280;
__device__ __forceinline__ void convert_items(const Args& a, LAS float* scr, int lane, int first, int step, int end, int skip = 0) {
    unsigned char* ws = a.ws;
    bf16* Win_t = (bf16*)(ws + WS_WIN); unsigned char* Wout_t = ws + WS_WOUT; bf16* Wpool_t = (bf16*)(ws + WS_WPOOL); unsigned char* Wd_t = ws + WS_WD; unsigned char* Wgu_t = ws + WS_WGU;
    for (int it = first; it < end; it += step) {
        int r = it < I_IN + I_OUT + I_POOL ? it : it + skip;
        if (r < I_IN) { const int kb = r / 129, nb = r % 129, n0 = 32 * nb; const int drow = n0 < 3072 ? n0 : (n0 == 3072 ? 4096 : n0 - 32);
            tr_item(a.in[10], DIN, Win_t, 2048, drow, 64 * kb, n0, scr, lane); continue; } r -= I_IN;
        if (r < I_OUT) { const int kb = r / 64, nb = r % 64; tr_item8(a.in[18], 2048, Wout_t, 2048, 32 * nb, 64 * kb, 32 * nb, scr, lane); continue; } r -= I_OUT;
        if (r < I_POOL) { const int g = r / 32, rr = r % 32, kb = rr / 8, nb = rr % 8; tr_item(a.in[16] + g * 65536, 256, Wpool_t + g * 65536, 256, 32 * nb, 64 * kb, 32 * nb, scr, lane); continue; } r -= I_POOL;
        if (r < I_E) { const int e = r / 512, rr = r % 512, kb = rr / 16, nb = rr % 16, n0 = 32 * nb; const float* src = e < 64 ? a.in[21] + (size_t)e * 2048 * 512 : a.in[24];
            tr_item8(src, 512, Wgu_t + (size_t)e * 1024 * 2048, 2048, (n0 / 128) * 256 + (n0 % 128), 64 * kb, n0, scr, lane); continue; } r -= I_E;
        if (r < I_E) { const int e = r / 512, rr = r % 512, kb = rr / 16, nb = rr % 16, n0 = 32 * nb; const float* src = e < 64 ? a.in[22] + (size_t)e * 2048 * 512 : a.in[25];
            tr_item8(src, 512, Wgu_t + (size_t)e * 1024 * 2048, 2048, (n0 / 128) * 256 + 128 + (n0 % 128), 64 * kb, n0, scr, lane); continue; } r -= I_E;
        { const int e = 64 - r / 512, rr = r % 512, kb = rr / 64, nb = rr % 64; const float* src = e < 64 ? a.in[23] + (size_t)e * 512 * 2048 : a.in[26];
            tr_item8(src, 2048, Wd_t + (size_t)e * 2048 * 512, 512, 32 * nb, 64 * kb, 32 * nb, scr, lane); }
    }
}

__device__ __forceinline__ void phase0(const Args& a, LAS unsigned char* lds, int tid, int lane, int wave, int vcu, int G, bool do_mod = true, bool do_tr = true) {
    unsigned char* ws = a.ws;
    if (vcu < 192 && do_mod) {
        LAS float* sc = (LAS float*)lds;
        LAS float* red = (LAS float*)(lds + 73728);
        for (int i = tid; i < 9 * 2048; i += 512) { const int r = i >> 11, k = i & 2047; const float v = r < 8 ? a.in[1][r * 2048 + k] : a.in[3][k]; sc[i] = silu_f(v); }
        __syncthreads();
        const float* wm = a.in[4]; const float* bm = a.in[5]; float* mod = (float*)(ws + WS_MOD);
        for (int chunk = vcu; chunk < 192; chunk += G) {
            const int n0 = chunk * 64, ks = lane >> 4, n4 = (lane & 15) * 4;
            f32x4 acc[9];
#pragma unroll
            for (int r = 0; r < 9; ++r) acc[r] = (f32x4){0.f, 0.f, 0.f, 0.f};
#pragma unroll 4
            for (int kk = 0; kk < 256; kk += 4) { const int k = wave * 256 + kk + ks; const f32x4 wv = __builtin_nontemporal_load((const f32x4*)(wm + (size_t)k * 12288 + n0 + n4));
#pragma unroll
                for (int r = 0; r < 9; ++r) { const float s = sc[r * 2048 + k]; acc[r] += wv * s; } }
#pragma unroll
            for (int r = 0; r < 9; ++r)
#pragma unroll
                for (int j = 0; j < 4; ++j) { float v = acc[r][j]; v += __shfl_xor(v, 16); v += __shfl_xor(v, 32); acc[r][j] = v; }
            if (lane < 16) {
#pragma unroll
                for (int r = 0; r < 9; ++r) *(LAS f32x4*)(red + (wave * 9 + r) * 64 + n4) = acc[r]; }
            __syncthreads();
            for (int i = tid; i < 9 * 64; i += 512) { const int r = i >> 6, n = i & 63; float s = 0.f;
#pragma unroll
                for (int w = 0; w < 8; ++w) s += red[(w * 9 + r) * 64 + n];
                mod[r * 12288 + n0 + n] = s + bm[n0 + n]; }
            __syncthreads();
        }
    }
    __syncthreads();
    if (do_tr) convert_items(a, (LAS float*)(lds + wave * 16384), lane, vcu * 8 + wave, G * 8, NITEMS_P0 - 2 * I_E, 2 * I_E);
    { const float* wr = a.in[19]; bf16* whi = (bf16*)(ws + WS_WRT); bf16* wlo = whi + 64 * 2048;
      for (int idx = vcu * 512 + tid; idx < 64 * 256; idx += G * 512) { const int e = idx >> 8, k8 = idx & 255; unsigned hi[8], lo[8];
#pragma unroll
          for (int j = 0; j < 8; ++j) { const float v = wr[(size_t)(8 * k8 + j) * 64 + e]; hi[j] = f2bf(v); lo[j] = f2bf(v - __builtin_bit_cast(float, hi[j] << 16)); }
          v4u oh, ol; oh.x = hi[0] | (hi[1] << 16); oh.y = hi[2] | (hi[3] << 16); oh.z = hi[4] | (hi[5] << 16); oh.w = hi[6] | (hi[7] << 16);
          ol.x = lo[0] | (lo[1] << 16); ol.y = lo[2] | (lo[3] << 16); ol.z = lo[4] | (lo[5] << 16); ol.w = lo[6] | (lo[7] << 16);
          *(v4u*)(whi + (size_t)e * 2048 + 8 * k8) = oh; (void)ol; (void)wlo; } }
    { v4u* z = (v4u*)((bf16*)(ws + WS_WIN) + (size_t)DIN * 2048); const int nz = (DINP - DIN) * 2048 / 8;
      for (int i = vcu * 512 + tid; i < nz; i += G * 512) z[i] = (v4u){0u, 0u, 0u, 0u}; }
}

__device__ __forceinline__ void phase1(const Args& a, int lane, int wave, int vcu, int G) {
    const float* mod = (const float*)(a.ws + WS_MOD); bf16* H = (bf16*)(a.ws + RA_H); const float* g = a.in[6];
    for (int m = vcu * 8 + wave; m < MROWS; m += G * 8) {
        const float* xr = m < NT ? a.in[0] + (size_t)m * 2048 : a.in[2] + (size_t)(m - NT) * 2048;
        const float* mr = mod + (size_t)(m < NT ? (m >> 11) : 8) * 12288;
        f32x4 v[8]; float ss = 0.f;
#pragma unroll
        for (int j = 0; j < 8; ++j) { v[j] = __builtin_nontemporal_load((const f32x4*)(xr + 4 * (lane + 64 * j))); ss += v[j][0] * v[j][0] + v[j][1] * v[j][1] + v[j][2] * v[j][2] + v[j][3] * v[j][3]; }
        const float rstd = rsqrtf(wave_sum(ss) * (1.f / 2048.f) + EPS);
#pragma unroll
        for (int j = 0; j < 8; ++j) { const int c = 4 * (lane + 64 * j); const f32x4 gg = *(const f32x4*)(g + c), sh = *(const f32x4*)(mr + c), sc = *(const f32x4*)(mr + 2048 + c);
            const f32x4 o = v[j] * rstd * gg * (sc + 1.f) + sh;
            v2u q; q.x = pk2(o[0], o[1]); q.y = pk2(o[2], o[3]); *(v2u*)(H + (size_t)m * 2048 + c) = q; }
    }
}

__device__ __forceinline__ int scan_row(int b, int dir, int s) {
    if (s < 256) { const int tc = dir ? 255 - s : s; return NT + b * 256 + tc; }
    const int t0 = s - 256; return b * 2048 + (dir ? 2047 - t0 : t0);
}
__device__ __forceinline__ void prep_item(const Args& a, LAS unsigned char* lds, int tid, int dir, int b, int ch) {
    unsigned char* ws = a.ws;
    const bf16* Q = (const bf16*)(ws + RA_Q); const bf16* Kb = (const bf16*)(ws + RA_K); const float* ALR = (const float*)(ws + RA_ALR);
    v4u* QG = (v4u*)(ws + PQG); bf16* AM = (bf16*)(ws + PAM); bf16* KD = (bf16*)(ws + PKD); float* DEC = (float*)(ws + PDEC);
    constexpr int TS = 520;
    LAS float* alr = (LAS float*)lds;
    LAS bf16* Kt = (LAS bf16*)(lds + 4096);
    LAS bf16* Qt = (LAS bf16*)(lds + 4096 + 64 * TS * 2);
    const int col = tid, h = col >> 7, dk = col & 127;
    const int lane = tid & 63, wave = __builtin_amdgcn_readfirstlane(tid >> 6), l15 = lane & 15, l4 = lane >> 4;
    const bool lat = ch >= 4;
    if (tid < 256) { const int i = tid >> 2, r4 = (tid & 3) * 4; const int row = scan_row(b, dir, ch * 64 + i);
        *(LAS f32x4*)(alr + i * 16 + r4) = *(const f32x4*)(ALR + (size_t)row * 32 + dir * 16 + r4); }
    { v4u kr[8], qr[8];
#pragma unroll
      for (int q = 0; q < 8; ++q) { const int p = tid + 512 * q, i = p >> 6, c8 = (p & 63) * 8; const int row = scan_row(b, dir, ch * 64 + i);
          kr[q] = *(const v4u*)(Kb + (size_t)row * 512 + c8); if (lat) qr[q] = *(const v4u*)(Q + (size_t)row * 512 + c8); }
#pragma unroll
      for (int q = 0; q < 8; ++q) { const int p = tid + 512 * q, i = p >> 6, c8 = (p & 63) * 8; *(LAS v4u*)(Kt + i * TS + c8) = kr[q]; if (lat) *(LAS v4u*)(Qt + i * TS + c8) = qr[q]; } }
    const float* wa2 = dir ? a.in[13] : a.in[11]; const float bia = (dir ? a.in[14] : a.in[12])[col];
    float w[16];
#pragma unroll
    for (int r = 0; r < 16; ++r) w[r] = wa2[r * 512 + col];
    LDS_BARRIER();
    float Gv[64]; float Gc = 0.f;
#pragma unroll
    for (int i = 0; i < 64; ++i) { float z = bia;
#pragma unroll
        for (int r4 = 0; r4 < 4; ++r4) { const f32x4 x = *(const LAS f32x4*)(alr + i * 16 + 4 * r4); z += x[0] * w[4 * r4] + x[1] * w[4 * r4 + 1] + x[2] * w[4 * r4 + 2] + x[3] * w[4 * r4 + 3]; }
        Gc += (fminf(z, 0.f) - __logf(1.f + __expf(-fabsf(z)))) * (1.f / 16.f); Gv[i] = Gc; }
    const float Gmid = Gv[32], Gend = Gv[63];
    DEC[((size_t)(dir * 8 + b) * 36 + ch) * 512 + col] = __expf(Gend);
    bf16* kdrow = KD + ((((size_t)(dir * 8 + b) * 36 + ch) * 4 + h) * 128 + dk) * 64;
#pragma unroll
    for (int i0 = 0; i0 < 64; i0 += 8) { unsigned kd[8];
#pragma unroll
        for (int ii = 0; ii < 8; ++ii) { const int i = i0 + ii; const float kv = bf1(Kt[i * TS + col]);
            kd[ii] = f2bf(kv * __expf(Gend - Gv[i]));
            if (lat) { const float qv = bf1(Qt[i * TS + col]) * 0.08838834764831845f;
                Qt[i * TS + col] = (bf16)f2bf(qv * __expf(Gv[i] - Gmid)); Kt[i * TS + col] = (bf16)f2bf(kv * __expf(Gmid - Gv[i])); } }
        v4u o; o.x = kd[0] | (kd[1] << 16); o.y = kd[2] | (kd[3] << 16); o.z = kd[4] | (kd[5] << 16); o.w = kd[6] | (kd[7] << 16);
        *(v4u*)(kdrow + i0) = o; }
    if (lat) {
        LDS_BARRIER();
        const int hh = wave >> 1; bf16* amt = AM + ((((size_t)(dir * 8 + b) * 32 + (ch - 4)) * 4 + hh) * 64) * 64;
#pragma unroll
        for (int t2 = 0; t2 < 2; ++t2) { const int ti = (wave & 1) * 2 + t2; f32x4 c[4];
#pragma unroll
            for (int tj = 0; tj < 4; ++tj) c[tj] = (f32x4){0.f, 0.f, 0.f, 0.f};
#pragma unroll
            for (int ks = 0; ks < 4; ++ks) { const int ko = hh * 128 + 32 * ks + 8 * l4;
                const bf16x8 bq = *(const LAS bf16x8*)(Qt + (16 * ti + l15) * TS + ko);
#pragma unroll
                for (int tj = 0; tj < 4; ++tj) { const bf16x8 ak = *(const LAS bf16x8*)(Kt + (16 * tj + l15) * TS + ko);
                    c[tj] = __builtin_amdgcn_mfma_f32_16x16x32_bf16(ak, bq, c[tj], 0, 0, 0); } }
            const int i = 16 * ti + l15;
#pragma unroll
            for (int tj = 0; tj < 4; ++tj) { const int j0 = 16 * tj + 4 * l4;
                v2u p; p.x = pk2(j0 <= i ? c[tj][0] : 0.f, j0 + 1 <= i ? c[tj][1] : 0.f); p.y = pk2(j0 + 2 <= i ? c[tj][2] : 0.f, j0 + 3 <= i ? c[tj][3] : 0.f);
                *(v2u*)(amt + i * 64 + j0) = p; } }
        LDS_BARRIER();
        { const float eg = __expf(Gmid);
#pragma unroll 8
          for (int i = 0; i < 64; ++i) Qt[i * TS + col] = (bf16)f2bf(bf1(Qt[i * TS + col]) * eg); }
        LDS_BARRIER();
        { v4u* qgt = QG + ((((size_t)(dir * 8 + b) * 32 + (ch - 4)) * 4) * 1024);
#pragma unroll
          for (int q = 0; q < 8; ++q) { const int p = tid + 512 * q; const int hq = p >> 10, rem = p & 1023, i = rem >> 4, c16 = rem & 15;
              qgt[p] = *(const LAS v4u*)(Qt + i * TS + hq * 128 + c16 * 8); } }
    }
    LDS_BARRIER();
}
__device__ __forceinline__ void phase3_prep(const Args& a, LAS unsigned char* lds, int tid, int vcu, int G) {
    for (int item = vcu; item < 2 * 8 * 32; item += G) { const int lc = item & 31, b = (item >> 5) & 7, dir = item >> 8; prep_item(a, lds, tid, dir, b, 4 + lc); }
    for (int item = vcu; item < 2 * 8 * 4; item += G) { const int cc = item & 3, b = (item >> 2) & 7, dir = item >> 5; prep_item(a, lds, tid, dir, b, cc); }
}

struct ConvItem { const float* src; unsigned char* dst; int drow, k0, n0, lds, ldd; };
constexpr int N_DOWN_CHAIN = 36 * 2048 - 2 * I_E;
__device__ __forceinline__ ConvItem conv_decode(const Args& a, int id) {
    ConvItem c;
    if (id >= 2 * I_E) {
        const int r = (id - 2 * I_E) % N_DOWN_CHAIN; const int e = 64 - r / 512, rr = r % 512, kb = rr / 64, nb = rr % 64;
        c.n0 = 32 * nb; c.k0 = 64 * kb; c.src = e < 64 ? a.in[23] + (size_t)e * 512 * 2048 : a.in[26]; c.dst = a.ws + WS_WD + (size_t)e * 2048 * 512; c.drow = c.n0; c.lds = 2048; c.ldd = 512; return c; }
    const int up = id >= I_E ? 1 : 0; const int r = id - up * I_E; const int e = r / 512, rr = r % 512, kb = rr / 16, nb = rr % 16;
    c.n0 = 32 * nb; c.k0 = 64 * kb; c.lds = 512; c.ldd = 2048;
    c.src = e < 64 ? a.in[21 + up] + (size_t)e * 2048 * 512 : a.in[24 + up];
    c.dst = a.ws + WS_WGU + (size_t)e * 1024 * 2048; c.drow = (c.n0 / 128) * 256 + up * 128 + (c.n0 % 128); return c;
}
__device__ __forceinline__ void conv_load(f32x4 (&t)[8], const ConvItem& c, int lane) {
#pragma unroll
    for (int i = 0; i < 8; ++i) t[i] = __builtin_nontemporal_load((const f32x4*)(c.src + (size_t)(c.k0 + 8 * i + (lane >> 3)) * c.lds + c.n0 + 4 * (lane & 7)));
}
__device__ __forceinline__ void conv_finish(const f32x4 (&t)[8], const ConvItem& c, LAS float* scr, int lane) {
#pragma unroll
    for (int i = 0; i < 8; ++i) { LAS float* d = scr + (8 * i + (lane >> 3)) * 33 + 4 * (lane & 7); d[0] = t[i][0]; d[1] = t[i][1]; d[2] = t[i][2]; d[3] = t[i][3]; }
    LDS_WAIT(); asm volatile("" ::: "memory");
    const int cc = lane & 7;
#pragma unroll
    for (int j = 0; j < 4; ++j) { const int n = (lane >> 3) + 8 * j; const LAS float* sp = scr + (8 * cc) * 33 + n;
        v2u o; o.x = pk4_fp8(sp[0 * 33] * SC_W, sp[1 * 33] * SC_W, sp[2 * 33] * SC_W, sp[3 * 33] * SC_W); o.y = pk4_fp8(sp[4 * 33] * SC_W, sp[5 * 33] * SC_W, sp[6 * 33] * SC_W, sp[7 * 33] * SC_W);
        __builtin_nontemporal_store(o, (v2u*)(c.dst + (size_t)(c.drow + n) * c.ldd + c.k0 + 8 * cc)); }
    LDS_WAIT(); asm volatile("" ::: "memory");
}
constexpr int GL_CONV = 73728;
constexpr int GL_QG = 0, GL_ST = 17408, GL_KDT = 34816, GL_VT = 53248, GL_AM = 62464, GL_DEC = 71680;
__device__ __forceinline__ void phase_chain(const Args& a, LAS unsigned char* lds, int tid, int lane, int wave, int vcu, int G) {
    unsigned char* ws = a.ws;
    const v4u* QG = (const v4u*)(ws + PQG); const v4u* AM = (const v4u*)(ws + PAM); const v4u* KD = (const v4u*)(ws + PKD); const float* DEC = (const float*)(ws + PDEC);
    const bf16* V = (const bf16*)(ws + RA_V); bf16* OF = (bf16*)(ws + RA_OF);
    const int l15 = lane & 15, l4 = lane >> 4;
    int cstep = 0;
    for (int item = vcu; item < 256; item += G) {
        const int vs = item & 3, dir = (item >> 2) & 1, h = (item >> 3) & 3, b = item >> 5;
        f32x4 S[4];
#pragma unroll
        for (int tv = 0; tv < 4; ++tv) S[tv] = (f32x4){0.f, 0.f, 0.f, 0.f};
        v4u rq[2], ra, rk[2], rv; float rdec = 0.f; f32x4 ct[8]; ConvItem ci;
#define GL_LOAD(ch_, LATL) do { const int ch__ = (ch_); \
            if (LATL) { const size_t t_ = ((((size_t)(dir * 8 + b) * 32 + (ch__ - 4)) * 4 + h) * 1024); rq[0] = QG[t_ + tid]; rq[1] = QG[t_ + tid + 512]; ra = AM[t_ / 2 + tid]; } \
            { const size_t t_ = ((((size_t)(dir * 8 + b) * 36 + ch__) * 4 + h) * 1024); rk[0] = KD[t_ + tid]; rk[1] = KD[t_ + tid + 512]; } \
            { const int row_ = scan_row(b, dir, ch__ * 64 + (tid >> 3)); rv = *(const v4u*)(V + (size_t)row_ * 1024 + h * 256 + vs * 64 + 8 * (tid & 7)); } \
            rdec = DEC[((size_t)(dir * 8 + b) * 36 + ch__) * 512 + h * 128 + (tid & 127)]; } while (0)
#define GL_STEP(ch_, LAT, LATN, MORE) do { const int ch = (ch_); \
              \
            _Pragma("unroll") for (int tv = 0; tv < 4; ++tv) { v2u p; p.x = pk2(S[tv][0], S[tv][1]); p.y = pk2(S[tv][2], S[tv][3]); \
                *(LAS v2u*)(lds + GL_ST + (16 * tv + l15) * 272 + (16 * wave + 4 * l4) * 2) = p; } \
            if (LAT) { _Pragma("unroll") for (int q = 0; q < 2; ++q) { const int p = tid + 512 * q; *(LAS v4u*)(lds + GL_QG + (p >> 4) * 272 + (p & 15) * 16) = rq[q]; } \
                *(LAS v4u*)(lds + GL_AM + (tid >> 3) * 144 + (tid & 7) * 16) = ra; } \
            _Pragma("unroll") for (int q = 0; q < 2; ++q) { const int p = tid + 512 * q; *(LAS v4u*)(lds + GL_KDT + (p >> 3) * 144 + (p & 7) * 16) = rk[q]; } \
            { const int i = tid >> 3, c = tid & 7; LAS bf16* vt = (LAS bf16*)(lds + GL_VT) + i; \
              vt[(8 * c + 0) * 72] = (bf16)(rv.x & 0xffffu); vt[(8 * c + 1) * 72] = (bf16)(rv.x >> 16); vt[(8 * c + 2) * 72] = (bf16)(rv.y & 0xffffu); vt[(8 * c + 3) * 72] = (bf16)(rv.y >> 16); \
              vt[(8 * c + 4) * 72] = (bf16)(rv.z & 0xffffu); vt[(8 * c + 5) * 72] = (bf16)(rv.z >> 16); vt[(8 * c + 6) * 72] = (bf16)(rv.w & 0xffffu); vt[(8 * c + 7) * 72] = (bf16)(rv.w >> 16); } \
            if (tid < 128) *(LAS float*)(lds + GL_DEC + tid * 4) = rdec; \
            LDS_BARRIER(); \
            if (MORE) GL_LOAD(ch + 1, LATN); \
            if (LAT) {   \
                const int ti = wave >> 1, tv0 = (wave & 1) * 2; f32x4 c0 = (f32x4){0.f, 0.f, 0.f, 0.f}, c1 = c0; bf16x8 fb[6], f0[6], f1[6]; \
                _Pragma("unroll") for (int ks = 0; ks < 4; ++ks) { const int ko = (32 * ks + 8 * l4) * 2; \
                    fb[ks] = *(const LAS bf16x8*)(lds + GL_QG + (16 * ti + l15) * 272 + ko); \
                    f0[ks] = *(const LAS bf16x8*)(lds + GL_ST + (16 * tv0 + l15) * 272 + ko); f1[ks] = *(const LAS bf16x8*)(lds + GL_ST + (16 * tv0 + 16 + l15) * 272 + ko); } \
                _Pragma("unroll") for (int ks = 0; ks < 2; ++ks) { const int ko = (32 * ks + 8 * l4) * 2; \
                    fb[4 + ks] = *(const LAS bf16x8*)(lds + GL_AM + (16 * ti + l15) * 144 + ko); \
                    f0[4 + ks] = *(const LAS bf16x8*)(lds + GL_VT + (16 * tv0 + l15) * 144 + ko); f1[4 + ks] = *(const LAS bf16x8*)(lds + GL_VT + (16 * tv0 + 16 + l15) * 144 + ko); } \
                _Pragma("unroll") for (int ks = 0; ks < 6; ++ks) { c0 = __builtin_amdgcn_mfma_f32_16x16x32_bf16(f0[ks], fb[ks], c0, 0, 0, 0); c1 = __builtin_amdgcn_mfma_f32_16x16x32_bf16(f1[ks], fb[ks], c1, 0, 0, 0); } \
                const int s_ = ch * 64 + 16 * ti + l15; const int t0 = s_ - 256; const int t = dir ? 2047 - t0 : t0; \
                bf16* orow = OF + ((size_t)dir * NT + b * 2048 + t) * 1024 + h * 256 + vs * 64 + 16 * tv0 + 4 * l4; \
                v2u p0, p1; p0.x = pk2(c0[0], c0[1]); p0.y = pk2(c0[2], c0[3]); p1.x = pk2(c1[0], c1[1]); p1.y = pk2(c1[2], c1[3]); \
                *(v2u*)(orow) = p0; *(v2u*)(orow + 16) = p1; } \
              \
            { const f32x4 d4 = *(const LAS f32x4*)(lds + GL_DEC + (16 * wave + 4 * l4) * 4); bf16x8 fk[2], fv[2][4]; \
              _Pragma("unroll") for (int ks = 0; ks < 2; ++ks) { const int ko = (32 * ks + 8 * l4) * 2; fk[ks] = *(const LAS bf16x8*)(lds + GL_KDT + (16 * wave + l15) * 144 + ko); \
                  _Pragma("unroll") for (int tv = 0; tv < 4; ++tv) fv[ks][tv] = *(const LAS bf16x8*)(lds + GL_VT + (16 * tv + l15) * 144 + ko); } \
              _Pragma("unroll") for (int tv = 0; tv < 4; ++tv) S[tv] = S[tv] * d4; \
              _Pragma("unroll") for (int ks = 0; ks < 2; ++ks) \
                  _Pragma("unroll") for (int tv = 0; tv < 4; ++tv) S[tv] = __builtin_amdgcn_mfma_f32_16x16x32_bf16(fk[ks], fv[ks][tv], S[tv], 0, 0, 0); } \
              \
            conv_finish(ct, ci, (LAS float*)(lds + GL_CONV + wave * 8448), lane); ++cstep; ci = conv_decode(a, cstep * (G * 8) + vcu * 8 + wave); conv_load(ct, ci, lane); \
            LDS_BARRIER(); } while (0)
        ci = conv_decode(a, cstep * (G * 8) + vcu * 8 + wave); conv_load(ct, ci, lane);
        GL_LOAD(0, false);
        GL_STEP(0, false, false, true); GL_STEP(1, false, false, true); GL_STEP(2, false, false, true); GL_STEP(3, false, true, true);
#pragma unroll 1
        for (int c2 = 4; c2 < 35; ++c2) { GL_STEP(c2, true, true, true); }
        GL_STEP(35, true, true, false);
#undef GL_STEP
#undef GL_LOAD
    }
    for (int id = cstep * (G * 8) + vcu * 8 + wave; id < 2 * I_E; id += G * 8) { const ConvItem c = conv_decode(a, id); f32x4 t[8]; conv_load(t, c, lane); conv_finish(t, c, (LAS float*)(lds + GL_CONV + wave * 8448), lane); }
}

template <int HALFW>
__device__ __forceinline__ void pool_item(const bf16* P, bf16* DP, LAS float* tmp, int tid, int b, int r, int g) {
    const int rlo = r - HALFW < 0 ? 0 : r - HALFW, rhi = r + HALFW > 32 ? 32 : r + HALFW;
    const float rinv = 1.f / (float)(rhi - rlo);
#pragma unroll 1
    for (int q = 0; q < 4; ++q) { const int p = tid + 512 * q, c = p >> 5, ch0 = (p & 31) * 8; float acc[8]; v4u x[2 * HALFW];
#pragma unroll
        for (int u = 0; u < 2 * HALFW; ++u) { const int rr = (rlo + u < rhi) ? rlo + u : rlo; x[u] = *(const v4u*)(P + ((size_t)(b * 2048 + rr * 64 + c)) * 1024 + g * 256 + ch0); }
#pragma unroll
        for (int j = 0; j < 8; ++j) acc[j] = 0.f;
#pragma unroll
        for (int u = 0; u < 2 * HALFW; ++u) { const float m = (rlo + u < rhi) ? 1.f : 0.f;
            acc[0] += m * bflo(x[u].x); acc[1] += m * bfhi(x[u].x); acc[2] += m * bflo(x[u].y); acc[3] += m * bfhi(x[u].y); acc[4] += m * bflo(x[u].z); acc[5] += m * bfhi(x[u].z); acc[6] += m * bflo(x[u].w); acc[7] += m * bfhi(x[u].w); }
        *(LAS f32x4*)(tmp + c * 256 + ch0) = (f32x4){acc[0] * rinv, acc[1] * rinv, acc[2] * rinv, acc[3] * rinv};
        *(LAS f32x4*)(tmp + c * 256 + ch0 + 4) = (f32x4){acc[4] * rinv, acc[5] * rinv, acc[6] * rinv, acc[7] * rinv}; }
    __syncthreads();
#pragma unroll 1
    for (int q = 0; q < 4; ++q) { const int p = tid + 512 * q, c = p >> 5, ch0 = (p & 31) * 8;
        const int clo = c - HALFW < 0 ? 0 : c - HALFW, chi = c + HALFW > 64 ? 64 : c + HALFW; const float cinv = 1.f / (float)(chi - clo);
        const size_t o = ((size_t)(b * 2048 + r * 64 + c)) * 1024 + g * 256 + ch0;
        const v4u x = *(const v4u*)(P + o);
        f32x4 a0 = (f32x4){0.f, 0.f, 0.f, 0.f}, a1 = a0;
#pragma unroll
        for (int u = 0; u < 2 * HALFW; ++u) { const int cc = (clo + u < chi) ? clo + u : clo; const float m = (clo + u < chi) ? 1.f : 0.f;
            a0 += *(const LAS f32x4*)(tmp + cc * 256 + ch0) * m; a1 += *(const LAS f32x4*)(tmp + cc * 256 + ch0 + 4) * m; }
        v4u d; d.x = pk2(a0[0] * cinv - bflo(x.x), a0[1] * cinv - bfhi(x.x)); d.y = pk2(a0[2] * cinv - bflo(x.y), a0[3] * cinv - bfhi(x.y));
        d.z = pk2(a1[0] * cinv - bflo(x.z), a1[1] * cinv - bfhi(x.z)); d.w = pk2(a1[2] * cinv - bflo(x.w), a1[3] * cinv - bfhi(x.w));
        *(v4u*)(DP + o) = d; }
    __syncthreads();
}
__device__ __forceinline__ void phase3_pool(const Args& a, LAS unsigned char* lds, int tid, int vcu, int G) {
    const bf16* P = (const bf16*)(a.ws + RA_P); bf16* DP = (bf16*)(a.ws + RA_DPOOL);
    LAS float* tmp = (LAS float*)lds;
    for (int item = vcu; item < 1024; item += G) {
        const int g = item >> 8, r = (item >> 3) & 31, b = item & 7;
        const int gg = 3 - g;
        if (gg == 0) pool_item<1>(P, DP, tmp, tid, b, r, gg); else if (gg == 1) pool_item<2>(P, DP, tmp, tid, b, r, gg); else if (gg == 2) pool_item<4>(P, DP, tmp, tid, b, r, gg); else pool_item<8>(P, DP, tmp, tid, b, r, gg);
    }
}

__device__ __forceinline__ void phase4_post(const Args& a, int lane, int wave, int vcu, int G) {
    const bf16* OF = (const bf16*)(a.ws + RA_OF); const bf16* OB = OF + (size_t)NT * 1024; const bf16* Rr = (const bf16*)(a.ws + RA_R); unsigned char* Y = a.ws + RA_YMIX;
    const float* gn = a.in[15];
    f32x4 g4[4];
#pragma unroll
    for (int q = 0; q < 4; ++q) g4[q] = *(const f32x4*)(gn + 16 * lane + 4 * q);
#pragma unroll 2
    for (int t = vcu * 8 + wave; t < NT; t += G * 8) {
        const size_t o = (size_t)t * 1024 + 16 * lane;
        const v4u f0 = __builtin_nontemporal_load((const v4u*)(OF + o)), f1 = __builtin_nontemporal_load((const v4u*)(OF + o + 8)), b0 = __builtin_nontemporal_load((const v4u*)(OB + o)), b1 = __builtin_nontemporal_load((const v4u*)(OB + o + 8)), r0 = __builtin_nontemporal_load((const v4u*)(Rr + o)), r1 = __builtin_nontemporal_load((const v4u*)(Rr + o + 8));
        float x[16], r[16];
#pragma unroll
        for (int w = 0; w < 4; ++w) { x[2 * w] = bflo(f0[w]) + bflo(b0[w]); x[2 * w + 1] = bfhi(f0[w]) + bfhi(b0[w]); x[8 + 2 * w] = bflo(f1[w]) + bflo(b1[w]); x[8 + 2 * w + 1] = bfhi(f1[w]) + bfhi(b1[w]);
            r[2 * w] = bflo(r0[w]); r[2 * w + 1] = bfhi(r0[w]); r[8 + 2 * w] = bflo(r1[w]); r[8 + 2 * w + 1] = bfhi(r1[w]); }
        float ss = 0.f;
#pragma unroll
        for (int q = 0; q < 16; ++q) ss += x[q] * x[q];
        ss += __shfl_xor(ss, 1); ss += __shfl_xor(ss, 2); ss += __shfl_xor(ss, 4); ss += __shfl_xor(ss, 8);
        const float sc = rsqrtf(ss * (1.f / 256.f) + EPS);
        float y[16];
#pragma unroll
        for (int q = 0; q < 16; ++q) y[q] = x[q] * sc * g4[q >> 2][q & 3] * silu_f(r[q]);
        v4u o0;
#pragma unroll
        for (int w = 0; w < 4; ++w) o0[w] = pk4_fp8(y[4 * w] * SC_Y, y[4 * w + 1] * SC_Y, y[4 * w + 2] * SC_Y, y[4 * w + 3] * SC_Y);
        *(v4u*)(Y + (size_t)t * 2048 + 16 * lane) = o0;
    }
}

__device__ __forceinline__ void phase6(const Args& a, LAS unsigned char* lds, int tid, int lane, int wave, int vcu, int G) {
    unsigned char* ws = a.ws;
    const float* mod = (const float*)(ws + WS_MOD); const bf16* Y1 = (const bf16*)(ws + RA_Y1); bf16* X1 = (bf16*)(ws + RA_X1); unsigned char* H2 = ws + RA_H2;
    const float* gpost = a.in[7]; const float* gpre2 = a.in[8]; const float* rbias = a.in[20];
    const bf16* whi = (const bf16*)(ws + WS_WRT);
    LAS float* part = (LAS float*)lds;
    LAS float* logit = (LAS float*)(lds + LDS_LOGIT);
    LAS u64* masks = (LAS u64*)(lds + LDS_MASKS);
    int* cnt = (int*)(ws + T_CNT); u64* tmask = (u64*)(ws + T_MASK); float* tokw = (float*)(ws + T_TOKW);
    const int l15 = lane & 15, l4 = lane >> 4;
    for (int blk = vcu; blk < NT / 64; blk += G) {
        for (int it = 0; it < 2; ++it) {
#pragma unroll 1
            for (int rep_ = 0; rep_ < P7_REP_ROWS; ++rep_) {
#pragma unroll 1
            for (int rr = 0; rr < 4; ++rr) {
                const int lr = wave * 4 + rr, t = blk * 64 + it * 32 + lr; const float* mr = mod + (size_t)(t >> 11) * 12288;
                const bf16* yr = Y1 + (size_t)t * 2048; const float* xr = a.in[0] + (size_t)t * 2048;
                f32x4 y[8]; float ss = 0.f;
#pragma unroll
                for (int j = 0; j < 8; ++j) { const v2u yb = __builtin_nontemporal_load((const v2u*)(yr + 4 * (lane + 64 * j))); y[j] = (f32x4){bflo(yb.x), bfhi(yb.x), bflo(yb.y), bfhi(yb.y)}; ss += y[j][0] * y[j][0] + y[j][1] * y[j][1] + y[j][2] * y[j][2] + y[j][3] * y[j][3]; }
                const float rstd1 = rsqrtf(wave_sum(ss) * (1.f / 2048.f) + EPS);
                float s2 = 0.f;
#pragma unroll
                for (int j = 0; j < 8; ++j) { const int c = 4 * (lane + 64 * j); const f32x4 x = __builtin_nontemporal_load((const f32x4*)(xr + c)), gp = *(const f32x4*)(gpost + c), gt = *(const f32x4*)(mr + 4096 + c);
                    const f32x4 x1 = x + gt * (y[j] * rstd1 * gp); y[j] = x1;
                    v2u xb; xb.x = pk2(x1[0], x1[1]); xb.y = pk2(x1[2], x1[3]); __builtin_nontemporal_store(xb, (v2u*)(X1 + (size_t)t * 2048 + c));
                    s2 += x1[0] * x1[0] + x1[1] * x1[1] + x1[2] * x1[2] + x1[3] * x1[3]; }
                const float rstd2 = rsqrtf(wave_sum(s2) * (1.f / 2048.f) + EPS);
#pragma unroll
                for (int j = 0; j < 8; ++j) { const int c = 4 * (lane + 64 * j); const f32x4 g2 = *(const f32x4*)(gpre2 + c), sh = *(const f32x4*)(mr + 6144 + c), sc = *(const f32x4*)(mr + 8192 + c);
                    const f32x4 hh = y[j] * rstd2 * g2 * (sc + 1.f) + sh;
                    v2u qh; qh.x = pk2(hh[0], hh[1]); qh.y = pk2(hh[2], hh[3]);
                    *(LAS v2u*)(lds + RT_HI + lr * RT_ROWB + c * 2) = qh;
                    *(unsigned*)(H2 + (size_t)t * 2048 + c) = pk4_fp8(hh[0] * SC_H, hh[1] * SC_H, hh[2] * SC_H, hh[3] * SC_H); }
            }
            __syncthreads();
            }
            { f32x4 acc[2][4];
#pragma unroll
              for (int mt = 0; mt < 2; ++mt)
#pragma unroll
                  for (int et = 0; et < 4; ++et) acc[mt][et] = (f32x4){0.f, 0.f, 0.f, 0.f};
#pragma unroll 1
              for (int kh = 0; kh < 2; ++kh) {
                  bf16x8 bh[4][4];
#pragma unroll
                  for (int k4 = 0; k4 < 4; ++k4) { const int k0 = 256 * wave + 32 * (4 * kh + k4) + 8 * l4;
#pragma unroll
                      for (int et = 0; et < 4; ++et) bh[k4][et] = *(const bf16x8*)(whi + (size_t)(16 * et + l15) * 2048 + k0); }
#pragma unroll
                  for (int k4 = 0; k4 < 4; ++k4) { const int k0 = 256 * wave + 32 * (4 * kh + k4) + 8 * l4;
#pragma unroll
                      for (int mt = 0; mt < 2; ++mt) { const bf16x8 ah = *(const LAS bf16x8*)(lds + RT_HI + (16 * mt + l15) * RT_ROWB + k0 * 2);
#pragma unroll
                          for (int et = 0; et < 4; ++et) acc[mt][et] = __builtin_amdgcn_mfma_f32_16x16x32_bf16(ah, bh[k4][et], acc[mt][et], 0, 0, 0); } } }
              __syncthreads();
#pragma unroll
              for (int mt = 0; mt < 2; ++mt)
#pragma unroll
                  for (int et = 0; et < 4; ++et)
#pragma unroll
                      for (int q = 0; q < 4; ++q) part[(wave * 32 + 16 * mt + 4 * l4 + q) * 64 + 16 * et + l15] = acc[mt][et][q]; }
            __syncthreads();
#pragma unroll
            for (int q = 0; q < 4; ++q) { const int idx = tid + 512 * q; float sacc = 0.f;
#pragma unroll
                for (int w = 0; w < 8; ++w) sacc += part[w * 2048 + idx];
                logit[idx] = sacc; }
            __syncthreads();
#pragma unroll 1
            for (int rep_ = 0; rep_ < P7_REP_RT; ++rep_) {
#pragma unroll 1
            for (int rr = 0; rr < 4; ++rr) {
                const int lr = wave * 4 + rr, t = blk * 64 + it * 32 + lr;
                const float lg = logit[lr * 64 + lane]; const float s = 1.f / (1.f + __expf(-lg)); const float sel = s + rbias[lane];
                float m1 = sel; m1 = fmaxf(m1, __shfl_xor(m1, 1)); m1 = fmaxf(m1, __shfl_xor(m1, 2)); m1 = fmaxf(m1, __shfl_xor(m1, 4));
                const u64 eq = __ballot(sel == m1); const unsigned gb = (unsigned)(eq >> (lane & ~7)) & 0xffu; const int first = __builtin_ctz(gb);
                float v2 = ((lane & 7) == first) ? -INFINITY : sel; v2 = fmaxf(v2, __shfl_xor(v2, 1)); v2 = fmaxf(v2, __shfl_xor(v2, 2)); v2 = fmaxf(v2, __shfl_xor(v2, 4));
                const float gs = m1 + v2; const int g = lane >> 3; int grank = 0;
#pragma unroll
                for (int g2 = 0; g2 < 8; ++g2) { const float o = __builtin_bit_cast(float, __builtin_amdgcn_readlane(__builtin_bit_cast(int, gs), g2 * 8)); grank += (o > gs || (o == gs && g2 < g)) ? 1 : 0; }
                const bool gsel = grank < 4; const float mk = gsel ? sel : -INFINITY; int rank = 0;
#pragma unroll 8
                for (int e2 = 0; e2 < 64; ++e2) { const float o = __builtin_bit_cast(float, __builtin_amdgcn_readlane(__builtin_bit_cast(int, mk), e2)); rank += (o > mk || (o == mk && e2 < lane)) ? 1 : 0; }
                const bool chosen = gsel && rank < 8;
                const u64 mask = __ballot(chosen); const float ssum = wave_sum(chosen ? s : 0.f);
                const int kidx = __popcll(mask & ((1ull << lane) - 1ull));
                if (chosen) tokw[(size_t)t * 8 + kidx] = s / ssum * 2.5f;
                if (lane == 0) { tmask[t] = mask; masks[it * 32 + lr] = mask; }
            }
            __syncthreads();
            }
        }
        if (wave == 0) { const u64 m = masks[lane]; int mine = 0;
#pragma unroll 8
            for (int e = 0; e < 64; ++e) { const int c = __popcll(__ballot((m >> e) & 1ull)); mine = (lane == e) ? c : mine; }
            cnt[blk * 64 + lane] = mine; }
        __syncthreads();
    }
}

__device__ __forceinline__ void phase7(const Args& a, LAS unsigned char* lds, int tid, int lane, int wave, int vcu, int G) {
    unsigned char* ws = a.ws;
    const int* cnt = (const int*)(ws + T_CNT); const u64* tmask = (const u64*)(ws + T_MASK); const float* tokw = (const float*)(ws + T_TOKW);
    int* tokslot = (int*)(ws + T_TOKSLOT); int* slottok = (int*)(ws + T_SLOTTOK); float* slotw = (float*)(ws + T_SLOTW); int* tile = (int*)(ws + T_TILE);
    LAS int* part = (LAS int*)(lds + 131072);
    bool converted = false;
    for (int blk = vcu; blk < NT / 64; blk += G) {
        int pre = 0, all = 0;
#pragma unroll 8
        for (int b2 = wave; b2 < 256; b2 += 8) { const int c = cnt[b2 * 64 + lane]; all += c; pre += (b2 < blk) ? c : 0; }
        part[(wave * 2) * 64 + lane] = pre; part[(wave * 2 + 1) * 64 + lane] = all;
        LDS_BARRIER();
        if (wave == 0) {
            int p = 0, t = 0;
#pragma unroll
            for (int w = 0; w < 8; ++w) { p += part[(w * 2) * 64 + lane]; t += part[(w * 2 + 1) * 64 + lane]; }
            int incl = t;
#pragma unroll
            for (int o = 1; o < 64; o <<= 1) { const int v = __shfl_up(incl, o); if (lane >= o) incl += v; }
            const int start = incl - t; const int base = start + p;
            const int tokn = blk * 64 + lane; const u64 m = tmask[tokn];
#pragma unroll 8
            for (int e = 0; e < 64; ++e) { const bool bit = (m >> e) & 1ull; const u64 bal = __ballot(bit); const int be = __builtin_amdgcn_readlane(base, e);
                if (bit) { const int rank = __popcll(bal & ((1ull << lane) - 1ull)); const int slot = be + rank; const int k = __popcll(m & ((1ull << e) - 1ull));
                    slottok[slot] = tokn; slotw[slot] = tokw[(size_t)tokn * 8 + k]; tokslot[(size_t)tokn * 8 + k] = slot; } }
            slottok[SH_ROW0 + tokn] = tokn; slotw[SH_ROW0 + tokn] = 1.f;
            if (blk == 0) {
                const int nte = (t + 255) >> 8; int inc2 = nte;
#pragma unroll
                for (int o = 1; o < 64; o <<= 1) { const int v = __shfl_up(inc2, o); if (lane >= o) inc2 += v; }
                const int n0 = inc2 - nte; const int ntot = __builtin_amdgcn_readlane(inc2, 63);
                for (int j = 0; j < nte; ++j) { tile[n0 + j] = lane; tile[NTILE_MAX + n0 + j] = start + j * 256; tile[2 * NTILE_MAX + n0 + j] = (t - j * 256) < 256 ? (t - j * 256) : 256; }
                tile[ntot + lane] = 64; tile[NTILE_MAX + ntot + lane] = SH_ROW0 + lane * 256; tile[2 * NTILE_MAX + ntot + lane] = 256;
                if (lane == 0) tile[3 * NTILE_MAX] = ntot + 64;
            }
        } else if (!converted) {
            converted = true;
            convert_items(a, (LAS float*)(lds + wave * 16384), lane, NITEMS_P0 + (G == 256 ? N_DOWN_CHAIN + N_DOWN_EARLY : 0) + vcu * 7 + (wave - 1), G * 7, NITEMS);
        }
        LDS_BARRIER();
    }
}

__device__ __forceinline__ void phase10(const Args& a, LAS unsigned char* lds, int lane, int wave, int vcu, int G) {
    unsigned char* ws = a.ws;
    const float* mod = (const float*)(ws + WS_MOD); const unsigned char* SO = ws + WS_SLOTOUT; const int* tokslot = (const int*)(ws + T_TOKSLOT); const float* gp = a.in[9];
    LAS float* ysc = (LAS float*)(lds + wave * 8192);
    const unsigned lo16_ = 16u * (unsigned)lane;
#pragma unroll 1
    for (int t = vcu * 8 + wave; t < NT; t += G * 8) {
        const float* mr = mod + (size_t)(t >> 11) * 12288;
        const int myslot = lane < 8 ? tokslot[(size_t)t * 8 + lane] : SH_ROW0 + t;
        unsigned lo16 = lo16_; asm volatile("" : "+v"(lo16));
        v4u x[9][2]; v2u xb[8];
        const unsigned char* x1r = (const unsigned char*)((const bf16*)(ws + RA_X1) + (size_t)t * 2048);
#pragma unroll
        for (int k = 0; k < 9; ++k) { const int slot = __builtin_amdgcn_readlane(myslot, k); const unsigned char* sr = SO + (size_t)slot * 2048;
#pragma unroll
            for (int j = 0; j < 2; ++j) x[k][j] = __builtin_nontemporal_load((const v4u*)(sr + (lo16 + 1024u * j))); }
        float y[2][16];
#pragma unroll
        for (int j = 0; j < 2; ++j)
#pragma unroll
            for (int q = 0; q < 16; ++q) y[j][q] = 0.f;
#pragma unroll
        for (int k = 0; k < 9; ++k)
#pragma unroll
            for (int j = 0; j < 2; ++j) { v4u v = x[k][j]; asm volatile("" : "+v"(v) : "v"(y[j][0]), "v"(y[j][15]));
#pragma unroll
                for (int w = 0; w < 4; ++w) { const unsigned d = v[w]; const auto lo = __builtin_amdgcn_cvt_pk_f32_fp8(d, false), hi = __builtin_amdgcn_cvt_pk_f32_fp8(d, true);
                    y[j][4 * w] += lo[0]; y[j][4 * w + 1] += lo[1]; y[j][4 * w + 2] += hi[0]; y[j][4 * w + 3] += hi[1]; } }
        asm volatile("" ::: "memory");
#pragma unroll
        for (int j = 0; j < 8; ++j) xb[j] = __builtin_nontemporal_load((const v2u*)(x1r + (lo16 / 2u + 512u * j)));
        float ss = 0.f;
#pragma unroll
        for (int j = 0; j < 2; ++j)
#pragma unroll
            for (int q = 0; q < 16; ++q) ss += y[j][q] * y[j][q];
        const float rstd = rsqrtf(wave_sum(ss) * (1.f / 2048.f) + EPS * SC_O * SC_O);
#pragma unroll
        for (int j = 0; j < 2; ++j)
#pragma unroll
            for (int q = 0; q < 4; ++q) *(LAS f32x4*)(ysc + 16 * (lane + 64 * j) + 4 * q) = (f32x4){y[j][4 * q], y[j][4 * q + 1], y[j][4 * q + 2], y[j][4 * q + 3]};
        LDS_WAIT(); asm volatile("" ::: "memory");
        unsigned char* outr = (unsigned char*)(a.out + (size_t)t * 2048); const unsigned char* gpb = (const unsigned char*)gp;
        const unsigned char* gt2b = (const unsigned char*)(mr + 10240);
#pragma unroll
        for (int j = 0; j < 8; ++j) { const unsigned cb = lo16 + 1024u * j; const f32x4 yy = *(const LAS f32x4*)(ysc + 4 * (lane + 64 * j)), g = *(const f32x4*)(gpb + cb), gt = *(const f32x4*)(gt2b + cb);
            const f32x4 x1 = (f32x4){bflo(xb[j].x), bfhi(xb[j].x), bflo(xb[j].y), bfhi(xb[j].y)};
            *(f32x4*)(outr + cb) = x1 + gt * (yy * rstd * g); }
        LDS_WAIT(); asm volatile("" ::: "memory");
    }
}

__global__ void __launch_bounds__(512, 2) fwd(Args args) {
    extern __shared__ __attribute__((aligned(16))) unsigned char lds_raw[];
    LAS unsigned char* lds = (LAS unsigned char*)lds_raw;
    const int tid = threadIdx.x, lane = tid & 63, wave = __builtin_amdgcn_readfirstlane(tid >> 6);
    const int G = gridDim.x, bx = blockIdx.x;
    const int vcu = (G % 8 == 0) ? (bx % 8) * (G / 8) + bx / 8 : bx;
    unsigned char* ws = args.ws;
    volatile LAS unsigned* MISC = (volatile LAS unsigned*)(lds + LDS_MISC);
    if (tid < 64) MISC[tid] = 0u;
    __syncthreads();
    const int lo = args.ph_lo, hi = args.ph_hi;
    XcdBarrier bar; bar.bar = (unsigned*)(ws + WS_CTL) + 4096; bar.x = 0; bar.st = nullptr;
    if (hi - lo > 1) bar = xcd_barrier_post((unsigned*)(ws + WS_CTL) + 4096, MISC + 8);
#ifndef PH_MASK
#define PH_MASK 0xfff
#endif
#define IN(k) (((PH_MASK >> (k)) & 1) && lo <= (k) && (k) < hi)
#define SEAM(k) do { if (IN(k) && IN((k) + 1)) xcd_barrier(bar); } while (0)

#ifndef REP_PHASE
#define REP_PHASE -1
#endif
#define PH_IDS int tz_ = threadIdx.x; asm volatile("" : "+v"(tz_)); const int tid = tz_, lane = tz_ & 63, wave = __builtin_amdgcn_readfirstlane(tz_ >> 6); (void)tid; (void)lane; (void)wave;
#define RUNPH(k, ...) do { if (IN(k)) { { PH_IDS __VA_ARGS__ } if (REP_PHASE == (k)) { xcd_barrier(bar); { PH_IDS __VA_ARGS__ } } SEAM(k); } } while (0)
#ifdef PROBE_P0
    if (IN(0)) { { PH_IDS phase0(args, lds, tid, lane, wave, vcu, G); } xcd_barrier(bar); { PH_IDS phase0(args, lds, tid, lane, wave, vcu, G, PROBE_P0 == 1, PROBE_P0 == 2); } SEAM(0); }
#else
    RUNPH(0, phase0(args, lds, tid, lane, wave, vcu, G););
#endif
    RUNPH(1, phase1(args, lane, wave, vcu, G););
    RUNPH(2, {
        InSched S; S.D.init(ws + RA_H, ws + WS_WIN, 2048, 2048, NT, DINP, G, bx);
        EpiIn E{ws};
        pg8::gemm_phase<EpiIn, InSched>(lds, 2048, S, E);
        { const int nbusy = (InSched::NLAT + InSched::NCTX) % G; const int nidle = G - nbusy;
          if (G == 256 && bx >= nbusy) convert_items(args, (LAS float*)(lds + wave * 16384), lane, NITEMS_P0 + N_DOWN_CHAIN + (bx - nbusy) * 8 + wave, nidle * 8, NITEMS_P0 + N_DOWN_CHAIN + N_DOWN_EARLY); } });
#ifndef P3_REP_PREP
#define P3_REP_PREP 1
#endif
#ifndef P3_REP_POOL
#define P3_REP_POOL 1
#endif
    RUNPH(3, for (int r_ = 0; r_ < P3_REP_PREP; ++r_) phase3_prep(args, lds, tid, vcu, G); for (int r_ = 0; r_ < P3_REP_POOL; ++r_) phase3_pool(args, lds, tid, vcu, G););
    RUNPH(4, phase_chain(args, lds, tid, lane, wave, vcu, G););
    RUNPH(5, {
        phase4_post(args, lane, wave, vcu, G);
        PoolSched S{(const char*)(ws + RA_DPOOL), (const char*)(ws + WS_WPOOL), G, vcu};
        EpiPool E{ws + RA_YMIX, args.in[17]};
        int kpool = 256; asm volatile("" : "+s"(kpool));
        pg8::gemm_phase<EpiPool, PoolSched>(lds, kpool, S, E); });
    RUNPH(6, {
        DenseSched S; S.init(ws + RA_YMIX, ws + WS_WOUT, 1024, 1024, NT, 2048, G, bx);
        EpiOut E{(bf16*)(ws + RA_Y1)};
        int kout = 1024; asm volatile("" : "+s"(kout));
        pg8::gemm_phase<EpiOut, DenseSched, true>(lds, kout, S, E); });
    RUNPH(7, phase6(args, lds, tid, lane, wave, vcu, G););
    RUNPH(8, phase7(args, lds, tid, lane, wave, vcu, G););
    RUNPH(9, {
        MoeGUSched S{(const char*)(ws + RA_H2), (const char*)(ws + WS_WGU), (const int*)(ws + T_TILE), (const int*)(ws + T_SLOTTOK), G, vcu};
        EpiGU E{ws + WS_ACT, (const float*)(ws + T_SLOTW)};
        int kgu = 1024; asm volatile("" : "+s"(kgu));
        pg8::gemm_phase<EpiGU, MoeGUSched, true>(lds, kgu, S, E); });
    RUNPH(10, {
        MoeDownSched S{(const char*)(ws + WS_ACT), (const char*)(ws + WS_WD), (const int*)(ws + T_TILE), G, vcu};
        EpiDown E{ws + WS_SLOTOUT};
        int kdn = 256; asm volatile("" : "+s"(kdn));
        pg8::gemm_phase<EpiDown, MoeDownSched, true>(lds, kdn, S, E); });
    if (IN(11)) { { PH_IDS phase10(args, lds, lane, wave, vcu, G); } if (REP_PHASE == 11) { xcd_barrier(bar); { PH_IDS phase10(args, lds, lane, wave, vcu, G); } } }
#undef IN
#undef SEAM
}

extern "C" void kernel_launch(void* const* d_in, const int* in_sizes, int n_in, void* d_out, int out_size, void* d_ws, size_t ws_size, hipStream_t stream) {
    static int grid = 0;
    if (grid == 0) {
        if (n_in != 27 || out_size != NT * DM || ws_size < WS_NEED) { fprintf(stderr, "kernel_launch: unexpected problem: n_in %d out %d ws %zu (need %zu)\n", n_in, out_size, ws_size, (size_t)WS_NEED); grid = -1; return; }
        int dev = 0, cus = 0, per_cu = 0;
        if (hipGetDevice(&dev) != hipSuccess || hipDeviceGetAttribute(&cus, hipDeviceAttributeMultiprocessorCount, dev) != hipSuccess) { grid = -1; return; }
        if (hipFuncSetAttribute((const void*)fwd, hipFuncAttributeMaxDynamicSharedMemorySize, LDS_BYTES) != hipSuccess) { fprintf(stderr, "kernel_launch: hipFuncSetAttribute failed\n"); grid = -1; return; }
        if (hipOccupancyMaxActiveBlocksPerMultiprocessor(&per_cu, (const void*)fwd, 512, LDS_BYTES) != hipSuccess || per_cu < 1) { fprintf(stderr, "kernel_launch: occupancy query says %d\n", per_cu); }
        (void)hipGetLastError();
        grid = cus;
    }
    if (grid < 0) return;
    (void)hipMemsetAsync((char*)d_ws + WS_CTL, 0, CTL_ZERO_BYTES, stream);
    Args a{};
    for (int i = 0; i < 27; ++i) a.in[i] = (const float*)d_in[i];
    a.out = (float*)d_out; a.ws = (unsigned char*)d_ws;
    if (N_LAUNCHES == 1) {
        a.ph_lo = 0; a.ph_hi = NPH;
        hipLaunchKernelGGL(fwd, dim3(grid), dim3(512), LDS_BYTES, stream, a);
    } else {
        for (int p = 0; p < NPH; ++p) { a.ph_lo = p; a.ph_hi = p + 1; hipLaunchKernelGGL(fwd, dim3(grid), dim3(512), LDS_BYTES, stream, a); }
    }
}
```

```cpp
#include <hip/hip_runtime.h>
#include <cstdio>
#include <cstdint>

#ifndef P7_REP_ROWS
#define P7_REP_ROWS 1
#endif
#ifndef P7_REP_LOG
#define P7_REP_LOG 1
#endif
#ifndef P7_REP_RT
#define P7_REP_RT 1
#endif
#ifndef N_LAUNCHES
#define N_LAUNCHES 1
#endif

#define GAS __attribute__((address_space(1)))
#define LAS __attribute__((address_space(3)))
typedef unsigned short bf16;
typedef unsigned v4u __attribute__((ext_vector_type(4)));
typedef unsigned v2u __attribute__((ext_vector_type(2)));
typedef float f32x4 __attribute__((ext_vector_type(4)));
typedef short bf16x8 __attribute__((ext_vector_type(8)));
typedef unsigned long long u64;

constexpr int NB = 8, SEQ = 2048, DM = 2048, CTXL = 256;
constexpr int NT = NB * SEQ;
constexpr int NTC = NB * CTXL;
constexpr int MROWS = NT + NTC;
constexpr int DIN = 4128, DINP = 4352;
constexpr int NE = 64, TOPK = 8, DE = 512;
constexpr int NSLOT_E = NT * TOPK;
constexpr int SH_ROW0 = NSLOT_E + 256;
constexpr int NSLOT = SH_ROW0 + NT;
constexpr int NTILE_MAX = 704;
constexpr float EPS = 1e-6f;
constexpr int NPH = 12;

constexpr size_t MiB = 1u << 20;
constexpr size_t WS_CTL = 0, CTL_ZERO_BYTES = 64 * 1024;
constexpr size_t WS_MOD = 1 * MiB;
constexpr size_t WS_WRT = 1 * MiB + 512 * 1024;
constexpr size_t WS_WIN = 2 * MiB;
constexpr size_t WS_WOUT = WS_WIN + 17 * MiB;
constexpr size_t WS_WPOOL = WS_WOUT + 8 * MiB;
constexpr size_t WS_WD = WS_WPOOL + 1 * MiB;
constexpr size_t WS_WGU = WS_WD + 130 * MiB;
constexpr size_t WS_RA = WS_WGU + 260 * MiB;
constexpr size_t RA_H = WS_RA;
constexpr size_t RA_OF = WS_RA;
constexpr size_t RA_H2 = WS_RA;
constexpr size_t RA_Q = WS_RA + 128 * MiB;
constexpr size_t RA_K = RA_Q + 16 * MiB;
constexpr size_t RA_V = RA_K + 18 * MiB;
constexpr size_t RA_R = RA_V + 36 * MiB;
constexpr size_t RA_P = RA_R + 32 * MiB;
constexpr size_t RA_ALR = RA_P + 32 * MiB;
constexpr size_t RA_DPOOL = RA_ALR + 3 * MiB;
constexpr size_t RA_YMIX = RA_DPOOL + 32 * MiB;
constexpr size_t RA_Y1 = WS_RA + 128 * MiB;
constexpr size_t RA_X1 = WS_RA + 192 * MiB;
constexpr size_t RA_END = RA_YMIX + 64 * MiB;
constexpr size_t WS_SLOTOUT = WS_WGU;
constexpr size_t WS_ACT = RA_END > WS_SLOTOUT + 578 * MiB ? RA_END : WS_SLOTOUT + 578 * MiB;
constexpr size_t WS_END = WS_ACT + 145 * MiB;
constexpr size_t PQG = WS_ACT;
constexpr size_t PAM = WS_ACT + 32 * MiB;
constexpr size_t PKD = WS_ACT + 96 * MiB;
constexpr size_t PDEC = WS_ACT + 132 * MiB;
constexpr size_t WS_T0 = WS_END;
constexpr size_t T_CNT = WS_T0;
constexpr size_t T_MASK = T_CNT + 65536;
constexpr size_t T_TOKW = T_MASK + 131072;
constexpr size_t T_TOKSLOT = T_TOKW + 524288;
constexpr size_t T_SLOTTOK = T_TOKSLOT + 524288;
constexpr size_t T_SLOTW = T_SLOTTOK + 655360;
constexpr size_t T_TILE = T_SLOTW + 655360;
constexpr size_t WS_NEED = (T_TILE + 16384 + 4095) / 4096 * 4096;

constexpr int RING_BYTES = 131072;
constexpr int LDS_BYTES = 147456;
constexpr int LDS_MISC = LDS_BYTES - 256;
constexpr int RT_ROWB = 4112;
constexpr int RT_HI = 0;
constexpr int LDS_LOGIT = 32 * RT_ROWB;
constexpr int LDS_MASKS = LDS_LOGIT + 8192;
static_assert(LDS_MASKS + 512 <= LDS_MISC, "LDS map");

#define LDS_WAIT() asm volatile("s_waitcnt lgkmcnt(0)" ::: "memory")
#define LDS_BARRIER() do { asm volatile("s_waitcnt lgkmcnt(0)" ::: "memory"); __builtin_amdgcn_s_barrier(); asm volatile("" ::: "memory"); } while (0)
#define VM_WAIT() asm volatile("s_waitcnt vmcnt(0)" ::: "memory")

__device__ __forceinline__ unsigned f2bf(float f) { unsigned u = __builtin_bit_cast(unsigned, f); return (u + 0x7fffu + ((u >> 16) & 1u)) >> 16; }
__device__ __forceinline__ unsigned pk2(float lo, float hi) { return f2bf(lo) | (f2bf(hi) << 16); }
__device__ __forceinline__ float bflo(unsigned u) { return __builtin_bit_cast(float, u << 16); }
__device__ __forceinline__ float bfhi(unsigned u) { return __builtin_bit_cast(float, u & 0xffff0000u); }
__device__ __forceinline__ float bf1(bf16 b) { return __builtin_bit_cast(float, ((unsigned)b) << 16); }
template <int CTRL, int ROWMASK = 0xf, bool BOUND = false>
__device__ __forceinline__ float dppf(float v) { return __builtin_bit_cast(float, __builtin_amdgcn_update_dpp(0, __builtin_bit_cast(int, v), CTRL, ROWMASK, 0xf, BOUND)); }
__device__ __forceinline__ float wave_sum(float v) {
    v += dppf<0x111, 0xf, true>(v); v += dppf<0x112, 0xf, true>(v); v += dppf<0x114, 0xf, true>(v); v += dppf<0x118, 0xf, true>(v);
    v += dppf<0x142, 0xa>(v); v += dppf<0x143, 0xc>(v);
    return __builtin_bit_cast(float, __builtin_amdgcn_readlane(__builtin_bit_cast(int, v), 63));
}
__device__ __forceinline__ float silu_f(float x) { return x * __builtin_amdgcn_rcpf(1.f + __expf(-x)); }

#define XB_TMO      128
#define XB_XCNT(j)  (256  + 64 * (j))
#define XB_XSUB(j)  (1280 + 64 * (j))
#define XB_XGEN(j)  (2304 + 64 * (j))
#define XB_TOP      3328
#define XB_TOPGEN   3392
#define XCD_BAR_WORDS 3456
#define XB_SPIN_CAP (1u << 18)

__device__ __forceinline__ unsigned xb_ld(unsigned* p)              { return __hip_atomic_load(p, __ATOMIC_RELAXED, __HIP_MEMORY_SCOPE_AGENT); }
__device__ __forceinline__ unsigned xb_add(unsigned* p, unsigned v) { return __hip_atomic_fetch_add(p, v, __ATOMIC_RELAXED, __HIP_MEMORY_SCOPE_AGENT); }
__device__ __forceinline__ unsigned xb_xcc_id() { return (unsigned)__builtin_amdgcn_s_getreg((3 << 11) | 20) & 0xFu; }
#define XB_SPIN(cond, bar) do { unsigned _sp = 0; while (cond) { __builtin_amdgcn_s_sleep(1); \
    if ((++_sp & 255u) == 0u) { if (xb_ld(&(bar)[XB_TMO])) break; if (_sp > XB_SPIN_CAP) { atomicAdd(&(bar)[XB_TMO], 1u); break; } } } } while (0)

struct XcdBarrier { unsigned* bar; unsigned x; volatile LAS unsigned* st; };

__device__ __forceinline__ XcdBarrier xcd_barrier_post(unsigned* bar, volatile LAS unsigned* st) {
    XcdBarrier b; b.bar = bar; b.x = xb_xcc_id(); b.st = st;
    if (threadIdx.x == 0) (void)xb_add(&bar[XB_XCNT(b.x)], 1u);
    return b;
}
__device__ __forceinline__ void xcd_barrier_complete(unsigned* bar, unsigned x, unsigned& nloc, unsigned& nx) {
    const unsigned G = gridDim.x * gridDim.y * gridDim.z;
    unsigned sum, cnt, mine, sp = 0u;
    for (;;) {
        sum = 0u; cnt = 0u; mine = 0u;
#pragma unroll
        for (unsigned j = 0; j < 16; ++j) { const unsigned c = xb_ld(&bar[XB_XCNT(j)]); sum += c; cnt += (c > 0u) ? 1u : 0u; mine = (j == x) ? c : mine; }
        if (sum == G) break;
        __builtin_amdgcn_s_sleep(1);
        if ((++sp & 255u) == 0u) { if (xb_ld(&bar[XB_TMO])) break; if (sp > XB_SPIN_CAP) { atomicAdd(&bar[XB_TMO], 1u); break; } }
    }
    nloc = mine > 0u ? mine : 1u; nx = cnt > 0u ? cnt : 1u;
}
__device__ __forceinline__ void xcd_barrier(const XcdBarrier& b) {
    asm volatile("s_waitcnt vmcnt(0)" ::: "memory");
    __syncthreads();
    if (threadIdx.x == 0) {
        unsigned* bar = b.bar;
        __builtin_amdgcn_s_waitcnt(0);
        unsigned nloc = b.st[0], nx = b.st[1];
        if (nloc == 0u) { xcd_barrier_complete(bar, b.x, nloc, nx); b.st[0] = nloc; b.st[1] = nx; }
        const unsigned old = xb_add(&bar[XB_XSUB(b.x)], 1u);
        const unsigned gen = old / nloc;
        if (old + 1u == (gen + 1u) * nloc) {
            __builtin_amdgcn_fence(__ATOMIC_RELEASE, "agent");
            asm volatile("s_waitcnt vmcnt(0)" ::: "memory");
            const unsigned og = xb_add(&bar[XB_TOP], 1u);
            const unsigned tg = og / nx;
            if (og + 1u == (tg + 1u) * nx) xb_add(&bar[XB_TOPGEN], 1u);
            else XB_SPIN(xb_ld(&bar[XB_TOPGEN]) == tg, bar);
            __builtin_amdgcn_fence(__ATOMIC_ACQUIRE, "agent");
            xb_add(&bar[XB_XGEN(b.x)], 1u);
            asm volatile("s_waitcnt vmcnt(0)" ::: "memory");
        } else {
            XB_SPIN(xb_ld(&bar[XB_XGEN(b.x)]) == gen, bar);
            __builtin_amdgcn_fence(__ATOMIC_ACQUIRE, "agent");
            asm volatile("s_waitcnt vmcnt(0)" ::: "memory");
        }
    }
    __syncthreads();
}

namespace pg8 {
constexpr int BM = 256, BK = 64, HALF = 128, HTB = HALF * BK * 2, STAGE_BYTES = 8 * HTB, NXCD = 8, WGM = 8;
__device__ __forceinline__ int lds_byte(int r, int c) { const int st = (r >> 4) * 2 + (c >> 5), rr = r & 15, cc = c & 31, ob = rr * 64 + cc * 2; return st * 1024 + (ob ^ (((ob >> 9) & 1) << 5)); }
__device__ __forceinline__ void stage_rc(int b, int& R, int& C) { const int st = b / 1024, sb = b % 1024, swz = sb ^ (((sb >> 9) & 1) << 5); R = (st >> 1) * 16 + swz / 64; C = (st & 1) * 32 + (swz % 64) / 2; }
__device__ __forceinline__ int perm32(int rho) { const int n = rho >> 4, i = rho & 15; return 8 * (i >> 2) + 4 * n + (i & 3); }
__device__ __forceinline__ unsigned cvt_pk_bf16(float lo, float hi) { unsigned r; asm volatile("v_cvt_pk_bf16_f32 %0, %1, %2" : "=v"(r) : "v"(lo), "v"(hi)); return r; }

typedef int v8i __attribute__((ext_vector_type(8)));
typedef int v4i __attribute__((ext_vector_type(4)));
template <class Epi, class Sched, bool FP8 = false>
__device__ __forceinline__ void gemm_phase(LAS unsigned char* lds, const int K, const Sched& S, const Epi& E) {
    typedef typename Sched::U Unit;
    const int tid = threadIdx.x, wid = __builtin_amdgcn_readfirstlane(tid >> 6), lane = tid & 63, wr = wid >> 2, wc = wid & 3, fr = lane & 15, fq = lane >> 4;
    const int nt = K / BK;
    int R[2], C[2]; unsigned voffB[2];
#pragma unroll
    for (int i = 0; i < 2; ++i) { stage_rc(tid * 16 + i * 8192, R[i], C[i]);
        const int Rb = Epi::PERMK == 2 ? (64 * (R[i] >> 5) + 16 * ((R[i] & 15) >> 2) + 4 * ((R[i] >> 4) & 1) + (R[i] & 3)) : (Epi::PERMK == 1 ? ((R[i] & ~31) + perm32(R[i] & 31)) : R[i]);
        voffB[i] = (unsigned)(Rb * K + C[i]) * 2u; }
    const size_t kstep = (size_t)(BK * 2);
    const size_t hstepB = (size_t)(Epi::PERMK == 2 ? 8 : HALF) * K * 2;
    const unsigned ldsw = (unsigned)wid * 1024u;
    const int aoff = lds_byte(wr * 64 + fr, fq * 8), boff = lds_byte(wc * 32 + fr, fq * 8);
#define PG8_SA(b, h) (((b) * 2 + (h)) * HTB)
#define PG8_SB(b, h) ((4 + (b) * 2 + (h)) * HTB)
#define PG8_STAGE(bufoff, gbase, v0, v1) do { \
        __builtin_amdgcn_global_load_lds((const unsigned*)((const char*)(gbase) + (v0)), (LAS unsigned*)(lds + (bufoff) + ldsw), 16, 0, 0); \
        __builtin_amdgcn_global_load_lds((const unsigned*)((const char*)(gbase) + (v1)), (LAS unsigned*)(lds + (bufoff) + ldsw + 8192), 16, 0, 0); } while (0)
#define PG8_LDA(dst, b, h) do { _Pragma("unroll") for (int m = 0; m < 4; ++m) { const v4i lo_ = *(const LAS v4i*)(lds + PG8_SA(b, h) + aoff + m * 2048), hi_ = *(const LAS v4i*)(lds + PG8_SA(b, h) + aoff + m * 2048 + 1024); \
        dst[m] = __builtin_shufflevector(lo_, hi_, 0, 1, 2, 3, 4, 5, 6, 7); } } while (0)
#define PG8_LDB(dst, b, h) do { _Pragma("unroll") for (int n = 0; n < 2; ++n) { const v4i lo_ = *(const LAS v4i*)(lds + PG8_SB(b, h) + boff + n * 2048), hi_ = *(const LAS v4i*)(lds + PG8_SB(b, h) + boff + n * 2048 + 1024); \
        dst[n] = __builtin_shufflevector(lo_, hi_, 0, 1, 2, 3, 4, 5, 6, 7); } } while (0)
#define PG8_H0(x) ((bf16x8)__builtin_shufflevector(x, x, 0, 1, 2, 3))
#define PG8_H1(x) ((bf16x8)__builtin_shufflevector(x, x, 4, 5, 6, 7))
#define PG8_MMA(ai, bj, At, Bt) do { __builtin_amdgcn_s_setprio(1); if constexpr (FP8) asm volatile("s_nop 4"); _Pragma("unroll") for (int m = 0; m < 4; ++m) _Pragma("unroll") for (int n = 0; n < 2; ++n) { \
        if constexpr (FP8) asm volatile("v_mfma_f32_16x16x128_f8f6f4 %0, %1, %2, %0" : "+v"(acc[ai][bj][m][n]) : "v"(Bt[n]), "v"(At[m])); \
        else { acc[ai][bj][m][n] = __builtin_amdgcn_mfma_f32_16x16x32_bf16(PG8_H0(Bt[n]), PG8_H0(At[m]), acc[ai][bj][m][n], 0, 0, 0); \
               acc[ai][bj][m][n] = __builtin_amdgcn_mfma_f32_16x16x32_bf16(PG8_H1(Bt[n]), PG8_H1(At[m]), acc[ai][bj][m][n], 0, 0, 0); } } \
        __builtin_amdgcn_s_setprio(0); } while (0)
#define PG8_WAIT_V(n) asm volatile("s_waitcnt vmcnt(" #n ")" ::: "memory")
#define PG8_WAIT_L(n) asm volatile("s_waitcnt lgkmcnt(" #n ")" ::: "memory")
#define PG8_BAR __builtin_amdgcn_s_barrier()
#define PG8_SCHED __builtin_amdgcn_sched_barrier(0)
    Unit cur, nxt; int ui = 0;
    if (!S.next(0, cur)) return;
    f32x4 acc[2][2][4][2];
#pragma unroll
    for (int a = 0; a < 2; ++a)
#pragma unroll
        for (int b = 0; b < 2; ++b)
#pragma unroll
            for (int m = 0; m < 4; ++m)
#pragma unroll
                for (int n = 0; n < 2; ++n) acc[a][b][m][n] = (f32x4){0.f, 0.f, 0.f, 0.f};
    v8i At[4], B0[2], B1[2];
    unsigned vA[4], vN[4];
    S.aoffs(cur, R, C, vA);
    const char* cA = cur.A; const char* cB = cur.B;
    PG8_STAGE(PG8_SB(0, 0), cB, voffB[0], voffB[1]); PG8_STAGE(PG8_SB(0, 1), cB + hstepB, voffB[0], voffB[1]); PG8_STAGE(PG8_SA(0, 0), cA, vA[0], vA[1]); PG8_STAGE(PG8_SA(0, 1), cA, vA[2], vA[3]);
    if (wr == 1) PG8_BAR;
    PG8_WAIT_V(2); PG8_BAR;
    PG8_STAGE(PG8_SB(1, 0), cB + kstep, voffB[0], voffB[1]); PG8_STAGE(PG8_SA(1, 0), cA + kstep, vA[0], vA[1]); PG8_STAGE(PG8_SB(1, 1), cB + hstepB + kstep, voffB[0], voffB[1]);
    PG8_WAIT_V(6); PG8_BAR;
    for (;;) {
        const bool has_next = S.next(ui + 1, nxt);
        const bool lo_only = S.lo_only(cur);
        const char* nA = has_next ? nxt.A : cA; const char* nB = has_next ? nxt.B : cB;
        if (has_next) S.aoffs(nxt, R, C, vN); else { vN[0] = vA[0]; vN[1] = vA[1]; vN[2] = vA[2]; vN[3] = vA[3]; }
        for (int t = 0; t < nt; t += 2) {
            const bool last = (t == nt - 2);
            const char* a1 = cA + (size_t)(t + 1) * kstep;
            const char* a2 = last ? nA : cA + (size_t)(t + 2) * kstep; const char* b2 = last ? nB : cB + (size_t)(t + 2) * kstep;
            const char* a3 = a2 + kstep; const char* b3 = b2 + kstep;
            const unsigned x0 = last ? vN[0] : vA[0], x1 = last ? vN[1] : vA[1], x2 = last ? vN[2] : vA[2], x3 = last ? vN[3] : vA[3];
            PG8_LDB(B0, 0, 0); PG8_LDB(B1, 0, 1); PG8_SCHED; PG8_LDA(At, 0, 0); PG8_STAGE(PG8_SA(1, 1), a1, vA[2], vA[3]);
            PG8_WAIT_V(8); PG8_WAIT_L(0); PG8_BAR; PG8_MMA(0, 0, At, B0); PG8_MMA(0, 1, At, B1); PG8_BAR; PG8_SCHED;
            PG8_LDA(At, 0, 1); PG8_STAGE(PG8_SB(0, 0), b2, voffB[0], voffB[1]); PG8_STAGE(PG8_SB(0, 1), b2 + hstepB, voffB[0], voffB[1]); PG8_STAGE(PG8_SA(0, 0), a2, x0, x1);
            PG8_WAIT_V(8); PG8_WAIT_L(0); PG8_BAR; if (!lo_only) { PG8_MMA(1, 0, At, B0); PG8_MMA(1, 1, At, B1); } PG8_BAR; PG8_SCHED;
            PG8_LDB(B0, 1, 0); PG8_LDB(B1, 1, 1); PG8_SCHED; PG8_LDA(At, 1, 0); PG8_STAGE(PG8_SA(0, 1), a2, x2, x3);
            PG8_WAIT_V(8); PG8_WAIT_L(0); PG8_BAR; PG8_MMA(0, 0, At, B0); PG8_MMA(0, 1, At, B1); PG8_BAR; PG8_SCHED;
            PG8_LDA(At, 1, 1); PG8_STAGE(PG8_SB(1, 0), b3, voffB[0], voffB[1]); PG8_STAGE(PG8_SB(1, 1), b3 + hstepB, voffB[0], voffB[1]); PG8_STAGE(PG8_SA(1, 0), a3, x0, x1);
            PG8_WAIT_V(8); PG8_WAIT_L(0); PG8_BAR; if (!lo_only) { PG8_MMA(1, 0, At, B0); PG8_MMA(1, 1, At, B1); } PG8_BAR; PG8_SCHED;
        }
        if (wr == 0) PG8_BAR;
        if constexpr (FP8) asm volatile("s_nop 15\n\ts_nop 15");
        { int tz = threadIdx.x; asm volatile("" : "+v"(tz));
          const int wid_ = tz >> 6, lane_ = tz & 63; E(acc, cur, wid_ >> 2, wid_ & 3, lane_ & 15, lane_ >> 4);
#ifdef PROBE_EPI2
          if constexpr (Epi::PROBE2) { asm volatile("" : "+v"(tz)); const int w2 = tz >> 6, l2 = tz & 63; E(acc, cur, w2 >> 2, w2 & 3, l2 & 15, l2 >> 4); }
#endif
#ifdef PROBE_DRAIN
          if constexpr (Epi::PROBE2) { asm volatile("s_waitcnt vmcnt(0)" ::: "memory"); }
#endif
        }
        if constexpr (Sched::HOOK) { if (ui == Sched::HOOK_UNIT) { asm volatile("s_waitcnt vmcnt(0)" ::: "memory"); PG8_BAR; S.publish(); } }
        if (!has_next) break;
#pragma unroll
        for (int a = 0; a < 2; ++a)
#pragma unroll
            for (int b = 0; b < 2; ++b)
#pragma unroll
                for (int m = 0; m < 4; ++m)
#pragma unroll
                    for (int n = 0; n < 2; ++n) acc[a][b][m][n] = (f32x4){0.f, 0.f, 0.f, 0.f};
        cur = nxt; cA = nA; cB = nB; ++ui;
        vA[0] = vN[0]; vA[1] = vN[1]; vA[2] = vN[2]; vA[3] = vN[3];
        if (wr == 1) PG8_BAR;
    }
    PG8_WAIT_V(0);
    PG8_BAR;
#undef PG8_SA
#undef PG8_SB
#undef PG8_STAGE
#undef PG8_LDA
#undef PG8_LDB
#undef PG8_H0
#undef PG8_H1
#undef PG8_MMA
#undef PG8_WAIT_V
#undef PG8_WAIT_L
#undef PG8_BAR
#undef PG8_SCHED
}
}

struct Args { const float* in[27]; float* out; unsigned char* ws; int ph_lo, ph_hi; };
static_assert(sizeof(Args) == 27 * 8 + 8 + 8 + 8, "Args has no padding");

struct DenseU { const char* A; const char* B; int pm, pn; };
struct DenseSched {
    typedef DenseU U; static constexpr bool HOOK = false; static constexpr int HOOK_UNIT = -1; __device__ __forceinline__ void publish() const {} __device__ __forceinline__ bool lo_only(const U&) const { return false; }
    const char* A; const char* B; int lda, K, nM, nN, nwg, G, c;
    __device__ __forceinline__ void init(const void* A_, const void* B_, int lda_, int K_, int M, int N, int G_, int c_) { A = (const char*)A_; B = (const char*)B_; lda = lda_; K = K_; nM = M / 256; nN = N / 256; nwg = nM * nN; G = G_; c = c_; }
    __device__ __forceinline__ bool next(int i, U& u) const {
        const long L = (long)i * G + c; if (L >= nwg) return false;
        int wgid = (int)L; { const int q = nwg / 8, r = nwg % 8, xcd = wgid % 8, off = wgid / 8; wgid = (xcd < r ? xcd * (q + 1) : r * (q + 1) + (xcd - r) * q) + off; }
        const int nig = 8 * nN, gid = wgid / nig, fm = gid * 8, gsz = (nM - fm) < 8 ? (nM - fm) : 8;
        u.pm = fm + ((wgid % nig) % gsz); u.pn = (wgid % nig) / gsz;
        u.A = A + (size_t)u.pm * 256 * lda * 2; u.B = B + (size_t)u.pn * 256 * K * 2; return true;
    }
    __device__ __forceinline__ void aoffs(const U&, const int (&R)[2], const int (&C)[2], unsigned (&v)[4]) const {
#pragma unroll
        for (int h = 0; h < 2; ++h)
#pragma unroll
            for (int i = 0; i < 2; ++i) v[h * 2 + i] = (unsigned)((h * 128 + R[i]) * lda + C[i]) * 2u;
    }
};
constexpr int CTL_INPROJ_DONE = 15200;
struct InSched {
    typedef DenseU U; static constexpr bool HOOK = true; static constexpr int HOOK_UNIT = 3; __device__ __forceinline__ bool lo_only(const U&) const { return false; }
    DenseSched D;
    unsigned* done;
    static constexpr int NLAT = 64 * 17, NCTX = 8 * 7;
    __device__ __forceinline__ void publish() const {
        if (D.G == 256 && threadIdx.x == 0) { __builtin_amdgcn_fence(__ATOMIC_RELEASE, "agent"); asm volatile("s_waitcnt vmcnt(0)" ::: "memory"); (void)__hip_atomic_fetch_add(done, 1u, __ATOMIC_RELAXED, __HIP_MEMORY_SCOPE_AGENT); } }
    __device__ __forceinline__ void fin(U& u) const { u.A = D.A + (size_t)u.pm * 256 * D.lda * 2; u.B = D.B + (size_t)u.pn * 256 * D.K * 2; }
    __device__ __forceinline__ bool next(int i, U& u) const {
        const int L = i * D.G + D.c;
        if (D.G != 256) { if (L < NLAT) return D.next(i, u); const int j = L - NLAT; if (j >= NCTX) return false; const int q = j % 7; u.pm = 64 + j / 7; u.pn = q < 6 ? q + 2 : 16; fin(u); return true; }
        if (L < 960) { D.next(i, u); u.pn = u.pn < 10 ? u.pn : u.pn + 2; fin(u); return true; }
        if (L < 1016) { const int j = L - 960, q = j % 7; u.pm = 64 + j / 7; u.pn = q < 6 ? q + 2 : 16; fin(u); return true; }
        if (L < 1024) { u.pm = 56 + (L - 1016); u.pn = 10; fin(u); return true; }
        if (L < 1088) { u.pm = L - 1024; u.pn = 11; fin(u); return true; }
        if (L < 1144) { u.pm = L - 1088; u.pn = 10; fin(u); return true; }
        return false;
    }
    __device__ __forceinline__ void aoffs(const U& u, const int (&R)[2], const int (&C)[2], unsigned (&v)[4]) const { D.aoffs(u, R, C, v); }
};
struct PoolU { const char* A; const char* B; int pm, g; };
struct PoolSched {
    typedef PoolU U; static constexpr bool HOOK = false; static constexpr int HOOK_UNIT = -1; __device__ __forceinline__ void publish() const {} __device__ __forceinline__ bool lo_only(const U&) const { return false; }
    const char* A; const char* B; int G, c;
    __device__ __forceinline__ bool next(int i, U& u) const {
        const int L = i * G + c; if (L >= 256) return false;
        u.g = L & 3; u.pm = L >> 2;
        u.A = A + ((size_t)u.pm * 256 * 1024 + u.g * 256) * 2; u.B = B + (size_t)u.g * 256 * 256 * 2; return true;
    }
    __device__ __forceinline__ void aoffs(const U&, const int (&R)[2], const int (&C)[2], unsigned (&v)[4]) const {
#pragma unroll
        for (int h = 0; h < 2; ++h)
#pragma unroll
            for (int i = 0; i < 2; ++i) v[h * 2 + i] = (unsigned)((h * 128 + R[i]) * 1024 + C[i]) * 2u;
    }
};
struct MoeU { const char* A; const char* B; int row0, nrows, pn; };
struct MoeGUSched {
    typedef MoeU U; static constexpr bool HOOK = false; static constexpr int HOOK_UNIT = -1; __device__ __forceinline__ void publish() const {} __device__ __forceinline__ bool lo_only(const U& u) const { return u.nrows <= 128; }
    const char* H2; const char* W; const int* tile; const int* slot_tok; int G, c;
    __device__ __forceinline__ bool next(int i, U& u) const {
        const int nt = tile[3 * NTILE_MAX]; const int L = i * G + c; if (L >= nt * 4) return false;
        const int t = L >> 2; u.pn = L & 3; const int e = tile[t]; u.row0 = tile[NTILE_MAX + t]; u.nrows = tile[2 * NTILE_MAX + t];
        u.A = H2; u.B = W + ((size_t)e * 1024 + u.pn * 256) * 2048; return true;
    }
    __device__ __forceinline__ void aoffs(const U& u, const int (&R)[2], const int (&C)[2], unsigned (&v)[4]) const {
#pragma unroll
        for (int h = 0; h < 2; ++h)
#pragma unroll
            for (int i = 0; i < 2; ++i) { int r = h * 128 + R[i]; r = r < u.nrows ? r : u.nrows - 1; const int tok = slot_tok[u.row0 + r]; v[h * 2 + i] = (unsigned)(tok * 1024 + C[i]) * 2u; }
    }
};
struct MoeDownSched {
    typedef MoeU U; static constexpr bool HOOK = false; static constexpr int HOOK_UNIT = -1; __device__ __forceinline__ void publish() const {} __device__ __forceinline__ bool lo_only(const U& u) const { return u.nrows <= 128; }
    const char* ACT; const char* W; const int* tile; int G, c;
    __device__ __forceinline__ bool next(int i, U& u) const {
        const int nt = tile[3 * NTILE_MAX]; const int L = i * G + c; if (L >= nt * 8) return false;
        const int t = L >> 3; u.pn = L & 7; const int e = tile[t]; u.row0 = tile[NTILE_MAX + t]; u.nrows = tile[2 * NTILE_MAX + t];
        u.A = ACT + (size_t)u.row0 * 512; u.B = W + ((size_t)e * 2048 + u.pn * 256) * 512; return true;
    }
    __device__ __forceinline__ void aoffs(const U&, const int (&R)[2], const int (&C)[2], unsigned (&v)[4]) const {
#pragma unroll
        for (int h = 0; h < 2; ++h)
#pragma unroll
            for (int i = 0; i < 2; ++i) v[h * 2 + i] = (unsigned)((h * 128 + R[i]) * 256 + C[i]) * 2u;
    }
};

constexpr float SC_W = 256.f, SC_H = 16.f, SC_A = 16.f, SC_Y = 8.f;
__device__ __forceinline__ unsigned pk4_fp8(float a, float b, float c, float d) {
    a = __builtin_amdgcn_fmed3f(a, -448.f, 448.f); b = __builtin_amdgcn_fmed3f(b, -448.f, 448.f); c = __builtin_amdgcn_fmed3f(c, -448.f, 448.f); d = __builtin_amdgcn_fmed3f(d, -448.f, 448.f);
    unsigned w = 0; w = __builtin_amdgcn_cvt_pk_fp8_f32(a, b, w, false); w = __builtin_amdgcn_cvt_pk_fp8_f32(c, d, w, true); return w;
}
struct EpiIn {
    static constexpr int PERMK = 1; static constexpr bool PROBE2 = false;
    unsigned char* ws;
    __device__ __forceinline__ void operator()(const f32x4 (&acc)[2][2][4][2], const DenseU& u, int wr, int wc, int fr, int fq) const {
        const int pn = u.pn; const int row0 = u.pm * 256 + wr * 64 + fr;
        if (pn == 16) {
            if (wc != 0) return;
            float* alr = (float*)(ws + RA_ALR);
#pragma unroll
            for (int ai = 0; ai < 2; ++ai)
#pragma unroll
                for (int m = 0; m < 4; ++m) { float* rp = alr + (size_t)(row0 + ai * 128 + m * 16) * 32 + 8 * fq;
                    *(f32x4*)(rp) = acc[ai][0][m][0]; *(f32x4*)(rp + 4) = acc[ai][0][m][1]; }
            return;
        }
        bf16* base; int ld, colt; bool lat_only;
        if (pn < 2) { base = (bf16*)(ws + RA_Q); ld = 512; colt = pn * 256; lat_only = true; }
        else if (pn < 4) { base = (bf16*)(ws + RA_K); ld = 512; colt = (pn - 2) * 256; lat_only = false; }
        else if (pn < 8) { base = (bf16*)(ws + RA_V); ld = 1024; colt = (pn - 4) * 256; lat_only = false; }
        else if (pn < 12) { base = (bf16*)(ws + RA_R); ld = 1024; colt = (pn - 8) * 256; lat_only = true; }
        else { base = (bf16*)(ws + RA_P); ld = 1024; colt = (pn - 12) * 256; lat_only = true; }
        if (lat_only && u.pm >= 64) return;
        const int col0 = colt + wc * 32 + 8 * fq;
#pragma unroll
        for (int ai = 0; ai < 2; ++ai)
#pragma unroll
            for (int m = 0; m < 4; ++m) { bf16* rp = base + (size_t)(row0 + ai * 128 + m * 16) * ld + col0;
#pragma unroll
                for (int bj = 0; bj < 2; ++bj) { const f32x4 v0 = acc[ai][bj][m][0], v1 = acc[ai][bj][m][1];
                    v4u o; o.x = pg8::cvt_pk_bf16(v0[0], v0[1]); o.y = pg8::cvt_pk_bf16(v0[2], v0[3]); o.z = pg8::cvt_pk_bf16(v1[0], v1[1]); o.w = pg8::cvt_pk_bf16(v1[2], v1[3]);
                    *(v4u*)(rp + bj * 128) = o; } }
    }
};
struct EpiPool {
    static constexpr int PERMK = 1; static constexpr bool PROBE2 = false;
    unsigned char* ymix; const float* scale;
    __device__ __forceinline__ void operator()(const f32x4 (&acc)[2][2][4][2], const PoolU& u, int wr, int wc, int fr, int fq) const {
        const int row0 = u.pm * 256 + wr * 64 + fr; const int c0 = u.g * 256 + wc * 32 + 8 * fq;
#pragma unroll
        for (int ai = 0; ai < 2; ++ai)
#pragma unroll
            for (int m = 0; m < 4; ++m) { unsigned char* rp = ymix + (size_t)(row0 + ai * 128 + m * 16) * 2048 + 1024 + c0;
#pragma unroll
                for (int bj = 0; bj < 2; ++bj) { const f32x4 s0 = *(const f32x4*)(scale + c0 + bj * 128) * SC_Y, s1 = *(const f32x4*)(scale + c0 + bj * 128 + 4) * SC_Y;
                    const f32x4 v0 = acc[ai][bj][m][0] * s0, v1 = acc[ai][bj][m][1] * s1;
                    v2u o; o.x = pk4_fp8(v0[0], v0[1], v0[2], v0[3]); o.y = pk4_fp8(v1[0], v1[1], v1[2], v1[3]);
                    *(v2u*)(rp + bj * 128) = o; } }
    }
};
struct EpiOut {
    static constexpr int PERMK = 1; static constexpr bool PROBE2 = false;
    bf16* y;
    __device__ __forceinline__ void operator()(const f32x4 (&acc)[2][2][4][2], const DenseU& u, int wr, int wc, int fr, int fq) const {
        const int row0 = u.pm * 256 + wr * 64 + fr, col0 = u.pn * 256 + wc * 32 + 8 * fq;
#pragma unroll
        for (int ai = 0; ai < 2; ++ai)
#pragma unroll
            for (int m = 0; m < 4; ++m) { bf16* rp = y + (size_t)(row0 + ai * 128 + m * 16) * 2048 + col0;
#pragma unroll
                for (int bj = 0; bj < 2; ++bj) { constexpr float inv = 1.f / (SC_W * SC_Y); const f32x4 v0 = acc[ai][bj][m][0] * inv, v1 = acc[ai][bj][m][1] * inv;
                    v4u o; o.x = pg8::cvt_pk_bf16(v0[0], v0[1]); o.y = pg8::cvt_pk_bf16(v0[2], v0[3]); o.z = pg8::cvt_pk_bf16(v1[0], v1[1]); o.w = pg8::cvt_pk_bf16(v1[2], v1[3]);
                    *(v4u*)(rp + bj * 128) = o; } }
    }
};
struct EpiGU {
    static constexpr int PERMK = 1; static constexpr bool PROBE2 = false;
    unsigned char* act; const float* slot_w;
    __device__ __forceinline__ void operator()(const f32x4 (&acc)[2][2][4][2], const MoeU& u, int wr, int wc, int fr, int fq) const {
        const int c0 = u.pn * 128 + wc * 32 + 8 * fq; constexpr float inv = 1.f / (SC_W * SC_H);
#pragma unroll
        for (int ai = 0; ai < 2; ++ai)
#pragma unroll
            for (int m = 0; m < 4; ++m) { const int r = ai * 128 + wr * 64 + m * 16 + fr;
                if (r < u.nrows) { const float w = slot_w[u.row0 + r] * SC_A; float o[8];
#pragma unroll
                    for (int n = 0; n < 2; ++n)
#pragma unroll
                        for (int j = 0; j < 4; ++j) { const float g = acc[ai][0][m][n][j] * inv, up = acc[ai][1][m][n][j] * inv; o[n * 4 + j] = silu_f(g) * up * w; }
                    v2u q; q.x = pk4_fp8(o[0], o[1], o[2], o[3]); q.y = pk4_fp8(o[4], o[5], o[6], o[7]);
                    *(v2u*)(act + (size_t)(u.row0 + r) * 512 + c0) = q; } }
    }
};
constexpr float SC_O = 32.f;
struct EpiDown {
    static constexpr int PERMK = 2; static constexpr bool PROBE2 = true;
    unsigned char* so;
    __device__ __forceinline__ void operator()(const f32x4 (&acc)[2][2][4][2], const MoeU& u, int wr, int wc, int fr, int fq) const {
        const int c0 = u.pn * 256 + wc * 64 + 16 * fq; constexpr float sc = SC_O / (SC_W * SC_A);
#pragma unroll
        for (int ai = 0; ai < 2; ++ai)
#pragma unroll
            for (int m = 0; m < 4; ++m) { const int r = ai * 128 + wr * 64 + m * 16 + fr;
                if (r < u.nrows) { const f32x4 a0 = acc[ai][0][m][0] * sc, a1 = acc[ai][0][m][1] * sc, b0 = acc[ai][1][m][0] * sc, b1 = acc[ai][1][m][1] * sc;
                    v4u o; o.x = pk4_fp8(a0[0], a0[1], a0[2], a0[3]); o.y = pk4_fp8(a1[0], a1[1], a1[2], a1[3]); o.z = pk4_fp8(b0[0], b0[1], b0[2], b0[3]); o.w = pk4_fp8(b1[0], b1[1], b1[2], b1[3]);
                    __builtin_nontemporal_store(o, (v4u*)(so + (size_t)(u.row0 + r) * 2048 + c0)); } }
    }
};

__device__ __forceinline__ void tr_item(const float* W, int ldn, bf16* WT, int Kd, int drow0, int k0, int n0, LAS float* scr, int lane) {
    f32x4 t[8];
#pragma unroll
    for (int i = 0; i < 8; ++i) t[i] = __builtin_nontemporal_load((const f32x4*)(W + (size_t)(k0 + 8 * i + (lane >> 3)) * ldn + n0 + 4 * (lane & 7)));
#pragma unroll
    for (int i = 0; i < 8; ++i) { LAS float* d = scr + (8 * i + (lane >> 3)) * 33 + 4 * (lane & 7); d[0] = t[i][0]; d[1] = t[i][1]; d[2] = t[i][2]; d[3] = t[i][3]; }
    LDS_WAIT(); asm volatile("" ::: "memory");
    const int c = lane & 7;
#pragma unroll
    for (int j = 0; j < 4; ++j) { const int n = (lane >> 3) + 8 * j; const LAS float* s = scr + (8 * c) * 33 + n;
        v4u o; o.x = pk2(s[0 * 33], s[1 * 33]); o.y = pk2(s[2 * 33], s[3 * 33]); o.z = pk2(s[4 * 33], s[5 * 33]); o.w = pk2(s[6 * 33], s[7 * 33]);
        *(v4u*)(WT + (size_t)(drow0 + n) * Kd + k0 + 8 * c) = o; }
    LDS_WAIT(); asm volatile("" ::: "memory");
}

__device__ __forceinline__ void tr_item8(const float* W, int ldn, unsigned char* WT, int Kd, int drow0, int k0, int n0, LAS float* scr, int lane) {
    f32x4 t[8];
#pragma unroll
    for (int i = 0; i < 8; ++i) t[i] = __builtin_nontemporal_load((const f32x4*)(W + (size_t)(k0 + 8 * i + (lane >> 3)) * ldn + n0 + 4 * (lane & 7)));
#pragma unroll
    for (int i = 0; i < 8; ++i) { LAS float* d = scr + (8 * i + (lane >> 3)) * 33 + 4 * (lane & 7); d[0] = t[i][0]; d[1] = t[i][1]; d[2] = t[i][2]; d[3] = t[i][3]; }
    LDS_WAIT(); asm volatile("" ::: "memory");
    const int c = lane & 7;
#pragma unroll
    for (int j = 0; j < 4; ++j) { const int n = (lane >> 3) + 8 * j; const LAS float* s = scr + (8 * c) * 33 + n;
        v2u o; o.x = pk4_fp8(s[0 * 33] * SC_W, s[1 * 33] * SC_W, s[2 * 33] * SC_W, s[3 * 33] * SC_W); o.y = pk4_fp8(s[4 * 33] * SC_W, s[5 * 33] * SC_W, s[6 * 33] * SC_W, s[7 * 33] * SC_W);
        *(v2u*)(WT + (size_t)(drow0 + n) * Kd + k0 + 8 * c) = o; }
    LDS_WAIT(); asm volatile("" ::: "memory");
}

constexpr int I_IN = 32 * 129, I_OUT = 32 * 64, I_POOL = 4 * 4 * 8, I_E = 65 * 512;
constexpr int NITEMS = I_IN + I_OUT + I_POOL + 3 * I_E;
constexpr int N_DOWN_CHAIN = 36 * 2048 - 2 * I_E;
constexpr int N_DOWN_PREP = 72 * 8 * 4;
constexpr int N_DOWN_POST = 4 * 2048;
constexpr int NITEMS_P0 = NITEMS - 33280;
__device__ __forceinline__ void convert_items(const Args& a, LAS float* scr, int lane, int first, int step, int end, int skip = 0) {
    unsigned char* ws = a.ws;
    bf16* Win_t = (bf16*)(ws + WS_WIN); unsigned char* Wout_t = ws + WS_WOUT; bf16* Wpool_t = (bf16*)(ws + WS_WPOOL); unsigned char* Wd_t = ws + WS_WD; unsigned char* Wgu_t = ws + WS_WGU;
    for (int it = first; it < end; it += step) {
        int r = it < I_IN + I_OUT + I_POOL ? it : it + skip;
        if (r < I_IN) { const int kb = r / 129, nb = r % 129, n0 = 32 * nb; const int drow = n0 < 3072 ? n0 : (n0 == 3072 ? 4096 : n0 - 32);
            tr_item(a.in[10], DIN, Win_t, 2048, drow, 64 * kb, n0, scr, lane); continue; } r -= I_IN;
        if (r < I_OUT) { const int kb = r / 64, nb = r % 64; tr_item8(a.in[18], 2048, Wout_t, 2048, 32 * nb, 64 * kb, 32 * nb, scr, lane); continue; } r -= I_OUT;
        if (r < I_POOL) { const int g = r / 32, rr = r % 32, kb = rr / 8, nb = rr % 8; tr_item(a.in[16] + g * 65536, 256, Wpool_t + g * 65536, 256, 32 * nb, 64 * kb, 32 * nb, scr, lane); continue; } r -= I_POOL;
        if (r < I_E) { const int e = r / 512, rr = r % 512, kb = rr / 16, nb = rr % 16, n0 = 32 * nb; const float* src = e < 64 ? a.in[21] + (size_t)e * 2048 * 512 : a.in[24];
            tr_item8(src, 512, Wgu_t + (size_t)e * 1024 * 2048, 2048, (n0 / 128) * 256 + (n0 % 128), 64 * kb, n0, scr, lane); continue; } r -= I_E;
        if (r < I_E) { const int e = r / 512, rr = r % 512, kb = rr / 16, nb = rr % 16, n0 = 32 * nb; const float* src = e < 64 ? a.in[22] + (size_t)e * 2048 * 512 : a.in[25];
            tr_item8(src, 512, Wgu_t + (size_t)e * 1024 * 2048, 2048, (n0 / 128) * 256 + 128 + (n0 % 128), 64 * kb, n0, scr, lane); continue; } r -= I_E;
        { const int e = 64 - r / 512, rr = r % 512, kb = rr / 64, nb = rr % 64; const float* src = e < 64 ? a.in[23] + (size_t)e * 512 * 2048 : a.in[26];
            tr_item8(src, 2048, Wd_t + (size_t)e * 2048 * 512, 512, 32 * nb, 64 * kb, 32 * nb, scr, lane); }
    }
}

__device__ __forceinline__ void phase0(const Args& a, LAS unsigned char* lds, int tid, int lane, int wave, int vcu, int G, bool do_mod = true, bool do_tr = true) {
    unsigned char* ws = a.ws;
    if (vcu < 192 && do_mod) {
        LAS float* sc = (LAS float*)lds;
        LAS float* red = (LAS float*)(lds + 73728);
        { float vb[36];
#pragma unroll
          for (int j = 0; j < 36; ++j) { const int i = tid + 512 * j, k = i & 2047; vb[j] = j < 32 ? a.in[1][(j >> 2) * 2048 + k] : a.in[3][k]; }
#pragma unroll
          for (int j = 0; j < 36; ++j) sc[tid + 512 * j] = silu_f(vb[j]); }
        __syncthreads();
        const float* wm = a.in[4]; const float* bm = a.in[5]; float* mod = (float*)(ws + WS_MOD);
        for (int chunk = vcu; chunk < 192; chunk += G) {
            const int n0 = chunk * 64, ks = lane >> 4, n4 = (lane & 15) * 4;
            f32x4 acc[9];
#pragma unroll
            for (int r = 0; r < 9; ++r) acc[r] = (f32x4){0.f, 0.f, 0.f, 0.f};
#pragma unroll 4
            for (int kk = 0; kk < 256; kk += 4) { const int k = wave * 256 + kk + ks; const f32x4 wv = __builtin_nontemporal_load((const f32x4*)(wm + (size_t)k * 12288 + n0 + n4));
#pragma unroll
                for (int r = 0; r < 9; ++r) { const float s = sc[r * 2048 + k]; acc[r] += wv * s; } }
#pragma unroll
            for (int r = 0; r < 9; ++r)
#pragma unroll
                for (int j = 0; j < 4; ++j) { float v = acc[r][j]; v += __shfl_xor(v, 16); v += __shfl_xor(v, 32); acc[r][j] = v; }
            if (lane < 16) {
#pragma unroll
                for (int r = 0; r < 9; ++r) *(LAS f32x4*)(red + (wave * 9 + r) * 64 + n4) = acc[r]; }
            __syncthreads();
            for (int i = tid; i < 9 * 64; i += 512) { const int r = i >> 6, n = i & 63; float s = 0.f;
#pragma unroll
                for (int w = 0; w < 8; ++w) s += red[(w * 9 + r) * 64 + n];
                mod[r * 12288 + n0 + n] = s + bm[n0 + n]; }
            __syncthreads();
        }
    }
    __syncthreads();
    if (do_tr) convert_items(a, (LAS float*)(lds + wave * 16384), lane, vcu * 8 + wave, G * 8, NITEMS_P0 - 2 * I_E, 2 * I_E);
    { const float* wr = a.in[19]; bf16* whi = (bf16*)(ws + WS_WRT); bf16* wlo = whi + 64 * 2048;
      for (int idx = vcu * 512 + tid; idx < 64 * 256; idx += G * 512) { const int e = idx >> 8, k8 = idx & 255; unsigned hi[8], lo[8];
#pragma unroll
          for (int j = 0; j < 8; ++j) { const float v = wr[(size_t)(8 * k8 + j) * 64 + e]; hi[j] = f2bf(v); lo[j] = f2bf(v - __builtin_bit_cast(float, hi[j] << 16)); }
          v4u oh, ol; oh.x = hi[0] | (hi[1] << 16); oh.y = hi[2] | (hi[3] << 16); oh.z = hi[4] | (hi[5] << 16); oh.w = hi[6] | (hi[7] << 16);
          ol.x = lo[0] | (lo[1] << 16); ol.y = lo[2] | (lo[3] << 16); ol.z = lo[4] | (lo[5] << 16); ol.w = lo[6] | (lo[7] << 16);
          *(v4u*)(whi + (size_t)e * 2048 + 8 * k8) = oh; (void)ol; (void)wlo; } }
    { v4u* z = (v4u*)((bf16*)(ws + WS_WIN) + (size_t)DIN * 2048); const int nz = (DINP - DIN) * 2048 / 8;
      for (int i = vcu * 512 + tid; i < nz; i += G * 512) z[i] = (v4u){0u, 0u, 0u, 0u}; }
}

__device__ __forceinline__ void phase1(const Args& a, int lane, int wave, int vcu, int G) {
    const float* mod = (const float*)(a.ws + WS_MOD); bf16* H = (bf16*)(a.ws + RA_H); const float* g = a.in[6];
    for (int m = vcu * 8 + wave; m < MROWS; m += G * 8) {
        const float* xr = m < NT ? a.in[0] + (size_t)m * 2048 : a.in[2] + (size_t)(m - NT) * 2048;
        const float* mr = mod + (size_t)(m < NT ? (m >> 11) : 8) * 12288;
        f32x4 v[8]; float ss = 0.f;
#pragma unroll
        for (int j = 0; j < 8; ++j) { v[j] = __builtin_nontemporal_load((const f32x4*)(xr + 4 * (lane + 64 * j))); ss += v[j][0] * v[j][0] + v[j][1] * v[j][1] + v[j][2] * v[j][2] + v[j][3] * v[j][3]; }
        const float rstd = rsqrtf(wave_sum(ss) * (1.f / 2048.f) + EPS);
#pragma unroll
        for (int j = 0; j < 8; ++j) { const int c = 4 * (lane + 64 * j); const f32x4 gg = *(const f32x4*)(g + c), sh = *(const f32x4*)(mr + c), sc = *(const f32x4*)(mr + 2048 + c);
            const f32x4 o = v[j] * rstd * gg * (sc + 1.f) + sh;
            v2u q; q.x = pk2(o[0], o[1]); q.y = pk2(o[2], o[3]); *(v2u*)(H + (size_t)m * 2048 + c) = q; }
    }
}

__device__ __forceinline__ int scan_row(int b, int dir, int s) {
    if (s < 256) { const int tc = dir ? 255 - s : s; return NT + b * 256 + tc; }
    const int t0 = s - 256; return b * 2048 + (dir ? 2047 - t0 : t0);
}
constexpr float L2E = 1.4426950408889634f;
__device__ __forceinline__ unsigned cvtpk_bf16(float lo, float hi) { unsigned r; asm("v_cvt_pk_bf16_f32 %0, %1, %2" : "=v"(r) : "v"(lo), "v"(hi)); return r; }
__device__ __forceinline__ void prep_item(const Args& a, LAS unsigned char* lds, int tid, int dir, int b, int ch) {
    unsigned char* ws = a.ws;
    const bf16* Q = (const bf16*)(ws + RA_Q); const bf16* Kb = (const bf16*)(ws + RA_K); const float* ALR = (const float*)(ws + RA_ALR);
    v4u* QG = (v4u*)(ws + PQG); bf16* AM = (bf16*)(ws + PAM); bf16* KD = (bf16*)(ws + PKD); float* DEC = (float*)(ws + PDEC);
    constexpr int TS = 520;
    LAS float* alr = (LAS float*)lds;
    LAS bf16* Kt = (LAS bf16*)(lds + 4096);
    LAS bf16* Qt = (LAS bf16*)(lds + 4096 + 64 * TS * 2);
    const int col = tid, h = col >> 7, dk = col & 127;
    const int lane = tid & 63, wave = __builtin_amdgcn_readfirstlane(tid >> 6), l15 = lane & 15, l4 = lane >> 4;
    const bool lat = ch >= 4;
    if (tid < 256) { const int i = tid >> 2, r4 = (tid & 3) * 4; const int row = scan_row(b, dir, ch * 64 + i);
        *(LAS f32x4*)(alr + i * 16 + r4) = *(const f32x4*)(ALR + (size_t)row * 32 + dir * 16 + r4); }
    { v4u kr[8], qr[8];
#pragma unroll
      for (int q = 0; q < 8; ++q) { const int p = tid + 512 * q, i = p >> 6, c8 = (p & 63) * 8; const int row = scan_row(b, dir, ch * 64 + i);
          kr[q] = *(const v4u*)(Kb + (size_t)row * 512 + c8); if (lat) qr[q] = *(const v4u*)(Q + (size_t)row * 512 + c8); }
#pragma unroll
      for (int q = 0; q < 8; ++q) { const int p = tid + 512 * q, i = p >> 6, c8 = (p & 63) * 8; *(LAS v4u*)(Kt + i * TS + c8) = kr[q]; if (lat) *(LAS v4u*)(Qt + i * TS + c8) = qr[q]; } }
    const float* wa2 = dir ? a.in[13] : a.in[11]; const float bia = (dir ? a.in[14] : a.in[12])[col];
    float w[16];
#pragma unroll
    for (int r = 0; r < 16; ++r) w[r] = wa2[r * 512 + col];
    LDS_BARRIER();
    float Gv[64]; float Gc = 0.f;
#pragma unroll
    for (int i = 0; i < 64; ++i) { float zp[4];
#pragma unroll
        for (int r4 = 0; r4 < 4; ++r4) { const f32x4 x = *(const LAS f32x4*)(alr + i * 16 + 4 * r4); zp[r4] = x[0] * w[4 * r4] + x[1] * w[4 * r4 + 1] + x[2] * w[4 * r4 + 2] + x[3] * w[4 * r4 + 3]; }
        const float z = bia + ((zp[0] + zp[1]) + (zp[2] + zp[3]));
        Gc += fminf(z, 0.f) * (L2E / 16.f) - __builtin_amdgcn_logf(1.f + __builtin_amdgcn_exp2f(-fabsf(z) * L2E)) * (1.f / 16.f); Gv[i] = Gc; }
    const float Gmid = Gv[32], Gend = Gv[63];
    DEC[((size_t)(dir * 8 + b) * 36 + ch) * 512 + col] = __builtin_amdgcn_exp2f(Gend);
    const float eEM = __builtin_amdgcn_exp2f(Gend - Gmid);
    bf16* kdrow = KD + ((((size_t)(dir * 8 + b) * 36 + ch) * 4 + h) * 128 + dk) * 64;
#pragma unroll
    for (int i0 = 0; i0 < 64; i0 += 8) { float kd[8];
#pragma unroll
        for (int ii = 0; ii < 8; ++ii) { const int i = i0 + ii; const float kv = bf1(Kt[i * TS + col]);
            if (lat) { const float em = __builtin_amdgcn_exp2f(Gmid - Gv[i]); kd[ii] = kv * (em * eEM);
                const float qv = bf1(Qt[i * TS + col]) * 0.08838834764831845f;
                const unsigned qk = cvtpk_bf16(qv * __builtin_amdgcn_exp2f(Gv[i] - Gmid), kv * em);
                Qt[i * TS + col] = (bf16)(qk & 0xffffu); Kt[i * TS + col] = (bf16)(qk >> 16); }
            else kd[ii] = kv * __builtin_amdgcn_exp2f(Gend - Gv[i]); }
        v4u o; o.x = cvtpk_bf16(kd[0], kd[1]); o.y = cvtpk_bf16(kd[2], kd[3]); o.z = cvtpk_bf16(kd[4], kd[5]); o.w = cvtpk_bf16(kd[6], kd[7]);
        *(v4u*)(kdrow + i0) = o; }
    if (lat) {
        LDS_BARRIER();
        const int hh = wave >> 1; bf16* amt = AM + ((((size_t)(dir * 8 + b) * 32 + (ch - 4)) * 4 + hh) * 64) * 64;
#pragma unroll
        for (int t2 = 0; t2 < 2; ++t2) { const int ti = (wave & 1) * 2 + t2; f32x4 c[4];
#pragma unroll
            for (int tj = 0; tj < 4; ++tj) c[tj] = (f32x4){0.f, 0.f, 0.f, 0.f};
#pragma unroll
            for (int ks = 0; ks < 4; ++ks) { const int ko = hh * 128 + 32 * ks + 8 * l4;
                const bf16x8 bq = *(const LAS bf16x8*)(Qt + (16 * ti + l15) * TS + ko);
#pragma unroll
                for (int tj = 0; tj < 4; ++tj) { const bf16x8 ak = *(const LAS bf16x8*)(Kt + (16 * tj + l15) * TS + ko);
                    c[tj] = __builtin_amdgcn_mfma_f32_16x16x32_bf16(ak, bq, c[tj], 0, 0, 0); } }
            const int i = 16 * ti + l15;
#pragma unroll
            for (int tj = 0; tj < 4; ++tj) { const int j0 = 16 * tj + 4 * l4;
                v2u p; p.x = pk2(j0 <= i ? c[tj][0] : 0.f, j0 + 1 <= i ? c[tj][1] : 0.f); p.y = pk2(j0 + 2 <= i ? c[tj][2] : 0.f, j0 + 3 <= i ? c[tj][3] : 0.f);
                *(v2u*)(amt + i * 64 + j0) = p; } }
        LDS_BARRIER();
        { const float eg = __builtin_amdgcn_exp2f(Gmid);
#pragma unroll 8
          for (int i = 0; i < 64; ++i) Qt[i * TS + col] = (bf16)(cvtpk_bf16(bf1(Qt[i * TS + col]) * eg, 0.f) & 0xffffu); }
        LDS_BARRIER();
        { v4u* qgt = QG + ((((size_t)(dir * 8 + b) * 32 + (ch - 4)) * 4) * 1024);
#pragma unroll
          for (int q = 0; q < 8; ++q) { const int p = tid + 512 * q; const int hq = p >> 10, rem = p & 1023, i = rem >> 4, c16 = rem & 15;
              qgt[p] = *(const LAS v4u*)(Qt + i * TS + hq * 128 + c16 * 8); } }
    }
    LDS_BARRIER();
}
__device__ __forceinline__ void phase3_prep(const Args& a, LAS unsigned char* lds, int tid, int vcu, int G, int bx) {
    if (G == 256) {
#pragma unroll 1
        for (int k = 0; k < 3; ++k) {
            int code = -1;
            if (bx >= 120) code = (bx - 120) + 136 * k;
            else if (bx >= 104) { if (k < 2) code = -2 - (2 * (bx - 104) + k); }
            else { if (k == 0) code = 408 + bx; else if (k == 1 && bx < 32) code = -2 - (32 + bx); }
            if (code == -1) continue;
            const bool lat = code >= 0; const int item = lat ? code : -2 - code;
            const int dir = lat ? item >> 8 : item >> 5, b = lat ? (item >> 5) & 7 : (item >> 2) & 7, ch = lat ? 4 + (item & 31) : (item & 3);
            prep_item(a, lds, tid, dir, b, ch);
        }
        if (bx >= 32 && bx < 104) { const int wave = __builtin_amdgcn_readfirstlane(tid >> 6);
            convert_items(a, (LAS float*)(lds + wave * 16384), tid & 63, NITEMS_P0 + N_DOWN_CHAIN + (bx - 32) * 8 + wave, 72 * 8, NITEMS_P0 + N_DOWN_CHAIN + N_DOWN_PREP);
            LDS_BARRIER(); }
        return;
    }
    for (int item = vcu; item < 2 * 8 * 32; item += G) { const int lc = item & 31, b = (item >> 5) & 7, dir = item >> 8; prep_item(a, lds, tid, dir, b, 4 + lc); }
    for (int item = vcu; item < 2 * 8 * 4; item += G) { const int cc = item & 3, b = (item >> 2) & 7, dir = item >> 5; prep_item(a, lds, tid, dir, b, cc); }
}

struct ConvItem { const float* src; unsigned char* dst; int drow, k0, n0, lds, ldd; };
__device__ __forceinline__ ConvItem conv_decode(const Args& a, int id) {
    ConvItem c;
    if (id >= 2 * I_E) {
        int r = id - 2 * I_E; r = r < I_E ? r : r - I_E; const int e = 64 - r / 512, rr = r % 512, kb = rr / 64, nb = rr % 64;
        c.n0 = 32 * nb; c.k0 = 64 * kb; c.src = e < 64 ? a.in[23] + (size_t)e * 512 * 2048 : a.in[26]; c.dst = a.ws + WS_WD + (size_t)e * 2048 * 512; c.drow = c.n0; c.lds = 2048; c.ldd = 512; return c; }
    const int up = id >= I_E ? 1 : 0; const int r = id - up * I_E; const int e = r / 512, rr = r % 512, kb = rr / 16, nb = rr % 16;
    c.n0 = 32 * nb; c.k0 = 64 * kb; c.lds = 512; c.ldd = 2048;
    c.src = e < 64 ? a.in[21 + up] + (size_t)e * 2048 * 512 : a.in[24 + up];
    c.dst = a.ws + WS_WGU + (size_t)e * 1024 * 2048; c.drow = (c.n0 / 128) * 256 + up * 128 + (c.n0 % 128); return c;
}
__device__ __forceinline__ void conv_load(f32x4 (&t)[8], const ConvItem& c, int lane) {
#pragma unroll
    for (int i = 0; i < 8; ++i) t[i] = __builtin_nontemporal_load((const f32x4*)(c.src + (size_t)(c.k0 + 8 * i + (lane >> 3)) * c.lds + c.n0 + 4 * (lane & 7)));
}
__device__ __forceinline__ void conv_finish(const f32x4 (&t)[8], const ConvItem& c, LAS float* scr, int lane) {
#pragma unroll
    for (int i = 0; i < 8; ++i) { LAS float* d = scr + (8 * i + (lane >> 3)) * 33 + 4 * (lane & 7); d[0] = t[i][0]; d[1] = t[i][1]; d[2] = t[i][2]; d[3] = t[i][3]; }
    LDS_WAIT(); asm volatile("" ::: "memory");
    const int cc = lane & 7;
#pragma unroll
    for (int j = 0; j < 4; ++j) { const int n = (lane >> 3) + 8 * j; const LAS float* sp = scr + (8 * cc) * 33 + n;
        v2u o; o.x = pk4_fp8(sp[0 * 33] * SC_W, sp[1 * 33] * SC_W, sp[2 * 33] * SC_W, sp[3 * 33] * SC_W); o.y = pk4_fp8(sp[4 * 33] * SC_W, sp[5 * 33] * SC_W, sp[6 * 33] * SC_W, sp[7 * 33] * SC_W);
        __builtin_nontemporal_store(o, (v2u*)(c.dst + (size_t)(c.drow + n) * c.ldd + c.k0 + 8 * cc)); }
    LDS_WAIT(); asm volatile("" ::: "memory");
}
constexpr int GL_CONV = 73728;
constexpr int GL_QG = 0, GL_ST = 17408, GL_KDT = 34816, GL_VT = 53248, GL_AM = 62464, GL_DEC = 71680;
__device__ __forceinline__ void phase_chain(const Args& a, LAS unsigned char* lds, int tid, int lane, int wave, int vcu, int G) {
    unsigned char* ws = a.ws;
    const v4u* QG = (const v4u*)(ws + PQG); const v4u* AM = (const v4u*)(ws + PAM); const v4u* KD = (const v4u*)(ws + PKD); const float* DEC = (const float*)(ws + PDEC);
    const bf16* V = (const bf16*)(ws + RA_V); bf16* OF = (bf16*)(ws + RA_OF);
    const int l15 = lane & 15, l4 = lane >> 4;
    int cstep = 0;
    for (int item = vcu; item < 256; item += G) {
        const int vs = item & 3, dir = (item >> 2) & 1, h = (item >> 3) & 3, b = item >> 5;
        f32x4 S[4];
#pragma unroll
        for (int tv = 0; tv < 4; ++tv) S[tv] = (f32x4){0.f, 0.f, 0.f, 0.f};
        v4u rq[2], ra, rk[2], rv; float rdec = 0.f; f32x4 ct[8]; ConvItem ci;
#define GL_LOAD(ch_, LATL) do { const int ch__ = (ch_); \
            if (LATL) { const size_t t_ = ((((size_t)(dir * 8 + b) * 32 + (ch__ - 4)) * 4 + h) * 1024); rq[0] = QG[t_ + tid]; rq[1] = QG[t_ + tid + 512]; ra = AM[t_ / 2 + tid]; } \
            { const size_t t_ = ((((size_t)(dir * 8 + b) * 36 + ch__) * 4 + h) * 1024); rk[0] = KD[t_ + tid]; rk[1] = KD[t_ + tid + 512]; } \
            { const int row_ = scan_row(b, dir, ch__ * 64 + (tid >> 3)); rv = *(const v4u*)(V + (size_t)row_ * 1024 + h * 256 + vs * 64 + 8 * (tid & 7)); } \
            rdec = DEC[((size_t)(dir * 8 + b) * 36 + ch__) * 512 + h * 128 + (tid & 127)]; } while (0)
#define GL_STEP(ch_, LAT, LATN, MORE) do { const int ch = (ch_); \
              \
            _Pragma("unroll") for (int tv = 0; tv < 4; ++tv) { v2u p; p.x = pk2(S[tv][0], S[tv][1]); p.y = pk2(S[tv][2], S[tv][3]); \
                *(LAS v2u*)(lds + GL_ST + (16 * tv + l15) * 272 + (16 * wave + 4 * l4) * 2) = p; } \
            if (LAT) { _Pragma("unroll") for (int q = 0; q < 2; ++q) { const int p = tid + 512 * q; *(LAS v4u*)(lds + GL_QG + (p >> 4) * 272 + (p & 15) * 16) = rq[q]; } \
                *(LAS v4u*)(lds + GL_AM + (tid >> 3) * 144 + (tid & 7) * 16) = ra; } \
            _Pragma("unroll") for (int q = 0; q < 2; ++q) { const int p = tid + 512 * q; *(LAS v4u*)(lds + GL_KDT + (p >> 3) * 144 + (p & 7) * 16) = rk[q]; } \
            { const int i = tid >> 3, c = tid & 7; LAS bf16* vt = (LAS bf16*)(lds + GL_VT) + i; \
              vt[(8 * c + 0) * 72] = (bf16)(rv.x & 0xffffu); vt[(8 * c + 1) * 72] = (bf16)(rv.x >> 16); vt[(8 * c + 2) * 72] = (bf16)(rv.y & 0xffffu); vt[(8 * c + 3) * 72] = (bf16)(rv.y >> 16); \
              vt[(8 * c + 4) * 72] = (bf16)(rv.z & 0xffffu); vt[(8 * c + 5) * 72] = (bf16)(rv.z >> 16); vt[(8 * c + 6) * 72] = (bf16)(rv.w & 0xffffu); vt[(8 * c + 7) * 72] = (bf16)(rv.w >> 16); } \
            if (tid < 128) *(LAS float*)(lds + GL_DEC + tid * 4) = rdec; \
            LDS_BARRIER(); \
            if (MORE) GL_LOAD(ch + 1, LATN); \
            if (LAT) {   \
                const int ti = wave >> 1, tv0 = (wave & 1) * 2; f32x4 c0 = (f32x4){0.f, 0.f, 0.f, 0.f}, c1 = c0; bf16x8 fb[6], f0[6], f1[6]; \
                _Pragma("unroll") for (int ks = 0; ks < 4; ++ks) { const int ko = (32 * ks + 8 * l4) * 2; \
                    fb[ks] = *(const LAS bf16x8*)(lds + GL_QG + (16 * ti + l15) * 272 + ko); \
                    f0[ks] = *(const LAS bf16x8*)(lds + GL_ST + (16 * tv0 + l15) * 272 + ko); f1[ks] = *(const LAS bf16x8*)(lds + GL_ST + (16 * tv0 + 16 + l15) * 272 + ko); } \
                _Pragma("unroll") for (int ks = 0; ks < 2; ++ks) { const int ko = (32 * ks + 8 * l4) * 2; \
                    fb[4 + ks] = *(const LAS bf16x8*)(lds + GL_AM + (16 * ti + l15) * 144 + ko); \
                    f0[4 + ks] = *(const LAS bf16x8*)(lds + GL_VT + (16 * tv0 + l15) * 144 + ko); f1[4 + ks] = *(const LAS bf16x8*)(lds + GL_VT + (16 * tv0 + 16 + l15) * 144 + ko); } \
                _Pragma("unroll") for (int ks = 0; ks < 6; ++ks) { c0 = __builtin_amdgcn_mfma_f32_16x16x32_bf16(f0[ks], fb[ks], c0, 0, 0, 0); c1 = __builtin_amdgcn_mfma_f32_16x16x32_bf16(f1[ks], fb[ks], c1, 0, 0, 0); } \
                const int s_ = ch * 64 + 16 * ti + l15; const int t0 = s_ - 256; const int t = dir ? 2047 - t0 : t0; \
                bf16* orow = OF + ((size_t)dir * NT + b * 2048 + t) * 1024 + h * 256 + vs * 64 + 16 * tv0 + 4 * l4; \
                v2u p0, p1; p0.x = pk2(c0[0], c0[1]); p0.y = pk2(c0[2], c0[3]); p1.x = pk2(c1[0], c1[1]); p1.y = pk2(c1[2], c1[3]); \
                *(v2u*)(orow) = p0; *(v2u*)(orow + 16) = p1; } \
              \
            { const f32x4 d4 = *(const LAS f32x4*)(lds + GL_DEC + (16 * wave + 4 * l4) * 4); bf16x8 fk[2], fv[2][4]; \
              _Pragma("unroll") for (int ks = 0; ks < 2; ++ks) { const int ko = (32 * ks + 8 * l4) * 2; fk[ks] = *(const LAS bf16x8*)(lds + GL_KDT + (16 * wave + l15) * 144 + ko); \
                  _Pragma("unroll") for (int tv = 0; tv < 4; ++tv) fv[ks][tv] = *(const LAS bf16x8*)(lds + GL_VT + (16 * tv + l15) * 144 + ko); } \
              _Pragma("unroll") for (int tv = 0; tv < 4; ++tv) S[tv] = S[tv] * d4; \
              _Pragma("unroll") for (int ks = 0; ks < 2; ++ks) \
                  _Pragma("unroll") for (int tv = 0; tv < 4; ++tv) S[tv] = __builtin_amdgcn_mfma_f32_16x16x32_bf16(fk[ks], fv[ks][tv], S[tv], 0, 0, 0); } \
              \
            conv_finish(ct, ci, (LAS float*)(lds + GL_CONV + wave * 8448), lane); ++cstep; ci = conv_decode(a, cstep * (G * 8) + vcu * 8 + wave); conv_load(ct, ci, lane); \
            LDS_BARRIER(); } while (0)
        ci = conv_decode(a, cstep * (G * 8) + vcu * 8 + wave); conv_load(ct, ci, lane);
        GL_LOAD(0, false);
        GL_STEP(0, false, false, true); GL_STEP(1, false, false, true); GL_STEP(2, false, false, true); GL_STEP(3, false, true, true);
#pragma unroll 1
        for (int c2 = 4; c2 < 35; ++c2) { GL_STEP(c2, true, true, true); }
        GL_STEP(35, true, true, false);
#undef GL_STEP
#undef GL_LOAD
    }
    for (int id = cstep * (G * 8) + vcu * 8 + wave; id < 2 * I_E; id += G * 8) { const ConvItem c = conv_decode(a, id); f32x4 t[8]; conv_load(t, c, lane); conv_finish(t, c, (LAS float*)(lds + GL_CONV + wave * 8448), lane); }
}

template <int HALFW>
__device__ __forceinline__ void pool_item(const bf16* P, bf16* DP, LAS float* tmp, int tid, int b, int r, int g) {
    const int rlo = r - HALFW < 0 ? 0 : r - HALFW, rhi = r + HALFW > 32 ? 32 : r + HALFW;
    const float rinv = 1.f / (float)(rhi - rlo);
#pragma unroll 1
    for (int q = 0; q < 4; ++q) { const int p = tid + 512 * q, c = p >> 5, ch0 = (p & 31) * 8; float acc[8]; v4u x[2 * HALFW];
#pragma unroll
        for (int u = 0; u < 2 * HALFW; ++u) { const int rr = (rlo + u < rhi) ? rlo + u : rlo; x[u] = *(const v4u*)(P + ((size_t)(b * 2048 + rr * 64 + c)) * 1024 + g * 256 + ch0); }
#pragma unroll
        for (int j = 0; j < 8; ++j) acc[j] = 0.f;
#pragma unroll
        for (int u = 0; u < 2 * HALFW; ++u) { const float m = (rlo + u < rhi) ? 1.f : 0.f;
            acc[0] += m * bflo(x[u].x); acc[1] += m * bfhi(x[u].x); acc[2] += m * bflo(x[u].y); acc[3] += m * bfhi(x[u].y); acc[4] += m * bflo(x[u].z); acc[5] += m * bfhi(x[u].z); acc[6] += m * bflo(x[u].w); acc[7] += m * bfhi(x[u].w); }
        *(LAS f32x4*)(tmp + c * 256 + ch0) = (f32x4){acc[0] * rinv, acc[1] * rinv, acc[2] * rinv, acc[3] * rinv};
        *(LAS f32x4*)(tmp + c * 256 + ch0 + 4) = (f32x4){acc[4] * rinv, acc[5] * rinv, acc[6] * rinv, acc[7] * rinv}; }
    __syncthreads();
#pragma unroll 1
    for (int q = 0; q < 4; ++q) { const int p = tid + 512 * q, c = p >> 5, ch0 = (p & 31) * 8;
        const int clo = c - HALFW < 0 ? 0 : c - HALFW, chi = c + HALFW > 64 ? 64 : c + HALFW; const float cinv = 1.f / (float)(chi - clo);
        const size_t o = ((size_t)(b * 2048 + r * 64 + c)) * 1024 + g * 256 + ch0;
        const v4u x = *(const v4u*)(P + o);
        f32x4 a0 = (f32x4){0.f, 0.f, 0.f, 0.f}, a1 = a0;
#pragma unroll
        for (int u = 0; u < 2 * HALFW; ++u) { const int cc = (clo + u < chi) ? clo + u : clo; const float m = (clo + u < chi) ? 1.f : 0.f;
            a0 += *(const LAS f32x4*)(tmp + cc * 256 + ch0) * m; a1 += *(const LAS f32x4*)(tmp + cc * 256 + ch0 + 4) * m; }
        v4u d; d.x = pk2(a0[0] * cinv - bflo(x.x), a0[1] * cinv - bfhi(x.x)); d.y = pk2(a0[2] * cinv - bflo(x.y), a0[3] * cinv - bfhi(x.y));
        d.z = pk2(a1[0] * cinv - bflo(x.z), a1[1] * cinv - bfhi(x.z)); d.w = pk2(a1[2] * cinv - bflo(x.w), a1[3] * cinv - bfhi(x.w));
        *(v4u*)(DP + o) = d; }
    __syncthreads();
}
constexpr int CTL_POOL_TICKET = 15000;
__device__ __forceinline__ void phase3_pool(const Args& a, LAS unsigned char* lds, int tid, int vcu, int G) {
    const bf16* P = (const bf16*)(a.ws + RA_P); bf16* DP = (bf16*)(a.ws + RA_DPOOL);
    LAS float* tmp = (LAS float*)lds;
    unsigned* ctr = (unsigned*)(a.ws + WS_CTL) + CTL_POOL_TICKET;
    volatile LAS unsigned* tk = (volatile LAS unsigned*)(lds + LDS_MISC) + 16;
    unsigned nxt = 0;
    if (tid == 0) nxt = __hip_atomic_fetch_add(ctr, 1u, __ATOMIC_RELAXED, __HIP_MEMORY_SCOPE_AGENT);
    for (;;) {
        if (tid == 0) *tk = nxt;
        LDS_BARRIER();
        const int item = (int)*tk;
        if (item >= 1024) break;
        if (tid == 0) nxt = __hip_atomic_fetch_add(ctr, 1u, __ATOMIC_RELAXED, __HIP_MEMORY_SCOPE_AGENT);
        const int g = item >> 8, r = (item >> 3) & 31, b = item & 7;
        const int gg = 3 - g;
        if (gg == 0) pool_item<1>(P, DP, tmp, tid, b, r, gg); else if (gg == 1) pool_item<2>(P, DP, tmp, tid, b, r, gg); else if (gg == 2) pool_item<4>(P, DP, tmp, tid, b, r, gg); else pool_item<8>(P, DP, tmp, tid, b, r, gg);
    }
    LDS_BARRIER();
}

__device__ __forceinline__ void phase4_post(const Args& a, LAS unsigned char* lds, int lane, int wave, int vcu, int G) {
    const bf16* OF = (const bf16*)(a.ws + RA_OF); const bf16* OB = OF + (size_t)NT * 1024; const bf16* Rr = (const bf16*)(a.ws + RA_R); unsigned char* Y = a.ws + RA_YMIX;
    const float* gn = a.in[15];
    f32x4 g4[4];
#pragma unroll
    for (int q = 0; q < 4; ++q) g4[q] = *(const f32x4*)(gn + 16 * lane + 4 * q);
    int it = 0; ConvItem ci; f32x4 ct[8];
#pragma unroll 1
    for (int t0 = vcu * 8 + wave; t0 < NT; t0 += 2 * G * 8, ++it) {
        ci = conv_decode(a, 2 * I_E + N_DOWN_CHAIN + N_DOWN_PREP + it * (G * 8) + vcu * 8 + wave); conv_load(ct, ci, lane);
#pragma unroll
        for (int h2 = 0; h2 < 2; ++h2) { const int t = t0 + h2 * G * 8; if (t < NT) {
        const size_t o = (size_t)t * 1024 + 16 * lane;
        const v4u f0 = __builtin_nontemporal_load((const v4u*)(OF + o)), f1 = __builtin_nontemporal_load((const v4u*)(OF + o + 8)), b0 = __builtin_nontemporal_load((const v4u*)(OB + o)), b1 = __builtin_nontemporal_load((const v4u*)(OB + o + 8)), r0 = __builtin_nontemporal_load((const v4u*)(Rr + o)), r1 = __builtin_nontemporal_load((const v4u*)(Rr + o + 8));
        float x[16], r[16];
#pragma unroll
        for (int w = 0; w < 4; ++w) { x[2 * w] = bflo(f0[w]) + bflo(b0[w]); x[2 * w + 1] = bfhi(f0[w]) + bfhi(b0[w]); x[8 + 2 * w] = bflo(f1[w]) + bflo(b1[w]); x[8 + 2 * w + 1] = bfhi(f1[w]) + bfhi(b1[w]);
            r[2 * w] = bflo(r0[w]); r[2 * w + 1] = bfhi(r0[w]); r[8 + 2 * w] = bflo(r1[w]); r[8 + 2 * w + 1] = bfhi(r1[w]); }
        float ss = 0.f;
#pragma unroll
        for (int q = 0; q < 16; ++q) ss += x[q] * x[q];
        ss += dppf<0xB1>(ss); ss += dppf<0x4E>(ss); ss += dppf<0x141>(ss); ss += dppf<0x140>(ss);
        const float sc = rsqrtf(ss * (1.f / 256.f) + EPS);
        float y[16];
#pragma unroll
        for (int q = 0; q < 16; ++q) y[q] = x[q] * sc * g4[q >> 2][q & 3] * silu_f(r[q]);
        v4u o0;
#pragma unroll
        for (int w = 0; w < 4; ++w) o0[w] = pk4_fp8(y[4 * w] * SC_Y, y[4 * w + 1] * SC_Y, y[4 * w + 2] * SC_Y, y[4 * w + 3] * SC_Y);
        *(v4u*)(Y + (size_t)t * 2048 + 16 * lane) = o0;
        } }
        conv_finish(ct, ci, (LAS float*)(lds + wave * 16384), lane);
    }
}

__device__ __forceinline__ void phase6(const Args& a, LAS unsigned char* lds, int tid, int lane, int wave, int vcu, int G) {
    unsigned char* ws = a.ws;
    const float* mod = (const float*)(ws + WS_MOD); const bf16* Y1 = (const bf16*)(ws + RA_Y1); bf16* X1 = (bf16*)(ws + RA_X1); unsigned char* H2 = ws + RA_H2;
    const float* gpost = a.in[7]; const float* gpre2 = a.in[8]; const float* rbias = a.in[20];
    const bf16* whi = (const bf16*)(ws + WS_WRT);
    LAS float* part = (LAS float*)lds;
    LAS float* logit = (LAS float*)(lds + LDS_LOGIT);
    LAS u64* masks = (LAS u64*)(lds + LDS_MASKS);
    int* cnt = (int*)(ws + T_CNT); u64* tmask = (u64*)(ws + T_MASK); float* tokw = (float*)(ws + T_TOKW);
    const int l15 = lane & 15, l4 = lane >> 4;
    const float rb = rbias[lane];
    for (int blk = vcu; blk < NT / 64; blk += G) {
        for (int it = 0; it < 2; ++it) {
            bf16x8 bh[8][4];
#pragma unroll 1
            for (int rep_ = 0; rep_ < P7_REP_ROWS; ++rep_) {
#pragma unroll 1
            for (int rr = 0; rr < 4; ++rr) {
                const int lr = wave * 4 + rr, t = blk * 64 + it * 32 + lr; const float* mr = mod + (size_t)(t >> 11) * 12288;
                const bf16* yr = Y1 + (size_t)t * 2048; const float* xr = a.in[0] + (size_t)t * 2048;
                f32x4 y[8], xv[8]; v2u ybv[8]; float ss = 0.f;
#pragma unroll
                for (int j = 0; j < 8; ++j) { ybv[j] = __builtin_nontemporal_load((const v2u*)(yr + 4 * (lane + 64 * j))); xv[j] = __builtin_nontemporal_load((const f32x4*)(xr + 4 * (lane + 64 * j))); }
#pragma unroll
                for (int j = 0; j < 8; ++j) { const v2u yb = ybv[j]; y[j] = (f32x4){bflo(yb.x), bfhi(yb.x), bflo(yb.y), bfhi(yb.y)}; ss += y[j][0] * y[j][0] + y[j][1] * y[j][1] + y[j][2] * y[j][2] + y[j][3] * y[j][3]; }
                const float rstd1 = rsqrtf(wave_sum(ss) * (1.f / 2048.f) + EPS);
                float s2 = 0.f;
#pragma unroll
                for (int j = 0; j < 8; ++j) { const int c = 4 * (lane + 64 * j); const f32x4 x = xv[j], gp = *(const f32x4*)(gpost + c), gt = *(const f32x4*)(mr + 4096 + c);
                    const f32x4 x1 = x + gt * (y[j] * rstd1 * gp); y[j] = x1;
                    v2u xb; xb.x = pk2(x1[0], x1[1]); xb.y = pk2(x1[2], x1[3]); __builtin_nontemporal_store(xb, (v2u*)(X1 + (size_t)t * 2048 + c));
                    s2 += x1[0] * x1[0] + x1[1] * x1[1] + x1[2] * x1[2] + x1[3] * x1[3]; }
                const float rstd2 = rsqrtf(wave_sum(s2) * (1.f / 2048.f) + EPS);
#pragma unroll
                for (int j = 0; j < 8; ++j) { const int c = 4 * (lane + 64 * j); const f32x4 g2 = *(const f32x4*)(gpre2 + c), sh = *(const f32x4*)(mr + 6144 + c), sc = *(const f32x4*)(mr + 8192 + c);
                    const f32x4 hh = y[j] * rstd2 * g2 * (sc + 1.f) + sh;
                    v2u qh; qh.x = pk2(hh[0], hh[1]); qh.y = pk2(hh[2], hh[3]);
                    *(LAS v2u*)(lds + RT_HI + lr * RT_ROWB + c * 2) = qh;
                    *(unsigned*)(H2 + (size_t)t * 2048 + c) = pk4_fp8(hh[0] * SC_H, hh[1] * SC_H, hh[2] * SC_H, hh[3] * SC_H); }
            }
#pragma unroll
            for (int k8 = 0; k8 < 4; ++k8) { const int k0 = 256 * wave + 32 * k8 + 8 * l4;
#pragma unroll
                for (int et = 0; et < 4; ++et) bh[k8][et] = *(const bf16x8*)(whi + (size_t)(16 * et + l15) * 2048 + k0); }
            __syncthreads();
            }
#pragma unroll
            for (int k8 = 4; k8 < 8; ++k8) { const int k0 = 256 * wave + 32 * k8 + 8 * l4;
#pragma unroll
                for (int et = 0; et < 4; ++et) bh[k8][et] = *(const bf16x8*)(whi + (size_t)(16 * et + l15) * 2048 + k0); }
            { f32x4 acc[2][4];
#pragma unroll
              for (int mt = 0; mt < 2; ++mt)
#pragma unroll
                  for (int et = 0; et < 4; ++et) acc[mt][et] = (f32x4){0.f, 0.f, 0.f, 0.f};
#pragma unroll
              for (int k8 = 0; k8 < 8; ++k8) { const int k0 = 256 * wave + 32 * k8 + 8 * l4;
#pragma unroll
                  for (int mt = 0; mt < 2; ++mt) { const bf16x8 ah = *(const LAS bf16x8*)(lds + RT_HI + (16 * mt + l15) * RT_ROWB + k0 * 2);
#pragma unroll
                      for (int et = 0; et < 4; ++et) acc[mt][et] = __builtin_amdgcn_mfma_f32_16x16x32_bf16(ah, bh[k8][et], acc[mt][et], 0, 0, 0); } }
              __syncthreads();
#pragma unroll
              for (int mt = 0; mt < 2; ++mt)
#pragma unroll
                  for (int et = 0; et < 4; ++et)
#pragma unroll
                      for (int q = 0; q < 4; ++q) part[(wave * 32 + 16 * mt + 4 * l4 + q) * 64 + 16 * et + l15] = acc[mt][et][q]; }
            __syncthreads();
#pragma unroll
            for (int q = 0; q < 4; ++q) { const int idx = tid + 512 * q; float sacc = 0.f;
#pragma unroll
                for (int w = 0; w < 8; ++w) sacc += part[w * 2048 + idx];
                logit[idx] = sacc; }
            __syncthreads();
#pragma unroll 1
            for (int rep_ = 0; rep_ < P7_REP_RT; ++rep_) {
#pragma unroll 1
            for (int rr = 0; rr < 4; ++rr) {
                const int lr = wave * 4 + rr, t = blk * 64 + it * 32 + lr;
                const float lg = logit[lr * 64 + lane]; const float s = 1.f / (1.f + __expf(-lg)); const float sel = s + rb;
                float m1 = sel; m1 = fmaxf(m1, dppf<0xB1>(m1)); m1 = fmaxf(m1, dppf<0x4E>(m1)); m1 = fmaxf(m1, dppf<0x141>(m1));
                const u64 eq = __ballot(sel == m1); const unsigned gb = (unsigned)(eq >> (lane & ~7)) & 0xffu; const int first = __builtin_ctz(gb);
                float v2 = ((lane & 7) == first) ? -INFINITY : sel; v2 = fmaxf(v2, dppf<0xB1>(v2)); v2 = fmaxf(v2, dppf<0x4E>(v2)); v2 = fmaxf(v2, dppf<0x141>(v2));
                const float gs = m1 + v2; const int g = lane >> 3; int grank = 0;
#pragma unroll
                for (int g2 = 0; g2 < 8; ++g2) { const float o = __builtin_bit_cast(float, __builtin_amdgcn_readlane(__builtin_bit_cast(int, gs), g2 * 8)); grank += (o > gs || (o == gs && g2 < g)) ? 1 : 0; }
                const bool gsel = grank < 4; const float mk = gsel ? sel : -INFINITY; int rank = 0;
                const u64 gsm = __ballot(gsel);
#pragma unroll 1
                for (int g2 = 0; g2 < 8; ++g2) { if (!((gsm >> (8 * g2)) & 1ull)) continue;
#pragma unroll
                    for (int j2 = 0; j2 < 8; ++j2) { const int e2 = 8 * g2 + j2; const float o = __builtin_bit_cast(float, __builtin_amdgcn_readlane(__builtin_bit_cast(int, mk), e2)); rank += (o > mk || (o == mk && e2 < lane)) ? 1 : 0; } }
                const bool chosen = gsel && rank < 8;
                const u64 mask = __ballot(chosen); const float ssum = wave_sum(chosen ? s : 0.f);
                const int kidx = __popcll(mask & ((1ull << lane) - 1ull));
                if (chosen) tokw[(size_t)t * 8 + kidx] = s / ssum * 2.5f;
                if (lane == 0) { tmask[t] = mask; masks[it * 32 + lr] = mask; }
            }
            __syncthreads();
            }
        }
        if (wave == 0) { const u64 m = masks[lane]; int mine = 0;
#pragma unroll 8
            for (int e = 0; e < 64; ++e) { const int c = __popcll(__ballot((m >> e) & 1ull)); mine = (lane == e) ? c : mine; }
            cnt[blk * 64 + lane] = mine; }
        __syncthreads();
    }
}

__device__ __forceinline__ void phase7(const Args& a, LAS unsigned char* lds, int tid, int lane, int wave, int vcu, int G) {
    unsigned char* ws = a.ws;
    const int* cnt = (const int*)(ws + T_CNT); const u64* tmask = (const u64*)(ws + T_MASK); const float* tokw = (const float*)(ws + T_TOKW);
    int* tokslot = (int*)(ws + T_TOKSLOT); int* slottok = (int*)(ws + T_SLOTTOK); float* slotw = (float*)(ws + T_SLOTW); int* tile = (int*)(ws + T_TILE);
    LAS int* part = (LAS int*)(lds + 131072);
    bool converted = false;
    for (int blk = vcu; blk < NT / 64; blk += G) {
        int pre = 0, all = 0;
#pragma unroll 8
        for (int b2 = wave; b2 < 256; b2 += 8) { const int c = cnt[b2 * 64 + lane]; all += c; pre += (b2 < blk) ? c : 0; }
        part[(wave * 2) * 64 + lane] = pre; part[(wave * 2 + 1) * 64 + lane] = all;
        LDS_BARRIER();
        if (wave == 0) {
            int p = 0, t = 0;
#pragma unroll
            for (int w = 0; w < 8; ++w) { p += part[(w * 2) * 64 + lane]; t += part[(w * 2 + 1) * 64 + lane]; }
            int incl = t;
#pragma unroll
            for (int o = 1; o < 64; o <<= 1) { const int v = __shfl_up(incl, o); if (lane >= o) incl += v; }
            const int start = incl - t; const int base = start + p;
            const int tokn = blk * 64 + lane; const u64 m = tmask[tokn];
            const f32x4 wA = *(const f32x4*)(tokw + (size_t)tokn * 8), wB = *(const f32x4*)(tokw + (size_t)tokn * 8 + 4);
            float wv[8] = {wA[0], wA[1], wA[2], wA[3], wB[0], wB[1], wB[2], wB[3]}; int sl[8] = {0, 0, 0, 0, 0, 0, 0, 0};
#pragma unroll 8
            for (int e = 0; e < 64; ++e) { const bool bit = (m >> e) & 1ull; const u64 bal = __ballot(bit); const int be = __builtin_amdgcn_readlane(base, e);
                const int rank = __popcll(bal & ((1ull << lane) - 1ull)); const int slot = be + rank;
                if (bit) { slottok[slot] = tokn; slotw[slot] = wv[0]; }
#pragma unroll
                for (int j = 0; j < 7; ++j) { wv[j] = bit ? wv[j + 1] : wv[j]; sl[j] = bit ? sl[j + 1] : sl[j]; }
                sl[7] = bit ? slot : sl[7]; }
            { int* ts = tokslot + (size_t)tokn * 8; *(v4u*)(ts) = (v4u){(unsigned)sl[0], (unsigned)sl[1], (unsigned)sl[2], (unsigned)sl[3]}; *(v4u*)(ts + 4) = (v4u){(unsigned)sl[4], (unsigned)sl[5], (unsigned)sl[6], (unsigned)sl[7]}; }
            slottok[SH_ROW0 + tokn] = tokn; slotw[SH_ROW0 + tokn] = 1.f;
            if (blk == 0) {
                const int nte = (t + 255) >> 8; int inc2 = nte;
#pragma unroll
                for (int o = 1; o < 64; o <<= 1) { const int v = __shfl_up(inc2, o); if (lane >= o) inc2 += v; }
                const int n0 = inc2 - nte; const int ntot = __builtin_amdgcn_readlane(inc2, 63);
                for (int j = 0; j < nte; ++j) { tile[n0 + j] = lane; tile[NTILE_MAX + n0 + j] = start + j * 256; tile[2 * NTILE_MAX + n0 + j] = (t - j * 256) < 256 ? (t - j * 256) : 256; }
                tile[ntot + lane] = 64; tile[NTILE_MAX + ntot + lane] = SH_ROW0 + lane * 256; tile[2 * NTILE_MAX + ntot + lane] = 256;
                if (lane == 0) tile[3 * NTILE_MAX] = ntot + 64;
            }
        } else if (!converted) {
            converted = true;
            convert_items(a, (LAS float*)(lds + wave * 16384), lane, NITEMS_P0 + (G == 256 ? N_DOWN_CHAIN + N_DOWN_PREP + N_DOWN_POST : 0) + vcu * 7 + (wave - 1), G * 7, NITEMS);
        }
        LDS_BARRIER();
    }
}

__device__ __forceinline__ void phase10(const Args& a, LAS unsigned char* lds, int lane, int wave, int vcu, int G) {
    unsigned char* ws = a.ws;
    const float* mod = (const float*)(ws + WS_MOD); const unsigned char* SO = ws + WS_SLOTOUT; const int* tokslot = (const int*)(ws + T_TOKSLOT); const float* gp = a.in[9];
    LAS float* ysc = (LAS float*)(lds + wave * 8192);
    const unsigned lo16_ = 16u * (unsigned)lane;
    int nslot = tokslot[(size_t)(vcu * 8 + wave) * 8 + (lane & 7)];
#pragma unroll 1
    for (int t = vcu * 8 + wave; t < NT; t += G * 8) {
        const float* mr = mod + (size_t)(t >> 11) * 12288;
        const int myslot = lane < 8 ? nslot : SH_ROW0 + t;
        { const int tn = t + G * 8 < NT ? t + G * 8 : t; nslot = tokslot[(size_t)tn * 8 + (lane & 7)]; }
        unsigned lo16 = lo16_; asm volatile("" : "+v"(lo16));
        v4u x[9][2]; v2u xb[8];
        const unsigned char* x1r = (const unsigned char*)((const bf16*)(ws + RA_X1) + (size_t)t * 2048);
#pragma unroll
        for (int k = 0; k < 9; ++k) { const int slot = __builtin_amdgcn_readlane(myslot, k); const unsigned char* sr = SO + (size_t)slot * 2048;
#pragma unroll
            for (int j = 0; j < 2; ++j) x[k][j] = __builtin_nontemporal_load((const v4u*)(sr + (lo16 + 1024u * j))); }
#pragma unroll
        for (int j = 0; j < 8; ++j) xb[j] = __builtin_nontemporal_load((const v2u*)(x1r + (lo16 / 2u + 512u * j)));
        float y[2][16];
#pragma unroll
        for (int j = 0; j < 2; ++j)
#pragma unroll
            for (int q = 0; q < 16; ++q) y[j][q] = 0.f;
#pragma unroll
        for (int k = 0; k < 9; ++k)
#pragma unroll
            for (int j = 0; j < 2; ++j) { v4u v = x[k][j]; asm volatile("" : "+v"(v) : "v"(y[j][0]), "v"(y[j][15]));
#pragma unroll
                for (int w = 0; w < 4; ++w) { const unsigned d = v[w]; const auto lo = __builtin_amdgcn_cvt_pk_f32_fp8(d, false), hi = __builtin_amdgcn_cvt_pk_f32_fp8(d, true);
                    y[j][4 * w] += lo[0]; y[j][4 * w + 1] += lo[1]; y[j][4 * w + 2] += hi[0]; y[j][4 * w + 3] += hi[1]; } }
        float ss = 0.f;
#pragma unroll
        for (int j = 0; j < 2; ++j)
#pragma unroll
            for (int q = 0; q < 16; ++q) ss += y[j][q] * y[j][q];
        const float rstd = rsqrtf(wave_sum(ss) * (1.f / 2048.f) + EPS * SC_O * SC_O);
#pragma unroll
        for (int j = 0; j < 2; ++j)
#pragma unroll
            for (int q = 0; q < 4; ++q) *(LAS f32x4*)(ysc + 16 * (lane + 64 * j) + 4 * q) = (f32x4){y[j][4 * q], y[j][4 * q + 1], y[j][4 * q + 2], y[j][4 * q + 3]};
        LDS_WAIT(); asm volatile("" ::: "memory");
        unsigned char* outr = (unsigned char*)(a.out + (size_t)t * 2048); const unsigned char* gpb = (const unsigned char*)gp;
        const unsigned char* gt2b = (const unsigned char*)(mr + 10240);
#pragma unroll
        for (int j = 0; j < 8; ++j) { const unsigned cb = lo16 + 1024u * j; const f32x4 yy = *(const LAS f32x4*)(ysc + 4 * (lane + 64 * j)), g = *(const f32x4*)(gpb + cb), gt = *(const f32x4*)(gt2b + cb);
            const f32x4 x1 = (f32x4){bflo(xb[j].x), bfhi(xb[j].x), bflo(xb[j].y), bfhi(xb[j].y)};
            *(f32x4*)(outr + cb) = x1 + gt * (yy * rstd * g); }
        LDS_WAIT(); asm volatile("" ::: "memory");
    }
}

__global__ void __launch_bounds__(512, 2) fwd(Args args) {
    extern __shared__ __attribute__((aligned(16))) unsigned char lds_raw[];
    LAS unsigned char* lds = (LAS unsigned char*)lds_raw;
    const int tid = threadIdx.x, lane = tid & 63, wave = __builtin_amdgcn_readfirstlane(tid >> 6);
    const int G = gridDim.x, bx = blockIdx.x;
    const int vcu = (G % 8 == 0) ? (bx % 8) * (G / 8) + bx / 8 : bx;
    unsigned char* ws = args.ws;
    volatile LAS unsigned* MISC = (volatile LAS unsigned*)(lds + LDS_MISC);
    if (tid < 64) MISC[tid] = 0u;
    __syncthreads();
    const int lo = args.ph_lo, hi = args.ph_hi;
    XcdBarrier bar; bar.bar = (unsigned*)(ws + WS_CTL) + 4096; bar.x = 0; bar.st = nullptr;
    if (hi - lo > 1) bar = xcd_barrier_post((unsigned*)(ws + WS_CTL) + 4096, MISC + 8);
#ifndef PH_MASK
#define PH_MASK 0xfff
#endif
#define IN(k) (((PH_MASK >> (k)) & 1) && lo <= (k) && (k) < hi)
#define SEAM(k) do { if (IN(k) && IN((k) + 1)) xcd_barrier(bar); } while (0)

#ifndef REP_PHASE
#define REP_PHASE -1
#endif
#define PH_IDS int tz_ = threadIdx.x; asm volatile("" : "+v"(tz_)); const int tid = tz_, lane = tz_ & 63, wave = __builtin_amdgcn_readfirstlane(tz_ >> 6); (void)tid; (void)lane; (void)wave;
#define RUNPH(k, ...) do { if (IN(k)) { { PH_IDS __VA_ARGS__ } if (REP_PHASE == (k)) { xcd_barrier(bar); { PH_IDS __VA_ARGS__ } } SEAM(k); } } while (0)
#ifdef PROBE_P0
    if (IN(0)) { { PH_IDS phase0(args, lds, tid, lane, wave, vcu, G); } xcd_barrier(bar); { PH_IDS phase0(args, lds, tid, lane, wave, vcu, G, PROBE_P0 == 1, PROBE_P0 == 2); } SEAM(0); }
#else
    RUNPH(0, phase0(args, lds, tid, lane, wave, vcu, G););
#endif
    RUNPH(1, phase1(args, lane, wave, vcu, G););
    if (IN(2)) { { PH_IDS
        InSched S; S.D.init(ws + RA_H, ws + WS_WIN, 2048, 2048, NT, G == 256 ? 15 * 256 : DINP, G, bx); S.done = (unsigned*)(ws + WS_CTL) + CTL_INPROJ_DONE;
        EpiIn E{ws};
        pg8::gemm_phase<EpiIn, InSched>(lds, 2048, S, E); }
        if (IN(3)) { if (G == 256) {
                asm volatile("s_waitcnt vmcnt(0)" ::: "memory"); __syncthreads();
                if (threadIdx.x == 0) { unsigned* dn = (unsigned*)(ws + WS_CTL) + CTL_INPROJ_DONE; unsigned sp = 0;
                    while (xb_ld(dn) < 256u) { __builtin_amdgcn_s_sleep(1); if (++sp > XB_SPIN_CAP) break; }
                    __builtin_amdgcn_fence(__ATOMIC_ACQUIRE, "agent"); }
                __syncthreads(); }
            else xcd_barrier(bar); } }
#ifndef P3_REP_PREP
#define P3_REP_PREP 1
#endif
#ifndef P3_REP_POOL
#define P3_REP_POOL 1
#endif
    RUNPH(3, for (int r_ = 0; r_ < P3_REP_PREP; ++r_) phase3_prep(args, lds, tid, vcu, G, bx); for (int r_ = 0; r_ < P3_REP_POOL; ++r_) phase3_pool(args, lds, tid, vcu, G););
    RUNPH(4, phase_chain(args, lds, tid, lane, wave, vcu, G););
    RUNPH(5, {
        phase4_post(args, lds, lane, wave, vcu, G);
        LDS_BARRIER();
        PoolSched S{(const char*)(ws + RA_DPOOL), (const char*)(ws + WS_WPOOL), G, vcu};
        EpiPool E{ws + RA_YMIX, args.in[17]};
        int kpool = 256; asm volatile("" : "+s"(kpool));
        pg8::gemm_phase<EpiPool, PoolSched>(lds, kpool, S, E); });
    RUNPH(6, {
        DenseSched S; S.init(ws + RA_YMIX, ws + WS_WOUT, 1024, 1024, NT, 2048, G, bx);
        EpiOut E{(bf16*)(ws + RA_Y1)};
        int kout = 1024; asm volatile("" : "+s"(kout));
        pg8::gemm_phase<EpiOut, DenseSched, true>(lds, kout, S, E); });
    RUNPH(7, phase6(args, lds, tid, lane, wave, vcu, G););
    RUNPH(8, phase7(args, lds, tid, lane, wave, vcu, G););
    RUNPH(9, {
        MoeGUSched S{(const char*)(ws + RA_H2), (const char*)(ws + WS_WGU), (const int*)(ws + T_TILE), (const int*)(ws + T_SLOTTOK), G, vcu};
        EpiGU E{ws + WS_ACT, (const float*)(ws + T_SLOTW)};
        int kgu = 1024; asm volatile("" : "+s"(kgu));
        pg8::gemm_phase<EpiGU, MoeGUSched, true>(lds, kgu, S, E); });
    RUNPH(10, {
        MoeDownSched S{(const char*)(ws + WS_ACT), (const char*)(ws + WS_WD), (const int*)(ws + T_TILE), G, vcu};
        EpiDown E{ws + WS_SLOTOUT};
        int kdn = 256; asm volatile("" : "+s"(kdn));
        pg8::gemm_phase<EpiDown, MoeDownSched, true>(lds, kdn, S, E); });
    if (IN(11)) { { PH_IDS phase10(args, lds, lane, wave, vcu, G); } if (REP_PHASE == 11) { xcd_barrier(bar); { PH_IDS phase10(args, lds, lane, wave, vcu, G); } } }
#undef IN
#undef SEAM
}

extern "C" void kernel_launch(void* const* d_in, const int* in_sizes, int n_in, void* d_out, int out_size, void* d_ws, size_t ws_size, hipStream_t stream) {
    static int grid = 0;
    if (grid == 0) {
        if (n_in != 27 || out_size != NT * DM || ws_size < WS_NEED) { fprintf(stderr, "kernel_launch: unexpected problem: n_in %d out %d ws %zu (need %zu)\n", n_in, out_size, ws_size, (size_t)WS_NEED); grid = -1; return; }
        int dev = 0, cus = 0, per_cu = 0;
        if (hipGetDevice(&dev) != hipSuccess || hipDeviceGetAttribute(&cus, hipDeviceAttributeMultiprocessorCount, dev) != hipSuccess) { grid = -1; return; }
        if (hipFuncSetAttribute((const void*)fwd, hipFuncAttributeMaxDynamicSharedMemorySize, LDS_BYTES) != hipSuccess) { fprintf(stderr, "kernel_launch: hipFuncSetAttribute failed\n"); grid = -1; return; }
        if (hipOccupancyMaxActiveBlocksPerMultiprocessor(&per_cu, (const void*)fwd, 512, LDS_BYTES) != hipSuccess || per_cu < 1) { fprintf(stderr, "kernel_launch: occupancy query says %d\n", per_cu); }
        (void)hipGetLastError();
        grid = cus;
    }
    if (grid < 0) return;
    (void)hipMemsetAsync((char*)d_ws + WS_CTL, 0, CTL_ZERO_BYTES, stream);
    Args a{};
    for (int i = 0; i < 27; ++i) a.in[i] = (const float*)d_in[i];
    a.out = (float*)d_out; a.ws = (unsigned char*)d_ws;
    if (N_LAUNCHES == 1) {
        a.ph_lo = 0; a.ph_hi = NPH;
        hipLaunchKernelGGL(fwd, dim3(grid), dim3(512), LDS_BYTES, stream, a);
    } else {
        for (int p = 0; p < NPH; ++p) { a.ph_lo = p; a.ph_hi = p + 1; hipLaunchKernelGGL(fwd, dim3(grid), dim3(512), LDS_BYTES, stream, a); }
    }
}
```
